# Optimizing an MI355X kernel written in HIP

```python
import math
import jax, jax.numpy as jnp
from jax import lax
import numpy as np

D_MODEL = 1024
BATCH = 8
SEQ = 4096
DEPTH = 1

MIX_WIDTH = D_MODEL
RET_WIDTH = MIX_WIDTH // 2
ATT_WIDTH = MIX_WIDTH - RET_WIDTH
HEAD_DIM = 64
RET_HEADS = RET_WIDTH // HEAD_DIM
ATT_HEADS = ATT_WIDTH // HEAD_DIM
RET_CHUNK = 128
ROPE_BASE = 10000.0
DILATED_PATTERNS = ((128, 1), (512, 4), (2048, 16))
N_BUCKETS = 32
MAX_DISTANCE = 1024
N_EXPERTS = 16
CAPACITY_FACTOR = 2
D_FF = 2 * D_MODEL
EPS = 1e-6
PROJ_COLS = 4 * RET_WIDTH + 3 * ATT_WIDTH

kernel_name = "hybrid_retention_dilated_ecmoe_encoder"


def _rmsnorm(x, g):
    xf = x.astype(jnp.float32)
    y = xf * lax.rsqrt(jnp.mean(xf * xf, axis=-1, keepdims=True) + EPS)
    return (y * g.astype(jnp.float32)).astype(x.dtype)


def _heads(t, n_heads):
    b, s, _ = t.shape
    return t.reshape(b, s, n_heads, HEAD_DIM).transpose(0, 2, 1, 3)


def _merge_heads(t):
    b, h, s, dh = t.shape
    return t.transpose(0, 2, 1, 3).reshape(b, s, h * dh)


def _rope(x):
    s, dh = x.shape[2], x.shape[3]
    half = dh // 2
    pos = jnp.arange(s, dtype=jnp.float32)
    inv = ROPE_BASE ** (-jnp.arange(0, dh, 2, dtype=jnp.float32) / dh)
    ang = pos[:, None] * inv[None, :]
    cos, sin = jnp.cos(ang).astype(x.dtype), jnp.sin(ang).astype(x.dtype)
    x1, x2 = x[..., :half], x[..., half:]
    return jnp.concatenate([x1 * cos - x2 * sin, x2 * cos + x1 * sin], axis=-1)


def _retention_dir(q, k, v, log_g, strict):
    b, h, s, dh = q.shape
    c = RET_CHUNK
    n = s // c
    qc = q.reshape(b, h, n, c, dh)
    kc = k.reshape(b, h, n, c, dh)
    vc = v.reshape(b, h, n, c, dh)
    lg = log_g.astype(jnp.float32)
    idx = jnp.arange(c, dtype=jnp.float32)
    diff = idx[:, None] - idx[None, :]
    keep = (diff > 0) if strict else (diff >= 0)
    dmat = jnp.where(keep[None], jnp.exp(jnp.maximum(diff, 0.0)[None] * lg[:, None, None]), 0.0)
    scores = jnp.einsum('bhncd,bhnmd->bhncm', qc, kc) * dmat[:, None]
    inner = jnp.einsum('bhncm,bhnme->bhnce', scores, vc)
    zeta = jnp.exp((c - 1 - idx)[None, :] * lg[:, None])
    xi = jnp.exp((idx + 1)[None, :] * lg[:, None])
    g_chunk = jnp.exp(c * lg)[None, :, None, None]
    kv = jnp.einsum('bhnmd,hm,bhnme->bhnde', kc, zeta, vc)

    def step(state, kv_i):
        return g_chunk * state + kv_i, state

    _, r_prev = lax.scan(step, jnp.zeros_like(kv[:, :, 0]), jnp.moveaxis(kv, 2, 0))
    r_prev = jnp.moveaxis(r_prev, 0, 2)
    cross = jnp.einsum('bhncd,bhnde->bhnce', qc, r_prev) * xi[None, :, None, :, None]
    return (inner + cross).reshape(b, h, s, dh)


def _t5_bucket(rel):
    half = N_BUCKETS // 2
    max_exact = half // 2
    bucket = jnp.where(rel > 0, half, 0)
    n = jnp.abs(rel)
    nf = jnp.maximum(n, 1).astype(jnp.float32)
    large = max_exact + (jnp.log(nf / max_exact) / math.log(MAX_DISTANCE / max_exact)
                         * (half - max_exact)).astype(jnp.int32)
    large = jnp.minimum(large, half - 1)
    return bucket + jnp.where(n < max_exact, n, large)


def _dilated_pattern(q, k, v, rel_bias, window, dilation):
    b, h, s, dh = q.shape
    side = window // (2 * dilation)
    L = s // dilation
    qb = side
    nb = -(-L // qb)
    Lp = nb * qb

    def strided(t):
        return t.reshape(b, h, L, dilation, dh).transpose(0, 1, 3, 2, 4)

    qs = jnp.pad(strided(q), ((0, 0), (0, 0), (0, 0), (0, Lp - L), (0, 0))).reshape(b, h, dilation, nb, qb, dh)

    def neighbours(t):
        tp = jnp.pad(strided(t), ((0, 0), (0, 0), (0, 0), (qb, Lp - L + qb), (0, 0)))
        tp = tp.reshape(b, h, dilation, nb + 2, qb, dh)
        return jnp.concatenate([tp[:, :, :, 0:nb], tp[:, :, :, 1:nb + 1], tp[:, :, :, 2:nb + 2]], axis=4)

    ks, vs = neighbours(k), neighbours(v)
    t = jnp.arange(qb, dtype=jnp.int32)
    u = jnp.arange(3 * qb, dtype=jnp.int32)
    off = u[None, :] - qb - t[:, None]
    bias = rel_bias[_t5_bucket(off * dilation)].transpose(2, 0, 1).astype(jnp.float32)
    kpos = jnp.arange(nb, dtype=jnp.int32)[:, None] * qb + u[None, :] - qb
    valid = (jnp.abs(off) <= side)[None] & ((kpos >= 0) & (kpos < L))[:, None, :]
    logits = jnp.einsum('bhrnqd,bhrnkd->bhrnqk', qs, ks).astype(jnp.float32) * (dh ** -0.5)
    logits = logits + bias[None, :, None, None]
    logits = jnp.where(valid[None, None, None], logits, -1e30)
    m = jnp.max(logits, axis=-1, keepdims=True)
    p = jnp.exp(logits - m)
    l = jnp.sum(p, axis=-1, keepdims=True)
    o = jnp.einsum('bhrnqk,bhrnkd->bhrnqd', p, vs.astype(jnp.float32)) / l
    lse = (m + jnp.log(l))[..., 0]
    o = o.reshape(b, h, dilation, Lp, dh)[:, :, :, :L].transpose(0, 1, 3, 2, 4).reshape(b, h, s, dh)
    lse = lse.reshape(b, h, dilation, Lp)[..., :L].transpose(0, 1, 3, 2).reshape(b, h, s)
    return o, lse


def _dilated_mixture(q, k, v, rel_bias):
    outs, lses = [], []
    for window, dilation in DILATED_PATTERNS:
        o, lse = _dilated_pattern(q, k, v, rel_bias, window, dilation)
        outs.append(o)
        lses.append(lse)
    w = jax.nn.softmax(jnp.stack(lses, axis=0), axis=0)
    return sum(w[i][..., None] * outs[i] for i in range(len(outs)))


def _expert_choice_moe(h, w_router, w_gate, w_up, w_down):
    b, s, d = h.shape
    cap = CAPACITY_FACTOR * s // N_EXPERTS
    aff = jax.nn.softmax(jnp.einsum('bsd,de->bse', h, w_router).astype(jnp.float32), axis=-1)
    gates, idx = lax.top_k(aff.transpose(0, 2, 1), cap)
    xg = jax.vmap(lambda xb, ib: xb[ib])(h, idx)
    hid = jax.nn.silu(jnp.einsum('becd,edf->becf', xg, w_gate)) * jnp.einsum('becd,edf->becf', xg, w_up)
    y = jnp.einsum('becf,efd->becd', hid, w_down) * gates[..., None].astype(hid.dtype)
    out = jax.vmap(lambda yb, ib: jnp.zeros((s, d), yb.dtype).at[ib.reshape(-1)].add(yb.reshape(-1, d)))(y, idx)
    return out.astype(h.dtype)


def setup_inputs(seed: int = 0) -> dict:
    key = jax.random.key(seed)
    ks = jax.random.split(key, 13)
    f32 = jnp.float32
    base_decay = jnp.asarray(np.log(1.0 - 2.0 ** (-5.0 - np.arange(RET_HEADS))).astype(np.float32))
    return {
        "x": jax.random.normal(ks[0], (BATCH, SEQ, D_MODEL), f32),
        "norm1_gain": 1.0 + 0.02 * jax.random.normal(ks[1], (DEPTH, D_MODEL), f32),
        "w_in": jax.random.normal(ks[2], (DEPTH, D_MODEL, PROJ_COLS), f32) * D_MODEL ** -0.5,
        "ret_log_decay": base_decay[None, None, :] * (1.0 + 0.05 * jax.random.normal(ks[3], (DEPTH, 2, RET_HEADS), f32)),
        "ret_gn_gain": 1.0 + 0.02 * jax.random.normal(ks[4], (DEPTH, RET_WIDTH), f32),
        "rel_bias": 0.5 * jax.random.normal(ks[5], (N_BUCKETS, ATT_HEADS), f32),
        "w_out": jax.random.normal(ks[6], (DEPTH, MIX_WIDTH, D_MODEL), f32) * MIX_WIDTH ** -0.5,
        "norm2_gain": 1.0 + 0.02 * jax.random.normal(ks[7], (DEPTH, D_MODEL), f32),
        "w_router": jax.random.normal(ks[8], (DEPTH, D_MODEL, N_EXPERTS), f32) * D_MODEL ** -0.5,
        "w_gate": jax.random.normal(ks[9], (DEPTH, N_EXPERTS, D_MODEL, D_FF), f32) * D_MODEL ** -0.5,
        "w_up": jax.random.normal(ks[10], (DEPTH, N_EXPERTS, D_MODEL, D_FF), f32) * D_MODEL ** -0.5,
        "w_down": jax.random.normal(ks[11], (DEPTH, N_EXPERTS, D_FF, D_MODEL), f32) * D_FF ** -0.5,
        "final_gain": 1.0 + 0.02 * jax.random.normal(ks[12], (D_MODEL,), f32),
    }


def reference(x, norm1_gain, w_in, ret_log_decay, ret_gn_gain, rel_bias, w_out,
              norm2_gain, w_router, w_gate, w_up, w_down, final_gain):
    splits = [RET_WIDTH, 2 * RET_WIDTH, 3 * RET_WIDTH, 4 * RET_WIDTH,
              4 * RET_WIDTH + ATT_WIDTH, 4 * RET_WIDTH + 2 * ATT_WIDTH]
    for layer in range(DEPTH):
        h = _rmsnorm(x, norm1_gain[layer])
        proj = jnp.einsum('bsd,dp->bsp', h, w_in[layer])
        rq, rk, rv, rg, aq, ak, av = jnp.split(proj, splits, axis=-1)

        rq = _rope(_heads(rq, RET_HEADS))
        rk = _rope(_heads(rk, RET_HEADS)) * (HEAD_DIM ** -0.5)
        rv = _heads(rv, RET_HEADS)
        fwd = _retention_dir(rq, rk, rv, ret_log_decay[layer, 0], False)
        bwd = jnp.flip(_retention_dir(jnp.flip(rq, 2), jnp.flip(rk, 2), jnp.flip(rv, 2),
                                      ret_log_decay[layer, 1], True), 2)
        r = (fwd + bwd).astype(jnp.float32)
        mu = jnp.mean(r, axis=-1, keepdims=True)
        var = jnp.mean(jnp.square(r - mu), axis=-1, keepdims=True)
        r = _merge_heads((r - mu) * lax.rsqrt(var + EPS)) * ret_gn_gain[layer].astype(jnp.float32)
        r = (jax.nn.silu(rg.astype(jnp.float32)) * r).astype(x.dtype)

        a = _dilated_mixture(_heads(aq, ATT_HEADS), _heads(ak, ATT_HEADS), _heads(av, ATT_HEADS), rel_bias)
        a = _merge_heads(a).astype(x.dtype)

        mixed = jnp.concatenate([r, a], axis=-1)
        x = x + jnp.einsum('bsm,md->bsd', mixed, w_out[layer])

        h2 = _rmsnorm(x, norm2_gain[layer])
        x = x + _expert_choice_moe(h2, w_router[layer], w_gate[layer], w_up[layer], w_down[layer])
    return _rmsnorm(x, final_gain)
```

```cpp
#include <hip/hip_runtime.h>
#include <cstdint>
#include <cstdio>

typedef unsigned short bf16_t;
#define DEV __device__ __forceinline__

constexpr int NB = 8, S = 4096, D = 1024, M = NB * S;
constexpr int NH = 8, HD = 64, PC = 3584;
constexpr int NE = 16, CAP = 512, DFF = 2048, MR = NE * NB * CAP;
constexpr int NCH = 32, CH = 128;
constexpr float EPS = 1e-6f, LOG2E = 1.4426950408889634f;

constexpr size_t MiB = 1u << 20;
constexpr size_t WS_CTL = 0;
constexpr size_t WS_ROPE = 1 * MiB;
constexpr size_t WS_BIAS = 2 * MiB;
constexpr size_t WS_IDX = 2 * MiB + 512 * 1024;
constexpr size_t WS_AFF = 3 * MiB;
constexpr size_t WS_INV = 5 * MiB;
constexpr size_t WS_WOUT = 7 * MiB;
constexpr size_t WS_WIN = 9 * MiB;
constexpr size_t WS_XN = 16 * MiB;
constexpr size_t WS_RQ = 80 * MiB, WS_RK = 112 * MiB, WS_RV = 144 * MiB, WS_RG = 176 * MiB;
constexpr size_t WS_AQ = 208 * MiB, WS_AK = 240 * MiB, WS_AV = 272 * MiB;
constexpr size_t WS_ATTO = 304 * MiB;
constexpr size_t WS_ATTL = 400 * MiB;
constexpr size_t WS_KF = 403 * MiB;
constexpr size_t WS_ST = 208 * MiB;
constexpr size_t WS_WD = 80 * MiB;
constexpr size_t WS_WGU = 144 * MiB;
constexpr size_t WS_Y = 144 * MiB;
constexpr size_t WS_HID = 272 * MiB;
constexpr size_t WS_END = 528 * MiB;

DEV unsigned f2bf(float f) { unsigned u = __float_as_uint(f); return (u + 0x7fffu + ((u >> 16) & 1u)) >> 16; }
DEV float bf2f(unsigned h) { return __uint_as_float(h << 16); }
DEV unsigned pk2(float lo, float hi) { return f2bf(lo) | (f2bf(hi) << 16); }
DEV float wave_sum(float v) {
#pragma unroll
    for (int o = 1; o < 64; o <<= 1) v += __shfl_xor(v, o);
    return v;
}

__global__ void k_prep_tables(float* ropeT, float* biasT, const float* rel_bias) {
    int t = blockIdx.x * blockDim.x + threadIdx.x;
    if (t < S * 32) {
        int pos = t >> 5, i = t & 31;
        double inv = pow(10000.0, -(double)i / 32.0);
        double ang = (double)pos * inv;
        ropeT[t] = (float)cos(ang); ropeT[S * 32 + t] = (float)sin(ang);
    }
    if (t < 3 * NH * 129) {
        int p = t / (NH * 129), h = (t / 129) % NH, o = t % 129 - 64;
        int dil = p == 0 ? 1 : (p == 1 ? 4 : 16);
        int rel = o * dil, n = rel < 0 ? -rel : rel;
        int bucket = rel > 0 ? 16 : 0;
        if (n < 8) bucket += n;
        else { int large = 8 + (int)(log((double)n / 8.0) / log(128.0) * 8.0); if (large > 15) large = 15; bucket += large; }
        biasT[t] = rel_bias[bucket * NH + h] * LOG2E;
    }
}
__global__ __launch_bounds__(256) void k_prep_xn(const float* x, const float* g, bf16_t* XN) {
    int lane = threadIdx.x & 63, row = blockIdx.x * 4 + (threadIdx.x >> 6);
    const float4* xr = (const float4*)(x + (size_t)row * D) + lane;
    float4 v[4]; float s = 0.f;
#pragma unroll
    for (int j = 0; j < 4; ++j) { v[j] = xr[64 * j]; s += v[j].x * v[j].x + v[j].y * v[j].y + v[j].z * v[j].z + v[j].w * v[j].w; }
    float rs = rsqrtf(wave_sum(s) * (1.f / D) + EPS);
    uint2* o = (uint2*)(XN + (size_t)row * D) + lane;
#pragma unroll
    for (int j = 0; j < 4; ++j) { float4 gg = ((const float4*)g)[lane + 64 * j];
        o[64 * j] = make_uint2(pk2(v[j].x * rs * gg.x, v[j].y * rs * gg.y), pk2(v[j].z * rs * gg.z, v[j].w * rs * gg.w)); }
}
template <int MODE> DEV int rowmap(int n) {
    if (MODE == 0) return n;
    if (MODE == 1) { if (n >= 1024) return n; int base = n & ~63, d = n & 63; int nn = d >> 5, dd = d & 31; return base + 8 * (dd >> 2) + 4 * nn + (dd & 3); }
    if (MODE == 2) return (n >> 7) * 256 + (n & 127);
    return (n >> 7) * 256 + 128 + (n & 127);
}
template <int MODE> __global__ __launch_bounds__(256) void k_transpose(const float* src, bf16_t* dst, int K, int N, size_t src_estride, size_t dst_estride) {
    __shared__ float t[64][65];
    src += (size_t)blockIdx.z * src_estride; dst += (size_t)blockIdx.z * dst_estride;
    int k0 = blockIdx.y * 64, n0 = blockIdx.x * 64, tid = threadIdx.x;
#pragma unroll
    for (int i = 0; i < 4; ++i) { int kk = (tid >> 4) + 16 * i, c = (tid & 15) * 4;
        float4 v = *(const float4*)(src + (size_t)(k0 + kk) * N + n0 + c);
        t[kk][c] = v.x; t[kk][c + 1] = v.y; t[kk][c + 2] = v.z; t[kk][c + 3] = v.w; }
    __syncthreads();
#pragma unroll
    for (int i = 0; i < 2; ++i) { int n = (tid >> 3) + 32 * i, c = (tid & 7) * 8;
        uint4 o; o.x = pk2(t[c][n], t[c + 1][n]); o.y = pk2(t[c + 2][n], t[c + 3][n]); o.z = pk2(t[c + 4][n], t[c + 5][n]); o.w = pk2(t[c + 6][n], t[c + 7][n]);
        *(uint4*)(dst + (size_t)rowmap<MODE>(n0 + n) * K + k0 + c) = o; }
}

template <int MODE, class F> __global__ __launch_bounds__(256) void k_gemm_naive(F f, int K) {
    __shared__ float As[32][68]; __shared__ float Bs[32][132];
    const int tid = threadIdx.x, tx = tid & 15, ty = tid >> 4, bx = blockIdx.x, by = blockIdx.y;
    const int lr = tid >> 2, kc = (tid & 3) * 8;
    const bf16_t* ap = f.a_row(bx * 64 + lr) + kc;
    const bf16_t* bp0 = f.b_row(bx, by, lr) + kc;
    const bf16_t* bp1 = f.b_row(bx, by, 64 + lr) + kc;
    const int clo = MODE == 0 ? 8 * tx : 4 * tx, chi = MODE == 0 ? 8 * tx + 4 : 64 + 4 * tx;
    float lo[4][4], hi[4][4];
#pragma unroll
    for (int r = 0; r < 4; ++r)
#pragma unroll
        for (int i = 0; i < 4; ++i) { lo[r][i] = 0.f; hi[r][i] = 0.f; }
    for (int k0 = 0; k0 < K; k0 += 32) {
        uint4 av = *(const uint4*)(ap + k0), b0 = *(const uint4*)(bp0 + k0), b1 = *(const uint4*)(bp1 + k0);
        __syncthreads();
        const unsigned aw[4] = {av.x, av.y, av.z, av.w}, b0w[4] = {b0.x, b0.y, b0.z, b0.w}, b1w[4] = {b1.x, b1.y, b1.z, b1.w};
#pragma unroll
        for (int j = 0; j < 4; ++j) {
            As[kc + 2 * j][lr] = bf2f(aw[j] & 0xffffu); As[kc + 2 * j + 1][lr] = bf2f(aw[j] >> 16);
            Bs[kc + 2 * j][lr] = bf2f(b0w[j] & 0xffffu); Bs[kc + 2 * j + 1][lr] = bf2f(b0w[j] >> 16);
            Bs[kc + 2 * j][64 + lr] = bf2f(b1w[j] & 0xffffu); Bs[kc + 2 * j + 1][64 + lr] = bf2f(b1w[j] >> 16);
        }
        __syncthreads();
#pragma unroll 8
        for (int k = 0; k < 32; ++k) {
            const float4 a = *(const float4*)&As[k][ty * 4], p = *(const float4*)&Bs[k][clo], q = *(const float4*)&Bs[k][chi];
            const float ar[4] = {a.x, a.y, a.z, a.w}, pr[4] = {p.x, p.y, p.z, p.w}, qr[4] = {q.x, q.y, q.z, q.w};
#pragma unroll
            for (int r = 0; r < 4; ++r)
#pragma unroll
                for (int i = 0; i < 4; ++i) { lo[r][i] += ar[r] * pr[i]; hi[r][i] += ar[r] * qr[i]; }
        }
    }
#pragma unroll
    for (int r = 0; r < 4; ++r) f.store(bx * 64 + ty * 4 + r, bx, by, tx, lo[r], hi[r]);
}

struct FInProj {
    const bf16_t* XN; const bf16_t* Win; unsigned char* ws; const float* ropeT;
    DEV const bf16_t* a_row(int g) const { return XN + (size_t)g * D; }
    DEV const bf16_t* b_row(int, int by, int l) const { return Win + (size_t)(by * 128 + l) * D; }
    DEV void store(int g, int, int by, int tx, const float* lo, const float* hi) const {
        const int J0 = by * 128 + 8 * tx, grp = J0 >> 9, within = J0 & 511, hd = within >> 6, j0 = within & 63, b = g >> 12, s = g & 4095;
        bf16_t* dst = (bf16_t*)(ws + WS_RQ + (size_t)grp * 32 * MiB) + ((size_t)(b * NH + hd) * S + s) * HD + j0;
        float o[8];
        if (grp < 2) {
            const int gg = j0 >> 3; const float sc = grp == 1 ? 0.125f : 1.f;
#pragma unroll
            for (int i = 0; i < 4; ++i) { const float c = ropeT[s * 32 + 4 * gg + i], sn = ropeT[S * 32 + s * 32 + 4 * gg + i];
                o[i] = (lo[i] * c - hi[i] * sn) * sc; o[4 + i] = (hi[i] * c + lo[i] * sn) * sc; }
        } else {
            const float sc = grp == 4 ? 0.125f * LOG2E : 1.f;
#pragma unroll
            for (int i = 0; i < 4; ++i) { o[i] = lo[i] * sc; o[4 + i] = hi[i] * sc; }
        }
        *(uint4*)dst = make_uint4(pk2(o[0], o[1]), pk2(o[2], o[3]), pk2(o[4], o[5]), pk2(o[6], o[7]));
    }
};
struct FOutProj {
    const bf16_t* mixed; const bf16_t* Wout; const float* x; float* x1;
    DEV const bf16_t* a_row(int g) const { return mixed + (size_t)g * D; }
    DEV const bf16_t* b_row(int, int by, int l) const { return Wout + (size_t)(by * 128 + l) * D; }
    DEV void store(int g, int, int by, int tx, const float* lo, const float* hi) const {
        const size_t off = (size_t)g * D + by * 128 + 8 * tx;
        const float4 a = *(const float4*)(x + off), b = *(const float4*)(x + off + 4);
        *(float4*)(x1 + off) = make_float4(a.x + lo[0], a.y + lo[1], a.z + lo[2], a.w + lo[3]);
        *(float4*)(x1 + off + 4) = make_float4(b.x + hi[0], b.y + hi[1], b.z + hi[2], b.w + hi[3]);
    }
};
struct FExp1 {
    const bf16_t* H2b; const bf16_t* Wgu; const int* idx; bf16_t* hid;
    DEV const bf16_t* a_row(int g) const { const int e = g >> 12, bb = (g >> 9) & 7; return H2b + ((size_t)bb * S + idx[g]) * D; (void)e; }
    DEV const bf16_t* b_row(int bx, int by, int l) const { const int e = bx >> 6, hc0 = by * 64, tile = hc0 >> 7, c0 = hc0 & 127;
        return Wgu + ((size_t)e * 4096 + tile * 256 + (l < 64 ? c0 + l : 128 + c0 + l - 64)) * D; }
    DEV void store(int g, int, int by, int tx, const float* lo, const float* hi) const {
        float o[4];
#pragma unroll
        for (int i = 0; i < 4; ++i) o[i] = lo[i] / (1.f + __expf(-lo[i])) * hi[i];
        *(uint2*)(hid + (size_t)g * DFF + by * 64 + 4 * tx) = make_uint2(pk2(o[0], o[1]), pk2(o[2], o[3]));
    }
};
struct FExp2 {
    const bf16_t* hid; const bf16_t* Wd; bf16_t* y;
    DEV const bf16_t* a_row(int g) const { return hid + (size_t)g * DFF; }
    DEV const bf16_t* b_row(int bx, int by, int l) const { const int e = bx >> 6; return Wd + ((size_t)e * 1024 + by * 128 + l) * DFF; }
    DEV void store(int g, int, int by, int tx, const float* lo, const float* hi) const {
        *(uint4*)(y + (size_t)g * D + by * 128 + 8 * tx) = make_uint4(pk2(lo[0], lo[1]), pk2(lo[2], lo[3]), pk2(hi[0], hi[1]), pk2(hi[2], hi[3]));
    }
};

__global__ __launch_bounds__(256) void k_ret_naive(const bf16_t* RQ, const bf16_t* RK, const bf16_t* RV, const bf16_t* RG, const float* logdecay, const float* gn_gain, bf16_t* mixed) {
    __shared__ float Ks[32][64]; __shared__ float Vs[32][64];
    const int tid = threadIdx.x, h = blockIdx.y, b = blockIdx.z, i = blockIdx.x * 256 + tid;
    const size_t hb = (size_t)(b * NH + h) * S * HD;
    float q[64], acc[64];
    { const uint4* qp = (const uint4*)(RQ + hb + (size_t)i * HD);
#pragma unroll
      for (int c = 0; c < 8; ++c) { uint4 w = qp[c]; const unsigned ww[4] = {w.x, w.y, w.z, w.w};
#pragma unroll
          for (int j = 0; j < 4; ++j) { q[c * 8 + 2 * j] = bf2f(ww[j] & 0xffffu); q[c * 8 + 2 * j + 1] = bf2f(ww[j] >> 16); } } }
#pragma unroll
    for (int d = 0; d < 64; ++d) acc[d] = 0.f;
    const float lg0 = logdecay[h] * LOG2E, lg1 = logdecay[NH + h] * LOG2E;
    for (int j0 = 0; j0 < S; j0 += 32) {
        __syncthreads();
        { const int r = tid >> 3, c = (tid & 7) * 8;
          uint4 kw = *(const uint4*)(RK + hb + (size_t)(j0 + r) * HD + c), vw = *(const uint4*)(RV + hb + (size_t)(j0 + r) * HD + c);
          const unsigned k4[4] = {kw.x, kw.y, kw.z, kw.w}, v4[4] = {vw.x, vw.y, vw.z, vw.w};
#pragma unroll
          for (int j = 0; j < 4; ++j) { Ks[r][c + 2 * j] = bf2f(k4[j] & 0xffffu); Ks[r][c + 2 * j + 1] = bf2f(k4[j] >> 16); Vs[r][c + 2 * j] = bf2f(v4[j] & 0xffffu); Vs[r][c + 2 * j + 1] = bf2f(v4[j] >> 16); } }
        __syncthreads();
        for (int jj = 0; jj < 32; ++jj) {
            float s = 0.f;
#pragma unroll
            for (int d = 0; d < 64; d += 4) { const float4 kk = *(const float4*)&Ks[jj][d]; s += q[d] * kk.x + q[d + 1] * kk.y + q[d + 2] * kk.z + q[d + 3] * kk.w; }
            const int j = j0 + jj; const float dec = j <= i ? exp2f(lg0 * (float)(i - j)) : exp2f(lg1 * (float)(j - i));
            s *= dec;
#pragma unroll
            for (int d = 0; d < 64; d += 4) { const float4 vv = *(const float4*)&Vs[jj][d]; acc[d] += s * vv.x; acc[d + 1] += s * vv.y; acc[d + 2] += s * vv.z; acc[d + 3] += s * vv.w; }
        }
    }
    float mu = 0.f;
#pragma unroll
    for (int d = 0; d < 64; ++d) mu += acc[d];
    mu *= (1.f / 64.f); float var = 0.f;
#pragma unroll
    for (int d = 0; d < 64; ++d) { const float t = acc[d] - mu; var += t * t; }
    const float rstd = rsqrtf(var * (1.f / 64.f) + EPS);
    const bf16_t* gp = RG + hb + (size_t)i * HD; bf16_t* op = mixed + ((size_t)b * S + i) * D + h * HD;
#pragma unroll
    for (int d = 0; d < 64; d += 2) {
        const float g0 = bf2f(gp[d]), g1 = bf2f(gp[d + 1]);
        const float o0 = (acc[d] - mu) * rstd * gn_gain[h * HD + d] * (g0 / (1.f + __expf(-g0)));
        const float o1 = (acc[d + 1] - mu) * rstd * gn_gain[h * HD + d + 1] * (g1 / (1.f + __expf(-g1)));
        *(unsigned*)(op + d) = pk2(o0, o1);
    }
}
__global__ __launch_bounds__(256) void k_attn_naive(const bf16_t* AQ, const bf16_t* AK, const bf16_t* AV, const float* biasT, bf16_t* mixed) {
    const int tid = threadIdx.x, h = blockIdx.y, b = blockIdx.z, i = blockIdx.x * 256 + tid;
    const size_t hb = (size_t)(b * NH + h) * S * HD;
    float q[64], acc[64];
    { const uint4* qp = (const uint4*)(AQ + hb + (size_t)i * HD);
#pragma unroll
      for (int c = 0; c < 8; ++c) { uint4 w = qp[c]; const unsigned ww[4] = {w.x, w.y, w.z, w.w};
#pragma unroll
          for (int j = 0; j < 4; ++j) { q[c * 8 + 2 * j] = bf2f(ww[j] & 0xffffu); q[c * 8 + 2 * j + 1] = bf2f(ww[j] >> 16); } } }
#pragma unroll
    for (int d = 0; d < 64; ++d) acc[d] = 0.f;
    float m = -1e30f, l = 0.f;
    for (int p = 0; p < 3; ++p) {
        const int dil = p == 0 ? 1 : (p == 1 ? 4 : 16);
        for (int o = -64; o <= 64; ++o) {
            const int kp = i + o * dil; if (kp < 0 || kp >= S) continue;
            const uint4* kr = (const uint4*)(AK + hb + (size_t)kp * HD); float s = 0.f;
#pragma unroll
            for (int c = 0; c < 8; ++c) { uint4 w = kr[c]; const unsigned ww[4] = {w.x, w.y, w.z, w.w};
#pragma unroll
                for (int j = 0; j < 4; ++j) s += q[c * 8 + 2 * j] * bf2f(ww[j] & 0xffffu) + q[c * 8 + 2 * j + 1] * bf2f(ww[j] >> 16); }
            s += biasT[(p * NH + h) * 129 + o + 64];
            const float mn = fmaxf(m, s), f = exp2f(m - mn), pe = exp2f(s - mn); m = mn; l = l * f + pe;
            const uint4* vr = (const uint4*)(AV + hb + (size_t)kp * HD);
#pragma unroll
            for (int c = 0; c < 8; ++c) { uint4 w = vr[c]; const unsigned ww[4] = {w.x, w.y, w.z, w.w};
#pragma unroll
                for (int j = 0; j < 4; ++j) { acc[c * 8 + 2 * j] = acc[c * 8 + 2 * j] * f + pe * bf2f(ww[j] & 0xffffu); acc[c * 8 + 2 * j + 1] = acc[c * 8 + 2 * j + 1] * f + pe * bf2f(ww[j] >> 16); } }
        }
    }
    const float il = 1.f / l; bf16_t* op = mixed + ((size_t)b * S + i) * D + 512 + h * HD;
#pragma unroll
    for (int d = 0; d < 64; d += 2) *(unsigned*)(op + d) = pk2(acc[d] * il, acc[d + 1] * il);
}

__global__ __launch_bounds__(256) void k_router(const float* x1, const float* g2, const float* wr, bf16_t* H2b, float* aff, int* inv) {
    const int lane = threadIdx.x & 63, row = blockIdx.x * 4 + (threadIdx.x >> 6);
    const float4* xr = (const float4*)(x1 + (size_t)row * D) + lane;
    float4 v[4]; float s = 0.f;
#pragma unroll
    for (int j = 0; j < 4; ++j) { v[j] = xr[64 * j]; s += v[j].x * v[j].x + v[j].y * v[j].y + v[j].z * v[j].z + v[j].w * v[j].w; }
    const float rs = rsqrtf(wave_sum(s) * (1.f / D) + EPS);
    float lg[16];
#pragma unroll
    for (int e = 0; e < 16; ++e) lg[e] = 0.f;
    uint2* o = (uint2*)(H2b + (size_t)row * D) + lane;
#pragma unroll
    for (int j = 0; j < 4; ++j) { const float4 gg = ((const float4*)g2)[lane + 64 * j];
        const float hv[4] = {v[j].x * rs * gg.x, v[j].y * rs * gg.y, v[j].z * rs * gg.z, v[j].w * rs * gg.w};
        o[64 * j] = make_uint2(pk2(hv[0], hv[1]), pk2(hv[2], hv[3]));
#pragma unroll
        for (int t = 0; t < 4; ++t) { const float4* w4 = (const float4*)(wr + (size_t)(4 * lane + 256 * j + t) * NE);
#pragma unroll
            for (int c = 0; c < 4; ++c) { const float4 w = w4[c]; lg[4 * c] += hv[t] * w.x; lg[4 * c + 1] += hv[t] * w.y; lg[4 * c + 2] += hv[t] * w.z; lg[4 * c + 3] += hv[t] * w.w; } } }
    float mx = -1e30f;
#pragma unroll
    for (int e = 0; e < 16; ++e) { lg[e] = wave_sum(lg[e]); mx = fmaxf(mx, lg[e]); }
    float sum = 0.f;
#pragma unroll
    for (int e = 0; e < 16; ++e) { lg[e] = __expf(lg[e] - mx); sum += lg[e]; }
    const float is = 1.f / sum;
    if (lane < 16) { float a = 0.f;
#pragma unroll
        for (int e = 0; e < 16; ++e) a = lane == e ? lg[e] * is : a;
        aff[(size_t)row * NE + lane] = a; inv[(size_t)row * NE + lane] = -1; }
}
__global__ __launch_bounds__(256) void k_topk_naive(const float* aff, int* idx, int* inv) {
    __shared__ float a[S];
    const int e = blockIdx.x, b = blockIdx.y, tid = threadIdx.x;
    for (int s = tid; s < S; s += 256) a[s] = aff[((size_t)b * S + s) * NE + e];
    __syncthreads();
    for (int s = tid; s < S; s += 256) { const float v = a[s]; int rank = 0;
        for (int j = 0; j < S; ++j) { const float w = a[j]; rank += (w > v) || (w == v && j < s); }
        if (rank < CAP) { idx[(e * NB + b) * CAP + rank] = s; inv[((size_t)b * S + s) * NE + e] = rank; } }
}
__global__ __launch_bounds__(256) void k_final(float* xo, const float* aff, const int* inv, const bf16_t* y, const float* fg) {
    const int lane = threadIdx.x & 63, row = blockIdx.x * 4 + (threadIdx.x >> 6), b = row >> 12;
    float4* xr = (float4*)(xo + (size_t)row * D) + lane;
    float4 v[4];
#pragma unroll
    for (int j = 0; j < 4; ++j) v[j] = xr[64 * j];
    for (int e = 0; e < NE; ++e) { const int sl = inv[(size_t)row * NE + e]; if (sl < 0) continue;
        const float g = aff[(size_t)row * NE + e]; const uint2* yr = (const uint2*)(y + ((size_t)e * 4096 + b * CAP + sl) * D) + lane;
#pragma unroll
        for (int j = 0; j < 4; ++j) { const uint2 w = yr[64 * j]; v[j].x += g * bf2f(w.x & 0xffffu); v[j].y += g * bf2f(w.x >> 16); v[j].z += g * bf2f(w.y & 0xffffu); v[j].w += g * bf2f(w.y >> 16); } }
    float s = 0.f;
#pragma unroll
    for (int j = 0; j < 4; ++j) s += v[j].x * v[j].x + v[j].y * v[j].y + v[j].z * v[j].z + v[j].w * v[j].w;
    const float rs = rsqrtf(wave_sum(s) * (1.f / D) + EPS);
#pragma unroll
    for (int j = 0; j < 4; ++j) { const float4 gg = ((const float4*)fg)[lane + 64 * j]; xr[64 * j] = make_float4(v[j].x * rs * gg.x, v[j].y * rs * gg.y, v[j].z * rs * gg.z, v[j].w * rs * gg.w); }
}

extern "C" void kernel_launch(void* const* d_in, const int* in_sizes, int n_in, void* d_out, int out_size, void* d_ws, size_t ws_size, hipStream_t stream) {
    if (n_in != 13 || in_sizes[0] != M * D || out_size != M * D || ws_size < WS_END) { fprintf(stderr, "kernel_launch: unexpected shapes n_in %d in0 %d out %d ws %zu (need %zu)\n", n_in, n_in > 0 ? in_sizes[0] : -1, out_size, ws_size, (size_t)WS_END); return; }
    const float* x = (const float*)d_in[0]; const float* g1 = (const float*)d_in[1]; const float* w_in = (const float*)d_in[2]; const float* logdecay = (const float*)d_in[3];
    const float* gn_gain = (const float*)d_in[4]; const float* rel_bias = (const float*)d_in[5]; const float* w_out = (const float*)d_in[6]; const float* g2 = (const float*)d_in[7];
    const float* w_router = (const float*)d_in[8]; const float* w_gate = (const float*)d_in[9]; const float* w_up = (const float*)d_in[10]; const float* w_down = (const float*)d_in[11]; const float* fg = (const float*)d_in[12];
    unsigned char* ws = (unsigned char*)d_ws; float* out = (float*)d_out;
    float* ropeT = (float*)(ws + WS_ROPE); float* biasT = (float*)(ws + WS_BIAS); int* idx = (int*)(ws + WS_IDX); float* aff = (float*)(ws + WS_AFF); int* inv = (int*)(ws + WS_INV);
    bf16_t* Wout = (bf16_t*)(ws + WS_WOUT); bf16_t* Win = (bf16_t*)(ws + WS_WIN); bf16_t* XN = (bf16_t*)(ws + WS_XN);
    bf16_t* Wd = (bf16_t*)(ws + WS_WD); bf16_t* Wgu = (bf16_t*)(ws + WS_WGU); bf16_t* yb = (bf16_t*)(ws + WS_Y); bf16_t* hid = (bf16_t*)(ws + WS_HID);
    hipMemsetAsync(ws + WS_CTL, 0, 1 * MiB, stream);
    k_prep_tables<<<(S * 32 + 255) / 256, 256, 0, stream>>>(ropeT, biasT, rel_bias);
    k_prep_xn<<<M / 4, 256, 0, stream>>>(x, g1, XN);
    k_transpose<1><<<dim3(PC / 64, D / 64, 1), 256, 0, stream>>>(w_in, Win, D, PC, 0, 0);
    k_transpose<0><<<dim3(D / 64, D / 64, 1), 256, 0, stream>>>(w_out, Wout, D, D, 0, 0);
    { FInProj f{XN, Win, ws, ropeT}; k_gemm_naive<0, FInProj><<<dim3(M / 64, PC / 128), 256, 0, stream>>>(f, D); }
    bf16_t* mixed = XN;
    k_ret_naive<<<dim3(S / 256, NH, NB), 256, 0, stream>>>((const bf16_t*)(ws + WS_RQ), (const bf16_t*)(ws + WS_RK), (const bf16_t*)(ws + WS_RV), (const bf16_t*)(ws + WS_RG), logdecay, gn_gain, mixed);
    k_attn_naive<<<dim3(S / 256, NH, NB), 256, 0, stream>>>((const bf16_t*)(ws + WS_AQ), (const bf16_t*)(ws + WS_AK), (const bf16_t*)(ws + WS_AV), biasT, mixed);
    { FOutProj f{mixed, Wout, x, out}; k_gemm_naive<0, FOutProj><<<dim3(M / 64, D / 128), 256, 0, stream>>>(f, D); }
    k_transpose<2><<<dim3(DFF / 64, D / 64, NE), 256, 0, stream>>>(w_gate, Wgu, D, DFF, (size_t)D * DFF, (size_t)4096 * D);
    k_transpose<3><<<dim3(DFF / 64, D / 64, NE), 256, 0, stream>>>(w_up, Wgu, D, DFF, (size_t)D * DFF, (size_t)4096 * D);
    k_transpose<0><<<dim3(D / 64, DFF / 64, NE), 256, 0, stream>>>(w_down, Wd, DFF, D, (size_t)DFF * D, (size_t)D * DFF);
    bf16_t* H2b = XN;
    k_router<<<M / 4, 256, 0, stream>>>(out, g2, w_router, H2b, aff, inv);
    k_topk_naive<<<dim3(NE, NB), 256, 0, stream>>>(aff, idx, inv);
    { FExp1 f{H2b, Wgu, idx, hid}; k_gemm_naive<1, FExp1><<<dim3(MR / 64, DFF / 64), 256, 0, stream>>>(f, D); }
    { FExp2 f{hid, Wd, yb}; k_gemm_naive<0, FExp2><<<dim3(MR / 64, D / 128), 256, 0, stream>>>(f, DFF); }
    k_final<<<M / 4, 256, 0, stream>>>(out, aff, inv, yb, fg);
}
```

```cpp
#include <hip/hip_runtime.h>
#include <hip/hip_cooperative_groups.h>
#include <cstdint>
#include <cstdio>
namespace cg = cooperative_groups;

typedef unsigned short bf16_t;
#define DEV __device__ __forceinline__
#define LAS __attribute__((address_space(3)))

constexpr int NB = 8, S = 4096, D = 1024, M = NB * S;
constexpr int NH = 8, HD = 64, PC = 3584;
constexpr int NE = 16, CAP = 512, DFF = 2048, MR = NE * NB * CAP;
constexpr float EPS = 1e-6f, LOG2E = 1.4426950408889634f;
constexpr int NWAVES = 8, NTHR = 512;
constexpr int LDS_BYTES = 147456;

constexpr size_t MiB = 1u << 20;
constexpr size_t WS_CTL = 0;
constexpr size_t WS_ROPE = 1 * MiB;
constexpr size_t WS_BIAS = 2 * MiB;
constexpr size_t WS_IDX = 2 * MiB + 512 * 1024;
constexpr size_t WS_AFF = 3 * MiB;
constexpr size_t WS_INV = 5 * MiB;
constexpr size_t WS_WOUT = 7 * MiB;
constexpr size_t WS_WIN = 9 * MiB;
constexpr size_t WS_XN = 16 * MiB;
constexpr size_t WS_RQ = 80 * MiB, WS_RK = 112 * MiB, WS_RV = 144 * MiB, WS_RG = 176 * MiB;
constexpr size_t WS_AQ = 208 * MiB, WS_AK = 240 * MiB, WS_AV = 272 * MiB;
constexpr size_t WS_ATTO = 304 * MiB;
constexpr size_t WS_ATTL = 400 * MiB;
constexpr size_t WS_KF = 403 * MiB;
constexpr size_t WS_ST = 208 * MiB;
constexpr size_t WS_WD = 80 * MiB;
constexpr size_t WS_WGU = 144 * MiB;
constexpr size_t WS_Y = 144 * MiB;
constexpr size_t WS_HID = 272 * MiB;
constexpr size_t WS_END = 528 * MiB;

DEV unsigned f2bf(float f) { unsigned u = __float_as_uint(f); return (u + 0x7fffu + ((u >> 16) & 1u)) >> 16; }
DEV float bf2f(unsigned h) { return __uint_as_float(h << 16); }
DEV unsigned pk2(float lo, float hi) { return f2bf(lo) | (f2bf(hi) << 16); }
DEV float wave_sum(float v) {
#pragma unroll
    for (int o = 1; o < 64; o <<= 1) v += __shfl_xor(v, o);
    return v;
}
#define LDS_WAIT() asm volatile("s_waitcnt lgkmcnt(0)" ::: "memory")
namespace pg8 {
#define PG8_LAS __attribute__((address_space(3)))
typedef short bf16x8 __attribute__((ext_vector_type(8)));
typedef float f32x4 __attribute__((ext_vector_type(4)));
typedef unsigned u32x4 __attribute__((ext_vector_type(4)));
constexpr int BM = 256, BK = 64, HALF = 128, HTB = HALF * BK * 2, STAGE_BYTES = 8 * HTB, NXCD = 8, WGM = 8;
__host__ __device__ __forceinline__ int lds_byte(int r, int c) { const int st = (r >> 4) * 2 + (c >> 5), rr = r & 15, cc = c & 31, ob = rr * 64 + cc * 2; return st * 1024 + (ob ^ (((ob >> 9) & 1) << 5)); }
__host__ __device__ __forceinline__ void stage_rc(int b, int& R, int& C) { const int st = b / 1024, sb = b % 1024, swz = sb ^ (((sb >> 9) & 1) << 5); R = (st >> 1) * 16 + swz / 64; C = (st & 1) * 32 + (swz % 64) / 2; }
__host__ __device__ __forceinline__ int perm32(int rho) { const int n = rho >> 4, i = rho & 15; return 8 * (i >> 2) + 4 * n + (i & 3); }
struct Unit { int pm, pn; };
struct Gemm { const bf16_t* A; const bf16_t* Bt; int K; };
struct StaticOrder {
    int nM, nN, nwg, G, c;
    __device__ void init(int M_, int N_, int G_, int c_) { nM = M_ / BM; nN = N_ / BM; nwg = nM * nN; G = G_; c = c_; }
    __device__ bool next(int i, Unit& u) const {
        const long L = (long)i * G + c; if (L >= nwg) return false;
        int wgid = (int)L; { const int q = nwg / NXCD, r = nwg % NXCD, xcd = wgid % NXCD, off = wgid / NXCD; wgid = (xcd < r ? xcd * (q + 1) : r * (q + 1) + (xcd - r) * q) + off; }
        const int nig = WGM * nN, gid = wgid / nig, fm = gid * WGM, gsz = (nM - fm) < WGM ? (nM - fm) : WGM;
        u.pm = fm + ((wgid % nig) % gsz); u.pn = (wgid % nig) / gsz; return true;
    }
};
__device__ __forceinline__ unsigned cvt_pk_bf16(float lo, float hi) { unsigned r; asm volatile("v_cvt_pk_bf16_f32 %0, %1, %2" : "=v"(r) : "v"(lo), "v"(hi)); return r; }

template <class Epi, class Sched, bool ALIGN_EPI>
__device__ __forceinline__ void gemm_phase(PG8_LAS unsigned char* lds, const Gemm g, const Sched& S, const Epi& E) {
    const int tid = threadIdx.x, wid = __builtin_amdgcn_readfirstlane(tid >> 6), lane = tid & 63, wr = wid >> 2, wc = wid & 3, fr = lane & 15, fq = lane >> 4;
    const int K = g.K, nt = K / BK;
    int Ri[2], Ci[2]; unsigned voffB[2];
#pragma unroll
    for (int i = 0; i < 2; ++i) { int R, C; stage_rc(tid * 16 + i * 8192, R, C); const int Rb = Epi::PERM ? ((R & ~31) + perm32(R & 31)) : R;
        Ri[i] = R; Ci[i] = C; voffB[i] = (unsigned)(Rb * K + C) * 2u; }
    const size_t kstep = (size_t)(BK * 2);
    const size_t hstep = (size_t)HALF * K * 2;
    const size_t tstep = 2 * hstep;
    const unsigned ldsw = (unsigned)wid * 1024u;
    const int aoff = lds_byte(wr * 64 + fr, fq * 8), boff = lds_byte(wc * 32 + fr, fq * 8);
    const char* gA = (const char*)g.A;
#define PG8_SA(b, h) (((b) * 2 + (h)) * HTB)
#define PG8_SB(b, h) ((4 + (b) * 2 + (h)) * HTB)
#define PG8_STAGE(bufoff, gbase, voff) do { _Pragma("unroll") for (int _i = 0; _i < 2; ++_i) \
        __builtin_amdgcn_global_load_lds((const unsigned*)((const char*)(gbase) + (voff)[_i]), (PG8_LAS unsigned*)(lds + (bufoff) + ldsw + _i * 8192), 16, 0, 0); } while (0)
#define PG8_STAGE_A(bufoff, AO, h, kb) do { _Pragma("unroll") for (int _i = 0; _i < 2; ++_i) \
        __builtin_amdgcn_global_load_lds((const unsigned*)(gA + (size_t)((AO)[h][_i] + (unsigned)(kb))), (PG8_LAS unsigned*)(lds + (bufoff) + ldsw + _i * 8192), 16, 0, 0); } while (0)
#define PG8_LDA(dst, b, h) do { _Pragma("unroll") for (int m = 0; m < 4; ++m) _Pragma("unroll") for (int k = 0; k < 2; ++k) dst[m][k] = *(const PG8_LAS bf16x8*)(lds + PG8_SA(b, h) + aoff + m * 2048 + k * 1024); } while (0)
#define PG8_LDB(dst, b, h) do { _Pragma("unroll") for (int n = 0; n < 2; ++n) _Pragma("unroll") for (int k = 0; k < 2; ++k) dst[n][k] = *(const PG8_LAS bf16x8*)(lds + PG8_SB(b, h) + boff + n * 2048 + k * 1024); } while (0)
#define PG8_MMA(ai, bj, At, Bt) do { __builtin_amdgcn_s_setprio(1); _Pragma("unroll") for (int m = 0; m < 4; ++m) _Pragma("unroll") for (int n = 0; n < 2; ++n) _Pragma("unroll") for (int k = 0; k < 2; ++k) \
        acc[ai][bj][m][n] = __builtin_amdgcn_mfma_f32_16x16x32_bf16(Bt[n][k], At[m][k], acc[ai][bj][m][n], 0, 0, 0); __builtin_amdgcn_s_setprio(0); } while (0)
#define PG8_WAIT_V(n) asm volatile("s_waitcnt vmcnt(" #n ")" ::: "memory")
#define PG8_WAIT_L(n) asm volatile("s_waitcnt lgkmcnt(" #n ")" ::: "memory")
#define PG8_BAR __builtin_amdgcn_s_barrier()
#define PG8_SCHED __builtin_amdgcn_sched_barrier(0)
#define PG8_AOFFS(AO, u) do { _Pragma("unroll") for (int _h = 0; _h < 2; ++_h) _Pragma("unroll") for (int _i = 0; _i < 2; ++_i) (AO)[_h][_i] = S.row_off(u, _h * HALF + Ri[_i]) + (unsigned)(Ci[_i] * 2); } while (0)
    Unit cur, nxt; int ui = 0;
    if (!S.next(0, cur)) return;
    f32x4 acc[2][2][4][2];
#pragma unroll
    for (int a = 0; a < 2; ++a)
#pragma unroll
        for (int b = 0; b < 2; ++b)
#pragma unroll
            for (int m = 0; m < 4; ++m)
#pragma unroll
                for (int n = 0; n < 2; ++n) acc[a][b][m][n] = (f32x4){0.f, 0.f, 0.f, 0.f};
    bf16x8 At[4][2], B0[2][2], B1[2][2];
    unsigned aoc[2][2], aon[2][2];
    PG8_AOFFS(aoc, cur);
    const char* cB = (const char*)g.Bt + (size_t)cur.pn * tstep;
    PG8_STAGE(PG8_SB(0, 0), cB, voffB); PG8_STAGE(PG8_SB(0, 1), cB + hstep, voffB); PG8_STAGE_A(PG8_SA(0, 0), aoc, 0, 0); PG8_STAGE_A(PG8_SA(0, 1), aoc, 1, 0);
    if (wr == 1) PG8_BAR;
    PG8_WAIT_V(2); PG8_BAR;
    PG8_STAGE(PG8_SB(1, 0), cB + kstep, voffB); PG8_STAGE_A(PG8_SA(1, 0), aoc, 0, 128); PG8_STAGE(PG8_SB(1, 1), cB + hstep + kstep, voffB);
    PG8_WAIT_V(6); PG8_BAR;
    for (;;) {
        const bool has_next = S.next(ui + 1, nxt);
        const char* nB = cB;
        if (has_next) { PG8_AOFFS(aon, nxt); nB = (const char*)g.Bt + (size_t)nxt.pn * tstep; }
        else {
#pragma unroll
            for (int _h = 0; _h < 2; ++_h)
#pragma unroll
                for (int _i = 0; _i < 2; ++_i) aon[_h][_i] = aoc[_h][_i]; }
        for (int t = 0; t < nt; t += 2) {
            const bool last = (t == nt - 2);
            const unsigned k1 = (unsigned)(t + 1) * 128u, k2 = last ? 0u : (unsigned)(t + 2) * 128u, k3 = k2 + 128u;
            unsigned a2o[2][2];
#pragma unroll
            for (int _h = 0; _h < 2; ++_h)
#pragma unroll
                for (int _i = 0; _i < 2; ++_i) a2o[_h][_i] = last ? aon[_h][_i] : aoc[_h][_i];
            const char* b2 = last ? nB : cB + (size_t)(t + 2) * kstep; const char* b3 = b2 + kstep;
            PG8_LDB(B0, 0, 0); PG8_LDB(B1, 0, 1); PG8_SCHED; PG8_LDA(At, 0, 0); PG8_STAGE_A(PG8_SA(1, 1), aoc, 1, k1);
            PG8_WAIT_V(8); PG8_WAIT_L(0); PG8_BAR; PG8_MMA(0, 0, At, B0); PG8_MMA(0, 1, At, B1); PG8_BAR; PG8_SCHED;
            PG8_LDA(At, 0, 1); PG8_STAGE(PG8_SB(0, 0), b2, voffB); PG8_STAGE(PG8_SB(0, 1), b2 + hstep, voffB); PG8_STAGE_A(PG8_SA(0, 0), a2o, 0, k2);
            PG8_WAIT_V(8); PG8_WAIT_L(0); PG8_BAR; PG8_MMA(1, 0, At, B0); PG8_MMA(1, 1, At, B1); PG8_BAR; PG8_SCHED;
            PG8_LDB(B0, 1, 0); PG8_LDB(B1, 1, 1); PG8_SCHED; PG8_LDA(At, 1, 0); PG8_STAGE_A(PG8_SA(0, 1), a2o, 1, k2);
            PG8_WAIT_V(8); PG8_WAIT_L(0); PG8_BAR; PG8_MMA(0, 0, At, B0); PG8_MMA(0, 1, At, B1); PG8_BAR; PG8_SCHED;
            PG8_LDA(At, 1, 1); PG8_STAGE(PG8_SB(1, 0), b3, voffB); PG8_STAGE(PG8_SB(1, 1), b3 + hstep, voffB); PG8_STAGE_A(PG8_SA(1, 0), a2o, 0, k3);
            PG8_WAIT_V(8); PG8_WAIT_L(0); PG8_BAR; PG8_MMA(1, 0, At, B0); PG8_MMA(1, 1, At, B1); PG8_BAR; PG8_SCHED;
        }
        if constexpr (ALIGN_EPI) { if (wr == 0) PG8_BAR; }
        E(acc, cur, wr, wc, fr, fq);
        if (!has_next) break;
#pragma unroll
        for (int a = 0; a < 2; ++a)
#pragma unroll
            for (int b = 0; b < 2; ++b)
#pragma unroll
                for (int m = 0; m < 4; ++m)
#pragma unroll
                    for (int n = 0; n < 2; ++n) acc[a][b][m][n] = (f32x4){0.f, 0.f, 0.f, 0.f};
        cur = nxt; cB = nB; ++ui;
#pragma unroll
        for (int _h = 0; _h < 2; ++_h)
#pragma unroll
            for (int _i = 0; _i < 2; ++_i) aoc[_h][_i] = aon[_h][_i];
        if constexpr (ALIGN_EPI) { if (wr == 1) PG8_BAR; }
    }
    PG8_WAIT_V(0);
    if constexpr (!ALIGN_EPI) { if (wr == 0) PG8_BAR; }
    PG8_BAR;
#undef PG8_SA
#undef PG8_SB
#undef PG8_STAGE
#undef PG8_STAGE_A
#undef PG8_LDA
#undef PG8_LDB
#undef PG8_MMA
#undef PG8_WAIT_V
#undef PG8_WAIT_L
#undef PG8_BAR
#undef PG8_SCHED
#undef PG8_AOFFS
}
}
struct SchedPlain : pg8::StaticOrder {
    unsigned rowbytes;
    DEV unsigned row_off(const pg8::Unit& u, int r) const { return (unsigned)(u.pm * 256 + r) * rowbytes; }
};
struct SchedMoe1 : pg8::StaticOrder {
    const int* idx;
    DEV bool next(int i, pg8::Unit& u) const { if (!pg8::StaticOrder::next(i, u)) return false; u.pn += (u.pm >> 4) * 16; return true; }
    DEV unsigned row_off(const pg8::Unit& u, int r) const { const int g = u.pm * 256 + r; const int tok = ((g >> 9) & 7) * S + idx[g]; return (unsigned)tok * (unsigned)(D * 2); }
};
struct SchedMoe2 : pg8::StaticOrder {
    DEV bool next(int i, pg8::Unit& u) const { if (!pg8::StaticOrder::next(i, u)) return false; u.pn += (u.pm >> 4) * 4; return true; }
    DEV unsigned row_off(const pg8::Unit& u, int r) const { return (unsigned)(u.pm * 256 + r) * (unsigned)(DFF * 2); }
};
typedef pg8::f32x4 f32x4; typedef pg8::u32x4 u32x4;
struct EpiInProj {
    static constexpr bool PERM = true;
    unsigned char* ws; const float* ropeT;
    DEV void operator()(const f32x4 (&acc)[2][2][4][2], const pg8::Unit& u, int wr, int wc, int fr, int fq) const {
        const int grp = u.pn >> 1;
        bf16_t* gbase = (bf16_t*)(ws + WS_RQ + (size_t)grp * 32 * MiB);
        const float sc = (grp == 1) ? 0.125f : (grp == 4 ? 0.125f * LOG2E : 1.f);
#pragma unroll
        for (int ai = 0; ai < 2; ++ai)
#pragma unroll
            for (int m = 0; m < 4; ++m) {
                const int row = u.pm * 256 + ai * 128 + wr * 64 + m * 16 + fr, b = row >> 12, s = row & 4095;
#pragma unroll
                for (int bj = 0; bj < 2; ++bj) {
                    const int hd = 4 * (u.pn & 1) + 2 * bj + (wc >> 1), j0 = 32 * (wc & 1) + 8 * fq;
                    f32x4 lo = acc[ai][bj][m][0], hi = acc[ai][bj][m][1];
                    if (grp < 2) {
                        const f32x4 c = *(const f32x4*)(ropeT + s * 32 + (j0 >> 1)), sn = *(const f32x4*)(ropeT + S * 32 + s * 32 + (j0 >> 1));
                        const f32x4 l2 = lo * c - hi * sn, h2 = hi * c + lo * sn; lo = l2; hi = h2;
                    }
                    lo = lo * sc; hi = hi * sc;
                    u32x4 w; w.x = pg8::cvt_pk_bf16(lo[0], lo[1]); w.y = pg8::cvt_pk_bf16(lo[2], lo[3]); w.z = pg8::cvt_pk_bf16(hi[0], hi[1]); w.w = pg8::cvt_pk_bf16(hi[2], hi[3]);
                    *(u32x4*)(gbase + ((size_t)(b * NH + hd) * S + s) * HD + j0) = w;
                }
            }
    }
};
struct EpiOutProj {
    static constexpr bool PERM = true;
    const float* x; float* x1;
    DEV void operator()(const f32x4 (&acc)[2][2][4][2], const pg8::Unit& u, int wr, int wc, int fr, int fq) const {
#pragma unroll
        for (int ai = 0; ai < 2; ++ai)
#pragma unroll
            for (int m = 0; m < 4; ++m) {
                const int row = u.pm * 256 + ai * 128 + wr * 64 + m * 16 + fr;
#pragma unroll
                for (int bj = 0; bj < 2; ++bj) { const size_t off = (size_t)row * D + u.pn * 256 + bj * 128 + wc * 32 + 8 * fq;
                    const f32x4 a = *(const f32x4*)(x + off), b = *(const f32x4*)(x + off + 4);
                    *(f32x4*)(x1 + off) = a + acc[ai][bj][m][0]; *(f32x4*)(x1 + off + 4) = b + acc[ai][bj][m][1]; }
            }
    }
};
struct EpiSwiGLU {
    static constexpr bool PERM = true;
    bf16_t* hid;
    DEV void operator()(const f32x4 (&acc)[2][2][4][2], const pg8::Unit& u, int wr, int wc, int fr, int fq) const {
        const int pnl = u.pn & 15;
#pragma unroll
        for (int ai = 0; ai < 2; ++ai)
#pragma unroll
            for (int m = 0; m < 4; ++m) {
                const int row = u.pm * 256 + ai * 128 + wr * 64 + m * 16 + fr;
                float o[8];
#pragma unroll
                for (int n = 0; n < 2; ++n)
#pragma unroll
                    for (int i = 0; i < 4; ++i) { const float gt = acc[ai][0][m][n][i], up = acc[ai][1][m][n][i];
                        o[4 * n + i] = gt * __builtin_amdgcn_rcpf(1.f + __builtin_amdgcn_exp2f(-gt * LOG2E)) * up; }
                u32x4 w; w.x = pg8::cvt_pk_bf16(o[0], o[1]); w.y = pg8::cvt_pk_bf16(o[2], o[3]); w.z = pg8::cvt_pk_bf16(o[4], o[5]); w.w = pg8::cvt_pk_bf16(o[6], o[7]);
                *(u32x4*)(hid + (size_t)row * DFF + pnl * 128 + wc * 32 + 8 * fq) = w;
            }
    }
};
struct EpiDown {
    static constexpr bool PERM = true;
    bf16_t* y;
    DEV void operator()(const f32x4 (&acc)[2][2][4][2], const pg8::Unit& u, int wr, int wc, int fr, int fq) const {
        const int pnl = u.pn & 3;
#pragma unroll
        for (int ai = 0; ai < 2; ++ai)
#pragma unroll
            for (int m = 0; m < 4; ++m) {
                const int row = u.pm * 256 + ai * 128 + wr * 64 + m * 16 + fr;
#pragma unroll
                for (int bj = 0; bj < 2; ++bj) { const f32x4 lo = acc[ai][bj][m][0], hi = acc[ai][bj][m][1];
                    u32x4 w; w.x = pg8::cvt_pk_bf16(lo[0], lo[1]); w.y = pg8::cvt_pk_bf16(lo[2], lo[3]); w.z = pg8::cvt_pk_bf16(hi[0], hi[1]); w.w = pg8::cvt_pk_bf16(hi[2], hi[3]);
                    *(u32x4*)(y + (size_t)row * D + pnl * 256 + bj * 128 + wc * 32 + 8 * fq) = w; }
            }
    }
};
struct Args { const float* in[13]; float* out; unsigned char* ws; int ph_lo, ph_hi; };
enum { IN_X = 0, IN_G1, IN_WIN, IN_DECAY, IN_GN, IN_RELB, IN_WOUT, IN_G2, IN_WR, IN_WG, IN_WU, IN_WDN, IN_FG };

template <int MODE> DEV int rowmap(int n) {
    if (MODE == 0) return n;
    if (MODE == 1) { if (n >= 1024) return n; const int base = n & ~63, d = n & 63, nn = d >> 5, dd = d & 31; return base + 8 * (dd >> 2) + 4 * nn + (dd & 3); }
    if (MODE == 2) return (n >> 7) * 256 + (n & 127);
    return (n >> 7) * 256 + 128 + (n & 127);
}
template <int MODE> DEV void transpose_item(const float* src, bf16_t* dst, int K, int N, int k0, int n0, float* scr, int lane) {
#pragma unroll 4
    for (int i = 0; i < 16; ++i) { const int kk = (lane >> 4) + 4 * i, c = (lane & 15) * 4;
        const float4 v = *(const float4*)(src + (size_t)(k0 + kk) * N + n0 + c);
        scr[kk * 65 + c] = v.x; scr[kk * 65 + c + 1] = v.y; scr[kk * 65 + c + 2] = v.z; scr[kk * 65 + c + 3] = v.w; }
    LDS_WAIT();
#pragma unroll 2
    for (int i = 0; i < 8; ++i) { const int n = (lane >> 3) + 8 * i, c = (lane & 7) * 8; const float* s = scr + c * 65 + n;
        uint4 o; o.x = pk2(s[0], s[65]); o.y = pk2(s[2 * 65], s[3 * 65]); o.z = pk2(s[4 * 65], s[5 * 65]); o.w = pk2(s[6 * 65], s[7 * 65]);
        *(uint4*)(dst + (size_t)rowmap<MODE>(n0 + n) * K + k0 + c) = o; }
    LDS_WAIT();
}
DEV void rms_row_to_bf16(const float* xrow, const float* g, bf16_t* orow, int lane) {
    const float4* xr = (const float4*)xrow + lane;
    float4 v[4]; float s = 0.f;
#pragma unroll
    for (int j = 0; j < 4; ++j) { v[j] = xr[64 * j]; s += v[j].x * v[j].x + v[j].y * v[j].y + v[j].z * v[j].z + v[j].w * v[j].w; }
    const float rs = rsqrtf(wave_sum(s) * (1.f / D) + EPS);
    uint2* o = (uint2*)orow + lane;
#pragma unroll
    for (int j = 0; j < 4; ++j) { const float4 gg = ((const float4*)g)[lane + 64 * j];
        o[64 * j] = make_uint2(pk2(v[j].x * rs * gg.x, v[j].y * rs * gg.y), pk2(v[j].z * rs * gg.z, v[j].w * rs * gg.w)); }
}
DEV void phase_prep(const Args& a, unsigned char* lds, int gw, int NGW, int lane, int wave) {
    unsigned char* ws = a.ws;
    float* ropeT = (float*)(ws + WS_ROPE); float* biasT = (float*)(ws + WS_BIAS);
    for (int t = gw * 64 + lane; t < S * 32; t += NGW * 64) {
        const int pos = t >> 5, i = t & 31; const double inv = pow(10000.0, -(double)i / 32.0), ang = (double)pos * inv;
        ropeT[t] = (float)cos(ang); ropeT[S * 32 + t] = (float)sin(ang);
        if (t < 3 * NH * 129) { const int p = t / (NH * 129), h = (t / 129) % NH, o = t % 129 - 64, dil = p == 0 ? 1 : (p == 1 ? 4 : 16), rel = o * dil, n = rel < 0 ? -rel : rel;
            int bucket = rel > 0 ? 16 : 0;
            if (n < 8) bucket += n; else { int large = 8 + (int)(log((double)n / 8.0) / log(128.0) * 8.0); if (large > 15) large = 15; bucket += large; }
            biasT[t] = a.in[IN_RELB][bucket * NH + h] * LOG2E; }
    }
    float* scr = (float*)(lds + wave * 16640);
    constexpr int I_IN = (D / 64) * (PC / 64), I_OUT = (D / 64) * (D / 64);
    for (int it = gw; it < I_IN + I_OUT; it += NGW) {
        if (it < I_IN) transpose_item<1>(a.in[IN_WIN], (bf16_t*)(ws + WS_WIN), D, PC, (it / (PC / 64)) * 64, (it % (PC / 64)) * 64, scr, lane);
        else { const int r = it - I_IN; transpose_item<0>(a.in[IN_WOUT], (bf16_t*)(ws + WS_WOUT), D, D, (r / (D / 64)) * 64, (r % (D / 64)) * 64, scr, lane); }
    }
    for (int m = gw; m < M; m += NGW) rms_row_to_bf16(a.in[IN_X] + (size_t)m * D, a.in[IN_G1], (bf16_t*)(ws + WS_XN) + (size_t)m * D, lane);
}
DEV void phase_latew(const Args& a, unsigned char* lds, int gw, int NGW, int lane, int wave) {
    unsigned char* ws = a.ws; float* scr = (float*)(lds + wave * 16640);
    constexpr int I_G = (D / 64) * (DFF / 64);
    for (int it = gw; it < 3 * NE * I_G; it += NGW) {
        const int which = it / (NE * I_G), r = it % (NE * I_G), e = r / I_G, q = r % I_G;
        if (which == 0) transpose_item<2>(a.in[IN_WG] + (size_t)e * D * DFF, (bf16_t*)(ws + WS_WGU) + (size_t)e * 4096 * D, D, DFF, (q / (DFF / 64)) * 64, (q % (DFF / 64)) * 64, scr, lane);
        else if (which == 1) transpose_item<3>(a.in[IN_WU] + (size_t)e * D * DFF, (bf16_t*)(ws + WS_WGU) + (size_t)e * 4096 * D, D, DFF, (q / (DFF / 64)) * 64, (q % (DFF / 64)) * 64, scr, lane);
        else transpose_item<0>(a.in[IN_WDN] + (size_t)e * DFF * D, (bf16_t*)(ws + WS_WD) + (size_t)e * D * DFF, DFF, D, (q / (D / 64)) * 64, (q % (D / 64)) * 64, scr, lane);
    }
}
DEV void phase_router(const Args& a, int gw, int NGW, int lane) {
    unsigned char* ws = a.ws; const float* x1 = a.out; const float* g2 = a.in[IN_G2]; const float* wr = a.in[IN_WR];
    bf16_t* H2b = (bf16_t*)(ws + WS_XN); float* aff = (float*)(ws + WS_AFF); int* inv = (int*)(ws + WS_INV);
    for (int row = gw; row < M; row += NGW) {
        const float4* xr = (const float4*)(x1 + (size_t)row * D) + lane;
        float4 v[4]; float s = 0.f;
#pragma unroll
        for (int j = 0; j < 4; ++j) { v[j] = xr[64 * j]; s += v[j].x * v[j].x + v[j].y * v[j].y + v[j].z * v[j].z + v[j].w * v[j].w; }
        const float rs = rsqrtf(wave_sum(s) * (1.f / D) + EPS);
        float lg[16];
#pragma unroll
        for (int e = 0; e < 16; ++e) lg[e] = 0.f;
        uint2* o = (uint2*)(H2b + (size_t)row * D) + lane;
#pragma unroll
        for (int j = 0; j < 4; ++j) { const float4 gg = ((const float4*)g2)[lane + 64 * j];
            const float hv[4] = {v[j].x * rs * gg.x, v[j].y * rs * gg.y, v[j].z * rs * gg.z, v[j].w * rs * gg.w};
            o[64 * j] = make_uint2(pk2(hv[0], hv[1]), pk2(hv[2], hv[3]));
#pragma unroll
            for (int t = 0; t < 4; ++t) { const float4* w4 = (const float4*)(wr + (size_t)(4 * lane + 256 * j + t) * NE);
#pragma unroll
                for (int c = 0; c < 4; ++c) { const float4 w = w4[c]; lg[4 * c] += hv[t] * w.x; lg[4 * c + 1] += hv[t] * w.y; lg[4 * c + 2] += hv[t] * w.z; lg[4 * c + 3] += hv[t] * w.w; } } }
        float mx = -1e30f;
#pragma unroll
        for (int e = 0; e < 16; ++e) { lg[e] = wave_sum(lg[e]); mx = fmaxf(mx, lg[e]); }
        float sum = 0.f;
#pragma unroll
        for (int e = 0; e < 16; ++e) { lg[e] = __expf(lg[e] - mx); sum += lg[e]; }
        const float is = 1.f / sum;
        if (lane < 16) { float av = 0.f;
#pragma unroll
            for (int e = 0; e < 16; ++e) av = lane == e ? lg[e] * is : av;
            aff[(size_t)row * NE + lane] = av; inv[(size_t)row * NE + lane] = -1; }
    }
}
DEV void phase_topk_simple(const Args& a, unsigned char* lds, int wg, int G, int tid) {
    unsigned char* ws = a.ws; const float* aff = (const float*)(ws + WS_AFF); int* idx = (int*)(ws + WS_IDX); int* inv = (int*)(ws + WS_INV);
    float* av = (float*)lds;
    for (int it = wg; it < NE * NB; it += G) {
        const int e = it / NB, b = it % NB;
        __syncthreads();
        for (int s = tid; s < S; s += NTHR) av[s] = aff[((size_t)b * S + s) * NE + e];
        __syncthreads();
        for (int s = tid; s < S; s += NTHR) { const float v = av[s]; int rank = 0;
            for (int j = 0; j < S; ++j) { const float w = av[j]; rank += (w > v) || (w == v && j < s); }
            if (rank < CAP) { idx[(e * NB + b) * CAP + rank] = s; inv[((size_t)b * S + s) * NE + e] = rank; } }
    }
}
DEV void phase_final(const Args& a, int gw, int NGW, int lane) {
    unsigned char* ws = a.ws; float* xo = a.out; const float* aff = (const float*)(ws + WS_AFF); const int* inv = (const int*)(ws + WS_INV); const bf16_t* y = (const bf16_t*)(ws + WS_Y); const float* fg = a.in[IN_FG];
    for (int row = gw; row < M; row += NGW) {
        const int b = row >> 12;
        float4* xr = (float4*)(xo + (size_t)row * D) + lane;
        float4 v[4];
#pragma unroll
        for (int j = 0; j < 4; ++j) v[j] = xr[64 * j];
        for (int e = 0; e < NE; ++e) { const int sl = inv[(size_t)row * NE + e]; if (sl < 0) continue;
            const float g = aff[(size_t)row * NE + e]; const uint2* yr = (const uint2*)(y + ((size_t)e * 4096 + b * CAP + sl) * D) + lane;
#pragma unroll
            for (int j = 0; j < 4; ++j) { const uint2 w = yr[64 * j]; v[j].x += g * bf2f(w.x & 0xffffu); v[j].y += g * bf2f(w.x >> 16); v[j].z += g * bf2f(w.y & 0xffffu); v[j].w += g * bf2f(w.y >> 16); } }
        float s = 0.f;
#pragma unroll
        for (int j = 0; j < 4; ++j) s += v[j].x * v[j].x + v[j].y * v[j].y + v[j].z * v[j].z + v[j].w * v[j].w;
        const float rs = rsqrtf(wave_sum(s) * (1.f / D) + EPS);
#pragma unroll
        for (int j = 0; j < 4; ++j) { const float4 gg = ((const float4*)fg)[lane + 64 * j]; xr[64 * j] = make_float4(v[j].x * rs * gg.x, v[j].y * rs * gg.y, v[j].z * rs * gg.z, v[j].w * rs * gg.w); }
    }
}
DEV void phase_ret_simple(const Args& a, unsigned char* lds, int wg, int G, int tid) {
    unsigned char* ws = a.ws;
    const bf16_t* RQ = (const bf16_t*)(ws + WS_RQ); const bf16_t* RK = (const bf16_t*)(ws + WS_RK); const bf16_t* RV = (const bf16_t*)(ws + WS_RV); const bf16_t* RG = (const bf16_t*)(ws + WS_RG);
    const float* logdecay = a.in[IN_DECAY]; const float* gn_gain = a.in[IN_GN]; bf16_t* mixed = (bf16_t*)(ws + WS_XN);
    float (*Ks)[64] = (float (*)[64])lds; float (*Vs)[64] = (float (*)[64])(lds + 32 * 64 * 4);
    for (int vb = wg; vb < NB * NH * 8; vb += G) {
        const int b = vb >> 6, h = (vb >> 3) & 7, i = (vb & 7) * 512 + tid;
        const size_t hb = (size_t)(b * NH + h) * S * HD;
        float q[64], acc[64];
        { const uint4* qp = (const uint4*)(RQ + hb + (size_t)i * HD);
#pragma unroll
          for (int c = 0; c < 8; ++c) { const uint4 w = qp[c]; const unsigned ww[4] = {w.x, w.y, w.z, w.w};
#pragma unroll
              for (int j = 0; j < 4; ++j) { q[c * 8 + 2 * j] = bf2f(ww[j] & 0xffffu); q[c * 8 + 2 * j + 1] = bf2f(ww[j] >> 16); } } }
#pragma unroll
        for (int d = 0; d < 64; ++d) acc[d] = 0.f;
        const float lg0 = logdecay[h] * LOG2E, lg1 = logdecay[NH + h] * LOG2E;
        for (int j0 = 0; j0 < S; j0 += 32) {
            __syncthreads();
            if (tid < 256) { const int r = tid >> 3, c = (tid & 7) * 8;
              const uint4 kw = *(const uint4*)(RK + hb + (size_t)(j0 + r) * HD + c), vw = *(const uint4*)(RV + hb + (size_t)(j0 + r) * HD + c);
              const unsigned k4[4] = {kw.x, kw.y, kw.z, kw.w}, v4[4] = {vw.x, vw.y, vw.z, vw.w};
#pragma unroll
              for (int j = 0; j < 4; ++j) { Ks[r][c + 2 * j] = bf2f(k4[j] & 0xffffu); Ks[r][c + 2 * j + 1] = bf2f(k4[j] >> 16); Vs[r][c + 2 * j] = bf2f(v4[j] & 0xffffu); Vs[r][c + 2 * j + 1] = bf2f(v4[j] >> 16); } }
            __syncthreads();
            for (int jj = 0; jj < 32; ++jj) {
                float s = 0.f;
#pragma unroll
                for (int d = 0; d < 64; d += 4) { const float4 kk = *(const float4*)&Ks[jj][d]; s += q[d] * kk.x + q[d + 1] * kk.y + q[d + 2] * kk.z + q[d + 3] * kk.w; }
                const int j = j0 + jj; const float dec = j <= i ? exp2f(lg0 * (float)(i - j)) : exp2f(lg1 * (float)(j - i));
                s *= dec;
#pragma unroll
                for (int d = 0; d < 64; d += 4) { const float4 vv = *(const float4*)&Vs[jj][d]; acc[d] += s * vv.x; acc[d + 1] += s * vv.y; acc[d + 2] += s * vv.z; acc[d + 3] += s * vv.w; }
            }
        }
        float mu = 0.f;
#pragma unroll
        for (int d = 0; d < 64; ++d) mu += acc[d];
        mu *= (1.f / 64.f); float var = 0.f;
#pragma unroll
        for (int d = 0; d < 64; ++d) { const float t = acc[d] - mu; var += t * t; }
        const float rstd = rsqrtf(var * (1.f / 64.f) + EPS);
        const bf16_t* gp = RG + hb + (size_t)i * HD; bf16_t* op = mixed + ((size_t)b * S + i) * D + h * HD;
#pragma unroll
        for (int d = 0; d < 64; d += 2) {
            const float g0 = bf2f(gp[d]), g1 = bf2f(gp[d + 1]);
            const float o0 = (acc[d] - mu) * rstd * gn_gain[h * HD + d] * (g0 / (1.f + __expf(-g0)));
            const float o1 = (acc[d + 1] - mu) * rstd * gn_gain[h * HD + d + 1] * (g1 / (1.f + __expf(-g1)));
            *(unsigned*)(op + d) = pk2(o0, o1);
        }
    }
}
DEV void phase_attn_simple(const Args& a, int wg, int G, int tid) {
    unsigned char* ws = a.ws;
    const bf16_t* AQ = (const bf16_t*)(ws + WS_AQ); const bf16_t* AK = (const bf16_t*)(ws + WS_AK); const bf16_t* AV = (const bf16_t*)(ws + WS_AV);
    const float* biasT = (const float*)(ws + WS_BIAS); bf16_t* mixed = (bf16_t*)(ws + WS_XN);
    for (int vb = wg; vb < NB * NH * 8; vb += G) {
        const int b = vb >> 6, h = (vb >> 3) & 7, i = (vb & 7) * 512 + tid;
        const size_t hb = (size_t)(b * NH + h) * S * HD;
        float q[64], acc[64];
        { const uint4* qp = (const uint4*)(AQ + hb + (size_t)i * HD);
#pragma unroll
          for (int c = 0; c < 8; ++c) { const uint4 w = qp[c]; const unsigned ww[4] = {w.x, w.y, w.z, w.w};
#pragma unroll
              for (int j = 0; j < 4; ++j) { q[c * 8 + 2 * j] = bf2f(ww[j] & 0xffffu); q[c * 8 + 2 * j + 1] = bf2f(ww[j] >> 16); } } }
#pragma unroll
        for (int d = 0; d < 64; ++d) acc[d] = 0.f;
        float m = -1e30f, l = 0.f;
        for (int p = 0; p < 3; ++p) {
            const int dil = p == 0 ? 1 : (p == 1 ? 4 : 16);
            for (int o = -64; o <= 64; ++o) {
                const int kp = i + o * dil; if (kp < 0 || kp >= S) continue;
                const uint4* kr = (const uint4*)(AK + hb + (size_t)kp * HD); float s = 0.f;
#pragma unroll
                for (int c = 0; c < 8; ++c) { const uint4 w = kr[c]; const unsigned ww[4] = {w.x, w.y, w.z, w.w};
#pragma unroll
                    for (int j = 0; j < 4; ++j) s += q[c * 8 + 2 * j] * bf2f(ww[j] & 0xffffu) + q[c * 8 + 2 * j + 1] * bf2f(ww[j] >> 16); }
                s += biasT[(p * NH + h) * 129 + o + 64];
                const float mn = fmaxf(m, s), f = exp2f(m - mn), pe = exp2f(s - mn); m = mn; l = l * f + pe;
                const uint4* vr = (const uint4*)(AV + hb + (size_t)kp * HD);
#pragma unroll
                for (int c = 0; c < 8; ++c) { const uint4 w = vr[c]; const unsigned ww[4] = {w.x, w.y, w.z, w.w};
#pragma unroll
                    for (int j = 0; j < 4; ++j) { acc[c * 8 + 2 * j] = acc[c * 8 + 2 * j] * f + pe * bf2f(ww[j] & 0xffffu); acc[c * 8 + 2 * j + 1] = acc[c * 8 + 2 * j + 1] * f + pe * bf2f(ww[j] >> 16); } }
            }
        }
        const float il = 1.f / l; bf16_t* op = mixed + ((size_t)b * S + i) * D + 512 + h * HD;
#pragma unroll
        for (int d = 0; d < 64; d += 2) *(unsigned*)(op + d) = pk2(acc[d] * il, acc[d + 1] * il);
    }
}
#ifndef MK_LAUNCHES
#define MK_LAUNCHES 1
#endif
constexpr int NPH = 11;
__global__ void __launch_bounds__(NTHR, 2) mega(Args a) {
    extern __shared__ __attribute__((aligned(16))) unsigned char lds[];
    const int tid = threadIdx.x, lane = tid & 63, wave = __builtin_amdgcn_readfirstlane(tid >> 6);
    const int G = gridDim.x, wg = blockIdx.x, gw = wg * NWAVES + wave, NGW = G * NWAVES;
    unsigned char* ws = a.ws;
    const int lo = a.ph_lo, hi = a.ph_hi;
#define IN(k) (lo <= (k) && (k) < hi)
#define SEAM(k) do { if (IN(k) && IN((k) + 1)) { cg::this_grid().sync(); } } while (0)
    if (IN(0)) { phase_prep(a, lds, gw, NGW, lane, wave); }
    SEAM(0);
    if (IN(1)) { pg8::Gemm g{(const bf16_t*)(ws + WS_XN), (const bf16_t*)(ws + WS_WIN), D}; SchedPlain Sc; Sc.init(M, PC, G, wg); Sc.rowbytes = D * 2;
        EpiInProj E{ws, (const float*)(ws + WS_ROPE)};
        pg8::gemm_phase<EpiInProj, SchedPlain, true>((LAS unsigned char*)lds, g, Sc, E); }
    SEAM(1);
    if (IN(2)) { phase_attn_simple(a, wg, G, tid); }
    SEAM(2);
    if (IN(3)) { }
    SEAM(3);
    if (IN(4)) { phase_ret_simple(a, lds, wg, G, tid); }
    SEAM(4);
    if (IN(5)) { pg8::Gemm g{(const bf16_t*)(ws + WS_XN), (const bf16_t*)(ws + WS_WOUT), D}; SchedPlain Sc; Sc.init(M, D, G, wg); Sc.rowbytes = D * 2;
        EpiOutProj E{a.in[IN_X], a.out};
        pg8::gemm_phase<EpiOutProj, SchedPlain, true>((LAS unsigned char*)lds, g, Sc, E); }
    SEAM(5);
    if (IN(6)) { phase_router(a, gw, NGW, lane); phase_latew(a, lds, gw, NGW, lane, wave); }
    SEAM(6);
    if (IN(7)) { phase_topk_simple(a, lds, wg, G, tid); }
    SEAM(7);
    if (IN(8)) { pg8::Gemm g{(const bf16_t*)(ws + WS_XN), (const bf16_t*)(ws + WS_WGU), D}; SchedMoe1 Sc; Sc.init(MR, 4096, G, wg); Sc.idx = (const int*)(ws + WS_IDX);
        EpiSwiGLU E{(bf16_t*)(ws + WS_HID)};
        pg8::gemm_phase<EpiSwiGLU, SchedMoe1, true>((LAS unsigned char*)lds, g, Sc, E); }
    SEAM(8);
    if (IN(9)) { pg8::Gemm g{(const bf16_t*)(ws + WS_HID), (const bf16_t*)(ws + WS_WD), DFF}; SchedMoe2 Sc; Sc.init(MR, D, G, wg);
        EpiDown E{(bf16_t*)(ws + WS_Y)};
        pg8::gemm_phase<EpiDown, SchedMoe2, true>((LAS unsigned char*)lds, g, Sc, E); }
    SEAM(9);
    if (IN(10)) { phase_final(a, gw, NGW, lane); }
#undef IN
#undef SEAM
}

extern "C" void kernel_launch(void* const* d_in, const int* in_sizes, int n_in, void* d_out, int out_size, void* d_ws, size_t ws_size, hipStream_t stream) {
    static int grid = 0;
    if (grid == 0) {
        if (n_in != 13 || in_sizes[0] != M * D || out_size != M * D || ws_size < WS_END) { fprintf(stderr, "kernel_launch: unexpected shapes n_in %d in0 %d out %d ws %zu (need %zu)\n", n_in, n_in > 0 ? in_sizes[0] : -1, out_size, ws_size, (size_t)WS_END); grid = -1; return; }
        int dev = 0, cus = 0, per_cu = 0;
        (void)hipGetDevice(&dev); (void)hipDeviceGetAttribute(&cus, hipDeviceAttributeMultiprocessorCount, dev);
        (void)hipFuncSetAttribute((const void*)mega, hipFuncAttributeMaxDynamicSharedMemorySize, LDS_BYTES);
        if (hipOccupancyMaxActiveBlocksPerMultiprocessor(&per_cu, (const void*)mega, NTHR, LDS_BYTES) != hipSuccess || per_cu < 1) { fprintf(stderr, "kernel_launch: occupancy query says %d blocks/CU\n", per_cu); per_cu = 1; }
        (void)hipGetLastError();
        grid = cus * 1;
        if (grid > cus * per_cu) grid = cus * per_cu;
    }
    if (grid < 0) return;
    (void)hipMemsetAsync((char*)d_ws + WS_CTL, 0, 1 * MiB, stream);
    Args a{};
    for (int i = 0; i < 13; ++i) a.in[i] = (const float*)d_in[i];
    a.out = (float*)d_out; a.ws = (unsigned char*)d_ws;
#if MK_LAUNCHES == 1
    a.ph_lo = 0; a.ph_hi = NPH;
    void* args[] = {&a};
    hipError_t e = hipLaunchCooperativeKernel((const void*)mega, dim3(grid), dim3(NTHR), args, LDS_BYTES, stream);
    if (e != hipSuccess) fprintf(stderr, "cooperative launch failed: %s (grid %d)\n", hipGetErrorString(e), grid);
#else
    for (int p = 0; p < NPH; ++p) { a.ph_lo = p; a.ph_hi = p + 1; hipLaunchKernelGGL(mega, dim3(grid), dim3(NTHR), LDS_BYTES, stream, a); }
#endif
}
```

```cpp
#include <hip/hip_runtime.h>
#include <hip/hip_cooperative_groups.h>
#include <cstdint>
#include <cstdio>
namespace cg = cooperative_groups;

typedef unsigned short bf16_t;
#define DEV __device__ __forceinline__
#define LAS __attribute__((address_space(3)))

constexpr int NB = 8, S = 4096, D = 1024, M = NB * S;
constexpr int NH = 8, HD = 64, PC = 3584;
constexpr int NE = 16, CAP = 512, DFF = 2048, MR = NE * NB * CAP;
constexpr float EPS = 1e-6f, LOG2E = 1.4426950408889634f;
constexpr int NWAVES = 8, NTHR = 512;
constexpr int LDS_BYTES = 147456;

constexpr size_t MiB = 1u << 20;
constexpr size_t WS_CTL = 0;
constexpr size_t WS_ROPE = 1 * MiB;
constexpr size_t WS_BIAS = 2 * MiB;
constexpr size_t WS_IDX = 2 * MiB + 512 * 1024;
constexpr size_t WS_AFF = 3 * MiB;
constexpr size_t WS_INV = 5 * MiB;
constexpr size_t WS_WOUT = 7 * MiB;
constexpr size_t WS_WIN = 9 * MiB;
constexpr size_t WS_XN = 16 * MiB;
constexpr size_t WS_RQ = 80 * MiB, WS_RK = 112 * MiB, WS_RV = 144 * MiB, WS_RG = 176 * MiB;
constexpr size_t WS_AQ = 208 * MiB, WS_AK = 240 * MiB, WS_AV = 272 * MiB;
constexpr size_t WS_ATTO = 304 * MiB;
constexpr size_t WS_ATTL = 400 * MiB;
constexpr size_t WS_KF = 403 * MiB;
constexpr size_t WS_ST = 208 * MiB;
constexpr size_t WS_WD = 80 * MiB;
constexpr size_t WS_WGU = 144 * MiB;
constexpr size_t WS_Y = 144 * MiB;
constexpr size_t WS_HID = 272 * MiB;
constexpr size_t WS_END = 528 * MiB;

DEV unsigned f2bf(float f) { unsigned u = __float_as_uint(f); return (u + 0x7fffu + ((u >> 16) & 1u)) >> 16; }
DEV float bf2f(unsigned h) { return __uint_as_float(h << 16); }
DEV unsigned pk2(float lo, float hi) { return f2bf(lo) | (f2bf(hi) << 16); }
DEV float wave_sum(float v) {
#pragma unroll
    for (int o = 1; o < 64; o <<= 1) v += __shfl_xor(v, o);
    return v;
}
#define LDS_WAIT() asm volatile("s_waitcnt lgkmcnt(0)" ::: "memory")
namespace pg8 {
#define PG8_LAS __attribute__((address_space(3)))
typedef short bf16x8 __attribute__((ext_vector_type(8)));
typedef float f32x4 __attribute__((ext_vector_type(4)));
typedef unsigned u32x4 __attribute__((ext_vector_type(4)));
constexpr int BM = 256, BK = 64, HALF = 128, HTB = HALF * BK * 2, STAGE_BYTES = 8 * HTB, NXCD = 8, WGM = 8;
__host__ __device__ __forceinline__ int lds_byte(int r, int c) { const int st = (r >> 4) * 2 + (c >> 5), rr = r & 15, cc = c & 31, ob = rr * 64 + cc * 2; return st * 1024 + (ob ^ (((ob >> 9) & 1) << 5)); }
__host__ __device__ __forceinline__ void stage_rc(int b, int& R, int& C) { const int st = b / 1024, sb = b % 1024, swz = sb ^ (((sb >> 9) & 1) << 5); R = (st >> 1) * 16 + swz / 64; C = (st & 1) * 32 + (swz % 64) / 2; }
__host__ __device__ __forceinline__ int perm32(int rho) { const int n = rho >> 4, i = rho & 15; return 8 * (i >> 2) + 4 * n + (i & 3); }
struct Unit { int pm, pn; };
struct Gemm { const bf16_t* A; const bf16_t* Bt; int K; };
struct StaticOrder {
    int nM, nN, nwg, G, c;
    __device__ void init(int M_, int N_, int G_, int c_) { nM = M_ / BM; nN = N_ / BM; nwg = nM * nN; G = G_; c = c_; }
    __device__ bool next(int i, Unit& u) const {
        const long L = (long)i * G + c; if (L >= nwg) return false;
        int wgid = (int)L; { const int q = nwg / NXCD, r = nwg % NXCD, xcd = wgid % NXCD, off = wgid / NXCD; wgid = (xcd < r ? xcd * (q + 1) : r * (q + 1) + (xcd - r) * q) + off; }
        const int nig = WGM * nN, gid = wgid / nig, fm = gid * WGM, gsz = (nM - fm) < WGM ? (nM - fm) : WGM;
        u.pm = fm + ((wgid % nig) % gsz); u.pn = (wgid % nig) / gsz; return true;
    }
};
__device__ __forceinline__ unsigned cvt_pk_bf16(float lo, float hi) { unsigned r; asm volatile("v_cvt_pk_bf16_f32 %0, %1, %2" : "=v"(r) : "v"(lo), "v"(hi)); return r; }

template <class Epi, class Sched, bool ALIGN_EPI>
__device__ __forceinline__ void gemm_phase(PG8_LAS unsigned char* lds, const Gemm g, const Sched& S, const Epi& E) {
    const int tid = threadIdx.x, wid = __builtin_amdgcn_readfirstlane(tid >> 6), lane = tid & 63, wr = wid >> 2, wc = wid & 3, fr = lane & 15, fq = lane >> 4;
    const int K = g.K, nt = K / BK;
    int Ri[2], Ci[2]; unsigned voffB[2];
#pragma unroll
    for (int i = 0; i < 2; ++i) { int R, C; stage_rc(tid * 16 + i * 8192, R, C); const int Rb = Epi::PERM ? ((R & ~31) + perm32(R & 31)) : R;
        Ri[i] = R; Ci[i] = C; voffB[i] = (unsigned)(Rb * K + C) * 2u; }
    const size_t kstep = (size_t)(BK * 2);
    const size_t hstep = (size_t)HALF * K * 2;
    const size_t tstep = 2 * hstep;
    const unsigned ldsw = (unsigned)wid * 1024u;
    const int aoff = lds_byte(wr * 64 + fr, fq * 8), boff = lds_byte(wc * 32 + fr, fq * 8);
    const char* gA = (const char*)g.A;
#define PG8_SA(b, h) (((b) * 2 + (h)) * HTB)
#define PG8_SB(b, h) ((4 + (b) * 2 + (h)) * HTB)
#define PG8_STAGE(bufoff, gbase, voff) do { _Pragma("unroll") for (int _i = 0; _i < 2; ++_i) \
        __builtin_amdgcn_global_load_lds((const unsigned*)((const char*)(gbase) + (voff)[_i]), (PG8_LAS unsigned*)(lds + (bufoff) + ldsw + _i * 8192), 16, 0, 0); } while (0)
#define PG8_STAGE_A(bufoff, AO, h, kb) do { _Pragma("unroll") for (int _i = 0; _i < 2; ++_i) \
        __builtin_amdgcn_global_load_lds((const unsigned*)(gA + (size_t)((AO)[h][_i] + (unsigned)(kb))), (PG8_LAS unsigned*)(lds + (bufoff) + ldsw + _i * 8192), 16, 0, 0); } while (0)
#define PG8_LDA(dst, b, h) do { _Pragma("unroll") for (int m = 0; m < 4; ++m) _Pragma("unroll") for (int k = 0; k < 2; ++k) dst[m][k] = *(const PG8_LAS bf16x8*)(lds + PG8_SA(b, h) + aoff + m * 2048 + k * 1024); } while (0)
#define PG8_LDB(dst, b, h) do { _Pragma("unroll") for (int n = 0; n < 2; ++n) _Pragma("unroll") for (int k = 0; k < 2; ++k) dst[n][k] = *(const PG8_LAS bf16x8*)(lds + PG8_SB(b, h) + boff + n * 2048 + k * 1024); } while (0)
#define PG8_MMA(ai, bj, At, Bt) do { __builtin_amdgcn_s_setprio(1); _Pragma("unroll") for (int m = 0; m < 4; ++m) _Pragma("unroll") for (int n = 0; n < 2; ++n) _Pragma("unroll") for (int k = 0; k < 2; ++k) \
        acc[ai][bj][m][n] = __builtin_amdgcn_mfma_f32_16x16x32_bf16(Bt[n][k], At[m][k], acc[ai][bj][m][n], 0, 0, 0); __builtin_amdgcn_s_setprio(0); } while (0)
#define PG8_WAIT_V(n) asm volatile("s_waitcnt vmcnt(" #n ")" ::: "memory")
#define PG8_WAIT_L(n) asm volatile("s_waitcnt lgkmcnt(" #n ")" ::: "memory")
#define PG8_BAR __builtin_amdgcn_s_barrier()
#define PG8_SCHED __builtin_amdgcn_sched_barrier(0)
#define PG8_AOFFS(AO, u) do { _Pragma("unroll") for (int _h = 0; _h < 2; ++_h) _Pragma("unroll") for (int _i = 0; _i < 2; ++_i) (AO)[_h][_i] = S.row_off(u, _h * HALF + Ri[_i]) + (unsigned)(Ci[_i] * 2); } while (0)
    Unit cur, nxt; int ui = 0;
    if (!S.next(0, cur)) return;
    f32x4 acc[2][2][4][2];
#pragma unroll
    for (int a = 0; a < 2; ++a)
#pragma unroll
        for (int b = 0; b < 2; ++b)
#pragma unroll
            for (int m = 0; m < 4; ++m)
#pragma unroll
                for (int n = 0; n < 2; ++n) acc[a][b][m][n] = (f32x4){0.f, 0.f, 0.f, 0.f};
    bf16x8 At[4][2], B0[2][2], B1[2][2];
    unsigned aoc[2][2], aon[2][2];
    PG8_AOFFS(aoc, cur);
    const char* cB = (const char*)g.Bt + (size_t)cur.pn * tstep;
    PG8_STAGE(PG8_SB(0, 0), cB, voffB); PG8_STAGE(PG8_SB(0, 1), cB + hstep, voffB); PG8_STAGE_A(PG8_SA(0, 0), aoc, 0, 0); PG8_STAGE_A(PG8_SA(0, 1), aoc, 1, 0);
    if (wr == 1) PG8_BAR;
    PG8_WAIT_V(2); PG8_BAR;
    PG8_STAGE(PG8_SB(1, 0), cB + kstep, voffB); PG8_STAGE_A(PG8_SA(1, 0), aoc, 0, 128); PG8_STAGE(PG8_SB(1, 1), cB + hstep + kstep, voffB);
    PG8_WAIT_V(6); PG8_BAR;
    for (;;) {
        const bool has_next = S.next(ui + 1, nxt);
        const char* nB = cB;
        if (has_next) { PG8_AOFFS(aon, nxt); nB = (const char*)g.Bt + (size_t)nxt.pn * tstep; }
        else {
#pragma unroll
            for (int _h = 0; _h < 2; ++_h)
#pragma unroll
                for (int _i = 0; _i < 2; ++_i) aon[_h][_i] = aoc[_h][_i]; }
        for (int t = 0; t < nt; t += 2) {
            const bool last = (t == nt - 2);
            const unsigned k1 = (unsigned)(t + 1) * 128u, k2 = last ? 0u : (unsigned)(t + 2) * 128u, k3 = k2 + 128u;
            unsigned a2o[2][2];
#pragma unroll
            for (int _h = 0; _h < 2; ++_h)
#pragma unroll
                for (int _i = 0; _i < 2; ++_i) a2o[_h][_i] = last ? aon[_h][_i] : aoc[_h][_i];
            const char* b2 = last ? nB : cB + (size_t)(t + 2) * kstep; const char* b3 = b2 + kstep;
            PG8_LDB(B0, 0, 0); PG8_LDB(B1, 0, 1); PG8_SCHED; PG8_LDA(At, 0, 0); PG8_STAGE_A(PG8_SA(1, 1), aoc, 1, k1);
            PG8_WAIT_V(8); PG8_WAIT_L(0); PG8_BAR; PG8_MMA(0, 0, At, B0); PG8_MMA(0, 1, At, B1); PG8_BAR; PG8_SCHED;
            PG8_LDA(At, 0, 1); PG8_STAGE(PG8_SB(0, 0), b2, voffB); PG8_STAGE(PG8_SB(0, 1), b2 + hstep, voffB); PG8_STAGE_A(PG8_SA(0, 0), a2o, 0, k2);
            PG8_WAIT_V(8); PG8_WAIT_L(0); PG8_BAR; PG8_MMA(1, 0, At, B0); PG8_MMA(1, 1, At, B1); PG8_BAR; PG8_SCHED;
            PG8_LDB(B0, 1, 0); PG8_LDB(B1, 1, 1); PG8_SCHED; PG8_LDA(At, 1, 0); PG8_STAGE_A(PG8_SA(0, 1), a2o, 1, k2);
            PG8_WAIT_V(8); PG8_WAIT_L(0); PG8_BAR; PG8_MMA(0, 0, At, B0); PG8_MMA(0, 1, At, B1); PG8_BAR; PG8_SCHED;
            PG8_LDA(At, 1, 1); PG8_STAGE(PG8_SB(1, 0), b3, voffB); PG8_STAGE(PG8_SB(1, 1), b3 + hstep, voffB); PG8_STAGE_A(PG8_SA(1, 0), a2o, 0, k3);
            PG8_WAIT_V(8); PG8_WAIT_L(0); PG8_BAR; PG8_MMA(1, 0, At, B0); PG8_MMA(1, 1, At, B1); PG8_BAR; PG8_SCHED;
        }
        if constexpr (ALIGN_EPI) { if (wr == 0) PG8_BAR; }
        E(acc, cur, wr, wc, fr, fq);
        if (!has_next) break;
#pragma unroll
        for (int a = 0; a < 2; ++a)
#pragma unroll
            for (int b = 0; b < 2; ++b)
#pragma unroll
                for (int m = 0; m < 4; ++m)
#pragma unroll
                    for (int n = 0; n < 2; ++n) acc[a][b][m][n] = (f32x4){0.f, 0.f, 0.f, 0.f};
        cur = nxt; cB = nB; ++ui;
#pragma unroll
        for (int _h = 0; _h < 2; ++_h)
#pragma unroll
            for (int _i = 0; _i < 2; ++_i) aoc[_h][_i] = aon[_h][_i];
        if constexpr (ALIGN_EPI) { if (wr == 1) PG8_BAR; }
    }
    PG8_WAIT_V(0);
    if constexpr (!ALIGN_EPI) { if (wr == 0) PG8_BAR; }
    PG8_BAR;
#undef PG8_SA
#undef PG8_SB
#undef PG8_STAGE
#undef PG8_STAGE_A
#undef PG8_LDA
#undef PG8_LDB
#undef PG8_MMA
#undef PG8_WAIT_V
#undef PG8_WAIT_L
#undef PG8_BAR
#undef PG8_SCHED
#undef PG8_AOFFS
}
}
struct SchedPlain : pg8::StaticOrder {
    unsigned rowbytes;
    DEV unsigned row_off(const pg8::Unit& u, int r) const { return (unsigned)(u.pm * 256 + r) * rowbytes; }
};
struct SchedMoe1 : pg8::StaticOrder {
    const int* idx;
    DEV bool next(int i, pg8::Unit& u) const { if (!pg8::StaticOrder::next(i, u)) return false; u.pn += (u.pm >> 4) * 16; return true; }
    DEV unsigned row_off(const pg8::Unit& u, int r) const { const int g = u.pm * 256 + r; const int tok = ((g >> 9) & 7) * S + idx[g]; return (unsigned)tok * (unsigned)(D * 2); }
};
struct SchedMoe2 : pg8::StaticOrder {
    DEV bool next(int i, pg8::Unit& u) const { if (!pg8::StaticOrder::next(i, u)) return false; u.pn += (u.pm >> 4) * 4; return true; }
    DEV unsigned row_off(const pg8::Unit& u, int r) const { return (unsigned)(u.pm * 256 + r) * (unsigned)(DFF * 2); }
};
typedef pg8::f32x4 f32x4; typedef pg8::u32x4 u32x4;
struct EpiInProj {
    static constexpr bool PERM = true;
    unsigned char* ws; const float* ropeT;
    DEV void operator()(const f32x4 (&acc)[2][2][4][2], const pg8::Unit& u, int wr, int wc, int fr, int fq) const {
        const int grp = u.pn >> 1;
        bf16_t* gbase = (bf16_t*)(ws + WS_RQ + (size_t)grp * 32 * MiB);
        const float sc = (grp == 1) ? 0.125f : (grp == 4 ? 0.125f * LOG2E : 1.f);
#pragma unroll
        for (int ai = 0; ai < 2; ++ai)
#pragma unroll
            for (int m = 0; m < 4; ++m) {
                const int row = u.pm * 256 + ai * 128 + wr * 64 + m * 16 + fr, b = row >> 12, s = row & 4095;
#pragma unroll
                for (int bj = 0; bj < 2; ++bj) {
                    const int hd = 4 * (u.pn & 1) + 2 * bj + (wc >> 1), j0 = 32 * (wc & 1) + 8 * fq;
                    f32x4 lo = acc[ai][bj][m][0], hi = acc[ai][bj][m][1];
                    if (grp < 2) {
                        const f32x4 c = *(const f32x4*)(ropeT + s * 32 + (j0 >> 1)), sn = *(const f32x4*)(ropeT + S * 32 + s * 32 + (j0 >> 1));
                        const f32x4 l2 = lo * c - hi * sn, h2 = hi * c + lo * sn; lo = l2; hi = h2;
                    }
                    lo = lo * sc; hi = hi * sc;
                    u32x4 w; w.x = pg8::cvt_pk_bf16(lo[0], lo[1]); w.y = pg8::cvt_pk_bf16(lo[2], lo[3]); w.z = pg8::cvt_pk_bf16(hi[0], hi[1]); w.w = pg8::cvt_pk_bf16(hi[2], hi[3]);
                    *(u32x4*)(gbase + ((size_t)(b * NH + hd) * S + s) * HD + j0) = w;
                }
            }
    }
};
struct EpiOutProj {
    static constexpr bool PERM = true;
    const float* x; float* x1;
    DEV void operator()(const f32x4 (&acc)[2][2][4][2], const pg8::Unit& u, int wr, int wc, int fr, int fq) const {
#pragma unroll
        for (int ai = 0; ai < 2; ++ai)
#pragma unroll
            for (int m = 0; m < 4; ++m) {
                const int row = u.pm * 256 + ai * 128 + wr * 64 + m * 16 + fr;
#pragma unroll
                for (int bj = 0; bj < 2; ++bj) { const size_t off = (size_t)row * D + u.pn * 256 + bj * 128 + wc * 32 + 8 * fq;
                    const f32x4 a = *(const f32x4*)(x + off), b = *(const f32x4*)(x + off + 4);
                    *(f32x4*)(x1 + off) = a + acc[ai][bj][m][0]; *(f32x4*)(x1 + off + 4) = b + acc[ai][bj][m][1]; }
            }
    }
};
struct EpiSwiGLU {
    static constexpr bool PERM = true;
    bf16_t* hid;
    DEV void operator()(const f32x4 (&acc)[2][2][4][2], const pg8::Unit& u, int wr, int wc, int fr, int fq) const {
        const int pnl = u.pn & 15;
#pragma unroll
        for (int ai = 0; ai < 2; ++ai)
#pragma unroll
            for (int m = 0; m < 4; ++m) {
                const int row = u.pm * 256 + ai * 128 + wr * 64 + m * 16 + fr;
                float o[8];
#pragma unroll
                for (int n = 0; n < 2; ++n)
#pragma unroll
                    for (int i = 0; i < 4; ++i) { const float gt = acc[ai][0][m][n][i], up = acc[ai][1][m][n][i];
                        o[4 * n + i] = gt * __builtin_amdgcn_rcpf(1.f + __builtin_amdgcn_exp2f(-gt * LOG2E)) * up; }
                u32x4 w; w.x = pg8::cvt_pk_bf16(o[0], o[1]); w.y = pg8::cvt_pk_bf16(o[2], o[3]); w.z = pg8::cvt_pk_bf16(o[4], o[5]); w.w = pg8::cvt_pk_bf16(o[6], o[7]);
                *(u32x4*)(hid + (size_t)row * DFF + pnl * 128 + wc * 32 + 8 * fq) = w;
            }
    }
};
struct EpiDown {
    static constexpr bool PERM = true;
    bf16_t* y;
    DEV void operator()(const f32x4 (&acc)[2][2][4][2], const pg8::Unit& u, int wr, int wc, int fr, int fq) const {
        const int pnl = u.pn & 3;
#pragma unroll
        for (int ai = 0; ai < 2; ++ai)
#pragma unroll
            for (int m = 0; m < 4; ++m) {
                const int row = u.pm * 256 + ai * 128 + wr * 64 + m * 16 + fr;
#pragma unroll
                for (int bj = 0; bj < 2; ++bj) { const f32x4 lo = acc[ai][bj][m][0], hi = acc[ai][bj][m][1];
                    u32x4 w; w.x = pg8::cvt_pk_bf16(lo[0], lo[1]); w.y = pg8::cvt_pk_bf16(lo[2], lo[3]); w.z = pg8::cvt_pk_bf16(hi[0], hi[1]); w.w = pg8::cvt_pk_bf16(hi[2], hi[3]);
                    *(u32x4*)(y + (size_t)row * D + pnl * 256 + bj * 128 + wc * 32 + 8 * fq) = w; }
            }
    }
};
struct Args { const float* in[13]; float* out; unsigned char* ws; int ph_lo, ph_hi; };
enum { IN_X = 0, IN_G1, IN_WIN, IN_DECAY, IN_GN, IN_RELB, IN_WOUT, IN_G2, IN_WR, IN_WG, IN_WU, IN_WDN, IN_FG };

template <int MODE> DEV int rowmap(int n) {
    if (MODE == 0) return n;
    if (MODE == 1) { if (n >= 1024) return n; const int base = n & ~63, d = n & 63, nn = d >> 5, dd = d & 31; return base + 8 * (dd >> 2) + 4 * nn + (dd & 3); }
    if (MODE == 2) return (n >> 7) * 256 + (n & 127);
    return (n >> 7) * 256 + 128 + (n & 127);
}
template <int MODE> DEV void transpose_item(const float* src, bf16_t* dst, int K, int N, int k0, int n0, float* scr, int lane) {
#pragma unroll 4
    for (int i = 0; i < 16; ++i) { const int kk = (lane >> 4) + 4 * i, c = (lane & 15) * 4;
        const float4 v = *(const float4*)(src + (size_t)(k0 + kk) * N + n0 + c);
        scr[kk * 65 + c] = v.x; scr[kk * 65 + c + 1] = v.y; scr[kk * 65 + c + 2] = v.z; scr[kk * 65 + c + 3] = v.w; }
    LDS_WAIT();
#pragma unroll 2
    for (int i = 0; i < 8; ++i) { const int n = (lane >> 3) + 8 * i, c = (lane & 7) * 8; const float* s = scr + c * 65 + n;
        uint4 o; o.x = pk2(s[0], s[65]); o.y = pk2(s[2 * 65], s[3 * 65]); o.z = pk2(s[4 * 65], s[5 * 65]); o.w = pk2(s[6 * 65], s[7 * 65]);
        *(uint4*)(dst + (size_t)rowmap<MODE>(n0 + n) * K + k0 + c) = o; }
    LDS_WAIT();
}
DEV void rms_row_to_bf16(const float* xrow, const float* g, bf16_t* orow, int lane) {
    const float4* xr = (const float4*)xrow + lane;
    float4 v[4]; float s = 0.f;
#pragma unroll
    for (int j = 0; j < 4; ++j) { v[j] = xr[64 * j]; s += v[j].x * v[j].x + v[j].y * v[j].y + v[j].z * v[j].z + v[j].w * v[j].w; }
    const float rs = rsqrtf(wave_sum(s) * (1.f / D) + EPS);
    uint2* o = (uint2*)orow + lane;
#pragma unroll
    for (int j = 0; j < 4; ++j) { const float4 gg = ((const float4*)g)[lane + 64 * j];
        o[64 * j] = make_uint2(pk2(v[j].x * rs * gg.x, v[j].y * rs * gg.y), pk2(v[j].z * rs * gg.z, v[j].w * rs * gg.w)); }
}
DEV void phase_prep(const Args& a, unsigned char* lds, int gw, int NGW, int lane, int wave) {
    unsigned char* ws = a.ws;
    float* ropeT = (float*)(ws + WS_ROPE); float* biasT = (float*)(ws + WS_BIAS);
    for (int t = gw * 64 + lane; t < S * 32; t += NGW * 64) {
        const int pos = t >> 5, i = t & 31; const double inv = pow(10000.0, -(double)i / 32.0), ang = (double)pos * inv;
        ropeT[t] = (float)cos(ang); ropeT[S * 32 + t] = (float)sin(ang);
        if (t < 3 * NH * 129) { const int p = t / (NH * 129), h = (t / 129) % NH, o = t % 129 - 64, dil = p == 0 ? 1 : (p == 1 ? 4 : 16), rel = o * dil, n = rel < 0 ? -rel : rel;
            int bucket = rel > 0 ? 16 : 0;
            if (n < 8) bucket += n; else { int large = 8 + (int)(log((double)n / 8.0) / log(128.0) * 8.0); if (large > 15) large = 15; bucket += large; }
            biasT[t] = a.in[IN_RELB][bucket * NH + h] * LOG2E; }
    }
    float* scr = (float*)(lds + wave * 16640);
    constexpr int I_IN = (D / 64) * (PC / 64), I_OUT = (D / 64) * (D / 64);
    for (int it = gw; it < I_IN + I_OUT; it += NGW) {
        if (it < I_IN) transpose_item<1>(a.in[IN_WIN], (bf16_t*)(ws + WS_WIN), D, PC, (it / (PC / 64)) * 64, (it % (PC / 64)) * 64, scr, lane);
        else { const int r = it - I_IN; transpose_item<0>(a.in[IN_WOUT], (bf16_t*)(ws + WS_WOUT), D, D, (r / (D / 64)) * 64, (r % (D / 64)) * 64, scr, lane); }
    }
    for (int m = gw; m < M; m += NGW) rms_row_to_bf16(a.in[IN_X] + (size_t)m * D, a.in[IN_G1], (bf16_t*)(ws + WS_XN) + (size_t)m * D, lane);
}
DEV void phase_latew(const Args& a, unsigned char* lds, int gw, int NGW, int lane, int wave) {
    unsigned char* ws = a.ws; float* scr = (float*)(lds + wave * 16640);
    constexpr int I_G = (D / 64) * (DFF / 64);
    for (int it = gw; it < 3 * NE * I_G; it += NGW) {
        const int which = it / (NE * I_G), r = it % (NE * I_G), e = r / I_G, q = r % I_G;
        if (which == 0) transpose_item<2>(a.in[IN_WG] + (size_t)e * D * DFF, (bf16_t*)(ws + WS_WGU) + (size_t)e * 4096 * D, D, DFF, (q / (DFF / 64)) * 64, (q % (DFF / 64)) * 64, scr, lane);
        else if (which == 1) transpose_item<3>(a.in[IN_WU] + (size_t)e * D * DFF, (bf16_t*)(ws + WS_WGU) + (size_t)e * 4096 * D, D, DFF, (q / (DFF / 64)) * 64, (q % (DFF / 64)) * 64, scr, lane);
        else transpose_item<0>(a.in[IN_WDN] + (size_t)e * DFF * D, (bf16_t*)(ws + WS_WD) + (size_t)e * D * DFF, DFF, D, (q / (D / 64)) * 64, (q % (D / 64)) * 64, scr, lane);
    }
}
DEV void phase_router(const Args& a, int gw, int NGW, int lane) {
    unsigned char* ws = a.ws; const float* x1 = a.out; const float* g2 = a.in[IN_G2]; const float* wr = a.in[IN_WR];
    bf16_t* H2b = (bf16_t*)(ws + WS_XN); float* aff = (float*)(ws + WS_AFF); int* inv = (int*)(ws + WS_INV);
    for (int row = gw; row < M; row += NGW) {
        const float4* xr = (const float4*)(x1 + (size_t)row * D) + lane;
        float4 v[4]; float s = 0.f;
#pragma unroll
        for (int j = 0; j < 4; ++j) { v[j] = xr[64 * j]; s += v[j].x * v[j].x + v[j].y * v[j].y + v[j].z * v[j].z + v[j].w * v[j].w; }
        const float rs = rsqrtf(wave_sum(s) * (1.f / D) + EPS);
        float lg[16];
#pragma unroll
        for (int e = 0; e < 16; ++e) lg[e] = 0.f;
        uint2* o = (uint2*)(H2b + (size_t)row * D) + lane;
#pragma unroll
        for (int j = 0; j < 4; ++j) { const float4 gg = ((const float4*)g2)[lane + 64 * j];
            const float hv[4] = {v[j].x * rs * gg.x, v[j].y * rs * gg.y, v[j].z * rs * gg.z, v[j].w * rs * gg.w};
            o[64 * j] = make_uint2(pk2(hv[0], hv[1]), pk2(hv[2], hv[3]));
#pragma unroll
            for (int t = 0; t < 4; ++t) { const float4* w4 = (const float4*)(wr + (size_t)(4 * lane + 256 * j + t) * NE);
#pragma unroll
                for (int c = 0; c < 4; ++c) { const float4 w = w4[c]; lg[4 * c] += hv[t] * w.x; lg[4 * c + 1] += hv[t] * w.y; lg[4 * c + 2] += hv[t] * w.z; lg[4 * c + 3] += hv[t] * w.w; } } }
        float mx = -1e30f;
#pragma unroll
        for (int e = 0; e < 16; ++e) { lg[e] = wave_sum(lg[e]); mx = fmaxf(mx, lg[e]); }
        float sum = 0.f;
#pragma unroll
        for (int e = 0; e < 16; ++e) { lg[e] = __expf(lg[e] - mx); sum += lg[e]; }
        const float is = 1.f / sum;
        if (lane < 16) { float av = 0.f;
#pragma unroll
            for (int e = 0; e < 16; ++e) av = lane == e ? lg[e] * is : av;
            aff[(size_t)row * NE + lane] = av; inv[(size_t)row * NE + lane] = -1; }
    }
}
DEV void phase_topk_simple(const Args& a, unsigned char* lds, int wg, int G, int tid) {
    unsigned char* ws = a.ws; const float* aff = (const float*)(ws + WS_AFF); int* idx = (int*)(ws + WS_IDX); int* inv = (int*)(ws + WS_INV);
    float* av = (float*)lds;
    for (int it = wg; it < NE * NB; it += G) {
        const int e = it / NB, b = it % NB;
        __syncthreads();
        for (int s = tid; s < S; s += NTHR) av[s] = aff[((size_t)b * S + s) * NE + e];
        __syncthreads();
        for (int s = tid; s < S; s += NTHR) { const float v = av[s]; int rank = 0;
            for (int j = 0; j < S; ++j) { const float w = av[j]; rank += (w > v) || (w == v && j < s); }
            if (rank < CAP) { idx[(e * NB + b) * CAP + rank] = s; inv[((size_t)b * S + s) * NE + e] = rank; } }
    }
}
DEV void phase_final(const Args& a, int gw, int NGW, int lane) {
    unsigned char* ws = a.ws; float* xo = a.out; const float* aff = (const float*)(ws + WS_AFF); const int* inv = (const int*)(ws + WS_INV); const bf16_t* y = (const bf16_t*)(ws + WS_Y); const float* fg = a.in[IN_FG];
    for (int row = gw; row < M; row += NGW) {
        const int b = row >> 12;
        float4* xr = (float4*)(xo + (size_t)row * D) + lane;
        float4 v[4];
#pragma unroll
        for (int j = 0; j < 4; ++j) v[j] = xr[64 * j];
        for (int e = 0; e < NE; ++e) { const int sl = inv[(size_t)row * NE + e]; if (sl < 0) continue;
            const float g = aff[(size_t)row * NE + e]; const uint2* yr = (const uint2*)(y + ((size_t)e * 4096 + b * CAP + sl) * D) + lane;
#pragma unroll
            for (int j = 0; j < 4; ++j) { const uint2 w = yr[64 * j]; v[j].x += g * bf2f(w.x & 0xffffu); v[j].y += g * bf2f(w.x >> 16); v[j].z += g * bf2f(w.y & 0xffffu); v[j].w += g * bf2f(w.y >> 16); } }
        float s = 0.f;
#pragma unroll
        for (int j = 0; j < 4; ++j) s += v[j].x * v[j].x + v[j].y * v[j].y + v[j].z * v[j].z + v[j].w * v[j].w;
        const float rs = rsqrtf(wave_sum(s) * (1.f / D) + EPS);
#pragma unroll
        for (int j = 0; j < 4; ++j) { const float4 gg = ((const float4*)fg)[lane + 64 * j]; xr[64 * j] = make_float4(v[j].x * rs * gg.x, v[j].y * rs * gg.y, v[j].z * rs * gg.z, v[j].w * rs * gg.w); }
    }
}
typedef short bf16x8 __attribute__((ext_vector_type(8)));
typedef float f32x16 __attribute__((ext_vector_type(16)));
typedef short s16x4 __attribute__((ext_vector_type(4)));
typedef LAS const char* lds_cptr;
constexpr int VROW = 192;
constexpr int VSLOT = 32 * VROW;
constexpr int MIX_WAVE_LDS = 2 * VSLOT;
constexpr int MIX_BIAS_OFF = NWAVES * MIX_WAVE_LDS;
DEV int crow(int r, int hi) { return (r & 3) + 8 * (r >> 2) + 4 * hi; }
DEV s16x4 vtr(lds_cptr p) { return __builtin_bit_cast(s16x4, __builtin_amdgcn_ds_read_tr16_b64_v4i16((LAS s16x4*)p)); }
DEV bf16x8 tr_frag(lds_cptr slot, int s, int blk, int lane) {
    const int h = lane >> 5; lds_cptr p = slot + (16 * s + 4 * h + ((lane & 15) >> 2)) * VROW + (32 * blk + 16 * ((lane >> 4) & 1) + 4 * (lane & 3)) * 2;
    const s16x4 lo = vtr(p), hi = vtr(p + 8 * VROW);
    return (bf16x8){lo[0], lo[1], lo[2], lo[3], hi[0], hi[1], hi[2], hi[3]};
}
DEV void load_frags(bf16x8 (&f)[4], const bf16_t* rowp, int lane) {
    const int h = lane >> 5;
#pragma unroll
    for (int st = 0; st < 4; ++st) f[st] = *(const bf16x8*)(rowp + 16 * st + 8 * h);
}
DEV bf16x8 pack_p(const f32x16& p, int s) {
    u32x4 w; w.x = pg8::cvt_pk_bf16(p[8 * s], p[8 * s + 1]); w.y = pg8::cvt_pk_bf16(p[8 * s + 2], p[8 * s + 3]); w.z = pg8::cvt_pk_bf16(p[8 * s + 4], p[8 * s + 5]); w.w = pg8::cvt_pk_bf16(p[8 * s + 6], p[8 * s + 7]);
    return __builtin_bit_cast(bf16x8, w);
}
#define MFMA32(a, b, c) __builtin_amdgcn_mfma_f32_32x32x16_bf16((a), (b), (c), 0, 0, 0)
DEV float ex2(float x) { return __builtin_amdgcn_exp2f(x); }

DEV void attn_item(const Args& a, unsigned char* lds, int item, int lane, int wave) {
    unsigned char* ws = a.ws;
    const int p = item >> 13, rem = item & 8191, bh = rem >> 7, qblk = rem & 127;
    const int dil = p == 0 ? 1 : (p == 1 ? 4 : 16), L = S / dil, bpr = L >> 5;
    const int r = qblk / bpr, q0 = (qblk % bpr) * 32;
    const bf16_t* Qh = (const bf16_t*)(ws + WS_AQ) + (size_t)bh * S * HD; const bf16_t* Kh = (const bf16_t*)(ws + WS_AK) + (size_t)bh * S * HD; const bf16_t* Vh = (const bf16_t*)(ws + WS_AV) + (size_t)bh * S * HD;
    const LAS float* biasL = (const LAS float*)((LAS unsigned char*)lds + MIX_BIAS_OFF) + (p * NH + (bh & 7)) * 129;
    LAS unsigned char* slot = (LAS unsigned char*)lds + wave * MIX_WAVE_LDS; lds_cptr slot3 = (lds_cptr)slot;
    const int t = lane & 31, hi = lane >> 5;
    bf16x8 qf[4]; load_frags(qf, Qh + (size_t)((q0 + t) * dil + r) * HD, lane);
    f32x16 o0 = {}, o1 = {}; float m = -1e30f, l = 0.f;
    for (int kk = 0; kk < 5; ++kk) {
        const int kbase = q0 - 64 + 32 * kk;
        if (kbase + 31 < 0 || kbase >= L) continue;
        { const int rr = lane >> 3, ch = lane & 7;
          u32x4 v[4];
#pragma unroll
          for (int i = 0; i < 4; ++i) { int ki = kbase + rr + 8 * i; ki = ki < 0 ? 0 : (ki >= L ? L - 1 : ki); v[i] = *(const u32x4*)(Vh + (size_t)(ki * dil + r) * HD + ch * 8); }
#pragma unroll
          for (int i = 0; i < 4; ++i) *(LAS u32x4*)(slot + (rr + 8 * i) * VROW + ch * 16) = v[i]; }
        bf16x8 kf[4]; { int ki = kbase + t; ki = ki < 0 ? 0 : (ki >= L ? L - 1 : ki); load_frags(kf, Kh + (size_t)(ki * dil + r) * HD, lane); }
        f32x16 sc = {};
#pragma unroll
        for (int st = 0; st < 4; ++st) sc = MFMA32(kf[st], qf[st], sc);
        float mx = -1e30f;
#pragma unroll
        for (int rg = 0; rg < 16; ++rg) { const int key = crow(rg, hi), bi = 32 * kk + key - t, ki = kbase + key;
            const bool ok = bi >= 0 && bi <= 128 && ki >= 0 && ki < L;
            const float bv = biasL[bi < 0 ? 0 : (bi > 128 ? 128 : bi)];
            sc[rg] = ok ? sc[rg] + bv : -1e30f; mx = fmaxf(mx, sc[rg]); }
        mx = fmaxf(mx, __shfl_xor(mx, 32));
        const float mn = fmaxf(m, mx), f = ex2(m - mn); m = mn;
        float ps = 0.f;
#pragma unroll
        for (int rg = 0; rg < 16; ++rg) { sc[rg] = ex2(sc[rg] - mn); ps += sc[rg]; }
        l = l * f + ps;
#pragma unroll
        for (int rg = 0; rg < 16; ++rg) { o0[rg] *= f; o1[rg] *= f; }
        const bf16x8 p0 = pack_p(sc, 0), p1 = pack_p(sc, 1);
        LDS_WAIT();
        o0 = MFMA32(tr_frag(slot3, 0, 0, lane), p0, o0); o0 = MFMA32(tr_frag(slot3, 1, 0, lane), p1, o0);
        o1 = MFMA32(tr_frag(slot3, 0, 1, lane), p0, o1); o1 = MFMA32(tr_frag(slot3, 1, 1, lane), p1, o1);
        LDS_WAIT();
    }
    l += __shfl_xor(l, 32);
    const float il = 1.f / l;
    const size_t orow = ((size_t)p * NB * NH + bh) * S + (size_t)((q0 + t) * dil + r);
    bf16_t* op = (bf16_t*)(ws + WS_ATTO) + orow * HD;
#pragma unroll
    for (int g4 = 0; g4 < 4; ++g4) {
        *(uint2*)(op + 8 * g4 + 4 * hi) = make_uint2(pg8::cvt_pk_bf16(o0[4 * g4] * il, o0[4 * g4 + 1] * il), pg8::cvt_pk_bf16(o0[4 * g4 + 2] * il, o0[4 * g4 + 3] * il));
        *(uint2*)(op + 32 + 8 * g4 + 4 * hi) = make_uint2(pg8::cvt_pk_bf16(o1[4 * g4] * il, o1[4 * g4 + 1] * il), pg8::cvt_pk_bf16(o1[4 * g4 + 2] * il, o1[4 * g4 + 3] * il));
    }
    if (hi == 0) ((float*)(ws + WS_ATTL))[orow] = m + __log2f(l);
}
DEV void retstate_item(const Args& a, unsigned char* lds, int item, int lane, int wave) {
    unsigned char* ws = a.ws;
    const int dir = item & 1, n = (item >> 1) & 31, bh = item >> 6, h = bh & 7;
    const bf16_t* Kc = (const bf16_t*)(ws + WS_RK) + ((size_t)bh * S + n * 128) * HD; const bf16_t* Vc = (const bf16_t*)(ws + WS_RV) + ((size_t)bh * S + n * 128) * HD;
    const float lg = a.in[IN_DECAY][dir * NH + h] * LOG2E;
    LAS unsigned char* vs = (LAS unsigned char*)lds + wave * MIX_WAVE_LDS; LAS unsigned char* ks = vs + VSLOT; lds_cptr vs3 = (lds_cptr)vs, ks3 = (lds_cptr)ks;
    f32x16 acc[2][2] = {};
    for (int blk = 0; blk < 4; ++blk) {
        { const int rr = lane >> 3, ch = lane & 7;
          u32x4 v[4], k[4];
#pragma unroll
          for (int i = 0; i < 4; ++i) { const int mrow = 32 * blk + rr + 8 * i; v[i] = *(const u32x4*)(Vc + (size_t)mrow * HD + ch * 8); k[i] = *(const u32x4*)(Kc + (size_t)mrow * HD + ch * 8); }
#pragma unroll
          for (int i = 0; i < 4; ++i) { const int mrow = 32 * blk + rr + 8 * i; const float z = ex2(lg * (float)(dir == 0 ? 127 - mrow : mrow));
              const unsigned kw[4] = {k[i].x, k[i].y, k[i].z, k[i].w}; u32x4 o;
              o.x = pg8::cvt_pk_bf16(bf2f(kw[0] & 0xffffu) * z, bf2f(kw[0] >> 16) * z); o.y = pg8::cvt_pk_bf16(bf2f(kw[1] & 0xffffu) * z, bf2f(kw[1] >> 16) * z);
              o.z = pg8::cvt_pk_bf16(bf2f(kw[2] & 0xffffu) * z, bf2f(kw[2] >> 16) * z); o.w = pg8::cvt_pk_bf16(bf2f(kw[3] & 0xffffu) * z, bf2f(kw[3] >> 16) * z);
              *(LAS u32x4*)(vs + (rr + 8 * i) * VROW + ch * 16) = v[i]; *(LAS u32x4*)(ks + (rr + 8 * i) * VROW + ch * 16) = o; } }
        LDS_WAIT();
#pragma unroll
        for (int s = 0; s < 2; ++s) {
            const bf16x8 v0 = tr_frag(vs3, s, 0, lane), v1 = tr_frag(vs3, s, 1, lane), k0 = tr_frag(ks3, s, 0, lane), k1 = tr_frag(ks3, s, 1, lane);
            acc[0][0] = MFMA32(v0, k0, acc[0][0]); acc[0][1] = MFMA32(v0, k1, acc[0][1]); acc[1][0] = MFMA32(v1, k0, acc[1][0]); acc[1][1] = MFMA32(v1, k1, acc[1][1]);
        }
        LDS_WAIT();
    }
    float* KT = (float*)(ws + WS_KF) + (((size_t)dir * NB * NH + bh) * 32 + n) * 4096;
    const int c = lane & 31, hi = lane >> 5;
#pragma unroll
    for (int eb = 0; eb < 2; ++eb)
#pragma unroll
        for (int db = 0; db < 2; ++db)
#pragma unroll
            for (int rg = 0; rg < 16; ++rg) KT[(32 * eb + crow(rg, hi)) * 64 + 32 * db + c] = acc[eb][db][rg];
}
DEV void phase_scan(const Args& a, int gtid, int NT) {
    unsigned char* ws = a.ws;
    for (int sl = gtid; sl < 2 * NB * NH * 1024; sl += NT) {
        const int dir = sl >> 16, bh = (sl >> 10) & 63, q = sl & 1023, h = bh & 7;
        const float gC = ex2(a.in[IN_DECAY][dir * NH + h] * LOG2E * 128.f);
        const float4* kt = (const float4*)(ws + WS_KF) + ((size_t)dir * NB * NH + bh) * 32 * 1024 + q;
        uint2* st = (uint2*)(ws + WS_ST) + ((size_t)dir * NB * NH + bh) * 32 * 1024 + q;
        float4 s = make_float4(0.f, 0.f, 0.f, 0.f);
        for (int i = 0; i < 32; ++i) { const int n = dir == 0 ? i : 31 - i;
            st[(size_t)n * 1024] = make_uint2(pg8::cvt_pk_bf16(s.x, s.y), pg8::cvt_pk_bf16(s.z, s.w));
            const float4 kv = kt[(size_t)n * 1024];
            s.x = gC * s.x + kv.x; s.y = gC * s.y + kv.y; s.z = gC * s.z + kv.z; s.w = gC * s.w + kv.w; }
    }
}
DEV void retout_item(const Args& a, unsigned char* lds, int item, int lane, int wave) {
    unsigned char* ws = a.ws;
    const int qb = item & 3, n = (item >> 2) & 31, bh = item >> 7, h = bh & 7, b = bh >> 3;
    const bf16_t* Qc = (const bf16_t*)(ws + WS_RQ) + ((size_t)bh * S + n * 128) * HD; const bf16_t* Kc = (const bf16_t*)(ws + WS_RK) + ((size_t)bh * S + n * 128) * HD;
    const bf16_t* Vc = (const bf16_t*)(ws + WS_RV) + ((size_t)bh * S + n * 128) * HD;
    const bf16_t* SF = (const bf16_t*)(ws + WS_ST) + (((size_t)0 * NB * NH + bh) * 32 + n) * 4096; const bf16_t* SB = (const bf16_t*)(ws + WS_ST) + (((size_t)1 * NB * NH + bh) * 32 + n) * 4096;
    const float lg0 = a.in[IN_DECAY][h] * LOG2E, lg1 = a.in[IN_DECAY][NH + h] * LOG2E;
    LAS unsigned char* slot = (LAS unsigned char*)lds + wave * MIX_WAVE_LDS; lds_cptr slot3 = (lds_cptr)slot;
    const int t = lane & 31, hi = lane >> 5, c = 32 * qb + t;
    bf16x8 qf[4]; load_frags(qf, Qc + (size_t)c * HD, lane);
    f32x16 o0 = {}, o1 = {};
    { bf16x8 s0[4], s1[4]; load_frags(s0, SF + (size_t)t * 64, lane); load_frags(s1, SF + (size_t)(32 + t) * 64, lane);
#pragma unroll
      for (int st = 0; st < 4; ++st) { o0 = MFMA32(s0[st], qf[st], o0); o1 = MFMA32(s1[st], qf[st], o1); }
      const float fa = ex2(lg0 * (float)(c + 1) - lg1 * (float)(128 - c));
#pragma unroll
      for (int rg = 0; rg < 16; ++rg) { o0[rg] *= fa; o1[rg] *= fa; }
      load_frags(s0, SB + (size_t)t * 64, lane); load_frags(s1, SB + (size_t)(32 + t) * 64, lane);
#pragma unroll
      for (int st = 0; st < 4; ++st) { o0 = MFMA32(s0[st], qf[st], o0); o1 = MFMA32(s1[st], qf[st], o1); }
      const float fb = ex2(lg1 * (float)(128 - c));
#pragma unroll
      for (int rg = 0; rg < 16; ++rg) { o0[rg] *= fb; o1[rg] *= fb; } }
    for (int kb = 0; kb < 4; ++kb) {
        { const int rr = lane >> 3, ch = lane & 7;
          u32x4 v[4];
#pragma unroll
          for (int i = 0; i < 4; ++i) v[i] = *(const u32x4*)(Vc + (size_t)(32 * kb + rr + 8 * i) * HD + ch * 8);
#pragma unroll
          for (int i = 0; i < 4; ++i) *(LAS u32x4*)(slot + (rr + 8 * i) * VROW + ch * 16) = v[i]; }
        bf16x8 kf[4]; load_frags(kf, Kc + (size_t)(32 * kb + t) * HD, lane);
        f32x16 sc = {};
#pragma unroll
        for (int st = 0; st < 4; ++st) sc = MFMA32(kf[st], qf[st], sc);
#pragma unroll
        for (int rg = 0; rg < 16; ++rg) { const int mk = 32 * kb + crow(rg, hi), df = c - mk; sc[rg] *= df >= 0 ? ex2(lg0 * (float)df) : ex2(lg1 * (float)(-df)); }
        const bf16x8 p0 = pack_p(sc, 0), p1 = pack_p(sc, 1);
        LDS_WAIT();
        o0 = MFMA32(tr_frag(slot3, 0, 0, lane), p0, o0); o0 = MFMA32(tr_frag(slot3, 1, 0, lane), p1, o0);
        o1 = MFMA32(tr_frag(slot3, 0, 1, lane), p0, o1); o1 = MFMA32(tr_frag(slot3, 1, 1, lane), p1, o1);
        LDS_WAIT();
    }
    float sm = 0.f;
#pragma unroll
    for (int rg = 0; rg < 16; ++rg) sm += o0[rg] + o1[rg];
    sm += __shfl_xor(sm, 32); const float mu = sm * (1.f / 64.f); float vq = 0.f;
#pragma unroll
    for (int rg = 0; rg < 16; ++rg) { const float d0 = o0[rg] - mu, d1 = o1[rg] - mu; vq += d0 * d0 + d1 * d1; }
    vq += __shfl_xor(vq, 32); const float rstd = rsqrtf(vq * (1.f / 64.f) + EPS);
    const size_t pos = (size_t)n * 128 + c;
    const bf16_t* gp = (const bf16_t*)(ws + WS_RG) + ((size_t)bh * S + pos) * HD; bf16_t* op = (bf16_t*)(ws + WS_XN) + ((size_t)b * S + pos) * D + h * HD; const float* gn = a.in[IN_GN] + h * HD;
#pragma unroll
    for (int db = 0; db < 2; ++db)
#pragma unroll
        for (int g4 = 0; g4 < 4; ++g4) { const int e0 = 32 * db + 8 * g4 + 4 * hi; const uint2 gw = *(const uint2*)(gp + e0); const float4 gg = *(const float4*)(gn + e0);
            const float gate[4] = {bf2f(gw.x & 0xffffu), bf2f(gw.x >> 16), bf2f(gw.y & 0xffffu), bf2f(gw.y >> 16)}; const float gv[4] = {gg.x, gg.y, gg.z, gg.w}; float o[4];
#pragma unroll
            for (int i = 0; i < 4; ++i) { const float rv = (db == 0 ? o0[4 * g4 + i] : o1[4 * g4 + i]); o[i] = (rv - mu) * rstd * gv[i] * (gate[i] / (1.f + __expf(-gate[i]))); }
            *(uint2*)(op + e0) = make_uint2(pg8::cvt_pk_bf16(o[0], o[1]), pg8::cvt_pk_bf16(o[2], o[3])); }
}
DEV void phase_attn_merge(const Args& a, int gtid, int NT) {
    unsigned char* ws = a.ws; const float* L = (const float*)(ws + WS_ATTL); const bf16_t* O = (const bf16_t*)(ws + WS_ATTO); bf16_t* mixed = (bf16_t*)(ws + WS_XN);
    for (int it = gtid; it < NB * NH * S * 8; it += NT) {
        const int ch = it & 7, row = it >> 3;
        const int bh = row >> 12, pos = row & 4095, b = bh >> 3, h = bh & 7;
        const float l0 = L[row], l1 = L[(size_t)NB * NH * S + row], l2 = L[(size_t)2 * NB * NH * S + row];
        const float mx = fmaxf(l0, fmaxf(l1, l2)); float w0 = ex2(l0 - mx), w1 = ex2(l1 - mx), w2 = ex2(l2 - mx); const float is = 1.f / (w0 + w1 + w2); w0 *= is; w1 *= is; w2 *= is;
        const uint4 a0 = *(const uint4*)(O + (size_t)row * HD + ch * 8), a1 = *(const uint4*)(O + ((size_t)NB * NH * S + row) * HD + ch * 8), a2 = *(const uint4*)(O + ((size_t)2 * NB * NH * S + row) * HD + ch * 8);
        const unsigned x0[4] = {a0.x, a0.y, a0.z, a0.w}, x1[4] = {a1.x, a1.y, a1.z, a1.w}, x2[4] = {a2.x, a2.y, a2.z, a2.w}; unsigned o[4];
#pragma unroll
        for (int j = 0; j < 4; ++j) o[j] = pg8::cvt_pk_bf16(w0 * bf2f(x0[j] & 0xffffu) + w1 * bf2f(x1[j] & 0xffffu) + w2 * bf2f(x2[j] & 0xffffu), w0 * bf2f(x0[j] >> 16) + w1 * bf2f(x1[j] >> 16) + w2 * bf2f(x2[j] >> 16));
        *(uint4*)(mixed + ((size_t)b * S + pos) * D + 512 + h * HD + ch * 8) = make_uint4(o[0], o[1], o[2], o[3]);
    }
}
DEV void phase_mix_a(const Args& a, unsigned char* lds, int gw, int NGW, int lane, int wave, int tid) {
    { const float* bt = (const float*)(a.ws + WS_BIAS); float* bl = (float*)(lds + MIX_BIAS_OFF); for (int i = tid; i < 3 * NH * 129; i += NTHR) bl[i] = bt[i]; }
    __syncthreads();
    for (int it = gw; it < 2 * 32 * NB * NH; it += NGW) retstate_item(a, lds, it, lane, wave);
    for (int it = gw; it < 3 * 8192; it += NGW) attn_item(a, lds, it, lane, wave);
}
DEV void phase_mix_b(const Args& a, unsigned char* lds, int gw, int NGW, int lane, int wave, int tid, int wg, int G) {
    for (int it = gw; it < NB * NH * 32 * 4; it += NGW) retout_item(a, lds, it, lane, wave);
    phase_attn_merge(a, wg * NTHR + tid, G * NTHR);
}
#ifndef MK_LAUNCHES
#define MK_LAUNCHES 1
#endif
constexpr int NPH = 11;
__global__ void __launch_bounds__(NTHR, 2) mega(Args a) {
    extern __shared__ __attribute__((aligned(16))) unsigned char lds[];
    const int tid = threadIdx.x, lane = tid & 63, wave = __builtin_amdgcn_readfirstlane(tid >> 6);
    const int G = gridDim.x, wg = blockIdx.x, gw = wg * NWAVES + wave, NGW = G * NWAVES;
    unsigned char* ws = a.ws;
    const int lo = a.ph_lo, hi = a.ph_hi;
#define IN(k) (lo <= (k) && (k) < hi)
#define SEAM(k) do { if (IN(k) && IN((k) + 1)) { cg::this_grid().sync(); } } while (0)
    if (IN(0)) { phase_prep(a, lds, gw, NGW, lane, wave); }
    SEAM(0);
    if (IN(1)) { pg8::Gemm g{(const bf16_t*)(ws + WS_XN), (const bf16_t*)(ws + WS_WIN), D}; SchedPlain Sc; Sc.init(M, PC, G, wg); Sc.rowbytes = D * 2;
        EpiInProj E{ws, (const float*)(ws + WS_ROPE)};
        pg8::gemm_phase<EpiInProj, SchedPlain, true>((LAS unsigned char*)lds, g, Sc, E); }
    SEAM(1);
    if (IN(2)) { phase_mix_a(a, lds, gw, NGW, lane, wave, tid); }
    SEAM(2);
    if (IN(3)) { phase_scan(a, wg * NTHR + tid, G * NTHR); }
    SEAM(3);
    if (IN(4)) { phase_mix_b(a, lds, gw, NGW, lane, wave, tid, wg, G); }
    SEAM(4);
    if (IN(5)) { pg8::Gemm g{(const bf16_t*)(ws + WS_XN), (const bf16_t*)(ws + WS_WOUT), D}; SchedPlain Sc; Sc.init(M, D, G, wg); Sc.rowbytes = D * 2;
        EpiOutProj E{a.in[IN_X], a.out};
        pg8::gemm_phase<EpiOutProj, SchedPlain, true>((LAS unsigned char*)lds, g, Sc, E); }
    SEAM(5);
    if (IN(6)) { phase_router(a, gw, NGW, lane); phase_latew(a, lds, gw, NGW, lane, wave); }
    SEAM(6);
    if (IN(7)) { phase_topk_simple(a, lds, wg, G, tid); }
    SEAM(7);
    if (IN(8)) { pg8::Gemm g{(const bf16_t*)(ws + WS_XN), (const bf16_t*)(ws + WS_WGU), D}; SchedMoe1 Sc; Sc.init(MR, 4096, G, wg); Sc.idx = (const int*)(ws + WS_IDX);
        EpiSwiGLU E{(bf16_t*)(ws + WS_HID)};
        pg8::gemm_phase<EpiSwiGLU, SchedMoe1, true>((LAS unsigned char*)lds, g, Sc, E); }
    SEAM(8);
    if (IN(9)) { pg8::Gemm g{(const bf16_t*)(ws + WS_HID), (const bf16_t*)(ws + WS_WD), DFF}; SchedMoe2 Sc; Sc.init(MR, D, G, wg);
        EpiDown E{(bf16_t*)(ws + WS_Y)};
        pg8::gemm_phase<EpiDown, SchedMoe2, true>((LAS unsigned char*)lds, g, Sc, E); }
    SEAM(9);
    if (IN(10)) { phase_final(a, gw, NGW, lane); }
#undef IN
#undef SEAM
}

extern "C" void kernel_launch(void* const* d_in, const int* in_sizes, int n_in, void* d_out, int out_size, void* d_ws, size_t ws_size, hipStream_t stream) {
    static int grid = 0;
    if (grid == 0) {
        if (n_in != 13 || in_sizes[0] != M * D || out_size != M * D || ws_size < WS_END) { fprintf(stderr, "kernel_launch: unexpected shapes n_in %d in0 %d out %d ws %zu (need %zu)\n", n_in, n_in > 0 ? in_sizes[0] : -1, out_size, ws_size, (size_t)WS_END); grid = -1; return; }
        int dev = 0, cus = 0, per_cu = 0;
        (void)hipGetDevice(&dev); (void)hipDeviceGetAttribute(&cus, hipDeviceAttributeMultiprocessorCount, dev);
        (void)hipFuncSetAttribute((const void*)mega, hipFuncAttributeMaxDynamicSharedMemorySize, LDS_BYTES);
        if (hipOccupancyMaxActiveBlocksPerMultiprocessor(&per_cu, (const void*)mega, NTHR, LDS_BYTES) != hipSuccess || per_cu < 1) { fprintf(stderr, "kernel_launch: occupancy query says %d blocks/CU\n", per_cu); per_cu = 1; }
        (void)hipGetLastError();
        grid = cus * 1;
        if (grid > cus * per_cu) grid = cus * per_cu;
    }
    if (grid < 0) return;
    (void)hipMemsetAsync((char*)d_ws + WS_CTL, 0, 1 * MiB, stream);
    Args a{};
    for (int i = 0; i < 13; ++i) a.in[i] = (const float*)d_in[i];
    a.out = (float*)d_out; a.ws = (unsigned char*)d_ws;
#if MK_LAUNCHES == 1
    a.ph_lo = 0; a.ph_hi = NPH;
    void* args[] = {&a};
    hipError_t e = hipLaunchCooperativeKernel((const void*)mega, dim3(grid), dim3(NTHR), args, LDS_BYTES, stream);
    if (e != hipSuccess) fprintf(stderr, "cooperative launch failed: %s (grid %d)\n", hipGetErrorString(e), grid);
#else
    for (int p = 0; p < NPH; ++p) { a.ph_lo = p; a.ph_hi = p + 1; hipLaunchKernelGGL(mega, dim3(grid), dim3(NTHR), LDS_BYTES, stream, a); }
#endif
}
```

```cpp
#include <hip/hip_runtime.h>
#include <hip/hip_cooperative_groups.h>
#include <cstdint>
#include <cstdio>
namespace cg = cooperative_groups;

typedef unsigned short bf16_t;
#define DEV __device__ __forceinline__
#define LAS __attribute__((address_space(3)))

constexpr int NB = 8, S = 4096, D = 1024, M = NB * S;
constexpr int NH = 8, HD = 64, PC = 3584;
constexpr int NE = 16, CAP = 512, DFF = 2048, MR = NE * NB * CAP;
constexpr float EPS = 1e-6f, LOG2E = 1.4426950408889634f;
constexpr int NWAVES = 8, NTHR = 512;
constexpr int LDS_BYTES = 147456;

constexpr size_t MiB = 1u << 20;
constexpr size_t WS_CTL = 0;
constexpr size_t WS_ROPE = 1 * MiB;
constexpr size_t WS_BIAS = 2 * MiB;
constexpr size_t WS_IDX = 2 * MiB + 512 * 1024;
constexpr size_t WS_AFF = 3 * MiB;
constexpr size_t WS_INV = 5 * MiB;
constexpr size_t WS_AFFT = 9 * MiB;
constexpr size_t WS_WOUT = 7 * MiB;
constexpr size_t WS_WIN = 9 * MiB;
constexpr size_t WS_XN = 16 * MiB;
constexpr size_t WS_RQ = 80 * MiB, WS_RK = 112 * MiB, WS_RV = 144 * MiB, WS_RG = 176 * MiB;
constexpr size_t WS_AQ = 208 * MiB, WS_AK = 240 * MiB, WS_AV = 272 * MiB;
constexpr size_t WS_ATTO = 304 * MiB;
constexpr size_t WS_ATTL = 400 * MiB;
constexpr size_t WS_KF = 403 * MiB;
constexpr size_t WS_ST = 208 * MiB;
constexpr size_t WS_WD = 80 * MiB;
constexpr size_t WS_WGU = 144 * MiB;
constexpr size_t WS_Y = 144 * MiB;
constexpr size_t WS_HID = 272 * MiB;
constexpr size_t WS_END = 528 * MiB;

DEV unsigned f2bf(float f) { unsigned u = __float_as_uint(f); return (u + 0x7fffu + ((u >> 16) & 1u)) >> 16; }
DEV float bf2f(unsigned h) { return __uint_as_float(h << 16); }
DEV unsigned pk2(float lo, float hi) { return f2bf(lo) | (f2bf(hi) << 16); }
DEV float wave_sum(float v) {
#pragma unroll
    for (int o = 1; o < 64; o <<= 1) v += __shfl_xor(v, o);
    return v;
}
#define LDS_WAIT() asm volatile("s_waitcnt lgkmcnt(0)" ::: "memory")
namespace pg8 {
#define PG8_LAS __attribute__((address_space(3)))
typedef short bf16x8 __attribute__((ext_vector_type(8)));
typedef float f32x4 __attribute__((ext_vector_type(4)));
typedef unsigned u32x4 __attribute__((ext_vector_type(4)));
constexpr int BM = 256, BK = 64, HALF = 128, HTB = HALF * BK * 2, STAGE_BYTES = 8 * HTB, NXCD = 8, WGM = 8;
__host__ __device__ __forceinline__ int lds_byte(int r, int c) { const int st = (r >> 4) * 2 + (c >> 5), rr = r & 15, cc = c & 31, ob = rr * 64 + cc * 2; return st * 1024 + (ob ^ (((ob >> 9) & 1) << 5)); }
__host__ __device__ __forceinline__ void stage_rc(int b, int& R, int& C) { const int st = b / 1024, sb = b % 1024, swz = sb ^ (((sb >> 9) & 1) << 5); R = (st >> 1) * 16 + swz / 64; C = (st & 1) * 32 + (swz % 64) / 2; }
__host__ __device__ __forceinline__ int perm32(int rho) { const int n = rho >> 4, i = rho & 15; return 8 * (i >> 2) + 4 * n + (i & 3); }
struct Unit { int pm, pn; };
struct Gemm { const bf16_t* A; const bf16_t* Bt; int K; };
struct StaticOrder {
    int nM, nN, nwg, G, c;
    __device__ void init(int M_, int N_, int G_, int c_) { nM = M_ / BM; nN = N_ / BM; nwg = nM * nN; G = G_; c = c_; }
    __device__ bool next(int i, Unit& u) const {
        const long L = (long)i * G + c; if (L >= nwg) return false;
        int wgid = (int)L; { const int q = nwg / NXCD, r = nwg % NXCD, xcd = wgid % NXCD, off = wgid / NXCD; wgid = (xcd < r ? xcd * (q + 1) : r * (q + 1) + (xcd - r) * q) + off; }
        const int nig = WGM * nN, gid = wgid / nig, fm = gid * WGM, gsz = (nM - fm) < WGM ? (nM - fm) : WGM;
        u.pm = fm + ((wgid % nig) % gsz); u.pn = (wgid % nig) / gsz; return true;
    }
};
__device__ __forceinline__ unsigned cvt_pk_bf16(float lo, float hi) { unsigned r; asm volatile("v_cvt_pk_bf16_f32 %0, %1, %2" : "=v"(r) : "v"(lo), "v"(hi)); return r; }

template <class Epi, class Sched, bool ALIGN_EPI>
__device__ __forceinline__ void gemm_phase(PG8_LAS unsigned char* lds, const Gemm g, const Sched& S, const Epi& E) {
    const int tid = threadIdx.x, wid = __builtin_amdgcn_readfirstlane(tid >> 6), lane = tid & 63, wr = wid >> 2, wc = wid & 3, fr = lane & 15, fq = lane >> 4;
    const int K = g.K, nt = K / BK;
    int Ri[2], Ci[2]; unsigned voffB[2];
#pragma unroll
    for (int i = 0; i < 2; ++i) { int R, C; stage_rc(tid * 16 + i * 8192, R, C); const int Rb = Epi::PERM ? ((R & ~31) + perm32(R & 31)) : R;
        Ri[i] = R; Ci[i] = C; voffB[i] = (unsigned)(Rb * K + C) * 2u; }
    const size_t kstep = (size_t)(BK * 2);
    const size_t hstep = (size_t)HALF * K * 2;
    const size_t tstep = 2 * hstep;
    const unsigned ldsw = (unsigned)wid * 1024u;
    const int aoff = lds_byte(wr * 64 + fr, fq * 8), boff = lds_byte(wc * 32 + fr, fq * 8);
    const char* gA = (const char*)g.A;
#define PG8_SA(b, h) (((b) * 2 + (h)) * HTB)
#define PG8_SB(b, h) ((4 + (b) * 2 + (h)) * HTB)
#define PG8_STAGE(bufoff, gbase, voff) do { _Pragma("unroll") for (int _i = 0; _i < 2; ++_i) \
        __builtin_amdgcn_global_load_lds((const unsigned*)((const char*)(gbase) + (voff)[_i]), (PG8_LAS unsigned*)(lds + (bufoff) + ldsw + _i * 8192), 16, 0, 0); } while (0)
#define PG8_STAGE_A(bufoff, AO, h, kb) do { _Pragma("unroll") for (int _i = 0; _i < 2; ++_i) \
        __builtin_amdgcn_global_load_lds((const unsigned*)(gA + (size_t)((AO)[h][_i] + (unsigned)(kb))), (PG8_LAS unsigned*)(lds + (bufoff) + ldsw + _i * 8192), 16, 0, 0); } while (0)
#define PG8_LDA(dst, b, h) do { _Pragma("unroll") for (int m = 0; m < 4; ++m) _Pragma("unroll") for (int k = 0; k < 2; ++k) dst[m][k] = *(const PG8_LAS bf16x8*)(lds + PG8_SA(b, h) + aoff + m * 2048 + k * 1024); } while (0)
#define PG8_LDB(dst, b, h) do { _Pragma("unroll") for (int n = 0; n < 2; ++n) _Pragma("unroll") for (int k = 0; k < 2; ++k) dst[n][k] = *(const PG8_LAS bf16x8*)(lds + PG8_SB(b, h) + boff + n * 2048 + k * 1024); } while (0)
#define PG8_MMA(ai, bj, At, Bt) do { __builtin_amdgcn_s_setprio(1); _Pragma("unroll") for (int m = 0; m < 4; ++m) _Pragma("unroll") for (int n = 0; n < 2; ++n) _Pragma("unroll") for (int k = 0; k < 2; ++k) \
        acc[ai][bj][m][n] = __builtin_amdgcn_mfma_f32_16x16x32_bf16(Bt[n][k], At[m][k], acc[ai][bj][m][n], 0, 0, 0); __builtin_amdgcn_s_setprio(0); } while (0)
#define PG8_WAIT_V(n) asm volatile("s_waitcnt vmcnt(" #n ")" ::: "memory")
#define PG8_WAIT_L(n) asm volatile("s_waitcnt lgkmcnt(" #n ")" ::: "memory")
#define PG8_BAR __builtin_amdgcn_s_barrier()
#define PG8_SCHED __builtin_amdgcn_sched_barrier(0)
#define PG8_AOFFS(AO, u) do { _Pragma("unroll") for (int _h = 0; _h < 2; ++_h) _Pragma("unroll") for (int _i = 0; _i < 2; ++_i) (AO)[_h][_i] = S.row_off(u, _h * HALF + Ri[_i]) + (unsigned)(Ci[_i] * 2); } while (0)
    Unit cur, nxt; int ui = 0;
    if (!S.next(0, cur)) return;
    f32x4 acc[2][2][4][2];
#pragma unroll
    for (int a = 0; a < 2; ++a)
#pragma unroll
        for (int b = 0; b < 2; ++b)
#pragma unroll
            for (int m = 0; m < 4; ++m)
#pragma unroll
                for (int n = 0; n < 2; ++n) acc[a][b][m][n] = (f32x4){0.f, 0.f, 0.f, 0.f};
    bf16x8 At[4][2], B0[2][2], B1[2][2];
    unsigned aoc[2][2], aon[2][2];
    PG8_AOFFS(aoc, cur);
    const char* cB = (const char*)g.Bt + (size_t)cur.pn * tstep;
    PG8_STAGE(PG8_SB(0, 0), cB, voffB); PG8_STAGE(PG8_SB(0, 1), cB + hstep, voffB); PG8_STAGE_A(PG8_SA(0, 0), aoc, 0, 0); PG8_STAGE_A(PG8_SA(0, 1), aoc, 1, 0);
    if (wr == 1) PG8_BAR;
    PG8_WAIT_V(2); PG8_BAR;
    PG8_STAGE(PG8_SB(1, 0), cB + kstep, voffB); PG8_STAGE_A(PG8_SA(1, 0), aoc, 0, 128); PG8_STAGE(PG8_SB(1, 1), cB + hstep + kstep, voffB);
    PG8_WAIT_V(6); PG8_BAR;
    for (;;) {
        const bool has_next = S.next(ui + 1, nxt);
        const char* nB = cB;
        if (has_next) { PG8_AOFFS(aon, nxt); nB = (const char*)g.Bt + (size_t)nxt.pn * tstep; }
        else {
#pragma unroll
            for (int _h = 0; _h < 2; ++_h)
#pragma unroll
                for (int _i = 0; _i < 2; ++_i) aon[_h][_i] = aoc[_h][_i]; }
        for (int t = 0; t < nt; t += 2) {
            const bool last = (t == nt - 2);
            const unsigned k1 = (unsigned)(t + 1) * 128u, k2 = last ? 0u : (unsigned)(t + 2) * 128u, k3 = k2 + 128u;
            unsigned a2o[2][2];
#pragma unroll
            for (int _h = 0; _h < 2; ++_h)
#pragma unroll
                for (int _i = 0; _i < 2; ++_i) a2o[_h][_i] = last ? aon[_h][_i] : aoc[_h][_i];
            const char* b2 = last ? nB : cB + (size_t)(t + 2) * kstep; const char* b3 = b2 + kstep;
            PG8_LDB(B0, 0, 0); PG8_LDB(B1, 0, 1); PG8_SCHED; PG8_LDA(At, 0, 0); PG8_STAGE_A(PG8_SA(1, 1), aoc, 1, k1);
            PG8_WAIT_V(8); PG8_WAIT_L(0); PG8_BAR; PG8_MMA(0, 0, At, B0); PG8_MMA(0, 1, At, B1); PG8_BAR; PG8_SCHED;
            PG8_LDA(At, 0, 1); PG8_STAGE(PG8_SB(0, 0), b2, voffB); PG8_STAGE(PG8_SB(0, 1), b2 + hstep, voffB); PG8_STAGE_A(PG8_SA(0, 0), a2o, 0, k2);
            PG8_WAIT_V(8); PG8_WAIT_L(0); PG8_BAR; PG8_MMA(1, 0, At, B0); PG8_MMA(1, 1, At, B1); PG8_BAR; PG8_SCHED;
            PG8_LDB(B0, 1, 0); PG8_LDB(B1, 1, 1); PG8_SCHED; PG8_LDA(At, 1, 0); PG8_STAGE_A(PG8_SA(0, 1), a2o, 1, k2);
            PG8_WAIT_V(8); PG8_WAIT_L(0); PG8_BAR; PG8_MMA(0, 0, At, B0); PG8_MMA(0, 1, At, B1); PG8_BAR; PG8_SCHED;
            PG8_LDA(At, 1, 1); PG8_STAGE(PG8_SB(1, 0), b3, voffB); PG8_STAGE(PG8_SB(1, 1), b3 + hstep, voffB); PG8_STAGE_A(PG8_SA(1, 0), a2o, 0, k3);
            PG8_WAIT_V(8); PG8_WAIT_L(0); PG8_BAR; PG8_MMA(1, 0, At, B0); PG8_MMA(1, 1, At, B1); PG8_BAR; PG8_SCHED;
        }
        if constexpr (ALIGN_EPI) { if (wr == 0) PG8_BAR; }
        E(acc, cur, wr, wc, fr, fq);
        if (!has_next) break;
#pragma unroll
        for (int a = 0; a < 2; ++a)
#pragma unroll
            for (int b = 0; b < 2; ++b)
#pragma unroll
                for (int m = 0; m < 4; ++m)
#pragma unroll
                    for (int n = 0; n < 2; ++n) acc[a][b][m][n] = (f32x4){0.f, 0.f, 0.f, 0.f};
        cur = nxt; cB = nB; ++ui;
#pragma unroll
        for (int _h = 0; _h < 2; ++_h)
#pragma unroll
            for (int _i = 0; _i < 2; ++_i) aoc[_h][_i] = aon[_h][_i];
        if constexpr (ALIGN_EPI) { if (wr == 1) PG8_BAR; }
    }
    PG8_WAIT_V(0);
    if constexpr (!ALIGN_EPI) { if (wr == 0) PG8_BAR; }
    PG8_BAR;
#undef PG8_SA
#undef PG8_SB
#undef PG8_STAGE
#undef PG8_STAGE_A
#undef PG8_LDA
#undef PG8_LDB
#undef PG8_MMA
#undef PG8_WAIT_V
#undef PG8_WAIT_L
#undef PG8_BAR
#undef PG8_SCHED
#undef PG8_AOFFS
}
}
struct SchedPlain : pg8::StaticOrder {
    unsigned rowbytes;
    DEV unsigned row_off(const pg8::Unit& u, int r) const { return (unsigned)(u.pm * 256 + r) * rowbytes; }
};
struct SchedMoe1 : pg8::StaticOrder {
    const int* idx;
    DEV bool next(int i, pg8::Unit& u) const { if (!pg8::StaticOrder::next(i, u)) return false; u.pn += (u.pm >> 4) * 16; return true; }
    DEV unsigned row_off(const pg8::Unit& u, int r) const { const int g = u.pm * 256 + r; const int tok = ((g >> 9) & 7) * S + idx[g]; return (unsigned)tok * (unsigned)(D * 2); }
};
struct SchedMoe2 : pg8::StaticOrder {
    DEV bool next(int i, pg8::Unit& u) const { if (!pg8::StaticOrder::next(i, u)) return false; u.pn += (u.pm >> 4) * 4; return true; }
    DEV unsigned row_off(const pg8::Unit& u, int r) const { return (unsigned)(u.pm * 256 + r) * (unsigned)(DFF * 2); }
};
typedef pg8::f32x4 f32x4; typedef pg8::u32x4 u32x4;
struct EpiInProj {
    static constexpr bool PERM = true;
    unsigned char* ws; const float* ropeT;
    DEV void operator()(const f32x4 (&acc)[2][2][4][2], const pg8::Unit& u, int wr, int wc, int fr, int fq) const {
        const int grp = u.pn >> 1;
        bf16_t* gbase = (bf16_t*)(ws + WS_RQ + (size_t)grp * 32 * MiB);
        const float sc = (grp == 1) ? 0.125f : (grp == 4 ? 0.125f * LOG2E : 1.f);
#pragma unroll
        for (int ai = 0; ai < 2; ++ai)
#pragma unroll
            for (int m = 0; m < 4; ++m) {
                const int row = u.pm * 256 + ai * 128 + wr * 64 + m * 16 + fr, b = row >> 12, s = row & 4095;
#pragma unroll
                for (int bj = 0; bj < 2; ++bj) {
                    const int hd = 4 * (u.pn & 1) + 2 * bj + (wc >> 1), j0 = 32 * (wc & 1) + 8 * fq;
                    f32x4 lo = acc[ai][bj][m][0], hi = acc[ai][bj][m][1];
                    if (grp < 2) {
                        const f32x4 c = *(const f32x4*)(ropeT + s * 32 + (j0 >> 1)), sn = *(const f32x4*)(ropeT + S * 32 + s * 32 + (j0 >> 1));
                        const f32x4 l2 = lo * c - hi * sn, h2 = hi * c + lo * sn; lo = l2; hi = h2;
                    }
                    lo = lo * sc; hi = hi * sc;
                    u32x4 w; w.x = pg8::cvt_pk_bf16(lo[0], lo[1]); w.y = pg8::cvt_pk_bf16(lo[2], lo[3]); w.z = pg8::cvt_pk_bf16(hi[0], hi[1]); w.w = pg8::cvt_pk_bf16(hi[2], hi[3]);
                    *(u32x4*)(gbase + ((size_t)(b * NH + hd) * S + s) * HD + j0) = w;
                }
            }
    }
};
struct EpiOutProj {
    static constexpr bool PERM = true;
    const float* x; float* x1;
    DEV void operator()(const f32x4 (&acc)[2][2][4][2], const pg8::Unit& u, int wr, int wc, int fr, int fq) const {
#pragma unroll
        for (int ai = 0; ai < 2; ++ai)
#pragma unroll
            for (int m = 0; m < 4; ++m) {
                const int row = u.pm * 256 + ai * 128 + wr * 64 + m * 16 + fr;
#pragma unroll
                for (int bj = 0; bj < 2; ++bj) { const size_t off = (size_t)row * D + u.pn * 256 + bj * 128 + wc * 32 + 8 * fq;
                    const f32x4 a = *(const f32x4*)(x + off), b = *(const f32x4*)(x + off + 4);
                    *(f32x4*)(x1 + off) = a + acc[ai][bj][m][0]; *(f32x4*)(x1 + off + 4) = b + acc[ai][bj][m][1]; }
            }
    }
};
struct EpiSwiGLU {
    static constexpr bool PERM = true;
    bf16_t* hid;
    DEV void operator()(const f32x4 (&acc)[2][2][4][2], const pg8::Unit& u, int wr, int wc, int fr, int fq) const {
        const int pnl = u.pn & 15;
#pragma unroll
        for (int ai = 0; ai < 2; ++ai)
#pragma unroll
            for (int m = 0; m < 4; ++m) {
                const int row = u.pm * 256 + ai * 128 + wr * 64 + m * 16 + fr;
                float o[8];
#pragma unroll
                for (int n = 0; n < 2; ++n)
#pragma unroll
                    for (int i = 0; i < 4; ++i) { const float gt = acc[ai][0][m][n][i], up = acc[ai][1][m][n][i];
                        o[4 * n + i] = gt * __builtin_amdgcn_rcpf(1.f + __builtin_amdgcn_exp2f(-gt * LOG2E)) * up; }
                u32x4 w; w.x = pg8::cvt_pk_bf16(o[0], o[1]); w.y = pg8::cvt_pk_bf16(o[2], o[3]); w.z = pg8::cvt_pk_bf16(o[4], o[5]); w.w = pg8::cvt_pk_bf16(o[6], o[7]);
                *(u32x4*)(hid + (size_t)row * DFF + pnl * 128 + wc * 32 + 8 * fq) = w;
            }
    }
};
struct EpiDown {
    static constexpr bool PERM = true;
    bf16_t* y;
    DEV void operator()(const f32x4 (&acc)[2][2][4][2], const pg8::Unit& u, int wr, int wc, int fr, int fq) const {
        const int pnl = u.pn & 3;
#pragma unroll
        for (int ai = 0; ai < 2; ++ai)
#pragma unroll
            for (int m = 0; m < 4; ++m) {
                const int row = u.pm * 256 + ai * 128 + wr * 64 + m * 16 + fr;
#pragma unroll
                for (int bj = 0; bj < 2; ++bj) { const f32x4 lo = acc[ai][bj][m][0], hi = acc[ai][bj][m][1];
                    u32x4 w; w.x = pg8::cvt_pk_bf16(lo[0], lo[1]); w.y = pg8::cvt_pk_bf16(lo[2], lo[3]); w.z = pg8::cvt_pk_bf16(hi[0], hi[1]); w.w = pg8::cvt_pk_bf16(hi[2], hi[3]);
                    *(u32x4*)(y + (size_t)row * D + pnl * 256 + bj * 128 + wc * 32 + 8 * fq) = w; }
            }
    }
};
struct Args { const float* in[13]; float* out; unsigned char* ws; int ph_lo, ph_hi; };
enum { IN_X = 0, IN_G1, IN_WIN, IN_DECAY, IN_GN, IN_RELB, IN_WOUT, IN_G2, IN_WR, IN_WG, IN_WU, IN_WDN, IN_FG };

struct TrItem { const float* src; bf16_t* dst; int K, N, k0, n0, mode; };
DEV void tr_load(const TrItem& t, f32x4 (&v)[16], int lane) {
#pragma unroll
    for (int i = 0; i < 16; ++i) { const int kk = (lane >> 4) + 4 * i, c = (lane & 15) * 4; v[i] = *(const f32x4*)(t.src + (size_t)(t.k0 + kk) * t.N + t.n0 + c); }
}
DEV int rowmap_rt(int mode, int n) {
    if (mode == 0) return n;
    if (mode == 1) { if (n >= 1024) return n; const int base = n & ~63, d = n & 63, nn = d >> 5, dd = d & 31; return base + 8 * (dd >> 2) + 4 * nn + (dd & 3); }
    return (n >> 7) * 256 + (mode == 3 ? 128 : 0) + (n & 127);
}
DEV void tr_finish(const TrItem& t, const f32x4 (&v)[16], LAS float* scr, int lane) {
#pragma unroll
    for (int i = 0; i < 16; ++i) { const int kk = (lane >> 4) + 4 * i, c = (lane & 15) * 4;
        scr[kk * 65 + c] = v[i][0]; scr[kk * 65 + c + 1] = v[i][1]; scr[kk * 65 + c + 2] = v[i][2]; scr[kk * 65 + c + 3] = v[i][3]; }
    LDS_WAIT();
#pragma unroll
    for (int i = 0; i < 8; ++i) { const int n = (lane >> 3) + 8 * i, c = (lane & 7) * 8; const LAS float* sp = scr + c * 65 + n;
        u32x4 o; o.x = pk2(sp[0], sp[65]); o.y = pk2(sp[2 * 65], sp[3 * 65]); o.z = pk2(sp[4 * 65], sp[5 * 65]); o.w = pk2(sp[6 * 65], sp[7 * 65]);
        *(u32x4*)(t.dst + (size_t)rowmap_rt(t.mode, t.n0 + n) * t.K + t.k0 + c) = o; }
    LDS_WAIT();
}
template <class Dec> DEV void tr_run(const Dec& dec, int nitems, int gw, int NGW, LAS float* scr, int lane) {
    int it = gw; if (it >= nitems) return;
    TrItem cur, nxt; f32x4 va[16], vb[16];
    dec(it, cur); tr_load(cur, va, lane);
    for (;;) {
        const int n1 = it + NGW; const bool h1 = n1 < nitems;
        if (h1) { dec(n1, nxt); tr_load(nxt, vb, lane); }
        tr_finish(cur, va, scr, lane);
        if (!h1) break;
        const int n2 = n1 + NGW; const bool h2 = n2 < nitems;
        if (h2) { dec(n2, cur); tr_load(cur, va, lane); }
        tr_finish(nxt, vb, scr, lane);
        if (!h2) break;
        it = n2;
    }
}
DEV void rms_row_to_bf16(const float* xrow, const float* g, bf16_t* orow, int lane) {
    const float4* xr = (const float4*)xrow + lane;
    float4 v[4]; float s = 0.f;
#pragma unroll
    for (int j = 0; j < 4; ++j) { v[j] = xr[64 * j]; s += v[j].x * v[j].x + v[j].y * v[j].y + v[j].z * v[j].z + v[j].w * v[j].w; }
    const float rs = rsqrtf(wave_sum(s) * (1.f / D) + EPS);
    uint2* o = (uint2*)orow + lane;
#pragma unroll
    for (int j = 0; j < 4; ++j) { const float4 gg = ((const float4*)g)[lane + 64 * j];
        o[64 * j] = make_uint2(pk2(v[j].x * rs * gg.x, v[j].y * rs * gg.y), pk2(v[j].z * rs * gg.z, v[j].w * rs * gg.w)); }
}
DEV void phase_prep(const Args& a, unsigned char* lds, int gw, int NGW, int lane, int wave) {
    unsigned char* ws = a.ws;
    float* ropeT = (float*)(ws + WS_ROPE); float* biasT = (float*)(ws + WS_BIAS);
    for (int t = gw * 64 + lane; t < S * 32; t += NGW * 64) {
        const int pos = t >> 5, i = t & 31; const double inv = pow(10000.0, -(double)i / 32.0), ang = (double)pos * inv;
        ropeT[t] = (float)cos(ang); ropeT[S * 32 + t] = (float)sin(ang);
        if (t < 3 * NH * 129) { const int p = t / (NH * 129), h = (t / 129) % NH, o = t % 129 - 64, dil = p == 0 ? 1 : (p == 1 ? 4 : 16), rel = o * dil, n = rel < 0 ? -rel : rel;
            int bucket = rel > 0 ? 16 : 0;
            if (n < 8) bucket += n; else { int large = 8 + (int)(log((double)n / 8.0) / log(128.0) * 8.0); if (large > 15) large = 15; bucket += large; }
            biasT[t] = a.in[IN_RELB][bucket * NH + h] * LOG2E; }
    }
    LAS float* scr = (LAS float*)((LAS unsigned char*)lds + wave * 16640);
    constexpr int I_IN = (D / 64) * (PC / 64), I_OUT = (D / 64) * (D / 64);
    { const float* w_in = a.in[IN_WIN]; const float* w_out = a.in[IN_WOUT]; bf16_t* Win = (bf16_t*)(ws + WS_WIN); bf16_t* Wout = (bf16_t*)(ws + WS_WOUT);
      auto dec = [=](int it, TrItem& t) { if (it < I_IN) { t.src = w_in; t.dst = Win; t.K = D; t.N = PC; t.k0 = (it / (PC / 64)) * 64; t.n0 = (it % (PC / 64)) * 64; t.mode = 1; }
          else { const int r = it - I_IN; t.src = w_out; t.dst = Wout; t.K = D; t.N = D; t.k0 = (r / (D / 64)) * 64; t.n0 = (r % (D / 64)) * 64; t.mode = 0; } };
      tr_run(dec, I_IN + I_OUT, gw, NGW, scr, lane); }
    for (int m = gw; m < M; m += NGW) rms_row_to_bf16(a.in[IN_X] + (size_t)m * D, a.in[IN_G1], (bf16_t*)(ws + WS_XN) + (size_t)m * D, lane);
}
DEV void phase_latew(const Args& a, unsigned char* lds, int gw, int NGW, int lane, int wave) {
    unsigned char* ws = a.ws; LAS float* scr = (LAS float*)((LAS unsigned char*)lds + wave * 16640);
    constexpr int I_G = (D / 64) * (DFF / 64);
    const float* wg_ = a.in[IN_WG]; const float* wu_ = a.in[IN_WU]; const float* wd_ = a.in[IN_WDN]; bf16_t* Wgu = (bf16_t*)(ws + WS_WGU); bf16_t* Wd = (bf16_t*)(ws + WS_WD);
    auto dec = [=](int it, TrItem& t) { const int which = it / (NE * I_G), r = it % (NE * I_G), e = r / I_G, q = r % I_G;
        if (which < 2) { t.src = (which == 0 ? wg_ : wu_) + (size_t)e * D * DFF; t.dst = Wgu + (size_t)e * 4096 * D; t.K = D; t.N = DFF; t.k0 = (q / (DFF / 64)) * 64; t.n0 = (q % (DFF / 64)) * 64; t.mode = 2 + which; }
        else { t.src = wd_ + (size_t)e * DFF * D; t.dst = Wd + (size_t)e * D * DFF; t.K = DFF; t.N = D; t.k0 = (q / (D / 64)) * 64; t.n0 = (q % (D / 64)) * 64; t.mode = 0; } };
    tr_run(dec, 3 * NE * I_G, gw, NGW, scr, lane);
}
DEV void phase_router(const Args& a, unsigned char* lds, int gw, int NGW, int lane, int tid) {
    unsigned char* ws = a.ws; const float* x1 = a.out; const float* g2 = a.in[IN_G2]; const float* wr = a.in[IN_WR];
    bf16_t* H2b = (bf16_t*)(ws + WS_XN); float* aff = (float*)(ws + WS_AFF); float* affT = (float*)(ws + WS_AFFT); int* inv = (int*)(ws + WS_INV);
    LAS f32x4* wl = (LAS f32x4*)(LAS unsigned char*)lds;
    for (int i = tid; i < D * 4; i += NTHR) { const int k = i >> 2, c = i & 3, slot = (k & 3) * 256 + (k >> 2); wl[slot * 4 + ((c + (slot >> 2)) & 3)] = *(const f32x4*)(wr + (size_t)k * NE + 4 * c); }
    __syncthreads();
    for (int row = gw; row < M; row += NGW) {
        const float4* xr = (const float4*)(x1 + (size_t)row * D) + lane;
        float4 v[4]; float s = 0.f;
#pragma unroll
        for (int j = 0; j < 4; ++j) { v[j] = xr[64 * j]; s += v[j].x * v[j].x + v[j].y * v[j].y + v[j].z * v[j].z + v[j].w * v[j].w; }
        const float rs = rsqrtf(wave_sum(s) * (1.f / D) + EPS);
        f32x4 lg[4];
#pragma unroll
        for (int c = 0; c < 4; ++c) lg[c] = (f32x4){0.f, 0.f, 0.f, 0.f};
        uint2* o = (uint2*)(H2b + (size_t)row * D) + lane;
#pragma unroll
        for (int j = 0; j < 4; ++j) { const float4 gg = ((const float4*)g2)[lane + 64 * j];
            const float hv[4] = {v[j].x * rs * gg.x, v[j].y * rs * gg.y, v[j].z * rs * gg.z, v[j].w * rs * gg.w};
            o[64 * j] = make_uint2(pk2(hv[0], hv[1]), pk2(hv[2], hv[3]));
#pragma unroll
            for (int t = 0; t < 4; ++t) { const int slot = t * 256 + lane + 64 * j, rot = (lane >> 2) & 3;
#pragma unroll
                for (int c = 0; c < 4; ++c) lg[c] += hv[t] * wl[slot * 4 + ((c + rot) & 3)];
                __builtin_amdgcn_sched_barrier(0); } }
        float l16[16]; float mx = -1e30f;
#pragma unroll
        for (int e = 0; e < 16; ++e) { l16[e] = wave_sum(lg[e >> 2][e & 3]); mx = fmaxf(mx, l16[e]); }
        float sum = 0.f;
#pragma unroll
        for (int e = 0; e < 16; ++e) { l16[e] = __expf(l16[e] - mx); sum += l16[e]; }
        const float is = 1.f / sum;
        if (lane < 16) { float av = 0.f;
#pragma unroll
            for (int e = 0; e < 16; ++e) av = lane == e ? l16[e] * is : av;
            aff[(size_t)row * NE + lane] = av; inv[(size_t)row * NE + lane] = -1; affT[((size_t)(row >> 12) * NE + lane) * S + (row & 4095)] = av; }
    }
    __syncthreads();
}
DEV void phase_topk(const Args& a, unsigned char* lds, int wg, int G, int tid, int lane, int wave) {
    unsigned char* ws = a.ws; const float* affT = (const float*)(ws + WS_AFFT); int* idx = (int*)(ws + WS_IDX); int* inv = (int*)(ws + WS_INV);
    LAS unsigned* hist = (LAS unsigned*)(LAS unsigned char*)lds; LAS unsigned* wsum = hist + 256; LAS unsigned* bc = hist + 272;
    for (int it = wg; it < NE * NB; it += G) {
        const int e = it & 15, b = it >> 4;
        unsigned u[8];
        { const uint4* src = (const uint4*)(affT + ((size_t)b * NE + e) * S + 8 * tid); const uint4 p = src[0], q = src[1]; u[0] = p.x; u[1] = p.y; u[2] = p.z; u[3] = p.w; u[4] = q.x; u[5] = q.y; u[6] = q.z; u[7] = q.w; }
        unsigned prefix = 0u, kk = CAP;
#pragma unroll
        for (int pass = 0; pass < 4; ++pass) {
            const int shift = 24 - 8 * pass;
            __syncthreads();
            if (tid < 256) hist[tid] = 0u;
            __syncthreads();
#pragma unroll
            for (int j = 0; j < 8; ++j) if (pass == 0 || (u[j] >> (shift + 8)) == prefix) atomicAdd((unsigned*)&hist[(u[j] >> shift) & 255u], 1u);
            __syncthreads();
            if (wave == 0) {
                const unsigned c0 = hist[4 * lane], c1 = hist[4 * lane + 1], c2 = hist[4 * lane + 2], c3 = hist[4 * lane + 3], tot = c0 + c1 + c2 + c3;
                unsigned incl = tot;
#pragma unroll
                for (int o = 1; o < 64; o <<= 1) { const unsigned t = __shfl_down(incl, o); if (lane + o < 64) incl += t; }
                const unsigned excl = incl - tot;
                if (excl < kk && kk <= incl) { unsigned acc = excl; int bin;
                    if (acc + c3 >= kk) bin = 3; else { acc += c3; if (acc + c2 >= kk) bin = 2; else { acc += c2; if (acc + c1 >= kk) bin = 1; else { acc += c1; bin = 0; } } }
                    bc[0] = 4 * lane + bin; bc[1] = kk - acc; }
            }
            __syncthreads();
            prefix = (prefix << 8) | bc[0]; kk = bc[1];
        }
        const unsigned T = prefix, need = kk;
        unsigned cg_ = 0u, ce = 0u;
#pragma unroll
        for (int j = 0; j < 8; ++j) { cg_ += u[j] > T; ce += u[j] == T; }
        unsigned pk = cg_ | (ce << 16), incl = pk;
#pragma unroll
        for (int o = 1; o < 64; o <<= 1) { const unsigned t = __shfl_up(incl, o); if (lane >= o) incl += t; }
        if (lane == 63) wsum[wave] = incl;
        __syncthreads();
        unsigned base = 0u;
#pragma unroll
        for (int w = 0; w < NWAVES; ++w) base += w < wave ? wsum[w] : 0u;
        const unsigned ex = base + incl - pk; unsigned gtb = ex & 0xffffu, eqb = ex >> 16;
#pragma unroll
        for (int j = 0; j < 8; ++j) { const bool g = u[j] > T, q = u[j] == T; const unsigned slot = gtb + (eqb < need ? eqb : need);
            if (g || (q && eqb < need)) { const int s = 8 * tid + j; idx[(e * NB + b) * CAP + slot] = s; inv[((size_t)b * S + s) * NE + e] = (int)slot; }
            gtb += g; eqb += q; }
    }
}
DEV void phase_final(const Args& a, int gw, int NGW, int lane) {
    unsigned char* ws = a.ws; float* xo = a.out; const float* aff = (const float*)(ws + WS_AFF); const int* inv = (const int*)(ws + WS_INV); const bf16_t* y = (const bf16_t*)(ws + WS_Y); const float* fg = a.in[IN_FG];
    for (int row = gw; row < M; row += NGW) {
        const int b = row >> 12;
        float4* xr = (float4*)(xo + (size_t)row * D) + lane;
        float4 v[4];
#pragma unroll
        for (int j = 0; j < 4; ++j) v[j] = xr[64 * j];
        for (int e = 0; e < NE; ++e) { const int sl = inv[(size_t)row * NE + e]; if (sl < 0) continue;
            const float g = aff[(size_t)row * NE + e]; const uint2* yr = (const uint2*)(y + ((size_t)e * 4096 + b * CAP + sl) * D) + lane;
#pragma unroll
            for (int j = 0; j < 4; ++j) { const uint2 w = yr[64 * j]; v[j].x += g * bf2f(w.x & 0xffffu); v[j].y += g * bf2f(w.x >> 16); v[j].z += g * bf2f(w.y & 0xffffu); v[j].w += g * bf2f(w.y >> 16); } }
        float s = 0.f;
#pragma unroll
        for (int j = 0; j < 4; ++j) s += v[j].x * v[j].x + v[j].y * v[j].y + v[j].z * v[j].z + v[j].w * v[j].w;
        const float rs = rsqrtf(wave_sum(s) * (1.f / D) + EPS);
#pragma unroll
        for (int j = 0; j < 4; ++j) { const float4 gg = ((const float4*)fg)[lane + 64 * j]; xr[64 * j] = make_float4(v[j].x * rs * gg.x, v[j].y * rs * gg.y, v[j].z * rs * gg.z, v[j].w * rs * gg.w); }
    }
}
typedef short bf16x8 __attribute__((ext_vector_type(8)));
typedef float f32x16 __attribute__((ext_vector_type(16)));
typedef short s16x4 __attribute__((ext_vector_type(4)));
typedef LAS const char* lds_cptr;
constexpr int VROW = 192;
constexpr int VSLOT = 32 * VROW;
constexpr int MIX_WAVE_LDS = 2 * VSLOT;
constexpr int MIX_BIAS_OFF = NWAVES * MIX_WAVE_LDS;
DEV int crow(int r, int hi) { return (r & 3) + 8 * (r >> 2) + 4 * hi; }
DEV s16x4 vtr(lds_cptr p) { return __builtin_bit_cast(s16x4, __builtin_amdgcn_ds_read_tr16_b64_v4i16((LAS s16x4*)p)); }
DEV bf16x8 tr_frag(lds_cptr slot, int s, int blk, int lane) {
    const int h = lane >> 5; lds_cptr p = slot + (16 * s + 4 * h + ((lane & 15) >> 2)) * VROW + (32 * blk + 16 * ((lane >> 4) & 1) + 4 * (lane & 3)) * 2;
    const s16x4 lo = vtr(p), hi = vtr(p + 8 * VROW);
    return (bf16x8){lo[0], lo[1], lo[2], lo[3], hi[0], hi[1], hi[2], hi[3]};
}
DEV void load_frags(bf16x8 (&f)[4], const bf16_t* rowp, int lane) {
    const int h = lane >> 5;
#pragma unroll
    for (int st = 0; st < 4; ++st) f[st] = *(const bf16x8*)(rowp + 16 * st + 8 * h);
}
DEV bf16x8 pack_p(const f32x16& p, int s) {
    u32x4 w; w.x = pg8::cvt_pk_bf16(p[8 * s], p[8 * s + 1]); w.y = pg8::cvt_pk_bf16(p[8 * s + 2], p[8 * s + 3]); w.z = pg8::cvt_pk_bf16(p[8 * s + 4], p[8 * s + 5]); w.w = pg8::cvt_pk_bf16(p[8 * s + 6], p[8 * s + 7]);
    return __builtin_bit_cast(bf16x8, w);
}
#define MFMA32(a, b, c) __builtin_amdgcn_mfma_f32_32x32x16_bf16((a), (b), (c), 0, 0, 0)
DEV float ex2(float x) { return __builtin_amdgcn_exp2f(x); }

DEV void attn_item(const Args& a, unsigned char* lds, int item, int lane, int wave) {
    unsigned char* ws = a.ws;
    const int p = item >> 13, rem = item & 8191, bh = rem >> 7, qblk = rem & 127;
    const int dil = p == 0 ? 1 : (p == 1 ? 4 : 16), L = S / dil, bpr = L >> 5;
    const int r = qblk / bpr, q0 = (qblk % bpr) * 32;
    const bf16_t* Qh = (const bf16_t*)(ws + WS_AQ) + (size_t)bh * S * HD; const bf16_t* Kh = (const bf16_t*)(ws + WS_AK) + (size_t)bh * S * HD; const bf16_t* Vh = (const bf16_t*)(ws + WS_AV) + (size_t)bh * S * HD;
    const LAS float* biasL = (const LAS float*)((LAS unsigned char*)lds + MIX_BIAS_OFF) + (p * NH + (bh & 7)) * 129;
    LAS unsigned char* slot = (LAS unsigned char*)lds + wave * MIX_WAVE_LDS; lds_cptr slot3 = (lds_cptr)slot;
    const int t = lane & 31, hi = lane >> 5;
    bf16x8 qf[4]; load_frags(qf, Qh + (size_t)((q0 + t) * dil + r) * HD, lane);
    f32x16 o0 = {}, o1 = {}; float m = -1e30f, l = 0.f;
    for (int kk = 0; kk < 5; ++kk) {
        const int kbase = q0 - 64 + 32 * kk;
        if (kbase + 31 < 0 || kbase >= L) continue;
        { const int rr = lane >> 3, ch = lane & 7;
          u32x4 v[4];
#pragma unroll
          for (int i = 0; i < 4; ++i) { int ki = kbase + rr + 8 * i; ki = ki < 0 ? 0 : (ki >= L ? L - 1 : ki); v[i] = *(const u32x4*)(Vh + (size_t)(ki * dil + r) * HD + ch * 8); }
#pragma unroll
          for (int i = 0; i < 4; ++i) *(LAS u32x4*)(slot + (rr + 8 * i) * VROW + ch * 16) = v[i]; }
        bf16x8 kf[4]; { int ki = kbase + t; ki = ki < 0 ? 0 : (ki >= L ? L - 1 : ki); load_frags(kf, Kh + (size_t)(ki * dil + r) * HD, lane); }
        f32x16 sc = {};
#pragma unroll
        for (int st = 0; st < 4; ++st) sc = MFMA32(kf[st], qf[st], sc);
        float mx = -1e30f;
#pragma unroll
        for (int rg = 0; rg < 16; ++rg) { const int key = crow(rg, hi), bi = 32 * kk + key - t, ki = kbase + key;
            const bool ok = bi >= 0 && bi <= 128 && ki >= 0 && ki < L;
            const float bv = biasL[bi < 0 ? 0 : (bi > 128 ? 128 : bi)];
            sc[rg] = ok ? sc[rg] + bv : -1e30f; mx = fmaxf(mx, sc[rg]); }
        mx = fmaxf(mx, __shfl_xor(mx, 32));
        const float mn = fmaxf(m, mx), f = ex2(m - mn); m = mn;
        float ps = 0.f;
#pragma unroll
        for (int rg = 0; rg < 16; ++rg) { sc[rg] = ex2(sc[rg] - mn); ps += sc[rg]; }
        l = l * f + ps;
#pragma unroll
        for (int rg = 0; rg < 16; ++rg) { o0[rg] *= f; o1[rg] *= f; }
        const bf16x8 p0 = pack_p(sc, 0), p1 = pack_p(sc, 1);
        LDS_WAIT();
        o0 = MFMA32(tr_frag(slot3, 0, 0, lane), p0, o0); o0 = MFMA32(tr_frag(slot3, 1, 0, lane), p1, o0);
        o1 = MFMA32(tr_frag(slot3, 0, 1, lane), p0, o1); o1 = MFMA32(tr_frag(slot3, 1, 1, lane), p1, o1);
        LDS_WAIT();
    }
    l += __shfl_xor(l, 32);
    const float il = 1.f / l;
    const size_t orow = ((size_t)p * NB * NH + bh) * S + (size_t)((q0 + t) * dil + r);
    bf16_t* op = (bf16_t*)(ws + WS_ATTO) + orow * HD;
#pragma unroll
    for (int g4 = 0; g4 < 4; ++g4) {
        *(uint2*)(op + 8 * g4 + 4 * hi) = make_uint2(pg8::cvt_pk_bf16(o0[4 * g4] * il, o0[4 * g4 + 1] * il), pg8::cvt_pk_bf16(o0[4 * g4 + 2] * il, o0[4 * g4 + 3] * il));
        *(uint2*)(op + 32 + 8 * g4 + 4 * hi) = make_uint2(pg8::cvt_pk_bf16(o1[4 * g4] * il, o1[4 * g4 + 1] * il), pg8::cvt_pk_bf16(o1[4 * g4 + 2] * il, o1[4 * g4 + 3] * il));
    }
    if (hi == 0) ((float*)(ws + WS_ATTL))[orow] = m + __log2f(l);
}
DEV void retstate_item(const Args& a, unsigned char* lds, int item, int lane, int wave) {
    unsigned char* ws = a.ws;
    const int dir = item & 1, n = (item >> 1) & 31, bh = item >> 6, h = bh & 7;
    const bf16_t* Kc = (const bf16_t*)(ws + WS_RK) + ((size_t)bh * S + n * 128) * HD; const bf16_t* Vc = (const bf16_t*)(ws + WS_RV) + ((size_t)bh * S + n * 128) * HD;
    const float lg = a.in[IN_DECAY][dir * NH + h] * LOG2E;
    LAS unsigned char* vs = (LAS unsigned char*)lds + wave * MIX_WAVE_LDS; LAS unsigned char* ks = vs + VSLOT; lds_cptr vs3 = (lds_cptr)vs, ks3 = (lds_cptr)ks;
    f32x16 acc[2][2] = {};
    for (int blk = 0; blk < 4; ++blk) {
        { const int rr = lane >> 3, ch = lane & 7;
          u32x4 v[4], k[4];
#pragma unroll
          for (int i = 0; i < 4; ++i) { const int mrow = 32 * blk + rr + 8 * i; v[i] = *(const u32x4*)(Vc + (size_t)mrow * HD + ch * 8); k[i] = *(const u32x4*)(Kc + (size_t)mrow * HD + ch * 8); }
#pragma unroll
          for (int i = 0; i < 4; ++i) { const int mrow = 32 * blk + rr + 8 * i; const float z = ex2(lg * (float)(dir == 0 ? 127 - mrow : mrow));
              const unsigned kw[4] = {k[i].x, k[i].y, k[i].z, k[i].w}; u32x4 o;
              o.x = pg8::cvt_pk_bf16(bf2f(kw[0] & 0xffffu) * z, bf2f(kw[0] >> 16) * z); o.y = pg8::cvt_pk_bf16(bf2f(kw[1] & 0xffffu) * z, bf2f(kw[1] >> 16) * z);
              o.z = pg8::cvt_pk_bf16(bf2f(kw[2] & 0xffffu) * z, bf2f(kw[2] >> 16) * z); o.w = pg8::cvt_pk_bf16(bf2f(kw[3] & 0xffffu) * z, bf2f(kw[3] >> 16) * z);
              *(LAS u32x4*)(vs + (rr + 8 * i) * VROW + ch * 16) = v[i]; *(LAS u32x4*)(ks + (rr + 8 * i) * VROW + ch * 16) = o; } }
        LDS_WAIT();
#pragma unroll
        for (int s = 0; s < 2; ++s) {
            const bf16x8 v0 = tr_frag(vs3, s, 0, lane), v1 = tr_frag(vs3, s, 1, lane), k0 = tr_frag(ks3, s, 0, lane), k1 = tr_frag(ks3, s, 1, lane);
            acc[0][0] = MFMA32(v0, k0, acc[0][0]); acc[0][1] = MFMA32(v0, k1, acc[0][1]); acc[1][0] = MFMA32(v1, k0, acc[1][0]); acc[1][1] = MFMA32(v1, k1, acc[1][1]);
        }
        LDS_WAIT();
    }
    float* KT = (float*)(ws + WS_KF) + (((size_t)dir * NB * NH + bh) * 32 + n) * 4096;
    const int c = lane & 31, hi = lane >> 5;
#pragma unroll
    for (int eb = 0; eb < 2; ++eb)
#pragma unroll
        for (int db = 0; db < 2; ++db)
#pragma unroll
            for (int rg = 0; rg < 16; ++rg) KT[(32 * eb + crow(rg, hi)) * 64 + 32 * db + c] = acc[eb][db][rg];
}
DEV void phase_scan(const Args& a, int gtid, int NT) {
    unsigned char* ws = a.ws;
    for (int sl = gtid; sl < 2 * NB * NH * 1024; sl += NT) {
        const int dir = sl >> 16, bh = (sl >> 10) & 63, q = sl & 1023, h = bh & 7;
        const float gC = ex2(a.in[IN_DECAY][dir * NH + h] * LOG2E * 128.f);
        const float4* kt = (const float4*)(ws + WS_KF) + ((size_t)dir * NB * NH + bh) * 32 * 1024 + q;
        uint2* st = (uint2*)(ws + WS_ST) + ((size_t)dir * NB * NH + bh) * 32 * 1024 + q;
        float4 s = make_float4(0.f, 0.f, 0.f, 0.f);
        for (int i = 0; i < 32; ++i) { const int n = dir == 0 ? i : 31 - i;
            st[(size_t)n * 1024] = make_uint2(pg8::cvt_pk_bf16(s.x, s.y), pg8::cvt_pk_bf16(s.z, s.w));
            const float4 kv = kt[(size_t)n * 1024];
            s.x = gC * s.x + kv.x; s.y = gC * s.y + kv.y; s.z = gC * s.z + kv.z; s.w = gC * s.w + kv.w; }
    }
}
DEV void retout_item(const Args& a, unsigned char* lds, int item, int lane, int wave) {
    unsigned char* ws = a.ws;
    const int qb = item & 3, n = (item >> 2) & 31, bh = item >> 7, h = bh & 7, b = bh >> 3;
    const bf16_t* Qc = (const bf16_t*)(ws + WS_RQ) + ((size_t)bh * S + n * 128) * HD; const bf16_t* Kc = (const bf16_t*)(ws + WS_RK) + ((size_t)bh * S + n * 128) * HD;
    const bf16_t* Vc = (const bf16_t*)(ws + WS_RV) + ((size_t)bh * S + n * 128) * HD;
    const bf16_t* SF = (const bf16_t*)(ws + WS_ST) + (((size_t)0 * NB * NH + bh) * 32 + n) * 4096; const bf16_t* SB = (const bf16_t*)(ws + WS_ST) + (((size_t)1 * NB * NH + bh) * 32 + n) * 4096;
    const float lg0 = a.in[IN_DECAY][h] * LOG2E, lg1 = a.in[IN_DECAY][NH + h] * LOG2E;
    LAS unsigned char* slot = (LAS unsigned char*)lds + wave * MIX_WAVE_LDS; lds_cptr slot3 = (lds_cptr)slot;
    const int t = lane & 31, hi = lane >> 5, c = 32 * qb + t;
    bf16x8 qf[4]; load_frags(qf, Qc + (size_t)c * HD, lane);
    f32x16 o0 = {}, o1 = {};
    { bf16x8 s0[4], s1[4]; load_frags(s0, SF + (size_t)t * 64, lane); load_frags(s1, SF + (size_t)(32 + t) * 64, lane);
#pragma unroll
      for (int st = 0; st < 4; ++st) { o0 = MFMA32(s0[st], qf[st], o0); o1 = MFMA32(s1[st], qf[st], o1); }
      const float fa = ex2(lg0 * (float)(c + 1) - lg1 * (float)(128 - c));
#pragma unroll
      for (int rg = 0; rg < 16; ++rg) { o0[rg] *= fa; o1[rg] *= fa; }
      load_frags(s0, SB + (size_t)t * 64, lane); load_frags(s1, SB + (size_t)(32 + t) * 64, lane);
#pragma unroll
      for (int st = 0; st < 4; ++st) { o0 = MFMA32(s0[st], qf[st], o0); o1 = MFMA32(s1[st], qf[st], o1); }
      const float fb = ex2(lg1 * (float)(128 - c));
#pragma unroll
      for (int rg = 0; rg < 16; ++rg) { o0[rg] *= fb; o1[rg] *= fb; } }
    for (int kb = 0; kb < 4; ++kb) {
        { const int rr = lane >> 3, ch = lane & 7;
          u32x4 v[4];
#pragma unroll
          for (int i = 0; i < 4; ++i) v[i] = *(const u32x4*)(Vc + (size_t)(32 * kb + rr + 8 * i) * HD + ch * 8);
#pragma unroll
          for (int i = 0; i < 4; ++i) *(LAS u32x4*)(slot + (rr + 8 * i) * VROW + ch * 16) = v[i]; }
        bf16x8 kf[4]; load_frags(kf, Kc + (size_t)(32 * kb + t) * HD, lane);
        f32x16 sc = {};
#pragma unroll
        for (int st = 0; st < 4; ++st) sc = MFMA32(kf[st], qf[st], sc);
#pragma unroll
        for (int rg = 0; rg < 16; ++rg) { const int mk = 32 * kb + crow(rg, hi), df = c - mk; sc[rg] *= df >= 0 ? ex2(lg0 * (float)df) : ex2(lg1 * (float)(-df)); }
        const bf16x8 p0 = pack_p(sc, 0), p1 = pack_p(sc, 1);
        LDS_WAIT();
        o0 = MFMA32(tr_frag(slot3, 0, 0, lane), p0, o0); o0 = MFMA32(tr_frag(slot3, 1, 0, lane), p1, o0);
        o1 = MFMA32(tr_frag(slot3, 0, 1, lane), p0, o1); o1 = MFMA32(tr_frag(slot3, 1, 1, lane), p1, o1);
        LDS_WAIT();
    }
    float sm = 0.f;
#pragma unroll
    for (int rg = 0; rg < 16; ++rg) sm += o0[rg] + o1[rg];
    sm += __shfl_xor(sm, 32); const float mu = sm * (1.f / 64.f); float vq = 0.f;
#pragma unroll
    for (int rg = 0; rg < 16; ++rg) { const float d0 = o0[rg] - mu, d1 = o1[rg] - mu; vq += d0 * d0 + d1 * d1; }
    vq += __shfl_xor(vq, 32); const float rstd = rsqrtf(vq * (1.f / 64.f) + EPS);
    const size_t pos = (size_t)n * 128 + c;
    const bf16_t* gp = (const bf16_t*)(ws + WS_RG) + ((size_t)bh * S + pos) * HD; bf16_t* op = (bf16_t*)(ws + WS_XN) + ((size_t)b * S + pos) * D + h * HD; const float* gn = a.in[IN_GN] + h * HD;
#pragma unroll
    for (int db = 0; db < 2; ++db)
#pragma unroll
        for (int g4 = 0; g4 < 4; ++g4) { const int e0 = 32 * db + 8 * g4 + 4 * hi; const uint2 gw = *(const uint2*)(gp + e0); const float4 gg = *(const float4*)(gn + e0);
            const float gate[4] = {bf2f(gw.x & 0xffffu), bf2f(gw.x >> 16), bf2f(gw.y & 0xffffu), bf2f(gw.y >> 16)}; const float gv[4] = {gg.x, gg.y, gg.z, gg.w}; float o[4];
#pragma unroll
            for (int i = 0; i < 4; ++i) { const float rv = (db == 0 ? o0[4 * g4 + i] : o1[4 * g4 + i]); o[i] = (rv - mu) * rstd * gv[i] * (gate[i] / (1.f + __expf(-gate[i]))); }
            *(uint2*)(op + e0) = make_uint2(pg8::cvt_pk_bf16(o[0], o[1]), pg8::cvt_pk_bf16(o[2], o[3])); }
}
DEV void phase_attn_merge(const Args& a, int gtid, int NT) {
    unsigned char* ws = a.ws; const float* L = (const float*)(ws + WS_ATTL); const bf16_t* O = (const bf16_t*)(ws + WS_ATTO); bf16_t* mixed = (bf16_t*)(ws + WS_XN);
    for (int it = gtid; it < NB * NH * S * 8; it += NT) {
        const int ch = it & 7, row = it >> 3;
        const int bh = row >> 12, pos = row & 4095, b = bh >> 3, h = bh & 7;
        const float l0 = L[row], l1 = L[(size_t)NB * NH * S + row], l2 = L[(size_t)2 * NB * NH * S + row];
        const float mx = fmaxf(l0, fmaxf(l1, l2)); float w0 = ex2(l0 - mx), w1 = ex2(l1 - mx), w2 = ex2(l2 - mx); const float is = 1.f / (w0 + w1 + w2); w0 *= is; w1 *= is; w2 *= is;
        const uint4 a0 = *(const uint4*)(O + (size_t)row * HD + ch * 8), a1 = *(const uint4*)(O + ((size_t)NB * NH * S + row) * HD + ch * 8), a2 = *(const uint4*)(O + ((size_t)2 * NB * NH * S + row) * HD + ch * 8);
        const unsigned x0[4] = {a0.x, a0.y, a0.z, a0.w}, x1[4] = {a1.x, a1.y, a1.z, a1.w}, x2[4] = {a2.x, a2.y, a2.z, a2.w}; unsigned o[4];
#pragma unroll
        for (int j = 0; j < 4; ++j) o[j] = pg8::cvt_pk_bf16(w0 * bf2f(x0[j] & 0xffffu) + w1 * bf2f(x1[j] & 0xffffu) + w2 * bf2f(x2[j] & 0xffffu), w0 * bf2f(x0[j] >> 16) + w1 * bf2f(x1[j] >> 16) + w2 * bf2f(x2[j] >> 16));
        *(uint4*)(mixed + ((size_t)b * S + pos) * D + 512 + h * HD + ch * 8) = make_uint4(o[0], o[1], o[2], o[3]);
    }
}
DEV void phase_mix_a(const Args& a, unsigned char* lds, int gw, int NGW, int lane, int wave, int tid) {
    { const float* bt = (const float*)(a.ws + WS_BIAS); float* bl = (float*)(lds + MIX_BIAS_OFF); for (int i = tid; i < 3 * NH * 129; i += NTHR) bl[i] = bt[i]; }
    __syncthreads();
    for (int it = gw; it < 2 * 32 * NB * NH; it += NGW) retstate_item(a, lds, it, lane, wave);
    for (int it = gw; it < 3 * 8192; it += NGW) attn_item(a, lds, it, lane, wave);
}
DEV void phase_mix_b(const Args& a, unsigned char* lds, int gw, int NGW, int lane, int wave, int tid, int wg, int G) {
    for (int it = gw; it < NB * NH * 32 * 4; it += NGW) retout_item(a, lds, it, lane, wave);
    phase_attn_merge(a, wg * NTHR + tid, G * NTHR);
}
#ifndef MK_LAUNCHES
#define MK_LAUNCHES 1
#endif
constexpr int NPH = 11;
#ifndef PROBE_REP
#define PROBE_REP 0
#endif
#define REP(k) if (((PROBE_REP) >> (k)) & 1) for (int _r = 0; _r < 2; ++_r, cg::this_grid().sync())
__global__ void __launch_bounds__(NTHR, 2) mega(Args a) {
    extern __shared__ __attribute__((aligned(16))) unsigned char lds[];
    const int tid = threadIdx.x, lane = tid & 63, wave = __builtin_amdgcn_readfirstlane(tid >> 6);
    const int G = gridDim.x, wg = blockIdx.x, gw = wg * NWAVES + wave, NGW = G * NWAVES;
    unsigned char* ws = a.ws;
    const int lo = a.ph_lo, hi = a.ph_hi;
#define IN(k) (lo <= (k) && (k) < hi)
#define SEAM(k) do { if (IN(k) && IN((k) + 1)) { cg::this_grid().sync(); } } while (0)
    if (IN(0)) { REP(0) { phase_prep(a, lds, gw, NGW, lane, wave); } phase_prep(a, lds, gw, NGW, lane, wave); }
    SEAM(0);
    if (IN(1)) { pg8::Gemm g{(const bf16_t*)(ws + WS_XN), (const bf16_t*)(ws + WS_WIN), D}; SchedPlain Sc; Sc.init(M, PC, G, wg); Sc.rowbytes = D * 2;
        EpiInProj E{ws, (const float*)(ws + WS_ROPE)};
        pg8::gemm_phase<EpiInProj, SchedPlain, true>((LAS unsigned char*)lds, g, Sc, E); }
    SEAM(1);
    if (IN(2)) { REP(2) { phase_mix_a(a, lds, gw, NGW, lane, wave, tid); } phase_mix_a(a, lds, gw, NGW, lane, wave, tid); }
    SEAM(2);
    if (IN(3)) { REP(3) { phase_scan(a, wg * NTHR + tid, G * NTHR); } phase_scan(a, wg * NTHR + tid, G * NTHR); }
    SEAM(3);
    if (IN(4)) { REP(4) { phase_mix_b(a, lds, gw, NGW, lane, wave, tid, wg, G); } phase_mix_b(a, lds, gw, NGW, lane, wave, tid, wg, G); }
    SEAM(4);
    if (IN(5)) { pg8::Gemm g{(const bf16_t*)(ws + WS_XN), (const bf16_t*)(ws + WS_WOUT), D}; SchedPlain Sc; Sc.init(M, D, G, wg); Sc.rowbytes = D * 2;
        EpiOutProj E{a.in[IN_X], a.out};
        pg8::gemm_phase<EpiOutProj, SchedPlain, true>((LAS unsigned char*)lds, g, Sc, E); }
    SEAM(5);
    if (IN(6)) { REP(6) { phase_router(a, lds, gw, NGW, lane, tid); phase_latew(a, lds, gw, NGW, lane, wave); } phase_router(a, lds, gw, NGW, lane, tid); phase_latew(a, lds, gw, NGW, lane, wave); }
    SEAM(6);
    if (IN(7)) { REP(7) { phase_topk(a, lds, wg, G, tid, lane, wave); } phase_topk(a, lds, wg, G, tid, lane, wave); }
    SEAM(7);
    if (IN(8)) { pg8::Gemm g{(const bf16_t*)(ws + WS_XN), (const bf16_t*)(ws + WS_WGU), D}; SchedMoe1 Sc; Sc.init(MR, 4096, G, wg); Sc.idx = (const int*)(ws + WS_IDX);
        EpiSwiGLU E{(bf16_t*)(ws + WS_HID)};
        pg8::gemm_phase<EpiSwiGLU, SchedMoe1, true>((LAS unsigned char*)lds, g, Sc, E); }
    SEAM(8);
    if (IN(9)) { pg8::Gemm g{(const bf16_t*)(ws + WS_HID), (const bf16_t*)(ws + WS_WD), DFF}; SchedMoe2 Sc; Sc.init(MR, D, G, wg);
        EpiDown E{(bf16_t*)(ws + WS_Y)};
        pg8::gemm_phase<EpiDown, SchedMoe2, true>((LAS unsigned char*)lds, g, Sc, E); }
    SEAM(9);
    if (IN(10)) { phase_final(a, gw, NGW, lane); }
#undef IN
#undef SEAM
}

extern "C" void kernel_launch(void* const* d_in, const int* in_sizes, int n_in, void* d_out, int out_size, void* d_ws, size_t ws_size, hipStream_t stream) {
    static int grid = 0;
    if (grid == 0) {
        if (n_in != 13 || in_sizes[0] != M * D || out_size != M * D || ws_size < WS_END) { fprintf(stderr, "kernel_launch: unexpected shapes n_in %d in0 %d out %d ws %zu (need %zu)\n", n_in, n_in > 0 ? in_sizes[0] : -1, out_size, ws_size, (size_t)WS_END); grid = -1; return; }
        int dev = 0, cus = 0, per_cu = 0;
        (void)hipGetDevice(&dev); (void)hipDeviceGetAttribute(&cus, hipDeviceAttributeMultiprocessorCount, dev);
        (void)hipFuncSetAttribute((const void*)mega, hipFuncAttributeMaxDynamicSharedMemorySize, LDS_BYTES);
        if (hipOccupancyMaxActiveBlocksPerMultiprocessor(&per_cu, (const void*)mega, NTHR, LDS_BYTES) != hipSuccess || per_cu < 1) { fprintf(stderr, "kernel_launch: occupancy query says %d blocks/CU\n", per_cu); per_cu = 1; }
        (void)hipGetLastError();
        grid = cus * 1;
        if (grid > cus * per_cu) grid = cus * per_cu;
    }
    if (grid < 0) return;
    (void)hipMemsetAsync((char*)d_ws + WS_CTL, 0, 1 * MiB, stream);
    Args a{};
    for (int i = 0; i < 13; ++i) a.in[i] = (const float*)d_in[i];
    a.out = (float*)d_out; a.ws = (unsigned char*)d_ws;
#if MK_LAUNCHES == 1
    a.ph_lo = 0; a.ph_hi = NPH;
    void* args[] = {&a};
    hipError_t e = hipLaunchCooperativeKernel((const void*)mega, dim3(grid), dim3(NTHR), args, LDS_BYTES, stream);
    if (e != hipSuccess) fprintf(stderr, "cooperative launch failed: %s (grid %d)\n", hipGetErrorString(e), grid);
#else
    for (int p = 0; p < NPH; ++p) { a.ph_lo = p; a.ph_hi = p + 1; hipLaunchKernelGGL(mega, dim3(grid), dim3(NTHR), LDS_BYTES, stream, a); }
#endif
}
```

```cpp
#include <hip/hip_runtime.h>
#include <hip/hip_cooperative_groups.h>
#include <cstdint>
#include <cstdio>
namespace cg = cooperative_groups;

typedef unsigned short bf16_t;
#define DEV __device__ __forceinline__
#define LAS __attribute__((address_space(3)))

constexpr int NB = 8, S = 4096, D = 1024, M = NB * S;
constexpr int NH = 8, HD = 64, PC = 3584;
constexpr int NE = 16, CAP = 512, DFF = 2048, MR = NE * NB * CAP;
constexpr float EPS = 1e-6f, LOG2E = 1.4426950408889634f;
constexpr int NWAVES = 8, NTHR = 512;
constexpr int LDS_BYTES = 147456;

constexpr size_t MiB = 1u << 20;
constexpr size_t WS_CTL = 0;
constexpr size_t WS_ROPE = 1 * MiB;
constexpr size_t WS_BIAS = 2 * MiB;
constexpr size_t WS_IDX = 2 * MiB + 512 * 1024;
constexpr size_t WS_AFF = 3 * MiB;
constexpr size_t WS_INV = 5 * MiB;
constexpr size_t WS_AFFT = 9 * MiB;
constexpr size_t WS_WOUT = 7 * MiB;
constexpr size_t WS_WIN = 9 * MiB;
constexpr size_t WS_XN = 16 * MiB;
constexpr size_t WS_RQ = 80 * MiB, WS_RK = 112 * MiB, WS_RV = 144 * MiB, WS_RG = 176 * MiB;
constexpr size_t WS_AQ = 208 * MiB, WS_AK = 240 * MiB, WS_AV = 272 * MiB;
constexpr size_t WS_ATTO = 304 * MiB;
constexpr size_t WS_ATTL = 400 * MiB;
constexpr size_t WS_KF = 403 * MiB;
constexpr size_t WS_ST = 208 * MiB;
constexpr size_t WS_WD = 80 * MiB;
constexpr size_t WS_WGU = 144 * MiB;
constexpr size_t WS_Y = 144 * MiB;
constexpr size_t WS_HID = 272 * MiB;
constexpr size_t WS_END = 528 * MiB;

DEV unsigned f2bf(float f) { unsigned u = __float_as_uint(f); return (u + 0x7fffu + ((u >> 16) & 1u)) >> 16; }
DEV float bf2f(unsigned h) { return __uint_as_float(h << 16); }
DEV unsigned pk2(float lo, float hi) { return f2bf(lo) | (f2bf(hi) << 16); }
DEV float wave_sum(float v) {
#pragma unroll
    for (int o = 1; o < 64; o <<= 1) v += __shfl_xor(v, o);
    return v;
}
#define LDS_WAIT() asm volatile("s_waitcnt lgkmcnt(0)" ::: "memory")
namespace pg8 {
#define PG8_LAS __attribute__((address_space(3)))
typedef short bf16x8 __attribute__((ext_vector_type(8)));
typedef float f32x4 __attribute__((ext_vector_type(4)));
typedef unsigned u32x4 __attribute__((ext_vector_type(4)));
constexpr int BM = 256, BK = 64, HALF = 128, HTB = HALF * BK * 2, STAGE_BYTES = 8 * HTB, NXCD = 8, WGM = 8;
__host__ __device__ __forceinline__ int lds_byte(int r, int c) { const int st = (r >> 4) * 2 + (c >> 5), rr = r & 15, cc = c & 31, ob = rr * 64 + cc * 2; return st * 1024 + (ob ^ (((ob >> 9) & 1) << 5)); }
__host__ __device__ __forceinline__ void stage_rc(int b, int& R, int& C) { const int st = b / 1024, sb = b % 1024, swz = sb ^ (((sb >> 9) & 1) << 5); R = (st >> 1) * 16 + swz / 64; C = (st & 1) * 32 + (swz % 64) / 2; }
__host__ __device__ __forceinline__ int perm32(int rho) { const int n = rho >> 4, i = rho & 15; return 8 * (i >> 2) + 4 * n + (i & 3); }
struct Unit { int pm, pn; };
struct Gemm { const bf16_t* A; const bf16_t* Bt; int K; };
struct StaticOrder {
    int nM, nN, nwg, G, c;
    __device__ void init(int M_, int N_, int G_, int c_) { nM = M_ / BM; nN = N_ / BM; nwg = nM * nN; G = G_; c = c_; }
    __device__ bool next(int i, Unit& u) const {
        const long L = (long)i * G + c; if (L >= nwg) return false;
        int wgid = (int)L; { const int q = nwg / NXCD, r = nwg % NXCD, xcd = wgid % NXCD, off = wgid / NXCD; wgid = (xcd < r ? xcd * (q + 1) : r * (q + 1) + (xcd - r) * q) + off; }
        const int nig = WGM * nN, gid = wgid / nig, fm = gid * WGM, gsz = (nM - fm) < WGM ? (nM - fm) : WGM;
        u.pm = fm + ((wgid % nig) % gsz); u.pn = (wgid % nig) / gsz; return true;
    }
};
__device__ __forceinline__ unsigned cvt_pk_bf16(float lo, float hi) { unsigned r; asm volatile("v_cvt_pk_bf16_f32 %0, %1, %2" : "=v"(r) : "v"(lo), "v"(hi)); return r; }

template <class Epi, class Sched, bool ALIGN_EPI>
__device__ __forceinline__ void gemm_phase(PG8_LAS unsigned char* lds, const Gemm g, const Sched& S, const Epi& E) {
    const int tid = threadIdx.x, wid = __builtin_amdgcn_readfirstlane(tid >> 6), lane = tid & 63, wr = wid >> 2, wc = wid & 3, fr = lane & 15, fq = lane >> 4;
    const int K = g.K, nt = K / BK;
    int Ri[2], Ci[2]; unsigned voffB[2];
#pragma unroll
    for (int i = 0; i < 2; ++i) { int R, C; stage_rc(tid * 16 + i * 8192, R, C); const int Rb = Epi::PERM ? ((R & ~31) + perm32(R & 31)) : R;
        Ri[i] = R; Ci[i] = C; voffB[i] = (unsigned)(Rb * K + C) * 2u; }
    const size_t kstep = (size_t)(BK * 2);
    const size_t hstep = (size_t)HALF * K * 2;
    const size_t tstep = 2 * hstep;
    const unsigned ldsw = (unsigned)wid * 1024u;
    const int aoff = lds_byte(wr * 64 + fr, fq * 8), boff = lds_byte(wc * 32 + fr, fq * 8);
    const char* gA = (const char*)g.A;
#define PG8_SA(b, h) (((b) * 2 + (h)) * HTB)
#define PG8_SB(b, h) ((4 + (b) * 2 + (h)) * HTB)
#define PG8_STAGE(bufoff, gbase, voff) do { _Pragma("unroll") for (int _i = 0; _i < 2; ++_i) \
        __builtin_amdgcn_global_load_lds((const unsigned*)((const char*)(gbase) + (voff)[_i]), (PG8_LAS unsigned*)(lds + (bufoff) + ldsw + _i * 8192), 16, 0, 0); } while (0)
#define PG8_STAGE_A(bufoff, AO, h, kb) do { _Pragma("unroll") for (int _i = 0; _i < 2; ++_i) \
        __builtin_amdgcn_global_load_lds((const unsigned*)(gA + (size_t)((AO)[h][_i] + (unsigned)(kb))), (PG8_LAS unsigned*)(lds + (bufoff) + ldsw + _i * 8192), 16, 0, 0); } while (0)
#define PG8_LDA(dst, b, h) do { _Pragma("unroll") for (int m = 0; m < 4; ++m) _Pragma("unroll") for (int k = 0; k < 2; ++k) dst[m][k] = *(const PG8_LAS bf16x8*)(lds + PG8_SA(b, h) + aoff + m * 2048 + k * 1024); } while (0)
#define PG8_LDB(dst, b, h) do { _Pragma("unroll") for (int n = 0; n < 2; ++n) _Pragma("unroll") for (int k = 0; k < 2; ++k) dst[n][k] = *(const PG8_LAS bf16x8*)(lds + PG8_SB(b, h) + boff + n * 2048 + k * 1024); } while (0)
#define PG8_MMA(ai, bj, At, Bt) do { __builtin_amdgcn_s_setprio(1); _Pragma("unroll") for (int m = 0; m < 4; ++m) _Pragma("unroll") for (int n = 0; n < 2; ++n) _Pragma("unroll") for (int k = 0; k < 2; ++k) \
        acc[ai][bj][m][n] = __builtin_amdgcn_mfma_f32_16x16x32_bf16(Bt[n][k], At[m][k], acc[ai][bj][m][n], 0, 0, 0); __builtin_amdgcn_s_setprio(0); } while (0)
#define PG8_WAIT_V(n) asm volatile("s_waitcnt vmcnt(" #n ")" ::: "memory")
#define PG8_WAIT_L(n) asm volatile("s_waitcnt lgkmcnt(" #n ")" ::: "memory")
#define PG8_BAR __builtin_amdgcn_s_barrier()
#define PG8_SCHED __builtin_amdgcn_sched_barrier(0)
#define PG8_AOFFS(AO, u) do { _Pragma("unroll") for (int _h = 0; _h < 2; ++_h) _Pragma("unroll") for (int _i = 0; _i < 2; ++_i) (AO)[_h][_i] = S.row_off(u, _h * HALF + Ri[_i]) + (unsigned)(Ci[_i] * 2); } while (0)
    Unit cur, nxt; int ui = 0;
    if (!S.next(0, cur)) return;
    f32x4 acc[2][2][4][2];
#pragma unroll
    for (int a = 0; a < 2; ++a)
#pragma unroll
        for (int b = 0; b < 2; ++b)
#pragma unroll
            for (int m = 0; m < 4; ++m)
#pragma unroll
                for (int n = 0; n < 2; ++n) acc[a][b][m][n] = (f32x4){0.f, 0.f, 0.f, 0.f};
    bf16x8 At[4][2], B0[2][2], B1[2][2];
    unsigned aoc[2][2], aon[2][2];
    PG8_AOFFS(aoc, cur);
    const char* cB = (const char*)g.Bt + (size_t)cur.pn * tstep;
    PG8_STAGE(PG8_SB(0, 0), cB, voffB); PG8_STAGE(PG8_SB(0, 1), cB + hstep, voffB); PG8_STAGE_A(PG8_SA(0, 0), aoc, 0, 0); PG8_STAGE_A(PG8_SA(0, 1), aoc, 1, 0);
    if (wr == 1) PG8_BAR;
    PG8_WAIT_V(2); PG8_BAR;
    PG8_STAGE(PG8_SB(1, 0), cB + kstep, voffB); PG8_STAGE_A(PG8_SA(1, 0), aoc, 0, 128); PG8_STAGE(PG8_SB(1, 1), cB + hstep + kstep, voffB);
    PG8_WAIT_V(6); PG8_BAR;
    for (;;) {
        const bool has_next = S.next(ui + 1, nxt);
        const char* nB = cB;
        if (has_next) { PG8_AOFFS(aon, nxt); nB = (const char*)g.Bt + (size_t)nxt.pn * tstep; }
        else {
#pragma unroll
            for (int _h = 0; _h < 2; ++_h)
#pragma unroll
                for (int _i = 0; _i < 2; ++_i) aon[_h][_i] = aoc[_h][_i]; }
        for (int t = 0; t < nt; t += 2) {
            const bool last = (t == nt - 2);
            const unsigned k1 = (unsigned)(t + 1) * 128u, k2 = last ? 0u : (unsigned)(t + 2) * 128u, k3 = k2 + 128u;
            unsigned a2o[2][2];
#pragma unroll
            for (int _h = 0; _h < 2; ++_h)
#pragma unroll
                for (int _i = 0; _i < 2; ++_i) a2o[_h][_i] = last ? aon[_h][_i] : aoc[_h][_i];
            const char* b2 = last ? nB : cB + (size_t)(t + 2) * kstep; const char* b3 = b2 + kstep;
            PG8_LDB(B0, 0, 0); PG8_LDB(B1, 0, 1); PG8_SCHED; PG8_LDA(At, 0, 0); PG8_STAGE_A(PG8_SA(1, 1), aoc, 1, k1);
            PG8_WAIT_V(8); PG8_WAIT_L(0); PG8_BAR; PG8_MMA(0, 0, At, B0); PG8_MMA(0, 1, At, B1); PG8_BAR; PG8_SCHED;
            PG8_LDA(At, 0, 1); PG8_STAGE(PG8_SB(0, 0), b2, voffB); PG8_STAGE(PG8_SB(0, 1), b2 + hstep, voffB); PG8_STAGE_A(PG8_SA(0, 0), a2o, 0, k2);
            PG8_WAIT_V(8); PG8_WAIT_L(0); PG8_BAR; PG8_MMA(1, 0, At, B0); PG8_MMA(1, 1, At, B1); PG8_BAR; PG8_SCHED;
            PG8_LDB(B0, 1, 0); PG8_LDB(B1, 1, 1); PG8_SCHED; PG8_LDA(At, 1, 0); PG8_STAGE_A(PG8_SA(0, 1), a2o, 1, k2);
            PG8_WAIT_V(8); PG8_WAIT_L(0); PG8_BAR; PG8_MMA(0, 0, At, B0); PG8_MMA(0, 1, At, B1); PG8_BAR; PG8_SCHED;
            PG8_LDA(At, 1, 1); PG8_STAGE(PG8_SB(1, 0), b3, voffB); PG8_STAGE(PG8_SB(1, 1), b3 + hstep, voffB); PG8_STAGE_A(PG8_SA(1, 0), a2o, 0, k3);
            PG8_WAIT_V(8); PG8_WAIT_L(0); PG8_BAR; PG8_MMA(1, 0, At, B0); PG8_MMA(1, 1, At, B1); PG8_BAR; PG8_SCHED;
        }
        if constexpr (ALIGN_EPI) { if (wr == 0) PG8_BAR; }
        E(acc, cur, wr, wc, fr, fq);
        if (!has_next) break;
#pragma unroll
        for (int a = 0; a < 2; ++a)
#pragma unroll
            for (int b = 0; b < 2; ++b)
#pragma unroll
                for (int m = 0; m < 4; ++m)
#pragma unroll
                    for (int n = 0; n < 2; ++n) acc[a][b][m][n] = (f32x4){0.f, 0.f, 0.f, 0.f};
        cur = nxt; cB = nB; ++ui;
#pragma unroll
        for (int _h = 0; _h < 2; ++_h)
#pragma unroll
            for (int _i = 0; _i < 2; ++_i) aoc[_h][_i] = aon[_h][_i];
        if constexpr (ALIGN_EPI) { if (wr == 1) PG8_BAR; }
    }
    PG8_WAIT_V(0);
    if constexpr (!ALIGN_EPI) { if (wr == 0) PG8_BAR; }
    PG8_BAR;
#undef PG8_SA
#undef PG8_SB
#undef PG8_STAGE
#undef PG8_STAGE_A
#undef PG8_LDA
#undef PG8_LDB
#undef PG8_MMA
#undef PG8_WAIT_V
#undef PG8_WAIT_L
#undef PG8_BAR
#undef PG8_SCHED
#undef PG8_AOFFS
}
}
struct SchedPlain : pg8::StaticOrder {
    unsigned rowbytes;
    DEV unsigned row_off(const pg8::Unit& u, int r) const { return (unsigned)(u.pm * 256 + r) * rowbytes; }
};
struct SchedMoe1 : pg8::StaticOrder {
    const int* idx;
    DEV bool next(int i, pg8::Unit& u) const { if (!pg8::StaticOrder::next(i, u)) return false; u.pn += (u.pm >> 4) * 16; return true; }
    DEV unsigned row_off(const pg8::Unit& u, int r) const { const int g = u.pm * 256 + r; const int tok = ((g >> 9) & 7) * S + idx[g]; return (unsigned)tok * (unsigned)(D * 2); }
};
struct SchedMoe2 : pg8::StaticOrder {
    DEV bool next(int i, pg8::Unit& u) const { if (!pg8::StaticOrder::next(i, u)) return false; u.pn += (u.pm >> 4) * 4; return true; }
    DEV unsigned row_off(const pg8::Unit& u, int r) const { return (unsigned)(u.pm * 256 + r) * (unsigned)(DFF * 2); }
};
typedef pg8::f32x4 f32x4; typedef pg8::u32x4 u32x4;
struct EpiInProj {
    static constexpr bool PERM = true;
    unsigned char* ws; const float* ropeT;
    DEV void operator()(const f32x4 (&acc)[2][2][4][2], const pg8::Unit& u, int wr, int wc, int fr, int fq) const {
        const int grp = u.pn >> 1;
        bf16_t* gbase = (bf16_t*)(ws + WS_RQ + (size_t)grp * 32 * MiB);
        const float sc = (grp == 1) ? 0.125f : (grp == 4 ? 0.125f * LOG2E : 1.f);
#pragma unroll
        for (int ai = 0; ai < 2; ++ai)
#pragma unroll
            for (int m = 0; m < 4; ++m) {
                const int row = u.pm * 256 + ai * 128 + wr * 64 + m * 16 + fr, b = row >> 12, s = row & 4095;
#pragma unroll
                for (int bj = 0; bj < 2; ++bj) {
                    const int hd = 4 * (u.pn & 1) + 2 * bj + (wc >> 1), j0 = 32 * (wc & 1) + 8 * fq;
                    f32x4 lo = acc[ai][bj][m][0], hi = acc[ai][bj][m][1];
                    if (grp < 2) {
                        const f32x4 c = *(const f32x4*)(ropeT + s * 32 + (j0 >> 1)), sn = *(const f32x4*)(ropeT + S * 32 + s * 32 + (j0 >> 1));
                        const f32x4 l2 = lo * c - hi * sn, h2 = hi * c + lo * sn; lo = l2; hi = h2;
                    }
                    lo = lo * sc; hi = hi * sc;
                    u32x4 w; w.x = pg8::cvt_pk_bf16(lo[0], lo[1]); w.y = pg8::cvt_pk_bf16(lo[2], lo[3]); w.z = pg8::cvt_pk_bf16(hi[0], hi[1]); w.w = pg8::cvt_pk_bf16(hi[2], hi[3]);
                    *(u32x4*)(gbase + ((size_t)(b * NH + hd) * S + s) * HD + j0) = w;
                }
            }
    }
};
struct EpiOutProj {
    static constexpr bool PERM = true;
    const float* x; float* x1;
    DEV void operator()(const f32x4 (&acc)[2][2][4][2], const pg8::Unit& u, int wr, int wc, int fr, int fq) const {
#pragma unroll
        for (int ai = 0; ai < 2; ++ai)
#pragma unroll
            for (int m = 0; m < 4; ++m) {
                const int row = u.pm * 256 + ai * 128 + wr * 64 + m * 16 + fr;
#pragma unroll
                for (int bj = 0; bj < 2; ++bj) { const size_t off = (size_t)row * D + u.pn * 256 + bj * 128 + wc * 32 + 8 * fq;
                    const f32x4 a = *(const f32x4*)(x + off), b = *(const f32x4*)(x + off + 4);
                    *(f32x4*)(x1 + off) = a + acc[ai][bj][m][0]; *(f32x4*)(x1 + off + 4) = b + acc[ai][bj][m][1]; }
            }
    }
};
struct EpiSwiGLU {
    static constexpr bool PERM = true;
    bf16_t* hid;
    DEV void operator()(const f32x4 (&acc)[2][2][4][2], const pg8::Unit& u, int wr, int wc, int fr, int fq) const {
        const int pnl = u.pn & 15;
#pragma unroll
        for (int ai = 0; ai < 2; ++ai)
#pragma unroll
            for (int m = 0; m < 4; ++m) {
                const int row = u.pm * 256 + ai * 128 + wr * 64 + m * 16 + fr;
                float o[8];
#pragma unroll
                for (int n = 0; n < 2; ++n)
#pragma unroll
                    for (int i = 0; i < 4; ++i) { const float gt = acc[ai][0][m][n][i], up = acc[ai][1][m][n][i];
                        o[4 * n + i] = gt * __builtin_amdgcn_rcpf(1.f + __builtin_amdgcn_exp2f(-gt * LOG2E)) * up; }
                u32x4 w; w.x = pg8::cvt_pk_bf16(o[0], o[1]); w.y = pg8::cvt_pk_bf16(o[2], o[3]); w.z = pg8::cvt_pk_bf16(o[4], o[5]); w.w = pg8::cvt_pk_bf16(o[6], o[7]);
                *(u32x4*)(hid + (size_t)row * DFF + pnl * 128 + wc * 32 + 8 * fq) = w;
            }
    }
};
struct EpiDown {
    static constexpr bool PERM = true;
    bf16_t* y;
    DEV void operator()(const f32x4 (&acc)[2][2][4][2], const pg8::Unit& u, int wr, int wc, int fr, int fq) const {
        const int pnl = u.pn & 3;
#pragma unroll
        for (int ai = 0; ai < 2; ++ai)
#pragma unroll
            for (int m = 0; m < 4; ++m) {
                const int row = u.pm * 256 + ai * 128 + wr * 64 + m * 16 + fr;
#pragma unroll
                for (int bj = 0; bj < 2; ++bj) { const f32x4 lo = acc[ai][bj][m][0], hi = acc[ai][bj][m][1];
                    u32x4 w; w.x = pg8::cvt_pk_bf16(lo[0], lo[1]); w.y = pg8::cvt_pk_bf16(lo[2], lo[3]); w.z = pg8::cvt_pk_bf16(hi[0], hi[1]); w.w = pg8::cvt_pk_bf16(hi[2], hi[3]);
                    *(u32x4*)(y + (size_t)row * D + pnl * 256 + bj * 128 + wc * 32 + 8 * fq) = w; }
            }
    }
};
struct Args { const float* in[13]; float* out; unsigned char* ws; int ph_lo, ph_hi; };
enum { IN_X = 0, IN_G1, IN_WIN, IN_DECAY, IN_GN, IN_RELB, IN_WOUT, IN_G2, IN_WR, IN_WG, IN_WU, IN_WDN, IN_FG };

struct TrItem { const float* src; bf16_t* dst; int K, N, k0, n0, mode; };
DEV void tr_load(const TrItem& t, f32x4 (&v)[16], int lane) {
#pragma unroll
    for (int i = 0; i < 16; ++i) { const int kk = (lane >> 4) + 4 * i, c = (lane & 15) * 4; v[i] = *(const f32x4*)(t.src + (size_t)(t.k0 + kk) * t.N + t.n0 + c); }
}
DEV int rowmap_rt(int mode, int n) {
    if (mode == 0) return n;
    if (mode == 1) { if (n >= 1024) return n; const int base = n & ~63, d = n & 63, nn = d >> 5, dd = d & 31; return base + 8 * (dd >> 2) + 4 * nn + (dd & 3); }
    return (n >> 7) * 256 + (mode == 3 ? 128 : 0) + (n & 127);
}
DEV void tr_finish(const TrItem& t, const f32x4 (&v)[16], LAS float* scr, int lane) {
#pragma unroll
    for (int i = 0; i < 16; ++i) { const int kk = (lane >> 4) + 4 * i, c = (lane & 15) * 4;
        scr[kk * 65 + c] = v[i][0]; scr[kk * 65 + c + 1] = v[i][1]; scr[kk * 65 + c + 2] = v[i][2]; scr[kk * 65 + c + 3] = v[i][3]; }
    LDS_WAIT();
#pragma unroll
    for (int i = 0; i < 8; ++i) { const int n = (lane >> 3) + 8 * i, c = (lane & 7) * 8; const LAS float* sp = scr + c * 65 + n;
        u32x4 o; o.x = pk2(sp[0], sp[65]); o.y = pk2(sp[2 * 65], sp[3 * 65]); o.z = pk2(sp[4 * 65], sp[5 * 65]); o.w = pk2(sp[6 * 65], sp[7 * 65]);
        *(u32x4*)(t.dst + (size_t)rowmap_rt(t.mode, t.n0 + n) * t.K + t.k0 + c) = o; }
    LDS_WAIT();
}
template <class Dec> DEV void tr_run(const Dec& dec, int nitems, int gw, int NGW, LAS float* scr, int lane) {
    int it = gw; if (it >= nitems) return;
    TrItem cur, nxt; f32x4 va[16], vb[16];
    dec(it, cur); tr_load(cur, va, lane);
    for (;;) {
        const int n1 = it + NGW; const bool h1 = n1 < nitems;
        if (h1) { dec(n1, nxt); tr_load(nxt, vb, lane); }
        tr_finish(cur, va, scr, lane);
        if (!h1) break;
        const int n2 = n1 + NGW; const bool h2 = n2 < nitems;
        if (h2) { dec(n2, cur); tr_load(cur, va, lane); }
        tr_finish(nxt, vb, scr, lane);
        if (!h2) break;
        it = n2;
    }
}
DEV void rms_row_to_bf16(const float* xrow, const float* g, bf16_t* orow, int lane) {
    const float4* xr = (const float4*)xrow + lane;
    float4 v[4]; float s = 0.f;
#pragma unroll
    for (int j = 0; j < 4; ++j) { v[j] = xr[64 * j]; s += v[j].x * v[j].x + v[j].y * v[j].y + v[j].z * v[j].z + v[j].w * v[j].w; }
    const float rs = rsqrtf(wave_sum(s) * (1.f / D) + EPS);
    uint2* o = (uint2*)orow + lane;
#pragma unroll
    for (int j = 0; j < 4; ++j) { const float4 gg = ((const float4*)g)[lane + 64 * j];
        o[64 * j] = make_uint2(pk2(v[j].x * rs * gg.x, v[j].y * rs * gg.y), pk2(v[j].z * rs * gg.z, v[j].w * rs * gg.w)); }
}
DEV void phase_prep(const Args& a, unsigned char* lds, int gw, int NGW, int lane, int wave) {
    unsigned char* ws = a.ws;
    float* ropeT = (float*)(ws + WS_ROPE); float* biasT = (float*)(ws + WS_BIAS);
    for (int t = gw * 64 + lane; t < S * 32; t += NGW * 64) {
        const int pos = t >> 5, i = t & 31; const double inv = pow(10000.0, -(double)i / 32.0), ang = (double)pos * inv;
        ropeT[t] = (float)cos(ang); ropeT[S * 32 + t] = (float)sin(ang);
        if (t < 3 * NH * 129) { const int p = t / (NH * 129), h = (t / 129) % NH, o = t % 129 - 64, dil = p == 0 ? 1 : (p == 1 ? 4 : 16), rel = o * dil, n = rel < 0 ? -rel : rel;
            int bucket = rel > 0 ? 16 : 0;
            if (n < 8) bucket += n; else { int large = 8 + (int)(log((double)n / 8.0) / log(128.0) * 8.0); if (large > 15) large = 15; bucket += large; }
            biasT[t] = a.in[IN_RELB][bucket * NH + h] * LOG2E; }
    }
    LAS float* scr = (LAS float*)((LAS unsigned char*)lds + wave * 16640);
    constexpr int I_IN = (D / 64) * (PC / 64), I_OUT = (D / 64) * (D / 64);
    { const float* w_in = a.in[IN_WIN]; const float* w_out = a.in[IN_WOUT]; bf16_t* Win = (bf16_t*)(ws + WS_WIN); bf16_t* Wout = (bf16_t*)(ws + WS_WOUT);
      auto dec = [=](int it, TrItem& t) { if (it < I_IN) { t.src = w_in; t.dst = Win; t.K = D; t.N = PC; t.k0 = (it / (PC / 64)) * 64; t.n0 = (it % (PC / 64)) * 64; t.mode = 1; }
          else { const int r = it - I_IN; t.src = w_out; t.dst = Wout; t.K = D; t.N = D; t.k0 = (r / (D / 64)) * 64; t.n0 = (r % (D / 64)) * 64; t.mode = 0; } };
      tr_run(dec, I_IN + I_OUT, gw, NGW, scr, lane); }
    for (int m = gw; m < M; m += NGW) rms_row_to_bf16(a.in[IN_X] + (size_t)m * D, a.in[IN_G1], (bf16_t*)(ws + WS_XN) + (size_t)m * D, lane);
}
DEV void phase_latew(const Args& a, unsigned char* lds, int gw, int NGW, int lane, int wave) {
    unsigned char* ws = a.ws; LAS float* scr = (LAS float*)((LAS unsigned char*)lds + wave * 16640);
    constexpr int I_G = (D / 64) * (DFF / 64);
    const float* wg_ = a.in[IN_WG]; const float* wu_ = a.in[IN_WU]; const float* wd_ = a.in[IN_WDN]; bf16_t* Wgu = (bf16_t*)(ws + WS_WGU); bf16_t* Wd = (bf16_t*)(ws + WS_WD);
    auto dec = [=](int it, TrItem& t) { const int which = it / (NE * I_G), r = it % (NE * I_G), e = r / I_G, q = r % I_G;
        if (which < 2) { t.src = (which == 0 ? wg_ : wu_) + (size_t)e * D * DFF; t.dst = Wgu + (size_t)e * 4096 * D; t.K = D; t.N = DFF; t.k0 = (q / (DFF / 64)) * 64; t.n0 = (q % (DFF / 64)) * 64; t.mode = 2 + which; }
        else { t.src = wd_ + (size_t)e * DFF * D; t.dst = Wd + (size_t)e * D * DFF; t.K = DFF; t.N = D; t.k0 = (q / (D / 64)) * 64; t.n0 = (q % (D / 64)) * 64; t.mode = 0; } };
    tr_run(dec, 3 * NE * I_G, gw, NGW, scr, lane);
}
DEV void phase_router(const Args& a, unsigned char* lds, int gw, int NGW, int lane, int tid) {
    unsigned char* ws = a.ws; const float* x1 = a.out; const float* g2 = a.in[IN_G2]; const float* wr = a.in[IN_WR];
    bf16_t* H2b = (bf16_t*)(ws + WS_XN); float* aff = (float*)(ws + WS_AFF); float* affT = (float*)(ws + WS_AFFT); int* inv = (int*)(ws + WS_INV);
    LAS f32x4* wl = (LAS f32x4*)(LAS unsigned char*)lds;
    for (int i = tid; i < D * 4; i += NTHR) { const int k = i >> 2, c = i & 3, slot = (k & 3) * 256 + (k >> 2); wl[slot * 4 + ((c + (slot >> 2)) & 3)] = *(const f32x4*)(wr + (size_t)k * NE + 4 * c); }
    __syncthreads();
    for (int row = gw; row < M; row += NGW) {
        const float4* xr = (const float4*)(x1 + (size_t)row * D) + lane;
        float4 v[4]; float s = 0.f;
#pragma unroll
        for (int j = 0; j < 4; ++j) { v[j] = xr[64 * j]; s += v[j].x * v[j].x + v[j].y * v[j].y + v[j].z * v[j].z + v[j].w * v[j].w; }
        const float rs = rsqrtf(wave_sum(s) * (1.f / D) + EPS);
        f32x4 lg[4];
#pragma unroll
        for (int c = 0; c < 4; ++c) lg[c] = (f32x4){0.f, 0.f, 0.f, 0.f};
        uint2* o = (uint2*)(H2b + (size_t)row * D) + lane;
#pragma unroll
        for (int j = 0; j < 4; ++j) { const float4 gg = ((const float4*)g2)[lane + 64 * j];
            const float hv[4] = {v[j].x * rs * gg.x, v[j].y * rs * gg.y, v[j].z * rs * gg.z, v[j].w * rs * gg.w};
            o[64 * j] = make_uint2(pk2(hv[0], hv[1]), pk2(hv[2], hv[3]));
#pragma unroll
            for (int t = 0; t < 4; ++t) { const int slot = t * 256 + lane + 64 * j, rot = (lane >> 2) & 3;
#pragma unroll
                for (int c = 0; c < 4; ++c) lg[c] += hv[t] * wl[slot * 4 + ((c + rot) & 3)];
                __builtin_amdgcn_sched_barrier(0); } }
        float l16[16]; float mx = -1e30f;
#pragma unroll
        for (int e = 0; e < 16; ++e) { l16[e] = wave_sum(lg[e >> 2][e & 3]); mx = fmaxf(mx, l16[e]); }
        float sum = 0.f;
#pragma unroll
        for (int e = 0; e < 16; ++e) { l16[e] = __expf(l16[e] - mx); sum += l16[e]; }
        const float is = 1.f / sum;
        if (lane < 16) { float av = 0.f;
#pragma unroll
            for (int e = 0; e < 16; ++e) av = lane == e ? l16[e] * is : av;
            aff[(size_t)row * NE + lane] = av; inv[(size_t)row * NE + lane] = -1; affT[((size_t)(row >> 12) * NE + lane) * S + (row & 4095)] = av; }
    }
    __syncthreads();
}
DEV void phase_topk(const Args& a, unsigned char* lds, int wg, int G, int tid, int lane, int wave) {
    unsigned char* ws = a.ws; const float* affT = (const float*)(ws + WS_AFFT); int* idx = (int*)(ws + WS_IDX); int* inv = (int*)(ws + WS_INV);
    LAS unsigned* hist = (LAS unsigned*)(LAS unsigned char*)lds; LAS unsigned* wsum = hist + 256; LAS unsigned* bc = hist + 272;
    for (int it = wg; it < NE * NB; it += G) {
        const int e = it & 15, b = it >> 4;
        unsigned u[8];
        { const uint4* src = (const uint4*)(affT + ((size_t)b * NE + e) * S + 8 * tid); const uint4 p = src[0], q = src[1]; u[0] = p.x; u[1] = p.y; u[2] = p.z; u[3] = p.w; u[4] = q.x; u[5] = q.y; u[6] = q.z; u[7] = q.w; }
        unsigned prefix = 0u, kk = CAP;
#pragma unroll
        for (int pass = 0; pass < 4; ++pass) {
            const int shift = 24 - 8 * pass;
            __syncthreads();
            if (tid < 256) hist[tid] = 0u;
            __syncthreads();
#pragma unroll
            for (int j = 0; j < 8; ++j) if (pass == 0 || (u[j] >> (shift + 8)) == prefix) atomicAdd((unsigned*)&hist[(u[j] >> shift) & 255u], 1u);
            __syncthreads();
            if (wave == 0) {
                const unsigned c0 = hist[4 * lane], c1 = hist[4 * lane + 1], c2 = hist[4 * lane + 2], c3 = hist[4 * lane + 3], tot = c0 + c1 + c2 + c3;
                unsigned incl = tot;
#pragma unroll
                for (int o = 1; o < 64; o <<= 1) { const unsigned t = __shfl_down(incl, o); if (lane + o < 64) incl += t; }
                const unsigned excl = incl - tot;
                if (excl < kk && kk <= incl) { unsigned acc = excl; int bin;
                    if (acc + c3 >= kk) bin = 3; else { acc += c3; if (acc + c2 >= kk) bin = 2; else { acc += c2; if (acc + c1 >= kk) bin = 1; else { acc += c1; bin = 0; } } }
                    bc[0] = 4 * lane + bin; bc[1] = kk - acc; }
            }
            __syncthreads();
            prefix = (prefix << 8) | bc[0]; kk = bc[1];
        }
        const unsigned T = prefix, need = kk;
        unsigned cg_ = 0u, ce = 0u;
#pragma unroll
        for (int j = 0; j < 8; ++j) { cg_ += u[j] > T; ce += u[j] == T; }
        unsigned pk = cg_ | (ce << 16), incl = pk;
#pragma unroll
        for (int o = 1; o < 64; o <<= 1) { const unsigned t = __shfl_up(incl, o); if (lane >= o) incl += t; }
        if (lane == 63) wsum[wave] = incl;
        __syncthreads();
        unsigned base = 0u;
#pragma unroll
        for (int w = 0; w < NWAVES; ++w) base += w < wave ? wsum[w] : 0u;
        const unsigned ex = base + incl - pk; unsigned gtb = ex & 0xffffu, eqb = ex >> 16;
#pragma unroll
        for (int j = 0; j < 8; ++j) { const bool g = u[j] > T, q = u[j] == T; const unsigned slot = gtb + (eqb < need ? eqb : need);
            if (g || (q && eqb < need)) { const int s = 8 * tid + j; idx[(e * NB + b) * CAP + slot] = s; inv[((size_t)b * S + s) * NE + e] = (int)slot; }
            gtb += g; eqb += q; }
    }
}
DEV void phase_final(const Args& a, int gw, int NGW, int lane) {
    unsigned char* ws = a.ws; float* xo = a.out; const float* aff = (const float*)(ws + WS_AFF); const int* inv = (const int*)(ws + WS_INV); const bf16_t* y = (const bf16_t*)(ws + WS_Y); const float* fg = a.in[IN_FG];
    for (int row = gw; row < M; row += NGW) {
        const int b = row >> 12;
        float4* xr = (float4*)(xo + (size_t)row * D) + lane;
        float4 v[4];
#pragma unroll
        for (int j = 0; j < 4; ++j) v[j] = xr[64 * j];
        for (int e = 0; e < NE; ++e) { const int sl = inv[(size_t)row * NE + e]; if (sl < 0) continue;
            const float g = aff[(size_t)row * NE + e]; const uint2* yr = (const uint2*)(y + ((size_t)e * 4096 + b * CAP + sl) * D) + lane;
#pragma unroll
            for (int j = 0; j < 4; ++j) { const uint2 w = yr[64 * j]; v[j].x += g * bf2f(w.x & 0xffffu); v[j].y += g * bf2f(w.x >> 16); v[j].z += g * bf2f(w.y & 0xffffu); v[j].w += g * bf2f(w.y >> 16); } }
        float s = 0.f;
#pragma unroll
        for (int j = 0; j < 4; ++j) s += v[j].x * v[j].x + v[j].y * v[j].y + v[j].z * v[j].z + v[j].w * v[j].w;
        const float rs = rsqrtf(wave_sum(s) * (1.f / D) + EPS);
#pragma unroll
        for (int j = 0; j < 4; ++j) { const float4 gg = ((const float4*)fg)[lane + 64 * j]; xr[64 * j] = make_float4(v[j].x * rs * gg.x, v[j].y * rs * gg.y, v[j].z * rs * gg.z, v[j].w * rs * gg.w); }
    }
}
typedef short bf16x8 __attribute__((ext_vector_type(8)));
typedef float f32x16 __attribute__((ext_vector_type(16)));
typedef short s16x4 __attribute__((ext_vector_type(4)));
typedef LAS const char* lds_cptr;
constexpr int VROW = 192;
constexpr int VSLOT = 32 * VROW;
constexpr int MIX_WAVE_LDS = 2 * VSLOT;
constexpr int MIX_BIAS_OFF = NWAVES * MIX_WAVE_LDS;
DEV int crow(int r, int hi) { return (r & 3) + 8 * (r >> 2) + 4 * hi; }
DEV s16x4 vtr(lds_cptr p) { return __builtin_bit_cast(s16x4, __builtin_amdgcn_ds_read_tr16_b64_v4i16((LAS s16x4*)p)); }
DEV bf16x8 tr_frag(lds_cptr slot, int s, int blk, int lane) {
    const int h = lane >> 5; lds_cptr p = slot + (16 * s + 4 * h + ((lane & 15) >> 2)) * VROW + (32 * blk + 16 * ((lane >> 4) & 1) + 4 * (lane & 3)) * 2;
    const s16x4 lo = vtr(p), hi = vtr(p + 8 * VROW);
    return (bf16x8){lo[0], lo[1], lo[2], lo[3], hi[0], hi[1], hi[2], hi[3]};
}
DEV void load_frags(bf16x8 (&f)[4], const bf16_t* rowp, int lane) {
    const int h = lane >> 5;
#pragma unroll
    for (int st = 0; st < 4; ++st) f[st] = *(const bf16x8*)(rowp + 16 * st + 8 * h);
}
DEV bf16x8 pack_p(const f32x16& p, int s) {
    u32x4 w; w.x = pg8::cvt_pk_bf16(p[8 * s], p[8 * s + 1]); w.y = pg8::cvt_pk_bf16(p[8 * s + 2], p[8 * s + 3]); w.z = pg8::cvt_pk_bf16(p[8 * s + 4], p[8 * s + 5]); w.w = pg8::cvt_pk_bf16(p[8 * s + 6], p[8 * s + 7]);
    return __builtin_bit_cast(bf16x8, w);
}
#define MFMA32(a, b, c) __builtin_amdgcn_mfma_f32_32x32x16_bf16((a), (b), (c), 0, 0, 0)
DEV float ex2(float x) { return __builtin_amdgcn_exp2f(x); }

DEV void attn_item(const Args& a, unsigned char* lds, int item, int lane, int wave) {
    unsigned char* ws = a.ws;
    const int p = item >> 13, rem = item & 8191, bh = rem >> 7, qblk = rem & 127;
    const int dil = p == 0 ? 1 : (p == 1 ? 4 : 16), L = S / dil, bpr = L >> 5;
    const int r = qblk / bpr, q0 = (qblk % bpr) * 32;
    const bf16_t* Qh = (const bf16_t*)(ws + WS_AQ) + (size_t)bh * S * HD; const bf16_t* Kh = (const bf16_t*)(ws + WS_AK) + (size_t)bh * S * HD; const bf16_t* Vh = (const bf16_t*)(ws + WS_AV) + (size_t)bh * S * HD;
    const LAS float* biasL = (const LAS float*)((LAS unsigned char*)lds + MIX_BIAS_OFF) + (p * NH + (bh & 7)) * 129;
    LAS unsigned char* slot = (LAS unsigned char*)lds + wave * MIX_WAVE_LDS; lds_cptr slot3 = (lds_cptr)slot;
    const int t = lane & 31, hi = lane >> 5;
    bf16x8 qf[4]; load_frags(qf, Qh + (size_t)((q0 + t) * dil + r) * HD, lane);
    f32x16 o0 = {}, o1 = {}; float m = -1e30f, l = 0.f;
    for (int kk = 0; kk < 5; ++kk) {
        const int kbase = q0 - 64 + 32 * kk;
        if (kbase + 31 < 0 || kbase >= L) continue;
        { const int rr = lane >> 3, ch = lane & 7;
          u32x4 v[4];
#pragma unroll
          for (int i = 0; i < 4; ++i) { int ki = kbase + rr + 8 * i; ki = ki < 0 ? 0 : (ki >= L ? L - 1 : ki); v[i] = *(const u32x4*)(Vh + (size_t)(ki * dil + r) * HD + ch * 8); }
#pragma unroll
          for (int i = 0; i < 4; ++i) *(LAS u32x4*)(slot + (rr + 8 * i) * VROW + ch * 16) = v[i]; }
        bf16x8 kf[4]; { int ki = kbase + t; ki = ki < 0 ? 0 : (ki >= L ? L - 1 : ki); load_frags(kf, Kh + (size_t)(ki * dil + r) * HD, lane); }
        f32x16 sc = {};
#pragma unroll
        for (int st = 0; st < 4; ++st) sc = MFMA32(kf[st], qf[st], sc);
        float mx = -1e30f;
#pragma unroll
        for (int rg = 0; rg < 16; ++rg) { const int key = crow(rg, hi), bi = 32 * kk + key - t, ki = kbase + key;
            const bool ok = bi >= 0 && bi <= 128 && ki >= 0 && ki < L;
            const float bv = biasL[bi < 0 ? 0 : (bi > 128 ? 128 : bi)];
            sc[rg] = ok ? sc[rg] + bv : -1e30f; mx = fmaxf(mx, sc[rg]); }
        mx = fmaxf(mx, __shfl_xor(mx, 32));
        const float mn = fmaxf(m, mx), f = ex2(m - mn); m = mn;
        float ps = 0.f;
#pragma unroll
        for (int rg = 0; rg < 16; ++rg) { sc[rg] = ex2(sc[rg] - mn); ps += sc[rg]; }
        l = l * f + ps;
#pragma unroll
        for (int rg = 0; rg < 16; ++rg) { o0[rg] *= f; o1[rg] *= f; }
        const bf16x8 p0 = pack_p(sc, 0), p1 = pack_p(sc, 1);
        LDS_WAIT();
        o0 = MFMA32(tr_frag(slot3, 0, 0, lane), p0, o0); o0 = MFMA32(tr_frag(slot3, 1, 0, lane), p1, o0);
        o1 = MFMA32(tr_frag(slot3, 0, 1, lane), p0, o1); o1 = MFMA32(tr_frag(slot3, 1, 1, lane), p1, o1);
        LDS_WAIT();
    }
    l += __shfl_xor(l, 32);
    const float il = 1.f / l;
    const size_t orow = ((size_t)p * NB * NH + bh) * S + (size_t)((q0 + t) * dil + r);
    bf16_t* op = (bf16_t*)(ws + WS_ATTO) + orow * HD;
#pragma unroll
    for (int g4 = 0; g4 < 4; ++g4) {
        *(uint2*)(op + 8 * g4 + 4 * hi) = make_uint2(pg8::cvt_pk_bf16(o0[4 * g4] * il, o0[4 * g4 + 1] * il), pg8::cvt_pk_bf16(o0[4 * g4 + 2] * il, o0[4 * g4 + 3] * il));
        *(uint2*)(op + 32 + 8 * g4 + 4 * hi) = make_uint2(pg8::cvt_pk_bf16(o1[4 * g4] * il, o1[4 * g4 + 1] * il), pg8::cvt_pk_bf16(o1[4 * g4 + 2] * il, o1[4 * g4 + 3] * il));
    }
    if (hi == 0) ((float*)(ws + WS_ATTL))[orow] = m + __log2f(l);
}
DEV void retstate_item(const Args& a, unsigned char* lds, int item, int lane, int wave) {
    unsigned char* ws = a.ws;
    const int dir = item & 1, n = (item >> 1) & 31, bh = item >> 6, h = bh & 7;
    const bf16_t* Kc = (const bf16_t*)(ws + WS_RK) + ((size_t)bh * S + n * 128) * HD; const bf16_t* Vc = (const bf16_t*)(ws + WS_RV) + ((size_t)bh * S + n * 128) * HD;
    const float lg = a.in[IN_DECAY][dir * NH + h] * LOG2E;
    LAS unsigned char* vs = (LAS unsigned char*)lds + wave * MIX_WAVE_LDS; LAS unsigned char* ks = vs + VSLOT; lds_cptr vs3 = (lds_cptr)vs, ks3 = (lds_cptr)ks;
    f32x16 acc[2][2] = {};
    for (int blk = 0; blk < 4; ++blk) {
        { const int rr = lane >> 3, ch = lane & 7;
          u32x4 v[4], k[4];
#pragma unroll
          for (int i = 0; i < 4; ++i) { const int mrow = 32 * blk + rr + 8 * i; v[i] = *(const u32x4*)(Vc + (size_t)mrow * HD + ch * 8); k[i] = *(const u32x4*)(Kc + (size_t)mrow * HD + ch * 8); }
#pragma unroll
          for (int i = 0; i < 4; ++i) { const int mrow = 32 * blk + rr + 8 * i; const float z = ex2(lg * (float)(dir == 0 ? 127 - mrow : mrow));
              const unsigned kw[4] = {k[i].x, k[i].y, k[i].z, k[i].w}; u32x4 o;
              o.x = pg8::cvt_pk_bf16(bf2f(kw[0] & 0xffffu) * z, bf2f(kw[0] >> 16) * z); o.y = pg8::cvt_pk_bf16(bf2f(kw[1] & 0xffffu) * z, bf2f(kw[1] >> 16) * z);
              o.z = pg8::cvt_pk_bf16(bf2f(kw[2] & 0xffffu) * z, bf2f(kw[2] >> 16) * z); o.w = pg8::cvt_pk_bf16(bf2f(kw[3] & 0xffffu) * z, bf2f(kw[3] >> 16) * z);
              *(LAS u32x4*)(vs + (rr + 8 * i) * VROW + ch * 16) = v[i]; *(LAS u32x4*)(ks + (rr + 8 * i) * VROW + ch * 16) = o; } }
        LDS_WAIT();
#pragma unroll
        for (int s = 0; s < 2; ++s) {
            const bf16x8 v0 = tr_frag(vs3, s, 0, lane), v1 = tr_frag(vs3, s, 1, lane), k0 = tr_frag(ks3, s, 0, lane), k1 = tr_frag(ks3, s, 1, lane);
            acc[0][0] = MFMA32(v0, k0, acc[0][0]); acc[0][1] = MFMA32(v0, k1, acc[0][1]); acc[1][0] = MFMA32(v1, k0, acc[1][0]); acc[1][1] = MFMA32(v1, k1, acc[1][1]);
        }
        LDS_WAIT();
    }
    float* KT = (float*)(ws + WS_KF) + (((size_t)dir * NB * NH + bh) * 32 + n) * 4096;
    const int c = lane & 31, hi = lane >> 5;
#pragma unroll
    for (int eb = 0; eb < 2; ++eb)
#pragma unroll
        for (int db = 0; db < 2; ++db)
#pragma unroll
            for (int rg = 0; rg < 16; ++rg) KT[(32 * eb + crow(rg, hi)) * 64 + 32 * db + c] = acc[eb][db][rg];
}
DEV void phase_scan(const Args& a, int gtid, int NT) {
    unsigned char* ws = a.ws;
    for (int sl = gtid; sl < 2 * NB * NH * 1024; sl += NT) {
        const int dir = sl >> 16, bh = (sl >> 10) & 63, q = sl & 1023, h = bh & 7;
        const float gC = ex2(a.in[IN_DECAY][dir * NH + h] * LOG2E * 128.f);
        const float4* kt = (const float4*)(ws + WS_KF) + ((size_t)dir * NB * NH + bh) * 32 * 1024 + q;
        uint2* st = (uint2*)(ws + WS_ST) + ((size_t)dir * NB * NH + bh) * 32 * 1024 + q;
        float4 s = make_float4(0.f, 0.f, 0.f, 0.f);
        for (int i = 0; i < 32; ++i) { const int n = dir == 0 ? i : 31 - i;
            st[(size_t)n * 1024] = make_uint2(pg8::cvt_pk_bf16(s.x, s.y), pg8::cvt_pk_bf16(s.z, s.w));
            const float4 kv = kt[(size_t)n * 1024];
            s.x = gC * s.x + kv.x; s.y = gC * s.y + kv.y; s.z = gC * s.z + kv.z; s.w = gC * s.w + kv.w; }
    }
}
DEV void retout_item(const Args& a, unsigned char* lds, int item, int lane, int wave) {
    unsigned char* ws = a.ws;
    const int qb = item & 3, n = (item >> 2) & 31, bh = item >> 7, h = bh & 7, b = bh >> 3;
    const bf16_t* Qc = (const bf16_t*)(ws + WS_RQ) + ((size_t)bh * S + n * 128) * HD; const bf16_t* Kc = (const bf16_t*)(ws + WS_RK) + ((size_t)bh * S + n * 128) * HD;
    const bf16_t* Vc = (const bf16_t*)(ws + WS_RV) + ((size_t)bh * S + n * 128) * HD;
    const bf16_t* SF = (const bf16_t*)(ws + WS_ST) + (((size_t)0 * NB * NH + bh) * 32 + n) * 4096; const bf16_t* SB = (const bf16_t*)(ws + WS_ST) + (((size_t)1 * NB * NH + bh) * 32 + n) * 4096;
    const float lg0 = a.in[IN_DECAY][h] * LOG2E, lg1 = a.in[IN_DECAY][NH + h] * LOG2E;
    LAS unsigned char* slot = (LAS unsigned char*)lds + wave * MIX_WAVE_LDS; lds_cptr slot3 = (lds_cptr)slot;
    const int t = lane & 31, hi = lane >> 5, c = 32 * qb + t;
    bf16x8 qf[4]; load_frags(qf, Qc + (size_t)c * HD, lane);
    f32x16 o0 = {}, o1 = {};
    { bf16x8 s0[4], s1[4]; load_frags(s0, SF + (size_t)t * 64, lane); load_frags(s1, SF + (size_t)(32 + t) * 64, lane);
#pragma unroll
      for (int st = 0; st < 4; ++st) { o0 = MFMA32(s0[st], qf[st], o0); o1 = MFMA32(s1[st], qf[st], o1); }
      const float fa = ex2(lg0 * (float)(c + 1) - lg1 * (float)(128 - c));
#pragma unroll
      for (int rg = 0; rg < 16; ++rg) { o0[rg] *= fa; o1[rg] *= fa; }
      load_frags(s0, SB + (size_t)t * 64, lane); load_frags(s1, SB + (size_t)(32 + t) * 64, lane);
#pragma unroll
      for (int st = 0; st < 4; ++st) { o0 = MFMA32(s0[st], qf[st], o0); o1 = MFMA32(s1[st], qf[st], o1); }
      const float fb = ex2(lg1 * (float)(128 - c));
#pragma unroll
      for (int rg = 0; rg < 16; ++rg) { o0[rg] *= fb; o1[rg] *= fb; } }
    for (int kb = 0; kb < 4; ++kb) {
        { const int rr = lane >> 3, ch = lane & 7;
          u32x4 v[4];
#pragma unroll
          for (int i = 0; i < 4; ++i) v[i] = *(const u32x4*)(Vc + (size_t)(32 * kb + rr + 8 * i) * HD + ch * 8);
#pragma unroll
          for (int i = 0; i < 4; ++i) *(LAS u32x4*)(slot + (rr + 8 * i) * VROW + ch * 16) = v[i]; }
        bf16x8 kf[4]; load_frags(kf, Kc + (size_t)(32 * kb + t) * HD, lane);
        f32x16 sc = {};
#pragma unroll
        for (int st = 0; st < 4; ++st) sc = MFMA32(kf[st], qf[st], sc);
#pragma unroll
        for (int rg = 0; rg < 16; ++rg) { const int mk = 32 * kb + crow(rg, hi), df = c - mk; sc[rg] *= df >= 0 ? ex2(lg0 * (float)df) : ex2(lg1 * (float)(-df)); }
        const bf16x8 p0 = pack_p(sc, 0), p1 = pack_p(sc, 1);
        LDS_WAIT();
        o0 = MFMA32(tr_frag(slot3, 0, 0, lane), p0, o0); o0 = MFMA32(tr_frag(slot3, 1, 0, lane), p1, o0);
        o1 = MFMA32(tr_frag(slot3, 0, 1, lane), p0, o1); o1 = MFMA32(tr_frag(slot3, 1, 1, lane), p1, o1);
        LDS_WAIT();
    }
    float sm = 0.f;
#pragma unroll
    for (int rg = 0; rg < 16; ++rg) sm += o0[rg] + o1[rg];
    sm += __shfl_xor(sm, 32); const float mu = sm * (1.f / 64.f); float vq = 0.f;
#pragma unroll
    for (int rg = 0; rg < 16; ++rg) { const float d0 = o0[rg] - mu, d1 = o1[rg] - mu; vq += d0 * d0 + d1 * d1; }
    vq += __shfl_xor(vq, 32); const float rstd = rsqrtf(vq * (1.f / 64.f) + EPS);
    const size_t pos = (size_t)n * 128 + c;
    const bf16_t* gp = (const bf16_t*)(ws + WS_RG) + ((size_t)bh * S + pos) * HD; bf16_t* op = (bf16_t*)(ws + WS_XN) + ((size_t)b * S + pos) * D + h * HD; const float* gn = a.in[IN_GN] + h * HD;
#pragma unroll
    for (int db = 0; db < 2; ++db)
#pragma unroll
        for (int g4 = 0; g4 < 4; ++g4) { const int e0 = 32 * db + 8 * g4 + 4 * hi; const uint2 gw = *(const uint2*)(gp + e0); const float4 gg = *(const float4*)(gn + e0);
            const float gate[4] = {bf2f(gw.x & 0xffffu), bf2f(gw.x >> 16), bf2f(gw.y & 0xffffu), bf2f(gw.y >> 16)}; const float gv[4] = {gg.x, gg.y, gg.z, gg.w}; float o[4];
#pragma unroll
            for (int i = 0; i < 4; ++i) { const float rv = (db == 0 ? o0[4 * g4 + i] : o1[4 * g4 + i]); o[i] = (rv - mu) * rstd * gv[i] * (gate[i] / (1.f + __expf(-gate[i]))); }
            *(uint2*)(op + e0) = make_uint2(pg8::cvt_pk_bf16(o[0], o[1]), pg8::cvt_pk_bf16(o[2], o[3])); }
}
DEV void phase_attn_merge(const Args& a, int gtid, int NT) {
    unsigned char* ws = a.ws; const float* L = (const float*)(ws + WS_ATTL); const bf16_t* O = (const bf16_t*)(ws + WS_ATTO); bf16_t* mixed = (bf16_t*)(ws + WS_XN);
    for (int it = gtid; it < NB * NH * S * 8; it += NT) {
        const int ch = it & 7, row = it >> 3;
        const int bh = row >> 12, pos = row & 4095, b = bh >> 3, h = bh & 7;
        const float l0 = L[row], l1 = L[(size_t)NB * NH * S + row], l2 = L[(size_t)2 * NB * NH * S + row];
        const float mx = fmaxf(l0, fmaxf(l1, l2)); float w0 = ex2(l0 - mx), w1 = ex2(l1 - mx), w2 = ex2(l2 - mx); const float is = 1.f / (w0 + w1 + w2); w0 *= is; w1 *= is; w2 *= is;
        const uint4 a0 = *(const uint4*)(O + (size_t)row * HD + ch * 8), a1 = *(const uint4*)(O + ((size_t)NB * NH * S + row) * HD + ch * 8), a2 = *(const uint4*)(O + ((size_t)2 * NB * NH * S + row) * HD + ch * 8);
        const unsigned x0[4] = {a0.x, a0.y, a0.z, a0.w}, x1[4] = {a1.x, a1.y, a1.z, a1.w}, x2[4] = {a2.x, a2.y, a2.z, a2.w}; unsigned o[4];
#pragma unroll
        for (int j = 0; j < 4; ++j) o[j] = pg8::cvt_pk_bf16(w0 * bf2f(x0[j] & 0xffffu) + w1 * bf2f(x1[j] & 0xffffu) + w2 * bf2f(x2[j] & 0xffffu), w0 * bf2f(x0[j] >> 16) + w1 * bf2f(x1[j] >> 16) + w2 * bf2f(x2[j] >> 16));
        *(uint4*)(mixed + ((size_t)b * S + pos) * D + 512 + h * HD + ch * 8) = make_uint4(o[0], o[1], o[2], o[3]);
    }
}
DEV void phase_mix_a(const Args& a, unsigned char* lds, int gw, int NGW, int lane, int wave, int tid) {
    { const float* bt = (const float*)(a.ws + WS_BIAS); float* bl = (float*)(lds + MIX_BIAS_OFF); for (int i = tid; i < 3 * NH * 129; i += NTHR) bl[i] = bt[i]; }
    __syncthreads();
    for (int it = gw; it < 2 * 32 * NB * NH; it += NGW) retstate_item(a, lds, it, lane, wave);
    for (int it = gw; it < 3 * 8192; it += NGW) attn_item(a, lds, it, lane, wave);
}
DEV void phase_mix_b(const Args& a, unsigned char* lds, int gw, int NGW, int lane, int wave, int tid, int wg, int G) {
    for (int it = gw; it < NB * NH * 32 * 4; it += NGW) retout_item(a, lds, it, lane, wave);
    phase_attn_merge(a, wg * NTHR + tid, G * NTHR);
}
#define XB_TMO      128
#define XB_XCNT(j)  (256  + 64 * (j))
#define XB_XSUB(j)  (1280 + 64 * (j))
#define XB_XGEN(j)  (2304 + 64 * (j))
#define XB_TOP      3328
#define XB_TOPGEN   3392
#define XCD_BAR_WORDS 3456
#define XB_SPIN_CAP (1u << 18)

__device__ __forceinline__ unsigned xb_ld(unsigned* p)              { return __hip_atomic_load(p, __ATOMIC_RELAXED, __HIP_MEMORY_SCOPE_AGENT); }
__device__ __forceinline__ unsigned xb_add(unsigned* p, unsigned v) { return __hip_atomic_fetch_add(p, v, __ATOMIC_RELAXED, __HIP_MEMORY_SCOPE_AGENT); }
__device__ __forceinline__ unsigned xb_xcc_id() { return (unsigned)__builtin_amdgcn_s_getreg((3 << 11) | 20) & 0xFu; }
#define XB_SPIN(cond, bar) do { unsigned _sp = 0; while (cond) { __builtin_amdgcn_s_sleep(1); \
    if ((++_sp & 255u) == 0u) { if (xb_ld(&(bar)[XB_TMO])) break; if (_sp > XB_SPIN_CAP) { atomicAdd(&(bar)[XB_TMO], 1u); break; } } } } while (0)

struct XcdBarrier {
    unsigned* bar; unsigned x;
    volatile LAS unsigned* st;
};

__device__ __forceinline__ XcdBarrier xcd_barrier_post(unsigned* bar, volatile LAS unsigned* st) {
    XcdBarrier b; b.bar = bar; b.x = xb_xcc_id(); b.st = st;
    if (threadIdx.x == 0) (void)xb_add(&bar[XB_XCNT(b.x)], 1u);
    return b;
}
__device__ __forceinline__ void xcd_barrier_complete(unsigned* bar, unsigned x, unsigned& nloc, unsigned& nx) {
    const unsigned G = gridDim.x * gridDim.y * gridDim.z;
    unsigned sum, cnt, mine, sp = 0u;
    for (;;) {
        sum = 0u; cnt = 0u; mine = 0u;
#pragma unroll
        for (unsigned j = 0; j < 16; ++j) { const unsigned c = xb_ld(&bar[XB_XCNT(j)]); sum += c; cnt += (c > 0u) ? 1u : 0u; mine = (j == x) ? c : mine; }
        if (sum == G) break;
        __builtin_amdgcn_s_sleep(1);
        if ((++sp & 255u) == 0u) { if (xb_ld(&bar[XB_TMO])) break; if (sp > XB_SPIN_CAP) { atomicAdd(&bar[XB_TMO], 1u); break; } }
    }
    nloc = mine > 0u ? mine : 1u; nx = cnt > 0u ? cnt : 1u;
}

__device__ __forceinline__ void xcd_barrier(const XcdBarrier& b) {
    asm volatile("s_waitcnt vmcnt(0)" ::: "memory");
    __syncthreads();
    if (threadIdx.x == 0) {
        unsigned* bar = b.bar;
        __builtin_amdgcn_s_waitcnt(0);
        unsigned nloc = b.st[0], nx = b.st[1];
        if (nloc == 0u) { xcd_barrier_complete(bar, b.x, nloc, nx); b.st[0] = nloc; b.st[1] = nx; }
        const unsigned old = xb_add(&bar[XB_XSUB(b.x)], 1u);
        const unsigned gen = old / nloc;
        if (old + 1u == (gen + 1u) * nloc) {
            __builtin_amdgcn_fence(__ATOMIC_RELEASE, "agent");
            asm volatile("s_waitcnt vmcnt(0)" ::: "memory");
            const unsigned og = xb_add(&bar[XB_TOP], 1u);
            const unsigned tg = og / nx;
            if (og + 1u == (tg + 1u) * nx) xb_add(&bar[XB_TOPGEN], 1u);
            else XB_SPIN(xb_ld(&bar[XB_TOPGEN]) == tg, bar);
            __builtin_amdgcn_fence(__ATOMIC_ACQUIRE, "agent");
            xb_add(&bar[XB_XGEN(b.x)], 1u);
            asm volatile("s_waitcnt vmcnt(0)" ::: "memory");
        } else {
            XB_SPIN(xb_ld(&bar[XB_XGEN(b.x)]) == gen, bar);
            __builtin_amdgcn_fence(__ATOMIC_ACQUIRE, "agent");
            asm volatile("s_waitcnt vmcnt(0)" ::: "memory");
        }
    }
    __syncthreads();
}

#ifndef MK_LAUNCHES
#define MK_LAUNCHES 1
#endif
constexpr int NPH = 11;
#ifndef PROBE_REP
#define PROBE_REP 0
#endif
#define REP(k) if (((PROBE_REP) >> (k)) & 1) for (int _r = 0; _r < 2; ++_r, cg::this_grid().sync())
__global__ void __launch_bounds__(NTHR, 2) mega(Args a) {
    extern __shared__ __attribute__((aligned(16))) unsigned char lds[];
    const int tid = threadIdx.x, lane = tid & 63, wave = __builtin_amdgcn_readfirstlane(tid >> 6);
    const int G = gridDim.x, wg = blockIdx.x, gw = wg * NWAVES + wave, NGW = G * NWAVES;
    unsigned char* ws = a.ws;
    const int lo = a.ph_lo, hi = a.ph_hi;
    volatile LAS unsigned* bst = (volatile LAS unsigned*)((LAS unsigned char*)lds + LDS_BYTES - 64);
    if (tid < 2) bst[tid] = 0u;
    __syncthreads();
    XcdBarrier bar = xcd_barrier_post((unsigned*)(ws + WS_CTL) + 4096, bst);
#define IN(k) (lo <= (k) && (k) < hi)
#define SEAM(k) do { if (IN(k) && IN((k) + 1)) { if ((k) == 0) cg::this_grid().sync(); else xcd_barrier(bar); } } while (0)
    if (IN(0)) { REP(0) { phase_prep(a, lds, gw, NGW, lane, wave); } phase_prep(a, lds, gw, NGW, lane, wave); }
    SEAM(0);
    if (IN(1)) { pg8::Gemm g{(const bf16_t*)(ws + WS_XN), (const bf16_t*)(ws + WS_WIN), D}; SchedPlain Sc; Sc.init(M, PC, G, wg); Sc.rowbytes = D * 2;
        EpiInProj E{ws, (const float*)(ws + WS_ROPE)};
        pg8::gemm_phase<EpiInProj, SchedPlain, true>((LAS unsigned char*)lds, g, Sc, E); }
    SEAM(1);
    if (IN(2)) { REP(2) { phase_mix_a(a, lds, gw, NGW, lane, wave, tid); } phase_mix_a(a, lds, gw, NGW, lane, wave, tid); }
    SEAM(2);
    if (IN(3)) { REP(3) { phase_scan(a, wg * NTHR + tid, G * NTHR); } phase_scan(a, wg * NTHR + tid, G * NTHR); }
    SEAM(3);
    if (IN(4)) { REP(4) { phase_mix_b(a, lds, gw, NGW, lane, wave, tid, wg, G); } phase_mix_b(a, lds, gw, NGW, lane, wave, tid, wg, G); }
    SEAM(4);
    if (IN(5)) { pg8::Gemm g{(const bf16_t*)(ws + WS_XN), (const bf16_t*)(ws + WS_WOUT), D}; SchedPlain Sc; Sc.init(M, D, G, wg); Sc.rowbytes = D * 2;
        EpiOutProj E{a.in[IN_X], a.out};
        pg8::gemm_phase<EpiOutProj, SchedPlain, true>((LAS unsigned char*)lds, g, Sc, E); }
    SEAM(5);
    if (IN(6)) { REP(6) { phase_router(a, lds, gw, NGW, lane, tid); phase_latew(a, lds, gw, NGW, lane, wave); } phase_router(a, lds, gw, NGW, lane, tid); phase_latew(a, lds, gw, NGW, lane, wave); }
    SEAM(6);
    if (IN(7)) { REP(7) { phase_topk(a, lds, wg, G, tid, lane, wave); } phase_topk(a, lds, wg, G, tid, lane, wave); }
    SEAM(7);
    if (IN(8)) { pg8::Gemm g{(const bf16_t*)(ws + WS_XN), (const bf16_t*)(ws + WS_WGU), D}; SchedMoe1 Sc; Sc.init(MR, 4096, G, wg); Sc.idx = (const int*)(ws + WS_IDX);
        EpiSwiGLU E{(bf16_t*)(ws + WS_HID)};
        pg8::gemm_phase<EpiSwiGLU, SchedMoe1, true>((LAS unsigned char*)lds, g, Sc, E); }
    SEAM(8);
    if (IN(9)) { pg8::Gemm g{(const bf16_t*)(ws + WS_HID), (const bf16_t*)(ws + WS_WD), DFF}; SchedMoe2 Sc; Sc.init(MR, D, G, wg);
        EpiDown E{(bf16_t*)(ws + WS_Y)};
        pg8::gemm_phase<EpiDown, SchedMoe2, true>((LAS unsigned char*)lds, g, Sc, E); }
    SEAM(9);
    if (IN(10)) { phase_final(a, gw, NGW, lane); }
#undef IN
#undef SEAM
}

extern "C" void kernel_launch(void* const* d_in, const int* in_sizes, int n_in, void* d_out, int out_size, void* d_ws, size_t ws_size, hipStream_t stream) {
    static int grid = 0;
    if (grid == 0) {
        if (n_in != 13 || in_sizes[0] != M * D || out_size != M * D || ws_size < WS_END) { fprintf(stderr, "kernel_launch: unexpected shapes n_in %d in0 %d out %d ws %zu (need %zu)\n", n_in, n_in > 0 ? in_sizes[0] : -1, out_size, ws_size, (size_t)WS_END); grid = -1; return; }
        int dev = 0, cus = 0, per_cu = 0;
        (void)hipGetDevice(&dev); (void)hipDeviceGetAttribute(&cus, hipDeviceAttributeMultiprocessorCount, dev);
        (void)hipFuncSetAttribute((const void*)mega, hipFuncAttributeMaxDynamicSharedMemorySize, LDS_BYTES);
        if (hipOccupancyMaxActiveBlocksPerMultiprocessor(&per_cu, (const void*)mega, NTHR, LDS_BYTES) != hipSuccess || per_cu < 1) { fprintf(stderr, "kernel_launch: occupancy query says %d blocks/CU\n", per_cu); per_cu = 1; }
        (void)hipGetLastError();
        grid = cus * 1;
        if (grid > cus * per_cu) grid = cus * per_cu;
    }
    if (grid < 0) return;
    (void)hipMemsetAsync((char*)d_ws + WS_CTL, 0, 1 * MiB, stream);
    Args a{};
    for (int i = 0; i < 13; ++i) a.in[i] = (const float*)d_in[i];
    a.out = (float*)d_out; a.ws = (unsigned char*)d_ws;
#if MK_LAUNCHES == 1
    a.ph_lo = 0; a.ph_hi = NPH;
    void* args[] = {&a};
    hipError_t e = hipLaunchCooperativeKernel((const void*)mega, dim3(grid), dim3(NTHR), args, LDS_BYTES, stream);
    if (e != hipSuccess) fprintf(stderr, "cooperative launch failed: %s (grid %d)\n", hipGetErrorString(e), grid);
#else
    for (int p = 0; p < NPH; ++p) { a.ph_lo = p; a.ph_hi = p + 1; hipLaunchKernelGGL(mega, dim3(grid), dim3(NTHR), LDS_BYTES, stream, a); }
#endif
}
```

```cpp
#include <hip/hip_runtime.h>
#include <hip/hip_cooperative_groups.h>
#include <cstdint>
#include <cstdio>
namespace cg = cooperative_groups;

typedef unsigned short bf16_t;
#define DEV __device__ __forceinline__
#define LAS __attribute__((address_space(3)))

constexpr int NB = 8, S = 4096, D = 1024, M = NB * S;
constexpr int NH = 8, HD = 64, PC = 3584;
constexpr int NE = 16, CAP = 512, DFF = 2048, MR = NE * NB * CAP;
constexpr float EPS = 1e-6f, LOG2E = 1.4426950408889634f;
constexpr int NWAVES = 8, NTHR = 512;
constexpr int LDS_BYTES = 147456;

constexpr size_t MiB = 1u << 20;
constexpr size_t WS_CTL = 0;
constexpr size_t WS_ROPE = 1 * MiB;
constexpr size_t WS_BIAS = 2 * MiB;
constexpr size_t WS_IDX = 2 * MiB + 512 * 1024;
constexpr size_t WS_AFF = 3 * MiB;
constexpr size_t WS_INV = 5 * MiB;
constexpr size_t WS_AFFT = 9 * MiB;
constexpr size_t WS_WOUT = 7 * MiB;
constexpr size_t WS_WIN = 9 * MiB;
constexpr size_t WS_XN = 16 * MiB;
constexpr size_t WS_RQ = 80 * MiB, WS_RK = 112 * MiB, WS_RV = 144 * MiB, WS_RG = 176 * MiB;
constexpr size_t WS_AQ = 208 * MiB, WS_AK = 240 * MiB, WS_AV = 272 * MiB;
constexpr size_t WS_ATTO = 304 * MiB;
constexpr size_t WS_ATTL = 400 * MiB;
constexpr size_t WS_KF = 403 * MiB;
constexpr size_t WS_ST = 208 * MiB;
constexpr size_t WS_WD = 80 * MiB;
constexpr size_t WS_WGU = 144 * MiB;
constexpr size_t WS_Y = 144 * MiB;
constexpr size_t WS_HID = 272 * MiB;
constexpr size_t WS_END = 528 * MiB;

DEV unsigned f2bf(float f) { unsigned u = __float_as_uint(f); return (u + 0x7fffu + ((u >> 16) & 1u)) >> 16; }
DEV float bf2f(unsigned h) { return __uint_as_float(h << 16); }
DEV unsigned pk2(float lo, float hi) { return f2bf(lo) | (f2bf(hi) << 16); }
DEV float wave_sum(float v) {
#pragma unroll
    for (int o = 1; o < 64; o <<= 1) v += __shfl_xor(v, o);
    return v;
}
#define LDS_WAIT() asm volatile("s_waitcnt lgkmcnt(0)" ::: "memory")
namespace pg8 {
#define PG8_LAS __attribute__((address_space(3)))
typedef short bf16x8 __attribute__((ext_vector_type(8)));
typedef float f32x4 __attribute__((ext_vector_type(4)));
typedef unsigned u32x4 __attribute__((ext_vector_type(4)));
constexpr int BM = 256, BK = 64, HALF = 128, HTB = HALF * BK * 2, STAGE_BYTES = 8 * HTB, NXCD = 8, WGM = 8;
__host__ __device__ __forceinline__ int lds_byte(int r, int c) { const int st = (r >> 4) * 2 + (c >> 5), rr = r & 15, cc = c & 31, ob = rr * 64 + cc * 2; return st * 1024 + (ob ^ (((ob >> 9) & 1) << 5)); }
__host__ __device__ __forceinline__ void stage_rc(int b, int& R, int& C) { const int st = b / 1024, sb = b % 1024, swz = sb ^ (((sb >> 9) & 1) << 5); R = (st >> 1) * 16 + swz / 64; C = (st & 1) * 32 + (swz % 64) / 2; }
__host__ __device__ __forceinline__ int perm32(int rho) { const int n = rho >> 4, i = rho & 15; return 8 * (i >> 2) + 4 * n + (i & 3); }
struct Unit { int pm, pn; };
struct Gemm { const bf16_t* A; const bf16_t* Bt; int K; };
struct StaticOrder {
    int nM, nN, nwg, G, c;
    __device__ void init(int M_, int N_, int G_, int c_) { nM = M_ / BM; nN = N_ / BM; nwg = nM * nN; G = G_; c = c_; }
    __device__ bool next(int i, Unit& u) const {
        const long L = (long)i * G + c; if (L >= nwg) return false;
        int wgid = (int)L; { const int q = nwg / NXCD, r = nwg % NXCD, xcd = wgid % NXCD, off = wgid / NXCD; wgid = (xcd < r ? xcd * (q + 1) : r * (q + 1) + (xcd - r) * q) + off; }
        const int nig = WGM * nN, gid = wgid / nig, fm = gid * WGM, gsz = (nM - fm) < WGM ? (nM - fm) : WGM;
        u.pm = fm + ((wgid % nig) % gsz); u.pn = (wgid % nig) / gsz; return true;
    }
};
__device__ __forceinline__ unsigned cvt_pk_bf16(float lo, float hi) { unsigned r; asm volatile("v_cvt_pk_bf16_f32 %0, %1, %2" : "=v"(r) : "v"(lo), "v"(hi)); return r; }

typedef int v8i __attribute__((ext_vector_type(8)));
template <class Epi, class Sched, bool ALIGN_EPI, bool FP8 = false>
__device__ __forceinline__ void gemm_phase(PG8_LAS unsigned char* lds, const Gemm g, const Sched& S, const Epi& E) {
    const int tid = threadIdx.x, wid = __builtin_amdgcn_readfirstlane(tid >> 6), lane = tid & 63, wr = wid >> 2, wc = wid & 3, fr = lane & 15, fq = lane >> 4;
    const int K = g.K, RB = FP8 ? K : 2 * K, nt = RB / 128;
    unsigned voffB[2];
#pragma unroll
    for (int i = 0; i < 2; ++i) { int R, C; stage_rc(tid * 16 + i * 8192, R, C); const int Rb = Epi::PERM ? ((R & ~31) + perm32(R & 31)) : R;
        voffB[i] = (unsigned)(Rb * RB + C * 2); }
    const size_t kstep = (size_t)(BK * 2);
    const size_t hstep = (size_t)HALF * RB;
    const size_t tstep = 2 * hstep;
    const unsigned ldsw = (unsigned)wid * 1024u;
    const int aoff = FP8 ? lds_byte(wr * 64 + fr, fq * 16) : lds_byte(wr * 64 + fr, fq * 8), boff = FP8 ? lds_byte(wc * 32 + fr, fq * 16) : lds_byte(wc * 32 + fr, fq * 8);
    const int x16 = 16 * (fq & 1);
    const char* gA = (const char*)g.A;
#define PG8_SA(b, h) (((b) * 2 + (h)) * HTB)
#define PG8_SB(b, h) ((4 + (b) * 2 + (h)) * HTB)
#define PG8_STAGE(bufoff, gbase, voff) do { _Pragma("unroll") for (int _i = 0; _i < 2; ++_i) \
        __builtin_amdgcn_global_load_lds((const unsigned*)((const char*)(gbase) + (voff)[_i]), (PG8_LAS unsigned*)(lds + (bufoff) + ldsw + _i * 8192), 16, 0, 0); } while (0)
#define PG8_STAGE_A(bufoff, AO, h, kb) do { _Pragma("unroll") for (int _i = 0; _i < 2; ++_i) \
        __builtin_amdgcn_global_load_lds((const unsigned*)(gA + (size_t)((AO)[h][_i] + (unsigned)(kb))), (PG8_LAS unsigned*)(lds + (bufoff) + ldsw + _i * 8192), 16, 0, 0); } while (0)
#define PG8_LDA(dst, b, h) do { if constexpr (FP8) { _Pragma("unroll") for (int m = 0; m < 4; ++m) { dst[m][0] = *(const PG8_LAS bf16x8*)(lds + PG8_SA(b, h) + aoff + m * 2048 + x16); dst[m][1] = *(const PG8_LAS bf16x8*)(lds + PG8_SA(b, h) + aoff + m * 2048 + 16 - x16); } } \
    else { _Pragma("unroll") for (int m = 0; m < 4; ++m) _Pragma("unroll") for (int k = 0; k < 2; ++k) dst[m][k] = *(const PG8_LAS bf16x8*)(lds + PG8_SA(b, h) + aoff + m * 2048 + k * 1024); } } while (0)
#define PG8_LDB(dst, b, h) do { if constexpr (FP8) { _Pragma("unroll") for (int n = 0; n < 2; ++n) { dst[n][0] = *(const PG8_LAS bf16x8*)(lds + PG8_SB(b, h) + boff + n * 2048 + x16); dst[n][1] = *(const PG8_LAS bf16x8*)(lds + PG8_SB(b, h) + boff + n * 2048 + 16 - x16); } } \
    else { _Pragma("unroll") for (int n = 0; n < 2; ++n) _Pragma("unroll") for (int k = 0; k < 2; ++k) dst[n][k] = *(const PG8_LAS bf16x8*)(lds + PG8_SB(b, h) + boff + n * 2048 + k * 1024); } } while (0)
#define PG8_CAT8(x) __builtin_bit_cast(v8i, __builtin_shufflevector((x)[0], (x)[1], 0, 1, 2, 3, 4, 5, 6, 7, 8, 9, 10, 11, 12, 13, 14, 15))
#define PG8_MMA(ai, bj, At, Bt) do { __builtin_amdgcn_s_setprio(1); if constexpr (FP8) { _Pragma("unroll") for (int m = 0; m < 4; ++m) _Pragma("unroll") for (int n = 0; n < 2; ++n) \
        acc[ai][bj][m][n] = __builtin_amdgcn_mfma_scale_f32_16x16x128_f8f6f4(PG8_CAT8(Bt[n]), PG8_CAT8(At[m]), acc[ai][bj][m][n], 0, 0, 0, 0x7F7F7F7F, 0, 0x7F7F7F7F); } \
    else { _Pragma("unroll") for (int m = 0; m < 4; ++m) _Pragma("unroll") for (int n = 0; n < 2; ++n) _Pragma("unroll") for (int k = 0; k < 2; ++k) \
        acc[ai][bj][m][n] = __builtin_amdgcn_mfma_f32_16x16x32_bf16(Bt[n][k], At[m][k], acc[ai][bj][m][n], 0, 0, 0); } __builtin_amdgcn_s_setprio(0); } while (0)
#define PG8_WAIT_V(n) asm volatile("s_waitcnt vmcnt(" #n ")" ::: "memory")
#define PG8_WAIT_L(n) asm volatile("s_waitcnt lgkmcnt(" #n ")" ::: "memory")
#define PG8_BAR __builtin_amdgcn_s_barrier()
#define PG8_SCHED __builtin_amdgcn_sched_barrier(0)
#define PG8_AOFFS(AO, u) do { int _t = threadIdx.x; asm volatile("" : "+v"(_t)); _Pragma("unroll") for (int _i = 0; _i < 2; ++_i) { int _R, _C; stage_rc(_t * 16 + _i * 8192, _R, _C); \
        _Pragma("unroll") for (int _h = 0; _h < 2; ++_h) (AO)[_h][_i] = S.row_off(u, _h * HALF + _R) + (unsigned)(_C * 2); } } while (0)
    Unit cur, nxt; int ui = 0;
    if (!S.next(0, cur)) return;
    f32x4 acc[2][2][4][2];
#pragma unroll
    for (int a = 0; a < 2; ++a)
#pragma unroll
        for (int b = 0; b < 2; ++b)
#pragma unroll
            for (int m = 0; m < 4; ++m)
#pragma unroll
                for (int n = 0; n < 2; ++n) acc[a][b][m][n] = (f32x4){0.f, 0.f, 0.f, 0.f};
    bf16x8 At[4][2], B0[2][2], B1[2][2];
    unsigned aoc[2][2], aon[2][2];
    PG8_AOFFS(aoc, cur);
    const char* cB = (const char*)g.Bt + (size_t)cur.pn * tstep;
    PG8_STAGE(PG8_SB(0, 0), cB, voffB); PG8_STAGE(PG8_SB(0, 1), cB + hstep, voffB); PG8_STAGE_A(PG8_SA(0, 0), aoc, 0, 0); PG8_STAGE_A(PG8_SA(0, 1), aoc, 1, 0);
    if (wr == 1) PG8_BAR;
    PG8_WAIT_V(2); PG8_BAR;
    PG8_STAGE(PG8_SB(1, 0), cB + kstep, voffB); PG8_STAGE_A(PG8_SA(1, 0), aoc, 0, 128); PG8_STAGE(PG8_SB(1, 1), cB + hstep + kstep, voffB);
    PG8_WAIT_V(6); PG8_BAR;
    for (;;) {
        const bool has_next = S.next(ui + 1, nxt);
        const char* nB = cB;
        if (has_next) { PG8_AOFFS(aon, nxt); nB = (const char*)g.Bt + (size_t)nxt.pn * tstep; }
        else {
#pragma unroll
            for (int _h = 0; _h < 2; ++_h)
#pragma unroll
                for (int _i = 0; _i < 2; ++_i) aon[_h][_i] = aoc[_h][_i]; }
#pragma nounroll
        for (int t = 0; t < nt; t += 2) {
            const bool last = (t == nt - 2);
            const unsigned k1 = (unsigned)(t + 1) * 128u, k2 = last ? 0u : (unsigned)(t + 2) * 128u, k3 = k2 + 128u;
            const char* b2 = last ? nB : cB + (size_t)(t + 2) * kstep; const char* b3 = b2 + kstep;
            PG8_LDB(B0, 0, 0); PG8_LDB(B1, 0, 1); PG8_SCHED; PG8_LDA(At, 0, 0); PG8_STAGE_A(PG8_SA(1, 1), aoc, 1, k1);
            PG8_WAIT_V(8); PG8_WAIT_L(0); PG8_BAR; PG8_MMA(0, 0, At, B0); PG8_MMA(0, 1, At, B1); PG8_BAR; PG8_SCHED;
            if (last) {
#pragma unroll
                for (int _h = 0; _h < 2; ++_h)
#pragma unroll
                    for (int _i = 0; _i < 2; ++_i) aoc[_h][_i] = aon[_h][_i]; }
            PG8_LDA(At, 0, 1); PG8_STAGE(PG8_SB(0, 0), b2, voffB); PG8_STAGE(PG8_SB(0, 1), b2 + hstep, voffB); PG8_STAGE_A(PG8_SA(0, 0), aoc, 0, k2);
            PG8_WAIT_V(8); PG8_WAIT_L(0); PG8_BAR; PG8_MMA(1, 0, At, B0); PG8_MMA(1, 1, At, B1); PG8_BAR; PG8_SCHED;
            PG8_LDB(B0, 1, 0); PG8_LDB(B1, 1, 1); PG8_SCHED; PG8_LDA(At, 1, 0); PG8_STAGE_A(PG8_SA(0, 1), aoc, 1, k2);
            PG8_WAIT_V(8); PG8_WAIT_L(0); PG8_BAR; PG8_MMA(0, 0, At, B0); PG8_MMA(0, 1, At, B1); PG8_BAR; PG8_SCHED;
            PG8_LDA(At, 1, 1); PG8_STAGE(PG8_SB(1, 0), b3, voffB); PG8_STAGE(PG8_SB(1, 1), b3 + hstep, voffB); PG8_STAGE_A(PG8_SA(1, 0), aoc, 0, k3);
            PG8_WAIT_V(8); PG8_WAIT_L(0); PG8_BAR; PG8_MMA(1, 0, At, B0); PG8_MMA(1, 1, At, B1); PG8_BAR; PG8_SCHED;
        }
        if constexpr (ALIGN_EPI) { if (wr == 0) PG8_BAR; }
        { int t2 = threadIdx.x; asm volatile("" : "+v"(t2));
          const int w2 = __builtin_amdgcn_readfirstlane(t2 >> 6), l2 = t2 & 63; E(acc, cur, w2 >> 2, w2 & 3, l2 & 15, l2 >> 4); }
        if (!has_next) break;
#pragma unroll
        for (int a = 0; a < 2; ++a)
#pragma unroll
            for (int b = 0; b < 2; ++b)
#pragma unroll
                for (int m = 0; m < 4; ++m)
#pragma unroll
                    for (int n = 0; n < 2; ++n) acc[a][b][m][n] = (f32x4){0.f, 0.f, 0.f, 0.f};
        cur = nxt; cB = nB; ++ui;
        if constexpr (ALIGN_EPI) { if (wr == 1) PG8_BAR; }
    }
    PG8_WAIT_V(0);
    if constexpr (!ALIGN_EPI) { if (wr == 0) PG8_BAR; }
    PG8_BAR;
#undef PG8_SA
#undef PG8_SB
#undef PG8_STAGE
#undef PG8_STAGE_A
#undef PG8_LDA
#undef PG8_LDB
#undef PG8_MMA
#undef PG8_CAT8
#undef PG8_WAIT_V
#undef PG8_WAIT_L
#undef PG8_BAR
#undef PG8_SCHED
#undef PG8_AOFFS
}
}
struct SchedPlain : pg8::StaticOrder {
    unsigned rowbytes;
    DEV unsigned row_off(const pg8::Unit& u, int r) const { return (unsigned)(u.pm * 256 + r) * rowbytes; }
};
struct SchedMoe1 : pg8::StaticOrder {
    const int* idx;
    DEV bool next(int i, pg8::Unit& u) const { if (!pg8::StaticOrder::next(i, u)) return false; u.pn += (u.pm >> 4) * 16; return true; }
    DEV unsigned row_off(const pg8::Unit& u, int r) const { const int g = u.pm * 256 + r; const int tok = ((g >> 9) & 7) * S + idx[g]; return (unsigned)tok * (unsigned)D; }
};
struct SchedMoe2 : pg8::StaticOrder {
    DEV bool next(int i, pg8::Unit& u) const { if (!pg8::StaticOrder::next(i, u)) return false; u.pn += (u.pm >> 4) * 4; return true; }
    DEV unsigned row_off(const pg8::Unit& u, int r) const { return (unsigned)(u.pm * 256 + r) * (unsigned)DFF; }
};
typedef pg8::f32x4 f32x4; typedef pg8::u32x4 u32x4;
struct EpiInProj {
    static constexpr bool PERM = true;
    unsigned char* ws; const float* ropeT;
    DEV void operator()(const f32x4 (&acc)[2][2][4][2], const pg8::Unit& u, int wr, int wc, int fr, int fq) const {
        const int grp = u.pn >> 1;
        bf16_t* gbase = (bf16_t*)(ws + WS_RQ + (size_t)grp * 32 * MiB);
        const float sc = (grp == 1) ? 0.125f : (grp == 4 ? 0.125f * LOG2E : 1.f);
#pragma unroll
        for (int ai = 0; ai < 2; ++ai)
#pragma unroll
            for (int m = 0; m < 4; ++m) {
                const int row = u.pm * 256 + ai * 128 + wr * 64 + m * 16 + fr, b = row >> 12, s = row & 4095;
#pragma unroll
                for (int bj = 0; bj < 2; ++bj) {
                    const int hd = 4 * (u.pn & 1) + 2 * bj + (wc >> 1), j0 = 32 * (wc & 1) + 8 * fq;
                    f32x4 lo = acc[ai][bj][m][0], hi = acc[ai][bj][m][1];
                    if (grp < 2) {
                        const f32x4 c = *(const f32x4*)(ropeT + s * 32 + (j0 >> 1)), sn = *(const f32x4*)(ropeT + S * 32 + s * 32 + (j0 >> 1));
                        const f32x4 l2 = lo * c - hi * sn, h2 = hi * c + lo * sn; lo = l2; hi = h2;
                    }
                    lo = lo * sc; hi = hi * sc;
                    u32x4 w; w.x = pg8::cvt_pk_bf16(lo[0], lo[1]); w.y = pg8::cvt_pk_bf16(lo[2], lo[3]); w.z = pg8::cvt_pk_bf16(hi[0], hi[1]); w.w = pg8::cvt_pk_bf16(hi[2], hi[3]);
                    *(u32x4*)(gbase + ((size_t)(b * NH + hd) * S + s) * HD + j0) = w;
                }
            }
    }
};
struct EpiOutProj {
    static constexpr bool PERM = true;
    const float* x; float* x1;
    DEV void operator()(const f32x4 (&acc)[2][2][4][2], const pg8::Unit& u, int wr, int wc, int fr, int fq) const {
#pragma unroll
        for (int ai = 0; ai < 2; ++ai)
#pragma unroll
            for (int m = 0; m < 4; ++m) {
                const int row = u.pm * 256 + ai * 128 + wr * 64 + m * 16 + fr;
#pragma unroll
                for (int bj = 0; bj < 2; ++bj) { const size_t off = (size_t)row * D + u.pn * 256 + bj * 128 + wc * 32 + 8 * fq;
                    const f32x4 a = *(const f32x4*)(x + off), b = *(const f32x4*)(x + off + 4);
                    *(f32x4*)(x1 + off) = a + acc[ai][bj][m][0]; *(f32x4*)(x1 + off + 4) = b + acc[ai][bj][m][1]; }
            }
    }
};
DEV unsigned pk4_fp8e(float a, float b, float c, float d) { unsigned w = 0u; w = __builtin_amdgcn_cvt_pk_fp8_f32(a, b, w, false); w = __builtin_amdgcn_cvt_pk_fp8_f32(c, d, w, true); return w; }
struct EpiSwiGLU {
    static constexpr bool PERM = true;
    unsigned char* hid;
    DEV void operator()(const f32x4 (&acc)[2][2][4][2], const pg8::Unit& u, int wr, int wc, int fr, int fq) const {
        const int pnl = u.pn & 15;
#pragma unroll
        for (int ai = 0; ai < 2; ++ai)
#pragma unroll
            for (int m = 0; m < 4; ++m) {
                const int row = u.pm * 256 + ai * 128 + wr * 64 + m * 16 + fr;
                float o[8];
#pragma unroll
                for (int n = 0; n < 2; ++n)
#pragma unroll
                    for (int i = 0; i < 4; ++i) { const float gt = acc[ai][0][m][n][i] * (1.f / 32.f), up = acc[ai][1][m][n][i] * (1.f / 32.f);
                        o[4 * n + i] = gt * __builtin_amdgcn_rcpf(1.f + __builtin_amdgcn_exp2f(-gt * LOG2E)) * up; }
                *(uint2*)(hid + (size_t)row * DFF + pnl * 128 + wc * 32 + 8 * fq) = make_uint2(pk4_fp8e(o[0], o[1], o[2], o[3]), pk4_fp8e(o[4], o[5], o[6], o[7]));
            }
    }
};
struct EpiDown {
    static constexpr bool PERM = true;
    bf16_t* y;
    DEV void operator()(const f32x4 (&acc)[2][2][4][2], const pg8::Unit& u, int wr, int wc, int fr, int fq) const {
        const int pnl = u.pn & 3;
#pragma unroll
        for (int ai = 0; ai < 2; ++ai)
#pragma unroll
            for (int m = 0; m < 4; ++m) {
                const int row = u.pm * 256 + ai * 128 + wr * 64 + m * 16 + fr;
#pragma unroll
                for (int bj = 0; bj < 2; ++bj) { const f32x4 lo = acc[ai][bj][m][0] * (1.f / 32.f), hi = acc[ai][bj][m][1] * (1.f / 32.f);
                    u32x4 w; w.x = pg8::cvt_pk_bf16(lo[0], lo[1]); w.y = pg8::cvt_pk_bf16(lo[2], lo[3]); w.z = pg8::cvt_pk_bf16(hi[0], hi[1]); w.w = pg8::cvt_pk_bf16(hi[2], hi[3]);
                    *(u32x4*)(y + (size_t)row * D + pnl * 256 + bj * 128 + wc * 32 + 8 * fq) = w; }
            }
    }
};
struct Args { const float* in[13]; float* out; unsigned char* ws; int ph_lo, ph_hi; };
enum { IN_X = 0, IN_G1, IN_WIN, IN_DECAY, IN_GN, IN_RELB, IN_WOUT, IN_G2, IN_WR, IN_WG, IN_WU, IN_WDN, IN_FG };

struct TrItem { const float* src; bf16_t* dst; int K, N, k0, n0, mode, fp8; };
DEV unsigned pk4_fp8(float a, float b, float c, float d) { unsigned w = 0u; w = __builtin_amdgcn_cvt_pk_fp8_f32(a, b, w, false); w = __builtin_amdgcn_cvt_pk_fp8_f32(c, d, w, true); return w; }
DEV void tr_load(const TrItem& t, f32x4 (&v)[16], int lane) {
#pragma unroll
    for (int i = 0; i < 16; ++i) { const int kk = (lane >> 4) + 4 * i, c = (lane & 15) * 4; v[i] = *(const f32x4*)(t.src + (size_t)(t.k0 + kk) * t.N + t.n0 + c); }
}
DEV int rowmap_rt(int mode, int n) {
    if (mode == 0) return n;
    if (mode == 1) { if (n >= 1024) return n; const int base = n & ~63, d = n & 63, nn = d >> 5, dd = d & 31; return base + 8 * (dd >> 2) + 4 * nn + (dd & 3); }
    return (n >> 7) * 256 + (mode == 3 ? 128 : 0) + (n & 127);
}
DEV void tr_finish(const TrItem& t, const f32x4 (&v)[16], LAS float* scr, int lane) {
#pragma unroll
    for (int i = 0; i < 16; ++i) { const int kk = (lane >> 4) + 4 * i, c = (lane & 15) * 4;
        scr[kk * 65 + c] = v[i][0]; scr[kk * 65 + c + 1] = v[i][1]; scr[kk * 65 + c + 2] = v[i][2]; scr[kk * 65 + c + 3] = v[i][3]; }
    LDS_WAIT();
#pragma unroll
    for (int i = 0; i < 8; ++i) { const int n = (lane >> 3) + 8 * i, c = (lane & 7) * 8; const LAS float* sp = scr + c * 65 + n;
        if (t.fp8) {
            const unsigned lo = pk4_fp8(sp[0] * 32.f, sp[65] * 32.f, sp[2 * 65] * 32.f, sp[3 * 65] * 32.f), hi = pk4_fp8(sp[4 * 65] * 32.f, sp[5 * 65] * 32.f, sp[6 * 65] * 32.f, sp[7 * 65] * 32.f);
            *(uint2*)((unsigned char*)t.dst + (size_t)rowmap_rt(t.mode, t.n0 + n) * t.K + t.k0 + c) = make_uint2(lo, hi);
        } else {
        u32x4 o; o.x = pk2(sp[0], sp[65]); o.y = pk2(sp[2 * 65], sp[3 * 65]); o.z = pk2(sp[4 * 65], sp[5 * 65]); o.w = pk2(sp[6 * 65], sp[7 * 65]);
        *(u32x4*)(t.dst + (size_t)rowmap_rt(t.mode, t.n0 + n) * t.K + t.k0 + c) = o; } }
    LDS_WAIT();
}
template <class Dec> DEV void tr_run(const Dec& dec, int nitems, int gw, int NGW, LAS float* scr, int lane) {
    int it = gw; if (it >= nitems) return;
    TrItem cur, nxt; f32x4 va[16], vb[16];
    dec(it, cur); tr_load(cur, va, lane);
    for (;;) {
        const int n1 = it + NGW; const bool h1 = n1 < nitems;
        if (h1) { dec(n1, nxt); tr_load(nxt, vb, lane); }
        tr_finish(cur, va, scr, lane);
        if (!h1) break;
        const int n2 = n1 + NGW; const bool h2 = n2 < nitems;
        if (h2) { dec(n2, cur); tr_load(cur, va, lane); }
        tr_finish(nxt, vb, scr, lane);
        if (!h2) break;
        it = n2;
    }
}
DEV void rms_row_to_bf16(const float* xrow, const float* g, bf16_t* orow, int lane) {
    const float4* xr = (const float4*)xrow + lane;
    float4 v[4]; float s = 0.f;
#pragma unroll
    for (int j = 0; j < 4; ++j) { v[j] = xr[64 * j]; s += v[j].x * v[j].x + v[j].y * v[j].y + v[j].z * v[j].z + v[j].w * v[j].w; }
    const float rs = rsqrtf(wave_sum(s) * (1.f / D) + EPS);
    uint2* o = (uint2*)orow + lane;
#pragma unroll
    for (int j = 0; j < 4; ++j) { const float4 gg = ((const float4*)g)[lane + 64 * j];
        o[64 * j] = make_uint2(pk2(v[j].x * rs * gg.x, v[j].y * rs * gg.y), pk2(v[j].z * rs * gg.z, v[j].w * rs * gg.w)); }
}
DEV void phase_prep(const Args& a, unsigned char* lds, int gw, int NGW, int lane, int wave) {
    unsigned char* ws = a.ws;
    float* ropeT = (float*)(ws + WS_ROPE); float* biasT = (float*)(ws + WS_BIAS);
    for (int t = gw * 64 + lane; t < S * 32; t += NGW * 64) {
        const int pos = t >> 5, i = t & 31; const double inv = pow(10000.0, -(double)i / 32.0), ang = (double)pos * inv;
        ropeT[t] = (float)cos(ang); ropeT[S * 32 + t] = (float)sin(ang);
        if (t < 3 * NH * 129) { const int p = t / (NH * 129), h = (t / 129) % NH, o = t % 129 - 64, dil = p == 0 ? 1 : (p == 1 ? 4 : 16), rel = o * dil, n = rel < 0 ? -rel : rel;
            int bucket = rel > 0 ? 16 : 0;
            if (n < 8) bucket += n; else { int large = 8 + (int)(log((double)n / 8.0) / log(128.0) * 8.0); if (large > 15) large = 15; bucket += large; }
            biasT[t] = a.in[IN_RELB][bucket * NH + h] * LOG2E; }
    }
    LAS float* scr = (LAS float*)((LAS unsigned char*)lds + wave * 16640);
    constexpr int I_IN = (D / 64) * (PC / 64), I_OUT = (D / 64) * (D / 64);
    { const float* w_in = a.in[IN_WIN]; const float* w_out = a.in[IN_WOUT]; bf16_t* Win = (bf16_t*)(ws + WS_WIN); bf16_t* Wout = (bf16_t*)(ws + WS_WOUT);
      auto dec = [=](int it, TrItem& t) { if (it < I_IN) { t.src = w_in; t.dst = Win; t.K = D; t.N = PC; t.k0 = (it / (PC / 64)) * 64; t.n0 = (it % (PC / 64)) * 64; t.mode = 1; t.fp8 = 0; }
          else { const int r = it - I_IN; t.src = w_out; t.dst = Wout; t.K = D; t.N = D; t.k0 = (r / (D / 64)) * 64; t.n0 = (r % (D / 64)) * 64; t.mode = 0; t.fp8 = 0; } };
      tr_run(dec, I_IN + I_OUT, gw, NGW, scr, lane); }
    for (int m = gw; m < M; m += NGW) rms_row_to_bf16(a.in[IN_X] + (size_t)m * D, a.in[IN_G1], (bf16_t*)(ws + WS_XN) + (size_t)m * D, lane);
}
DEV void phase_latew(const Args& a, unsigned char* lds, int gw, int NGW, int lane, int wave) {
    unsigned char* ws = a.ws; LAS float* scr = (LAS float*)((LAS unsigned char*)lds + wave * 16640);
    constexpr int I_G = (D / 64) * (DFF / 64);
    const float* wg_ = a.in[IN_WG]; const float* wu_ = a.in[IN_WU]; const float* wd_ = a.in[IN_WDN]; bf16_t* Wgu = (bf16_t*)(ws + WS_WGU); bf16_t* Wd = (bf16_t*)(ws + WS_WD);
    auto dec = [=](int it, TrItem& t) { const int which = it / (NE * I_G), r = it % (NE * I_G), e = r / I_G, q = r % I_G;
        t.fp8 = 1;
        if (which < 2) { t.src = (which == 0 ? wg_ : wu_) + (size_t)e * D * DFF; t.dst = (bf16_t*)((unsigned char*)Wgu + (size_t)e * 4096 * D); t.K = D; t.N = DFF; t.k0 = (q / (DFF / 64)) * 64; t.n0 = (q % (DFF / 64)) * 64; t.mode = 2 + which; }
        else { t.src = wd_ + (size_t)e * DFF * D; t.dst = (bf16_t*)((unsigned char*)Wd + (size_t)e * D * DFF); t.K = DFF; t.N = D; t.k0 = (q / (D / 64)) * 64; t.n0 = (q % (D / 64)) * 64; t.mode = 0; } };
    tr_run(dec, 3 * NE * I_G, gw, NGW, scr, lane);
}
DEV void phase_router(const Args& a, unsigned char* lds, int gw, int NGW, int lane, int tid) {
    unsigned char* ws = a.ws; const float* x1 = a.out; const float* g2 = a.in[IN_G2]; const float* wr = a.in[IN_WR];
    bf16_t* H2b = (bf16_t*)(ws + WS_XN); float* aff = (float*)(ws + WS_AFF); float* affT = (float*)(ws + WS_AFFT); int* inv = (int*)(ws + WS_INV);
    LAS f32x4* wl = (LAS f32x4*)(LAS unsigned char*)lds;
    for (int i = tid; i < D * 4; i += NTHR) { const int k = i >> 2, c = i & 3, slot = (k & 3) * 256 + (k >> 2); wl[slot * 4 + ((c + (slot >> 2)) & 3)] = *(const f32x4*)(wr + (size_t)k * NE + 4 * c); }
    __syncthreads();
    for (int row = gw; row < M; row += NGW) {
        const float4* xr = (const float4*)(x1 + (size_t)row * D) + lane;
        float4 v[4]; float s = 0.f;
#pragma unroll
        for (int j = 0; j < 4; ++j) { v[j] = xr[64 * j]; s += v[j].x * v[j].x + v[j].y * v[j].y + v[j].z * v[j].z + v[j].w * v[j].w; }
        const float rs = rsqrtf(wave_sum(s) * (1.f / D) + EPS);
        f32x4 lg[4];
#pragma unroll
        for (int c = 0; c < 4; ++c) lg[c] = (f32x4){0.f, 0.f, 0.f, 0.f};
        unsigned* o = (unsigned*)((unsigned char*)H2b + (size_t)row * D) + lane;
#pragma unroll
        for (int j = 0; j < 4; ++j) { const float4 gg = ((const float4*)g2)[lane + 64 * j];
            const float hv[4] = {v[j].x * rs * gg.x, v[j].y * rs * gg.y, v[j].z * rs * gg.z, v[j].w * rs * gg.w};
            o[64 * j] = pk4_fp8(hv[0], hv[1], hv[2], hv[3]);
#pragma unroll
            for (int t = 0; t < 4; ++t) { const int slot = t * 256 + lane + 64 * j, rot = (lane >> 2) & 3;
#pragma unroll
                for (int c = 0; c < 4; ++c) lg[c] += hv[t] * wl[slot * 4 + ((c + rot) & 3)];
                __builtin_amdgcn_sched_barrier(0); } }
        float l16[16]; float mx = -1e30f;
#pragma unroll
        for (int e = 0; e < 16; ++e) { l16[e] = wave_sum(lg[e >> 2][e & 3]); mx = fmaxf(mx, l16[e]); }
        float sum = 0.f;
#pragma unroll
        for (int e = 0; e < 16; ++e) { l16[e] = __expf(l16[e] - mx); sum += l16[e]; }
        const float is = 1.f / sum;
        if (lane < 16) { float av = 0.f;
#pragma unroll
            for (int e = 0; e < 16; ++e) av = lane == e ? l16[e] * is : av;
            aff[(size_t)row * NE + lane] = av; inv[(size_t)row * NE + lane] = -1; affT[((size_t)(row >> 12) * NE + lane) * S + (row & 4095)] = av; }
    }
    __syncthreads();
}
DEV void phase_topk(const Args& a, unsigned char* lds, int wg, int G, int tid, int lane, int wave) {
    unsigned char* ws = a.ws; const float* affT = (const float*)(ws + WS_AFFT); int* idx = (int*)(ws + WS_IDX); int* inv = (int*)(ws + WS_INV);
    LAS unsigned* hist = (LAS unsigned*)(LAS unsigned char*)lds; LAS unsigned* wsum = hist + 256; LAS unsigned* bc = hist + 272;
    for (int it = wg; it < NE * NB; it += G) {
        const int e = it & 15, b = it >> 4;
        unsigned u[8];
        { const uint4* src = (const uint4*)(affT + ((size_t)b * NE + e) * S + 8 * tid); const uint4 p = src[0], q = src[1]; u[0] = p.x; u[1] = p.y; u[2] = p.z; u[3] = p.w; u[4] = q.x; u[5] = q.y; u[6] = q.z; u[7] = q.w; }
        unsigned prefix = 0u, kk = CAP;
#pragma unroll
        for (int pass = 0; pass < 4; ++pass) {
            const int shift = 24 - 8 * pass;
            __syncthreads();
            if (tid < 256) hist[tid] = 0u;
            __syncthreads();
#pragma unroll
            for (int j = 0; j < 8; ++j) if (pass == 0 || (u[j] >> (shift + 8)) == prefix) atomicAdd((unsigned*)&hist[(u[j] >> shift) & 255u], 1u);
            __syncthreads();
            if (wave == 0) {
                const unsigned c0 = hist[4 * lane], c1 = hist[4 * lane + 1], c2 = hist[4 * lane + 2], c3 = hist[4 * lane + 3], tot = c0 + c1 + c2 + c3;
                unsigned incl = tot;
#pragma unroll
                for (int o = 1; o < 64; o <<= 1) { const unsigned t = __shfl_down(incl, o); if (lane + o < 64) incl += t; }
                const unsigned excl = incl - tot;
                if (excl < kk && kk <= incl) { unsigned acc = excl; int bin;
                    if (acc + c3 >= kk) bin = 3; else { acc += c3; if (acc + c2 >= kk) bin = 2; else { acc += c2; if (acc + c1 >= kk) bin = 1; else { acc += c1; bin = 0; } } }
                    bc[0] = 4 * lane + bin; bc[1] = kk - acc; }
            }
            __syncthreads();
            prefix = (prefix << 8) | bc[0]; kk = bc[1];
        }
        const unsigned T = prefix, need = kk;
        unsigned cg_ = 0u, ce = 0u;
#pragma unroll
        for (int j = 0; j < 8; ++j) { cg_ += u[j] > T; ce += u[j] == T; }
        unsigned pk = cg_ | (ce << 16), incl = pk;
#pragma unroll
        for (int o = 1; o < 64; o <<= 1) { const unsigned t = __shfl_up(incl, o); if (lane >= o) incl += t; }
        if (lane == 63) wsum[wave] = incl;
        __syncthreads();
        unsigned base = 0u;
#pragma unroll
        for (int w = 0; w < NWAVES; ++w) base += w < wave ? wsum[w] : 0u;
        const unsigned ex = base + incl - pk; unsigned gtb = ex & 0xffffu, eqb = ex >> 16;
#pragma unroll
        for (int j = 0; j < 8; ++j) { const bool g = u[j] > T, q = u[j] == T; const unsigned slot = gtb + (eqb < need ? eqb : need);
            if (g || (q && eqb < need)) { const int s = 8 * tid + j; idx[(e * NB + b) * CAP + slot] = s; inv[((size_t)b * S + s) * NE + e] = (int)slot; }
            gtb += g; eqb += q; }
    }
}
DEV void phase_final(const Args& a, int gw, int NGW, int lane) {
    unsigned char* ws = a.ws; float* xo = a.out; const float* aff = (const float*)(ws + WS_AFF); const int* inv = (const int*)(ws + WS_INV); const bf16_t* y = (const bf16_t*)(ws + WS_Y); const float* fg = a.in[IN_FG];
    for (int row = gw; row < M; row += NGW) {
        const int b = row >> 12;
        float4* xr = (float4*)(xo + (size_t)row * D) + lane;
        float4 v[4];
#pragma unroll
        for (int j = 0; j < 4; ++j) v[j] = xr[64 * j];
        for (int e = 0; e < NE; ++e) { const int sl = inv[(size_t)row * NE + e]; if (sl < 0) continue;
            const float g = aff[(size_t)row * NE + e]; const uint2* yr = (const uint2*)(y + ((size_t)e * 4096 + b * CAP + sl) * D) + lane;
#pragma unroll
            for (int j = 0; j < 4; ++j) { const uint2 w = yr[64 * j]; v[j].x += g * bf2f(w.x & 0xffffu); v[j].y += g * bf2f(w.x >> 16); v[j].z += g * bf2f(w.y & 0xffffu); v[j].w += g * bf2f(w.y >> 16); } }
        float s = 0.f;
#pragma unroll
        for (int j = 0; j < 4; ++j) s += v[j].x * v[j].x + v[j].y * v[j].y + v[j].z * v[j].z + v[j].w * v[j].w;
        const float rs = rsqrtf(wave_sum(s) * (1.f / D) + EPS);
#pragma unroll
        for (int j = 0; j < 4; ++j) { const float4 gg = ((const float4*)fg)[lane + 64 * j]; xr[64 * j] = make_float4(v[j].x * rs * gg.x, v[j].y * rs * gg.y, v[j].z * rs * gg.z, v[j].w * rs * gg.w); }
    }
}
typedef short bf16x8 __attribute__((ext_vector_type(8)));
typedef float f32x16 __attribute__((ext_vector_type(16)));
typedef short s16x4 __attribute__((ext_vector_type(4)));
typedef LAS const char* lds_cptr;
constexpr int VROW = 192;
constexpr int VSLOT = 32 * VROW;
constexpr int MIX_WAVE_LDS = 2 * VSLOT;
constexpr int MIX_BIAS_OFF = NWAVES * MIX_WAVE_LDS;
DEV int crow(int r, int hi) { return (r & 3) + 8 * (r >> 2) + 4 * hi; }
DEV s16x4 vtr(lds_cptr p) { return __builtin_bit_cast(s16x4, __builtin_amdgcn_ds_read_tr16_b64_v4i16((LAS s16x4*)p)); }
DEV bf16x8 tr_frag(lds_cptr slot, int s, int blk, int lane) {
    const int h = lane >> 5; lds_cptr p = slot + (16 * s + 4 * h + ((lane & 15) >> 2)) * VROW + (32 * blk + 16 * ((lane >> 4) & 1) + 4 * (lane & 3)) * 2;
    const s16x4 lo = vtr(p), hi = vtr(p + 8 * VROW);
    return (bf16x8){lo[0], lo[1], lo[2], lo[3], hi[0], hi[1], hi[2], hi[3]};
}
DEV void load_frags(bf16x8 (&f)[4], const bf16_t* rowp, int lane) {
    const int h = lane >> 5;
#pragma unroll
    for (int st = 0; st < 4; ++st) f[st] = *(const bf16x8*)(rowp + 16 * st + 8 * h);
}
DEV bf16x8 pack_p(const f32x16& p, int s) {
    u32x4 w; w.x = pg8::cvt_pk_bf16(p[8 * s], p[8 * s + 1]); w.y = pg8::cvt_pk_bf16(p[8 * s + 2], p[8 * s + 3]); w.z = pg8::cvt_pk_bf16(p[8 * s + 4], p[8 * s + 5]); w.w = pg8::cvt_pk_bf16(p[8 * s + 6], p[8 * s + 7]);
    return __builtin_bit_cast(bf16x8, w);
}
#define MFMA32(a, b, c) __builtin_amdgcn_mfma_f32_32x32x16_bf16((a), (b), (c), 0, 0, 0)
DEV float ex2(float x) { return __builtin_amdgcn_exp2f(x); }

struct AttnIt { int p, bh, dil, L, r, q0, kmin, kmax; };
DEV void attn_decode(int item, AttnIt& d) {
    d.p = item >> 13; const int rem = item & 8191; d.bh = rem >> 7; const int qblk = rem & 127;
    d.dil = d.p == 0 ? 1 : (d.p == 1 ? 4 : 16); d.L = S / d.dil; const int bpr = d.L >> 5;
    d.r = qblk / bpr; d.q0 = (qblk % bpr) * 32;
    d.kmin = d.q0 >= 64 ? 0 : (64 - d.q0) >> 5; const int km = (d.L + 63 - d.q0) >> 5; d.kmax = km > 4 ? 4 : km;
}
DEV void attn_ldq(const Args& a, const AttnIt& d, bf16x8 (&qf)[4], int lane) {
    load_frags(qf, (const bf16_t*)(a.ws + WS_AQ) + (size_t)d.bh * S * HD + (size_t)((d.q0 + (lane & 31)) * d.dil + d.r) * HD, lane);
}
DEV void attn_ldkv(const Args& a, const AttnIt& d, int kk, bf16x8 (&kf)[4], u32x4 (&v)[4], int lane) {
    const bf16_t* Kh = (const bf16_t*)(a.ws + WS_AK) + (size_t)d.bh * S * HD; const bf16_t* Vh = (const bf16_t*)(a.ws + WS_AV) + (size_t)d.bh * S * HD;
    const int kbase = d.q0 - 64 + 32 * kk, rr = lane >> 3, ch = lane & 7;
    { int ki = kbase + (lane & 31); ki = ki < 0 ? 0 : (ki >= d.L ? d.L - 1 : ki); load_frags(kf, Kh + (size_t)(ki * d.dil + d.r) * HD, lane); }
#pragma unroll
    for (int i = 0; i < 4; ++i) { int ki = kbase + rr + 8 * i; ki = ki < 0 ? 0 : (ki >= d.L ? d.L - 1 : ki); v[i] = *(const u32x4*)(Vh + (size_t)(ki * d.dil + d.r) * HD + ch * 8); }
}
DEV void attn_items(const Args& a, unsigned char* lds, int gw, int NGW, int lane, int wave) {
    unsigned char* ws = a.ws;
    constexpr int NIT = 3 * 8192;
    int item = gw; if (item >= NIT) return;
    LAS unsigned char* slot = (LAS unsigned char*)lds + wave * MIX_WAVE_LDS; lds_cptr slot3 = (lds_cptr)slot;
    const int t = lane & 31, hi = lane >> 5, rr = lane >> 3, ch = lane & 7;
    AttnIt d; attn_decode(item, d);
    bf16x8 qf[4], kf[4]; u32x4 vv[4];
    attn_ldq(a, d, qf, lane); attn_ldkv(a, d, d.kmin, kf, vv, lane);
    for (;;) {
        const LAS float* biasL = (const LAS float*)((LAS unsigned char*)lds + MIX_BIAS_OFF) + (d.p * NH + (d.bh & 7)) * 129;
        f32x16 o0 = {}, o1 = {}; float m = -1e30f, l = 0.f;
        const int nitem = item + NGW; const bool hasn = nitem < NIT;
        AttnIt dn = d; if (hasn) attn_decode(nitem, dn);
        bf16x8 qn[4];
        for (int kk = d.kmin; kk <= d.kmax; ++kk) {
            const int kbase = d.q0 - 64 + 32 * kk;
#pragma unroll
            for (int i = 0; i < 4; ++i) *(LAS u32x4*)(slot + (rr + 8 * i) * VROW + ch * 16) = vv[i];
            asm volatile("" ::: "memory");
            f32x16 sc = {};
#pragma unroll
            for (int st = 0; st < 4; ++st) sc = MFMA32(kf[st], qf[st], sc);
            if (kk < d.kmax) attn_ldkv(a, d, kk + 1, kf, vv, lane);
            else if (hasn) { attn_ldq(a, dn, qn, lane); attn_ldkv(a, dn, dn.kmin, kf, vv, lane); }
            float mx = -1e30f;
#pragma unroll
            for (int rg = 0; rg < 16; ++rg) { const int key = crow(rg, hi), bi = 32 * kk + key - t, ki = kbase + key;
                const bool ok = bi >= 0 && bi <= 128 && ki >= 0 && ki < d.L;
                const float bv = biasL[bi < 0 ? 0 : (bi > 128 ? 128 : bi)];
                sc[rg] = ok ? sc[rg] + bv : -1e30f; mx = fmaxf(mx, sc[rg]); }
            mx = fmaxf(mx, __shfl_xor(mx, 32));
            const float mn = fmaxf(m, mx), f = ex2(m - mn); m = mn;
            float ps = 0.f;
#pragma unroll
            for (int rg = 0; rg < 16; ++rg) { sc[rg] = ex2(sc[rg] - mn); ps += sc[rg]; }
            l = l * f + ps;
#pragma unroll
            for (int rg = 0; rg < 16; ++rg) { o0[rg] *= f; o1[rg] *= f; }
            const bf16x8 p0 = pack_p(sc, 0), p1 = pack_p(sc, 1);
            o0 = MFMA32(tr_frag(slot3, 0, 0, lane), p0, o0); o0 = MFMA32(tr_frag(slot3, 1, 0, lane), p1, o0);
            o1 = MFMA32(tr_frag(slot3, 0, 1, lane), p0, o1); o1 = MFMA32(tr_frag(slot3, 1, 1, lane), p1, o1);
            asm volatile("" ::: "memory");
        }
        l += __shfl_xor(l, 32);
        const float il = 1.f / l;
        const size_t orow = ((size_t)d.p * NB * NH + d.bh) * S + (size_t)((d.q0 + t) * d.dil + d.r);
        bf16_t* op = (bf16_t*)(ws + WS_ATTO) + orow * HD;
#pragma unroll
        for (int g4 = 0; g4 < 4; ++g4) {
            *(uint2*)(op + 8 * g4 + 4 * hi) = make_uint2(pg8::cvt_pk_bf16(o0[4 * g4] * il, o0[4 * g4 + 1] * il), pg8::cvt_pk_bf16(o0[4 * g4 + 2] * il, o0[4 * g4 + 3] * il));
            *(uint2*)(op + 32 + 8 * g4 + 4 * hi) = make_uint2(pg8::cvt_pk_bf16(o1[4 * g4] * il, o1[4 * g4 + 1] * il), pg8::cvt_pk_bf16(o1[4 * g4 + 2] * il, o1[4 * g4 + 3] * il));
        }
        if (hi == 0) ((float*)(ws + WS_ATTL))[orow] = m + __log2f(l);
        if (!hasn) break;
        item = nitem; d = dn;
#pragma unroll
        for (int st = 0; st < 4; ++st) qf[st] = qn[st];
    }
}
DEV void retstate_item(const Args& a, unsigned char* lds, int item, int lane, int wave) {
    unsigned char* ws = a.ws;
    const int dir = item & 1, n = (item >> 1) & 31, bh = item >> 6, h = bh & 7;
    const bf16_t* Kc = (const bf16_t*)(ws + WS_RK) + ((size_t)bh * S + n * 128) * HD; const bf16_t* Vc = (const bf16_t*)(ws + WS_RV) + ((size_t)bh * S + n * 128) * HD;
    const float lg = a.in[IN_DECAY][dir * NH + h] * LOG2E;
    LAS unsigned char* vs = (LAS unsigned char*)lds + wave * MIX_WAVE_LDS; LAS unsigned char* ks = vs + VSLOT; lds_cptr vs3 = (lds_cptr)vs, ks3 = (lds_cptr)ks;
    f32x16 acc[2][2] = {};
    for (int blk = 0; blk < 4; ++blk) {
        { const int rr = lane >> 3, ch = lane & 7;
          u32x4 v[4], k[4];
#pragma unroll
          for (int i = 0; i < 4; ++i) { const int mrow = 32 * blk + rr + 8 * i; v[i] = *(const u32x4*)(Vc + (size_t)mrow * HD + ch * 8); k[i] = *(const u32x4*)(Kc + (size_t)mrow * HD + ch * 8); }
#pragma unroll
          for (int i = 0; i < 4; ++i) { const int mrow = 32 * blk + rr + 8 * i; const float z = ex2(lg * (float)(dir == 0 ? 127 - mrow : mrow));
              const unsigned kw[4] = {k[i].x, k[i].y, k[i].z, k[i].w}; u32x4 o;
              o.x = pg8::cvt_pk_bf16(bf2f(kw[0] & 0xffffu) * z, bf2f(kw[0] >> 16) * z); o.y = pg8::cvt_pk_bf16(bf2f(kw[1] & 0xffffu) * z, bf2f(kw[1] >> 16) * z);
              o.z = pg8::cvt_pk_bf16(bf2f(kw[2] & 0xffffu) * z, bf2f(kw[2] >> 16) * z); o.w = pg8::cvt_pk_bf16(bf2f(kw[3] & 0xffffu) * z, bf2f(kw[3] >> 16) * z);
              *(LAS u32x4*)(vs + (rr + 8 * i) * VROW + ch * 16) = v[i]; *(LAS u32x4*)(ks + (rr + 8 * i) * VROW + ch * 16) = o; } }
        LDS_WAIT();
#pragma unroll
        for (int s = 0; s < 2; ++s) {
            const bf16x8 v0 = tr_frag(vs3, s, 0, lane), v1 = tr_frag(vs3, s, 1, lane), k0 = tr_frag(ks3, s, 0, lane), k1 = tr_frag(ks3, s, 1, lane);
            acc[0][0] = MFMA32(v0, k0, acc[0][0]); acc[0][1] = MFMA32(v0, k1, acc[0][1]); acc[1][0] = MFMA32(v1, k0, acc[1][0]); acc[1][1] = MFMA32(v1, k1, acc[1][1]);
        }
        LDS_WAIT();
    }
    float* KT = (float*)(ws + WS_KF) + (((size_t)dir * NB * NH + bh) * 32 + n) * 4096;
    const int c = lane & 31, hi = lane >> 5;
#pragma unroll
    for (int eb = 0; eb < 2; ++eb)
#pragma unroll
        for (int db = 0; db < 2; ++db)
#pragma unroll
            for (int rg = 0; rg < 16; ++rg) KT[(32 * eb + crow(rg, hi)) * 64 + 32 * db + c] = acc[eb][db][rg];
}
DEV void phase_scan(const Args& a, int gtid, int NT) {
    unsigned char* ws = a.ws;
    for (int sl = gtid; sl < 2 * NB * NH * 1024; sl += NT) {
        const int dir = sl >> 16, bh = (sl >> 10) & 63, q = sl & 1023, h = bh & 7;
        const float gC = ex2(a.in[IN_DECAY][dir * NH + h] * LOG2E * 128.f);
        const float4* kt = (const float4*)(ws + WS_KF) + ((size_t)dir * NB * NH + bh) * 32 * 1024 + q;
        uint2* st = (uint2*)(ws + WS_ST) + ((size_t)dir * NB * NH + bh) * 32 * 1024 + q;
        float4 s = make_float4(0.f, 0.f, 0.f, 0.f);
        for (int i = 0; i < 32; ++i) { const int n = dir == 0 ? i : 31 - i;
            st[(size_t)n * 1024] = make_uint2(pg8::cvt_pk_bf16(s.x, s.y), pg8::cvt_pk_bf16(s.z, s.w));
            const float4 kv = kt[(size_t)n * 1024];
            s.x = gC * s.x + kv.x; s.y = gC * s.y + kv.y; s.z = gC * s.z + kv.z; s.w = gC * s.w + kv.w; }
    }
}
DEV void retout_item(const Args& a, unsigned char* lds, int item, int lane, int wave) {
    unsigned char* ws = a.ws;
    const int qb = item & 3, n = (item >> 2) & 31, bh = item >> 7, h = bh & 7, b = bh >> 3;
    const bf16_t* Qc = (const bf16_t*)(ws + WS_RQ) + ((size_t)bh * S + n * 128) * HD; const bf16_t* Kc = (const bf16_t*)(ws + WS_RK) + ((size_t)bh * S + n * 128) * HD;
    const bf16_t* Vc = (const bf16_t*)(ws + WS_RV) + ((size_t)bh * S + n * 128) * HD;
    const bf16_t* SF = (const bf16_t*)(ws + WS_ST) + (((size_t)0 * NB * NH + bh) * 32 + n) * 4096; const bf16_t* SB = (const bf16_t*)(ws + WS_ST) + (((size_t)1 * NB * NH + bh) * 32 + n) * 4096;
    const float lg0 = a.in[IN_DECAY][h] * LOG2E, lg1 = a.in[IN_DECAY][NH + h] * LOG2E;
    LAS unsigned char* slot = (LAS unsigned char*)lds + wave * MIX_WAVE_LDS; lds_cptr slot3 = (lds_cptr)slot;
    const int t = lane & 31, hi = lane >> 5, c = 32 * qb + t;
    bf16x8 qf[4]; load_frags(qf, Qc + (size_t)c * HD, lane);
    f32x16 o0 = {}, o1 = {};
    { bf16x8 s0[4], s1[4]; load_frags(s0, SF + (size_t)t * 64, lane); load_frags(s1, SF + (size_t)(32 + t) * 64, lane);
#pragma unroll
      for (int st = 0; st < 4; ++st) { o0 = MFMA32(s0[st], qf[st], o0); o1 = MFMA32(s1[st], qf[st], o1); }
      const float fa = ex2(lg0 * (float)(c + 1) - lg1 * (float)(128 - c));
#pragma unroll
      for (int rg = 0; rg < 16; ++rg) { o0[rg] *= fa; o1[rg] *= fa; }
      load_frags(s0, SB + (size_t)t * 64, lane); load_frags(s1, SB + (size_t)(32 + t) * 64, lane);
#pragma unroll
      for (int st = 0; st < 4; ++st) { o0 = MFMA32(s0[st], qf[st], o0); o1 = MFMA32(s1[st], qf[st], o1); }
      const float fb = ex2(lg1 * (float)(128 - c));
#pragma unroll
      for (int rg = 0; rg < 16; ++rg) { o0[rg] *= fb; o1[rg] *= fb; } }
    for (int kb = 0; kb < 4; ++kb) {
        { const int rr = lane >> 3, ch = lane & 7;
          u32x4 v[4];
#pragma unroll
          for (int i = 0; i < 4; ++i) v[i] = *(const u32x4*)(Vc + (size_t)(32 * kb + rr + 8 * i) * HD + ch * 8);
#pragma unroll
          for (int i = 0; i < 4; ++i) *(LAS u32x4*)(slot + (rr + 8 * i) * VROW + ch * 16) = v[i]; }
        bf16x8 kf[4]; load_frags(kf, Kc + (size_t)(32 * kb + t) * HD, lane);
        f32x16 sc = {};
#pragma unroll
        for (int st = 0; st < 4; ++st) sc = MFMA32(kf[st], qf[st], sc);
#pragma unroll
        for (int rg = 0; rg < 16; ++rg) { const int mk = 32 * kb + crow(rg, hi), df = c - mk; sc[rg] *= df >= 0 ? ex2(lg0 * (float)df) : ex2(lg1 * (float)(-df)); }
        const bf16x8 p0 = pack_p(sc, 0), p1 = pack_p(sc, 1);
        LDS_WAIT();
        o0 = MFMA32(tr_frag(slot3, 0, 0, lane), p0, o0); o0 = MFMA32(tr_frag(slot3, 1, 0, lane), p1, o0);
        o1 = MFMA32(tr_frag(slot3, 0, 1, lane), p0, o1); o1 = MFMA32(tr_frag(slot3, 1, 1, lane), p1, o1);
        LDS_WAIT();
    }
    float sm = 0.f;
#pragma unroll
    for (int rg = 0; rg < 16; ++rg) sm += o0[rg] + o1[rg];
    sm += __shfl_xor(sm, 32); const float mu = sm * (1.f / 64.f); float vq = 0.f;
#pragma unroll
    for (int rg = 0; rg < 16; ++rg) { const float d0 = o0[rg] - mu, d1 = o1[rg] - mu; vq += d0 * d0 + d1 * d1; }
    vq += __shfl_xor(vq, 32); const float rstd = rsqrtf(vq * (1.f / 64.f) + EPS);
    const size_t pos = (size_t)n * 128 + c;
    const bf16_t* gp = (const bf16_t*)(ws + WS_RG) + ((size_t)bh * S + pos) * HD; bf16_t* op = (bf16_t*)(ws + WS_XN) + ((size_t)b * S + pos) * D + h * HD; const float* gn = a.in[IN_GN] + h * HD;
#pragma unroll
    for (int db = 0; db < 2; ++db)
#pragma unroll
        for (int g4 = 0; g4 < 4; ++g4) { const int e0 = 32 * db + 8 * g4 + 4 * hi; const uint2 gw = *(const uint2*)(gp + e0); const float4 gg = *(const float4*)(gn + e0);
            const float gate[4] = {bf2f(gw.x & 0xffffu), bf2f(gw.x >> 16), bf2f(gw.y & 0xffffu), bf2f(gw.y >> 16)}; const float gv[4] = {gg.x, gg.y, gg.z, gg.w}; float o[4];
#pragma unroll
            for (int i = 0; i < 4; ++i) { const float rv = (db == 0 ? o0[4 * g4 + i] : o1[4 * g4 + i]); o[i] = (rv - mu) * rstd * gv[i] * (gate[i] / (1.f + __expf(-gate[i]))); }
            *(uint2*)(op + e0) = make_uint2(pg8::cvt_pk_bf16(o[0], o[1]), pg8::cvt_pk_bf16(o[2], o[3])); }
}
DEV void phase_attn_merge(const Args& a, int gtid, int NT) {
    unsigned char* ws = a.ws; const float* L = (const float*)(ws + WS_ATTL); const bf16_t* O = (const bf16_t*)(ws + WS_ATTO); bf16_t* mixed = (bf16_t*)(ws + WS_XN);
    for (int it = gtid; it < NB * NH * S * 8; it += NT) {
        const int ch = it & 7, row = it >> 3;
        const int bh = row >> 12, pos = row & 4095, b = bh >> 3, h = bh & 7;
        const float l0 = L[row], l1 = L[(size_t)NB * NH * S + row], l2 = L[(size_t)2 * NB * NH * S + row];
        const float mx = fmaxf(l0, fmaxf(l1, l2)); float w0 = ex2(l0 - mx), w1 = ex2(l1 - mx), w2 = ex2(l2 - mx); const float is = 1.f / (w0 + w1 + w2); w0 *= is; w1 *= is; w2 *= is;
        const uint4 a0 = *(const uint4*)(O + (size_t)row * HD + ch * 8), a1 = *(const uint4*)(O + ((size_t)NB * NH * S + row) * HD + ch * 8), a2 = *(const uint4*)(O + ((size_t)2 * NB * NH * S + row) * HD + ch * 8);
        const unsigned x0[4] = {a0.x, a0.y, a0.z, a0.w}, x1[4] = {a1.x, a1.y, a1.z, a1.w}, x2[4] = {a2.x, a2.y, a2.z, a2.w}; unsigned o[4];
#pragma unroll
        for (int j = 0; j < 4; ++j) o[j] = pg8::cvt_pk_bf16(w0 * bf2f(x0[j] & 0xffffu) + w1 * bf2f(x1[j] & 0xffffu) + w2 * bf2f(x2[j] & 0xffffu), w0 * bf2f(x0[j] >> 16) + w1 * bf2f(x1[j] >> 16) + w2 * bf2f(x2[j] >> 16));
        *(uint4*)(mixed + ((size_t)b * S + pos) * D + 512 + h * HD + ch * 8) = make_uint4(o[0], o[1], o[2], o[3]);
    }
}
DEV void phase_mix_a(const Args& a, unsigned char* lds, int gw, int NGW, int lane, int wave, int tid) {
    { const float* bt = (const float*)(a.ws + WS_BIAS); float* bl = (float*)(lds + MIX_BIAS_OFF); for (int i = tid; i < 3 * NH * 129; i += NTHR) bl[i] = bt[i]; }
    __syncthreads();
    for (int it = gw; it < 2 * 32 * NB * NH; it += NGW) retstate_item(a, lds, it, lane, wave);
    attn_items(a, lds, gw, NGW, lane, wave);
}
DEV void phase_mix_b(const Args& a, unsigned char* lds, int gw, int NGW, int lane, int wave, int tid, int wg, int G) {
    for (int it = gw; it < NB * NH * 32 * 4; it += NGW) retout_item(a, lds, it, lane, wave);
    phase_attn_merge(a, wg * NTHR + tid, G * NTHR);
}
#define XB_TMO      128
#define XB_XCNT(j)  (256  + 64 * (j))
#define XB_XSUB(j)  (1280 + 64 * (j))
#define XB_XGEN(j)  (2304 + 64 * (j))
#define XB_TOP      3328
#define XB_TOPGEN   3392
#define XCD_BAR_WORDS 3456
#define XB_SPIN_CAP (1u << 18)

__device__ __forceinline__ unsigned xb_ld(unsigned* p)              { return __hip_atomic_load(p, __ATOMIC_RELAXED, __HIP_MEMORY_SCOPE_AGENT); }
__device__ __forceinline__ unsigned xb_add(unsigned* p, unsigned v) { return __hip_atomic_fetch_add(p, v, __ATOMIC_RELAXED, __HIP_MEMORY_SCOPE_AGENT); }
__device__ __forceinline__ unsigned xb_xcc_id() { return (unsigned)__builtin_amdgcn_s_getreg((3 << 11) | 20) & 0xFu; }
#define XB_SPIN(cond, bar) do { unsigned _sp = 0; while (cond) { __builtin_amdgcn_s_sleep(1); \
    if ((++_sp & 255u) == 0u) { if (xb_ld(&(bar)[XB_TMO])) break; if (_sp > XB_SPIN_CAP) { atomicAdd(&(bar)[XB_TMO], 1u); break; } } } } while (0)

struct XcdBarrier {
    unsigned* bar; unsigned x;
    volatile LAS unsigned* st;
};

__device__ __forceinline__ XcdBarrier xcd_barrier_post(unsigned* bar, volatile LAS unsigned* st) {
    XcdBarrier b; b.bar = bar; b.x = xb_xcc_id(); b.st = st;
    if (threadIdx.x == 0) (void)xb_add(&bar[XB_XCNT(b.x)], 1u);
    return b;
}
__device__ __forceinline__ void xcd_barrier_complete(unsigned* bar, unsigned x, unsigned& nloc, unsigned& nx) {
    const unsigned G = gridDim.x * gridDim.y * gridDim.z;
    unsigned sum, cnt, mine, sp = 0u;
    for (;;) {
        sum = 0u; cnt = 0u; mine = 0u;
#pragma unroll
        for (unsigned j = 0; j < 16; ++j) { const unsigned c = xb_ld(&bar[XB_XCNT(j)]); sum += c; cnt += (c > 0u) ? 1u : 0u; mine = (j == x) ? c : mine; }
        if (sum == G) break;
        __builtin_amdgcn_s_sleep(1);
        if ((++sp & 255u) == 0u) { if (xb_ld(&bar[XB_TMO])) break; if (sp > XB_SPIN_CAP) { atomicAdd(&bar[XB_TMO], 1u); break; } }
    }
    nloc = mine > 0u ? mine : 1u; nx = cnt > 0u ? cnt : 1u;
}

__device__ __forceinline__ void xcd_barrier(const XcdBarrier& b) {
    asm volatile("s_waitcnt vmcnt(0)" ::: "memory");
    __syncthreads();
    if (threadIdx.x == 0) {
        unsigned* bar = b.bar;
        __builtin_amdgcn_s_waitcnt(0);
        unsigned nloc = b.st[0], nx = b.st[1];
        if (nloc == 0u) { xcd_barrier_complete(bar, b.x, nloc, nx); b.st[0] = nloc; b.st[1] = nx; }
        const unsigned old = xb_add(&bar[XB_XSUB(b.x)], 1u);
        const unsigned gen = old / nloc;
        if (old + 1u == (gen + 1u) * nloc) {
            __builtin_amdgcn_fence(__ATOMIC_RELEASE, "agent");
            asm volatile("s_waitcnt vmcnt(0)" ::: "memory");
            const unsigned og = xb_add(&bar[XB_TOP], 1u);
            const unsigned tg = og / nx;
            if (og + 1u == (tg + 1u) * nx) xb_add(&bar[XB_TOPGEN], 1u);
            else XB_SPIN(xb_ld(&bar[XB_TOPGEN]) == tg, bar);
            __builtin_amdgcn_fence(__ATOMIC_ACQUIRE, "agent");
            xb_add(&bar[XB_XGEN(b.x)], 1u);
            asm volatile("s_waitcnt vmcnt(0)" ::: "memory");
        } else {
            XB_SPIN(xb_ld(&bar[XB_XGEN(b.x)]) == gen, bar);
            __builtin_amdgcn_fence(__ATOMIC_ACQUIRE, "agent");
            asm volatile("s_waitcnt vmcnt(0)" ::: "memory");
        }
    }
    __syncthreads();
}

#ifndef MK_LAUNCHES
#define MK_LAUNCHES 1
#endif
constexpr int NPH = 11;
#ifndef PROBE_REP
#define PROBE_REP 0
#endif
#define REP(k) if (((PROBE_REP) >> (k)) & 1) for (int _r = 0; _r < 2; ++_r, cg::this_grid().sync())
__global__ void __launch_bounds__(NTHR, 2) mega(Args a) {
    extern __shared__ __attribute__((aligned(16))) unsigned char lds[];
    const int tid = threadIdx.x, lane = tid & 63, wave = __builtin_amdgcn_readfirstlane(tid >> 6);
    const int G = gridDim.x, wg = blockIdx.x, gw = wg * NWAVES + wave, NGW = G * NWAVES;
    unsigned char* ws = a.ws;
    const int lo = a.ph_lo, hi = a.ph_hi;
    volatile LAS unsigned* bst = (volatile LAS unsigned*)((LAS unsigned char*)lds + LDS_BYTES - 64);
    if (tid < 2) bst[tid] = 0u;
    __syncthreads();
    XcdBarrier bar = xcd_barrier_post((unsigned*)(ws + WS_CTL) + 4096, bst);
#define IN(k) (lo <= (k) && (k) < hi)
#define SEAM(k) do { if (IN(k) && IN((k) + 1)) { if ((k) == 0) cg::this_grid().sync(); else xcd_barrier(bar); } } while (0)
    if (IN(0)) { REP(0) { phase_prep(a, lds, gw, NGW, lane, wave); } phase_prep(a, lds, gw, NGW, lane, wave); }
    SEAM(0);
    if (IN(1)) { pg8::Gemm g{(const bf16_t*)(ws + WS_XN), (const bf16_t*)(ws + WS_WIN), D}; SchedPlain Sc; Sc.init(M, PC, G, wg); Sc.rowbytes = D * 2;
        EpiInProj E{ws, (const float*)(ws + WS_ROPE)};
        pg8::gemm_phase<EpiInProj, SchedPlain, true>((LAS unsigned char*)lds, g, Sc, E); }
    SEAM(1);
    if (IN(2)) { REP(2) { phase_mix_a(a, lds, gw, NGW, lane, wave, tid); } phase_mix_a(a, lds, gw, NGW, lane, wave, tid); }
    SEAM(2);
    if (IN(3)) { REP(3) { phase_scan(a, wg * NTHR + tid, G * NTHR); } phase_scan(a, wg * NTHR + tid, G * NTHR); }
    SEAM(3);
    if (IN(4)) { REP(4) { phase_mix_b(a, lds, gw, NGW, lane, wave, tid, wg, G); } phase_mix_b(a, lds, gw, NGW, lane, wave, tid, wg, G); }
    SEAM(4);
    if (IN(5)) { pg8::Gemm g{(const bf16_t*)(ws + WS_XN), (const bf16_t*)(ws + WS_WOUT), D}; SchedPlain Sc; Sc.init(M, D, G, wg); Sc.rowbytes = D * 2;
        EpiOutProj E{a.in[IN_X], a.out};
        pg8::gemm_phase<EpiOutProj, SchedPlain, true>((LAS unsigned char*)lds, g, Sc, E); }
    SEAM(5);
    if (IN(6)) { REP(6) { phase_router(a, lds, gw, NGW, lane, tid); phase_latew(a, lds, gw, NGW, lane, wave); } phase_router(a, lds, gw, NGW, lane, tid); phase_latew(a, lds, gw, NGW, lane, wave); }
    SEAM(6);
    if (IN(7)) { REP(7) { phase_topk(a, lds, wg, G, tid, lane, wave); } phase_topk(a, lds, wg, G, tid, lane, wave); }
    SEAM(7);
    if (IN(8)) { pg8::Gemm g{(const bf16_t*)(ws + WS_XN), (const bf16_t*)(ws + WS_WGU), D}; SchedMoe1 Sc; Sc.init(MR, 4096, G, wg); Sc.idx = (const int*)(ws + WS_IDX);
        EpiSwiGLU E{ws + WS_HID};
        pg8::gemm_phase<EpiSwiGLU, SchedMoe1, true, true>((LAS unsigned char*)lds, g, Sc, E); }
    SEAM(8);
    if (IN(9)) { pg8::Gemm g{(const bf16_t*)(ws + WS_HID), (const bf16_t*)(ws + WS_WD), DFF}; SchedMoe2 Sc; Sc.init(MR, D, G, wg);
        EpiDown E{(bf16_t*)(ws + WS_Y)};
        pg8::gemm_phase<EpiDown, SchedMoe2, true, true>((LAS unsigned char*)lds, g, Sc, E); }
    SEAM(9);
    if (IN(10)) { phase_final(a, gw, NGW, lane); }
#undef IN
#undef SEAM
}

extern "C" void kernel_launch(void* const* d_in, const int* in_sizes, int n_in, void* d_out, int out_size, void* d_ws, size_t ws_size, hipStream_t stream) {
    static int grid = 0;
    if (grid == 0) {
        if (n_in != 13 || in_sizes[0] != M * D || out_size != M * D || ws_size < WS_END) { fprintf(stderr, "kernel_launch: unexpected shapes n_in %d in0 %d out %d ws %zu (need %zu)\n", n_in, n_in > 0 ? in_sizes[0] : -1, out_size, ws_size, (size_t)WS_END); grid = -1; return; }
        int dev = 0, cus = 0, per_cu = 0;
        (void)hipGetDevice(&dev); (void)hipDeviceGetAttribute(&cus, hipDeviceAttributeMultiprocessorCount, dev);
        (void)hipFuncSetAttribute((const void*)mega, hipFuncAttributeMaxDynamicSharedMemorySize, LDS_BYTES);
        if (hipOccupancyMaxActiveBlocksPerMultiprocessor(&per_cu, (const void*)mega, NTHR, LDS_BYTES) != hipSuccess || per_cu < 1) { fprintf(stderr, "kernel_launch: occupancy query says %d blocks/CU\n", per_cu); per_cu = 1; }
        (void)hipGetLastError();
        grid = cus * 1;
        if (grid > cus * per_cu) grid = cus * per_cu;
    }
    if (grid < 0) return;
    (void)hipMemsetAsync((char*)d_ws + WS_CTL, 0, 1 * MiB, stream);
    Args a{};
    for (int i = 0; i < 13; ++i) a.in[i] = (const float*)d_in[i];
    a.out = (float*)d_out; a.ws = (unsigned char*)d_ws;
#if MK_LAUNCHES == 1
    a.ph_lo = 0; a.ph_hi = NPH;
    void* args[] = {&a};
    hipError_t e = hipLaunchCooperativeKernel((const void*)mega, dim3(grid), dim3(NTHR), args, LDS_BYTES, stream);
    if (e != hipSuccess) fprintf(stderr, "cooperative launch failed: %s (grid %d)\n", hipGetErrorString(e), grid);
#else
    for (int p = 0; p < NPH; ++p) { a.ph_lo = p; a.ph_hi = p + 1; hipLaunchKernelGGL(mega, dim3(grid), dim3(NTHR), LDS_BYTES, stream, a); }
#endif
}
```

```cpp
#include <hip/hip_runtime.h>
#include <hip/hip_cooperative_groups.h>
#include <cstdint>
#include <cstdio>
namespace cg = cooperative_groups;

typedef unsigned short bf16_t;
#define DEV __device__ __forceinline__
#define LAS __attribute__((address_space(3)))

constexpr int NB = 8, S = 4096, D = 1024, M = NB * S;
constexpr int NH = 8, HD = 64, PC = 3584;
constexpr int NE = 16, CAP = 512, DFF = 2048, MR = NE * NB * CAP;
constexpr float EPS = 1e-6f, LOG2E = 1.4426950408889634f;
constexpr int NWAVES = 8, NTHR = 512;
constexpr int LDS_BYTES = 147456;

constexpr size_t MiB = 1u << 20;
constexpr size_t WS_CTL = 0;
constexpr size_t WS_ROPE = 1 * MiB;
constexpr size_t WS_BIAS = 2 * MiB;
constexpr size_t WS_IDX = 2 * MiB + 512 * 1024;
constexpr size_t WS_AFF = 3 * MiB;
constexpr size_t WS_INV = 5 * MiB;
constexpr size_t WS_AFFT = 9 * MiB;
constexpr size_t WS_WOUT = 7 * MiB;
constexpr size_t WS_WIN = 9 * MiB;
constexpr size_t WS_XN = 16 * MiB;
constexpr size_t WS_RQ = 80 * MiB, WS_RK = 112 * MiB, WS_RV = 144 * MiB, WS_RG = 176 * MiB;
constexpr size_t WS_AQ = 208 * MiB, WS_AK = 240 * MiB, WS_AV = 272 * MiB;
constexpr size_t WS_ATTO = 304 * MiB;
constexpr size_t WS_ATTL = 400 * MiB;
constexpr size_t WS_KF = 403 * MiB;
constexpr size_t WS_X1 = 403 * MiB;
constexpr size_t WS_ST = 208 * MiB;
constexpr size_t WS_WD = 80 * MiB;
constexpr size_t WS_WGU = 144 * MiB;
constexpr size_t WS_Y = 144 * MiB;
constexpr size_t WS_HID = 272 * MiB;
constexpr size_t WS_END = 528 * MiB;

DEV unsigned f2bf(float f) { unsigned u = __float_as_uint(f); return (u + 0x7fffu + ((u >> 16) & 1u)) >> 16; }
DEV float bf2f(unsigned h) { return __uint_as_float(h << 16); }
DEV unsigned pk2(float lo, float hi) { return f2bf(lo) | (f2bf(hi) << 16); }
DEV float wave_sum(float v) {
#pragma unroll
    for (int o = 1; o < 64; o <<= 1) v += __shfl_xor(v, o);
    return v;
}
#define LDS_WAIT() asm volatile("s_waitcnt lgkmcnt(0)" ::: "memory")
namespace pg8 {
#define PG8_LAS __attribute__((address_space(3)))
typedef short bf16x8 __attribute__((ext_vector_type(8)));
typedef float f32x4 __attribute__((ext_vector_type(4)));
typedef unsigned u32x4 __attribute__((ext_vector_type(4)));
constexpr int BM = 256, BK = 64, HALF = 128, HTB = HALF * BK * 2, STAGE_BYTES = 8 * HTB, NXCD = 8, WGM = 8;
__host__ __device__ __forceinline__ int lds_byte(int r, int c) { const int st = (r >> 4) * 2 + (c >> 5), rr = r & 15, cc = c & 31, ob = rr * 64 + cc * 2; return st * 1024 + (ob ^ (((ob >> 9) & 1) << 5)); }
__host__ __device__ __forceinline__ void stage_rc(int b, int& R, int& C) { const int st = b / 1024, sb = b % 1024, swz = sb ^ (((sb >> 9) & 1) << 5); R = (st >> 1) * 16 + swz / 64; C = (st & 1) * 32 + (swz % 64) / 2; }
__host__ __device__ __forceinline__ int perm32(int rho) { const int n = rho >> 4, i = rho & 15; return 8 * (i >> 2) + 4 * n + (i & 3); }
struct Unit { int pm, pn; };
struct Gemm { const bf16_t* A; const bf16_t* Bt; int K; };
struct StaticOrder {
    int nM, nN, nwg, G, c;
    __device__ void init(int M_, int N_, int G_, int c_) { nM = M_ / BM; nN = N_ / BM; nwg = nM * nN; G = G_; c = c_; }
    __device__ bool next(int i, Unit& u) const {
        const long L = (long)i * G + c; if (L >= nwg) return false;
        int wgid = (int)L; { const int q = nwg / NXCD, r = nwg % NXCD, xcd = wgid % NXCD, off = wgid / NXCD; wgid = (xcd < r ? xcd * (q + 1) : r * (q + 1) + (xcd - r) * q) + off; }
        const int nig = WGM * nN, gid = wgid / nig, fm = gid * WGM, gsz = (nM - fm) < WGM ? (nM - fm) : WGM;
        u.pm = fm + ((wgid % nig) % gsz); u.pn = (wgid % nig) / gsz; return true;
    }
};
__device__ __forceinline__ unsigned cvt_pk_bf16(float lo, float hi) { unsigned r; asm volatile("v_cvt_pk_bf16_f32 %0, %1, %2" : "=v"(r) : "v"(lo), "v"(hi)); return r; }

typedef int v8i __attribute__((ext_vector_type(8)));
template <class Epi, class Sched, bool ALIGN_EPI, bool FP8 = false>
__device__ __forceinline__ void gemm_phase(PG8_LAS unsigned char* lds, const Gemm g, const Sched& S, const Epi& E) {
    const int tid = threadIdx.x, wid = __builtin_amdgcn_readfirstlane(tid >> 6), lane = tid & 63, wr = wid >> 2, wc = wid & 3, fr = lane & 15, fq = lane >> 4;
    const int K = g.K, RB = FP8 ? K : 2 * K, nt = RB / 128;
    unsigned voffB[2];
#pragma unroll
    for (int i = 0; i < 2; ++i) { int R, C; stage_rc(tid * 16 + i * 8192, R, C); const int Rb = Epi::PERM ? ((R & ~31) + perm32(R & 31)) : R;
        voffB[i] = (unsigned)(Rb * RB + C * 2); }
    const size_t kstep = (size_t)(BK * 2);
    const size_t hstep = (size_t)HALF * RB;
    const size_t tstep = 2 * hstep;
    const unsigned ldsw = (unsigned)wid * 1024u;
    const int aoff = FP8 ? lds_byte(wr * 64 + fr, fq * 16) : lds_byte(wr * 64 + fr, fq * 8), boff = FP8 ? lds_byte(wc * 32 + fr, fq * 16) : lds_byte(wc * 32 + fr, fq * 8);
    const int x16 = 16 * (fq & 1);
    const char* gA = (const char*)g.A;
#define PG8_SA(b, h) (((b) * 2 + (h)) * HTB)
#define PG8_SB(b, h) ((4 + (b) * 2 + (h)) * HTB)
#define PG8_STAGE(bufoff, gbase, voff) do { _Pragma("unroll") for (int _i = 0; _i < 2; ++_i) \
        __builtin_amdgcn_global_load_lds((const unsigned*)((const char*)(gbase) + (voff)[_i]), (PG8_LAS unsigned*)(lds + (bufoff) + ldsw + _i * 8192), 16, 0, 0); } while (0)
#define PG8_STAGE_A(bufoff, AO, h, kb) do { _Pragma("unroll") for (int _i = 0; _i < 2; ++_i) \
        __builtin_amdgcn_global_load_lds((const unsigned*)(gA + (size_t)((AO)[h][_i] + (unsigned)(kb))), (PG8_LAS unsigned*)(lds + (bufoff) + ldsw + _i * 8192), 16, 0, 0); } while (0)
#define PG8_LDA(dst, b, h) do { if constexpr (FP8) { _Pragma("unroll") for (int m = 0; m < 4; ++m) { dst[m][0] = *(const PG8_LAS bf16x8*)(lds + PG8_SA(b, h) + aoff + m * 2048 + x16); dst[m][1] = *(const PG8_LAS bf16x8*)(lds + PG8_SA(b, h) + aoff + m * 2048 + 16 - x16); } } \
    else { _Pragma("unroll") for (int m = 0; m < 4; ++m) _Pragma("unroll") for (int k = 0; k < 2; ++k) dst[m][k] = *(const PG8_LAS bf16x8*)(lds + PG8_SA(b, h) + aoff + m * 2048 + k * 1024); } } while (0)
#define PG8_LDB(dst, b, h) do { if constexpr (FP8) { _Pragma("unroll") for (int n = 0; n < 2; ++n) { dst[n][0] = *(const PG8_LAS bf16x8*)(lds + PG8_SB(b, h) + boff + n * 2048 + x16); dst[n][1] = *(const PG8_LAS bf16x8*)(lds + PG8_SB(b, h) + boff + n * 2048 + 16 - x16); } } \
    else { _Pragma("unroll") for (int n = 0; n < 2; ++n) _Pragma("unroll") for (int k = 0; k < 2; ++k) dst[n][k] = *(const PG8_LAS bf16x8*)(lds + PG8_SB(b, h) + boff + n * 2048 + k * 1024); } } while (0)
#define PG8_CAT8(x) __builtin_bit_cast(v8i, __builtin_shufflevector((x)[0], (x)[1], 0, 1, 2, 3, 4, 5, 6, 7, 8, 9, 10, 11, 12, 13, 14, 15))
#define PG8_MMA(ai, bj, At, Bt) do { __builtin_amdgcn_s_setprio(1); if constexpr (FP8) { _Pragma("unroll") for (int m = 0; m < 4; ++m) _Pragma("unroll") for (int n = 0; n < 2; ++n) \
        acc[ai][bj][m][n] = __builtin_amdgcn_mfma_scale_f32_16x16x128_f8f6f4(PG8_CAT8(Bt[n]), PG8_CAT8(At[m]), acc[ai][bj][m][n], 0, 0, 0, 0x7F7F7F7F, 0, 0x7F7F7F7F); } \
    else { _Pragma("unroll") for (int m = 0; m < 4; ++m) _Pragma("unroll") for (int n = 0; n < 2; ++n) _Pragma("unroll") for (int k = 0; k < 2; ++k) \
        acc[ai][bj][m][n] = __builtin_amdgcn_mfma_f32_16x16x32_bf16(Bt[n][k], At[m][k], acc[ai][bj][m][n], 0, 0, 0); } __builtin_amdgcn_s_setprio(0); } while (0)
#define PG8_WAIT_V(n) asm volatile("s_waitcnt vmcnt(" #n ")" ::: "memory")
#define PG8_WAIT_L(n) asm volatile("s_waitcnt lgkmcnt(" #n ")" ::: "memory")
#define PG8_BAR __builtin_amdgcn_s_barrier()
#define PG8_SCHED __builtin_amdgcn_sched_barrier(0)
#define PG8_AOFFS(AO, u) do { int _t = threadIdx.x; asm volatile("" : "+v"(_t)); _Pragma("unroll") for (int _i = 0; _i < 2; ++_i) { int _R, _C; stage_rc(_t * 16 + _i * 8192, _R, _C); \
        _Pragma("unroll") for (int _h = 0; _h < 2; ++_h) (AO)[_h][_i] = S.row_off(u, _h * HALF + _R) + (unsigned)(_C * 2); } } while (0)
    Unit cur, nxt; int ui = 0;
    if (!S.next(0, cur)) return;
    f32x4 acc[2][2][4][2];
#pragma unroll
    for (int a = 0; a < 2; ++a)
#pragma unroll
        for (int b = 0; b < 2; ++b)
#pragma unroll
            for (int m = 0; m < 4; ++m)
#pragma unroll
                for (int n = 0; n < 2; ++n) acc[a][b][m][n] = (f32x4){0.f, 0.f, 0.f, 0.f};
    bf16x8 At[4][2], B0[2][2], B1[2][2];
    unsigned aoc[2][2], aon[2][2];
    PG8_AOFFS(aoc, cur);
    const char* cB = (const char*)g.Bt + (size_t)cur.pn * tstep;
    PG8_STAGE(PG8_SB(0, 0), cB, voffB); PG8_STAGE(PG8_SB(0, 1), cB + hstep, voffB); PG8_STAGE_A(PG8_SA(0, 0), aoc, 0, 0); PG8_STAGE_A(PG8_SA(0, 1), aoc, 1, 0);
    if (wr == 1) PG8_BAR;
    PG8_WAIT_V(2); PG8_BAR;
    PG8_STAGE(PG8_SB(1, 0), cB + kstep, voffB); PG8_STAGE_A(PG8_SA(1, 0), aoc, 0, 128); PG8_STAGE(PG8_SB(1, 1), cB + hstep + kstep, voffB);
    PG8_WAIT_V(6); PG8_BAR;
    for (;;) {
        const bool has_next = S.next(ui + 1, nxt);
        const char* nB = cB;
        if (has_next) { PG8_AOFFS(aon, nxt); nB = (const char*)g.Bt + (size_t)nxt.pn * tstep; }
        else {
#pragma unroll
            for (int _h = 0; _h < 2; ++_h)
#pragma unroll
                for (int _i = 0; _i < 2; ++_i) aon[_h][_i] = aoc[_h][_i]; }
#pragma nounroll
        for (int t = 0; t < nt; t += 2) {
            const bool last = (t == nt - 2);
            const unsigned k1 = (unsigned)(t + 1) * 128u, k2 = last ? 0u : (unsigned)(t + 2) * 128u, k3 = k2 + 128u;
            const char* b2 = last ? nB : cB + (size_t)(t + 2) * kstep; const char* b3 = b2 + kstep;
            PG8_LDB(B0, 0, 0); PG8_LDB(B1, 0, 1); PG8_SCHED; PG8_LDA(At, 0, 0); PG8_STAGE_A(PG8_SA(1, 1), aoc, 1, k1);
            PG8_WAIT_V(8); PG8_WAIT_L(0); PG8_BAR; PG8_MMA(0, 0, At, B0); PG8_MMA(0, 1, At, B1); PG8_BAR; PG8_SCHED;
            if (last) {
#pragma unroll
                for (int _h = 0; _h < 2; ++_h)
#pragma unroll
                    for (int _i = 0; _i < 2; ++_i) aoc[_h][_i] = aon[_h][_i]; }
            PG8_LDA(At, 0, 1); PG8_STAGE(PG8_SB(0, 0), b2, voffB); PG8_STAGE(PG8_SB(0, 1), b2 + hstep, voffB); PG8_STAGE_A(PG8_SA(0, 0), aoc, 0, k2);
            PG8_WAIT_V(8); PG8_WAIT_L(0); PG8_BAR; PG8_MMA(1, 0, At, B0); PG8_MMA(1, 1, At, B1); PG8_BAR; PG8_SCHED;
            PG8_LDB(B0, 1, 0); PG8_LDB(B1, 1, 1); PG8_SCHED; PG8_LDA(At, 1, 0); PG8_STAGE_A(PG8_SA(0, 1), aoc, 1, k2);
            PG8_WAIT_V(8); PG8_WAIT_L(0); PG8_BAR; PG8_MMA(0, 0, At, B0); PG8_MMA(0, 1, At, B1); PG8_BAR; PG8_SCHED;
            PG8_LDA(At, 1, 1); PG8_STAGE(PG8_SB(1, 0), b3, voffB); PG8_STAGE(PG8_SB(1, 1), b3 + hstep, voffB); PG8_STAGE_A(PG8_SA(1, 0), aoc, 0, k3);
            PG8_WAIT_V(8); PG8_WAIT_L(0); PG8_BAR; PG8_MMA(1, 0, At, B0); PG8_MMA(1, 1, At, B1); PG8_BAR; PG8_SCHED;
        }
        if constexpr (ALIGN_EPI) { if (wr == 0) PG8_BAR; }
        { int t2 = threadIdx.x; asm volatile("" : "+v"(t2));
          const int w2 = __builtin_amdgcn_readfirstlane(t2 >> 6), l2 = t2 & 63; E(acc, cur, w2 >> 2, w2 & 3, l2 & 15, l2 >> 4); }
        if (!has_next) break;
#pragma unroll
        for (int a = 0; a < 2; ++a)
#pragma unroll
            for (int b = 0; b < 2; ++b)
#pragma unroll
                for (int m = 0; m < 4; ++m)
#pragma unroll
                    for (int n = 0; n < 2; ++n) acc[a][b][m][n] = (f32x4){0.f, 0.f, 0.f, 0.f};
        cur = nxt; cB = nB; ++ui;
        if constexpr (ALIGN_EPI) { if (wr == 1) PG8_BAR; }
    }
    PG8_WAIT_V(0);
    if constexpr (!ALIGN_EPI) { if (wr == 0) PG8_BAR; }
    PG8_BAR;
#undef PG8_SA
#undef PG8_SB
#undef PG8_STAGE
#undef PG8_STAGE_A
#undef PG8_LDA
#undef PG8_LDB
#undef PG8_MMA
#undef PG8_CAT8
#undef PG8_WAIT_V
#undef PG8_WAIT_L
#undef PG8_BAR
#undef PG8_SCHED
#undef PG8_AOFFS
}
}
struct SchedPlain : pg8::StaticOrder {
    unsigned rowbytes;
    DEV unsigned row_off(const pg8::Unit& u, int r) const { return (unsigned)(u.pm * 256 + r) * rowbytes; }
};
struct SchedMoe1 : pg8::StaticOrder {
    const int* idx;
    DEV bool next(int i, pg8::Unit& u) const { if (!pg8::StaticOrder::next(i, u)) return false; u.pn += (u.pm >> 4) * 16; return true; }
    DEV unsigned row_off(const pg8::Unit& u, int r) const { const int g = u.pm * 256 + r; const int tok = ((g >> 9) & 7) * S + idx[g]; return (unsigned)tok * (unsigned)D; }
};
struct SchedMoe2 : pg8::StaticOrder {
    DEV bool next(int i, pg8::Unit& u) const { if (!pg8::StaticOrder::next(i, u)) return false; u.pn += (u.pm >> 4) * 4; return true; }
    DEV unsigned row_off(const pg8::Unit& u, int r) const { return (unsigned)(u.pm * 256 + r) * (unsigned)DFF; }
};
typedef pg8::f32x4 f32x4; typedef pg8::u32x4 u32x4;
struct EpiInProj {
    static constexpr bool PERM = true;
    unsigned char* ws; const float* ropeT;
    DEV void operator()(const f32x4 (&acc)[2][2][4][2], const pg8::Unit& u, int wr, int wc, int fr, int fq) const {
        const int grp = u.pn >> 1;
        bf16_t* gbase = (bf16_t*)(ws + WS_RQ + (size_t)grp * 32 * MiB);
        const float sc = (grp == 1) ? 0.125f : (grp == 4 ? 0.125f * LOG2E : 1.f);
#pragma unroll
        for (int ai = 0; ai < 2; ++ai)
#pragma unroll
            for (int m = 0; m < 4; ++m) {
                const int row = u.pm * 256 + ai * 128 + wr * 64 + m * 16 + fr, b = row >> 12, s = row & 4095;
#pragma unroll
                for (int bj = 0; bj < 2; ++bj) {
                    const int hd = 4 * (u.pn & 1) + 2 * bj + (wc >> 1), j0 = 32 * (wc & 1) + 8 * fq;
                    f32x4 lo = acc[ai][bj][m][0], hi = acc[ai][bj][m][1];
                    if (grp < 2) {
                        const f32x4 c = *(const f32x4*)(ropeT + s * 32 + (j0 >> 1)), sn = *(const f32x4*)(ropeT + S * 32 + s * 32 + (j0 >> 1));
                        const f32x4 l2 = lo * c - hi * sn, h2 = hi * c + lo * sn; lo = l2; hi = h2;
                    }
                    lo = lo * sc; hi = hi * sc;
                    u32x4 w; w.x = pg8::cvt_pk_bf16(lo[0], lo[1]); w.y = pg8::cvt_pk_bf16(lo[2], lo[3]); w.z = pg8::cvt_pk_bf16(hi[0], hi[1]); w.w = pg8::cvt_pk_bf16(hi[2], hi[3]);
                    *(u32x4*)(gbase + ((size_t)(b * NH + hd) * S + s) * HD + j0) = w;
                }
            }
    }
};
struct EpiOutProj {
    static constexpr bool PERM = true;
    const float* x; bf16_t* x1;
    DEV void operator()(const f32x4 (&acc)[2][2][4][2], const pg8::Unit& u, int wr, int wc, int fr, int fq) const {
#pragma unroll
        for (int ai = 0; ai < 2; ++ai)
#pragma unroll
            for (int m = 0; m < 4; ++m) {
                const int row = u.pm * 256 + ai * 128 + wr * 64 + m * 16 + fr;
                f32x4 xa[2], xb[2];
#pragma unroll
                for (int bj = 0; bj < 2; ++bj) { const size_t off = (size_t)row * D + u.pn * 256 + bj * 128 + wc * 32 + 8 * fq; xa[bj] = *(const f32x4*)(x + off); xb[bj] = *(const f32x4*)(x + off + 4); }
#pragma unroll
                for (int bj = 0; bj < 2; ++bj) { const size_t off = (size_t)row * D + u.pn * 256 + bj * 128 + wc * 32 + 8 * fq;
                    const f32x4 lo = xa[bj] + acc[ai][bj][m][0], hi = xb[bj] + acc[ai][bj][m][1];
                    u32x4 w; w.x = pg8::cvt_pk_bf16(lo[0], lo[1]); w.y = pg8::cvt_pk_bf16(lo[2], lo[3]); w.z = pg8::cvt_pk_bf16(hi[0], hi[1]); w.w = pg8::cvt_pk_bf16(hi[2], hi[3]);
                    *(u32x4*)(x1 + off) = w; }
            }
    }
};
DEV unsigned pk4_fp8e(float a, float b, float c, float d) { unsigned w = 0u; w = __builtin_amdgcn_cvt_pk_fp8_f32(a, b, w, false); w = __builtin_amdgcn_cvt_pk_fp8_f32(c, d, w, true); return w; }
struct EpiSwiGLU {
    static constexpr bool PERM = true;
    unsigned char* hid;
    DEV void operator()(const f32x4 (&acc)[2][2][4][2], const pg8::Unit& u, int wr, int wc, int fr, int fq) const {
        const int pnl = u.pn & 15;
#pragma unroll
        for (int ai = 0; ai < 2; ++ai)
#pragma unroll
            for (int m = 0; m < 4; ++m) {
                const int row = u.pm * 256 + ai * 128 + wr * 64 + m * 16 + fr;
                float o[8];
#pragma unroll
                for (int n = 0; n < 2; ++n)
#pragma unroll
                    for (int i = 0; i < 4; ++i) { const float gt = acc[ai][0][m][n][i] * (1.f / 32.f), up = acc[ai][1][m][n][i] * (1.f / 32.f);
                        o[4 * n + i] = gt * __builtin_amdgcn_rcpf(1.f + __builtin_amdgcn_exp2f(-gt * LOG2E)) * up; }
                *(uint2*)(hid + (size_t)row * DFF + pnl * 128 + wc * 32 + 8 * fq) = make_uint2(pk4_fp8e(o[0], o[1], o[2], o[3]), pk4_fp8e(o[4], o[5], o[6], o[7]));
            }
    }
};
struct EpiDown {
    static constexpr bool PERM = true;
    bf16_t* y;
    DEV void operator()(const f32x4 (&acc)[2][2][4][2], const pg8::Unit& u, int wr, int wc, int fr, int fq) const {
        const int pnl = u.pn & 3;
#pragma unroll
        for (int ai = 0; ai < 2; ++ai)
#pragma unroll
            for (int m = 0; m < 4; ++m) {
                const int row = u.pm * 256 + ai * 128 + wr * 64 + m * 16 + fr;
#pragma unroll
                for (int bj = 0; bj < 2; ++bj) { const f32x4 lo = acc[ai][bj][m][0] * (1.f / 32.f), hi = acc[ai][bj][m][1] * (1.f / 32.f);
                    u32x4 w; w.x = pg8::cvt_pk_bf16(lo[0], lo[1]); w.y = pg8::cvt_pk_bf16(lo[2], lo[3]); w.z = pg8::cvt_pk_bf16(hi[0], hi[1]); w.w = pg8::cvt_pk_bf16(hi[2], hi[3]);
                    *(u32x4*)(y + (size_t)row * D + pnl * 256 + bj * 128 + wc * 32 + 8 * fq) = w; }
            }
    }
};
struct Args { const float* in[13]; float* out; unsigned char* ws; int ph_lo, ph_hi; int rep[12]; };
enum { IN_X = 0, IN_G1, IN_WIN, IN_DECAY, IN_GN, IN_RELB, IN_WOUT, IN_G2, IN_WR, IN_WG, IN_WU, IN_WDN, IN_FG };

struct TrItem { const float* src; bf16_t* dst; int K, N, k0, n0, mode, fp8; };
DEV unsigned pk4_fp8(float a, float b, float c, float d) { unsigned w = 0u; w = __builtin_amdgcn_cvt_pk_fp8_f32(a, b, w, false); w = __builtin_amdgcn_cvt_pk_fp8_f32(c, d, w, true); return w; }
DEV void tr_load(const TrItem& t, f32x4 (&v)[16], int lane) {
#pragma unroll
    for (int i = 0; i < 16; ++i) { const int kk = (lane >> 4) + 4 * i, c = (lane & 15) * 4; v[i] = *(const f32x4*)(t.src + (size_t)(t.k0 + kk) * t.N + t.n0 + c); }
}
DEV int rowmap_rt(int mode, int n) {
    if (mode == 0) return n;
    if (mode == 1) { if (n >= 1024) return n; const int base = n & ~63, d = n & 63, nn = d >> 5, dd = d & 31; return base + 8 * (dd >> 2) + 4 * nn + (dd & 3); }
    return (n >> 7) * 256 + (mode == 3 ? 128 : 0) + (n & 127);
}
DEV void tr_finish(const TrItem& t, const f32x4 (&v)[16], LAS float* scr, int lane) {
#pragma unroll
    for (int i = 0; i < 16; ++i) { const int kk = (lane >> 4) + 4 * i, c = (lane & 15) * 4;
        scr[kk * 65 + c] = v[i][0]; scr[kk * 65 + c + 1] = v[i][1]; scr[kk * 65 + c + 2] = v[i][2]; scr[kk * 65 + c + 3] = v[i][3]; }
    LDS_WAIT();
#pragma unroll
    for (int i = 0; i < 8; ++i) { const int n = (lane >> 3) + 8 * i, c = (lane & 7) * 8; const LAS float* sp = scr + c * 65 + n;
        if (t.fp8) {
            const unsigned lo = pk4_fp8(sp[0] * 32.f, sp[65] * 32.f, sp[2 * 65] * 32.f, sp[3 * 65] * 32.f), hi = pk4_fp8(sp[4 * 65] * 32.f, sp[5 * 65] * 32.f, sp[6 * 65] * 32.f, sp[7 * 65] * 32.f);
            *(uint2*)((unsigned char*)t.dst + (size_t)rowmap_rt(t.mode, t.n0 + n) * t.K + t.k0 + c) = make_uint2(lo, hi);
        } else {
        u32x4 o; o.x = pk2(sp[0], sp[65]); o.y = pk2(sp[2 * 65], sp[3 * 65]); o.z = pk2(sp[4 * 65], sp[5 * 65]); o.w = pk2(sp[6 * 65], sp[7 * 65]);
        *(u32x4*)(t.dst + (size_t)rowmap_rt(t.mode, t.n0 + n) * t.K + t.k0 + c) = o; } }
    LDS_WAIT();
}
template <class Dec> DEV void tr_run(const Dec& dec, int nitems, int gw, int NGW, LAS float* scr, int lane) {
    for (int it = gw; it < nitems; it += NGW) { TrItem cur; f32x4 va[16]; dec(it, cur); tr_load(cur, va, lane); tr_finish(cur, va, scr, lane); }
}
DEV void rms_row_to_bf16(const float* xrow, const float* g, bf16_t* orow, int lane) {
    const float4* xr = (const float4*)xrow + lane;
    float4 v[4]; float s = 0.f;
#pragma unroll
    for (int j = 0; j < 4; ++j) { v[j] = xr[64 * j]; s += v[j].x * v[j].x + v[j].y * v[j].y + v[j].z * v[j].z + v[j].w * v[j].w; }
    const float rs = rsqrtf(wave_sum(s) * (1.f / D) + EPS);
    uint2* o = (uint2*)orow + lane;
#pragma unroll
    for (int j = 0; j < 4; ++j) { const float4 gg = ((const float4*)g)[lane + 64 * j];
        o[64 * j] = make_uint2(pk2(v[j].x * rs * gg.x, v[j].y * rs * gg.y), pk2(v[j].z * rs * gg.z, v[j].w * rs * gg.w)); }
}
DEV void phase_prep(const Args& a, unsigned char* lds, int gw, int NGW, int lane, int wave) {
    unsigned char* ws = a.ws;
    float* ropeT = (float*)(ws + WS_ROPE); float* biasT = (float*)(ws + WS_BIAS);
    for (int t = gw * 64 + lane; t < S * 32; t += NGW * 64) {
        const int pos = t >> 5, i = t & 31; const double inv = pow(10000.0, -(double)i / 32.0), ang = (double)pos * inv;
        ropeT[t] = (float)cos(ang); ropeT[S * 32 + t] = (float)sin(ang);
        if (t < 3 * NH * 129) { const int p = t / (NH * 129), h = (t / 129) % NH, o = t % 129 - 64, dil = p == 0 ? 1 : (p == 1 ? 4 : 16), rel = o * dil, n = rel < 0 ? -rel : rel;
            int bucket = rel > 0 ? 16 : 0;
            if (n < 8) bucket += n; else { int large = 8 + (int)(log((double)n / 8.0) / log(128.0) * 8.0); if (large > 15) large = 15; bucket += large; }
            biasT[t] = a.in[IN_RELB][bucket * NH + h] * LOG2E; }
    }
    LAS float* scr = (LAS float*)((LAS unsigned char*)lds + wave * 16640);
    constexpr int I_IN = (D / 64) * (PC / 64), I_OUT = (D / 64) * (D / 64);
    { const float* w_in = a.in[IN_WIN]; const float* w_out = a.in[IN_WOUT]; bf16_t* Win = (bf16_t*)(ws + WS_WIN); bf16_t* Wout = (bf16_t*)(ws + WS_WOUT);
      auto dec = [=](int it, TrItem& t) { if (it < I_IN) { t.src = w_in; t.dst = Win; t.K = D; t.N = PC; t.k0 = (it / (PC / 64)) * 64; t.n0 = (it % (PC / 64)) * 64; t.mode = 1; t.fp8 = 0; }
          else { const int r = it - I_IN; t.src = w_out; t.dst = Wout; t.K = D; t.N = D; t.k0 = (r / (D / 64)) * 64; t.n0 = (r % (D / 64)) * 64; t.mode = 0; t.fp8 = 0; } };
      tr_run(dec, I_IN + I_OUT, gw, NGW, scr, lane); }
    for (int m = gw; m < M; m += NGW) rms_row_to_bf16(a.in[IN_X] + (size_t)m * D, a.in[IN_G1], (bf16_t*)(ws + WS_XN) + (size_t)m * D, lane);
}
DEV void phase_latew(const Args& a, unsigned char* lds, int gw, int NGW, int lane, int wave) {
    unsigned char* ws = a.ws; LAS float* scr = (LAS float*)((LAS unsigned char*)lds + wave * 16640);
    constexpr int I_G = (D / 64) * (DFF / 64);
    const float* wg_ = a.in[IN_WG]; const float* wu_ = a.in[IN_WU]; const float* wd_ = a.in[IN_WDN]; bf16_t* Wgu = (bf16_t*)(ws + WS_WGU); bf16_t* Wd = (bf16_t*)(ws + WS_WD);
    auto dec = [=](int it, TrItem& t) { const int which = it / (NE * I_G), r = it % (NE * I_G), e = r / I_G, q = r % I_G;
        t.fp8 = 1;
        if (which < 2) { t.src = (which == 0 ? wg_ : wu_) + (size_t)e * D * DFF; t.dst = (bf16_t*)((unsigned char*)Wgu + (size_t)e * 4096 * D); t.K = D; t.N = DFF; t.k0 = (q / (DFF / 64)) * 64; t.n0 = (q % (DFF / 64)) * 64; t.mode = 2 + which; }
        else { t.src = wd_ + (size_t)e * DFF * D; t.dst = (bf16_t*)((unsigned char*)Wd + (size_t)e * D * DFF); t.K = DFF; t.N = D; t.k0 = (q / (D / 64)) * 64; t.n0 = (q % (D / 64)) * 64; t.mode = 0; } };
    tr_run(dec, 3 * NE * I_G, gw, NGW, scr, lane);
}
DEV void phase_router(const Args& a, unsigned char* lds, int gw, int NGW, int lane, int tid) {
    unsigned char* ws = a.ws; const bf16_t* x1 = (const bf16_t*)(ws + WS_X1); const float* g2 = a.in[IN_G2]; const float* wr = a.in[IN_WR];
    bf16_t* H2b = (bf16_t*)(ws + WS_XN); float* aff = (float*)(ws + WS_AFF); float* affT = (float*)(ws + WS_AFFT); int* inv = (int*)(ws + WS_INV);
    LAS f32x4* wl = (LAS f32x4*)(LAS unsigned char*)lds;
    for (int i = tid; i < D * 4; i += NTHR) { const int k = i >> 2, c = i & 3, slot = (k & 3) * 256 + (k >> 2); wl[slot * 4 + ((c + (slot >> 2)) & 3)] = *(const f32x4*)(wr + (size_t)k * NE + 4 * c); }
    __syncthreads();
    uint2 xw[4], xn[4];
    { const uint2* xr = (const uint2*)(x1 + (size_t)gw * D) + lane;
#pragma unroll
      for (int j = 0; j < 4; ++j) xw[j] = xr[64 * j]; }
    for (int row = gw; row < M; row += NGW) {
        if (row + NGW < M) { const uint2* xr = (const uint2*)(x1 + (size_t)(row + NGW) * D) + lane;
#pragma unroll
            for (int j = 0; j < 4; ++j) xn[j] = xr[64 * j]; }
        float4 v[4]; float s = 0.f;
#pragma unroll
        for (int j = 0; j < 4; ++j) { v[j] = make_float4(bf2f(xw[j].x & 0xffffu), bf2f(xw[j].x >> 16), bf2f(xw[j].y & 0xffffu), bf2f(xw[j].y >> 16)); s += v[j].x * v[j].x + v[j].y * v[j].y + v[j].z * v[j].z + v[j].w * v[j].w; }
#pragma unroll
        for (int j = 0; j < 4; ++j) xw[j] = xn[j];
        const float rs = rsqrtf(wave_sum(s) * (1.f / D) + EPS);
        f32x4 lg[4];
#pragma unroll
        for (int c = 0; c < 4; ++c) lg[c] = (f32x4){0.f, 0.f, 0.f, 0.f};
        unsigned* o = (unsigned*)((unsigned char*)H2b + (size_t)row * D) + lane;
#pragma unroll
        for (int j = 0; j < 4; ++j) { const float4 gg = ((const float4*)g2)[lane + 64 * j];
            const float hv[4] = {v[j].x * rs * gg.x, v[j].y * rs * gg.y, v[j].z * rs * gg.z, v[j].w * rs * gg.w};
            o[64 * j] = pk4_fp8(hv[0], hv[1], hv[2], hv[3]);
#pragma unroll
            for (int t = 0; t < 4; ++t) { const int slot = t * 256 + lane + 64 * j, rot = (lane >> 2) & 3;
#pragma unroll
                for (int c = 0; c < 4; ++c) lg[c] += hv[t] * wl[slot * 4 + ((c + rot) & 3)];
                __builtin_amdgcn_sched_barrier(0); } }
        float l16[16]; float mx = -1e30f;
#pragma unroll
        for (int e = 0; e < 16; ++e) { l16[e] = wave_sum(lg[e >> 2][e & 3]); mx = fmaxf(mx, l16[e]); }
        float sum = 0.f;
#pragma unroll
        for (int e = 0; e < 16; ++e) { l16[e] = __expf(l16[e] - mx); sum += l16[e]; }
        const float is = 1.f / sum;
        if (lane < 16) { float av = 0.f;
#pragma unroll
            for (int e = 0; e < 16; ++e) av = lane == e ? l16[e] * is : av;
            aff[(size_t)row * NE + lane] = av; inv[(size_t)row * NE + lane] = -1; affT[((size_t)(row >> 12) * NE + lane) * S + (row & 4095)] = av; }
    }
    __syncthreads();
}
DEV void phase_topk(const Args& a, unsigned char* lds, int wg, int G, int tid, int lane, int wave) {
    unsigned char* ws = a.ws; const float* affT = (const float*)(ws + WS_AFFT); int* idx = (int*)(ws + WS_IDX); int* inv = (int*)(ws + WS_INV);
    LAS unsigned* hist = (LAS unsigned*)(LAS unsigned char*)lds; LAS unsigned* wsum = hist + 256; LAS unsigned* bc = hist + 272;
    for (int it = wg; it < NE * NB; it += G) {
        const int e = it & 15, b = it >> 4;
        unsigned u[8];
        { const uint4* src = (const uint4*)(affT + ((size_t)b * NE + e) * S + 8 * tid); const uint4 p = src[0], q = src[1]; u[0] = p.x; u[1] = p.y; u[2] = p.z; u[3] = p.w; u[4] = q.x; u[5] = q.y; u[6] = q.z; u[7] = q.w; }
        unsigned prefix = 0u, kk = CAP;
#pragma unroll
        for (int pass = 0; pass < 4; ++pass) {
            const int shift = 24 - 8 * pass;
            __syncthreads();
            if (tid < 256) hist[tid] = 0u;
            __syncthreads();
#pragma unroll
            for (int j = 0; j < 8; ++j) if (pass == 0 || (u[j] >> (shift + 8)) == prefix) atomicAdd((unsigned*)&hist[(u[j] >> shift) & 255u], 1u);
            __syncthreads();
            if (wave == 0) {
                const unsigned c0 = hist[4 * lane], c1 = hist[4 * lane + 1], c2 = hist[4 * lane + 2], c3 = hist[4 * lane + 3], tot = c0 + c1 + c2 + c3;
                unsigned incl = tot;
#pragma unroll
                for (int o = 1; o < 64; o <<= 1) { const unsigned t = __shfl_down(incl, o); if (lane + o < 64) incl += t; }
                const unsigned excl = incl - tot;
                if (excl < kk && kk <= incl) { unsigned acc = excl; int bin;
                    if (acc + c3 >= kk) bin = 3; else { acc += c3; if (acc + c2 >= kk) bin = 2; else { acc += c2; if (acc + c1 >= kk) bin = 1; else { acc += c1; bin = 0; } } }
                    bc[0] = 4 * lane + bin; bc[1] = kk - acc; }
            }
            __syncthreads();
            prefix = (prefix << 8) | bc[0]; kk = bc[1];
        }
        const unsigned T = prefix, need = kk;
        unsigned cg_ = 0u, ce = 0u;
#pragma unroll
        for (int j = 0; j < 8; ++j) { cg_ += u[j] > T; ce += u[j] == T; }
        unsigned pk = cg_ | (ce << 16), incl = pk;
#pragma unroll
        for (int o = 1; o < 64; o <<= 1) { const unsigned t = __shfl_up(incl, o); if (lane >= o) incl += t; }
        if (lane == 63) wsum[wave] = incl;
        __syncthreads();
        unsigned base = 0u;
#pragma unroll
        for (int w = 0; w < NWAVES; ++w) base += w < wave ? wsum[w] : 0u;
        const unsigned ex = base + incl - pk; unsigned gtb = ex & 0xffffu, eqb = ex >> 16;
#pragma unroll
        for (int j = 0; j < 8; ++j) { const bool g = u[j] > T, q = u[j] == T; const unsigned slot = gtb + (eqb < need ? eqb : need);
            if (g || (q && eqb < need)) { const int s = 8 * tid + j; idx[(e * NB + b) * CAP + slot] = s; inv[((size_t)b * S + s) * NE + e] = (int)slot; }
            gtb += g; eqb += q; }
    }
}
DEV void phase_final(const Args& a, int gw, int NGW, int lane) {
    unsigned char* ws = a.ws; float* xo = a.out; const bf16_t* x1 = (const bf16_t*)(ws + WS_X1); const float* aff = (const float*)(ws + WS_AFF); const int* inv = (const int*)(ws + WS_INV);
    const bf16_t* y = (const bf16_t*)(ws + WS_Y); const float* fg = a.in[IN_FG];
    uint2 xw[4], xn[4]; int iv = -1, ivn = -1; float av = 0.f, avn = 0.f;
    { const uint2* xr = (const uint2*)(x1 + (size_t)gw * D) + lane;
#pragma unroll
      for (int j = 0; j < 4; ++j) xw[j] = xr[64 * j];
      if (lane < NE) { iv = inv[(size_t)gw * NE + lane]; av = aff[(size_t)gw * NE + lane]; } }
    for (int row = gw; row < M; row += NGW) {
        const int b = row >> 12;
        if (row + NGW < M) { const uint2* xr = (const uint2*)(x1 + (size_t)(row + NGW) * D) + lane;
#pragma unroll
            for (int j = 0; j < 4; ++j) xn[j] = xr[64 * j];
            if (lane < NE) { ivn = inv[(size_t)(row + NGW) * NE + lane]; avn = aff[(size_t)(row + NGW) * NE + lane]; } }
        float4 v[4];
#pragma unroll
        for (int j = 0; j < 4; ++j) v[j] = make_float4(bf2f(xw[j].x & 0xffffu), bf2f(xw[j].x >> 16), bf2f(xw[j].y & 0xffffu), bf2f(xw[j].y >> 16));
        unsigned long long msk = __ballot(lane < NE && iv >= 0);
        while (msk) { const int e = __builtin_ctzll(msk); msk &= msk - 1;
            const int sl = __builtin_amdgcn_readlane(iv, e); const float g = __builtin_bit_cast(float, __builtin_amdgcn_readlane(__builtin_bit_cast(int, av), e));
            const uint2* yr = (const uint2*)(y + ((size_t)e * 4096 + b * CAP + sl) * D) + lane;
#pragma unroll
            for (int j = 0; j < 4; ++j) { const uint2 w = yr[64 * j]; v[j].x += g * bf2f(w.x & 0xffffu); v[j].y += g * bf2f(w.x >> 16); v[j].z += g * bf2f(w.y & 0xffffu); v[j].w += g * bf2f(w.y >> 16); } }
        float s = 0.f;
#pragma unroll
        for (int j = 0; j < 4; ++j) s += v[j].x * v[j].x + v[j].y * v[j].y + v[j].z * v[j].z + v[j].w * v[j].w;
        const float rs = rsqrtf(wave_sum(s) * (1.f / D) + EPS);
        float4* orow = (float4*)(xo + (size_t)row * D) + lane;
#pragma unroll
        for (int j = 0; j < 4; ++j) { const float4 gg = ((const float4*)fg)[lane + 64 * j]; orow[64 * j] = make_float4(v[j].x * rs * gg.x, v[j].y * rs * gg.y, v[j].z * rs * gg.z, v[j].w * rs * gg.w); }
#pragma unroll
        for (int j = 0; j < 4; ++j) xw[j] = xn[j];
        iv = ivn; av = avn;
    }
}
typedef short bf16x8 __attribute__((ext_vector_type(8)));
typedef float f32x16 __attribute__((ext_vector_type(16)));
typedef short s16x4 __attribute__((ext_vector_type(4)));
typedef LAS const char* lds_cptr;
constexpr int VROW = 192;
constexpr int VSLOT = 32 * VROW;
constexpr int KROW = 144;
constexpr int KSLOT = 32 * KROW;
constexpr int MIX_WAVE_LDS = 2 * VSLOT;
constexpr int MIX_BIAS_OFF = NWAVES * MIX_WAVE_LDS;
DEV int crow(int r, int hi) { return (r & 3) + 8 * (r >> 2) + 4 * hi; }
DEV s16x4 vtr(lds_cptr p) { return __builtin_bit_cast(s16x4, __builtin_amdgcn_ds_read_tr16_b64_v4i16((LAS s16x4*)p)); }
DEV bf16x8 tr_frag(lds_cptr slot, int s, int blk, int lane) {
    const int h = lane >> 5; lds_cptr p = slot + (16 * s + 4 * h + ((lane & 15) >> 2)) * VROW + (32 * blk + 16 * ((lane >> 4) & 1) + 4 * (lane & 3)) * 2;
    const s16x4 lo = vtr(p), hi = vtr(p + 8 * VROW);
    return (bf16x8){lo[0], lo[1], lo[2], lo[3], hi[0], hi[1], hi[2], hi[3]};
}
DEV void load_frags(bf16x8 (&f)[4], const bf16_t* rowp, int lane) {
    const int h = lane >> 5;
#pragma unroll
    for (int st = 0; st < 4; ++st) f[st] = *(const bf16x8*)(rowp + 16 * st + 8 * h);
}
DEV bf16x8 pack_p(const f32x16& p, int s) {
    u32x4 w; w.x = pg8::cvt_pk_bf16(p[8 * s], p[8 * s + 1]); w.y = pg8::cvt_pk_bf16(p[8 * s + 2], p[8 * s + 3]); w.z = pg8::cvt_pk_bf16(p[8 * s + 4], p[8 * s + 5]); w.w = pg8::cvt_pk_bf16(p[8 * s + 6], p[8 * s + 7]);
    return __builtin_bit_cast(bf16x8, w);
}

DEV void stage_rows_k(LAS unsigned char* ks, const u32x4 (&raw)[4], int lane) {
    const int rr = lane >> 3, ch = lane & 7;
#pragma unroll
    for (int i = 0; i < 4; ++i) *(LAS u32x4*)(ks + (rr + 8 * i) * KROW + ch * 16) = raw[i];
}
DEV void read_row_frags(bf16x8 (&f)[4], const LAS unsigned char* ks, int lane) {
    const LAS unsigned char* p = ks + (lane & 31) * KROW + (lane >> 5) * 16;
#pragma unroll
    for (int st = 0; st < 4; ++st) f[st] = *(const LAS bf16x8*)(p + st * 32);
}
#define MFMA32(a, b, c) __builtin_amdgcn_mfma_f32_32x32x16_bf16((a), (b), (c), 0, 0, 0)
DEV float ex2(float x) { return __builtin_amdgcn_exp2f(x); }

struct AttnIt { int p, bh, dil, L, r, q0, kmin, kmax; };
DEV void attn_decode(int li, int x, AttnIt& d) {
    d.p = li >> 10; d.bh = 8 * x + ((li >> 7) & 7); const int qblk = li & 127;
    d.dil = d.p == 0 ? 1 : (d.p == 1 ? 4 : 16); d.L = S / d.dil; const int bpr = d.L >> 5;
    d.r = qblk / bpr; d.q0 = (qblk % bpr) * 32;
    d.kmin = d.q0 >= 64 ? 0 : (64 - d.q0) >> 5; const int km = (d.L + 63 - d.q0) >> 5; d.kmax = km > 4 ? 4 : km;
}
DEV void attn_ldq(const Args& a, const AttnIt& d, u32x4 (&q)[4], int lane) {
    const bf16_t* Qh = (const bf16_t*)(a.ws + WS_AQ) + (size_t)d.bh * S * HD; const int rr = lane >> 3, ch = lane & 7;
#pragma unroll
    for (int i = 0; i < 4; ++i) q[i] = *(const u32x4*)(Qh + (size_t)((d.q0 + rr + 8 * i) * d.dil + d.r) * HD + ch * 8);
}
DEV void attn_ldkv(const Args& a, const AttnIt& d, int kk, u32x4 (&k)[4], u32x4 (&v)[4], int lane) {
    const bf16_t* Kh = (const bf16_t*)(a.ws + WS_AK) + (size_t)d.bh * S * HD; const bf16_t* Vh = (const bf16_t*)(a.ws + WS_AV) + (size_t)d.bh * S * HD;
    const int kbase = d.q0 - 64 + 32 * kk, rr = lane >> 3, ch = lane & 7;
#pragma unroll
    for (int i = 0; i < 4; ++i) { int ki = kbase + rr + 8 * i; ki = ki < 0 ? 0 : (ki >= d.L ? d.L - 1 : ki); const size_t off = (size_t)(ki * d.dil + d.r) * HD + ch * 8;
        k[i] = *(const u32x4*)(Kh + off); v[i] = *(const u32x4*)(Vh + off); }
}
DEV void attn_items(const Args& a, unsigned char* lds, int wg, int G, int lane, int wave) {
    unsigned char* ws = a.ws;
    constexpr int NIT = 3 * 1024; constexpr float THR = 6.f;
    const int x = wg & 7, NGW = (G >> 3) * NWAVES;
    int item = (wg >> 3) * NWAVES + wave; if (item >= NIT) return;
    LAS unsigned char* slot = (LAS unsigned char*)lds + wave * MIX_WAVE_LDS; lds_cptr slot3 = (lds_cptr)slot; LAS unsigned char* kslot = slot + VSLOT;
    const int t = lane & 31, hi = lane >> 5, rr = lane >> 3, ch = lane & 7;
    AttnIt d; attn_decode(item, x, d);
    bf16x8 qf[4], kf[4]; u32x4 qraw[4], kraw[4], vv[4];
    attn_ldq(a, d, qraw, lane); attn_ldkv(a, d, d.kmin, kraw, vv, lane);
    for (;;) {
        const LAS float* tph = (const LAS float*)((LAS unsigned char*)lds + MIX_BIAS_OFF) + (d.p * NH + (d.bh & 7)) * 192 + (32 + 4 * hi - t);
        f32x16 o0 = {}, o1 = {}; float m = 0.f, l = 0.f;
        const int nitem = item + NGW; const bool hasn = nitem < NIT;
        AttnIt dn = d; if (hasn) attn_decode(nitem, x, dn);
        stage_rows_k(kslot, qraw, lane); asm volatile("" ::: "memory"); read_row_frags(qf, kslot, lane); asm volatile("" ::: "memory");
        for (int kk = d.kmin; kk <= d.kmax; ++kk) {
            const int kbase = d.q0 - 64 + 32 * kk;
#pragma unroll
            for (int i = 0; i < 4; ++i) *(LAS u32x4*)(slot + (rr + 8 * i) * VROW + ch * 16) = vv[i];
            stage_rows_k(kslot, kraw, lane);
            asm volatile("" ::: "memory");
            read_row_frags(kf, kslot, lane);
            f32x16 sc = {};
#pragma unroll
            for (int st = 0; st < 4; ++st) sc = MFMA32(kf[st], qf[st], sc);
            if (kk < d.kmax) attn_ldkv(a, d, kk + 1, kraw, vv, lane);
            else if (hasn) { attn_ldq(a, dn, qraw, lane); attn_ldkv(a, dn, dn.kmin, kraw, vv, lane); }
            const LAS float* tb = tph + 32 * kk;
#pragma unroll
            for (int rg = 0; rg < 16; ++rg) sc[rg] = (sc[rg] - m) + tb[(rg & 3) + 8 * (rg >> 2)];
            if (kbase < 0 || kbase + 31 >= d.L) {
#pragma unroll
                for (int rg = 0; rg < 16; ++rg) { const int ki = kbase + crow(rg, hi); sc[rg] = (ki >= 0 && ki < d.L) ? sc[rg] : -1e30f; } }
            float mx = fmaxf(fmaxf(sc[0], sc[1]), fmaxf(sc[2], sc[3]));
#pragma unroll
            for (int rg = 4; rg < 16; rg += 4) mx = fmaxf(mx, fmaxf(fmaxf(sc[rg], sc[rg + 1]), fmaxf(sc[rg + 2], sc[rg + 3])));
            mx = fmaxf(mx, __shfl_xor(mx, 32));
            const bool first = kk == d.kmin;
            if (first || __any(mx > THR)) {
                const float dl = first ? mx : fmaxf(mx, 0.f), f = ex2(-dl); m += dl; l *= f;
#pragma unroll
                for (int rg = 0; rg < 16; ++rg) { sc[rg] -= dl; o0[rg] *= f; o1[rg] *= f; }
            }
            float ps0 = 0.f, ps1 = 0.f;
#pragma unroll
            for (int rg = 0; rg < 16; rg += 2) { sc[rg] = ex2(sc[rg]); sc[rg + 1] = ex2(sc[rg + 1]); ps0 += sc[rg]; ps1 += sc[rg + 1]; }
            l += ps0 + ps1;
            const bf16x8 p0 = pack_p(sc, 0), p1 = pack_p(sc, 1);
            o0 = MFMA32(tr_frag(slot3, 0, 0, lane), p0, o0); o0 = MFMA32(tr_frag(slot3, 1, 0, lane), p1, o0);
            o1 = MFMA32(tr_frag(slot3, 0, 1, lane), p0, o1); o1 = MFMA32(tr_frag(slot3, 1, 1, lane), p1, o1);
            asm volatile("" ::: "memory");
        }
        l += __shfl_xor(l, 32);
        const float il = 1.f / l;
        const size_t orow = ((size_t)d.p * NB * NH + d.bh) * S + (size_t)((d.q0 + t) * d.dil + d.r);
        bf16_t* op = (bf16_t*)(ws + WS_ATTO) + orow * HD;
#pragma unroll
        for (int g4 = 0; g4 < 4; ++g4) {
            *(uint2*)(op + 8 * g4 + 4 * hi) = make_uint2(pg8::cvt_pk_bf16(o0[4 * g4] * il, o0[4 * g4 + 1] * il), pg8::cvt_pk_bf16(o0[4 * g4 + 2] * il, o0[4 * g4 + 3] * il));
            *(uint2*)(op + 32 + 8 * g4 + 4 * hi) = make_uint2(pg8::cvt_pk_bf16(o1[4 * g4] * il, o1[4 * g4 + 1] * il), pg8::cvt_pk_bf16(o1[4 * g4 + 2] * il, o1[4 * g4 + 3] * il));
        }
        if (hi == 0) ((float*)(ws + WS_ATTL))[orow] = m + __log2f(l);
        if (!hasn) break;
        item = nitem; d = dn;
    }
}
DEV void retstate_item(const Args& a, unsigned char* lds, int item, int xg, int lane, int wave) {
    unsigned char* ws = a.ws;
    const int dir = item & 1, n = (item >> 1) & 31, bh = 8 * xg + (item >> 6), h = bh & 7;
    const bf16_t* Kc = (const bf16_t*)(ws + WS_RK) + ((size_t)bh * S + n * 128) * HD; const bf16_t* Vc = (const bf16_t*)(ws + WS_RV) + ((size_t)bh * S + n * 128) * HD;
    const float lg = a.in[IN_DECAY][dir * NH + h] * LOG2E;
    LAS unsigned char* vs = (LAS unsigned char*)lds + wave * MIX_WAVE_LDS; LAS unsigned char* ks = vs + VSLOT; lds_cptr vs3 = (lds_cptr)vs, ks3 = (lds_cptr)ks;
    f32x16 acc[2][2] = {};
    for (int blk = 0; blk < 4; ++blk) {
        { const int rr = lane >> 3, ch = lane & 7;
          u32x4 v[4], k[4];
#pragma unroll
          for (int i = 0; i < 4; ++i) { const int mrow = 32 * blk + rr + 8 * i; v[i] = *(const u32x4*)(Vc + (size_t)mrow * HD + ch * 8); k[i] = *(const u32x4*)(Kc + (size_t)mrow * HD + ch * 8); }
#pragma unroll
          for (int i = 0; i < 4; ++i) { const int mrow = 32 * blk + rr + 8 * i; const float z = ex2(lg * (float)(dir == 0 ? 127 - mrow : mrow));
              const unsigned kw[4] = {k[i].x, k[i].y, k[i].z, k[i].w}; u32x4 o;
              o.x = pg8::cvt_pk_bf16(bf2f(kw[0] & 0xffffu) * z, bf2f(kw[0] >> 16) * z); o.y = pg8::cvt_pk_bf16(bf2f(kw[1] & 0xffffu) * z, bf2f(kw[1] >> 16) * z);
              o.z = pg8::cvt_pk_bf16(bf2f(kw[2] & 0xffffu) * z, bf2f(kw[2] >> 16) * z); o.w = pg8::cvt_pk_bf16(bf2f(kw[3] & 0xffffu) * z, bf2f(kw[3] >> 16) * z);
              *(LAS u32x4*)(vs + (rr + 8 * i) * VROW + ch * 16) = v[i]; *(LAS u32x4*)(ks + (rr + 8 * i) * VROW + ch * 16) = o; } }
        LDS_WAIT();
#pragma unroll
        for (int s = 0; s < 2; ++s) {
            const bf16x8 v0 = tr_frag(vs3, s, 0, lane), v1 = tr_frag(vs3, s, 1, lane), k0 = tr_frag(ks3, s, 0, lane), k1 = tr_frag(ks3, s, 1, lane);
            acc[0][0] = MFMA32(v0, k0, acc[0][0]); acc[0][1] = MFMA32(v0, k1, acc[0][1]); acc[1][0] = MFMA32(v1, k0, acc[1][0]); acc[1][1] = MFMA32(v1, k1, acc[1][1]);
        }
        LDS_WAIT();
    }
    float* KT = (float*)(ws + WS_KF) + (((size_t)dir * NB * NH + bh) * 32 + n) * 4096;
    const int c = lane & 31, hi = lane >> 5;
#pragma unroll
    for (int eb = 0; eb < 2; ++eb)
#pragma unroll
        for (int db = 0; db < 2; ++db)
#pragma unroll
            for (int rg = 0; rg < 16; ++rg) KT[(32 * eb + crow(rg, hi)) * 64 + 32 * db + c] = acc[eb][db][rg];
}
DEV void phase_scan(const Args& a, int gtid, int NT) {
    unsigned char* ws = a.ws;
    for (int sl = gtid; sl < 2 * NB * NH * 1024; sl += NT) {
        const int dir = sl >> 16, bh = (sl >> 10) & 63, q = sl & 1023, h = bh & 7;
        const float gC = ex2(a.in[IN_DECAY][dir * NH + h] * LOG2E * 128.f);
        const float4* kt = (const float4*)(ws + WS_KF) + ((size_t)dir * NB * NH + bh) * 32 * 1024 + q;
        uint2* st = (uint2*)(ws + WS_ST) + ((size_t)dir * NB * NH + bh) * 32 * 1024 + q;
        float4 s = make_float4(0.f, 0.f, 0.f, 0.f);
        for (int i = 0; i < 32; ++i) { const int n = dir == 0 ? i : 31 - i;
            st[(size_t)n * 1024] = make_uint2(pg8::cvt_pk_bf16(s.x, s.y), pg8::cvt_pk_bf16(s.z, s.w));
            const float4 kv = kt[(size_t)n * 1024];
            s.x = gC * s.x + kv.x; s.y = gC * s.y + kv.y; s.z = gC * s.z + kv.z; s.w = gC * s.w + kv.w; }
    }
}
DEV void retout_item(const Args& a, unsigned char* lds, int item, int xg, int lane, int wave) {
    unsigned char* ws = a.ws;
    const int qb = item & 3, n = (item >> 2) & 31, bh = 8 * xg + (item >> 7), h = bh & 7, b = bh >> 3;
    const bf16_t* Qc = (const bf16_t*)(ws + WS_RQ) + ((size_t)bh * S + n * 128) * HD; const bf16_t* Kc = (const bf16_t*)(ws + WS_RK) + ((size_t)bh * S + n * 128) * HD;
    const bf16_t* Vc = (const bf16_t*)(ws + WS_RV) + ((size_t)bh * S + n * 128) * HD;
    const bf16_t* SF = (const bf16_t*)(ws + WS_ST) + (((size_t)0 * NB * NH + bh) * 32 + n) * 4096; const bf16_t* SB = (const bf16_t*)(ws + WS_ST) + (((size_t)1 * NB * NH + bh) * 32 + n) * 4096;
    const float lg0 = a.in[IN_DECAY][h] * LOG2E, lg1 = a.in[IN_DECAY][NH + h] * LOG2E;
    LAS unsigned char* slot = (LAS unsigned char*)lds + wave * MIX_WAVE_LDS; lds_cptr slot3 = (lds_cptr)slot;
    const int t = lane & 31, hi = lane >> 5, c = 32 * qb + t;
    bf16x8 qf[4]; load_frags(qf, Qc + (size_t)c * HD, lane);
    f32x16 o0 = {}, o1 = {};
    { bf16x8 s0[4], s1[4]; load_frags(s0, SF + (size_t)t * 64, lane); load_frags(s1, SF + (size_t)(32 + t) * 64, lane);
#pragma unroll
      for (int st = 0; st < 4; ++st) { o0 = MFMA32(s0[st], qf[st], o0); o1 = MFMA32(s1[st], qf[st], o1); }
      const float fa = ex2(lg0 * (float)(c + 1) - lg1 * (float)(128 - c));
#pragma unroll
      for (int rg = 0; rg < 16; ++rg) { o0[rg] *= fa; o1[rg] *= fa; }
      load_frags(s0, SB + (size_t)t * 64, lane); load_frags(s1, SB + (size_t)(32 + t) * 64, lane);
#pragma unroll
      for (int st = 0; st < 4; ++st) { o0 = MFMA32(s0[st], qf[st], o0); o1 = MFMA32(s1[st], qf[st], o1); }
      const float fb = ex2(lg1 * (float)(128 - c));
#pragma unroll
      for (int rg = 0; rg < 16; ++rg) { o0[rg] *= fb; o1[rg] *= fb; } }
    for (int kb = 0; kb < 4; ++kb) {
        { const int rr = lane >> 3, ch = lane & 7;
          u32x4 v[4];
#pragma unroll
          for (int i = 0; i < 4; ++i) v[i] = *(const u32x4*)(Vc + (size_t)(32 * kb + rr + 8 * i) * HD + ch * 8);
#pragma unroll
          for (int i = 0; i < 4; ++i) *(LAS u32x4*)(slot + (rr + 8 * i) * VROW + ch * 16) = v[i]; }
        bf16x8 kf[4]; load_frags(kf, Kc + (size_t)(32 * kb + t) * HD, lane);
        f32x16 sc = {};
#pragma unroll
        for (int st = 0; st < 4; ++st) sc = MFMA32(kf[st], qf[st], sc);
#pragma unroll
        for (int rg = 0; rg < 16; ++rg) { const int mk = 32 * kb + crow(rg, hi), df = c - mk; sc[rg] *= df >= 0 ? ex2(lg0 * (float)df) : ex2(lg1 * (float)(-df)); }
        const bf16x8 p0 = pack_p(sc, 0), p1 = pack_p(sc, 1);
        LDS_WAIT();
        o0 = MFMA32(tr_frag(slot3, 0, 0, lane), p0, o0); o0 = MFMA32(tr_frag(slot3, 1, 0, lane), p1, o0);
        o1 = MFMA32(tr_frag(slot3, 0, 1, lane), p0, o1); o1 = MFMA32(tr_frag(slot3, 1, 1, lane), p1, o1);
        LDS_WAIT();
    }
    float sm = 0.f;
#pragma unroll
    for (int rg = 0; rg < 16; ++rg) sm += o0[rg] + o1[rg];
    sm += __shfl_xor(sm, 32); const float mu = sm * (1.f / 64.f); float vq = 0.f;
#pragma unroll
    for (int rg = 0; rg < 16; ++rg) { const float d0 = o0[rg] - mu, d1 = o1[rg] - mu; vq += d0 * d0 + d1 * d1; }
    vq += __shfl_xor(vq, 32); const float rstd = rsqrtf(vq * (1.f / 64.f) + EPS);
    const size_t pos = (size_t)n * 128 + c;
    const bf16_t* gp = (const bf16_t*)(ws + WS_RG) + ((size_t)bh * S + pos) * HD; bf16_t* op = (bf16_t*)(ws + WS_XN) + ((size_t)b * S + pos) * D + h * HD; const float* gn = a.in[IN_GN] + h * HD;
#pragma unroll
    for (int db = 0; db < 2; ++db)
#pragma unroll
        for (int g4 = 0; g4 < 4; ++g4) { const int e0 = 32 * db + 8 * g4 + 4 * hi; const uint2 gw = *(const uint2*)(gp + e0); const float4 gg = *(const float4*)(gn + e0);
            const float gate[4] = {bf2f(gw.x & 0xffffu), bf2f(gw.x >> 16), bf2f(gw.y & 0xffffu), bf2f(gw.y >> 16)}; const float gv[4] = {gg.x, gg.y, gg.z, gg.w}; float o[4];
#pragma unroll
            for (int i = 0; i < 4; ++i) { const float rv = (db == 0 ? o0[4 * g4 + i] : o1[4 * g4 + i]); o[i] = (rv - mu) * rstd * gv[i] * (gate[i] / (1.f + __expf(-gate[i]))); }
            *(uint2*)(op + e0) = make_uint2(pg8::cvt_pk_bf16(o[0], o[1]), pg8::cvt_pk_bf16(o[2], o[3])); }
}
DEV void phase_attn_merge(const Args& a, int gtid, int NT) {
    unsigned char* ws = a.ws; const float* L = (const float*)(ws + WS_ATTL); const bf16_t* O = (const bf16_t*)(ws + WS_ATTO); bf16_t* mixed = (bf16_t*)(ws + WS_XN);
    for (int it = gtid; it < NB * NH * S * 8; it += NT) {
        const int ch = it & 7, row = it >> 3;
        const int bh = row >> 12, pos = row & 4095, b = bh >> 3, h = bh & 7;
        const float l0 = L[row], l1 = L[(size_t)NB * NH * S + row], l2 = L[(size_t)2 * NB * NH * S + row];
        const float mx = fmaxf(l0, fmaxf(l1, l2)); float w0 = ex2(l0 - mx), w1 = ex2(l1 - mx), w2 = ex2(l2 - mx); const float is = 1.f / (w0 + w1 + w2); w0 *= is; w1 *= is; w2 *= is;
        const uint4 a0 = *(const uint4*)(O + (size_t)row * HD + ch * 8), a1 = *(const uint4*)(O + ((size_t)NB * NH * S + row) * HD + ch * 8), a2 = *(const uint4*)(O + ((size_t)2 * NB * NH * S + row) * HD + ch * 8);
        const unsigned x0[4] = {a0.x, a0.y, a0.z, a0.w}, x1[4] = {a1.x, a1.y, a1.z, a1.w}, x2[4] = {a2.x, a2.y, a2.z, a2.w}; unsigned o[4];
#pragma unroll
        for (int j = 0; j < 4; ++j) o[j] = pg8::cvt_pk_bf16(w0 * bf2f(x0[j] & 0xffffu) + w1 * bf2f(x1[j] & 0xffffu) + w2 * bf2f(x2[j] & 0xffffu), w0 * bf2f(x0[j] >> 16) + w1 * bf2f(x1[j] >> 16) + w2 * bf2f(x2[j] >> 16));
        *(uint4*)(mixed + ((size_t)b * S + pos) * D + 512 + h * HD + ch * 8) = make_uint4(o[0], o[1], o[2], o[3]);
    }
}
DEV void phase_mix_a(const Args& a, unsigned char* lds, int wg, int G, int lane, int wave, int tid) {
    { const float* bt = (const float*)(a.ws + WS_BIAS); LAS float* bl = (LAS float*)((LAS unsigned char*)lds + MIX_BIAS_OFF);
      for (int i = tid; i < 3 * NH * 192; i += NTHR) { const int ph = i / 192, bi = i % 192 - 32; bl[i] = (bi >= 0 && bi <= 128) ? bt[ph * 129 + bi] : -1e30f; } }
    __syncthreads();
    const int x = wg & 7, wq = (wg >> 3) * NWAVES + wave, WPX = (G >> 3) * NWAVES;
    for (int rep = 0; rep < a.rep[0]; ++rep) { asm volatile("" : "+v"(lane)); for (int it = wq; it < 2 * 32 * NH; it += WPX) retstate_item(a, lds, it, x, lane, wave); }
    for (int rep = 0; rep < a.rep[1]; ++rep) { asm volatile("" : "+v"(lane)); attn_items(a, lds, wg, G, lane, wave); }
}
DEV void phase_mix_b(const Args& a, unsigned char* lds, int wg, int G, int lane, int wave, int tid) {
    const int x = wg & 7, wq = (wg >> 3) * NWAVES + wave, WPX = (G >> 3) * NWAVES;
    for (int rep = 0; rep < a.rep[2]; ++rep) { asm volatile("" : "+v"(lane)); for (int it = wq; it < NH * 32 * 4; it += WPX) retout_item(a, lds, it, x, lane, wave); }
    for (int rep = 0; rep < a.rep[3]; ++rep) { asm volatile("" : "+v"(tid)); phase_attn_merge(a, wg * NTHR + tid, G * NTHR); }
}
#define XB_TMO      128
#define XB_XCNT(j)  (256  + 64 * (j))
#define XB_XSUB(j)  (1280 + 64 * (j))
#define XB_XGEN(j)  (2304 + 64 * (j))
#define XB_TOP      3328
#define XB_TOPGEN   3392
#define XCD_BAR_WORDS 3456
#define XB_SPIN_CAP (1u << 18)

__device__ __forceinline__ unsigned xb_ld(unsigned* p)              { return __hip_atomic_load(p, __ATOMIC_RELAXED, __HIP_MEMORY_SCOPE_AGENT); }
__device__ __forceinline__ unsigned xb_add(unsigned* p, unsigned v) { return __hip_atomic_fetch_add(p, v, __ATOMIC_RELAXED, __HIP_MEMORY_SCOPE_AGENT); }
__device__ __forceinline__ unsigned xb_xcc_id() { return (unsigned)__builtin_amdgcn_s_getreg((3 << 11) | 20) & 0xFu; }
#define XB_SPIN(cond, bar) do { unsigned _sp = 0; while (cond) { __builtin_amdgcn_s_sleep(1); \
    if ((++_sp & 255u) == 0u) { if (xb_ld(&(bar)[XB_TMO])) break; if (_sp > XB_SPIN_CAP) { atomicAdd(&(bar)[XB_TMO], 1u); break; } } } } while (0)

struct XcdBarrier {
    unsigned* bar; unsigned x;
    volatile LAS unsigned* st;
};

__device__ __forceinline__ XcdBarrier xcd_barrier_post(unsigned* bar, volatile LAS unsigned* st) {
    XcdBarrier b; b.bar = bar; b.x = xb_xcc_id(); b.st = st;
    if (threadIdx.x == 0) (void)xb_add(&bar[XB_XCNT(b.x)], 1u);
    return b;
}
__device__ __forceinline__ void xcd_barrier_complete(unsigned* bar, unsigned x, unsigned& nloc, unsigned& nx) {
    const unsigned G = gridDim.x * gridDim.y * gridDim.z;
    unsigned sum, cnt, mine, sp = 0u;
    for (;;) {
        sum = 0u; cnt = 0u; mine = 0u;
#pragma unroll
        for (unsigned j = 0; j < 16; ++j) { const unsigned c = xb_ld(&bar[XB_XCNT(j)]); sum += c; cnt += (c > 0u) ? 1u : 0u; mine = (j == x) ? c : mine; }
        if (sum == G) break;
        __builtin_amdgcn_s_sleep(1);
        if ((++sp & 255u) == 0u) { if (xb_ld(&bar[XB_TMO])) break; if (sp > XB_SPIN_CAP) { atomicAdd(&bar[XB_TMO], 1u); break; } }
    }
    nloc = mine > 0u ? mine : 1u; nx = cnt > 0u ? cnt : 1u;
}

__device__ __forceinline__ void xcd_barrier(const XcdBarrier& b) {
    asm volatile("s_waitcnt vmcnt(0)" ::: "memory");
    __syncthreads();
    if (threadIdx.x == 0) {
        unsigned* bar = b.bar;
        __builtin_amdgcn_s_waitcnt(0);
        unsigned nloc = b.st[0], nx = b.st[1];
        if (nloc == 0u) { xcd_barrier_complete(bar, b.x, nloc, nx); b.st[0] = nloc; b.st[1] = nx; }
        const unsigned old = xb_add(&bar[XB_XSUB(b.x)], 1u);
        const unsigned gen = old / nloc;
        if (old + 1u == (gen + 1u) * nloc) {
            __builtin_amdgcn_fence(__ATOMIC_RELEASE, "agent");
            asm volatile("s_waitcnt vmcnt(0)" ::: "memory");
            const unsigned og = xb_add(&bar[XB_TOP], 1u);
            const unsigned tg = og / nx;
            if (og + 1u == (tg + 1u) * nx) xb_add(&bar[XB_TOPGEN], 1u);
            else XB_SPIN(xb_ld(&bar[XB_TOPGEN]) == tg, bar);
            __builtin_amdgcn_fence(__ATOMIC_ACQUIRE, "agent");
            xb_add(&bar[XB_XGEN(b.x)], 1u);
            asm volatile("s_waitcnt vmcnt(0)" ::: "memory");
        } else {
            XB_SPIN(xb_ld(&bar[XB_XGEN(b.x)]) == gen, bar);
            __builtin_amdgcn_fence(__ATOMIC_ACQUIRE, "agent");
            asm volatile("s_waitcnt vmcnt(0)" ::: "memory");
        }
    }
    __syncthreads();
}

#ifndef MK_LAUNCHES
#define MK_LAUNCHES 1
#endif
constexpr int NPH = 11;
typedef const __attribute__((address_space(4))) Args* kargs_t;
DEV Args load_args(kargs_t kp) { Args a;
#pragma unroll
    for (int i = 0; i < 13; ++i) a.in[i] = kp->in[i];
    a.out = kp->out; a.ws = kp->ws; a.ph_lo = kp->ph_lo; a.ph_hi = kp->ph_hi;
#pragma unroll
    for (int i = 0; i < 12; ++i) a.rep[i] = kp->rep[i];
    return a; }
#ifndef PROBE_REP
#define PROBE_REP 0
#endif
#define REP(k) if (((PROBE_REP) >> (k)) & 1) for (int _r = 0; _r < 2; ++_r, cg::this_grid().sync())
__global__ void __launch_bounds__(NTHR, 2) mega(Args a_) {
    kargs_t kp = (kargs_t)__builtin_amdgcn_kernarg_segment_ptr();
    extern __shared__ __attribute__((aligned(16))) unsigned char lds[];
    int tid = threadIdx.x, lane = tid & 63, wave = __builtin_amdgcn_readfirstlane(tid >> 6);
    const int G = gridDim.x, wg = blockIdx.x, NGW = G * NWAVES; int gw = wg * NWAVES + wave;
#define FRESH_IDS() do { tid = threadIdx.x; asm volatile("" : "+v"(tid)); lane = tid & 63; wave = __builtin_amdgcn_readfirstlane(tid >> 6); gw = wg * NWAVES + wave; } while (0)
    const int lo = kp->ph_lo, hi = kp->ph_hi;
    unsigned char* ws = kp->ws;
    volatile LAS unsigned* bst = (volatile LAS unsigned*)((LAS unsigned char*)lds + LDS_BYTES - 64);
    if (tid < 2) bst[tid] = 0u;
    __syncthreads();
    XcdBarrier bar = xcd_barrier_post((unsigned*)(ws + WS_CTL) + 4096, bst);
#define IN(k) (lo <= (k) && (k) < hi)
#define SEAM(k) do { if (IN(k) && IN((k) + 1)) { if ((k) == 0) cg::this_grid().sync(); else xcd_barrier(bar); } } while (0)
    if (IN(0)) { FRESH_IDS(); const Args a = load_args(kp); unsigned char* ws = a.ws; for (int r = 0; r < a.rep[6]; ++r) { FRESH_IDS(); phase_prep(a, lds, gw, NGW, lane, wave); } }
    SEAM(0);
    if (IN(1)) { FRESH_IDS(); const Args a = load_args(kp); unsigned char* ws = a.ws; pg8::Gemm g{(const bf16_t*)(ws + WS_XN), (const bf16_t*)(ws + WS_WIN), D}; SchedPlain Sc; Sc.init(M, PC, G, wg); Sc.rowbytes = D * 2;
        EpiInProj E{ws, (const float*)(ws + WS_ROPE)};
        for (int r = 0; r < a.rep[8]; ++r) { FRESH_IDS(); pg8::gemm_phase<EpiInProj, SchedPlain, true>((LAS unsigned char*)lds, g, Sc, E); } }
    SEAM(1);
    if (IN(2)) { FRESH_IDS(); const Args a = load_args(kp); unsigned char* ws = a.ws; phase_mix_a(a, lds, wg, G, lane, wave, tid); }
    SEAM(2);
    if (IN(3)) { FRESH_IDS(); const Args a = load_args(kp); unsigned char* ws = a.ws; phase_scan(a, wg * NTHR + tid, G * NTHR); }
    SEAM(3);
    if (IN(4)) { FRESH_IDS(); const Args a = load_args(kp); unsigned char* ws = a.ws; phase_mix_b(a, lds, wg, G, lane, wave, tid); }
    SEAM(4);
    if (IN(5)) { FRESH_IDS(); const Args a = load_args(kp); unsigned char* ws = a.ws; pg8::Gemm g{(const bf16_t*)(ws + WS_XN), (const bf16_t*)(ws + WS_WOUT), D}; SchedPlain Sc; Sc.init(M, D, G, wg); Sc.rowbytes = D * 2;
        EpiOutProj E{a.in[IN_X], (bf16_t*)(ws + WS_X1)};
        for (int r = 0; r < a.rep[9]; ++r) { FRESH_IDS(); pg8::gemm_phase<EpiOutProj, SchedPlain, true>((LAS unsigned char*)lds, g, Sc, E); } }
    SEAM(5);
    if (IN(6)) { FRESH_IDS(); const Args a = load_args(kp); unsigned char* ws = a.ws; for (int r = 0; r < a.rep[4]; ++r) { FRESH_IDS(); phase_router(a, lds, gw, NGW, lane, tid); } for (int r = 0; r < a.rep[5]; ++r) { FRESH_IDS(); phase_latew(a, lds, gw, NGW, lane, wave); } }
    SEAM(6);
    if (IN(7)) { FRESH_IDS(); const Args a = load_args(kp); unsigned char* ws = a.ws; for (int r = 0; r < a.rep[7]; ++r) { FRESH_IDS(); phase_topk(a, lds, wg, G, tid, lane, wave); } }
    SEAM(7);
    if (IN(8)) { FRESH_IDS(); const Args a = load_args(kp); unsigned char* ws = a.ws; pg8::Gemm g{(const bf16_t*)(ws + WS_XN), (const bf16_t*)(ws + WS_WGU), D}; SchedMoe1 Sc; Sc.init(MR, 4096, G, wg); Sc.idx = (const int*)(ws + WS_IDX);
        EpiSwiGLU E{ws + WS_HID};
        for (int r = 0; r < a.rep[10]; ++r) { FRESH_IDS(); pg8::gemm_phase<EpiSwiGLU, SchedMoe1, true, true>((LAS unsigned char*)lds, g, Sc, E); } }
    SEAM(8);
    if (IN(9)) { FRESH_IDS(); const Args a = load_args(kp); unsigned char* ws = a.ws; pg8::Gemm g{(const bf16_t*)(ws + WS_HID), (const bf16_t*)(ws + WS_WD), DFF}; SchedMoe2 Sc; Sc.init(MR, D, G, wg);
        EpiDown E{(bf16_t*)(ws + WS_Y)};
        for (int r = 0; r < a.rep[11]; ++r) { FRESH_IDS(); pg8::gemm_phase<EpiDown, SchedMoe2, true, true>((LAS unsigned char*)lds, g, Sc, E); } }
    SEAM(9);
    if (IN(10)) { FRESH_IDS(); const Args a = load_args(kp); unsigned char* ws = a.ws; phase_final(a, gw, NGW, lane); }
#undef IN
#undef SEAM
}

extern "C" void kernel_launch(void* const* d_in, const int* in_sizes, int n_in, void* d_out, int out_size, void* d_ws, size_t ws_size, hipStream_t stream) {
    static int grid = 0;
    if (grid == 0) {
        if (n_in != 13 || in_sizes[0] != M * D || out_size != M * D || ws_size < WS_END) { fprintf(stderr, "kernel_launch: unexpected shapes n_in %d in0 %d out %d ws %zu (need %zu)\n", n_in, n_in > 0 ? in_sizes[0] : -1, out_size, ws_size, (size_t)WS_END); grid = -1; return; }
        int dev = 0, cus = 0, per_cu = 0;
        (void)hipGetDevice(&dev); (void)hipDeviceGetAttribute(&cus, hipDeviceAttributeMultiprocessorCount, dev);
        (void)hipFuncSetAttribute((const void*)mega, hipFuncAttributeMaxDynamicSharedMemorySize, LDS_BYTES);
        if (hipOccupancyMaxActiveBlocksPerMultiprocessor(&per_cu, (const void*)mega, NTHR, LDS_BYTES) != hipSuccess || per_cu < 1) { fprintf(stderr, "kernel_launch: occupancy query says %d blocks/CU\n", per_cu); per_cu = 1; }
        (void)hipGetLastError();
        grid = cus * 1;
        if (grid > cus * per_cu) grid = cus * per_cu;
    }
    if (grid < 0) return;
    (void)hipMemsetAsync((char*)d_ws + WS_CTL, 0, 1 * MiB, stream);
    Args a{};
    for (int i = 0; i < 13; ++i) a.in[i] = (const float*)d_in[i];
    a.out = (float*)d_out; a.ws = (unsigned char*)d_ws;
#ifndef PROBE_R
#define PROBE_R {1, 1, 1, 1, 1, 1, 1, 1, 1, 1, 1, 1}
#endif
    { const int rr[12] = PROBE_R; for (int i = 0; i < 12; ++i) a.rep[i] = rr[i]; }
#if MK_LAUNCHES == 1
    a.ph_lo = 0; a.ph_hi = NPH;
    void* args[] = {&a};
    hipError_t e = hipLaunchCooperativeKernel((const void*)mega, dim3(grid), dim3(NTHR), args, LDS_BYTES, stream);
    if (e != hipSuccess) fprintf(stderr, "cooperative launch failed: %s (grid %d)\n", hipGetErrorString(e), grid);
#else
    for (int p = 0; p < NPH; ++p) { a.ph_lo = p; a.ph_hi = p + 1; hipLaunchKernelGGL(mega, dim3(grid), dim3(NTHR), LDS_BYTES, stream, a); }
#endif
}
```

```cpp
#include <hip/hip_runtime.h>
#include <hip/hip_cooperative_groups.h>
#include <cstdint>
#include <cstdio>
namespace cg = cooperative_groups;

typedef unsigned short bf16_t;
#define DEV __device__ __forceinline__
#define LAS __attribute__((address_space(3)))

constexpr int NB = 8, S = 4096, D = 1024, M = NB * S;
constexpr int NH = 8, HD = 64, PC = 3584;
constexpr int NE = 16, CAP = 512, DFF = 2048, MR = NE * NB * CAP;
constexpr float EPS = 1e-6f, LOG2E = 1.4426950408889634f;
constexpr int NWAVES = 8, NTHR = 512;
constexpr int LDS_BYTES = 163840;

constexpr size_t MiB = 1u << 20;
constexpr size_t WS_CTL = 0;
constexpr size_t WS_ROPE = 1 * MiB;
constexpr size_t WS_BIAS = 2 * MiB;
constexpr size_t WS_IDX = 2 * MiB + 512 * 1024;
constexpr size_t WS_AFF = 3 * MiB;
constexpr size_t WS_INV = 5 * MiB;
constexpr size_t WS_AFFT = 9 * MiB;
constexpr size_t WS_WOUT = 7 * MiB;
constexpr size_t WS_WIN = 9 * MiB;
constexpr size_t WS_XN = 16 * MiB;
constexpr size_t WS_RQ = 80 * MiB, WS_RK = 112 * MiB, WS_RV = 144 * MiB, WS_RG = 176 * MiB;
constexpr size_t WS_AQ = 208 * MiB, WS_AK = 240 * MiB, WS_AV = 272 * MiB;
constexpr size_t WS_ATTO = 304 * MiB;
constexpr size_t WS_ATTL = 400 * MiB;
constexpr size_t WS_KF = 403 * MiB;
constexpr size_t WS_X1 = 403 * MiB;
constexpr size_t WS_ST = 208 * MiB;
constexpr size_t WS_WD = 80 * MiB;
constexpr size_t WS_WGU = 144 * MiB;
constexpr size_t WS_Y = 144 * MiB;
constexpr size_t WS_HID = 272 * MiB;
constexpr size_t WS_END = 528 * MiB;

DEV unsigned f2bf(float f) { unsigned u = __float_as_uint(f); return (u + 0x7fffu + ((u >> 16) & 1u)) >> 16; }
DEV float bf2f(unsigned h) { return __uint_as_float(h << 16); }
DEV unsigned pk2(float lo, float hi) { return f2bf(lo) | (f2bf(hi) << 16); }
DEV float wave_sum(float v) {
#pragma unroll
    for (int o = 1; o < 64; o <<= 1) v += __shfl_xor(v, o);
    return v;
}
#define LDS_WAIT() asm volatile("s_waitcnt lgkmcnt(0)" ::: "memory")
namespace pg8 {
#define PG8_LAS __attribute__((address_space(3)))
typedef short bf16x8 __attribute__((ext_vector_type(8)));
typedef float f32x4 __attribute__((ext_vector_type(4)));
typedef unsigned u32x4 __attribute__((ext_vector_type(4)));
constexpr int BM = 256, BK = 64, HALF = 128, HTB = HALF * BK * 2, STAGE_BYTES = 8 * HTB, NXCD = 8, WGM = 8;
__host__ __device__ __forceinline__ int lds_byte(int r, int c) { const int st = (r >> 4) * 2 + (c >> 5), rr = r & 15, cc = c & 31, ob = rr * 64 + cc * 2; return st * 1024 + (ob ^ (((ob >> 9) & 1) << 5)); }
__host__ __device__ __forceinline__ void stage_rc(int b, int& R, int& C) { const int st = b / 1024, sb = b % 1024, swz = sb ^ (((sb >> 9) & 1) << 5); R = (st >> 1) * 16 + swz / 64; C = (st & 1) * 32 + (swz % 64) / 2; }
__host__ __device__ __forceinline__ int perm32(int rho) { const int n = rho >> 4, i = rho & 15; return 8 * (i >> 2) + 4 * n + (i & 3); }
struct Unit { int pm, pn, ui; };
struct Gemm { const bf16_t* A; const bf16_t* Bt; int K; };
struct StaticOrder {
    int nM, nN, nwg, G, c;
    __device__ void init(int M_, int N_, int G_, int c_) { nM = M_ / BM; nN = N_ / BM; nwg = nM * nN; G = G_; c = c_; }
    __device__ bool next(int i, Unit& u) const {
        const long L = (long)i * G + c; if (L >= nwg) return false;
        int wgid = (int)L; { const int q = nwg / NXCD, r = nwg % NXCD, xcd = wgid % NXCD, off = wgid / NXCD; wgid = (xcd < r ? xcd * (q + 1) : r * (q + 1) + (xcd - r) * q) + off; }
        const int nig = WGM * nN, gid = wgid / nig, fm = gid * WGM, gsz = (nM - fm) < WGM ? (nM - fm) : WGM;
        u.pm = fm + ((wgid % nig) % gsz); u.pn = (wgid % nig) / gsz; return true;
    }
};
__device__ __forceinline__ unsigned cvt_pk_bf16(float lo, float hi) { unsigned r; asm volatile("v_cvt_pk_bf16_f32 %0, %1, %2" : "=v"(r) : "v"(lo), "v"(hi)); return r; }

typedef int v8i __attribute__((ext_vector_type(8)));
template <class Epi, class Sched, bool ALIGN_EPI, bool FP8 = false>
__device__ __forceinline__ void gemm_phase(PG8_LAS unsigned char* lds, const Gemm g, const Sched& S, const Epi& E) {
    const int tid = threadIdx.x, wid = __builtin_amdgcn_readfirstlane(tid >> 6), lane = tid & 63, wr = wid >> 2, wc = wid & 3, fr = lane & 15, fq = lane >> 4;
    const int K = g.K, RB = FP8 ? K : 2 * K, nt = RB / 128;
    unsigned voffB[2];
#pragma unroll
    for (int i = 0; i < 2; ++i) { int R, C; stage_rc(tid * 16 + i * 8192, R, C); const int Rb = Epi::PERM ? ((R & ~31) + perm32(R & 31)) : R;
        voffB[i] = (unsigned)(Rb * RB + C * 2); }
    const size_t kstep = (size_t)(BK * 2);
    const size_t hstep = (size_t)HALF * RB;
    const size_t tstep = 2 * hstep;
    const unsigned ldsw = (unsigned)wid * 1024u;
    const int aoff = FP8 ? lds_byte(wr * 64 + fr, fq * 16) : lds_byte(wr * 64 + fr, fq * 8), boff = FP8 ? lds_byte(wc * 32 + fr, fq * 16) : lds_byte(wc * 32 + fr, fq * 8);
    const int x16 = 16 * (fq & 1);
    const char* gA = (const char*)g.A;
#define PG8_SA(b, h) (((b) * 2 + (h)) * HTB)
#define PG8_SB(b, h) ((4 + (b) * 2 + (h)) * HTB)
#define PG8_STAGE(bufoff, gbase, voff) do { _Pragma("unroll") for (int _i = 0; _i < 2; ++_i) \
        __builtin_amdgcn_global_load_lds((const unsigned*)((const char*)(gbase) + (voff)[_i]), (PG8_LAS unsigned*)(lds + (bufoff) + ldsw + _i * 8192), 16, 0, 0); } while (0)
#define PG8_STAGE_A(bufoff, AO, h, kb) do { _Pragma("unroll") for (int _i = 0; _i < 2; ++_i) \
        __builtin_amdgcn_global_load_lds((const unsigned*)(gA + (size_t)((AO)[h][_i] + (unsigned)(kb))), (PG8_LAS unsigned*)(lds + (bufoff) + ldsw + _i * 8192), 16, 0, 0); } while (0)
#define PG8_LDA(dst, b, h) do { if constexpr (FP8) { _Pragma("unroll") for (int m = 0; m < 4; ++m) { dst[m][0] = *(const PG8_LAS bf16x8*)(lds + PG8_SA(b, h) + aoff + m * 2048 + x16); dst[m][1] = *(const PG8_LAS bf16x8*)(lds + PG8_SA(b, h) + aoff + m * 2048 + 16 - x16); } } \
    else { _Pragma("unroll") for (int m = 0; m < 4; ++m) _Pragma("unroll") for (int k = 0; k < 2; ++k) dst[m][k] = *(const PG8_LAS bf16x8*)(lds + PG8_SA(b, h) + aoff + m * 2048 + k * 1024); } } while (0)
#define PG8_LDB(dst, b, h) do { if constexpr (FP8) { _Pragma("unroll") for (int n = 0; n < 2; ++n) { dst[n][0] = *(const PG8_LAS bf16x8*)(lds + PG8_SB(b, h) + boff + n * 2048 + x16); dst[n][1] = *(const PG8_LAS bf16x8*)(lds + PG8_SB(b, h) + boff + n * 2048 + 16 - x16); } } \
    else { _Pragma("unroll") for (int n = 0; n < 2; ++n) _Pragma("unroll") for (int k = 0; k < 2; ++k) dst[n][k] = *(const PG8_LAS bf16x8*)(lds + PG8_SB(b, h) + boff + n * 2048 + k * 1024); } } while (0)
#define PG8_CAT8(x) __builtin_bit_cast(v8i, __builtin_shufflevector((x)[0], (x)[1], 0, 1, 2, 3, 4, 5, 6, 7, 8, 9, 10, 11, 12, 13, 14, 15))
#define PG8_MMA(ai, bj, At, Bt) do { __builtin_amdgcn_s_setprio(1); if constexpr (FP8) { _Pragma("unroll") for (int m = 0; m < 4; ++m) _Pragma("unroll") for (int n = 0; n < 2; ++n) \
        acc[ai][bj][m][n] = __builtin_amdgcn_mfma_scale_f32_16x16x128_f8f6f4(PG8_CAT8(Bt[n]), PG8_CAT8(At[m]), acc[ai][bj][m][n], 0, 0, 0, 0, 0, 0); } \
    else { _Pragma("unroll") for (int m = 0; m < 4; ++m) _Pragma("unroll") for (int n = 0; n < 2; ++n) _Pragma("unroll") for (int k = 0; k < 2; ++k) \
        acc[ai][bj][m][n] = __builtin_amdgcn_mfma_f32_16x16x32_bf16(Bt[n][k], At[m][k], acc[ai][bj][m][n], 0, 0, 0); } __builtin_amdgcn_s_setprio(0); } while (0)
#define PG8_WAIT_V(n) asm volatile("s_waitcnt vmcnt(" #n ")" ::: "memory")
#define PG8_WAIT_L(n) asm volatile("s_waitcnt lgkmcnt(" #n ")" ::: "memory")
#define PG8_BAR __builtin_amdgcn_s_barrier()
#define PG8_SCHED __builtin_amdgcn_sched_barrier(0)
#define PG8_AOFFS(AO, u) do { int _t = threadIdx.x; asm volatile("" : "+v"(_t)); _Pragma("unroll") for (int _i = 0; _i < 2; ++_i) { int _R, _C; stage_rc(_t * 16 + _i * 8192, _R, _C); \
        _Pragma("unroll") for (int _h = 0; _h < 2; ++_h) (AO)[_h][_i] = S.row_off(u, _h * HALF + _R) + (unsigned)(_C * 2); } } while (0)
    Unit cur, nxt; int ui = 0;
    if (!S.next(0, cur)) return;
    f32x4 acc[2][2][4][2];
#pragma unroll
    for (int a = 0; a < 2; ++a)
#pragma unroll
        for (int b = 0; b < 2; ++b)
#pragma unroll
            for (int m = 0; m < 4; ++m)
#pragma unroll
                for (int n = 0; n < 2; ++n) acc[a][b][m][n] = (f32x4){0.f, 0.f, 0.f, 0.f};
    bf16x8 At[4][2], B0[2][2], B1[2][2];
    unsigned aoc[2][2];
    PG8_AOFFS(aoc, cur);
    const char* cB = (const char*)g.Bt + (size_t)cur.pn * tstep;
    PG8_STAGE(PG8_SB(0, 0), cB, voffB); PG8_STAGE(PG8_SB(0, 1), cB + hstep, voffB); PG8_STAGE_A(PG8_SA(0, 0), aoc, 0, 0); PG8_STAGE_A(PG8_SA(0, 1), aoc, 1, 0);
    if (wr == 1) PG8_BAR;
    PG8_WAIT_V(2); PG8_BAR;
    PG8_STAGE(PG8_SB(1, 0), cB + kstep, voffB); PG8_STAGE_A(PG8_SA(1, 0), aoc, 0, 128); PG8_STAGE(PG8_SB(1, 1), cB + hstep + kstep, voffB);
    PG8_WAIT_V(6); PG8_BAR;
    for (;;) {
        const bool has_next = S.next(ui + 1, nxt);
        const char* nB = cB;
        if (has_next) nB = (const char*)g.Bt + (size_t)nxt.pn * tstep;
#pragma nounroll
        for (int t = 0; t < nt; t += 2) {
            const bool last = (t == nt - 2);
            const unsigned k1 = (unsigned)(t + 1) * 128u, k2 = last ? 0u : (unsigned)(t + 2) * 128u, k3 = k2 + 128u;
            const char* b2 = last ? nB : cB + (size_t)(t + 2) * kstep; const char* b3 = b2 + kstep;
            PG8_LDB(B0, 0, 0); PG8_LDB(B1, 0, 1); PG8_SCHED; PG8_LDA(At, 0, 0); PG8_STAGE_A(PG8_SA(1, 1), aoc, 1, k1);
            PG8_WAIT_V(8); PG8_WAIT_L(0); PG8_BAR; PG8_MMA(0, 0, At, B0); PG8_MMA(0, 1, At, B1); PG8_BAR; PG8_SCHED;
            if (last && has_next) { PG8_AOFFS(aoc, nxt); }
            PG8_LDA(At, 0, 1); PG8_STAGE(PG8_SB(0, 0), b2, voffB); PG8_STAGE(PG8_SB(0, 1), b2 + hstep, voffB); PG8_STAGE_A(PG8_SA(0, 0), aoc, 0, k2);
            PG8_WAIT_V(8); PG8_WAIT_L(0); PG8_BAR; PG8_MMA(1, 0, At, B0); PG8_MMA(1, 1, At, B1); PG8_BAR; PG8_SCHED;
            PG8_LDB(B0, 1, 0); PG8_LDB(B1, 1, 1); PG8_SCHED; PG8_LDA(At, 1, 0); PG8_STAGE_A(PG8_SA(0, 1), aoc, 1, k2);
            PG8_WAIT_V(8); PG8_WAIT_L(0); PG8_BAR; PG8_MMA(0, 0, At, B0); PG8_MMA(0, 1, At, B1); PG8_BAR; PG8_SCHED;
            PG8_LDA(At, 1, 1); PG8_STAGE(PG8_SB(1, 0), b3, voffB); PG8_STAGE(PG8_SB(1, 1), b3 + hstep, voffB); PG8_STAGE_A(PG8_SA(1, 0), aoc, 0, k3);
            PG8_WAIT_V(8); PG8_WAIT_L(0); PG8_BAR; PG8_MMA(1, 0, At, B0); PG8_MMA(1, 1, At, B1); PG8_BAR; PG8_SCHED;
        }
        if constexpr (ALIGN_EPI) { if (wr == 0) PG8_BAR; }
        { int t2 = threadIdx.x; asm volatile("" : "+v"(t2));
          const int w2 = __builtin_amdgcn_readfirstlane(t2 >> 6), l2 = t2 & 63; E(acc, cur, w2 >> 2, w2 & 3, l2 & 15, l2 >> 4); }
        if (!has_next) break;
#pragma unroll
        for (int a = 0; a < 2; ++a)
#pragma unroll
            for (int b = 0; b < 2; ++b)
#pragma unroll
                for (int m = 0; m < 4; ++m)
#pragma unroll
                    for (int n = 0; n < 2; ++n) acc[a][b][m][n] = (f32x4){0.f, 0.f, 0.f, 0.f};
        cur = nxt; cB = nB; ++ui;
        if constexpr (ALIGN_EPI) { if (wr == 1) PG8_BAR; }
    }
    PG8_WAIT_V(0);
    if constexpr (!ALIGN_EPI) { if (wr == 0) PG8_BAR; }
    PG8_BAR;
#undef PG8_SA
#undef PG8_SB
#undef PG8_STAGE
#undef PG8_STAGE_A
#undef PG8_LDA
#undef PG8_LDB
#undef PG8_MMA
#undef PG8_CAT8
#undef PG8_WAIT_V
#undef PG8_WAIT_L
#undef PG8_BAR
#undef PG8_SCHED
#undef PG8_AOFFS
}
}
struct SchedPlain : pg8::StaticOrder {
    unsigned rowbytes;
    DEV unsigned row_off(const pg8::Unit& u, int r) const { return (unsigned)(u.pm * 256 + r) * rowbytes; }
};
struct SchedMoe1 : pg8::StaticOrder {
    const LAS int* idxl;
    DEV bool next(int i, pg8::Unit& u) const { if (!pg8::StaticOrder::next(i, u)) return false; u.pn += (u.pm >> 4) * 16; u.ui = i; return true; }
    DEV unsigned row_off(const pg8::Unit& u, int r) const { const int g = u.pm * 256 + r; const int tok = ((g >> 9) & 7) * S + idxl[u.ui * 256 + r]; return (unsigned)tok * (unsigned)D; }
};
struct SchedMoe2 : pg8::StaticOrder {
    DEV bool next(int i, pg8::Unit& u) const { if (!pg8::StaticOrder::next(i, u)) return false; u.pn += (u.pm >> 4) * 4; return true; }
    DEV unsigned row_off(const pg8::Unit& u, int r) const { return (unsigned)(u.pm * 256 + r) * (unsigned)DFF; }
};
typedef pg8::f32x4 f32x4; typedef pg8::u32x4 u32x4;
struct EpiInProj {
    static constexpr bool PERM = true;
    unsigned char* ws; const float* ropeT;
    DEV void operator()(const f32x4 (&acc)[2][2][4][2], const pg8::Unit& u, int wr, int wc, int fr, int fq) const {
        const int grp = u.pn >> 1;
        bf16_t* gbase = (bf16_t*)(ws + WS_RQ + (size_t)grp * 32 * MiB);
        const int j0 = 32 * (wc & 1) + 8 * fq;
        if (grp < 2) {
            const float sc = grp == 1 ? 0.125f : 1.f;
            f32x4 cs[2][4], sn[2][4];
#pragma unroll
            for (int ai = 0; ai < 2; ++ai)
#pragma unroll
                for (int m = 0; m < 4; ++m) { const int s = (u.pm * 256 + ai * 128 + wr * 64 + m * 16 + fr) & 4095;
                    cs[ai][m] = *(const f32x4*)(ropeT + s * 32 + (j0 >> 1)); sn[ai][m] = *(const f32x4*)(ropeT + S * 32 + s * 32 + (j0 >> 1)); }
#pragma unroll
            for (int ai = 0; ai < 2; ++ai)
#pragma unroll
                for (int m = 0; m < 4; ++m) {
                    const int row = u.pm * 256 + ai * 128 + wr * 64 + m * 16 + fr, b = row >> 12, s = row & 4095;
#pragma unroll
                    for (int bj = 0; bj < 2; ++bj) {
                        const int hd = 4 * (u.pn & 1) + 2 * bj + (wc >> 1);
                        const f32x4 lo = (acc[ai][bj][m][0] * cs[ai][m] - acc[ai][bj][m][1] * sn[ai][m]) * sc, hi = (acc[ai][bj][m][1] * cs[ai][m] + acc[ai][bj][m][0] * sn[ai][m]) * sc;
                        u32x4 w; w.x = pg8::cvt_pk_bf16(lo[0], lo[1]); w.y = pg8::cvt_pk_bf16(lo[2], lo[3]); w.z = pg8::cvt_pk_bf16(hi[0], hi[1]); w.w = pg8::cvt_pk_bf16(hi[2], hi[3]);
                        *(u32x4*)(gbase + ((size_t)(b * NH + hd) * S + s) * HD + j0) = w;
                    }
                }
        } else {
            const float sc = grp == 4 ? 0.125f * LOG2E : 1.f;
#pragma unroll
            for (int ai = 0; ai < 2; ++ai)
#pragma unroll
                for (int m = 0; m < 4; ++m) {
                    const int row = u.pm * 256 + ai * 128 + wr * 64 + m * 16 + fr, b = row >> 12, s = row & 4095;
#pragma unroll
                    for (int bj = 0; bj < 2; ++bj) {
                        const int hd = 4 * (u.pn & 1) + 2 * bj + (wc >> 1);
                        const f32x4 lo = acc[ai][bj][m][0] * sc, hi = acc[ai][bj][m][1] * sc;
                        u32x4 w; w.x = pg8::cvt_pk_bf16(lo[0], lo[1]); w.y = pg8::cvt_pk_bf16(lo[2], lo[3]); w.z = pg8::cvt_pk_bf16(hi[0], hi[1]); w.w = pg8::cvt_pk_bf16(hi[2], hi[3]);
                        *(u32x4*)(gbase + ((size_t)(b * NH + hd) * S + s) * HD + j0) = w;
                    }
                }
        }
    }
};
struct EpiOutProj {
    static constexpr bool PERM = true;
    const float* x; bf16_t* x1;
    DEV void operator()(const f32x4 (&acc)[2][2][4][2], const pg8::Unit& u, int wr, int wc, int fr, int fq) const {
#pragma unroll
        for (int ai = 0; ai < 2; ++ai)
#pragma unroll
            for (int m = 0; m < 4; ++m) {
                const int row = u.pm * 256 + ai * 128 + wr * 64 + m * 16 + fr;
                f32x4 xa[2], xb[2];
#pragma unroll
                for (int bj = 0; bj < 2; ++bj) { const size_t off = (size_t)row * D + u.pn * 256 + bj * 128 + wc * 32 + 8 * fq; xa[bj] = *(const f32x4*)(x + off); xb[bj] = *(const f32x4*)(x + off + 4); }
#pragma unroll
                for (int bj = 0; bj < 2; ++bj) { const size_t off = (size_t)row * D + u.pn * 256 + bj * 128 + wc * 32 + 8 * fq;
                    const f32x4 lo = xa[bj] + acc[ai][bj][m][0], hi = xb[bj] + acc[ai][bj][m][1];
                    u32x4 w; w.x = pg8::cvt_pk_bf16(lo[0], lo[1]); w.y = pg8::cvt_pk_bf16(lo[2], lo[3]); w.z = pg8::cvt_pk_bf16(hi[0], hi[1]); w.w = pg8::cvt_pk_bf16(hi[2], hi[3]);
                    *(u32x4*)(x1 + off) = w; }
            }
    }
};
DEV unsigned pk4_fp8e(float a, float b, float c, float d) { unsigned w = 0u; w = __builtin_amdgcn_cvt_pk_fp8_f32(a, b, w, false); w = __builtin_amdgcn_cvt_pk_fp8_f32(c, d, w, true); return w; }
struct EpiSwiGLU {
    static constexpr bool PERM = true;
    unsigned char* hid;
    DEV void operator()(const f32x4 (&acc)[2][2][4][2], const pg8::Unit& u, int wr, int wc, int fr, int fq) const {
        const int pnl = u.pn & 15;
#pragma unroll
        for (int ai = 0; ai < 2; ++ai)
#pragma unroll
            for (int m = 0; m < 4; ++m) {
                const int row = u.pm * 256 + ai * 128 + wr * 64 + m * 16 + fr;
                float o[8];
#pragma unroll
                for (int n = 0; n < 2; ++n)
#pragma unroll
                    for (int i = 0; i < 4; ++i) { const float ga = acc[ai][0][m][n][i], ua = acc[ai][1][m][n][i];
                        o[4 * n + i] = (ga * ua) * ((1.f / 1024.f) * __builtin_amdgcn_rcpf(1.f + __builtin_amdgcn_exp2f(ga * (-LOG2E / 32.f)))); }
                *(uint2*)(hid + (size_t)row * DFF + pnl * 128 + wc * 32 + 8 * fq) = make_uint2(pk4_fp8e(o[0], o[1], o[2], o[3]), pk4_fp8e(o[4], o[5], o[6], o[7]));
            }
    }
};
struct EpiDown {
    static constexpr bool PERM = true;
    bf16_t* y;
    DEV void operator()(const f32x4 (&acc)[2][2][4][2], const pg8::Unit& u, int wr, int wc, int fr, int fq) const {
        const int pnl = u.pn & 3;
#pragma unroll
        for (int ai = 0; ai < 2; ++ai)
#pragma unroll
            for (int m = 0; m < 4; ++m) {
                const int row = u.pm * 256 + ai * 128 + wr * 64 + m * 16 + fr;
#pragma unroll
                for (int bj = 0; bj < 2; ++bj) { const f32x4 lo = acc[ai][bj][m][0] * (1.f / 32.f), hi = acc[ai][bj][m][1] * (1.f / 32.f);
                    u32x4 w; w.x = pg8::cvt_pk_bf16(lo[0], lo[1]); w.y = pg8::cvt_pk_bf16(lo[2], lo[3]); w.z = pg8::cvt_pk_bf16(hi[0], hi[1]); w.w = pg8::cvt_pk_bf16(hi[2], hi[3]);
                    *(u32x4*)(y + (size_t)row * D + pnl * 256 + bj * 128 + wc * 32 + 8 * fq) = w; }
            }
    }
};
struct Args { const float* in[13]; float* out; unsigned char* ws; int ph_lo, ph_hi; int rep[16]; };
enum { IN_X = 0, IN_G1, IN_WIN, IN_DECAY, IN_GN, IN_RELB, IN_WOUT, IN_G2, IN_WR, IN_WG, IN_WU, IN_WDN, IN_FG };

struct TrItem { const float* src; bf16_t* dst; int K, N, k0, n0, mode, fp8; };
DEV unsigned pk4_fp8(float a, float b, float c, float d) { unsigned w = 0u; w = __builtin_amdgcn_cvt_pk_fp8_f32(a, b, w, false); w = __builtin_amdgcn_cvt_pk_fp8_f32(c, d, w, true); return w; }
DEV void tr_load(const TrItem& t, f32x4 (&v)[16], int lane) {
#pragma unroll
    for (int i = 0; i < 16; ++i) { const int kk = (lane >> 4) + 4 * i, c = (lane & 15) * 4; v[i] = *(const f32x4*)(t.src + (size_t)(t.k0 + kk) * t.N + t.n0 + c); }
}
DEV int rowmap_rt(int mode, int n) {
    if (mode == 0) return n;
    if (mode == 1) { if (n >= 1024) return n; const int base = n & ~63, d = n & 63, nn = d >> 5, dd = d & 31; return base + 8 * (dd >> 2) + 4 * nn + (dd & 3); }
    return (n >> 7) * 256 + (mode == 3 ? 128 : 0) + (n & 127);
}
DEV void tr_finish(const TrItem& t, const f32x4 (&v)[16], LAS float* scr, int lane) {
#pragma unroll
    for (int i = 0; i < 16; ++i) { const int kk = (lane >> 4) + 4 * i, c = (lane & 15) * 4;
        scr[kk * 65 + c] = v[i][0]; scr[kk * 65 + c + 1] = v[i][1]; scr[kk * 65 + c + 2] = v[i][2]; scr[kk * 65 + c + 3] = v[i][3]; }
    LDS_WAIT();
#pragma unroll
    for (int i = 0; i < 8; ++i) { const int n = (lane >> 3) + 8 * i, c = (lane & 7) * 8; const LAS float* sp = scr + c * 65 + n;
        if (t.fp8) {
            const unsigned lo = pk4_fp8(sp[0] * 32.f, sp[65] * 32.f, sp[2 * 65] * 32.f, sp[3 * 65] * 32.f), hi = pk4_fp8(sp[4 * 65] * 32.f, sp[5 * 65] * 32.f, sp[6 * 65] * 32.f, sp[7 * 65] * 32.f);
            *(uint2*)((unsigned char*)t.dst + (size_t)rowmap_rt(t.mode, t.n0 + n) * t.K + t.k0 + c) = make_uint2(lo, hi);
        } else {
        u32x4 o; o.x = pk2(sp[0], sp[65]); o.y = pk2(sp[2 * 65], sp[3 * 65]); o.z = pk2(sp[4 * 65], sp[5 * 65]); o.w = pk2(sp[6 * 65], sp[7 * 65]);
        *(u32x4*)(t.dst + (size_t)rowmap_rt(t.mode, t.n0 + n) * t.K + t.k0 + c) = o; } }
    LDS_WAIT();
}
template <class Dec> DEV void tr_run(const Dec& dec, int nitems, int gw, int NGW, LAS float* scr, int lane) {
    for (int it = gw; it < nitems; it += NGW) { TrItem cur; f32x4 va[16]; dec(it, cur); tr_load(cur, va, lane); tr_finish(cur, va, scr, lane); }
}
DEV void rms_row_to_bf16(const float* xrow, const float* g, bf16_t* orow, int lane) {
    const float4* xr = (const float4*)xrow + lane;
    float4 v[4]; float s = 0.f;
#pragma unroll
    for (int j = 0; j < 4; ++j) { v[j] = xr[64 * j]; s += v[j].x * v[j].x + v[j].y * v[j].y + v[j].z * v[j].z + v[j].w * v[j].w; }
    const float rs = rsqrtf(wave_sum(s) * (1.f / D) + EPS);
    uint2* o = (uint2*)orow + lane;
#pragma unroll
    for (int j = 0; j < 4; ++j) { const float4 gg = ((const float4*)g)[lane + 64 * j];
        o[64 * j] = make_uint2(pk2(v[j].x * rs * gg.x, v[j].y * rs * gg.y), pk2(v[j].z * rs * gg.z, v[j].w * rs * gg.w)); }
}
DEV void phase_prep(const Args& a, unsigned char* lds, int gw, int NGW, int lane, int wave) {
    unsigned char* ws = a.ws;
    float* ropeT = (float*)(ws + WS_ROPE); float* biasT = (float*)(ws + WS_BIAS);
    for (int t = gw * 64 + lane; t < S * 32; t += NGW * 64) {
        const int pos = t >> 5, i = t & 31; const double inv = pow(10000.0, -(double)i / 32.0), ang = (double)pos * inv;
        ropeT[t] = (float)cos(ang); ropeT[S * 32 + t] = (float)sin(ang);
        if (t < 3 * NH * 129) { const int p = t / (NH * 129), h = (t / 129) % NH, o = t % 129 - 64, dil = p == 0 ? 1 : (p == 1 ? 4 : 16), rel = o * dil, n = rel < 0 ? -rel : rel;
            int bucket = rel > 0 ? 16 : 0;
            if (n < 8) bucket += n; else { int large = 8 + (int)(log((double)n / 8.0) / log(128.0) * 8.0); if (large > 15) large = 15; bucket += large; }
            biasT[t] = a.in[IN_RELB][bucket * NH + h] * LOG2E; }
    }
    LAS float* scr = (LAS float*)((LAS unsigned char*)lds + wave * 16640);
    constexpr int I_IN = (D / 64) * (PC / 64), I_OUT = (D / 64) * (D / 64);
    { const float* w_in = a.in[IN_WIN]; const float* w_out = a.in[IN_WOUT]; bf16_t* Win = (bf16_t*)(ws + WS_WIN); bf16_t* Wout = (bf16_t*)(ws + WS_WOUT);
      auto dec = [=](int it, TrItem& t) { if (it < I_IN) { t.src = w_in; t.dst = Win; t.K = D; t.N = PC; t.k0 = (it / (PC / 64)) * 64; t.n0 = (it % (PC / 64)) * 64; t.mode = 1; t.fp8 = 0; }
          else { const int r = it - I_IN; t.src = w_out; t.dst = Wout; t.K = D; t.N = D; t.k0 = (r / (D / 64)) * 64; t.n0 = (r % (D / 64)) * 64; t.mode = 0; t.fp8 = 0; } };
      tr_run(dec, I_IN + I_OUT, gw, NGW, scr, lane); }
    for (int m = gw; m < M; m += NGW) rms_row_to_bf16(a.in[IN_X] + (size_t)m * D, a.in[IN_G1], (bf16_t*)(ws + WS_XN) + (size_t)m * D, lane);
}
DEV void phase_latew(const Args& a, unsigned char* lds, int gw, int NGW, int lane, int wave) {
    unsigned char* ws = a.ws; LAS float* scr = (LAS float*)((LAS unsigned char*)lds + wave * 16640);
    constexpr int I_G = (D / 64) * (DFF / 64);
    const float* wg_ = a.in[IN_WG]; const float* wu_ = a.in[IN_WU]; const float* wd_ = a.in[IN_WDN]; bf16_t* Wgu = (bf16_t*)(ws + WS_WGU); bf16_t* Wd = (bf16_t*)(ws + WS_WD);
    auto dec = [=](int it, TrItem& t) { const int which = it / (NE * I_G), r = it % (NE * I_G), e = r / I_G, q = r % I_G;
        t.fp8 = 1;
        if (which < 2) { t.src = (which == 0 ? wg_ : wu_) + (size_t)e * D * DFF; t.dst = (bf16_t*)((unsigned char*)Wgu + (size_t)e * 4096 * D); t.K = D; t.N = DFF; t.k0 = (q / (DFF / 64)) * 64; t.n0 = (q % (DFF / 64)) * 64; t.mode = 2 + which; }
        else { t.src = wd_ + (size_t)e * DFF * D; t.dst = (bf16_t*)((unsigned char*)Wd + (size_t)e * D * DFF); t.K = DFF; t.N = D; t.k0 = (q / (D / 64)) * 64; t.n0 = (q % (D / 64)) * 64; t.mode = 0; } };
    tr_run(dec, 3 * NE * I_G, gw, NGW, scr, lane);
}
DEV void phase_router(const Args& a, unsigned char* lds, int gw, int NGW, int lane, int tid) {
    unsigned char* ws = a.ws; const bf16_t* x1 = (const bf16_t*)(ws + WS_X1); const float* g2 = a.in[IN_G2]; const float* wr = a.in[IN_WR];
    bf16_t* H2b = (bf16_t*)(ws + WS_XN); float* aff = (float*)(ws + WS_AFF); float* affT = (float*)(ws + WS_AFFT); int* inv = (int*)(ws + WS_INV);
    LAS f32x4* wl = (LAS f32x4*)(LAS unsigned char*)lds;
    for (int i = tid; i < D * 4; i += NTHR) { const int k = i >> 2, c = i & 3, slot = (k & 3) * 256 + (k >> 2); wl[slot * 4 + ((c + (slot >> 2)) & 3)] = *(const f32x4*)(wr + (size_t)k * NE + 4 * c); }
    __syncthreads();
    uint2 xw[4], xn[4];
    { const uint2* xr = (const uint2*)(x1 + (size_t)gw * D) + lane;
#pragma unroll
      for (int j = 0; j < 4; ++j) xw[j] = xr[64 * j]; }
    for (int row = gw; row < M; row += NGW) {
        if (row + NGW < M) { const uint2* xr = (const uint2*)(x1 + (size_t)(row + NGW) * D) + lane;
#pragma unroll
            for (int j = 0; j < 4; ++j) xn[j] = xr[64 * j]; }
        float4 v[4]; float s = 0.f;
#pragma unroll
        for (int j = 0; j < 4; ++j) { v[j] = make_float4(bf2f(xw[j].x & 0xffffu), bf2f(xw[j].x >> 16), bf2f(xw[j].y & 0xffffu), bf2f(xw[j].y >> 16)); s += v[j].x * v[j].x + v[j].y * v[j].y + v[j].z * v[j].z + v[j].w * v[j].w; }
#pragma unroll
        for (int j = 0; j < 4; ++j) xw[j] = xn[j];
        const float rs = rsqrtf(wave_sum(s) * (1.f / D) + EPS);
        f32x4 lg[4];
#pragma unroll
        for (int c = 0; c < 4; ++c) lg[c] = (f32x4){0.f, 0.f, 0.f, 0.f};
        unsigned* o = (unsigned*)((unsigned char*)H2b + (size_t)row * D) + lane;
#pragma unroll
        for (int j = 0; j < 4; ++j) { const float4 gg = ((const float4*)g2)[lane + 64 * j];
            const float hv[4] = {v[j].x * rs * gg.x, v[j].y * rs * gg.y, v[j].z * rs * gg.z, v[j].w * rs * gg.w};
            o[64 * j] = pk4_fp8(hv[0], hv[1], hv[2], hv[3]);
#pragma unroll
            for (int t = 0; t < 4; ++t) { const int slot = t * 256 + lane + 64 * j, rot = (lane >> 2) & 3;
#pragma unroll
                for (int c = 0; c < 4; ++c) lg[c] += hv[t] * wl[slot * 4 + ((c + rot) & 3)];
                __builtin_amdgcn_sched_barrier(0); } }
        float l16[16]; float mx = -1e30f;
#pragma unroll
        for (int e = 0; e < 16; ++e) { l16[e] = wave_sum(lg[e >> 2][e & 3]); mx = fmaxf(mx, l16[e]); }
        float sum = 0.f;
#pragma unroll
        for (int e = 0; e < 16; ++e) { l16[e] = __expf(l16[e] - mx); sum += l16[e]; }
        const float is = 1.f / sum;
        if (lane < 16) { float av = 0.f;
#pragma unroll
            for (int e = 0; e < 16; ++e) av = lane == e ? l16[e] * is : av;
            aff[(size_t)row * NE + lane] = av; inv[(size_t)row * NE + lane] = -1; affT[((size_t)(row >> 12) * NE + lane) * S + (row & 4095)] = av; }
    }
    __syncthreads();
}
DEV void phase_topk(const Args& a, unsigned char* lds, int wg, int G, int tid, int lane, int wave) {
    unsigned char* ws = a.ws; const float* affT = (const float*)(ws + WS_AFFT); int* idx = (int*)(ws + WS_IDX); int* inv = (int*)(ws + WS_INV);
    LAS unsigned* hist = (LAS unsigned*)(LAS unsigned char*)lds; LAS unsigned* wsum = hist + 256; LAS unsigned* bc = hist + 272;
    for (int it = wg; it < NE * NB; it += G) {
        const int e = it & 15, b = it >> 4;
        unsigned u[8];
        { const uint4* src = (const uint4*)(affT + ((size_t)b * NE + e) * S + 8 * tid); const uint4 p = src[0], q = src[1]; u[0] = p.x; u[1] = p.y; u[2] = p.z; u[3] = p.w; u[4] = q.x; u[5] = q.y; u[6] = q.z; u[7] = q.w; }
        unsigned prefix = 0u, kk = CAP;
#pragma unroll
        for (int pass = 0; pass < 4; ++pass) {
            const int shift = 24 - 8 * pass;
            __syncthreads();
            if (tid < 256) hist[tid] = 0u;
            __syncthreads();
#pragma unroll
            for (int j = 0; j < 8; ++j) if (pass == 0 || (u[j] >> (shift + 8)) == prefix) atomicAdd((unsigned*)&hist[(u[j] >> shift) & 255u], 1u);
            __syncthreads();
            if (wave == 0) {
                const unsigned c0 = hist[4 * lane], c1 = hist[4 * lane + 1], c2 = hist[4 * lane + 2], c3 = hist[4 * lane + 3], tot = c0 + c1 + c2 + c3;
                unsigned incl = tot;
#pragma unroll
                for (int o = 1; o < 64; o <<= 1) { const unsigned t = __shfl_down(incl, o); if (lane + o < 64) incl += t; }
                const unsigned excl = incl - tot;
                if (excl < kk && kk <= incl) { unsigned acc = excl; int bin;
                    if (acc + c3 >= kk) bin = 3; else { acc += c3; if (acc + c2 >= kk) bin = 2; else { acc += c2; if (acc + c1 >= kk) bin = 1; else { acc += c1; bin = 0; } } }
                    bc[0] = 4 * lane + bin; bc[1] = kk - acc; }
            }
            __syncthreads();
            prefix = (prefix << 8) | bc[0]; kk = bc[1];
        }
        const unsigned T = prefix, need = kk;
        unsigned cg_ = 0u, ce = 0u;
#pragma unroll
        for (int j = 0; j < 8; ++j) { cg_ += u[j] > T; ce += u[j] == T; }
        unsigned pk = cg_ | (ce << 16), incl = pk;
#pragma unroll
        for (int o = 1; o < 64; o <<= 1) { const unsigned t = __shfl_up(incl, o); if (lane >= o) incl += t; }
        if (lane == 63) wsum[wave] = incl;
        __syncthreads();
        unsigned base = 0u;
#pragma unroll
        for (int w = 0; w < NWAVES; ++w) base += w < wave ? wsum[w] : 0u;
        const unsigned ex = base + incl - pk; unsigned gtb = ex & 0xffffu, eqb = ex >> 16;
#pragma unroll
        for (int j = 0; j < 8; ++j) { const bool g = u[j] > T, q = u[j] == T; const unsigned slot = gtb + (eqb < need ? eqb : need);
            if (g || (q && eqb < need)) { const int s = 8 * tid + j; idx[(e * NB + b) * CAP + slot] = s; inv[((size_t)b * S + s) * NE + e] = (int)slot; }
            gtb += g; eqb += q; }
    }
}
DEV void phase_final(const Args& a, int gw, int NGW, int lane) {
    unsigned char* ws = a.ws; float* xo = a.out; const bf16_t* x1 = (const bf16_t*)(ws + WS_X1); const float* aff = (const float*)(ws + WS_AFF); const int* inv = (const int*)(ws + WS_INV);
    const bf16_t* y = (const bf16_t*)(ws + WS_Y); const float* fg = a.in[IN_FG];
    uint2 xw[4], xn[4]; int iv = -1, ivn = -1; float av = 0.f, avn = 0.f;
    { const uint2* xr = (const uint2*)(x1 + (size_t)gw * D) + lane;
#pragma unroll
      for (int j = 0; j < 4; ++j) xw[j] = xr[64 * j];
      if (lane < NE) { iv = inv[(size_t)gw * NE + lane]; av = aff[(size_t)gw * NE + lane]; } }
    for (int row = gw; row < M; row += NGW) {
        const int b = row >> 12;
        if (row + NGW < M) { const uint2* xr = (const uint2*)(x1 + (size_t)(row + NGW) * D) + lane;
#pragma unroll
            for (int j = 0; j < 4; ++j) xn[j] = xr[64 * j];
            if (lane < NE) { ivn = inv[(size_t)(row + NGW) * NE + lane]; avn = aff[(size_t)(row + NGW) * NE + lane]; } }
        float4 v[4];
#pragma unroll
        for (int j = 0; j < 4; ++j) v[j] = make_float4(bf2f(xw[j].x & 0xffffu), bf2f(xw[j].x >> 16), bf2f(xw[j].y & 0xffffu), bf2f(xw[j].y >> 16));
        unsigned long long msk = __ballot(lane < NE && iv >= 0);
        while (msk) { const int e = __builtin_ctzll(msk); msk &= msk - 1;
            const int sl = __builtin_amdgcn_readlane(iv, e); const float g = __builtin_bit_cast(float, __builtin_amdgcn_readlane(__builtin_bit_cast(int, av), e));
            const uint2* yr = (const uint2*)(y + ((size_t)e * 4096 + b * CAP + sl) * D) + lane;
#pragma unroll
            for (int j = 0; j < 4; ++j) { const uint2 w = yr[64 * j]; v[j].x += g * bf2f(w.x & 0xffffu); v[j].y += g * bf2f(w.x >> 16); v[j].z += g * bf2f(w.y & 0xffffu); v[j].w += g * bf2f(w.y >> 16); } }
        float s = 0.f;
#pragma unroll
        for (int j = 0; j < 4; ++j) s += v[j].x * v[j].x + v[j].y * v[j].y + v[j].z * v[j].z + v[j].w * v[j].w;
        const float rs = rsqrtf(wave_sum(s) * (1.f / D) + EPS);
        float4* orow = (float4*)(xo + (size_t)row * D) + lane;
#pragma unroll
        for (int j = 0; j < 4; ++j) { const float4 gg = ((const float4*)fg)[lane + 64 * j]; orow[64 * j] = make_float4(v[j].x * rs * gg.x, v[j].y * rs * gg.y, v[j].z * rs * gg.z, v[j].w * rs * gg.w); }
#pragma unroll
        for (int j = 0; j < 4; ++j) xw[j] = xn[j];
        iv = ivn; av = avn;
    }
}
typedef short bf16x8 __attribute__((ext_vector_type(8)));
typedef float f32x16 __attribute__((ext_vector_type(16)));
typedef short s16x4 __attribute__((ext_vector_type(4)));
typedef LAS const char* lds_cptr;
typedef unsigned u32x2 __attribute__((ext_vector_type(2)));
constexpr int VROW = 192;
constexpr int VSLOT = 32 * VROW;
constexpr int KROW = 144;
constexpr int KSLOT = 32 * KROW;
constexpr int MIX_WAVE_LDS = 2 * VSLOT;
constexpr int MIX_BIAS_OFF = NWAVES * MIX_WAVE_LDS;
DEV int crow(int r, int hi) { return (r & 3) + 8 * (r >> 2) + 4 * hi; }
DEV s16x4 vtr(lds_cptr p) { return __builtin_bit_cast(s16x4, __builtin_amdgcn_ds_read_tr16_b64_v4i16((LAS s16x4*)p)); }
DEV bf16x8 tr_frag(lds_cptr slot, int s, int blk, int lane) {
    const int h = lane >> 5; lds_cptr p = slot + (16 * s + 4 * h + ((lane & 15) >> 2)) * VROW + (32 * blk + 16 * ((lane >> 4) & 1) + 4 * (lane & 3)) * 2;
    const s16x4 lo = vtr(p), hi = vtr(p + 8 * VROW);
    return (bf16x8){lo[0], lo[1], lo[2], lo[3], hi[0], hi[1], hi[2], hi[3]};
}
DEV void load_frags(bf16x8 (&f)[4], const bf16_t* rowp, int lane) {
    const int h = lane >> 5;
#pragma unroll
    for (int st = 0; st < 4; ++st) f[st] = *(const bf16x8*)(rowp + 16 * st + 8 * h);
}
DEV bf16x8 pack_p(const f32x16& p, int s) {
    u32x4 w; w.x = pg8::cvt_pk_bf16(p[8 * s], p[8 * s + 1]); w.y = pg8::cvt_pk_bf16(p[8 * s + 2], p[8 * s + 3]); w.z = pg8::cvt_pk_bf16(p[8 * s + 4], p[8 * s + 5]); w.w = pg8::cvt_pk_bf16(p[8 * s + 6], p[8 * s + 7]);
    return __builtin_bit_cast(bf16x8, w);
}

DEV void stage_rows_k(LAS unsigned char* ks, const u32x4 (&raw)[4], int lane) {
    const int rr = lane >> 3, ch = lane & 7;
#pragma unroll
    for (int i = 0; i < 4; ++i) *(LAS u32x4*)(ks + (rr + 8 * i) * KROW + ch * 16) = raw[i];
}
DEV void read_row_frags(bf16x8 (&f)[4], const LAS unsigned char* ks, int lane) {
    const LAS unsigned char* p = ks + (lane & 31) * KROW + (lane >> 5) * 16;
#pragma unroll
    for (int st = 0; st < 4; ++st) f[st] = *(const LAS bf16x8*)(p + st * 32);
}
#define MFMA32(a, b, c) __builtin_amdgcn_mfma_f32_32x32x16_bf16((a), (b), (c), 0, 0, 0)
DEV float ex2(float x) { return __builtin_amdgcn_exp2f(x); }

struct AttnIt { int p, bh, sh, L, r, q0, kmin, kmax; };
DEV void attn_decode(int li, int x, AttnIt& d) {
    d.p = li >> 9; d.bh = 8 * x + ((li >> 6) & 7); const int qblk = li & 63;
    d.sh = 2 * d.p; d.L = S >> d.sh; const int bpr = d.L >> 6;
    d.r = qblk / bpr; d.q0 = (qblk % bpr) * 64;
    d.kmin = d.q0 >= 64 ? 0 : 2; const int km = (d.L + 63 - d.q0) >> 5; d.kmax = km > 5 ? 5 : km;
}
DEV int med3i(int v, int lo, int hi) { return v < lo ? lo : (v > hi ? hi : v); }
DEV void attn_ldrows(const bf16_t* base, const AttnIt& d, int i0, u32x4 (&v)[4], int lane) {
    const int rr = lane >> 3, ch = lane & 7; const char* hb = (const char*)(base + (size_t)d.bh * S * HD); const unsigned cst = (unsigned)(d.r * 128 + ch * 16);
#pragma unroll
    for (int i = 0; i < 4; ++i) v[i] = *(const u32x4*)(hb + (((unsigned)med3i(i0 + rr + 8 * i, 0, d.L - 1) << (d.sh + 7)) + cst));
}
DEV void attn_ldkv(const Args& a, const AttnIt& d, int kk, u32x4 (&k)[4], u32x4 (&v)[4], int lane) {
    const int rr = lane >> 3, ch = lane & 7, i0 = d.q0 - 64 + 32 * kk; const unsigned cst = (unsigned)(d.r * 128 + ch * 16);
    const char* kb = (const char*)((const bf16_t*)(a.ws + WS_AK) + (size_t)d.bh * S * HD); const char* vb = (const char*)((const bf16_t*)(a.ws + WS_AV) + (size_t)d.bh * S * HD);
#pragma unroll
    for (int i = 0; i < 4; ++i) { const unsigned off = ((unsigned)med3i(i0 + rr + 8 * i, 0, d.L - 1) << (d.sh + 7)) + cst; k[i] = *(const u32x4*)(kb + off); v[i] = *(const u32x4*)(vb + off); }
}
DEV void attn_items(const Args& a, unsigned char* lds, int wg, int G, int lane, int wave) {
    unsigned char* ws = a.ws;
    constexpr int NIT = 3 * 512; constexpr float THR = 6.f;
    const int x = wg & 7, NGW = (G >> 3) * NWAVES;
    int item = (wg >> 3) * NWAVES + wave; if (item >= NIT) return;
    LAS unsigned char* slot = (LAS unsigned char*)lds + wave * MIX_WAVE_LDS; lds_cptr slot3 = (lds_cptr)slot; LAS unsigned char* kslot = slot + VSLOT;
    const int t = lane & 31, hi = lane >> 5, rr = lane >> 3, ch = lane & 7;
    AttnIt d; attn_decode(item, x, d);
    bf16x8 qf[2][4], kf[4]; u32x4 kraw[4], vv[4];
    attn_ldkv(a, d, d.kmin, kraw, vv, lane);
    for (;;) {
        const LAS float* tph = (const LAS float*)((LAS unsigned char*)lds + MIX_BIAS_OFF) + (d.p * NH + (d.bh & 7)) * 192 + (32 + 4 * hi - t);
        f32x16 o[2][2] = {}; float m[2] = {0.f, 0.f}, l[2] = {0.f, 0.f};
        const int nitem = item + NGW; const bool hasn = nitem < NIT;
        AttnIt dn = d; if (hasn) attn_decode(nitem, x, dn);
#pragma unroll
        for (int j = 0; j < 2; ++j) { u32x4 qraw[4]; attn_ldrows((const bf16_t*)(ws + WS_AQ), d, d.q0 + 32 * j, qraw, lane); stage_rows_k(kslot, qraw, lane); asm volatile("" ::: "memory"); read_row_frags(qf[j], kslot, lane); asm volatile("" ::: "memory"); }
        for (int kk = d.kmin; kk <= d.kmax; ++kk) {
            const int kbase = d.q0 - 64 + 32 * kk;
#pragma unroll
            for (int i = 0; i < 4; ++i) *(LAS u32x4*)(slot + (rr + 8 * i) * VROW + ch * 16) = vv[i];
            stage_rows_k(kslot, kraw, lane);
            asm volatile("" ::: "memory");
            read_row_frags(kf, kslot, lane);
            const bf16x8 v00 = tr_frag(slot3, 0, 0, lane), v10 = tr_frag(slot3, 1, 0, lane), v01 = tr_frag(slot3, 0, 1, lane), v11 = tr_frag(slot3, 1, 1, lane);
            asm volatile("" ::: "memory");
            if (kk < d.kmax) attn_ldkv(a, d, kk + 1, kraw, vv, lane);
            else if (hasn) attn_ldkv(a, dn, dn.kmin, kraw, vv, lane);
            const bool edge = kbase < 0 || kbase + 31 >= d.L;
#pragma unroll
            for (int j = 0; j < 2; ++j) {
                const int kj = kk - j; if (kj < 0 || kj > 4) continue;
                f32x16 sc = {};
#pragma unroll
                for (int st = 0; st < 4; ++st) sc = MFMA32(kf[st], qf[j][st], sc);
                const LAS float* tb = tph + 32 * kj;
#pragma unroll
                for (int rg = 0; rg < 16; ++rg) sc[rg] = (sc[rg] - m[j]) + tb[(rg & 3) + 8 * (rg >> 2)];
                if (edge) {
#pragma unroll
                    for (int rg = 0; rg < 16; ++rg) { const int ki = kbase + crow(rg, hi); sc[rg] = (ki >= 0 && ki < d.L) ? sc[rg] : -1e30f; } }
                float mx = fmaxf(fmaxf(sc[0], sc[1]), fmaxf(sc[2], sc[3]));
#pragma unroll
                for (int rg = 4; rg < 16; rg += 4) mx = fmaxf(mx, fmaxf(fmaxf(sc[rg], sc[rg + 1]), fmaxf(sc[rg + 2], sc[rg + 3])));
                mx = fmaxf(mx, __shfl_xor(mx, 32));
                const bool first = kj == 0 || kk == d.kmin;
                if (first || __any(mx > THR)) {
                    const float dl = first ? mx : fmaxf(mx, 0.f), f = ex2(-dl); m[j] += dl; l[j] *= f;
#pragma unroll
                    for (int rg = 0; rg < 16; ++rg) { sc[rg] -= dl; o[j][0][rg] *= f; o[j][1][rg] *= f; }
                }
                float ps0 = 0.f, ps1 = 0.f;
#pragma unroll
                for (int rg = 0; rg < 16; rg += 2) { sc[rg] = ex2(sc[rg]); sc[rg + 1] = ex2(sc[rg + 1]); ps0 += sc[rg]; ps1 += sc[rg + 1]; }
                l[j] += ps0 + ps1;
                const bf16x8 p0 = pack_p(sc, 0), p1 = pack_p(sc, 1);
                o[j][0] = MFMA32(v00, p0, o[j][0]); o[j][0] = MFMA32(v10, p1, o[j][0]);
                o[j][1] = MFMA32(v01, p0, o[j][1]); o[j][1] = MFMA32(v11, p1, o[j][1]);
            }
        }
#pragma unroll
        for (int j = 0; j < 2; ++j) {
            float lt = l[j] + __shfl_xor(l[j], 32);
            const float il = 1.f / lt;
            const size_t orow = ((size_t)d.p * NB * NH + d.bh) * S + (size_t)(((d.q0 + 32 * j + t) << d.sh) + d.r);
#pragma unroll
            for (int g4 = 0; g4 < 4; ++g4) {
                *(LAS u32x2*)(kslot + t * KROW + (8 * g4 + 4 * hi) * 2) = (u32x2){pg8::cvt_pk_bf16(o[j][0][4 * g4] * il, o[j][0][4 * g4 + 1] * il), pg8::cvt_pk_bf16(o[j][0][4 * g4 + 2] * il, o[j][0][4 * g4 + 3] * il)};
                *(LAS u32x2*)(kslot + t * KROW + (32 + 8 * g4 + 4 * hi) * 2) = (u32x2){pg8::cvt_pk_bf16(o[j][1][4 * g4] * il, o[j][1][4 * g4 + 1] * il), pg8::cvt_pk_bf16(o[j][1][4 * g4 + 2] * il, o[j][1][4 * g4 + 3] * il)};
            }
            asm volatile("" ::: "memory");
            { bf16_t* ob = (bf16_t*)(ws + WS_ATTO) + ((size_t)d.p * NB * NH + d.bh) * S * HD;
#pragma unroll
              for (int i = 0; i < 4; ++i) { const u32x4 w = *(const LAS u32x4*)(kslot + (rr + 8 * i) * KROW + ch * 16);
                  *(u32x4*)(ob + (size_t)(((d.q0 + 32 * j + rr + 8 * i) << d.sh) + d.r) * HD + ch * 8) = w; } }
            asm volatile("" ::: "memory");
            if (hi == 0) ((float*)(ws + WS_ATTL))[orow] = m[j] + __log2f(lt);
        }
        if (!hasn) break;
        item = nitem; d = dn;
    }
}
DEV void retstate_item(const Args& a, unsigned char* lds, int item, int xg, int lane, int wave) {
    unsigned char* ws = a.ws;
    const int dir = item & 1, n = (item >> 1) & 31, bh = 8 * xg + (item >> 6), h = bh & 7;
    const bf16_t* Kc = (const bf16_t*)(ws + WS_RK) + ((size_t)bh * S + n * 128) * HD; const bf16_t* Vc = (const bf16_t*)(ws + WS_RV) + ((size_t)bh * S + n * 128) * HD;
    const float lg = a.in[IN_DECAY][dir * NH + h] * LOG2E;
    LAS unsigned char* vs = (LAS unsigned char*)lds + wave * MIX_WAVE_LDS; LAS unsigned char* ks = vs + VSLOT; lds_cptr vs3 = (lds_cptr)vs, ks3 = (lds_cptr)ks;
    f32x16 acc[2][2] = {};
    for (int blk = 0; blk < 4; ++blk) {
        { const int rr = lane >> 3, ch = lane & 7;
          u32x4 v[4], k[4];
#pragma unroll
          for (int i = 0; i < 4; ++i) { const int mrow = 32 * blk + rr + 8 * i; v[i] = *(const u32x4*)(Vc + (size_t)mrow * HD + ch * 8); k[i] = *(const u32x4*)(Kc + (size_t)mrow * HD + ch * 8); }
#pragma unroll
          for (int i = 0; i < 4; ++i) { const int mrow = 32 * blk + rr + 8 * i; const float z = ex2(lg * (float)(dir == 0 ? 127 - mrow : mrow));
              const unsigned kw[4] = {k[i].x, k[i].y, k[i].z, k[i].w}; u32x4 o;
              o.x = pg8::cvt_pk_bf16(bf2f(kw[0] & 0xffffu) * z, bf2f(kw[0] >> 16) * z); o.y = pg8::cvt_pk_bf16(bf2f(kw[1] & 0xffffu) * z, bf2f(kw[1] >> 16) * z);
              o.z = pg8::cvt_pk_bf16(bf2f(kw[2] & 0xffffu) * z, bf2f(kw[2] >> 16) * z); o.w = pg8::cvt_pk_bf16(bf2f(kw[3] & 0xffffu) * z, bf2f(kw[3] >> 16) * z);
              *(LAS u32x4*)(vs + (rr + 8 * i) * VROW + ch * 16) = v[i]; *(LAS u32x4*)(ks + (rr + 8 * i) * VROW + ch * 16) = o; } }
        LDS_WAIT();
#pragma unroll
        for (int s = 0; s < 2; ++s) {
            const bf16x8 v0 = tr_frag(vs3, s, 0, lane), v1 = tr_frag(vs3, s, 1, lane), k0 = tr_frag(ks3, s, 0, lane), k1 = tr_frag(ks3, s, 1, lane);
            acc[0][0] = MFMA32(v0, k0, acc[0][0]); acc[0][1] = MFMA32(v0, k1, acc[0][1]); acc[1][0] = MFMA32(v1, k0, acc[1][0]); acc[1][1] = MFMA32(v1, k1, acc[1][1]);
        }
        LDS_WAIT();
    }
    float* KT = (float*)(ws + WS_KF) + (((size_t)dir * NB * NH + bh) * 32 + n) * 4096;
    const int c = lane & 31, hi = lane >> 5;
#pragma unroll
    for (int eb = 0; eb < 2; ++eb)
#pragma unroll
        for (int db = 0; db < 2; ++db)
#pragma unroll
            for (int rg = 0; rg < 16; ++rg) KT[(32 * eb + crow(rg, hi)) * 64 + 32 * db + c] = acc[eb][db][rg];
}
DEV void phase_scan(const Args& a, int gtid, int NT) {
    unsigned char* ws = a.ws;
    for (int sl = gtid; sl < 2 * NB * NH * 1024; sl += NT) {
        const int dir = sl >> 16, bh = (sl >> 10) & 63, q = sl & 1023, h = bh & 7;
        const float gC = ex2(a.in[IN_DECAY][dir * NH + h] * LOG2E * 128.f);
        const float4* kt = (const float4*)(ws + WS_KF) + ((size_t)dir * NB * NH + bh) * 32 * 1024 + q;
        uint2* st = (uint2*)(ws + WS_ST) + ((size_t)dir * NB * NH + bh) * 32 * 1024 + q;
        float4 s = make_float4(0.f, 0.f, 0.f, 0.f);
        for (int i = 0; i < 32; ++i) { const int n = dir == 0 ? i : 31 - i;
            st[(size_t)n * 1024] = make_uint2(pg8::cvt_pk_bf16(s.x, s.y), pg8::cvt_pk_bf16(s.z, s.w));
            const float4 kv = kt[(size_t)n * 1024];
            s.x = gC * s.x + kv.x; s.y = gC * s.y + kv.y; s.z = gC * s.z + kv.z; s.w = gC * s.w + kv.w; }
    }
}
DEV void retout_item(const Args& a, unsigned char* lds, int item, int xg, int lane, int wave) {
    unsigned char* ws = a.ws;
    const int qb = item & 3, n = (item >> 2) & 31, bh = 8 * xg + (item >> 7), h = bh & 7, b = bh >> 3;
    const bf16_t* Qc = (const bf16_t*)(ws + WS_RQ) + ((size_t)bh * S + n * 128) * HD; const bf16_t* Kc = (const bf16_t*)(ws + WS_RK) + ((size_t)bh * S + n * 128) * HD;
    const bf16_t* Vc = (const bf16_t*)(ws + WS_RV) + ((size_t)bh * S + n * 128) * HD;
    const bf16_t* SF = (const bf16_t*)(ws + WS_ST) + (((size_t)0 * NB * NH + bh) * 32 + n) * 4096; const bf16_t* SB = (const bf16_t*)(ws + WS_ST) + (((size_t)1 * NB * NH + bh) * 32 + n) * 4096;
    const float lg0 = a.in[IN_DECAY][h] * LOG2E, lg1 = a.in[IN_DECAY][NH + h] * LOG2E;
    LAS unsigned char* slot = (LAS unsigned char*)lds + wave * MIX_WAVE_LDS; lds_cptr slot3 = (lds_cptr)slot;
    const int t = lane & 31, hi = lane >> 5, c = 32 * qb + t;
    bf16x8 qf[4]; load_frags(qf, Qc + (size_t)c * HD, lane);
    f32x16 o0 = {}, o1 = {};
    { bf16x8 s0[4], s1[4]; load_frags(s0, SF + (size_t)t * 64, lane); load_frags(s1, SF + (size_t)(32 + t) * 64, lane);
#pragma unroll
      for (int st = 0; st < 4; ++st) { o0 = MFMA32(s0[st], qf[st], o0); o1 = MFMA32(s1[st], qf[st], o1); }
      const float fa = ex2(lg0 * (float)(c + 1) - lg1 * (float)(128 - c));
#pragma unroll
      for (int rg = 0; rg < 16; ++rg) { o0[rg] *= fa; o1[rg] *= fa; }
      load_frags(s0, SB + (size_t)t * 64, lane); load_frags(s1, SB + (size_t)(32 + t) * 64, lane);
#pragma unroll
      for (int st = 0; st < 4; ++st) { o0 = MFMA32(s0[st], qf[st], o0); o1 = MFMA32(s1[st], qf[st], o1); }
      const float fb = ex2(lg1 * (float)(128 - c));
#pragma unroll
      for (int rg = 0; rg < 16; ++rg) { o0[rg] *= fb; o1[rg] *= fb; } }
    for (int kb = 0; kb < 4; ++kb) {
        { const int rr = lane >> 3, ch = lane & 7;
          u32x4 v[4];
#pragma unroll
          for (int i = 0; i < 4; ++i) v[i] = *(const u32x4*)(Vc + (size_t)(32 * kb + rr + 8 * i) * HD + ch * 8);
#pragma unroll
          for (int i = 0; i < 4; ++i) *(LAS u32x4*)(slot + (rr + 8 * i) * VROW + ch * 16) = v[i]; }
        bf16x8 kf[4]; load_frags(kf, Kc + (size_t)(32 * kb + t) * HD, lane);
        f32x16 sc = {};
#pragma unroll
        for (int st = 0; st < 4; ++st) sc = MFMA32(kf[st], qf[st], sc);
#pragma unroll
        for (int rg = 0; rg < 16; ++rg) { const int mk = 32 * kb + crow(rg, hi), df = c - mk; sc[rg] *= df >= 0 ? ex2(lg0 * (float)df) : ex2(lg1 * (float)(-df)); }
        const bf16x8 p0 = pack_p(sc, 0), p1 = pack_p(sc, 1);
        LDS_WAIT();
        o0 = MFMA32(tr_frag(slot3, 0, 0, lane), p0, o0); o0 = MFMA32(tr_frag(slot3, 1, 0, lane), p1, o0);
        o1 = MFMA32(tr_frag(slot3, 0, 1, lane), p0, o1); o1 = MFMA32(tr_frag(slot3, 1, 1, lane), p1, o1);
        LDS_WAIT();
    }
    float sm = 0.f;
#pragma unroll
    for (int rg = 0; rg < 16; ++rg) sm += o0[rg] + o1[rg];
    sm += __shfl_xor(sm, 32); const float mu = sm * (1.f / 64.f); float vq = 0.f;
#pragma unroll
    for (int rg = 0; rg < 16; ++rg) { const float d0 = o0[rg] - mu, d1 = o1[rg] - mu; vq += d0 * d0 + d1 * d1; }
    vq += __shfl_xor(vq, 32); const float rstd = rsqrtf(vq * (1.f / 64.f) + EPS);
    const size_t pos = (size_t)n * 128 + c;
    const bf16_t* gp = (const bf16_t*)(ws + WS_RG) + ((size_t)bh * S + pos) * HD; bf16_t* op = (bf16_t*)(ws + WS_XN) + ((size_t)b * S + pos) * D + h * HD; const float* gn = a.in[IN_GN] + h * HD;
#pragma unroll
    for (int db = 0; db < 2; ++db)
#pragma unroll
        for (int g4 = 0; g4 < 4; ++g4) { const int e0 = 32 * db + 8 * g4 + 4 * hi; const uint2 gw = *(const uint2*)(gp + e0); const float4 gg = *(const float4*)(gn + e0);
            const float gate[4] = {bf2f(gw.x & 0xffffu), bf2f(gw.x >> 16), bf2f(gw.y & 0xffffu), bf2f(gw.y >> 16)}; const float gv[4] = {gg.x, gg.y, gg.z, gg.w}; float o[4];
#pragma unroll
            for (int i = 0; i < 4; ++i) { const float rv = (db == 0 ? o0[4 * g4 + i] : o1[4 * g4 + i]); o[i] = (rv - mu) * rstd * gv[i] * (gate[i] / (1.f + __expf(-gate[i]))); }
            *(uint2*)(op + e0) = make_uint2(pg8::cvt_pk_bf16(o[0], o[1]), pg8::cvt_pk_bf16(o[2], o[3])); }
}
DEV void phase_attn_merge(const Args& a, int gtid, int NT) {
    unsigned char* ws = a.ws; const float* L = (const float*)(ws + WS_ATTL); const bf16_t* O = (const bf16_t*)(ws + WS_ATTO); bf16_t* mixed = (bf16_t*)(ws + WS_XN);
    for (int it = gtid; it < NB * NH * S * 8; it += NT) {
        const int ch = it & 7, row = it >> 3;
        const int bh = row >> 12, pos = row & 4095, b = bh >> 3, h = bh & 7;
        const float l0 = L[row], l1 = L[(size_t)NB * NH * S + row], l2 = L[(size_t)2 * NB * NH * S + row];
        const float mx = fmaxf(l0, fmaxf(l1, l2)); float w0 = ex2(l0 - mx), w1 = ex2(l1 - mx), w2 = ex2(l2 - mx); const float is = 1.f / (w0 + w1 + w2); w0 *= is; w1 *= is; w2 *= is;
        const uint4 a0 = *(const uint4*)(O + (size_t)row * HD + ch * 8), a1 = *(const uint4*)(O + ((size_t)NB * NH * S + row) * HD + ch * 8), a2 = *(const uint4*)(O + ((size_t)2 * NB * NH * S + row) * HD + ch * 8);
        const unsigned x0[4] = {a0.x, a0.y, a0.z, a0.w}, x1[4] = {a1.x, a1.y, a1.z, a1.w}, x2[4] = {a2.x, a2.y, a2.z, a2.w}; unsigned o[4];
#pragma unroll
        for (int j = 0; j < 4; ++j) o[j] = pg8::cvt_pk_bf16(w0 * bf2f(x0[j] & 0xffffu) + w1 * bf2f(x1[j] & 0xffffu) + w2 * bf2f(x2[j] & 0xffffu), w0 * bf2f(x0[j] >> 16) + w1 * bf2f(x1[j] >> 16) + w2 * bf2f(x2[j] >> 16));
        *(uint4*)(mixed + ((size_t)b * S + pos) * D + 512 + h * HD + ch * 8) = make_uint4(o[0], o[1], o[2], o[3]);
    }
}
DEV void phase_mix_a(const Args& a, unsigned char* lds, int wg, int G, int lane, int wave, int tid) {
    { const float* bt = (const float*)(a.ws + WS_BIAS); LAS float* bl = (LAS float*)((LAS unsigned char*)lds + MIX_BIAS_OFF);
      for (int i = tid; i < 3 * NH * 192; i += NTHR) { const int ph = i / 192, bi = i % 192 - 32; bl[i] = (bi >= 0 && bi <= 128) ? bt[ph * 129 + bi] : -1e30f; } }
    __syncthreads();
    const int x = wg & 7, wq = (wg >> 3) * NWAVES + wave, WPX = (G >> 3) * NWAVES;
    for (int rep = 0; rep < a.rep[0]; ++rep) { asm volatile("" : "+v"(lane)); for (int it = wq; it < 2 * 32 * NH; it += WPX) retstate_item(a, lds, it, x, lane, wave); }
    for (int rep = 0; rep < a.rep[1]; ++rep) { asm volatile("" : "+v"(lane)); attn_items(a, lds, wg, G, lane, wave); }
}
DEV void phase_mix_b(const Args& a, unsigned char* lds, int wg, int G, int lane, int wave, int tid) {
    const int x = wg & 7, wq = (wg >> 3) * NWAVES + wave, WPX = (G >> 3) * NWAVES;
    for (int rep = 0; rep < a.rep[2]; ++rep) { asm volatile("" : "+v"(lane)); for (int it = wq; it < NH * 32 * 4; it += WPX) retout_item(a, lds, it, x, lane, wave); }
    for (int rep = 0; rep < a.rep[3]; ++rep) { asm volatile("" : "+v"(tid)); phase_attn_merge(a, wg * NTHR + tid, G * NTHR); }
}
#define XB_TMO      128
#define XB_XCNT(j)  (256  + 64 * (j))
#define XB_XSUB(j)  (1280 + 64 * (j))
#define XB_XGEN(j)  (2304 + 64 * (j))
#define XB_TOP      3328
#define XB_TOPGEN   3392
#define XCD_BAR_WORDS 3456
#define XB_SPIN_CAP (1u << 18)

__device__ __forceinline__ unsigned xb_ld(unsigned* p)              { return __hip_atomic_load(p, __ATOMIC_RELAXED, __HIP_MEMORY_SCOPE_AGENT); }
__device__ __forceinline__ unsigned xb_add(unsigned* p, unsigned v) { return __hip_atomic_fetch_add(p, v, __ATOMIC_RELAXED, __HIP_MEMORY_SCOPE_AGENT); }
__device__ __forceinline__ unsigned xb_xcc_id() { return (unsigned)__builtin_amdgcn_s_getreg((3 << 11) | 20) & 0xFu; }
#define XB_SPIN(cond, bar) do { unsigned _sp = 0; while (cond) { __builtin_amdgcn_s_sleep(1); \
    if ((++_sp & 255u) == 0u) { if (xb_ld(&(bar)[XB_TMO])) break; if (_sp > XB_SPIN_CAP) { atomicAdd(&(bar)[XB_TMO], 1u); break; } } } } while (0)

struct XcdBarrier {
    unsigned* bar; unsigned x;
    volatile LAS unsigned* st;
};

__device__ __forceinline__ XcdBarrier xcd_barrier_post(unsigned* bar, volatile LAS unsigned* st) {
    XcdBarrier b; b.bar = bar; b.x = xb_xcc_id(); b.st = st;
    if (threadIdx.x == 0) (void)xb_add(&bar[XB_XCNT(b.x)], 1u);
    return b;
}
__device__ __forceinline__ void xcd_barrier_complete(unsigned* bar, unsigned x, unsigned& nloc, unsigned& nx) {
    const unsigned G = gridDim.x * gridDim.y * gridDim.z;
    unsigned sum, cnt, mine, sp = 0u;
    for (;;) {
        sum = 0u; cnt = 0u; mine = 0u;
#pragma unroll
        for (unsigned j = 0; j < 16; ++j) { const unsigned c = xb_ld(&bar[XB_XCNT(j)]); sum += c; cnt += (c > 0u) ? 1u : 0u; mine = (j == x) ? c : mine; }
        if (sum == G) break;
        __builtin_amdgcn_s_sleep(1);
        if ((++sp & 255u) == 0u) { if (xb_ld(&bar[XB_TMO])) break; if (sp > XB_SPIN_CAP) { atomicAdd(&bar[XB_TMO], 1u); break; } }
    }
    nloc = mine > 0u ? mine : 1u; nx = cnt > 0u ? cnt : 1u;
}

__device__ __forceinline__ void xcd_barrier(const XcdBarrier& b) {
    asm volatile("s_waitcnt vmcnt(0)" ::: "memory");
    __syncthreads();
    if (threadIdx.x == 0) {
        unsigned* bar = b.bar;
        __builtin_amdgcn_s_waitcnt(0);
        unsigned nloc = b.st[0], nx = b.st[1];
        if (nloc == 0u) { xcd_barrier_complete(bar, b.x, nloc, nx); b.st[0] = nloc; b.st[1] = nx; }
        const unsigned old = xb_add(&bar[XB_XSUB(b.x)], 1u);
        const unsigned gen = old / nloc;
        if (old + 1u == (gen + 1u) * nloc) {
            __builtin_amdgcn_fence(__ATOMIC_RELEASE, "agent");
            asm volatile("s_waitcnt vmcnt(0)" ::: "memory");
            const unsigned og = xb_add(&bar[XB_TOP], 1u);
            const unsigned tg = og / nx;
            if (og + 1u == (tg + 1u) * nx) xb_add(&bar[XB_TOPGEN], 1u);
            else XB_SPIN(xb_ld(&bar[XB_TOPGEN]) == tg, bar);
            __builtin_amdgcn_fence(__ATOMIC_ACQUIRE, "agent");
            xb_add(&bar[XB_XGEN(b.x)], 1u);
            asm volatile("s_waitcnt vmcnt(0)" ::: "memory");
        } else {
            XB_SPIN(xb_ld(&bar[XB_XGEN(b.x)]) == gen, bar);
            __builtin_amdgcn_fence(__ATOMIC_ACQUIRE, "agent");
            asm volatile("s_waitcnt vmcnt(0)" ::: "memory");
        }
    }
    __syncthreads();
}

#ifndef MK_LAUNCHES
#define MK_LAUNCHES 1
#endif
constexpr int NPH = 11;
typedef const __attribute__((address_space(4))) Args* kargs_t;
DEV Args load_args(kargs_t kp) { Args a;
#pragma unroll
    for (int i = 0; i < 13; ++i) a.in[i] = kp->in[i];
    a.out = kp->out; a.ws = kp->ws; a.ph_lo = kp->ph_lo; a.ph_hi = kp->ph_hi;
#pragma unroll
    for (int i = 0; i < 16; ++i) a.rep[i] = kp->rep[i];
    return a; }
#ifndef PROBE_REP
#define PROBE_REP 0
#endif
#define REP(k) if (((PROBE_REP) >> (k)) & 1) for (int _r = 0; _r < 2; ++_r, cg::this_grid().sync())
__global__ void __launch_bounds__(NTHR, 2) mega(Args a_) {
    kargs_t kp = (kargs_t)__builtin_amdgcn_kernarg_segment_ptr();
    extern __shared__ __attribute__((aligned(16))) unsigned char lds[];
    int tid = threadIdx.x, lane = tid & 63, wave = __builtin_amdgcn_readfirstlane(tid >> 6);
    const int G = gridDim.x, wg = blockIdx.x, NGW = G * NWAVES; int gw = wg * NWAVES + wave;
#define FRESH_IDS() do { tid = threadIdx.x; asm volatile("" : "+v"(tid)); lane = tid & 63; wave = __builtin_amdgcn_readfirstlane(tid >> 6); gw = wg * NWAVES + wave; } while (0)
    const int lo = kp->ph_lo, hi = kp->ph_hi;
    unsigned char* ws = kp->ws;
    volatile LAS unsigned* bst = (volatile LAS unsigned*)((LAS unsigned char*)lds + LDS_BYTES - 64);
    if (tid < 2) bst[tid] = 0u;
    __syncthreads();
    XcdBarrier bar = xcd_barrier_post((unsigned*)(ws + WS_CTL) + 4096, bst);
#define IN(k) (lo <= (k) && (k) < hi)
#define SEAM(k) do { if (IN(k) && IN((k) + 1)) { if ((k) == 0) cg::this_grid().sync(); else xcd_barrier(bar); } } while (0)
    if (IN(0)) { FRESH_IDS(); const Args a = load_args(kp); unsigned char* ws = a.ws; for (int r = 0; r < a.rep[6]; ++r) { FRESH_IDS(); phase_prep(a, lds, gw, NGW, lane, wave); } }
    SEAM(0);
    if (IN(1)) { FRESH_IDS(); const Args a = load_args(kp); unsigned char* ws = a.ws; pg8::Gemm g{(const bf16_t*)(ws + WS_XN), (const bf16_t*)(ws + WS_WIN), D}; SchedPlain Sc; Sc.init(M, PC, G, wg); Sc.rowbytes = D * 2;
        EpiInProj E{ws, (const float*)(ws + WS_ROPE)};
        for (int r = 0; r < a.rep[8]; ++r) { FRESH_IDS(); pg8::Gemm g2 = g; asm volatile("" : "+s"(g2.A), "+s"(g2.Bt)); pg8::gemm_phase<EpiInProj, SchedPlain, true>((LAS unsigned char*)lds, g2, Sc, E); } }
    SEAM(1);
    if (IN(2)) { FRESH_IDS(); const Args a = load_args(kp); unsigned char* ws = a.ws; phase_mix_a(a, lds, wg, G, lane, wave, tid); }
    SEAM(2);
    if (IN(3)) { FRESH_IDS(); const Args a = load_args(kp); unsigned char* ws = a.ws; for (int r = 0; r < a.rep[13]; ++r) { FRESH_IDS(); phase_scan(a, wg * NTHR + tid, G * NTHR); } }
    SEAM(3);
    if (IN(4)) { FRESH_IDS(); const Args a = load_args(kp); unsigned char* ws = a.ws; phase_mix_b(a, lds, wg, G, lane, wave, tid); }
    SEAM(4);
    if (IN(5)) { FRESH_IDS(); const Args a = load_args(kp); unsigned char* ws = a.ws; pg8::Gemm g{(const bf16_t*)(ws + WS_XN), (const bf16_t*)(ws + WS_WOUT), D}; SchedPlain Sc; Sc.init(M, D, G, wg); Sc.rowbytes = D * 2;
        EpiOutProj E{a.in[IN_X], (bf16_t*)(ws + WS_X1)};
        for (int r = 0; r < a.rep[9]; ++r) { FRESH_IDS(); pg8::Gemm g2 = g; asm volatile("" : "+s"(g2.A), "+s"(g2.Bt)); pg8::gemm_phase<EpiOutProj, SchedPlain, true>((LAS unsigned char*)lds, g2, Sc, E); } }
    SEAM(5);
    if (IN(6)) { FRESH_IDS(); const Args a = load_args(kp); unsigned char* ws = a.ws; for (int r = 0; r < a.rep[4]; ++r) { FRESH_IDS(); phase_router(a, lds, gw, NGW, lane, tid); } for (int r = 0; r < a.rep[5]; ++r) { FRESH_IDS(); phase_latew(a, lds, gw, NGW, lane, wave); } }
    SEAM(6);
    if (IN(7)) { FRESH_IDS(); const Args a = load_args(kp); unsigned char* ws = a.ws; for (int r = 0; r < a.rep[7]; ++r) { FRESH_IDS(); phase_topk(a, lds, wg, G, tid, lane, wave); } }
    SEAM(7);
    if (IN(8)) { FRESH_IDS(); const Args a = load_args(kp); unsigned char* ws = a.ws; pg8::Gemm g{(const bf16_t*)(ws + WS_XN), (const bf16_t*)(ws + WS_WGU), D}; SchedMoe1 Sc; Sc.init(MR, 4096, G, wg); Sc.idxl = (const LAS int*)((LAS unsigned char*)lds + 131072);
        { const int* idxg = (const int*)(ws + WS_IDX); LAS int* il = (LAS int*)((LAS unsigned char*)lds + 131072); pg8::Unit uu;
          for (int i = 0; i < 16; ++i) if (Sc.next(i, uu) && tid < 256) il[i * 256 + tid] = idxg[uu.pm * 256 + tid];
          __syncthreads(); }
        EpiSwiGLU E{ws + WS_HID};
        for (int r = 0; r < a.rep[10]; ++r) { FRESH_IDS(); pg8::Gemm g2 = g; asm volatile("" : "+s"(g2.A), "+s"(g2.Bt)); pg8::gemm_phase<EpiSwiGLU, SchedMoe1, true, true>((LAS unsigned char*)lds, g2, Sc, E); } }
    SEAM(8);
    if (IN(9)) { FRESH_IDS(); const Args a = load_args(kp); unsigned char* ws = a.ws; pg8::Gemm g{(const bf16_t*)(ws + WS_HID), (const bf16_t*)(ws + WS_WD), DFF}; SchedMoe2 Sc; Sc.init(MR, D, G, wg);
        EpiDown E{(bf16_t*)(ws + WS_Y)};
        for (int r = 0; r < a.rep[11]; ++r) { FRESH_IDS(); pg8::Gemm g2 = g; asm volatile("" : "+s"(g2.A), "+s"(g2.Bt)); pg8::gemm_phase<EpiDown, SchedMoe2, true, true>((LAS unsigned char*)lds, g2, Sc, E); } }
    SEAM(9);
    if (IN(10)) { FRESH_IDS(); const Args a = load_args(kp); unsigned char* ws = a.ws; for (int r = 0; r < a.rep[12]; ++r) { FRESH_IDS(); phase_final(a, gw, NGW, lane); } }
#undef IN
#undef SEAM
}

extern "C" void kernel_launch(void* const* d_in, const int* in_sizes, int n_in, void* d_out, int out_size, void* d_ws, size_t ws_size, hipStream_t stream) {
    static int grid = 0;
    if (grid == 0) {
        if (n_in != 13 || in_sizes[0] != M * D || out_size != M * D || ws_size < WS_END) { fprintf(stderr, "kernel_launch: unexpected shapes n_in %d in0 %d out %d ws %zu (need %zu)\n", n_in, n_in > 0 ? in_sizes[0] : -1, out_size, ws_size, (size_t)WS_END); grid = -1; return; }
        int dev = 0, cus = 0, per_cu = 0;
        (void)hipGetDevice(&dev); (void)hipDeviceGetAttribute(&cus, hipDeviceAttributeMultiprocessorCount, dev);
        (void)hipFuncSetAttribute((const void*)mega, hipFuncAttributeMaxDynamicSharedMemorySize, LDS_BYTES);
        if (hipOccupancyMaxActiveBlocksPerMultiprocessor(&per_cu, (const void*)mega, NTHR, LDS_BYTES) != hipSuccess || per_cu < 1) { fprintf(stderr, "kernel_launch: occupancy query says %d blocks/CU\n", per_cu); per_cu = 1; }
        (void)hipGetLastError();
        grid = cus * 1;
        if (grid > cus * per_cu) grid = cus * per_cu;
    }
    if (grid < 0) return;
    (void)hipMemsetAsync((char*)d_ws + WS_CTL, 0, 1 * MiB, stream);
    Args a{};
    for (int i = 0; i < 13; ++i) a.in[i] = (const float*)d_in[i];
    a.out = (float*)d_out; a.ws = (unsigned char*)d_ws;
#ifndef PROBE_R
#define PROBE_R {1, 1, 1, 1, 1, 1, 1, 1, 1, 1, 1, 1, 1, 1, 1, 1}
#endif
    { const int rr[16] = PROBE_R; for (int i = 0; i < 16; ++i) a.rep[i] = rr[i]; }
#if MK_LAUNCHES == 1
    a.ph_lo = 0; a.ph_hi = NPH;
    void* args[] = {&a};
    hipError_t e = hipLaunchCooperativeKernel((const void*)mega, dim3(grid), dim3(NTHR), args, LDS_BYTES, stream);
    if (e != hipSuccess) fprintf(stderr, "cooperative launch failed: %s (grid %d)\n", hipGetErrorString(e), grid);
#else
    for (int p = 0; p < NPH; ++p) { a.ph_lo = p; a.ph_hi = p + 1; hipLaunchKernelGGL(mega, dim3(grid), dim3(NTHR), LDS_BYTES, stream, a); }
#endif
}
```

```cpp
#include <hip/hip_runtime.h>
#include <hip/hip_cooperative_groups.h>
#include <cstdint>
#include <cstdio>
namespace cg = cooperative_groups;

typedef unsigned short bf16_t;
#define DEV __device__ __forceinline__
#define LAS __attribute__((address_space(3)))

constexpr int NB = 8, S = 4096, D = 1024, M = NB * S;
constexpr int NH = 8, HD = 64, PC = 3584;
constexpr int NE = 16, CAP = 512, DFF = 2048, MR = NE * NB * CAP;
constexpr float EPS = 1e-6f, LOG2E = 1.4426950408889634f;
constexpr int NWAVES = 8, NTHR = 512;
constexpr int LDS_BYTES = 163840;

constexpr size_t MiB = 1u << 20;
constexpr size_t WS_CTL = 0;
constexpr size_t WS_ROPE = 1 * MiB;
constexpr size_t WS_BIAS = 2 * MiB;
constexpr size_t WS_IDX = 2 * MiB + 512 * 1024;
constexpr size_t WS_AFF = 3 * MiB;
constexpr size_t WS_INV = 5 * MiB;
constexpr size_t WS_AFFT = 9 * MiB;
constexpr size_t WS_WOUT = 7 * MiB;
constexpr size_t WS_WIN = 9 * MiB;
constexpr size_t WS_XN = 16 * MiB;
constexpr size_t WS_RQ = 80 * MiB, WS_RK = 112 * MiB, WS_RV = 144 * MiB, WS_RG = 176 * MiB;
constexpr size_t WS_AQ = 208 * MiB, WS_AK = 240 * MiB, WS_AV = 272 * MiB;
constexpr size_t WS_ATTO = 304 * MiB;
constexpr size_t WS_ATTL = 400 * MiB;
constexpr size_t WS_KF = 403 * MiB;
constexpr size_t WS_X1 = 403 * MiB;
constexpr size_t WS_ST = 208 * MiB;
constexpr size_t WS_WD = 80 * MiB;
constexpr size_t WS_WGU = 144 * MiB;
constexpr size_t WS_Y = 144 * MiB;
constexpr size_t WS_HID = 272 * MiB;
constexpr size_t WS_END = 528 * MiB;

DEV unsigned f2bf(float f) { unsigned u = __float_as_uint(f); return (u + 0x7fffu + ((u >> 16) & 1u)) >> 16; }
DEV float bf2f(unsigned h) { return __uint_as_float(h << 16); }
DEV unsigned pk2(float lo, float hi) { return f2bf(lo) | (f2bf(hi) << 16); }
DEV float wave_sum(float v) {
#pragma unroll
    for (int o = 1; o < 64; o <<= 1) v += __shfl_xor(v, o);
    return v;
}
#define LDS_WAIT() asm volatile("s_waitcnt lgkmcnt(0)" ::: "memory")
namespace pg8 {
#define PG8_LAS __attribute__((address_space(3)))
typedef short bf16x8 __attribute__((ext_vector_type(8)));
typedef float f32x4 __attribute__((ext_vector_type(4)));
typedef unsigned u32x4 __attribute__((ext_vector_type(4)));
constexpr int BM = 256, BK = 64, HALF = 128, HTB = HALF * BK * 2, STAGE_BYTES = 8 * HTB, NXCD = 8, WGM = 8;
__host__ __device__ __forceinline__ int lds_byte(int r, int c) { const int st = (r >> 4) * 2 + (c >> 5), rr = r & 15, cc = c & 31, ob = rr * 64 + cc * 2; return st * 1024 + (ob ^ (((ob >> 9) & 1) << 5)); }
__host__ __device__ __forceinline__ void stage_rc(int b, int& R, int& C) { const int st = b / 1024, sb = b % 1024, swz = sb ^ (((sb >> 9) & 1) << 5); R = (st >> 1) * 16 + swz / 64; C = (st & 1) * 32 + (swz % 64) / 2; }
__host__ __device__ __forceinline__ int perm32(int rho) { const int n = rho >> 4, i = rho & 15; return 8 * (i >> 2) + 4 * n + (i & 3); }
struct Unit { int pm, pn, ui; };
struct Gemm { const bf16_t* A; const bf16_t* Bt; int K; };
struct StaticOrder {
    int nM, nN, nwg, G, c;
    __device__ void init(int M_, int N_, int G_, int c_) { nM = M_ / BM; nN = N_ / BM; nwg = nM * nN; G = G_; c = c_; }
    __device__ bool next(int i, Unit& u) const {
        const long L = (long)i * G + c; if (L >= nwg) return false;
        int wgid = (int)L; { const int q = nwg / NXCD, r = nwg % NXCD, xcd = wgid % NXCD, off = wgid / NXCD; wgid = (xcd < r ? xcd * (q + 1) : r * (q + 1) + (xcd - r) * q) + off; }
        const int nig = WGM * nN, gid = wgid / nig, fm = gid * WGM, gsz = (nM - fm) < WGM ? (nM - fm) : WGM;
        u.pm = fm + ((wgid % nig) % gsz); u.pn = (wgid % nig) / gsz; return true;
    }
};
__device__ __forceinline__ unsigned cvt_pk_bf16(float lo, float hi) { unsigned r; asm volatile("v_cvt_pk_bf16_f32 %0, %1, %2" : "=v"(r) : "v"(lo), "v"(hi)); return r; }

typedef int v8i __attribute__((ext_vector_type(8)));
template <class Epi, class Sched, bool ALIGN_EPI, bool FP8 = false>
__device__ __forceinline__ void gemm_phase(PG8_LAS unsigned char* lds, const Gemm g, const Sched& S, const Epi& E) {
    const int tid = threadIdx.x, wid = __builtin_amdgcn_readfirstlane(tid >> 6), lane = tid & 63, wr = wid >> 2, wc = wid & 3, fr = lane & 15, fq = lane >> 4;
    const int K = g.K, RB = FP8 ? K : 2 * K, nt = RB / 128;
    unsigned voffB[2];
#pragma unroll
    for (int i = 0; i < 2; ++i) { int R, C; stage_rc(tid * 16 + i * 8192, R, C); const int Rb = Epi::PERM ? ((R & ~31) + perm32(R & 31)) : R;
        voffB[i] = (unsigned)(Rb * RB + C * 2); }
    const size_t kstep = (size_t)(BK * 2);
    const size_t hstep = (size_t)HALF * RB;
    const size_t tstep = 2 * hstep;
    const unsigned ldsw = (unsigned)wid * 1024u;
    const int aoff = FP8 ? lds_byte(wr * 64 + fr, fq * 16) : lds_byte(wr * 64 + fr, fq * 8), boff = FP8 ? lds_byte(wc * 32 + fr, fq * 16) : lds_byte(wc * 32 + fr, fq * 8);
    const int x16 = 16 * (fq & 1);
    const char* gA = (const char*)g.A;
#define PG8_SA(b, h) (((b) * 2 + (h)) * HTB)
#define PG8_SB(b, h) ((4 + (b) * 2 + (h)) * HTB)
#define PG8_STAGE(bufoff, gbase, voff) do { _Pragma("unroll") for (int _i = 0; _i < 2; ++_i) \
        __builtin_amdgcn_global_load_lds((const unsigned*)((const char*)(gbase) + (voff)[_i]), (PG8_LAS unsigned*)(lds + (bufoff) + ldsw + _i * 8192), 16, 0, 0); } while (0)
#define PG8_STAGE_A(bufoff, AO, h, kb) do { _Pragma("unroll") for (int _i = 0; _i < 2; ++_i) \
        __builtin_amdgcn_global_load_lds((const unsigned*)(gA + (size_t)((AO)[h][_i] + (unsigned)(kb))), (PG8_LAS unsigned*)(lds + (bufoff) + ldsw + _i * 8192), 16, 0, 0); } while (0)
#define PG8_LDA(dst, b, h) do { if constexpr (FP8) { _Pragma("unroll") for (int m = 0; m < 4; ++m) { dst[m][0] = *(const PG8_LAS bf16x8*)(lds + PG8_SA(b, h) + aoff + m * 2048 + x16); dst[m][1] = *(const PG8_LAS bf16x8*)(lds + PG8_SA(b, h) + aoff + m * 2048 + 16 - x16); } } \
    else { _Pragma("unroll") for (int m = 0; m < 4; ++m) _Pragma("unroll") for (int k = 0; k < 2; ++k) dst[m][k] = *(const PG8_LAS bf16x8*)(lds + PG8_SA(b, h) + aoff + m * 2048 + k * 1024); } } while (0)
#define PG8_LDB(dst, b, h) do { if constexpr (FP8) { _Pragma("unroll") for (int n = 0; n < 2; ++n) { dst[n][0] = *(const PG8_LAS bf16x8*)(lds + PG8_SB(b, h) + boff + n * 2048 + x16); dst[n][1] = *(const PG8_LAS bf16x8*)(lds + PG8_SB(b, h) + boff + n * 2048 + 16 - x16); } } \
    else { _Pragma("unroll") for (int n = 0; n < 2; ++n) _Pragma("unroll") for (int k = 0; k < 2; ++k) dst[n][k] = *(const PG8_LAS bf16x8*)(lds + PG8_SB(b, h) + boff + n * 2048 + k * 1024); } } while (0)
#define PG8_CAT8(x) __builtin_bit_cast(v8i, __builtin_shufflevector((x)[0], (x)[1], 0, 1, 2, 3, 4, 5, 6, 7, 8, 9, 10, 11, 12, 13, 14, 15))
#define PG8_MMA(ai, bj, At, Bt) do { __builtin_amdgcn_s_setprio(1); if constexpr (FP8) { _Pragma("unroll") for (int m = 0; m < 4; ++m) _Pragma("unroll") for (int n = 0; n < 2; ++n) \
        acc[ai][bj][m][n] = __builtin_amdgcn_mfma_scale_f32_16x16x128_f8f6f4(PG8_CAT8(Bt[n]), PG8_CAT8(At[m]), acc[ai][bj][m][n], 0, 0, 0, 0, 0, 0); } \
    else { _Pragma("unroll") for (int m = 0; m < 4; ++m) _Pragma("unroll") for (int n = 0; n < 2; ++n) _Pragma("unroll") for (int k = 0; k < 2; ++k) \
        acc[ai][bj][m][n] = __builtin_amdgcn_mfma_f32_16x16x32_bf16(Bt[n][k], At[m][k], acc[ai][bj][m][n], 0, 0, 0); } __builtin_amdgcn_s_setprio(0); } while (0)
#define PG8_WAIT_V(n) asm volatile("s_waitcnt vmcnt(" #n ")" ::: "memory")
#define PG8_WAIT_L(n) asm volatile("s_waitcnt lgkmcnt(" #n ")" ::: "memory")
#define PG8_BAR __builtin_amdgcn_s_barrier()
#define PG8_SCHED __builtin_amdgcn_sched_barrier(0)
#define PG8_AOFFS(AO, u) do { int _t = threadIdx.x; asm volatile("" : "+v"(_t)); _Pragma("unroll") for (int _i = 0; _i < 2; ++_i) { int _R, _C; stage_rc(_t * 16 + _i * 8192, _R, _C); \
        _Pragma("unroll") for (int _h = 0; _h < 2; ++_h) (AO)[_h][_i] = S.row_off(u, _h * HALF + _R) + (unsigned)(_C * 2); } } while (0)
    Unit cur, nxt; int ui = 0;
    if (!S.next(0, cur)) return;
    f32x4 acc[2][2][4][2];
#pragma unroll
    for (int a = 0; a < 2; ++a)
#pragma unroll
        for (int b = 0; b < 2; ++b)
#pragma unroll
            for (int m = 0; m < 4; ++m)
#pragma unroll
                for (int n = 0; n < 2; ++n) acc[a][b][m][n] = (f32x4){0.f, 0.f, 0.f, 0.f};
    bf16x8 At[4][2], B0[2][2], B1[2][2];
    unsigned aoc[2][2];
    PG8_AOFFS(aoc, cur);
    const char* cB = (const char*)g.Bt + (size_t)cur.pn * tstep;
    PG8_STAGE(PG8_SB(0, 0), cB, voffB); PG8_STAGE(PG8_SB(0, 1), cB + hstep, voffB); PG8_STAGE_A(PG8_SA(0, 0), aoc, 0, 0); PG8_STAGE_A(PG8_SA(0, 1), aoc, 1, 0);
    if (wr == 1) PG8_BAR;
    PG8_WAIT_V(2); PG8_BAR;
    PG8_STAGE(PG8_SB(1, 0), cB + kstep, voffB); PG8_STAGE_A(PG8_SA(1, 0), aoc, 0, 128); PG8_STAGE(PG8_SB(1, 1), cB + hstep + kstep, voffB);
    PG8_WAIT_V(6); PG8_BAR;
    for (;;) {
        const bool has_next = S.next(ui + 1, nxt);
        const char* nB = cB;
        if (has_next) nB = (const char*)g.Bt + (size_t)nxt.pn * tstep;
#pragma nounroll
        for (int t = 0; t < nt; t += 2) {
            const bool last = (t == nt - 2);
            const unsigned k1 = (unsigned)(t + 1) * 128u, k2 = last ? 0u : (unsigned)(t + 2) * 128u, k3 = k2 + 128u;
            const char* b2 = last ? nB : cB + (size_t)(t + 2) * kstep; const char* b3 = b2 + kstep;
            PG8_LDB(B0, 0, 0); PG8_LDB(B1, 0, 1); PG8_SCHED; PG8_LDA(At, 0, 0); PG8_STAGE_A(PG8_SA(1, 1), aoc, 1, k1);
            PG8_WAIT_V(8); PG8_WAIT_L(0); PG8_BAR; PG8_MMA(0, 0, At, B0); PG8_MMA(0, 1, At, B1); PG8_BAR; PG8_SCHED;
            if (last && has_next) { PG8_AOFFS(aoc, nxt); }
            PG8_LDA(At, 0, 1); PG8_STAGE(PG8_SB(0, 0), b2, voffB); PG8_STAGE(PG8_SB(0, 1), b2 + hstep, voffB); PG8_STAGE_A(PG8_SA(0, 0), aoc, 0, k2);
            PG8_WAIT_V(8); PG8_WAIT_L(0); PG8_BAR; PG8_MMA(1, 0, At, B0); PG8_MMA(1, 1, At, B1); PG8_BAR; PG8_SCHED;
            PG8_LDB(B0, 1, 0); PG8_LDB(B1, 1, 1); PG8_SCHED; PG8_LDA(At, 1, 0); PG8_STAGE_A(PG8_SA(0, 1), aoc, 1, k2);
            PG8_WAIT_V(8); PG8_WAIT_L(0); PG8_BAR; PG8_MMA(0, 0, At, B0); PG8_MMA(0, 1, At, B1); PG8_BAR; PG8_SCHED;
            PG8_LDA(At, 1, 1); PG8_STAGE(PG8_SB(1, 0), b3, voffB); PG8_STAGE(PG8_SB(1, 1), b3 + hstep, voffB); PG8_STAGE_A(PG8_SA(1, 0), aoc, 0, k3);
            PG8_WAIT_V(8); PG8_WAIT_L(0); PG8_BAR; PG8_MMA(1, 0, At, B0); PG8_MMA(1, 1, At, B1); PG8_BAR; PG8_SCHED;
        }
        if constexpr (ALIGN_EPI) { if (wr == 0) PG8_BAR; }
        { int t2 = threadIdx.x; asm volatile("" : "+v"(t2));
          const int w2 = __builtin_amdgcn_readfirstlane(t2 >> 6), l2 = t2 & 63; E(acc, cur, w2 >> 2, w2 & 3, l2 & 15, l2 >> 4); }
        if (!has_next) break;
#pragma unroll
        for (int a = 0; a < 2; ++a)
#pragma unroll
            for (int b = 0; b < 2; ++b)
#pragma unroll
                for (int m = 0; m < 4; ++m)
#pragma unroll
                    for (int n = 0; n < 2; ++n) acc[a][b][m][n] = (f32x4){0.f, 0.f, 0.f, 0.f};
        cur = nxt; cB = nB; ++ui;
        if constexpr (ALIGN_EPI) { if (wr == 1) PG8_BAR; }
    }
    PG8_WAIT_V(0);
    if constexpr (!ALIGN_EPI) { if (wr == 0) PG8_BAR; }
    PG8_BAR;
#undef PG8_SA
#undef PG8_SB
#undef PG8_STAGE
#undef PG8_STAGE_A
#undef PG8_LDA
#undef PG8_LDB
#undef PG8_MMA
#undef PG8_CAT8
#undef PG8_WAIT_V
#undef PG8_WAIT_L
#undef PG8_BAR
#undef PG8_SCHED
#undef PG8_AOFFS
}
}
struct SchedPlain : pg8::StaticOrder {
    unsigned rowbytes;
    DEV unsigned row_off(const pg8::Unit& u, int r) const { return (unsigned)(u.pm * 256 + r) * rowbytes; }
};
struct SchedMoe1 : pg8::StaticOrder {
    const LAS int* idxl;
    DEV bool next(int i, pg8::Unit& u) const { if (!pg8::StaticOrder::next(i, u)) return false; u.pn += (u.pm >> 4) * 16; u.ui = i; return true; }
    DEV unsigned row_off(const pg8::Unit& u, int r) const { const int g = u.pm * 256 + r; const int tok = ((g >> 9) & 7) * S + idxl[u.ui * 256 + r]; return (unsigned)tok * (unsigned)D; }
};
struct SchedMoe2 : pg8::StaticOrder {
    DEV bool next(int i, pg8::Unit& u) const { if (!pg8::StaticOrder::next(i, u)) return false; u.pn += (u.pm >> 4) * 4; return true; }
    DEV unsigned row_off(const pg8::Unit& u, int r) const { return (unsigned)(u.pm * 256 + r) * (unsigned)DFF; }
};
typedef pg8::f32x4 f32x4; typedef pg8::u32x4 u32x4;
struct EpiInProj {
    static constexpr bool PERM = true;
    unsigned char* ws; const float* ropeT;
    DEV void operator()(const f32x4 (&acc)[2][2][4][2], const pg8::Unit& u, int wr, int wc, int fr, int fq) const {
        const int grp = u.pn >> 1;
        bf16_t* gbase = (bf16_t*)(ws + WS_RQ + (size_t)grp * 32 * MiB);
        const int j0 = 32 * (wc & 1) + 8 * fq;
        if (grp < 2) {
            const float sc = grp == 1 ? 0.125f : 1.f;
            f32x4 cs[2][4], sn[2][4];
#pragma unroll
            for (int ai = 0; ai < 2; ++ai)
#pragma unroll
                for (int m = 0; m < 4; ++m) { const int s = (u.pm * 256 + ai * 128 + wr * 64 + m * 16 + fr) & 4095;
                    cs[ai][m] = *(const f32x4*)(ropeT + s * 32 + (j0 >> 1)); sn[ai][m] = *(const f32x4*)(ropeT + S * 32 + s * 32 + (j0 >> 1)); }
#pragma unroll
            for (int ai = 0; ai < 2; ++ai)
#pragma unroll
                for (int m = 0; m < 4; ++m) {
                    const int row = u.pm * 256 + ai * 128 + wr * 64 + m * 16 + fr, b = row >> 12, s = row & 4095;
#pragma unroll
                    for (int bj = 0; bj < 2; ++bj) {
                        const int hd = 4 * (u.pn & 1) + 2 * bj + (wc >> 1);
                        const f32x4 lo = (acc[ai][bj][m][0] * cs[ai][m] - acc[ai][bj][m][1] * sn[ai][m]) * sc, hi = (acc[ai][bj][m][1] * cs[ai][m] + acc[ai][bj][m][0] * sn[ai][m]) * sc;
                        u32x4 w; w.x = pg8::cvt_pk_bf16(lo[0], lo[1]); w.y = pg8::cvt_pk_bf16(lo[2], lo[3]); w.z = pg8::cvt_pk_bf16(hi[0], hi[1]); w.w = pg8::cvt_pk_bf16(hi[2], hi[3]);
                        *(u32x4*)(gbase + ((size_t)(b * NH + hd) * S + s) * HD + j0) = w;
                    }
                }
        } else {
            const float sc = grp == 4 ? 0.125f * LOG2E : 1.f;
#pragma unroll
            for (int ai = 0; ai < 2; ++ai)
#pragma unroll
                for (int m = 0; m < 4; ++m) {
                    const int row = u.pm * 256 + ai * 128 + wr * 64 + m * 16 + fr, b = row >> 12, s = row & 4095;
#pragma unroll
                    for (int bj = 0; bj < 2; ++bj) {
                        const int hd = 4 * (u.pn & 1) + 2 * bj + (wc >> 1);
                        const f32x4 lo = acc[ai][bj][m][0] * sc, hi = acc[ai][bj][m][1] * sc;
                        u32x4 w; w.x = pg8::cvt_pk_bf16(lo[0], lo[1]); w.y = pg8::cvt_pk_bf16(lo[2], lo[3]); w.z = pg8::cvt_pk_bf16(hi[0], hi[1]); w.w = pg8::cvt_pk_bf16(hi[2], hi[3]);
                        *(u32x4*)(gbase + ((size_t)(b * NH + hd) * S + s) * HD + j0) = w;
                    }
                }
        }
    }
};
struct EpiOutProj {
    static constexpr bool PERM = true;
    const float* x; bf16_t* x1;
    DEV void operator()(const f32x4 (&acc)[2][2][4][2], const pg8::Unit& u, int wr, int wc, int fr, int fq) const {
#pragma unroll
        for (int ai = 0; ai < 2; ++ai)
#pragma unroll
            for (int m = 0; m < 4; ++m) {
                const int row = u.pm * 256 + ai * 128 + wr * 64 + m * 16 + fr;
                f32x4 xa[2], xb[2];
#pragma unroll
                for (int bj = 0; bj < 2; ++bj) { const size_t off = (size_t)row * D + u.pn * 256 + bj * 128 + wc * 32 + 8 * fq; xa[bj] = *(const f32x4*)(x + off); xb[bj] = *(const f32x4*)(x + off + 4); }
#pragma unroll
                for (int bj = 0; bj < 2; ++bj) { const size_t off = (size_t)row * D + u.pn * 256 + bj * 128 + wc * 32 + 8 * fq;
                    const f32x4 lo = xa[bj] + acc[ai][bj][m][0], hi = xb[bj] + acc[ai][bj][m][1];
                    u32x4 w; w.x = pg8::cvt_pk_bf16(lo[0], lo[1]); w.y = pg8::cvt_pk_bf16(lo[2], lo[3]); w.z = pg8::cvt_pk_bf16(hi[0], hi[1]); w.w = pg8::cvt_pk_bf16(hi[2], hi[3]);
                    *(u32x4*)(x1 + off) = w; }
            }
    }
};
DEV unsigned pk4_fp8e(float a, float b, float c, float d) { unsigned w = 0u; w = __builtin_amdgcn_cvt_pk_fp8_f32(a, b, w, false); w = __builtin_amdgcn_cvt_pk_fp8_f32(c, d, w, true); return w; }
struct EpiSwiGLU {
    static constexpr bool PERM = true;
    unsigned char* hid;
    DEV void operator()(const f32x4 (&acc)[2][2][4][2], const pg8::Unit& u, int wr, int wc, int fr, int fq) const {
        const int pnl = u.pn & 15;
#pragma unroll
        for (int ai = 0; ai < 2; ++ai)
#pragma unroll
            for (int m = 0; m < 4; ++m) {
                const int row = u.pm * 256 + ai * 128 + wr * 64 + m * 16 + fr;
                float o[8];
#pragma unroll
                for (int n = 0; n < 2; ++n)
#pragma unroll
                    for (int i = 0; i < 4; ++i) { const float ga = acc[ai][0][m][n][i], ua = acc[ai][1][m][n][i];
                        o[4 * n + i] = (ga * ua) * ((1.f / 1024.f) * __builtin_amdgcn_rcpf(1.f + __builtin_amdgcn_exp2f(ga * (-LOG2E / 32.f)))); }
                *(uint2*)(hid + (size_t)row * DFF + pnl * 128 + wc * 32 + 8 * fq) = make_uint2(pk4_fp8e(o[0], o[1], o[2], o[3]), pk4_fp8e(o[4], o[5], o[6], o[7]));
            }
    }
};
struct EpiDown {
    static constexpr bool PERM = true;
    bf16_t* y;
    DEV void operator()(const f32x4 (&acc)[2][2][4][2], const pg8::Unit& u, int wr, int wc, int fr, int fq) const {
        const int pnl = u.pn & 3;
#pragma unroll
        for (int ai = 0; ai < 2; ++ai)
#pragma unroll
            for (int m = 0; m < 4; ++m) {
                const int row = u.pm * 256 + ai * 128 + wr * 64 + m * 16 + fr;
#pragma unroll
                for (int bj = 0; bj < 2; ++bj) { const f32x4 lo = acc[ai][bj][m][0] * (1.f / 32.f), hi = acc[ai][bj][m][1] * (1.f / 32.f);
                    u32x4 w; w.x = pg8::cvt_pk_bf16(lo[0], lo[1]); w.y = pg8::cvt_pk_bf16(lo[2], lo[3]); w.z = pg8::cvt_pk_bf16(hi[0], hi[1]); w.w = pg8::cvt_pk_bf16(hi[2], hi[3]);
                    *(u32x4*)(y + (size_t)row * D + pnl * 256 + bj * 128 + wc * 32 + 8 * fq) = w; }
            }
    }
};
struct Args { const float* in[13]; float* out; unsigned char* ws; int ph_lo, ph_hi; int rep[16]; };
enum { IN_X = 0, IN_G1, IN_WIN, IN_DECAY, IN_GN, IN_RELB, IN_WOUT, IN_G2, IN_WR, IN_WG, IN_WU, IN_WDN, IN_FG };

struct TrItem { const float* src; bf16_t* dst; int K, N, k0, n0, mode, fp8; };
DEV unsigned pk4_fp8(float a, float b, float c, float d) { unsigned w = 0u; w = __builtin_amdgcn_cvt_pk_fp8_f32(a, b, w, false); w = __builtin_amdgcn_cvt_pk_fp8_f32(c, d, w, true); return w; }
DEV void tr_load(const TrItem& t, f32x4 (&v)[16], int lane) {
#pragma unroll
    for (int i = 0; i < 16; ++i) { const int kk = (lane >> 4) + 4 * i, c = (lane & 15) * 4; v[i] = *(const f32x4*)(t.src + (size_t)(t.k0 + kk) * t.N + t.n0 + c); }
}
DEV int rowmap_rt(int mode, int n) {
    if (mode == 0) return n;
    if (mode == 1) { if (n >= 1024) return n; const int base = n & ~63, d = n & 63, nn = d >> 5, dd = d & 31; return base + 8 * (dd >> 2) + 4 * nn + (dd & 3); }
    return (n >> 7) * 256 + (mode == 3 ? 128 : 0) + (n & 127);
}
DEV void tr_finish(const TrItem& t, const f32x4 (&v)[16], LAS float* scr, int lane) {
#pragma unroll
    for (int i = 0; i < 16; ++i) { const int kk = (lane >> 4) + 4 * i, c = (lane & 15) * 4;
        scr[kk * 65 + c] = v[i][0]; scr[kk * 65 + c + 1] = v[i][1]; scr[kk * 65 + c + 2] = v[i][2]; scr[kk * 65 + c + 3] = v[i][3]; }
    LDS_WAIT();
#pragma unroll
    for (int i = 0; i < 8; ++i) { const int n = (lane >> 3) + 8 * i, c = (lane & 7) * 8; const LAS float* sp = scr + c * 65 + n;
        if (t.fp8) {
            const unsigned lo = pk4_fp8(sp[0] * 32.f, sp[65] * 32.f, sp[2 * 65] * 32.f, sp[3 * 65] * 32.f), hi = pk4_fp8(sp[4 * 65] * 32.f, sp[5 * 65] * 32.f, sp[6 * 65] * 32.f, sp[7 * 65] * 32.f);
            *(uint2*)((unsigned char*)t.dst + (size_t)rowmap_rt(t.mode, t.n0 + n) * t.K + t.k0 + c) = make_uint2(lo, hi);
        } else {
        u32x4 o; o.x = pk2(sp[0], sp[65]); o.y = pk2(sp[2 * 65], sp[3 * 65]); o.z = pk2(sp[4 * 65], sp[5 * 65]); o.w = pk2(sp[6 * 65], sp[7 * 65]);
        *(u32x4*)(t.dst + (size_t)rowmap_rt(t.mode, t.n0 + n) * t.K + t.k0 + c) = o; } }
    LDS_WAIT();
}
template <class Dec> DEV void tr_run(const Dec& dec, int nitems, int gw, int NGW, LAS float* scr, int lane) {
    for (int it = gw; it < nitems; it += NGW) { TrItem cur; f32x4 va[16]; dec(it, cur); tr_load(cur, va, lane); tr_finish(cur, va, scr, lane); }
}
DEV void rms_row_to_bf16(const float* xrow, const float* g, bf16_t* orow, int lane) {
    const float4* xr = (const float4*)xrow + lane;
    float4 v[4]; float s = 0.f;
#pragma unroll
    for (int j = 0; j < 4; ++j) { v[j] = xr[64 * j]; s += v[j].x * v[j].x + v[j].y * v[j].y + v[j].z * v[j].z + v[j].w * v[j].w; }
    const float rs = rsqrtf(wave_sum(s) * (1.f / D) + EPS);
    uint2* o = (uint2*)orow + lane;
#pragma unroll
    for (int j = 0; j < 4; ++j) { const float4 gg = ((const float4*)g)[lane + 64 * j];
        o[64 * j] = make_uint2(pk2(v[j].x * rs * gg.x, v[j].y * rs * gg.y), pk2(v[j].z * rs * gg.z, v[j].w * rs * gg.w)); }
}
DEV void phase_prep(const Args& a, unsigned char* lds, int gw, int NGW, int lane, int wave) {
    unsigned char* ws = a.ws;
    float* ropeT = (float*)(ws + WS_ROPE); float* biasT = (float*)(ws + WS_BIAS);
    for (int t = gw * 64 + lane; t < S * 32; t += NGW * 64) {
        const int pos = t >> 5, i = t & 31; const double inv = pow(10000.0, -(double)i / 32.0), ang = (double)pos * inv;
        ropeT[t] = (float)cos(ang); ropeT[S * 32 + t] = (float)sin(ang);
        if (t < 3 * NH * 129) { const int p = t / (NH * 129), h = (t / 129) % NH, o = t % 129 - 64, dil = p == 0 ? 1 : (p == 1 ? 4 : 16), rel = o * dil, n = rel < 0 ? -rel : rel;
            int bucket = rel > 0 ? 16 : 0;
            if (n < 8) bucket += n; else { int large = 8 + (int)(log((double)n / 8.0) / log(128.0) * 8.0); if (large > 15) large = 15; bucket += large; }
            biasT[t] = a.in[IN_RELB][bucket * NH + h] * LOG2E; }
    }
    LAS float* scr = (LAS float*)((LAS unsigned char*)lds + wave * 16640);
    constexpr int I_IN = (D / 64) * (PC / 64), I_OUT = (D / 64) * (D / 64);
    { const float* w_in = a.in[IN_WIN]; const float* w_out = a.in[IN_WOUT]; bf16_t* Win = (bf16_t*)(ws + WS_WIN); bf16_t* Wout = (bf16_t*)(ws + WS_WOUT);
      auto dec = [=](int it, TrItem& t) { if (it < I_IN) { t.src = w_in; t.dst = Win; t.K = D; t.N = PC; t.k0 = (it / (PC / 64)) * 64; t.n0 = (it % (PC / 64)) * 64; t.mode = 1; t.fp8 = 0; }
          else { const int r = it - I_IN; t.src = w_out; t.dst = Wout; t.K = D; t.N = D; t.k0 = (r / (D / 64)) * 64; t.n0 = (r % (D / 64)) * 64; t.mode = 0; t.fp8 = 0; } };
      tr_run(dec, I_IN + I_OUT, gw, NGW, scr, lane); }
    for (int m = gw; m < M; m += NGW) rms_row_to_bf16(a.in[IN_X] + (size_t)m * D, a.in[IN_G1], (bf16_t*)(ws + WS_XN) + (size_t)m * D, lane);
}
DEV void phase_latew(const Args& a, unsigned char* lds, int gw, int NGW, int lane, int wave) {
    unsigned char* ws = a.ws; LAS float* scr = (LAS float*)((LAS unsigned char*)lds + wave * 16640);
    constexpr int I_G = (D / 64) * (DFF / 64);
    const float* wg_ = a.in[IN_WG]; const float* wu_ = a.in[IN_WU]; const float* wd_ = a.in[IN_WDN]; bf16_t* Wgu = (bf16_t*)(ws + WS_WGU); bf16_t* Wd = (bf16_t*)(ws + WS_WD);
    auto dec = [=](int it, TrItem& t) { const int which = it / (NE * I_G), r = it % (NE * I_G), e = r / I_G, q = r % I_G;
        t.fp8 = 1;
        if (which < 2) { t.src = (which == 0 ? wg_ : wu_) + (size_t)e * D * DFF; t.dst = (bf16_t*)((unsigned char*)Wgu + (size_t)e * 4096 * D); t.K = D; t.N = DFF; t.k0 = (q / (DFF / 64)) * 64; t.n0 = (q % (DFF / 64)) * 64; t.mode = 2 + which; }
        else { t.src = wd_ + (size_t)e * DFF * D; t.dst = (bf16_t*)((unsigned char*)Wd + (size_t)e * D * DFF); t.K = DFF; t.N = D; t.k0 = (q / (D / 64)) * 64; t.n0 = (q % (D / 64)) * 64; t.mode = 0; } };
    tr_run(dec, 3 * NE * I_G, gw, NGW, scr, lane);
}
DEV void phase_router(const Args& a, unsigned char* lds, int gw, int NGW, int lane, int tid) {
    unsigned char* ws = a.ws; const bf16_t* x1 = (const bf16_t*)(ws + WS_X1); const float* g2 = a.in[IN_G2]; const float* wr = a.in[IN_WR];
    bf16_t* H2b = (bf16_t*)(ws + WS_XN); float* aff = (float*)(ws + WS_AFF); float* affT = (float*)(ws + WS_AFFT); int* inv = (int*)(ws + WS_INV);
    LAS f32x4* wl = (LAS f32x4*)(LAS unsigned char*)lds;
    for (int i = tid; i < D * 4; i += NTHR) { const int k = i >> 2, c = i & 3, slot = (k & 3) * 256 + (k >> 2); wl[slot * 4 + ((c + (slot >> 2)) & 3)] = *(const f32x4*)(wr + (size_t)k * NE + 4 * c); }
    __syncthreads();
    uint2 xw[4], xn[4];
    { const uint2* xr = (const uint2*)(x1 + (size_t)gw * D) + lane;
#pragma unroll
      for (int j = 0; j < 4; ++j) xw[j] = xr[64 * j]; }
    for (int row = gw; row < M; row += NGW) {
        if (row + NGW < M) { const uint2* xr = (const uint2*)(x1 + (size_t)(row + NGW) * D) + lane;
#pragma unroll
            for (int j = 0; j < 4; ++j) xn[j] = xr[64 * j]; }
        float4 v[4]; float s = 0.f;
#pragma unroll
        for (int j = 0; j < 4; ++j) { v[j] = make_float4(bf2f(xw[j].x & 0xffffu), bf2f(xw[j].x >> 16), bf2f(xw[j].y & 0xffffu), bf2f(xw[j].y >> 16)); s += v[j].x * v[j].x + v[j].y * v[j].y + v[j].z * v[j].z + v[j].w * v[j].w; }
#pragma unroll
        for (int j = 0; j < 4; ++j) xw[j] = xn[j];
        const float rs = rsqrtf(wave_sum(s) * (1.f / D) + EPS);
        f32x4 lg[4];
#pragma unroll
        for (int c = 0; c < 4; ++c) lg[c] = (f32x4){0.f, 0.f, 0.f, 0.f};
        unsigned* o = (unsigned*)((unsigned char*)H2b + (size_t)row * D) + lane;
#pragma unroll
        for (int j = 0; j < 4; ++j) { const float4 gg = ((const float4*)g2)[lane + 64 * j];
            const float hv[4] = {v[j].x * rs * gg.x, v[j].y * rs * gg.y, v[j].z * rs * gg.z, v[j].w * rs * gg.w};
            o[64 * j] = pk4_fp8(hv[0], hv[1], hv[2], hv[3]);
#pragma unroll
            for (int t = 0; t < 4; ++t) { const int slot = t * 256 + lane + 64 * j, rot = (lane >> 2) & 3;
#pragma unroll
                for (int c = 0; c < 4; ++c) lg[c] += hv[t] * wl[slot * 4 + ((c + rot) & 3)];
                __builtin_amdgcn_sched_barrier(0); } }
        float l16[16]; float mx = -1e30f;
#pragma unroll
        for (int e = 0; e < 16; ++e) { l16[e] = wave_sum(lg[e >> 2][e & 3]); mx = fmaxf(mx, l16[e]); }
        float sum = 0.f;
#pragma unroll
        for (int e = 0; e < 16; ++e) { l16[e] = __expf(l16[e] - mx); sum += l16[e]; }
        const float is = 1.f / sum;
        if (lane < 16) { float av = 0.f;
#pragma unroll
            for (int e = 0; e < 16; ++e) av = lane == e ? l16[e] * is : av;
            aff[(size_t)row * NE + lane] = av; inv[(size_t)row * NE + lane] = -1; affT[((size_t)(row >> 12) * NE + lane) * S + (row & 4095)] = av; }
    }
    __syncthreads();
}
DEV void phase_topk(const Args& a, unsigned char* lds, int wg, int G, int tid, int lane, int wave) {
    unsigned char* ws = a.ws; const float* affT = (const float*)(ws + WS_AFFT); int* idx = (int*)(ws + WS_IDX); int* inv = (int*)(ws + WS_INV);
    LAS unsigned* hist = (LAS unsigned*)(LAS unsigned char*)lds; LAS unsigned* wsum = hist + 256; LAS unsigned* bc = hist + 272;
    for (int it = wg; it < NE * NB; it += G) {
        const int e = it & 15, b = it >> 4;
        unsigned u[8];
        { const uint4* src = (const uint4*)(affT + ((size_t)b * NE + e) * S + 8 * tid); const uint4 p = src[0], q = src[1]; u[0] = p.x; u[1] = p.y; u[2] = p.z; u[3] = p.w; u[4] = q.x; u[5] = q.y; u[6] = q.z; u[7] = q.w; }
        unsigned prefix = 0u, kk = CAP;
#pragma unroll
        for (int pass = 0; pass < 4; ++pass) {
            const int shift = 24 - 8 * pass;
            __syncthreads();
            if (tid < 256) hist[tid] = 0u;
            __syncthreads();
#pragma unroll
            for (int j = 0; j < 8; ++j) if (pass == 0 || (u[j] >> (shift + 8)) == prefix) atomicAdd((unsigned*)&hist[(u[j] >> shift) & 255u], 1u);
            __syncthreads();
            if (wave == 0) {
                const unsigned c0 = hist[4 * lane], c1 = hist[4 * lane + 1], c2 = hist[4 * lane + 2], c3 = hist[4 * lane + 3], tot = c0 + c1 + c2 + c3;
                unsigned incl = tot;
#pragma unroll
                for (int o = 1; o < 64; o <<= 1) { const unsigned t = __shfl_down(incl, o); if (lane + o < 64) incl += t; }
                const unsigned excl = incl - tot;
                if (excl < kk && kk <= incl) { unsigned acc = excl; int bin;
                    if (acc + c3 >= kk) bin = 3; else { acc += c3; if (acc + c2 >= kk) bin = 2; else { acc += c2; if (acc + c1 >= kk) bin = 1; else { acc += c1; bin = 0; } } }
                    bc[0] = 4 * lane + bin; bc[1] = kk - acc; }
            }
            __syncthreads();
            prefix = (prefix << 8) | bc[0]; kk = bc[1];
        }
        const unsigned T = prefix, need = kk;
        unsigned cg_ = 0u, ce = 0u;
#pragma unroll
        for (int j = 0; j < 8; ++j) { cg_ += u[j] > T; ce += u[j] == T; }
        unsigned pk = cg_ | (ce << 16), incl = pk;
#pragma unroll
        for (int o = 1; o < 64; o <<= 1) { const unsigned t = __shfl_up(incl, o); if (lane >= o) incl += t; }
        if (lane == 63) wsum[wave] = incl;
        __syncthreads();
        unsigned base = 0u;
#pragma unroll
        for (int w = 0; w < NWAVES; ++w) base += w < wave ? wsum[w] : 0u;
        const unsigned ex = base + incl - pk; unsigned gtb = ex & 0xffffu, eqb = ex >> 16;
#pragma unroll
        for (int j = 0; j < 8; ++j) { const bool g = u[j] > T, q = u[j] == T; const unsigned slot = gtb + (eqb < need ? eqb : need);
            if (g || (q && eqb < need)) { const int s = 8 * tid + j; idx[(e * NB + b) * CAP + slot] = s; inv[((size_t)b * S + s) * NE + e] = (int)slot; }
            gtb += g; eqb += q; }
    }
}
DEV void phase_final(const Args& a, int gw, int NGW, int lane) {
    unsigned char* ws = a.ws; float* xo = a.out; const bf16_t* x1 = (const bf16_t*)(ws + WS_X1); const float* aff = (const float*)(ws + WS_AFF); const int* inv = (const int*)(ws + WS_INV);
    const bf16_t* y = (const bf16_t*)(ws + WS_Y); const float* fg = a.in[IN_FG];
    uint2 xw[4], xn[4]; int iv = -1, ivn = -1; float av = 0.f, avn = 0.f;
    { const uint2* xr = (const uint2*)(x1 + (size_t)gw * D) + lane;
#pragma unroll
      for (int j = 0; j < 4; ++j) xw[j] = xr[64 * j];
      if (lane < NE) { iv = inv[(size_t)gw * NE + lane]; av = aff[(size_t)gw * NE + lane]; } }
    for (int row = gw; row < M; row += NGW) {
        const int b = row >> 12;
        if (row + NGW < M) { const uint2* xr = (const uint2*)(x1 + (size_t)(row + NGW) * D) + lane;
#pragma unroll
            for (int j = 0; j < 4; ++j) xn[j] = xr[64 * j];
            if (lane < NE) { ivn = inv[(size_t)(row + NGW) * NE + lane]; avn = aff[(size_t)(row + NGW) * NE + lane]; } }
        float4 v[4];
#pragma unroll
        for (int j = 0; j < 4; ++j) v[j] = make_float4(bf2f(xw[j].x & 0xffffu), bf2f(xw[j].x >> 16), bf2f(xw[j].y & 0xffffu), bf2f(xw[j].y >> 16));
        unsigned long long msk = __ballot(lane < NE && iv >= 0);
        while (msk) { const int e = __builtin_ctzll(msk); msk &= msk - 1;
            const int sl = __builtin_amdgcn_readlane(iv, e); const float g = __builtin_bit_cast(float, __builtin_amdgcn_readlane(__builtin_bit_cast(int, av), e));
            const uint2* yr = (const uint2*)(y + ((size_t)e * 4096 + b * CAP + sl) * D) + lane;
#pragma unroll
            for (int j = 0; j < 4; ++j) { const uint2 w = yr[64 * j]; v[j].x += g * bf2f(w.x & 0xffffu); v[j].y += g * bf2f(w.x >> 16); v[j].z += g * bf2f(w.y & 0xffffu); v[j].w += g * bf2f(w.y >> 16); } }
        float s = 0.f;
#pragma unroll
        for (int j = 0; j < 4; ++j) s += v[j].x * v[j].x + v[j].y * v[j].y + v[j].z * v[j].z + v[j].w * v[j].w;
        const float rs = rsqrtf(wave_sum(s) * (1.f / D) + EPS);
        float4* orow = (float4*)(xo + (size_t)row * D) + lane;
#pragma unroll
        for (int j = 0; j < 4; ++j) { const float4 gg = ((const float4*)fg)[lane + 64 * j]; orow[64 * j] = make_float4(v[j].x * rs * gg.x, v[j].y * rs * gg.y, v[j].z * rs * gg.z, v[j].w * rs * gg.w); }
#pragma unroll
        for (int j = 0; j < 4; ++j) xw[j] = xn[j];
        iv = ivn; av = avn;
    }
}
typedef short bf16x8 __attribute__((ext_vector_type(8)));
typedef float f32x16 __attribute__((ext_vector_type(16)));
typedef short s16x4 __attribute__((ext_vector_type(4)));
typedef LAS const char* lds_cptr;
typedef unsigned u32x2 __attribute__((ext_vector_type(2)));
constexpr int VROW = 192;
constexpr int VSLOT = 32 * VROW;
constexpr int KROW = 144;
constexpr int KSLOT = 32 * KROW;
constexpr int MIX_WAVE_LDS = 2 * VSLOT;
constexpr int MIX_BIAS_OFF = NWAVES * MIX_WAVE_LDS;
DEV int crow(int r, int hi) { return (r & 3) + 8 * (r >> 2) + 4 * hi; }
DEV s16x4 vtr(lds_cptr p) { return __builtin_bit_cast(s16x4, __builtin_amdgcn_ds_read_tr16_b64_v4i16((LAS s16x4*)p)); }
DEV bf16x8 tr_frag(lds_cptr slot, int s, int blk, int lane) {
    const int h = lane >> 5; lds_cptr p = slot + (16 * s + 4 * h + ((lane & 15) >> 2)) * VROW + (32 * blk + 16 * ((lane >> 4) & 1) + 4 * (lane & 3)) * 2;
    const s16x4 lo = vtr(p), hi = vtr(p + 8 * VROW);
    return (bf16x8){lo[0], lo[1], lo[2], lo[3], hi[0], hi[1], hi[2], hi[3]};
}
DEV void load_frags(bf16x8 (&f)[4], const bf16_t* rowp, int lane) {
    const int h = lane >> 5;
#pragma unroll
    for (int st = 0; st < 4; ++st) f[st] = *(const bf16x8*)(rowp + 16 * st + 8 * h);
}
DEV bf16x8 pack_p(const f32x16& p, int s) {
    u32x4 w; w.x = pg8::cvt_pk_bf16(p[8 * s], p[8 * s + 1]); w.y = pg8::cvt_pk_bf16(p[8 * s + 2], p[8 * s + 3]); w.z = pg8::cvt_pk_bf16(p[8 * s + 4], p[8 * s + 5]); w.w = pg8::cvt_pk_bf16(p[8 * s + 6], p[8 * s + 7]);
    return __builtin_bit_cast(bf16x8, w);
}

DEV void stage_rows_k(LAS unsigned char* ks, const u32x4 (&raw)[4], int lane) {
    const int rr = lane >> 3, ch = lane & 7;
#pragma unroll
    for (int i = 0; i < 4; ++i) *(LAS u32x4*)(ks + (rr + 8 * i) * KROW + ch * 16) = raw[i];
}
DEV void read_row_frags(bf16x8 (&f)[4], const LAS unsigned char* ks, int lane) {
    const LAS unsigned char* p = ks + (lane & 31) * KROW + (lane >> 5) * 16;
#pragma unroll
    for (int st = 0; st < 4; ++st) f[st] = *(const LAS bf16x8*)(p + st * 32);
}
#define MFMA32(a, b, c) __builtin_amdgcn_mfma_f32_32x32x16_bf16((a), (b), (c), 0, 0, 0)
DEV float ex2(float x) { return __builtin_amdgcn_exp2f(x); }

struct AttnIt { int p, bh, sh, L, r, q0, kmin, kmax; };
DEV void attn_decode(int li, int x, AttnIt& d) {
    d.p = li >> 9; d.bh = 8 * x + ((li >> 6) & 7); const int qblk = li & 63;
    d.sh = 2 * d.p; d.L = S >> d.sh; const int bpr = d.L >> 6;
    d.r = qblk / bpr; d.q0 = (qblk % bpr) * 64;
    d.kmin = d.q0 >= 64 ? 0 : 2; const int km = (d.L + 63 - d.q0) >> 5; d.kmax = km > 5 ? 5 : km;
}
DEV int med3i(int v, int lo, int hi) { return v < lo ? lo : (v > hi ? hi : v); }
DEV void attn_ldrows(const bf16_t* base, const AttnIt& d, int i0, u32x4 (&v)[4], int lane) {
    const int rr = lane >> 3, ch = lane & 7; const char* hb = (const char*)(base + (size_t)d.bh * S * HD); const unsigned cst = (unsigned)(d.r * 128 + ch * 16);
#pragma unroll
    for (int i = 0; i < 4; ++i) v[i] = *(const u32x4*)(hb + (((unsigned)med3i(i0 + rr + 8 * i, 0, d.L - 1) << (d.sh + 7)) + cst));
}
DEV void attn_ldkv(const Args& a, const AttnIt& d, int kk, u32x4 (&k)[4], u32x4 (&v)[4], int lane) {
    const int rr = lane >> 3, ch = lane & 7, i0 = d.q0 - 64 + 32 * kk; const unsigned cst = (unsigned)(d.r * 128 + ch * 16);
    const char* kb = (const char*)((const bf16_t*)(a.ws + WS_AK) + (size_t)d.bh * S * HD); const char* vb = (const char*)((const bf16_t*)(a.ws + WS_AV) + (size_t)d.bh * S * HD);
#pragma unroll
    for (int i = 0; i < 4; ++i) { const unsigned off = ((unsigned)med3i(i0 + rr + 8 * i, 0, d.L - 1) << (d.sh + 7)) + cst; k[i] = *(const u32x4*)(kb + off); v[i] = *(const u32x4*)(vb + off); }
}
DEV void attn_items(const Args& a, unsigned char* lds, int wg, int G, int lane, int wave) {
    unsigned char* ws = a.ws;
    constexpr int NIT = 3 * 512; constexpr float THR = 6.f;
    const int x = wg & 7, NGW = (G >> 3) * NWAVES;
    int item = (wg >> 3) * NWAVES + wave; if (item >= NIT) return;
    LAS unsigned char* slot = (LAS unsigned char*)lds + wave * MIX_WAVE_LDS; lds_cptr slot3 = (lds_cptr)slot; LAS unsigned char* kslot = slot + VSLOT;
    const int t = lane & 31, hi = lane >> 5, rr = lane >> 3, ch = lane & 7;
    AttnIt d; attn_decode(item, x, d);
    bf16x8 qf[2][4], kf[4]; u32x4 kraw[4], vv[4];
    attn_ldkv(a, d, d.kmin, kraw, vv, lane);
    for (;;) {
        const LAS float* tph = (const LAS float*)((LAS unsigned char*)lds + MIX_BIAS_OFF) + (d.p * NH + (d.bh & 7)) * 192 + (32 + 4 * hi - t);
        f32x16 o[2][2] = {}; float m[2] = {0.f, 0.f}, l[2] = {0.f, 0.f};
        const int nitem = item + NGW; const bool hasn = nitem < NIT;
        AttnIt dn = d; if (hasn) attn_decode(nitem, x, dn);
#pragma unroll
        for (int j = 0; j < 2; ++j) { u32x4 qraw[4]; attn_ldrows((const bf16_t*)(ws + WS_AQ), d, d.q0 + 32 * j, qraw, lane); stage_rows_k(kslot, qraw, lane); asm volatile("" ::: "memory"); read_row_frags(qf[j], kslot, lane); asm volatile("" ::: "memory"); }
        for (int kk = d.kmin; kk <= d.kmax; ++kk) {
            const int kbase = d.q0 - 64 + 32 * kk;
#pragma unroll
            for (int i = 0; i < 4; ++i) *(LAS u32x4*)(slot + (rr + 8 * i) * VROW + ch * 16) = vv[i];
            stage_rows_k(kslot, kraw, lane);
            asm volatile("" ::: "memory");
            read_row_frags(kf, kslot, lane);
            const bf16x8 v00 = tr_frag(slot3, 0, 0, lane), v10 = tr_frag(slot3, 1, 0, lane), v01 = tr_frag(slot3, 0, 1, lane), v11 = tr_frag(slot3, 1, 1, lane);
            asm volatile("" ::: "memory");
            if (kk < d.kmax) attn_ldkv(a, d, kk + 1, kraw, vv, lane);
            else if (hasn) attn_ldkv(a, dn, dn.kmin, kraw, vv, lane);
            const bool edge = kbase < 0 || kbase + 31 >= d.L;
#pragma unroll
            for (int j = 0; j < 2; ++j) {
                const int kj = kk - j; if (kj < 0 || kj > 4) continue;
                f32x16 sc = {};
#pragma unroll
                for (int st = 0; st < 4; ++st) sc = MFMA32(kf[st], qf[j][st], sc);
                const LAS float* tb = tph + 32 * kj;
#pragma unroll
                for (int rg = 0; rg < 16; ++rg) sc[rg] = (sc[rg] - m[j]) + tb[(rg & 3) + 8 * (rg >> 2)];
                if (edge) {
#pragma unroll
                    for (int rg = 0; rg < 16; ++rg) { const int ki = kbase + crow(rg, hi); sc[rg] = (ki >= 0 && ki < d.L) ? sc[rg] : -1e30f; } }
                float mx = fmaxf(fmaxf(sc[0], sc[1]), fmaxf(sc[2], sc[3]));
#pragma unroll
                for (int rg = 4; rg < 16; rg += 4) mx = fmaxf(mx, fmaxf(fmaxf(sc[rg], sc[rg + 1]), fmaxf(sc[rg + 2], sc[rg + 3])));
                mx = fmaxf(mx, __shfl_xor(mx, 32));
                const bool first = kj == 0 || kk == d.kmin;
                if (first || __any(mx > THR)) {
                    const float dl = first ? mx : fmaxf(mx, 0.f), f = ex2(-dl); m[j] += dl; l[j] *= f;
#pragma unroll
                    for (int rg = 0; rg < 16; ++rg) { sc[rg] -= dl; o[j][0][rg] *= f; o[j][1][rg] *= f; }
                }
                float ps0 = 0.f, ps1 = 0.f;
#pragma unroll
                for (int rg = 0; rg < 16; rg += 2) { sc[rg] = ex2(sc[rg]); sc[rg + 1] = ex2(sc[rg + 1]); ps0 += sc[rg]; ps1 += sc[rg + 1]; }
                l[j] += ps0 + ps1;
                const bf16x8 p0 = pack_p(sc, 0), p1 = pack_p(sc, 1);
                o[j][0] = MFMA32(v00, p0, o[j][0]); o[j][0] = MFMA32(v10, p1, o[j][0]);
                o[j][1] = MFMA32(v01, p0, o[j][1]); o[j][1] = MFMA32(v11, p1, o[j][1]);
            }
        }
#pragma unroll
        for (int j = 0; j < 2; ++j) {
            float lt = l[j] + __shfl_xor(l[j], 32);
            const float il = 1.f / lt;
            const size_t orow = ((size_t)d.p * NB * NH + d.bh) * S + (size_t)(((d.q0 + 32 * j + t) << d.sh) + d.r);
#pragma unroll
            for (int g4 = 0; g4 < 4; ++g4) {
                *(LAS u32x2*)(kslot + t * KROW + (8 * g4 + 4 * hi) * 2) = (u32x2){pg8::cvt_pk_bf16(o[j][0][4 * g4] * il, o[j][0][4 * g4 + 1] * il), pg8::cvt_pk_bf16(o[j][0][4 * g4 + 2] * il, o[j][0][4 * g4 + 3] * il)};
                *(LAS u32x2*)(kslot + t * KROW + (32 + 8 * g4 + 4 * hi) * 2) = (u32x2){pg8::cvt_pk_bf16(o[j][1][4 * g4] * il, o[j][1][4 * g4 + 1] * il), pg8::cvt_pk_bf16(o[j][1][4 * g4 + 2] * il, o[j][1][4 * g4 + 3] * il)};
            }
            asm volatile("" ::: "memory");
            { bf16_t* ob = (bf16_t*)(ws + WS_ATTO) + ((size_t)d.p * NB * NH + d.bh) * S * HD;
#pragma unroll
              for (int i = 0; i < 4; ++i) { const u32x4 w = *(const LAS u32x4*)(kslot + (rr + 8 * i) * KROW + ch * 16);
                  *(u32x4*)(ob + (size_t)(((d.q0 + 32 * j + rr + 8 * i) << d.sh) + d.r) * HD + ch * 8) = w; } }
            asm volatile("" ::: "memory");
            if (hi == 0) ((float*)(ws + WS_ATTL))[orow] = m[j] + __log2f(lt);
        }
        if (!hasn) break;
        item = nitem; d = dn;
    }
}
DEV void retstate_item(const Args& a, unsigned char* lds, int item, int xg, int lane, int wave) {
    unsigned char* ws = a.ws;
    const int dir = item & 1, n = (item >> 1) & 31, bh = 8 * xg + (item >> 6), h = bh & 7;
    const bf16_t* Kc = (const bf16_t*)(ws + WS_RK) + ((size_t)bh * S + n * 128) * HD; const bf16_t* Vc = (const bf16_t*)(ws + WS_RV) + ((size_t)bh * S + n * 128) * HD;
    const float lg = a.in[IN_DECAY][dir * NH + h] * LOG2E;
    LAS unsigned char* vs = (LAS unsigned char*)lds + wave * MIX_WAVE_LDS; LAS unsigned char* ks = vs + VSLOT; lds_cptr vs3 = (lds_cptr)vs, ks3 = (lds_cptr)ks;
    f32x16 acc[2][2] = {};
    for (int blk = 0; blk < 4; ++blk) {
        { const int rr = lane >> 3, ch = lane & 7;
          u32x4 v[4], k[4];
#pragma unroll
          for (int i = 0; i < 4; ++i) { const int mrow = 32 * blk + rr + 8 * i; v[i] = *(const u32x4*)(Vc + (size_t)mrow * HD + ch * 8); k[i] = *(const u32x4*)(Kc + (size_t)mrow * HD + ch * 8); }
#pragma unroll
          for (int i = 0; i < 4; ++i) { const int mrow = 32 * blk + rr + 8 * i; const float z = ex2(lg * (float)(dir == 0 ? 127 - mrow : mrow));
              const unsigned kw[4] = {k[i].x, k[i].y, k[i].z, k[i].w}; u32x4 o;
              o.x = pg8::cvt_pk_bf16(bf2f(kw[0] & 0xffffu) * z, bf2f(kw[0] >> 16) * z); o.y = pg8::cvt_pk_bf16(bf2f(kw[1] & 0xffffu) * z, bf2f(kw[1] >> 16) * z);
              o.z = pg8::cvt_pk_bf16(bf2f(kw[2] & 0xffffu) * z, bf2f(kw[2] >> 16) * z); o.w = pg8::cvt_pk_bf16(bf2f(kw[3] & 0xffffu) * z, bf2f(kw[3] >> 16) * z);
              *(LAS u32x4*)(vs + (rr + 8 * i) * VROW + ch * 16) = v[i]; *(LAS u32x4*)(ks + (rr + 8 * i) * VROW + ch * 16) = o; } }
        LDS_WAIT();
#pragma unroll
        for (int s = 0; s < 2; ++s) {
            const bf16x8 v0 = tr_frag(vs3, s, 0, lane), v1 = tr_frag(vs3, s, 1, lane), k0 = tr_frag(ks3, s, 0, lane), k1 = tr_frag(ks3, s, 1, lane);
            acc[0][0] = MFMA32(v0, k0, acc[0][0]); acc[0][1] = MFMA32(v0, k1, acc[0][1]); acc[1][0] = MFMA32(v1, k0, acc[1][0]); acc[1][1] = MFMA32(v1, k1, acc[1][1]);
        }
        LDS_WAIT();
    }
    float* KT = (float*)(ws + WS_KF) + (((size_t)dir * NB * NH + bh) * 32 + n) * 4096;
    const int c = lane & 31, hi = lane >> 5;
#pragma unroll
    for (int eb = 0; eb < 2; ++eb)
#pragma unroll
        for (int db = 0; db < 2; ++db)
#pragma unroll
            for (int rg = 0; rg < 16; ++rg) KT[(32 * eb + crow(rg, hi)) * 64 + 32 * db + c] = acc[eb][db][rg];
}
DEV void phase_scan(const Args& a, int gtid, int NT) {
    unsigned char* ws = a.ws;
    for (int sl = gtid; sl < 2 * NB * NH * 1024; sl += NT) {
        const int dir = sl >> 16, bh = (sl >> 10) & 63, q = sl & 1023, h = bh & 7;
        const float gC = ex2(a.in[IN_DECAY][dir * NH + h] * LOG2E * 128.f);
        const float4* kt = (const float4*)(ws + WS_KF) + ((size_t)dir * NB * NH + bh) * 32 * 1024 + q;
        uint2* st = (uint2*)(ws + WS_ST) + ((size_t)dir * NB * NH + bh) * 32 * 1024 + q;
        float4 s = make_float4(0.f, 0.f, 0.f, 0.f);
        for (int i = 0; i < 32; ++i) { const int n = dir == 0 ? i : 31 - i;
            st[(size_t)n * 1024] = make_uint2(pg8::cvt_pk_bf16(s.x, s.y), pg8::cvt_pk_bf16(s.z, s.w));
            const float4 kv = kt[(size_t)n * 1024];
            s.x = gC * s.x + kv.x; s.y = gC * s.y + kv.y; s.z = gC * s.z + kv.z; s.w = gC * s.w + kv.w; }
    }
}
DEV void ld_rows32(const bf16_t* base, u32x4 (&v)[4], int lane) {
    const char* b = (const char*)base; const unsigned off = (unsigned)((lane >> 3) * 128 + (lane & 7) * 16);
#pragma unroll
    for (int i = 0; i < 4; ++i) v[i] = *(const u32x4*)(b + off + i * 1024);
}
DEV void retout_item(const Args& a, unsigned char* lds, int item, int xg, int lane, int wave) {
    unsigned char* ws = a.ws;
    const int hq = item & 1, n = (item >> 1) & 31, bh = 8 * xg + (item >> 6), h = bh & 7, b = bh >> 3;
    const bf16_t* Qc = (const bf16_t*)(ws + WS_RQ) + ((size_t)bh * S + n * 128) * HD; const bf16_t* Kc = (const bf16_t*)(ws + WS_RK) + ((size_t)bh * S + n * 128) * HD;
    const bf16_t* Vc = (const bf16_t*)(ws + WS_RV) + ((size_t)bh * S + n * 128) * HD; const bf16_t* Gc = (const bf16_t*)(ws + WS_RG) + ((size_t)bh * S + n * 128) * HD;
    const bf16_t* SF = (const bf16_t*)(ws + WS_ST) + (((size_t)0 * NB * NH + bh) * 32 + n) * 4096; const bf16_t* SB = (const bf16_t*)(ws + WS_ST) + (((size_t)1 * NB * NH + bh) * 32 + n) * 4096;
    const float lg0 = a.in[IN_DECAY][h] * LOG2E, lg1 = a.in[IN_DECAY][NH + h] * LOG2E;
    LAS unsigned char* slot = (LAS unsigned char*)lds + wave * MIX_WAVE_LDS; lds_cptr slot3 = (lds_cptr)slot; LAS unsigned char* kslot = slot + VSLOT;
    const int t = lane & 31, hi = lane >> 5, rr = lane >> 3, ch = lane & 7;
    bf16x8 qf[2][4];
#pragma unroll
    for (int j = 0; j < 2; ++j) { u32x4 raw[4]; ld_rows32(Qc + (size_t)(64 * hq + 32 * j) * HD, raw, lane); stage_rows_k(kslot, raw, lane); asm volatile("" ::: "memory"); read_row_frags(qf[j], kslot, lane); asm volatile("" ::: "memory"); }
    f32x16 o[2][2] = {};
#pragma unroll
    for (int dir = 0; dir < 2; ++dir) {
#pragma unroll
        for (int eb = 0; eb < 2; ++eb) { u32x4 raw[4]; bf16x8 sf[4]; ld_rows32((dir == 0 ? SF : SB) + (size_t)(32 * eb) * 64, raw, lane); stage_rows_k(kslot, raw, lane); asm volatile("" ::: "memory"); read_row_frags(sf, kslot, lane); asm volatile("" ::: "memory");
#pragma unroll
            for (int j = 0; j < 2; ++j)
#pragma unroll
                for (int st = 0; st < 4; ++st) o[j][eb] = MFMA32(sf[st], qf[j][st], o[j][eb]); }
#pragma unroll
        for (int j = 0; j < 2; ++j) { const int c = 64 * hq + 32 * j + t; const float f = dir == 0 ? ex2(lg0 * (float)(c + 1) - lg1 * (float)(128 - c)) : ex2(lg1 * (float)(128 - c));
#pragma unroll
            for (int rg = 0; rg < 16; ++rg) { o[j][0][rg] *= f; o[j][1][rg] *= f; } }
    }
    float f1[4], f2[4], b1[4], b2[4];
#pragma unroll
    for (int i = 0; i < 4; ++i) { f1[i] = __builtin_bit_cast(float, __builtin_amdgcn_readfirstlane(__builtin_bit_cast(int, ex2(-lg0 * (float)i)))); f2[i] = __builtin_bit_cast(float, __builtin_amdgcn_readfirstlane(__builtin_bit_cast(int, ex2(-lg0 * (float)(8 * i)))));
        b1[i] = __builtin_bit_cast(float, __builtin_amdgcn_readfirstlane(__builtin_bit_cast(int, ex2(lg1 * (float)i)))); b2[i] = __builtin_bit_cast(float, __builtin_amdgcn_readfirstlane(__builtin_bit_cast(int, ex2(lg1 * (float)(8 * i))))); }
#pragma nounroll
    for (int kb = 0; kb < 4; ++kb) {
        { u32x4 kraw[4], vv[4]; ld_rows32(Kc + (size_t)(32 * kb) * HD, kraw, lane); ld_rows32(Vc + (size_t)(32 * kb) * HD, vv, lane);
#pragma unroll
        for (int i = 0; i < 4; ++i) *(LAS u32x4*)(slot + (rr + 8 * i) * VROW + ch * 16) = vv[i];
        stage_rows_k(kslot, kraw, lane); }
        asm volatile("" ::: "memory");
        bf16x8 kf[4]; read_row_frags(kf, kslot, lane);
        const bf16x8 v00 = tr_frag(slot3, 0, 0, lane), v10 = tr_frag(slot3, 1, 0, lane), v01 = tr_frag(slot3, 0, 1, lane), v11 = tr_frag(slot3, 1, 1, lane);
        asm volatile("" ::: "memory");
#pragma unroll
        for (int j = 0; j < 2; ++j) {
            const int qbi = 2 * hq + j;
            f32x16 sc = {};
#pragma unroll
            for (int st = 0; st < 4; ++st) sc = MFMA32(kf[st], qf[j][st], sc);
            if (kb < qbi) { const float A = ex2(lg0 * (float)(32 * (qbi - kb) + t - 4 * hi)); float a2[4];
#pragma unroll
                for (int q = 0; q < 4; ++q) a2[q] = A * f2[q];
#pragma unroll
                for (int rg = 0; rg < 16; ++rg) sc[rg] *= a2[rg >> 2] * f1[rg & 3];
            } else if (kb > qbi) { const float A = ex2(lg1 * (float)(32 * (kb - qbi) - t + 4 * hi)); float a2[4];
#pragma unroll
                for (int q = 0; q < 4; ++q) a2[q] = A * b2[q];
#pragma unroll
                for (int rg = 0; rg < 16; ++rg) sc[rg] *= a2[rg >> 2] * b1[rg & 3];
            } else {
                int tt = t - 4 * hi; asm volatile("" : "+v"(tt));
#pragma unroll
                for (int rg = 0; rg < 16; ++rg) { const int df = tt - ((rg & 3) + 8 * (rg >> 2)); sc[rg] *= df >= 0 ? ex2(lg0 * (float)df) : ex2(lg1 * (float)(-df)); }
            }
            const bf16x8 p0 = pack_p(sc, 0), p1 = pack_p(sc, 1);
            o[j][0] = MFMA32(v00, p0, o[j][0]); o[j][0] = MFMA32(v10, p1, o[j][0]);
            o[j][1] = MFMA32(v01, p0, o[j][1]); o[j][1] = MFMA32(v11, p1, o[j][1]);
        }
    }
    const float* gn = a.in[IN_GN] + h * HD; const unsigned gnoff = (unsigned)(16 * hi); LAS unsigned char* kq = kslot + t * KROW + 8 * hi;
#pragma unroll
    for (int j = 0; j < 2; ++j) {
        const int r0 = n * 128 + 64 * hq + 32 * j;
        { u32x4 raw[4]; ld_rows32(Gc + (size_t)(64 * hq + 32 * j) * HD, raw, lane); stage_rows_k(kslot, raw, lane); asm volatile("" ::: "memory"); }
        float sm = 0.f;
#pragma unroll
        for (int rg = 0; rg < 16; ++rg) sm += o[j][0][rg] + o[j][1][rg];
        sm += __shfl_xor(sm, 32); const float mu = sm * (1.f / 64.f); float vq = 0.f;
#pragma unroll
        for (int rg = 0; rg < 16; ++rg) { const float d0 = o[j][0][rg] - mu, d1 = o[j][1][rg] - mu; vq += d0 * d0 + d1 * d1; }
        vq += __shfl_xor(vq, 32); const float rstd = rsqrtf(vq * (1.f / 64.f) + EPS);
        u32x2 ow[2][4];
#pragma unroll
        for (int db = 0; db < 2; ++db)
#pragma unroll
            for (int g4 = 0; g4 < 4; ++g4) { const u32x2 gw = *(const LAS u32x2*)(kq + (32 * db + 8 * g4) * 2); const float4 gg = *(const float4*)((const char*)gn + gnoff + (32 * db + 8 * g4) * 4);
                const float gate[4] = {bf2f(gw[0] & 0xffffu), bf2f(gw[0] >> 16), bf2f(gw[1] & 0xffffu), bf2f(gw[1] >> 16)}; const float gv[4] = {gg.x, gg.y, gg.z, gg.w}; float ov[4];
#pragma unroll
                for (int i = 0; i < 4; ++i) ov[i] = (o[j][db][4 * g4 + i] - mu) * rstd * gv[i] * (gate[i] * __builtin_amdgcn_rcpf(1.f + ex2(-gate[i] * LOG2E)));
                ow[db][g4] = (u32x2){pg8::cvt_pk_bf16(ov[0], ov[1]), pg8::cvt_pk_bf16(ov[2], ov[3])}; }
        asm volatile("" ::: "memory");
#pragma unroll
        for (int db = 0; db < 2; ++db)
#pragma unroll
            for (int g4 = 0; g4 < 4; ++g4) *(LAS u32x2*)(kq + (32 * db + 8 * g4) * 2) = ow[db][g4];
        asm volatile("" ::: "memory");
        { bf16_t* ob = (bf16_t*)(ws + WS_XN) + ((size_t)b * S + r0) * D + h * HD;
#pragma unroll
          for (int i = 0; i < 4; ++i) { const u32x4 w = *(const LAS u32x4*)(kslot + (rr + 8 * i) * KROW + ch * 16); *(u32x4*)(ob + (size_t)(rr + 8 * i) * D + ch * 8) = w; } }
        asm volatile("" ::: "memory");
    }
}
DEV void phase_attn_merge(const Args& a, int gtid, int NT) {
    unsigned char* ws = a.ws; const float* L = (const float*)(ws + WS_ATTL); const bf16_t* O = (const bf16_t*)(ws + WS_ATTO); bf16_t* mixed = (bf16_t*)(ws + WS_XN);
    for (int it = gtid; it < NB * NH * S * 8; it += NT) {
        const int ch = it & 7, row = it >> 3;
        const int bh = row >> 12, pos = row & 4095, b = bh >> 3, h = bh & 7;
        const float l0 = L[row], l1 = L[(size_t)NB * NH * S + row], l2 = L[(size_t)2 * NB * NH * S + row];
        const float mx = fmaxf(l0, fmaxf(l1, l2)); float w0 = ex2(l0 - mx), w1 = ex2(l1 - mx), w2 = ex2(l2 - mx); const float is = 1.f / (w0 + w1 + w2); w0 *= is; w1 *= is; w2 *= is;
        const uint4 a0 = *(const uint4*)(O + (size_t)row * HD + ch * 8), a1 = *(const uint4*)(O + ((size_t)NB * NH * S + row) * HD + ch * 8), a2 = *(const uint4*)(O + ((size_t)2 * NB * NH * S + row) * HD + ch * 8);
        const unsigned x0[4] = {a0.x, a0.y, a0.z, a0.w}, x1[4] = {a1.x, a1.y, a1.z, a1.w}, x2[4] = {a2.x, a2.y, a2.z, a2.w}; unsigned o[4];
#pragma unroll
        for (int j = 0; j < 4; ++j) o[j] = pg8::cvt_pk_bf16(w0 * bf2f(x0[j] & 0xffffu) + w1 * bf2f(x1[j] & 0xffffu) + w2 * bf2f(x2[j] & 0xffffu), w0 * bf2f(x0[j] >> 16) + w1 * bf2f(x1[j] >> 16) + w2 * bf2f(x2[j] >> 16));
        *(uint4*)(mixed + ((size_t)b * S + pos) * D + 512 + h * HD + ch * 8) = make_uint4(o[0], o[1], o[2], o[3]);
    }
}
DEV void phase_mix_a(const Args& a, unsigned char* lds, int wg, int G, int lane, int wave, int tid) {
    { const float* bt = (const float*)(a.ws + WS_BIAS); LAS float* bl = (LAS float*)((LAS unsigned char*)lds + MIX_BIAS_OFF);
      for (int i = tid; i < 3 * NH * 192; i += NTHR) { const int ph = i / 192, bi = i % 192 - 32; bl[i] = (bi >= 0 && bi <= 128) ? bt[ph * 129 + bi] : -1e30f; } }
    __syncthreads();
    const int x = wg & 7, wq = (wg >> 3) * NWAVES + wave, WPX = (G >> 3) * NWAVES;
    for (int rep = 0; rep < a.rep[0]; ++rep) { asm volatile("" : "+v"(lane)); for (int it = wq; it < 2 * 32 * NH; it += WPX) retstate_item(a, lds, it, x, lane, wave); }
    for (int rep = 0; rep < a.rep[1]; ++rep) { asm volatile("" : "+v"(lane)); attn_items(a, lds, wg, G, lane, wave); }
}
DEV void phase_mix_b(const Args& a, unsigned char* lds, int wg, int G, int lane, int wave, int tid) {
    const int x = wg & 7, wq = (wg >> 3) * NWAVES + wave, WPX = (G >> 3) * NWAVES;
    for (int rep = 0; rep < a.rep[2]; ++rep) { asm volatile("" : "+v"(lane)); for (int it = wq; it < NH * 32 * 2; it += WPX) retout_item(a, lds, it, x, lane, wave); }
    for (int rep = 0; rep < a.rep[3]; ++rep) { asm volatile("" : "+v"(tid)); phase_attn_merge(a, wg * NTHR + tid, G * NTHR); }
}
#define XB_TMO      128
#define XB_XCNT(j)  (256  + 64 * (j))
#define XB_XSUB(j)  (1280 + 64 * (j))
#define XB_XGEN(j)  (2304 + 64 * (j))
#define XB_TOP      3328
#define XB_TOPGEN   3392
#define XCD_BAR_WORDS 3456
#define XB_SPIN_CAP (1u << 18)

__device__ __forceinline__ unsigned xb_ld(unsigned* p)              { return __hip_atomic_load(p, __ATOMIC_RELAXED, __HIP_MEMORY_SCOPE_AGENT); }
__device__ __forceinline__ unsigned xb_add(unsigned* p, unsigned v) { return __hip_atomic_fetch_add(p, v, __ATOMIC_RELAXED, __HIP_MEMORY_SCOPE_AGENT); }
__device__ __forceinline__ unsigned xb_xcc_id() { return (unsigned)__builtin_amdgcn_s_getreg((3 << 11) | 20) & 0xFu; }
#define XB_SPIN(cond, bar) do { unsigned _sp = 0; while (cond) { __builtin_amdgcn_s_sleep(1); \
    if ((++_sp & 255u) == 0u) { if (xb_ld(&(bar)[XB_TMO])) break; if (_sp > XB_SPIN_CAP) { atomicAdd(&(bar)[XB_TMO], 1u); break; } } } } while (0)

struct XcdBarrier {
    unsigned* bar; unsigned x;
    volatile LAS unsigned* st;
};

__device__ __forceinline__ XcdBarrier xcd_barrier_post(unsigned* bar, volatile LAS unsigned* st) {
    XcdBarrier b; b.bar = bar; b.x = xb_xcc_id(); b.st = st;
    if (threadIdx.x == 0) (void)xb_add(&bar[XB_XCNT(b.x)], 1u);
    return b;
}
__device__ __forceinline__ void xcd_barrier_complete(unsigned* bar, unsigned x, unsigned& nloc, unsigned& nx) {
    const unsigned G = gridDim.x * gridDim.y * gridDim.z;
    unsigned sum, cnt, mine, sp = 0u;
    for (;;) {
        sum = 0u; cnt = 0u; mine = 0u;
#pragma unroll
        for (unsigned j = 0; j < 16; ++j) { const unsigned c = xb_ld(&bar[XB_XCNT(j)]); sum += c; cnt += (c > 0u) ? 1u : 0u; mine = (j == x) ? c : mine; }
        if (sum == G) break;
        __builtin_amdgcn_s_sleep(1);
        if ((++sp & 255u) == 0u) { if (xb_ld(&bar[XB_TMO])) break; if (sp > XB_SPIN_CAP) { atomicAdd(&bar[XB_TMO], 1u); break; } }
    }
    nloc = mine > 0u ? mine : 1u; nx = cnt > 0u ? cnt : 1u;
}

__device__ __forceinline__ void xcd_barrier(const XcdBarrier& b) {
    asm volatile("s_waitcnt vmcnt(0)" ::: "memory");
    __syncthreads();
    if (threadIdx.x == 0) {
        unsigned* bar = b.bar;
        __builtin_amdgcn_s_waitcnt(0);
        unsigned nloc = b.st[0], nx = b.st[1];
        if (nloc == 0u) { xcd_barrier_complete(bar, b.x, nloc, nx); b.st[0] = nloc; b.st[1] = nx; }
        const unsigned old = xb_add(&bar[XB_XSUB(b.x)], 1u);
        const unsigned gen = old / nloc;
        if (old + 1u == (gen + 1u) * nloc) {
            __builtin_amdgcn_fence(__ATOMIC_RELEASE, "agent");
            asm volatile("s_waitcnt vmcnt(0)" ::: "memory");
            const unsigned og = xb_add(&bar[XB_TOP], 1u);
            const unsigned tg = og / nx;
            if (og + 1u == (tg + 1u) * nx) xb_add(&bar[XB_TOPGEN], 1u);
            else XB_SPIN(xb_ld(&bar[XB_TOPGEN]) == tg, bar);
            __builtin_amdgcn_fence(__ATOMIC_ACQUIRE, "agent");
            xb_add(&bar[XB_XGEN(b.x)], 1u);
            asm volatile("s_waitcnt vmcnt(0)" ::: "memory");
        } else {
            XB_SPIN(xb_ld(&bar[XB_XGEN(b.x)]) == gen, bar);
            __builtin_amdgcn_fence(__ATOMIC_ACQUIRE, "agent");
            asm volatile("s_waitcnt vmcnt(0)" ::: "memory");
        }
    }
    __syncthreads();
}

#ifndef MK_LAUNCHES
#define MK_LAUNCHES 1
#endif
constexpr int NPH = 11;
typedef const __attribute__((address_space(4))) Args* kargs_t;
DEV Args load_args(kargs_t kp) { Args a;
#pragma unroll
    for (int i = 0; i < 13; ++i) a.in[i] = kp->in[i];
    a.out = kp->out; a.ws = kp->ws; a.ph_lo = kp->ph_lo; a.ph_hi = kp->ph_hi;
#pragma unroll
    for (int i = 0; i < 16; ++i) a.rep[i] = kp->rep[i];
    return a; }
#ifndef PROBE_REP
#define PROBE_REP 0
#endif
#define REP(k) if (((PROBE_REP) >> (k)) & 1) for (int _r = 0; _r < 2; ++_r, cg::this_grid().sync())
__global__ void __launch_bounds__(NTHR, 2) mega(Args a_) {
    kargs_t kp = (kargs_t)__builtin_amdgcn_kernarg_segment_ptr();
    extern __shared__ __attribute__((aligned(16))) unsigned char lds[];
    int tid = threadIdx.x, lane = tid & 63, wave = __builtin_amdgcn_readfirstlane(tid >> 6);
    const int G = gridDim.x, wg = blockIdx.x, NGW = G * NWAVES; int gw = wg * NWAVES + wave;
#define FRESH_IDS() do { tid = threadIdx.x; asm volatile("" : "+v"(tid)); lane = tid & 63; wave = __builtin_amdgcn_readfirstlane(tid >> 6); gw = wg * NWAVES + wave; } while (0)
    const int lo = kp->ph_lo, hi = kp->ph_hi;
    unsigned char* ws = kp->ws;
    volatile LAS unsigned* bst = (volatile LAS unsigned*)((LAS unsigned char*)lds + LDS_BYTES - 64);
    if (tid < 2) bst[tid] = 0u;
    __syncthreads();
    XcdBarrier bar = xcd_barrier_post((unsigned*)(ws + WS_CTL) + 4096, bst);
#define IN(k) (lo <= (k) && (k) < hi)
#define SEAM(k) do { if (IN(k) && IN((k) + 1)) { xcd_barrier(bar); } } while (0)
    if (IN(0)) { FRESH_IDS(); const Args a = load_args(kp); unsigned char* ws = a.ws; for (int r = 0; r < a.rep[6]; ++r) { FRESH_IDS(); phase_prep(a, lds, gw, NGW, lane, wave); } }
    SEAM(0);
    if (IN(1)) { FRESH_IDS(); const Args a = load_args(kp); unsigned char* ws = a.ws; pg8::Gemm g{(const bf16_t*)(ws + WS_XN), (const bf16_t*)(ws + WS_WIN), D}; SchedPlain Sc; Sc.init(M, PC, G, wg); Sc.rowbytes = D * 2;
        EpiInProj E{ws, (const float*)(ws + WS_ROPE)};
        for (int r = 0; r < a.rep[8]; ++r) { FRESH_IDS(); pg8::Gemm g2 = g; asm volatile("" : "+s"(g2.A), "+s"(g2.Bt)); pg8::gemm_phase<EpiInProj, SchedPlain, true>((LAS unsigned char*)lds, g2, Sc, E); } }
    SEAM(1);
    if (IN(2)) { FRESH_IDS(); const Args a = load_args(kp); unsigned char* ws = a.ws; phase_mix_a(a, lds, wg, G, lane, wave, tid); }
    SEAM(2);
    if (IN(3)) { FRESH_IDS(); const Args a = load_args(kp); unsigned char* ws = a.ws; for (int r = 0; r < a.rep[13]; ++r) { FRESH_IDS(); phase_scan(a, wg * NTHR + tid, G * NTHR); } }
    SEAM(3);
    if (IN(4)) { FRESH_IDS(); const Args a = load_args(kp); unsigned char* ws = a.ws; phase_mix_b(a, lds, wg, G, lane, wave, tid); }
    SEAM(4);
    { const Args a = load_args(kp); for (int r = 0; r < a.rep[14]; ++r) xcd_barrier(bar); for (int r = 0; r < a.rep[15]; ++r) cg::this_grid().sync(); }
    if (IN(5)) { FRESH_IDS(); const Args a = load_args(kp); unsigned char* ws = a.ws; pg8::Gemm g{(const bf16_t*)(ws + WS_XN), (const bf16_t*)(ws + WS_WOUT), D}; SchedPlain Sc; Sc.init(M, D, G, wg); Sc.rowbytes = D * 2;
        EpiOutProj E{a.in[IN_X], (bf16_t*)(ws + WS_X1)};
        for (int r = 0; r < a.rep[9]; ++r) { FRESH_IDS(); pg8::Gemm g2 = g; asm volatile("" : "+s"(g2.A), "+s"(g2.Bt)); pg8::gemm_phase<EpiOutProj, SchedPlain, true>((LAS unsigned char*)lds, g2, Sc, E); } }
    SEAM(5);
    if (IN(6)) { FRESH_IDS(); const Args a = load_args(kp); unsigned char* ws = a.ws; for (int r = 0; r < a.rep[4]; ++r) { FRESH_IDS(); phase_router(a, lds, gw, NGW, lane, tid); } for (int r = 0; r < a.rep[5]; ++r) { FRESH_IDS(); phase_latew(a, lds, gw, NGW, lane, wave); } }
    SEAM(6);
    if (IN(7)) { FRESH_IDS(); const Args a = load_args(kp); unsigned char* ws = a.ws; for (int r = 0; r < a.rep[7]; ++r) { FRESH_IDS(); phase_topk(a, lds, wg, G, tid, lane, wave); } }
    SEAM(7);
    if (IN(8)) { FRESH_IDS(); const Args a = load_args(kp); unsigned char* ws = a.ws; pg8::Gemm g{(const bf16_t*)(ws + WS_XN), (const bf16_t*)(ws + WS_WGU), D}; SchedMoe1 Sc; Sc.init(MR, 4096, G, wg); Sc.idxl = (const LAS int*)((LAS unsigned char*)lds + 131072);
        { const int* idxg = (const int*)(ws + WS_IDX); LAS int* il = (LAS int*)((LAS unsigned char*)lds + 131072); pg8::Unit uu;
          for (int i = 0; i < 16; ++i) if (Sc.next(i, uu) && tid < 256) il[i * 256 + tid] = idxg[uu.pm * 256 + tid];
          __syncthreads(); }
        EpiSwiGLU E{ws + WS_HID};
        for (int r = 0; r < a.rep[10]; ++r) { FRESH_IDS(); pg8::Gemm g2 = g; asm volatile("" : "+s"(g2.A), "+s"(g2.Bt)); pg8::gemm_phase<EpiSwiGLU, SchedMoe1, true, true>((LAS unsigned char*)lds, g2, Sc, E); } }
    SEAM(8);
    if (IN(9)) { FRESH_IDS(); const Args a = load_args(kp); unsigned char* ws = a.ws; pg8::Gemm g{(const bf16_t*)(ws + WS_HID), (const bf16_t*)(ws + WS_WD), DFF}; SchedMoe2 Sc; Sc.init(MR, D, G, wg);
        EpiDown E{(bf16_t*)(ws + WS_Y)};
        for (int r = 0; r < a.rep[11]; ++r) { FRESH_IDS(); pg8::Gemm g2 = g; asm volatile("" : "+s"(g2.A), "+s"(g2.Bt)); pg8::gemm_phase<EpiDown, SchedMoe2, true, true>((LAS unsigned char*)lds, g2, Sc, E); } }
    SEAM(9);
    if (IN(10)) { FRESH_IDS(); const Args a = load_args(kp); unsigned char* ws = a.ws; for (int r = 0; r < a.rep[12]; ++r) { FRESH_IDS(); phase_final(a, gw, NGW, lane); } }
#undef IN
#undef SEAM
}

extern "C" void kernel_launch(void* const* d_in, const int* in_sizes, int n_in, void* d_out, int out_size, void* d_ws, size_t ws_size, hipStream_t stream) {
    static int grid = 0;
    if (grid == 0) {
        if (n_in != 13 || in_sizes[0] != M * D || out_size != M * D || ws_size < WS_END) { fprintf(stderr, "kernel_launch: unexpected shapes n_in %d in0 %d out %d ws %zu (need %zu)\n", n_in, n_in > 0 ? in_sizes[0] : -1, out_size, ws_size, (size_t)WS_END); grid = -1; return; }
        int dev = 0, cus = 0, per_cu = 0;
        (void)hipGetDevice(&dev); (void)hipDeviceGetAttribute(&cus, hipDeviceAttributeMultiprocessorCount, dev);
        (void)hipFuncSetAttribute((const void*)mega, hipFuncAttributeMaxDynamicSharedMemorySize, LDS_BYTES);
        if (hipOccupancyMaxActiveBlocksPerMultiprocessor(&per_cu, (const void*)mega, NTHR, LDS_BYTES) != hipSuccess || per_cu < 1) { fprintf(stderr, "kernel_launch: occupancy query says %d blocks/CU\n", per_cu); per_cu = 1; }
        (void)hipGetLastError();
        grid = cus * 1;
        if (grid > cus * per_cu) grid = cus * per_cu;
    }
    if (grid < 0) return;
    (void)hipMemsetAsync((char*)d_ws + WS_CTL, 0, 1 * MiB, stream);
    Args a{};
    for (int i = 0; i < 13; ++i) a.in[i] = (const float*)d_in[i];
    a.out = (float*)d_out; a.ws = (unsigned char*)d_ws;
#ifndef PROBE_R
#define PROBE_R {1, 1, 1, 1, 1, 1, 1, 1, 1, 1, 1, 1, 1, 1, 0, 0}
#endif
    { const int rr[16] = PROBE_R; for (int i = 0; i < 16; ++i) a.rep[i] = rr[i]; }
#if MK_LAUNCHES == 1
    a.ph_lo = 0; a.ph_hi = NPH;
    void* args[] = {&a};
    hipError_t e = hipLaunchCooperativeKernel((const void*)mega, dim3(grid), dim3(NTHR), args, LDS_BYTES, stream);
    if (e != hipSuccess) fprintf(stderr, "cooperative launch failed: %s (grid %d)\n", hipGetErrorString(e), grid);
#else
    for (int p = 0; p < NPH; ++p) { a.ph_lo = p; a.ph_hi = p + 1; hipLaunchKernelGGL(mega, dim3(grid), dim3(NTHR), LDS_BYTES, stream, a); }
#endif
}
```

```cpp
#include <hip/hip_runtime.h>
#include <hip/hip_cooperative_groups.h>
#include <cstdint>
#include <cstdio>
namespace cg = cooperative_groups;

typedef unsigned short bf16_t;
#define DEV __device__ __forceinline__
#define LAS __attribute__((address_space(3)))

constexpr int NB = 8, S = 4096, D = 1024, M = NB * S;
constexpr int NH = 8, HD = 64, PC = 3584;
constexpr int NE = 16, CAP = 512, DFF = 2048, MR = NE * NB * CAP;
constexpr float EPS = 1e-6f, LOG2E = 1.4426950408889634f;
constexpr int NWAVES = 8, NTHR = 512;
constexpr int LDS_BYTES = 163840;

constexpr size_t MiB = 1u << 20;
constexpr size_t WS_CTL = 0;
constexpr size_t WS_ROPE = 1 * MiB;
constexpr size_t WS_BIAS = 2 * MiB;
constexpr size_t WS_IDX = 2 * MiB + 512 * 1024;
constexpr size_t WS_AFF = 3 * MiB;
constexpr size_t WS_INV = 5 * MiB;
constexpr size_t WS_AFFT = 9 * MiB;
constexpr size_t WS_WOUT = 7 * MiB;
constexpr size_t WS_WIN = 9 * MiB;
constexpr size_t WS_XN = 16 * MiB;
constexpr size_t WS_RQ = 80 * MiB, WS_RK = 112 * MiB, WS_RV = 144 * MiB, WS_RG = 176 * MiB;
constexpr size_t WS_AQ = 208 * MiB, WS_AK = 240 * MiB, WS_AV = 272 * MiB;
constexpr size_t WS_ATTO = 304 * MiB;
constexpr size_t WS_ATTL = 3 * MiB;
constexpr size_t WS_KF = 400 * MiB;
constexpr size_t WS_X1 = 80 * MiB;
constexpr size_t WS_ST = 208 * MiB;
constexpr size_t WS_WD = 432 * MiB;
constexpr size_t WS_WGU = 464 * MiB;
constexpr size_t WS_Y = 144 * MiB;
constexpr size_t WS_HID = 272 * MiB;
constexpr size_t WS_END = 528 * MiB;

DEV unsigned f2bf(float f) { unsigned u = __float_as_uint(f); return (u + 0x7fffu + ((u >> 16) & 1u)) >> 16; }
DEV float bf2f(unsigned h) { return __uint_as_float(h << 16); }
DEV unsigned pk2(float lo, float hi) { return f2bf(lo) | (f2bf(hi) << 16); }
DEV float wave_sum(float v) {
#pragma unroll
    for (int o = 1; o < 64; o <<= 1) v += __shfl_xor(v, o);
    return v;
}
#define LDS_WAIT() asm volatile("s_waitcnt lgkmcnt(0)" ::: "memory")
namespace pg8 {
#define PG8_LAS __attribute__((address_space(3)))
typedef short bf16x8 __attribute__((ext_vector_type(8)));
typedef float f32x4 __attribute__((ext_vector_type(4)));
typedef unsigned u32x4 __attribute__((ext_vector_type(4)));
constexpr int BM = 256, BK = 64, HALF = 128, HTB = HALF * BK * 2, STAGE_BYTES = 8 * HTB, NXCD = 8, WGM = 8;
__host__ __device__ __forceinline__ int lds_byte(int r, int c) { const int st = (r >> 4) * 2 + (c >> 5), rr = r & 15, cc = c & 31, ob = rr * 64 + cc * 2; return st * 1024 + (ob ^ (((ob >> 9) & 1) << 5)); }
__host__ __device__ __forceinline__ void stage_rc(int b, int& R, int& C) { const int st = b / 1024, sb = b % 1024, swz = sb ^ (((sb >> 9) & 1) << 5); R = (st >> 1) * 16 + swz / 64; C = (st & 1) * 32 + (swz % 64) / 2; }
__host__ __device__ __forceinline__ int perm32(int rho) { const int n = rho >> 4, i = rho & 15; return 8 * (i >> 2) + 4 * n + (i & 3); }
struct Unit { int pm, pn, ui; };
struct Gemm { const bf16_t* A; const bf16_t* Bt; int K; };
struct StaticOrder {
    int nM, nN, nwg, G, c, wgm;
    __device__ void init(int M_, int N_, int G_, int c_, int wgm_ = WGM) { nM = M_ / BM; nN = N_ / BM; nwg = nM * nN; G = G_; c = c_; wgm = wgm_; }
    __device__ bool next(int i, Unit& u) const {
        const long L = (long)i * G + c; if (L >= nwg) return false;
        int wgid = (int)L; { const int q = nwg / NXCD, r = nwg % NXCD, xcd = wgid % NXCD, off = wgid / NXCD; wgid = (xcd < r ? xcd * (q + 1) : r * (q + 1) + (xcd - r) * q) + off; }
        const int nig = wgm * nN, gid = wgid / nig, fm = gid * wgm, gsz = (nM - fm) < wgm ? (nM - fm) : wgm;
        u.pm = fm + ((wgid % nig) % gsz); u.pn = (wgid % nig) / gsz; return true;
    }
};
__device__ __forceinline__ unsigned cvt_pk_bf16(float lo, float hi) { unsigned r; asm volatile("v_cvt_pk_bf16_f32 %0, %1, %2" : "=v"(r) : "v"(lo), "v"(hi)); return r; }

typedef int v8i __attribute__((ext_vector_type(8)));
template <class Epi, class Sched, bool ALIGN_EPI, bool FP8 = false>
__device__ __forceinline__ void gemm_phase(PG8_LAS unsigned char* lds, const Gemm g, const Sched& S, const Epi& E) {
    const int tid = threadIdx.x, wid = __builtin_amdgcn_readfirstlane(tid >> 6), lane = tid & 63, wr = wid >> 2, wc = wid & 3, fr = lane & 15, fq = lane >> 4;
    const int K = g.K, RB = FP8 ? K : 2 * K, nt = RB / 128;
    unsigned voffB[2];
#pragma unroll
    for (int i = 0; i < 2; ++i) { int R, C; stage_rc(tid * 16 + i * 8192, R, C); const int Rb = Epi::PERM ? ((R & ~31) + perm32(R & 31)) : R;
        voffB[i] = (unsigned)(Rb * RB + C * 2); }
    const size_t kstep = (size_t)(BK * 2);
    const size_t hstep = (size_t)HALF * RB;
    const size_t tstep = 2 * hstep;
    const unsigned ldsw = (unsigned)wid * 1024u;
    const int aoff = FP8 ? lds_byte(wr * 64 + fr, fq * 16) : lds_byte(wr * 64 + fr, fq * 8), boff = FP8 ? lds_byte(wc * 32 + fr, fq * 16) : lds_byte(wc * 32 + fr, fq * 8);
    const int x16 = 16 * (fq & 1);
    const char* gA = (const char*)g.A;
#define PG8_SA(b, h) (((b) * 2 + (h)) * HTB)
#define PG8_SB(b, h) ((4 + (b) * 2 + (h)) * HTB)
#define PG8_STAGE(bufoff, gbase, voff) do { _Pragma("unroll") for (int _i = 0; _i < 2; ++_i) \
        __builtin_amdgcn_global_load_lds((const unsigned*)((const char*)(gbase) + (voff)[_i]), (PG8_LAS unsigned*)(lds + (bufoff) + ldsw + _i * 8192), 16, 0, 0); } while (0)
#define PG8_STAGE_A(bufoff, AO, h, kb) do { _Pragma("unroll") for (int _i = 0; _i < 2; ++_i) \
        __builtin_amdgcn_global_load_lds((const unsigned*)(gA + (size_t)((AO)[h][_i] + (unsigned)(kb))), (PG8_LAS unsigned*)(lds + (bufoff) + ldsw + _i * 8192), 16, 0, 0); } while (0)
#define PG8_LDA(dst, b, h) do { if constexpr (FP8) { _Pragma("unroll") for (int m = 0; m < 4; ++m) { dst[m][0] = *(const PG8_LAS bf16x8*)(lds + PG8_SA(b, h) + aoff + m * 2048 + x16); dst[m][1] = *(const PG8_LAS bf16x8*)(lds + PG8_SA(b, h) + aoff + m * 2048 + 16 - x16); } } \
    else { _Pragma("unroll") for (int m = 0; m < 4; ++m) _Pragma("unroll") for (int k = 0; k < 2; ++k) dst[m][k] = *(const PG8_LAS bf16x8*)(lds + PG8_SA(b, h) + aoff + m * 2048 + k * 1024); } } while (0)
#define PG8_LDB(dst, b, h) do { if constexpr (FP8) { _Pragma("unroll") for (int n = 0; n < 2; ++n) { dst[n][0] = *(const PG8_LAS bf16x8*)(lds + PG8_SB(b, h) + boff + n * 2048 + x16); dst[n][1] = *(const PG8_LAS bf16x8*)(lds + PG8_SB(b, h) + boff + n * 2048 + 16 - x16); } } \
    else { _Pragma("unroll") for (int n = 0; n < 2; ++n) _Pragma("unroll") for (int k = 0; k < 2; ++k) dst[n][k] = *(const PG8_LAS bf16x8*)(lds + PG8_SB(b, h) + boff + n * 2048 + k * 1024); } } while (0)
#define PG8_CAT8(x) __builtin_bit_cast(v8i, __builtin_shufflevector((x)[0], (x)[1], 0, 1, 2, 3, 4, 5, 6, 7, 8, 9, 10, 11, 12, 13, 14, 15))
#define PG8_MMA(ai, bj, At, Bt) do { __builtin_amdgcn_s_setprio(1); if constexpr (FP8) { _Pragma("unroll") for (int m = 0; m < 4; ++m) _Pragma("unroll") for (int n = 0; n < 2; ++n) \
        acc[ai][bj][m][n] = __builtin_amdgcn_mfma_scale_f32_16x16x128_f8f6f4(PG8_CAT8(Bt[n]), PG8_CAT8(At[m]), acc[ai][bj][m][n], 0, 0, 0, 0, 0, 0); } \
    else { _Pragma("unroll") for (int m = 0; m < 4; ++m) _Pragma("unroll") for (int n = 0; n < 2; ++n) _Pragma("unroll") for (int k = 0; k < 2; ++k) \
        acc[ai][bj][m][n] = __builtin_amdgcn_mfma_f32_16x16x32_bf16(Bt[n][k], At[m][k], acc[ai][bj][m][n], 0, 0, 0); } __builtin_amdgcn_s_setprio(0); } while (0)
#define PG8_WAIT_V(n) asm volatile("s_waitcnt vmcnt(" #n ")" ::: "memory")
#define PG8_WAIT_L(n) asm volatile("s_waitcnt lgkmcnt(" #n ")" ::: "memory")
#define PG8_BAR __builtin_amdgcn_s_barrier()
#define PG8_SCHED __builtin_amdgcn_sched_barrier(0)
#define PG8_AOFFS(AO, u) do { int _t = threadIdx.x; asm volatile("" : "+v"(_t)); _Pragma("unroll") for (int _i = 0; _i < 2; ++_i) { int _R, _C; stage_rc(_t * 16 + _i * 8192, _R, _C); \
        _Pragma("unroll") for (int _h = 0; _h < 2; ++_h) (AO)[_h][_i] = S.row_off(u, _h * HALF + _R) + (unsigned)(_C * 2); } } while (0)
    Unit cur, nxt; int ui = 0;
    if (!S.next(0, cur)) return;
    f32x4 acc[2][2][4][2];
#pragma unroll
    for (int a = 0; a < 2; ++a)
#pragma unroll
        for (int b = 0; b < 2; ++b)
#pragma unroll
            for (int m = 0; m < 4; ++m)
#pragma unroll
                for (int n = 0; n < 2; ++n) acc[a][b][m][n] = (f32x4){0.f, 0.f, 0.f, 0.f};
    bf16x8 At[4][2], B0[2][2], B1[2][2];
    unsigned aoc[2][2];
    PG8_AOFFS(aoc, cur);
    const char* cB = (const char*)g.Bt + (size_t)cur.pn * tstep;
    PG8_STAGE(PG8_SB(0, 0), cB, voffB); PG8_STAGE(PG8_SB(0, 1), cB + hstep, voffB); PG8_STAGE_A(PG8_SA(0, 0), aoc, 0, 0); PG8_STAGE_A(PG8_SA(0, 1), aoc, 1, 0);
    if (wr == 1) PG8_BAR;
    PG8_WAIT_V(2); PG8_BAR;
    PG8_STAGE(PG8_SB(1, 0), cB + kstep, voffB); PG8_STAGE_A(PG8_SA(1, 0), aoc, 0, 128); PG8_STAGE(PG8_SB(1, 1), cB + hstep + kstep, voffB);
    PG8_WAIT_V(6); PG8_BAR;
    for (;;) {
        const bool has_next = S.next(ui + 1, nxt);
        const char* nB = cB;
        if (has_next) nB = (const char*)g.Bt + (size_t)nxt.pn * tstep;
#pragma nounroll
        for (int t = 0; t < nt; t += 2) {
            const bool last = (t == nt - 2);
            const unsigned k1 = (unsigned)(t + 1) * 128u, k2 = last ? 0u : (unsigned)(t + 2) * 128u, k3 = k2 + 128u;
            const char* b2 = last ? nB : cB + (size_t)(t + 2) * kstep; const char* b3 = b2 + kstep;
            PG8_LDB(B0, 0, 0); PG8_LDB(B1, 0, 1); PG8_SCHED; PG8_LDA(At, 0, 0); PG8_STAGE_A(PG8_SA(1, 1), aoc, 1, k1);
            PG8_WAIT_V(8); PG8_WAIT_L(0); PG8_BAR; PG8_MMA(0, 0, At, B0); PG8_MMA(0, 1, At, B1); PG8_BAR; PG8_SCHED;
            if (last && has_next) { PG8_AOFFS(aoc, nxt); }
            PG8_LDA(At, 0, 1); PG8_STAGE(PG8_SB(0, 0), b2, voffB); PG8_STAGE(PG8_SB(0, 1), b2 + hstep, voffB); PG8_STAGE_A(PG8_SA(0, 0), aoc, 0, k2);
            PG8_WAIT_V(8); PG8_WAIT_L(0); PG8_BAR; PG8_MMA(1, 0, At, B0); PG8_MMA(1, 1, At, B1); PG8_BAR; PG8_SCHED;
            PG8_LDB(B0, 1, 0); PG8_LDB(B1, 1, 1); PG8_SCHED; PG8_LDA(At, 1, 0); PG8_STAGE_A(PG8_SA(0, 1), aoc, 1, k2);
            PG8_WAIT_V(8); PG8_WAIT_L(0); PG8_BAR; PG8_MMA(0, 0, At, B0); PG8_MMA(0, 1, At, B1); PG8_BAR; PG8_SCHED;
            PG8_LDA(At, 1, 1); PG8_STAGE(PG8_SB(1, 0), b3, voffB); PG8_STAGE(PG8_SB(1, 1), b3 + hstep, voffB); PG8_STAGE_A(PG8_SA(1, 0), aoc, 0, k3);
            PG8_WAIT_V(8); PG8_WAIT_L(0); PG8_BAR; PG8_MMA(1, 0, At, B0); PG8_MMA(1, 1, At, B1); PG8_BAR; PG8_SCHED;
        }
        if constexpr (ALIGN_EPI) { if (wr == 0) PG8_BAR; }
        { int t2 = threadIdx.x; asm volatile("" : "+v"(t2));
          const int w2 = __builtin_amdgcn_readfirstlane(t2 >> 6), l2 = t2 & 63; E(acc, cur, w2 >> 2, w2 & 3, l2 & 15, l2 >> 4); }
        if (!has_next) break;
#pragma unroll
        for (int a = 0; a < 2; ++a)
#pragma unroll
            for (int b = 0; b < 2; ++b)
#pragma unroll
                for (int m = 0; m < 4; ++m)
#pragma unroll
                    for (int n = 0; n < 2; ++n) acc[a][b][m][n] = (f32x4){0.f, 0.f, 0.f, 0.f};
        cur = nxt; cB = nB; ++ui;
        if constexpr (ALIGN_EPI) { if (wr == 1) PG8_BAR; }
    }
    PG8_WAIT_V(0);
    if constexpr (!ALIGN_EPI) { if (wr == 0) PG8_BAR; }
    PG8_BAR;
#undef PG8_SA
#undef PG8_SB
#undef PG8_STAGE
#undef PG8_STAGE_A
#undef PG8_LDA
#undef PG8_LDB
#undef PG8_MMA
#undef PG8_CAT8
#undef PG8_WAIT_V
#undef PG8_WAIT_L
#undef PG8_BAR
#undef PG8_SCHED
#undef PG8_AOFFS
}
}
struct SchedPlain : pg8::StaticOrder {
    unsigned rowbytes;
    DEV unsigned row_off(const pg8::Unit& u, int r) const { return (unsigned)(u.pm * 256 + r) * rowbytes; }
};
struct SchedMoe1 : pg8::StaticOrder {
    const LAS int* idxl;
    DEV bool next(int i, pg8::Unit& u) const { if (!pg8::StaticOrder::next(i, u)) return false; u.pn += (u.pm >> 4) * 16; u.ui = i; return true; }
    DEV unsigned row_off(const pg8::Unit& u, int r) const { const int g = u.pm * 256 + r; const int tok = ((g >> 9) & 7) * S + idxl[u.ui * 256 + r]; return (unsigned)tok * (unsigned)D; }
};
struct SchedMoe2 : pg8::StaticOrder {
    DEV bool next(int i, pg8::Unit& u) const { if (!pg8::StaticOrder::next(i, u)) return false; u.pn += (u.pm >> 4) * 4; return true; }
    DEV unsigned row_off(const pg8::Unit& u, int r) const { return (unsigned)(u.pm * 256 + r) * (unsigned)DFF; }
};
typedef pg8::f32x4 f32x4; typedef pg8::u32x4 u32x4;
struct EpiInProj {
    static constexpr bool PERM = true;
    unsigned char* ws; const float* ropeT;
    DEV void operator()(const f32x4 (&acc)[2][2][4][2], const pg8::Unit& u, int wr, int wc, int fr, int fq) const {
        const int grp = u.pn >> 1;
        bf16_t* gbase = (bf16_t*)(ws + WS_RQ + (size_t)grp * 32 * MiB);
        const int j0 = 32 * (wc & 1) + 8 * fq;
        if (grp < 2) {
            const float sc = grp == 1 ? 0.125f : 1.f;
            f32x4 cs[2][4], sn[2][4];
#pragma unroll
            for (int ai = 0; ai < 2; ++ai)
#pragma unroll
                for (int m = 0; m < 4; ++m) { const int s = (u.pm * 256 + ai * 128 + wr * 64 + m * 16 + fr) & 4095;
                    cs[ai][m] = *(const f32x4*)(ropeT + s * 32 + (j0 >> 1)); sn[ai][m] = *(const f32x4*)(ropeT + S * 32 + s * 32 + (j0 >> 1)); }
#pragma unroll
            for (int ai = 0; ai < 2; ++ai)
#pragma unroll
                for (int m = 0; m < 4; ++m) {
                    const int row = u.pm * 256 + ai * 128 + wr * 64 + m * 16 + fr, b = row >> 12, s = row & 4095;
#pragma unroll
                    for (int bj = 0; bj < 2; ++bj) {
                        const int hd = 4 * (u.pn & 1) + 2 * bj + (wc >> 1);
                        const f32x4 lo = (acc[ai][bj][m][0] * cs[ai][m] - acc[ai][bj][m][1] * sn[ai][m]) * sc, hi = (acc[ai][bj][m][1] * cs[ai][m] + acc[ai][bj][m][0] * sn[ai][m]) * sc;
                        u32x4 w; w.x = pg8::cvt_pk_bf16(lo[0], lo[1]); w.y = pg8::cvt_pk_bf16(lo[2], lo[3]); w.z = pg8::cvt_pk_bf16(hi[0], hi[1]); w.w = pg8::cvt_pk_bf16(hi[2], hi[3]);
                        *(u32x4*)(gbase + ((size_t)(b * NH + hd) * S + s) * HD + j0) = w;
                    }
                }
        } else {
            const float sc = grp == 4 ? 0.125f * LOG2E : 1.f;
#pragma unroll
            for (int ai = 0; ai < 2; ++ai)
#pragma unroll
                for (int m = 0; m < 4; ++m) {
                    const int row = u.pm * 256 + ai * 128 + wr * 64 + m * 16 + fr, b = row >> 12, s = row & 4095;
#pragma unroll
                    for (int bj = 0; bj < 2; ++bj) {
                        const int hd = 4 * (u.pn & 1) + 2 * bj + (wc >> 1);
                        const f32x4 lo = acc[ai][bj][m][0] * sc, hi = acc[ai][bj][m][1] * sc;
                        u32x4 w; w.x = pg8::cvt_pk_bf16(lo[0], lo[1]); w.y = pg8::cvt_pk_bf16(lo[2], lo[3]); w.z = pg8::cvt_pk_bf16(hi[0], hi[1]); w.w = pg8::cvt_pk_bf16(hi[2], hi[3]);
                        *(u32x4*)(gbase + ((size_t)(b * NH + hd) * S + s) * HD + j0) = w;
                    }
                }
        }
    }
};
struct EpiOutProj {
    static constexpr bool PERM = true;
    const float* x; bf16_t* x1;
    DEV void operator()(const f32x4 (&acc)[2][2][4][2], const pg8::Unit& u, int wr, int wc, int fr, int fq) const {
#pragma unroll
        for (int ai = 0; ai < 2; ++ai)
#pragma unroll
            for (int m = 0; m < 4; ++m) {
                const int row = u.pm * 256 + ai * 128 + wr * 64 + m * 16 + fr;
                f32x4 xa[2], xb[2];
#pragma unroll
                for (int bj = 0; bj < 2; ++bj) { const size_t off = (size_t)row * D + u.pn * 256 + bj * 128 + wc * 32 + 8 * fq; xa[bj] = *(const f32x4*)(x + off); xb[bj] = *(const f32x4*)(x + off + 4); }
#pragma unroll
                for (int bj = 0; bj < 2; ++bj) { const size_t off = (size_t)row * D + u.pn * 256 + bj * 128 + wc * 32 + 8 * fq;
                    const f32x4 lo = xa[bj] + acc[ai][bj][m][0], hi = xb[bj] + acc[ai][bj][m][1];
                    u32x4 w; w.x = pg8::cvt_pk_bf16(lo[0], lo[1]); w.y = pg8::cvt_pk_bf16(lo[2], lo[3]); w.z = pg8::cvt_pk_bf16(hi[0], hi[1]); w.w = pg8::cvt_pk_bf16(hi[2], hi[3]);
                    *(u32x4*)(x1 + off) = w; }
            }
    }
};
DEV unsigned pk4_fp8e(float a, float b, float c, float d) { unsigned w = 0u; w = __builtin_amdgcn_cvt_pk_fp8_f32(a, b, w, false); w = __builtin_amdgcn_cvt_pk_fp8_f32(c, d, w, true); return w; }
struct EpiSwiGLU {
    static constexpr bool PERM = true;
    unsigned char* hid;
    DEV void operator()(const f32x4 (&acc)[2][2][4][2], const pg8::Unit& u, int wr, int wc, int fr, int fq) const {
        const int pnl = u.pn & 15;
#pragma unroll
        for (int ai = 0; ai < 2; ++ai)
#pragma unroll
            for (int m = 0; m < 4; ++m) {
                const int row = u.pm * 256 + ai * 128 + wr * 64 + m * 16 + fr;
                float o[8];
#pragma unroll
                for (int n = 0; n < 2; ++n)
#pragma unroll
                    for (int i = 0; i < 4; ++i) { const float ga = acc[ai][0][m][n][i], ua = acc[ai][1][m][n][i];
                        o[4 * n + i] = (ga * ua) * ((1.f / 1024.f) * __builtin_amdgcn_rcpf(1.f + __builtin_amdgcn_exp2f(ga * (-LOG2E / 32.f)))); }
                *(uint2*)(hid + (size_t)row * DFF + pnl * 128 + wc * 32 + 8 * fq) = make_uint2(pk4_fp8e(o[0], o[1], o[2], o[3]), pk4_fp8e(o[4], o[5], o[6], o[7]));
            }
    }
};
struct EpiDown {
    static constexpr bool PERM = true;
    unsigned char* y;
    DEV void operator()(const f32x4 (&acc)[2][2][4][2], const pg8::Unit& u, int wr, int wc, int fr, int fq) const {
        const int pnl = u.pn & 3;
#pragma unroll
        for (int ai = 0; ai < 2; ++ai)
#pragma unroll
            for (int m = 0; m < 4; ++m) {
                const int row = u.pm * 256 + ai * 128 + wr * 64 + m * 16 + fr;
#pragma unroll
                for (int bj = 0; bj < 2; ++bj) { const f32x4 lo = acc[ai][bj][m][0] * (1.f / 32.f), hi = acc[ai][bj][m][1] * (1.f / 32.f);
                    *(uint2*)(y + (size_t)row * D + pnl * 256 + bj * 128 + wc * 32 + 8 * fq) = make_uint2(pk4_fp8e(lo[0], lo[1], lo[2], lo[3]), pk4_fp8e(hi[0], hi[1], hi[2], hi[3])); }
            }
    }
};
struct Args { const float* in[13]; float* out; unsigned char* ws; int ph_lo, ph_hi; int rep[16]; };
enum { IN_X = 0, IN_G1, IN_WIN, IN_DECAY, IN_GN, IN_RELB, IN_WOUT, IN_G2, IN_WR, IN_WG, IN_WU, IN_WDN, IN_FG };

struct TrItem { const float* src; bf16_t* dst; int K, N, k0, n0, mode, fp8; };
DEV unsigned pk4_fp8(float a, float b, float c, float d) { unsigned w = 0u; w = __builtin_amdgcn_cvt_pk_fp8_f32(a, b, w, false); w = __builtin_amdgcn_cvt_pk_fp8_f32(c, d, w, true); return w; }
DEV void tr_load(const TrItem& t, f32x4 (&v)[16], int lane) {
#pragma unroll
    for (int i = 0; i < 16; ++i) { const int kk = (lane >> 4) + 4 * i, c = (lane & 15) * 4; v[i] = *(const f32x4*)(t.src + (size_t)(t.k0 + kk) * t.N + t.n0 + c); }
}
DEV int rowmap_rt(int mode, int n) {
    if (mode == 0) return n;
    if (mode == 1) { if (n >= 1024) return n; const int base = n & ~63, d = n & 63, nn = d >> 5, dd = d & 31; return base + 8 * (dd >> 2) + 4 * nn + (dd & 3); }
    return (n >> 7) * 256 + (mode == 3 ? 128 : 0) + (n & 127);
}
DEV void tr_finish(const TrItem& t, const f32x4 (&v)[16], LAS float* scr, int lane) {
#pragma unroll
    for (int i = 0; i < 16; ++i) { const int kk = (lane >> 4) + 4 * i, c = (lane & 15) * 4;
        scr[kk * 65 + c] = v[i][0]; scr[kk * 65 + c + 1] = v[i][1]; scr[kk * 65 + c + 2] = v[i][2]; scr[kk * 65 + c + 3] = v[i][3]; }
    LDS_WAIT();
#pragma unroll
    for (int i = 0; i < 8; ++i) { const int n = (lane >> 3) + 8 * i, c = (lane & 7) * 8; const LAS float* sp = scr + c * 65 + n;
        if (t.fp8) {
            const unsigned lo = pk4_fp8(sp[0] * 32.f, sp[65] * 32.f, sp[2 * 65] * 32.f, sp[3 * 65] * 32.f), hi = pk4_fp8(sp[4 * 65] * 32.f, sp[5 * 65] * 32.f, sp[6 * 65] * 32.f, sp[7 * 65] * 32.f);
            *(uint2*)((unsigned char*)t.dst + (size_t)rowmap_rt(t.mode, t.n0 + n) * t.K + t.k0 + c) = make_uint2(lo, hi);
        } else {
        u32x4 o; o.x = pk2(sp[0], sp[65]); o.y = pk2(sp[2 * 65], sp[3 * 65]); o.z = pk2(sp[4 * 65], sp[5 * 65]); o.w = pk2(sp[6 * 65], sp[7 * 65]);
        *(u32x4*)(t.dst + (size_t)rowmap_rt(t.mode, t.n0 + n) * t.K + t.k0 + c) = o; } }
    LDS_WAIT();
}
template <class Dec> DEV void tr_run(const Dec& dec, int nitems, int gw, int NGW, LAS float* scr, int lane) {
    for (int it = gw; it < nitems; it += NGW) { TrItem cur; f32x4 va[16]; dec(it, cur); tr_load(cur, va, lane); tr_finish(cur, va, scr, lane); }
}
template <class Dec> DEV void tr_run2(const Dec& dec, int nitems, int gw, int NGW, LAS float* scr, int lane) {
    int it = gw; if (it >= nitems) return;
    TrItem cur, nxt; f32x4 va[16], vb[16];
    dec(it, cur); tr_load(cur, va, lane);
    for (;;) {
        const int n1 = it + NGW; const bool h1 = n1 < nitems;
        if (h1) { dec(n1, nxt); tr_load(nxt, vb, lane); }
        tr_finish(cur, va, scr, lane);
        if (!h1) break;
        const int n2 = n1 + NGW; const bool h2 = n2 < nitems;
        if (h2) { dec(n2, cur); tr_load(cur, va, lane); }
        tr_finish(nxt, vb, scr, lane);
        if (!h2) break;
        it = n2;
    }
}
DEV void rms_row_to_bf16(const float* xrow, const float* g, bf16_t* orow, int lane) {
    const float4* xr = (const float4*)xrow + lane;
    float4 v[4]; float s = 0.f;
#pragma unroll
    for (int j = 0; j < 4; ++j) { v[j] = xr[64 * j]; s += v[j].x * v[j].x + v[j].y * v[j].y + v[j].z * v[j].z + v[j].w * v[j].w; }
    const float rs = rsqrtf(wave_sum(s) * (1.f / D) + EPS);
    uint2* o = (uint2*)orow + lane;
#pragma unroll
    for (int j = 0; j < 4; ++j) { const float4 gg = ((const float4*)g)[lane + 64 * j];
        o[64 * j] = make_uint2(pk2(v[j].x * rs * gg.x, v[j].y * rs * gg.y), pk2(v[j].z * rs * gg.z, v[j].w * rs * gg.w)); }
}
DEV void phase_prep(const Args& a, unsigned char* lds, int gw, int NGW, int lane, int wave) {
    unsigned char* ws = a.ws;
    float* ropeT = (float*)(ws + WS_ROPE); float* biasT = (float*)(ws + WS_BIAS);
    for (int t = gw * 64 + lane; t < S * 32; t += NGW * 64) {
        const int pos = t >> 5, i = t & 31; const double inv = pow(10000.0, -(double)i / 32.0), ang = (double)pos * inv;
        ropeT[t] = (float)cos(ang); ropeT[S * 32 + t] = (float)sin(ang);
        if (t < 3 * NH * 129) { const int p = t / (NH * 129), h = (t / 129) % NH, o = t % 129 - 64, dil = p == 0 ? 1 : (p == 1 ? 4 : 16), rel = o * dil, n = rel < 0 ? -rel : rel;
            int bucket = rel > 0 ? 16 : 0;
            if (n < 8) bucket += n; else { int large = 8 + (int)(log((double)n / 8.0) / log(128.0) * 8.0); if (large > 15) large = 15; bucket += large; }
            biasT[t] = a.in[IN_RELB][bucket * NH + h] * LOG2E; }
    }
    LAS float* scr = (LAS float*)((LAS unsigned char*)lds + wave * 16640);
    constexpr int I_IN = (D / 64) * (PC / 64), I_OUT = (D / 64) * (D / 64);
    { const float* w_in = a.in[IN_WIN]; const float* w_out = a.in[IN_WOUT]; bf16_t* Win = (bf16_t*)(ws + WS_WIN); bf16_t* Wout = (bf16_t*)(ws + WS_WOUT);
      auto dec = [=](int it, TrItem& t) { if (it < I_IN) { t.src = w_in; t.dst = Win; t.K = D; t.N = PC; t.k0 = (it / (PC / 64)) * 64; t.n0 = (it % (PC / 64)) * 64; t.mode = 1; t.fp8 = 0; }
          else { const int r = it - I_IN; t.src = w_out; t.dst = Wout; t.K = D; t.N = D; t.k0 = (r / (D / 64)) * 64; t.n0 = (r % (D / 64)) * 64; t.mode = 0; t.fp8 = 0; } };
      tr_run(dec, I_IN + I_OUT, gw, NGW, scr, lane); }
    for (int m = gw; m < M; m += NGW) rms_row_to_bf16(a.in[IN_X] + (size_t)m * D, a.in[IN_G1], (bf16_t*)(ws + WS_XN) + (size_t)m * D, lane);
}
DEV void phase_latew(const Args& a, unsigned char* lds, int gw, int NGW, int lane, int wave) {
    unsigned char* ws = a.ws; LAS float* scr = (LAS float*)((LAS unsigned char*)lds + wave * 16640);
    constexpr int I_G = (D / 64) * (DFF / 64);
    const float* wg_ = a.in[IN_WG]; const float* wu_ = a.in[IN_WU]; const float* wd_ = a.in[IN_WDN]; bf16_t* Wgu = (bf16_t*)(ws + WS_WGU); bf16_t* Wd = (bf16_t*)(ws + WS_WD);
    auto dec = [=](int it, TrItem& t) { const int which = it / (NE * I_G), r = it % (NE * I_G), e = r / I_G, q = r % I_G;
        t.fp8 = 1;
        if (which < 2) { t.src = (which == 0 ? wg_ : wu_) + (size_t)e * D * DFF; t.dst = (bf16_t*)((unsigned char*)Wgu + (size_t)e * 4096 * D); t.K = D; t.N = DFF; t.k0 = (q / (DFF / 64)) * 64; t.n0 = (q % (DFF / 64)) * 64; t.mode = 2 + which; }
        else { t.src = wd_ + (size_t)e * DFF * D; t.dst = (bf16_t*)((unsigned char*)Wd + (size_t)e * D * DFF); t.K = DFF; t.N = D; t.k0 = (q / (D / 64)) * 64; t.n0 = (q % (D / 64)) * 64; t.mode = 0; } };
    tr_run2(dec, 3 * NE * I_G, gw, NGW, scr, lane);
}
DEV void phase_router(const Args& a, unsigned char* lds, int gw, int NGW, int lane, int tid) {
    unsigned char* ws = a.ws; const bf16_t* x1 = (const bf16_t*)(ws + WS_X1); const float* g2 = a.in[IN_G2]; const float* wr = a.in[IN_WR];
    bf16_t* H2b = (bf16_t*)(ws + WS_XN); float* aff = (float*)(ws + WS_AFF); float* affT = (float*)(ws + WS_AFFT); int* inv = (int*)(ws + WS_INV);
    LAS f32x4* wl = (LAS f32x4*)(LAS unsigned char*)lds;
    for (int i = tid; i < D * 4; i += NTHR) { const int k = i >> 2, c = i & 3, slot = (k & 3) * 256 + (k >> 2); wl[slot * 4 + ((c + (slot >> 2)) & 3)] = *(const f32x4*)(wr + (size_t)k * NE + 4 * c); }
    __syncthreads();
    uint2 xw[4], xn[4];
    { const uint2* xr = (const uint2*)(x1 + (size_t)gw * D) + lane;
#pragma unroll
      for (int j = 0; j < 4; ++j) xw[j] = xr[64 * j]; }
    for (int row = gw; row < M; row += NGW) {
        if (row + NGW < M) { const uint2* xr = (const uint2*)(x1 + (size_t)(row + NGW) * D) + lane;
#pragma unroll
            for (int j = 0; j < 4; ++j) xn[j] = xr[64 * j]; }
        float4 v[4]; float s = 0.f;
#pragma unroll
        for (int j = 0; j < 4; ++j) { v[j] = make_float4(bf2f(xw[j].x & 0xffffu), bf2f(xw[j].x >> 16), bf2f(xw[j].y & 0xffffu), bf2f(xw[j].y >> 16)); s += v[j].x * v[j].x + v[j].y * v[j].y + v[j].z * v[j].z + v[j].w * v[j].w; }
#pragma unroll
        for (int j = 0; j < 4; ++j) xw[j] = xn[j];
        const float rs = rsqrtf(wave_sum(s) * (1.f / D) + EPS);
        f32x4 lg[4];
#pragma unroll
        for (int c = 0; c < 4; ++c) lg[c] = (f32x4){0.f, 0.f, 0.f, 0.f};
        unsigned* o = (unsigned*)((unsigned char*)H2b + (size_t)row * D) + lane;
#pragma unroll
        for (int j = 0; j < 4; ++j) { const float4 gg = ((const float4*)g2)[lane + 64 * j];
            const float hv[4] = {v[j].x * rs * gg.x, v[j].y * rs * gg.y, v[j].z * rs * gg.z, v[j].w * rs * gg.w};
            o[64 * j] = pk4_fp8(hv[0], hv[1], hv[2], hv[3]);
#pragma unroll
            for (int t = 0; t < 4; ++t) { const int slot = t * 256 + lane + 64 * j, rot = (lane >> 2) & 3;
#pragma unroll
                for (int c = 0; c < 4; ++c) lg[c] += hv[t] * wl[slot * 4 + ((c + rot) & 3)];
                __builtin_amdgcn_sched_barrier(0); } }
        float r8[8], r4[4], r2[2], r1;
        { const bool up = lane & 32;
#pragma unroll
          for (int i = 0; i < 8; ++i) { const float mine = up ? lg[(i + 8) >> 2][(i + 8) & 3] : lg[i >> 2][i & 3], send = up ? lg[i >> 2][i & 3] : lg[(i + 8) >> 2][(i + 8) & 3]; r8[i] = mine + __shfl_xor(send, 32); } }
        { const bool up = lane & 16;
#pragma unroll
          for (int i = 0; i < 4; ++i) { const float mine = up ? r8[i + 4] : r8[i], send = up ? r8[i] : r8[i + 4]; r4[i] = mine + __shfl_xor(send, 16); } }
        { const bool up = lane & 8;
#pragma unroll
          for (int i = 0; i < 2; ++i) { const float mine = up ? r4[i + 2] : r4[i], send = up ? r4[i] : r4[i + 2]; r2[i] = mine + __shfl_xor(send, 8); } }
        { const bool up = lane & 4; const float mine = up ? r2[1] : r2[0], send = up ? r2[0] : r2[1]; r1 = mine + __shfl_xor(send, 4); }
        r1 += __shfl_xor(r1, 2); r1 += __shfl_xor(r1, 1);
        float mx = r1;
#pragma unroll
        for (int o = 4; o < 64; o <<= 1) mx = fmaxf(mx, __shfl_xor(mx, o));
        const float ex = __expf(r1 - mx); float sum = ex;
#pragma unroll
        for (int o = 4; o < 64; o <<= 1) sum += __shfl_xor(sum, o);
        const float av = ex / sum; const int e = lane >> 2;
        if ((lane & 3) == 0) { aff[(size_t)row * NE + e] = av; inv[(size_t)row * NE + e] = -1; affT[((size_t)(row >> 12) * NE + e) * S + (row & 4095)] = av; }
    }
    __syncthreads();
}
DEV void phase_topk(const Args& a, unsigned char* lds, int wg, int G, int tid, int lane, int wave) {
    unsigned char* ws = a.ws; const float* affT = (const float*)(ws + WS_AFFT); int* idx = (int*)(ws + WS_IDX); int* inv = (int*)(ws + WS_INV);
    LAS unsigned* hist = (LAS unsigned*)(LAS unsigned char*)lds; LAS unsigned* wsum = hist + 256; LAS unsigned* bc = hist + 272;
    for (int it = wg; it < NE * NB; it += G) {
        const int e = it & 15, b = it >> 4;
        unsigned u[8];
        { const uint4* src = (const uint4*)(affT + ((size_t)b * NE + e) * S + 8 * tid); const uint4 p = src[0], q = src[1]; u[0] = p.x; u[1] = p.y; u[2] = p.z; u[3] = p.w; u[4] = q.x; u[5] = q.y; u[6] = q.z; u[7] = q.w; }
        unsigned prefix = 0u, kk = CAP;
#pragma unroll
        for (int pass = 0; pass < 4; ++pass) {
            const int shift = 24 - 8 * pass;
            __syncthreads();
            if (tid < 256) hist[tid] = 0u;
            __syncthreads();
#pragma unroll
            for (int j = 0; j < 8; ++j) if (pass == 0 || (u[j] >> (shift + 8)) == prefix) atomicAdd((unsigned*)&hist[(u[j] >> shift) & 255u], 1u);
            __syncthreads();
            if (wave == 0) {
                const unsigned c0 = hist[4 * lane], c1 = hist[4 * lane + 1], c2 = hist[4 * lane + 2], c3 = hist[4 * lane + 3], tot = c0 + c1 + c2 + c3;
                unsigned incl = tot;
#pragma unroll
                for (int o = 1; o < 64; o <<= 1) { const unsigned t = __shfl_down(incl, o); if (lane + o < 64) incl += t; }
                const unsigned excl = incl - tot;
                if (excl < kk && kk <= incl) { unsigned acc = excl; int bin;
                    if (acc + c3 >= kk) bin = 3; else { acc += c3; if (acc + c2 >= kk) bin = 2; else { acc += c2; if (acc + c1 >= kk) bin = 1; else { acc += c1; bin = 0; } } }
                    bc[0] = 4 * lane + bin; bc[1] = kk - acc; }
            }
            __syncthreads();
            prefix = (prefix << 8) | bc[0]; kk = bc[1];
        }
        const unsigned T = prefix, need = kk;
        unsigned cg_ = 0u, ce = 0u;
#pragma unroll
        for (int j = 0; j < 8; ++j) { cg_ += u[j] > T; ce += u[j] == T; }
        unsigned pk = cg_ | (ce << 16), incl = pk;
#pragma unroll
        for (int o = 1; o < 64; o <<= 1) { const unsigned t = __shfl_up(incl, o); if (lane >= o) incl += t; }
        if (lane == 63) wsum[wave] = incl;
        __syncthreads();
        unsigned base = 0u;
#pragma unroll
        for (int w = 0; w < NWAVES; ++w) base += w < wave ? wsum[w] : 0u;
        const unsigned ex = base + incl - pk; unsigned gtb = ex & 0xffffu, eqb = ex >> 16;
#pragma unroll
        for (int j = 0; j < 8; ++j) { const bool g = u[j] > T, q = u[j] == T; const unsigned slot = gtb + (eqb < need ? eqb : need);
            if (g || (q && eqb < need)) { const int s = 8 * tid + j; idx[(e * NB + b) * CAP + slot] = s; inv[((size_t)b * S + s) * NE + e] = (int)slot; }
            gtb += g; eqb += q; }
    }
}
DEV void phase_final(const Args& a, int gw, int NGW, int lane) {
    unsigned char* ws = a.ws; float* xo = a.out; const bf16_t* x1 = (const bf16_t*)(ws + WS_X1); const float* aff = (const float*)(ws + WS_AFF); const int* inv = (const int*)(ws + WS_INV);
    const unsigned char* y = ws + WS_Y; const float* fg = a.in[IN_FG];
    uint2 xw[4], xn[4]; int iv = -1, ivn = -1; float av = 0.f, avn = 0.f;
    { const uint2* xr = (const uint2*)(x1 + (size_t)gw * D) + lane;
#pragma unroll
      for (int j = 0; j < 4; ++j) xw[j] = xr[64 * j];
      if (lane < NE) { iv = inv[(size_t)gw * NE + lane]; av = aff[(size_t)gw * NE + lane]; } }
    for (int row = gw; row < M; row += NGW) {
        const int b = row >> 12;
        if (row + NGW < M) { const uint2* xr = (const uint2*)(x1 + (size_t)(row + NGW) * D) + lane;
#pragma unroll
            for (int j = 0; j < 4; ++j) xn[j] = xr[64 * j];
            if (lane < NE) { ivn = inv[(size_t)(row + NGW) * NE + lane]; avn = aff[(size_t)(row + NGW) * NE + lane]; } }
        float4 v[4];
#pragma unroll
        for (int j = 0; j < 4; ++j) v[j] = make_float4(bf2f(xw[j].x & 0xffffu), bf2f(xw[j].x >> 16), bf2f(xw[j].y & 0xffffu), bf2f(xw[j].y >> 16));
        unsigned long long msk = __ballot(lane < NE && iv >= 0);
        while (msk) { const int e = __builtin_ctzll(msk); msk &= msk - 1;
            const int sl = __builtin_amdgcn_readlane(iv, e); const float g = __builtin_bit_cast(float, __builtin_amdgcn_readlane(__builtin_bit_cast(int, av), e));
            const unsigned* yr = (const unsigned*)(y + ((size_t)e * 4096 + b * CAP + sl) * D) + lane;
            unsigned w[4];
#pragma unroll
            for (int j = 0; j < 4; ++j) w[j] = yr[64 * j];
#pragma unroll
            for (int j = 0; j < 4; ++j) { const auto lo = __builtin_amdgcn_cvt_pk_f32_fp8((int)w[j], false), hi = __builtin_amdgcn_cvt_pk_f32_fp8((int)w[j], true);
                v[j].x += g * lo[0]; v[j].y += g * lo[1]; v[j].z += g * hi[0]; v[j].w += g * hi[1]; } }
        float s = 0.f;
#pragma unroll
        for (int j = 0; j < 4; ++j) s += v[j].x * v[j].x + v[j].y * v[j].y + v[j].z * v[j].z + v[j].w * v[j].w;
        const float rs = rsqrtf(wave_sum(s) * (1.f / D) + EPS);
        float4* orow = (float4*)(xo + (size_t)row * D) + lane;
#pragma unroll
        for (int j = 0; j < 4; ++j) { const float4 gg = ((const float4*)fg)[lane + 64 * j]; orow[64 * j] = make_float4(v[j].x * rs * gg.x, v[j].y * rs * gg.y, v[j].z * rs * gg.z, v[j].w * rs * gg.w); }
#pragma unroll
        for (int j = 0; j < 4; ++j) xw[j] = xn[j];
        iv = ivn; av = avn;
    }
}
typedef short bf16x8 __attribute__((ext_vector_type(8)));
typedef float f32x16 __attribute__((ext_vector_type(16)));
typedef short s16x4 __attribute__((ext_vector_type(4)));
typedef LAS const char* lds_cptr;
typedef unsigned u32x2 __attribute__((ext_vector_type(2)));
constexpr int VROW = 192;
constexpr int VSLOT = 32 * VROW;
constexpr int KROW = 144;
constexpr int KSLOT = 32 * KROW;
constexpr int MIX_WAVE_LDS = 16640;
constexpr int NWM = 6;
constexpr int MIX_BIAS_OFF = NWAVES * MIX_WAVE_LDS;
DEV int crow(int r, int hi) { return (r & 3) + 8 * (r >> 2) + 4 * hi; }
DEV s16x4 vtr(lds_cptr p) { return __builtin_bit_cast(s16x4, __builtin_amdgcn_ds_read_tr16_b64_v4i16((LAS s16x4*)p)); }
DEV bf16x8 tr_frag(lds_cptr slot, int s, int blk, int lane) {
    const int h = lane >> 5; lds_cptr p = slot + (16 * s + 4 * h + ((lane & 15) >> 2)) * VROW + (32 * blk + 16 * ((lane >> 4) & 1) + 4 * (lane & 3)) * 2;
    const s16x4 lo = vtr(p), hi = vtr(p + 8 * VROW);
    return (bf16x8){lo[0], lo[1], lo[2], lo[3], hi[0], hi[1], hi[2], hi[3]};
}
DEV void load_frags(bf16x8 (&f)[4], const bf16_t* rowp, int lane) {
    const int h = lane >> 5;
#pragma unroll
    for (int st = 0; st < 4; ++st) f[st] = *(const bf16x8*)(rowp + 16 * st + 8 * h);
}
DEV bf16x8 pack_p(const f32x16& p, int s) {
    u32x4 w; w.x = pg8::cvt_pk_bf16(p[8 * s], p[8 * s + 1]); w.y = pg8::cvt_pk_bf16(p[8 * s + 2], p[8 * s + 3]); w.z = pg8::cvt_pk_bf16(p[8 * s + 4], p[8 * s + 5]); w.w = pg8::cvt_pk_bf16(p[8 * s + 6], p[8 * s + 7]);
    return __builtin_bit_cast(bf16x8, w);
}

DEV void stage_rows_k(LAS unsigned char* ks, const u32x4 (&raw)[4], int lane) {
    const int rr = lane >> 3, ch = lane & 7;
#pragma unroll
    for (int i = 0; i < 4; ++i) *(LAS u32x4*)(ks + (rr + 8 * i) * KROW + ch * 16) = raw[i];
}
DEV void read_row_frags(bf16x8 (&f)[4], const LAS unsigned char* ks, int lane) {
    const LAS unsigned char* p = ks + (lane & 31) * KROW + (lane >> 5) * 16;
#pragma unroll
    for (int st = 0; st < 4; ++st) f[st] = *(const LAS bf16x8*)(p + st * 32);
}

DEV float other_half(float x) { const auto r = __builtin_amdgcn_permlane32_swap(__float_as_uint(x), __float_as_uint(x), false, false); return (threadIdx.x & 32) ? __uint_as_float(r[0]) : __uint_as_float(r[1]); }
DEV float max_halves(float x) { const auto r = __builtin_amdgcn_permlane32_swap(__float_as_uint(x), __float_as_uint(x), false, false); return fmaxf(__uint_as_float(r[0]), __uint_as_float(r[1])); }
DEV float sum_halves(float x) { const auto r = __builtin_amdgcn_permlane32_swap(__float_as_uint(x), __float_as_uint(x), false, false); return __uint_as_float(r[0]) + __uint_as_float(r[1]); }
#define MFMA32(a, b, c) __builtin_amdgcn_mfma_f32_32x32x16_bf16((a), (b), (c), 0, 0, 0)
DEV float ex2(float x) { return __builtin_amdgcn_exp2f(x); }

struct AttnIt { int p, bh, sh, L, r, q0, kmin, kmax; };
DEV void attn_decode(int li, int x, AttnIt& d) {
    d.p = li >> 9; d.bh = 8 * x + ((li >> 6) & 7); const int qblk = li & 63;
    d.sh = 2 * d.p; d.L = S >> d.sh; const int bpr = d.L >> 6;
    d.r = qblk / bpr; d.q0 = (qblk % bpr) * 64;
    d.kmin = d.q0 >= 64 ? 0 : 2; const int km = (d.L + 63 - d.q0) >> 5; d.kmax = km > 5 ? 5 : km;
}
DEV int med3i(int v, int lo, int hi) { return v < lo ? lo : (v > hi ? hi : v); }
DEV void attn_ldrows(const bf16_t* base, const AttnIt& d, int i0, u32x4 (&v)[4], int lane) {
    const int rr = lane >> 3, ch = lane & 7; const char* hb = (const char*)(base + (size_t)d.bh * S * HD); const unsigned cst = (unsigned)(d.r * 128 + ch * 16);
#pragma unroll
    for (int i = 0; i < 4; ++i) v[i] = *(const u32x4*)(hb + (((unsigned)med3i(i0 + rr + 8 * i, 0, d.L - 1) << (d.sh + 7)) + cst));
}
DEV void attn_ldkv(const Args& a, const AttnIt& d, int kk, u32x4 (&k)[4], u32x4 (&v)[4], int lane) {
    const int rr = lane >> 3, ch = lane & 7, i0 = d.q0 - 64 + 32 * kk; const unsigned cst = (unsigned)(d.r * 128 + ch * 16);
    const char* kb = (const char*)((const bf16_t*)(a.ws + WS_AK) + (size_t)d.bh * S * HD); const char* vb = (const char*)((const bf16_t*)(a.ws + WS_AV) + (size_t)d.bh * S * HD);
#pragma unroll
    for (int i = 0; i < 4; ++i) { const unsigned off = ((unsigned)med3i(i0 + rr + 8 * i, 0, d.L - 1) << (d.sh + 7)) + cst; k[i] = *(const u32x4*)(kb + off); v[i] = *(const u32x4*)(vb + off); }
}
DEV void attn_items(const Args& a, unsigned char* lds, int wg, int G, int lane, int wave) {
    unsigned char* ws = a.ws;
    constexpr int NIT = 3 * 512; constexpr float THR = 6.f;
    const int x = wg & 7, NGW = (G >> 3) * NWM;
    int item = (wg >> 3) * NWM + wave; if (item >= NIT) return;
    LAS unsigned char* slot = (LAS unsigned char*)lds + wave * MIX_WAVE_LDS; lds_cptr slot3 = (lds_cptr)slot; LAS unsigned char* kslot = slot + VSLOT;
    const int t = lane & 31, hi = lane >> 5, rr = lane >> 3, ch = lane & 7;
    AttnIt d; attn_decode(item, x, d);
    bf16x8 qf[2][4], kf[4]; u32x4 kraw[4], vv[4];
    attn_ldkv(a, d, d.kmin, kraw, vv, lane);
    for (;;) {
        const LAS float* tph = (const LAS float*)((LAS unsigned char*)lds + MIX_BIAS_OFF) + (d.p * NH + (d.bh & 7)) * 192 + (32 + 4 * hi - t);
        f32x16 o[2][2] = {}; float m[2] = {0.f, 0.f}, l[2] = {0.f, 0.f};
        const int nitem = item + NGW; const bool hasn = nitem < NIT;
        AttnIt dn = d; if (hasn) attn_decode(nitem, x, dn);
#pragma unroll
        for (int j = 0; j < 2; ++j) { u32x4 qraw[4]; attn_ldrows((const bf16_t*)(ws + WS_AQ), d, d.q0 + 32 * j, qraw, lane); stage_rows_k(kslot, qraw, lane); asm volatile("" ::: "memory"); read_row_frags(qf[j], kslot, lane); asm volatile("" ::: "memory"); }
        for (int kk = d.kmin; kk <= d.kmax; ++kk) {
            const int kbase = d.q0 - 64 + 32 * kk;
#pragma unroll
            for (int i = 0; i < 4; ++i) *(LAS u32x4*)(slot + (rr + 8 * i) * VROW + ch * 16) = vv[i];
            stage_rows_k(kslot, kraw, lane);
            asm volatile("" ::: "memory");
            read_row_frags(kf, kslot, lane);
            const bf16x8 v00 = tr_frag(slot3, 0, 0, lane), v10 = tr_frag(slot3, 1, 0, lane), v01 = tr_frag(slot3, 0, 1, lane), v11 = tr_frag(slot3, 1, 1, lane);
            asm volatile("" ::: "memory");
            if (kk < d.kmax) attn_ldkv(a, d, kk + 1, kraw, vv, lane);
            else if (hasn) attn_ldkv(a, dn, dn.kmin, kraw, vv, lane);
            const bool edge = kbase < 0 || kbase + 31 >= d.L;
#pragma unroll
            for (int j = 0; j < 2; ++j) {
                const int kj = kk - j; if (kj < 0 || kj > 4) continue;
                f32x16 sc = {};
#pragma unroll
                for (int st = 0; st < 4; ++st) sc = MFMA32(kf[st], qf[j][st], sc);
                const LAS float* tb = tph + 32 * kj;
#pragma unroll
                for (int rg = 0; rg < 16; ++rg) sc[rg] = (sc[rg] - m[j]) + tb[(rg & 3) + 8 * (rg >> 2)];
                if (edge) {
#pragma unroll
                    for (int rg = 0; rg < 16; ++rg) { const int ki = kbase + crow(rg, hi); sc[rg] = (ki >= 0 && ki < d.L) ? sc[rg] : -1e30f; } }
                float mx = fmaxf(fmaxf(sc[0], sc[1]), fmaxf(sc[2], sc[3]));
#pragma unroll
                for (int rg = 4; rg < 16; rg += 4) mx = fmaxf(mx, fmaxf(fmaxf(sc[rg], sc[rg + 1]), fmaxf(sc[rg + 2], sc[rg + 3])));
                mx = max_halves(mx);
                const bool first = kj == 0 || kk == d.kmin;
                if (first || __any(mx > THR)) {
                    const float dl = first ? mx : fmaxf(mx, 0.f), f = ex2(-dl); m[j] += dl; l[j] *= f;
#pragma unroll
                    for (int rg = 0; rg < 16; ++rg) { sc[rg] -= dl; o[j][0][rg] *= f; o[j][1][rg] *= f; }
                }
                float ps0 = 0.f, ps1 = 0.f;
#pragma unroll
                for (int rg = 0; rg < 16; rg += 2) { sc[rg] = ex2(sc[rg]); sc[rg + 1] = ex2(sc[rg + 1]); ps0 += sc[rg]; ps1 += sc[rg + 1]; }
                l[j] += ps0 + ps1;
                const bf16x8 p0 = pack_p(sc, 0), p1 = pack_p(sc, 1);
                o[j][0] = MFMA32(v00, p0, o[j][0]); o[j][0] = MFMA32(v10, p1, o[j][0]);
                o[j][1] = MFMA32(v01, p0, o[j][1]); o[j][1] = MFMA32(v11, p1, o[j][1]);
            }
        }
#pragma unroll
        for (int j = 0; j < 2; ++j) {
            float lt = sum_halves(l[j]);
            const float il = 1.f / lt;
            const size_t orow = ((size_t)d.p * NB * NH + d.bh) * S + (size_t)(((d.q0 + 32 * j + t) << d.sh) + d.r);
#pragma unroll
            for (int g4 = 0; g4 < 4; ++g4) {
                *(LAS u32x2*)(kslot + t * KROW + (8 * g4 + 4 * hi) * 2) = (u32x2){pg8::cvt_pk_bf16(o[j][0][4 * g4] * il, o[j][0][4 * g4 + 1] * il), pg8::cvt_pk_bf16(o[j][0][4 * g4 + 2] * il, o[j][0][4 * g4 + 3] * il)};
                *(LAS u32x2*)(kslot + t * KROW + (32 + 8 * g4 + 4 * hi) * 2) = (u32x2){pg8::cvt_pk_bf16(o[j][1][4 * g4] * il, o[j][1][4 * g4 + 1] * il), pg8::cvt_pk_bf16(o[j][1][4 * g4 + 2] * il, o[j][1][4 * g4 + 3] * il)};
            }
            asm volatile("" ::: "memory");
            { bf16_t* ob = (bf16_t*)(ws + WS_ATTO) + ((size_t)d.p * NB * NH + d.bh) * S * HD;
#pragma unroll
              for (int i = 0; i < 4; ++i) { const u32x4 w = *(const LAS u32x4*)(kslot + (rr + 8 * i) * KROW + ch * 16);
                  *(u32x4*)(ob + (size_t)(((d.q0 + 32 * j + rr + 8 * i) << d.sh) + d.r) * HD + ch * 8) = w; } }
            asm volatile("" ::: "memory");
            if (hi == 0) ((float*)(ws + WS_ATTL))[orow] = m[j] + __log2f(lt);
        }
        if (!hasn) break;
        item = nitem; d = dn;
    }
}
DEV void retstate_item(const Args& a, unsigned char* lds, int item, int xg, int lane, int wave) {
    unsigned char* ws = a.ws;
    const int dir = item & 1, n = (item >> 1) & 31, bh = 8 * xg + (item >> 6), h = bh & 7;
    const bf16_t* Kc = (const bf16_t*)(ws + WS_RK) + ((size_t)bh * S + n * 128) * HD; const bf16_t* Vc = (const bf16_t*)(ws + WS_RV) + ((size_t)bh * S + n * 128) * HD;
    const float lg = a.in[IN_DECAY][dir * NH + h] * LOG2E;
    LAS unsigned char* vs = (LAS unsigned char*)lds + wave * MIX_WAVE_LDS; LAS unsigned char* ks = vs + VSLOT; lds_cptr vs3 = (lds_cptr)vs, ks3 = (lds_cptr)ks;
    f32x16 acc[2][2] = {};
    for (int blk = 0; blk < 4; ++blk) {
        { const int rr = lane >> 3, ch = lane & 7;
          u32x4 v[4], k[4];
#pragma unroll
          for (int i = 0; i < 4; ++i) { const int mrow = 32 * blk + rr + 8 * i; v[i] = *(const u32x4*)(Vc + (size_t)mrow * HD + ch * 8); k[i] = *(const u32x4*)(Kc + (size_t)mrow * HD + ch * 8); }
#pragma unroll
          for (int i = 0; i < 4; ++i) { const int mrow = 32 * blk + rr + 8 * i; const float z = ex2(lg * (float)(dir == 0 ? 127 - mrow : mrow));
              const unsigned kw[4] = {k[i].x, k[i].y, k[i].z, k[i].w}; u32x4 o;
              o.x = pg8::cvt_pk_bf16(bf2f(kw[0] & 0xffffu) * z, bf2f(kw[0] >> 16) * z); o.y = pg8::cvt_pk_bf16(bf2f(kw[1] & 0xffffu) * z, bf2f(kw[1] >> 16) * z);
              o.z = pg8::cvt_pk_bf16(bf2f(kw[2] & 0xffffu) * z, bf2f(kw[2] >> 16) * z); o.w = pg8::cvt_pk_bf16(bf2f(kw[3] & 0xffffu) * z, bf2f(kw[3] >> 16) * z);
              *(LAS u32x4*)(vs + (rr + 8 * i) * VROW + ch * 16) = v[i]; *(LAS u32x4*)(ks + (rr + 8 * i) * VROW + ch * 16) = o; } }
        LDS_WAIT();
#pragma unroll
        for (int s = 0; s < 2; ++s) {
            const bf16x8 v0 = tr_frag(vs3, s, 0, lane), v1 = tr_frag(vs3, s, 1, lane), k0 = tr_frag(ks3, s, 0, lane), k1 = tr_frag(ks3, s, 1, lane);
            acc[0][0] = MFMA32(v0, k0, acc[0][0]); acc[0][1] = MFMA32(v0, k1, acc[0][1]); acc[1][0] = MFMA32(v1, k0, acc[1][0]); acc[1][1] = MFMA32(v1, k1, acc[1][1]);
        }
        LDS_WAIT();
    }
    bf16_t* KT = (bf16_t*)(ws + WS_KF) + (((size_t)dir * NB * NH + bh) * 32 + n) * 4096;
    const int c = lane & 31, hi = lane >> 5;
#pragma unroll
    for (int eb = 0; eb < 2; ++eb)
#pragma unroll
        for (int db = 0; db < 2; ++db)
#pragma unroll
            for (int rg = 0; rg < 16; ++rg) KT[(32 * eb + crow(rg, hi)) * 64 + 32 * db + c] = (bf16_t)f2bf(acc[eb][db][rg]);
}
DEV void phase_scan(const Args& a, int gtid, int NT) {
    unsigned char* ws = a.ws;
    for (int sl = gtid; sl < 2 * NB * NH * 1024; sl += NT) {
        const int dir = sl >> 16, bh = (sl >> 10) & 63, q = sl & 1023, h = bh & 7;
        const float gC = ex2(a.in[IN_DECAY][dir * NH + h] * LOG2E * 128.f);
        const uint2* kt = (const uint2*)(ws + WS_KF) + ((size_t)dir * NB * NH + bh) * 32 * 1024 + q;
        uint2* st = (uint2*)(ws + WS_ST) + ((size_t)dir * NB * NH + bh) * 32 * 1024 + q;
        float4 s = make_float4(0.f, 0.f, 0.f, 0.f);
        for (int i = 0; i < 32; ++i) { const int n = dir == 0 ? i : 31 - i;
            st[(size_t)n * 1024] = make_uint2(pg8::cvt_pk_bf16(s.x, s.y), pg8::cvt_pk_bf16(s.z, s.w));
            const uint2 kv = kt[(size_t)n * 1024];
            s.x = gC * s.x + bf2f(kv.x & 0xffffu); s.y = gC * s.y + bf2f(kv.x >> 16); s.z = gC * s.z + bf2f(kv.y & 0xffffu); s.w = gC * s.w + bf2f(kv.y >> 16); }
    }
}
DEV void ld_rows32(const bf16_t* base, u32x4 (&v)[4], int lane) {
    const char* b = (const char*)base; const unsigned off = (unsigned)((lane >> 3) * 128 + (lane & 7) * 16);
#pragma unroll
    for (int i = 0; i < 4; ++i) v[i] = *(const u32x4*)(b + off + i * 1024);
}
DEV void retout_item(const Args& a, unsigned char* lds, int item, int xg, int lane, int wave) {
    unsigned char* ws = a.ws;
    const int hq = item & 1, n = (item >> 1) & 31, bh = 8 * xg + (item >> 6), h = bh & 7, b = bh >> 3;
    const bf16_t* Qc = (const bf16_t*)(ws + WS_RQ) + ((size_t)bh * S + n * 128) * HD; const bf16_t* Kc = (const bf16_t*)(ws + WS_RK) + ((size_t)bh * S + n * 128) * HD;
    const bf16_t* Vc = (const bf16_t*)(ws + WS_RV) + ((size_t)bh * S + n * 128) * HD; const bf16_t* Gc = (const bf16_t*)(ws + WS_RG) + ((size_t)bh * S + n * 128) * HD;
    const bf16_t* SF = (const bf16_t*)(ws + WS_ST) + (((size_t)0 * NB * NH + bh) * 32 + n) * 4096; const bf16_t* SB = (const bf16_t*)(ws + WS_ST) + (((size_t)1 * NB * NH + bh) * 32 + n) * 4096;
    const float lg0 = a.in[IN_DECAY][h] * LOG2E, lg1 = a.in[IN_DECAY][NH + h] * LOG2E;
    LAS unsigned char* slot = (LAS unsigned char*)lds + wave * MIX_WAVE_LDS; lds_cptr slot3 = (lds_cptr)slot; LAS unsigned char* kslot = slot + VSLOT;
    const int t = lane & 31, hi = lane >> 5, rr = lane >> 3, ch = lane & 7;
    bf16x8 qf[2][4];
#pragma unroll
    for (int j = 0; j < 2; ++j) { u32x4 raw[4]; ld_rows32(Qc + (size_t)(64 * hq + 32 * j) * HD, raw, lane); stage_rows_k(kslot, raw, lane); asm volatile("" ::: "memory"); read_row_frags(qf[j], kslot, lane); asm volatile("" ::: "memory"); }
    f32x16 o[2][2] = {};
#pragma unroll
    for (int dir = 0; dir < 2; ++dir) {
#pragma unroll
        for (int eb = 0; eb < 2; ++eb) { u32x4 raw[4]; bf16x8 sf[4]; ld_rows32((dir == 0 ? SF : SB) + (size_t)(32 * eb) * 64, raw, lane); stage_rows_k(kslot, raw, lane); asm volatile("" ::: "memory"); read_row_frags(sf, kslot, lane); asm volatile("" ::: "memory");
#pragma unroll
            for (int j = 0; j < 2; ++j)
#pragma unroll
                for (int st = 0; st < 4; ++st) o[j][eb] = MFMA32(sf[st], qf[j][st], o[j][eb]); }
#pragma unroll
        for (int j = 0; j < 2; ++j) { const int c = 64 * hq + 32 * j + t; const float f = dir == 0 ? ex2(lg0 * (float)(c + 1) - lg1 * (float)(128 - c)) : ex2(lg1 * (float)(128 - c));
#pragma unroll
            for (int rg = 0; rg < 16; ++rg) { o[j][0][rg] *= f; o[j][1][rg] *= f; } }
    }
    float f1[4], f2[4], b1[4], b2[4];
#pragma unroll
    for (int i = 0; i < 4; ++i) { f1[i] = __builtin_bit_cast(float, __builtin_amdgcn_readfirstlane(__builtin_bit_cast(int, ex2(-lg0 * (float)i)))); f2[i] = __builtin_bit_cast(float, __builtin_amdgcn_readfirstlane(__builtin_bit_cast(int, ex2(-lg0 * (float)(8 * i)))));
        b1[i] = __builtin_bit_cast(float, __builtin_amdgcn_readfirstlane(__builtin_bit_cast(int, ex2(lg1 * (float)i)))); b2[i] = __builtin_bit_cast(float, __builtin_amdgcn_readfirstlane(__builtin_bit_cast(int, ex2(lg1 * (float)(8 * i))))); }
#pragma nounroll
    for (int kb = 0; kb < 4; ++kb) {
        { u32x4 kraw[4], vv[4]; ld_rows32(Kc + (size_t)(32 * kb) * HD, kraw, lane); ld_rows32(Vc + (size_t)(32 * kb) * HD, vv, lane);
#pragma unroll
        for (int i = 0; i < 4; ++i) *(LAS u32x4*)(slot + (rr + 8 * i) * VROW + ch * 16) = vv[i];
        stage_rows_k(kslot, kraw, lane); }
        asm volatile("" ::: "memory");
        bf16x8 kf[4]; read_row_frags(kf, kslot, lane);
        const bf16x8 v00 = tr_frag(slot3, 0, 0, lane), v10 = tr_frag(slot3, 1, 0, lane), v01 = tr_frag(slot3, 0, 1, lane), v11 = tr_frag(slot3, 1, 1, lane);
        asm volatile("" ::: "memory");
#pragma unroll
        for (int j = 0; j < 2; ++j) {
            const int qbi = 2 * hq + j;
            f32x16 sc = {};
#pragma unroll
            for (int st = 0; st < 4; ++st) sc = MFMA32(kf[st], qf[j][st], sc);
            if (kb < qbi) { const float A = ex2(lg0 * (float)(32 * (qbi - kb) + t - 4 * hi)); float a2[4];
#pragma unroll
                for (int q = 0; q < 4; ++q) a2[q] = A * f2[q];
#pragma unroll
                for (int rg = 0; rg < 16; ++rg) sc[rg] *= a2[rg >> 2] * f1[rg & 3];
            } else if (kb > qbi) { const float A = ex2(lg1 * (float)(32 * (kb - qbi) - t + 4 * hi)); float a2[4];
#pragma unroll
                for (int q = 0; q < 4; ++q) a2[q] = A * b2[q];
#pragma unroll
                for (int rg = 0; rg < 16; ++rg) sc[rg] *= a2[rg >> 2] * b1[rg & 3];
            } else {
                int tt = t - 4 * hi; asm volatile("" : "+v"(tt));
#pragma unroll
                for (int rg = 0; rg < 16; ++rg) { const int df = tt - ((rg & 3) + 8 * (rg >> 2)); sc[rg] *= df >= 0 ? ex2(lg0 * (float)df) : ex2(lg1 * (float)(-df)); }
            }
            const bf16x8 p0 = pack_p(sc, 0), p1 = pack_p(sc, 1);
            o[j][0] = MFMA32(v00, p0, o[j][0]); o[j][0] = MFMA32(v10, p1, o[j][0]);
            o[j][1] = MFMA32(v01, p0, o[j][1]); o[j][1] = MFMA32(v11, p1, o[j][1]);
        }
    }
    const float* gn = a.in[IN_GN] + h * HD; const unsigned gnoff = (unsigned)(16 * hi); LAS unsigned char* kq = kslot + t * KROW + 8 * hi;
#pragma unroll
    for (int j = 0; j < 2; ++j) {
        const int r0 = n * 128 + 64 * hq + 32 * j;
        { u32x4 raw[4]; ld_rows32(Gc + (size_t)(64 * hq + 32 * j) * HD, raw, lane); stage_rows_k(kslot, raw, lane); asm volatile("" ::: "memory"); }
        float sm = 0.f;
#pragma unroll
        for (int rg = 0; rg < 16; ++rg) sm += o[j][0][rg] + o[j][1][rg];
        sm = sum_halves(sm); const float mu = sm * (1.f / 64.f); float vq = 0.f;
#pragma unroll
        for (int rg = 0; rg < 16; ++rg) { const float d0 = o[j][0][rg] - mu, d1 = o[j][1][rg] - mu; vq += d0 * d0 + d1 * d1; }
        vq = sum_halves(vq); const float rstd = rsqrtf(vq * (1.f / 64.f) + EPS);
        u32x2 ow[2][4];
#pragma unroll
        for (int db = 0; db < 2; ++db)
#pragma unroll
            for (int g4 = 0; g4 < 4; ++g4) { const u32x2 gw = *(const LAS u32x2*)(kq + (32 * db + 8 * g4) * 2); const float4 gg = *(const float4*)((const char*)gn + gnoff + (32 * db + 8 * g4) * 4);
                const float gate[4] = {bf2f(gw[0] & 0xffffu), bf2f(gw[0] >> 16), bf2f(gw[1] & 0xffffu), bf2f(gw[1] >> 16)}; const float gv[4] = {gg.x, gg.y, gg.z, gg.w}; float ov[4];
#pragma unroll
                for (int i = 0; i < 4; ++i) ov[i] = (o[j][db][4 * g4 + i] - mu) * rstd * gv[i] * (gate[i] * __builtin_amdgcn_rcpf(1.f + ex2(-gate[i] * LOG2E)));
                ow[db][g4] = (u32x2){pg8::cvt_pk_bf16(ov[0], ov[1]), pg8::cvt_pk_bf16(ov[2], ov[3])}; }
        asm volatile("" ::: "memory");
#pragma unroll
        for (int db = 0; db < 2; ++db)
#pragma unroll
            for (int g4 = 0; g4 < 4; ++g4) *(LAS u32x2*)(kq + (32 * db + 8 * g4) * 2) = ow[db][g4];
        asm volatile("" ::: "memory");
        { bf16_t* ob = (bf16_t*)(ws + WS_XN) + ((size_t)b * S + r0) * D + h * HD;
#pragma unroll
          for (int i = 0; i < 4; ++i) { const u32x4 w = *(const LAS u32x4*)(kslot + (rr + 8 * i) * KROW + ch * 16); *(u32x4*)(ob + (size_t)(rr + 8 * i) * D + ch * 8) = w; } }
        asm volatile("" ::: "memory");
    }
}
DEV void phase_attn_merge(const Args& a, int gtid, int NT) {
    unsigned char* ws = a.ws; const float* L = (const float*)(ws + WS_ATTL); const bf16_t* O = (const bf16_t*)(ws + WS_ATTO); bf16_t* mixed = (bf16_t*)(ws + WS_XN);
    for (int it = gtid; it < NB * NH * S * 8; it += NT) {
        const int ch = it & 7, row = it >> 3;
        const int bh = row >> 12, pos = row & 4095, b = bh >> 3, h = bh & 7;
        const float l0 = L[row], l1 = L[(size_t)NB * NH * S + row], l2 = L[(size_t)2 * NB * NH * S + row];
        const float mx = fmaxf(l0, fmaxf(l1, l2)); float w0 = ex2(l0 - mx), w1 = ex2(l1 - mx), w2 = ex2(l2 - mx); const float is = 1.f / (w0 + w1 + w2); w0 *= is; w1 *= is; w2 *= is;
        const uint4 a0 = *(const uint4*)(O + (size_t)row * HD + ch * 8), a1 = *(const uint4*)(O + ((size_t)NB * NH * S + row) * HD + ch * 8), a2 = *(const uint4*)(O + ((size_t)2 * NB * NH * S + row) * HD + ch * 8);
        const unsigned x0[4] = {a0.x, a0.y, a0.z, a0.w}, x1[4] = {a1.x, a1.y, a1.z, a1.w}, x2[4] = {a2.x, a2.y, a2.z, a2.w}; unsigned o[4];
#pragma unroll
        for (int j = 0; j < 4; ++j) o[j] = pg8::cvt_pk_bf16(w0 * bf2f(x0[j] & 0xffffu) + w1 * bf2f(x1[j] & 0xffffu) + w2 * bf2f(x2[j] & 0xffffu), w0 * bf2f(x0[j] >> 16) + w1 * bf2f(x1[j] >> 16) + w2 * bf2f(x2[j] >> 16));
        *(uint4*)(mixed + ((size_t)b * S + pos) * D + 512 + h * HD + ch * 8) = make_uint4(o[0], o[1], o[2], o[3]);
    }
}
DEV void phase_mix_a(const Args& a, unsigned char* lds, int wg, int G, int lane, int wave, int tid) {
    { const float* bt = (const float*)(a.ws + WS_BIAS); LAS float* bl = (LAS float*)((LAS unsigned char*)lds + MIX_BIAS_OFF);
      for (int i = tid; i < 3 * NH * 192; i += NTHR) { const int ph = i / 192, bi = i % 192 - 32; bl[i] = (bi >= 0 && bi <= 128) ? bt[ph * 129 + bi] : -1e30f; } }
    __syncthreads();
    if (wave >= NWM) {
        for (int rep = 0; rep < a.rep[5]; ++rep) { asm volatile("" : "+v"(lane)); phase_latew(a, lds, wg * (NWAVES - NWM) + (wave - NWM), G * (NWAVES - NWM), lane, wave); }
        return;
    }
    const int x = wg & 7, wq = (wg >> 3) * NWM + wave, WPX = (G >> 3) * NWM;
    for (int rep = 0; rep < a.rep[0]; ++rep) { asm volatile("" : "+v"(lane)); for (int it = wq; it < 2 * 32 * NH; it += WPX) retstate_item(a, lds, it, x, lane, wave); }
    for (int rep = 0; rep < a.rep[1]; ++rep) { asm volatile("" : "+v"(lane)); attn_items(a, lds, wg, G, lane, wave); }
}
DEV void phase_mix_b(const Args& a, unsigned char* lds, int wg, int G, int lane, int wave, int tid) {
    const int x = wg & 7, wq = (wg >> 3) * NWAVES + wave, WPX = (G >> 3) * NWAVES;
    for (int rep = 0; rep < a.rep[2]; ++rep) { asm volatile("" : "+v"(lane)); for (int it = wq; it < NH * 32 * 2; it += WPX) retout_item(a, lds, it, x, lane, wave); }
    for (int rep = 0; rep < a.rep[3]; ++rep) { asm volatile("" : "+v"(tid)); phase_attn_merge(a, wg * NTHR + tid, G * NTHR); }
}
#define XB_TMO      128
#define XB_XCNT(j)  (256  + 64 * (j))
#define XB_XSUB(j)  (1280 + 64 * (j))
#define XB_XGEN(j)  (2304 + 64 * (j))
#define XB_TOP      3328
#define XB_TOPGEN   3392
#define XCD_BAR_WORDS 3456
#define XB_SPIN_CAP (1u << 18)

__device__ __forceinline__ unsigned xb_ld(unsigned* p)              { return __hip_atomic_load(p, __ATOMIC_RELAXED, __HIP_MEMORY_SCOPE_AGENT); }
__device__ __forceinline__ unsigned xb_add(unsigned* p, unsigned v) { return __hip_atomic_fetch_add(p, v, __ATOMIC_RELAXED, __HIP_MEMORY_SCOPE_AGENT); }
__device__ __forceinline__ unsigned xb_xcc_id() { return (unsigned)__builtin_amdgcn_s_getreg((3 << 11) | 20) & 0xFu; }
#define XB_SPIN(cond, bar) do { unsigned _sp = 0; while (cond) { __builtin_amdgcn_s_sleep(1); \
    if ((++_sp & 255u) == 0u) { if (xb_ld(&(bar)[XB_TMO])) break; if (_sp > XB_SPIN_CAP) { atomicAdd(&(bar)[XB_TMO], 1u); break; } } } } while (0)

struct XcdBarrier {
    unsigned* bar; unsigned x;
    volatile LAS unsigned* st;
};

__device__ __forceinline__ XcdBarrier xcd_barrier_post(unsigned* bar, volatile LAS unsigned* st) {
    XcdBarrier b; b.bar = bar; b.x = xb_xcc_id(); b.st = st;
    if (threadIdx.x == 0) (void)xb_add(&bar[XB_XCNT(b.x)], 1u);
    return b;
}
__device__ __forceinline__ void xcd_barrier_complete(unsigned* bar, unsigned x, unsigned& nloc, unsigned& nx) {
    const unsigned G = gridDim.x * gridDim.y * gridDim.z;
    unsigned sum, cnt, mine, sp = 0u;
    for (;;) {
        sum = 0u; cnt = 0u; mine = 0u;
#pragma unroll
        for (unsigned j = 0; j < 16; ++j) { const unsigned c = xb_ld(&bar[XB_XCNT(j)]); sum += c; cnt += (c > 0u) ? 1u : 0u; mine = (j == x) ? c : mine; }
        if (sum == G) break;
        __builtin_amdgcn_s_sleep(1);
        if ((++sp & 255u) == 0u) { if (xb_ld(&bar[XB_TMO])) break; if (sp > XB_SPIN_CAP) { atomicAdd(&bar[XB_TMO], 1u); break; } }
    }
    nloc = mine > 0u ? mine : 1u; nx = cnt > 0u ? cnt : 1u;
}

__device__ __forceinline__ void xcd_barrier(const XcdBarrier& b) {
    asm volatile("s_waitcnt vmcnt(0)" ::: "memory");
    __syncthreads();
    if (threadIdx.x == 0) {
        unsigned* bar = b.bar;
        __builtin_amdgcn_s_waitcnt(0);
        unsigned nloc = b.st[0], nx = b.st[1];
        if (nloc == 0u) { xcd_barrier_complete(bar, b.x, nloc, nx); b.st[0] = nloc; b.st[1] = nx; }
        const unsigned old = xb_add(&bar[XB_XSUB(b.x)], 1u);
        const unsigned gen = old / nloc;
        if (old + 1u == (gen + 1u) * nloc) {
            __builtin_amdgcn_fence(__ATOMIC_RELEASE, "agent");
            asm volatile("s_waitcnt vmcnt(0)" ::: "memory");
            const unsigned og = xb_add(&bar[XB_TOP], 1u);
            const unsigned tg = og / nx;
            if (og + 1u == (tg + 1u) * nx) xb_add(&bar[XB_TOPGEN], 1u);
            else XB_SPIN(xb_ld(&bar[XB_TOPGEN]) == tg, bar);
            __builtin_amdgcn_fence(__ATOMIC_ACQUIRE, "agent");
            xb_add(&bar[XB_XGEN(b.x)], 1u);
            asm volatile("s_waitcnt vmcnt(0)" ::: "memory");
        } else {
            XB_SPIN(xb_ld(&bar[XB_XGEN(b.x)]) == gen, bar);
            __builtin_amdgcn_fence(__ATOMIC_ACQUIRE, "agent");
            asm volatile("s_waitcnt vmcnt(0)" ::: "memory");
        }
    }
    __syncthreads();
}

#ifndef MK_LAUNCHES
#define MK_LAUNCHES 1
#endif
#ifndef WGM_MOE1
#define WGM_MOE1 8
#endif
#ifndef WGM_MOE2
#define WGM_MOE2 8
#endif
constexpr int NPH = 11;
typedef const __attribute__((address_space(4))) Args* kargs_t;
DEV Args load_args(kargs_t kp) { Args a;
#pragma unroll
    for (int i = 0; i < 13; ++i) a.in[i] = kp->in[i];
    a.out = kp->out; a.ws = kp->ws; a.ph_lo = kp->ph_lo; a.ph_hi = kp->ph_hi;
#pragma unroll
    for (int i = 0; i < 16; ++i) a.rep[i] = kp->rep[i];
    return a; }
#ifndef PROBE_REP
#define PROBE_REP 0
#endif
#define REP(k) if (((PROBE_REP) >> (k)) & 1) for (int _r = 0; _r < 2; ++_r, cg::this_grid().sync())
__global__ void __launch_bounds__(NTHR, 2) mega(Args a_) {
    kargs_t kp = (kargs_t)__builtin_amdgcn_kernarg_segment_ptr();
    extern __shared__ __attribute__((aligned(16))) unsigned char lds[];
    int tid = threadIdx.x, lane = tid & 63, wave = __builtin_amdgcn_readfirstlane(tid >> 6);
    const int G = gridDim.x, wg = blockIdx.x, NGW = G * NWAVES; int gw = wg * NWAVES + wave;
#define FRESH_IDS() do { tid = threadIdx.x; asm volatile("" : "+v"(tid)); lane = tid & 63; wave = __builtin_amdgcn_readfirstlane(tid >> 6); gw = wg * NWAVES + wave; } while (0)
    const int lo = kp->ph_lo, hi = kp->ph_hi;
    unsigned char* ws = kp->ws;
    volatile LAS unsigned* bst = (volatile LAS unsigned*)((LAS unsigned char*)lds + LDS_BYTES - 64);
    if (tid < 2) bst[tid] = 0u;
    __syncthreads();
    XcdBarrier bar = xcd_barrier_post((unsigned*)(ws + WS_CTL) + 4096, bst);
#define IN(k) (lo <= (k) && (k) < hi)
#define SEAM(k) do { if (IN(k) && IN((k) + 1)) { xcd_barrier(bar); } } while (0)
    if (IN(0)) { FRESH_IDS(); const Args a = load_args(kp); unsigned char* ws = a.ws; for (int r = 0; r < a.rep[6]; ++r) { FRESH_IDS(); phase_prep(a, lds, gw, NGW, lane, wave); } }
    SEAM(0);
    if (IN(1)) { FRESH_IDS(); const Args a = load_args(kp); unsigned char* ws = a.ws; pg8::Gemm g{(const bf16_t*)(ws + WS_XN), (const bf16_t*)(ws + WS_WIN), D}; SchedPlain Sc; Sc.init(M, PC, G, wg); Sc.rowbytes = D * 2;
        EpiInProj E{ws, (const float*)(ws + WS_ROPE)};
        for (int r = 0; r < a.rep[8]; ++r) { FRESH_IDS(); pg8::Gemm g2 = g; asm volatile("" : "+s"(g2.A), "+s"(g2.Bt)); pg8::gemm_phase<EpiInProj, SchedPlain, true>((LAS unsigned char*)lds, g2, Sc, E); } }
    SEAM(1);
    if (IN(2)) { FRESH_IDS(); const Args a = load_args(kp); unsigned char* ws = a.ws; phase_mix_a(a, lds, wg, G, lane, wave, tid); }
    SEAM(2);
    if (IN(3)) { FRESH_IDS(); const Args a = load_args(kp); unsigned char* ws = a.ws; for (int r = 0; r < a.rep[13]; ++r) { FRESH_IDS(); phase_scan(a, wg * NTHR + tid, G * NTHR); } }
    SEAM(3);
    if (IN(4)) { FRESH_IDS(); const Args a = load_args(kp); unsigned char* ws = a.ws; phase_mix_b(a, lds, wg, G, lane, wave, tid); }
    SEAM(4);
    { const Args a = load_args(kp); for (int r = 0; r < a.rep[14]; ++r) xcd_barrier(bar); for (int r = 0; r < a.rep[15]; ++r) cg::this_grid().sync(); }
    if (IN(5)) { FRESH_IDS(); const Args a = load_args(kp); unsigned char* ws = a.ws; pg8::Gemm g{(const bf16_t*)(ws + WS_XN), (const bf16_t*)(ws + WS_WOUT), D}; SchedPlain Sc; Sc.init(M, D, G, wg); Sc.rowbytes = D * 2;
        EpiOutProj E{a.in[IN_X], (bf16_t*)(ws + WS_X1)};
        for (int r = 0; r < a.rep[9]; ++r) { FRESH_IDS(); pg8::Gemm g2 = g; asm volatile("" : "+s"(g2.A), "+s"(g2.Bt)); pg8::gemm_phase<EpiOutProj, SchedPlain, true>((LAS unsigned char*)lds, g2, Sc, E); } }
    SEAM(5);
    if (IN(6)) { FRESH_IDS(); const Args a = load_args(kp); unsigned char* ws = a.ws; for (int r = 0; r < a.rep[4]; ++r) { FRESH_IDS(); phase_router(a, lds, gw, NGW, lane, tid); } }
    SEAM(6);
    if (IN(7)) { FRESH_IDS(); const Args a = load_args(kp); unsigned char* ws = a.ws; for (int r = 0; r < a.rep[7]; ++r) { FRESH_IDS(); phase_topk(a, lds, wg, G, tid, lane, wave); } }
    SEAM(7);
    if (IN(8)) { FRESH_IDS(); const Args a = load_args(kp); unsigned char* ws = a.ws; pg8::Gemm g{(const bf16_t*)(ws + WS_XN), (const bf16_t*)(ws + WS_WGU), D}; SchedMoe1 Sc; Sc.init(MR, 4096, G, wg, WGM_MOE1); Sc.idxl = (const LAS int*)((LAS unsigned char*)lds + 131072);
        { const int* idxg = (const int*)(ws + WS_IDX); LAS int* il = (LAS int*)((LAS unsigned char*)lds + 131072); pg8::Unit uu;
          for (int i = 0; i < 16; ++i) if (Sc.next(i, uu) && tid < 256) il[i * 256 + tid] = idxg[uu.pm * 256 + tid];
          __syncthreads(); }
        EpiSwiGLU E{ws + WS_HID};
        for (int r = 0; r < a.rep[10]; ++r) { FRESH_IDS(); pg8::Gemm g2 = g; asm volatile("" : "+s"(g2.A), "+s"(g2.Bt)); pg8::gemm_phase<EpiSwiGLU, SchedMoe1, true, true>((LAS unsigned char*)lds, g2, Sc, E); } }
    SEAM(8);
    if (IN(9)) { FRESH_IDS(); const Args a = load_args(kp); unsigned char* ws = a.ws; pg8::Gemm g{(const bf16_t*)(ws + WS_HID), (const bf16_t*)(ws + WS_WD), DFF}; SchedMoe2 Sc; Sc.init(MR, D, G, wg, WGM_MOE2);
        EpiDown E{ws + WS_Y};
        for (int r = 0; r < a.rep[11]; ++r) { FRESH_IDS(); pg8::Gemm g2 = g; asm volatile("" : "+s"(g2.A), "+s"(g2.Bt)); pg8::gemm_phase<EpiDown, SchedMoe2, true, true>((LAS unsigned char*)lds, g2, Sc, E); } }
    SEAM(9);
    if (IN(10)) { FRESH_IDS(); const Args a = load_args(kp); unsigned char* ws = a.ws; for (int r = 0; r < a.rep[12]; ++r) { FRESH_IDS(); phase_final(a, gw, NGW, lane); } }
#undef IN
#undef SEAM
}

extern "C" void kernel_launch(void* const* d_in, const int* in_sizes, int n_in, void* d_out, int out_size, void* d_ws, size_t ws_size, hipStream_t stream) {
    static int grid = 0;
    if (grid == 0) {
        if (n_in != 13 || in_sizes[0] != M * D || out_size != M * D || ws_size < WS_END) { fprintf(stderr, "kernel_launch: unexpected shapes n_in %d in0 %d out %d ws %zu (need %zu)\n", n_in, n_in > 0 ? in_sizes[0] : -1, out_size, ws_size, (size_t)WS_END); grid = -1; return; }
        int dev = 0, cus = 0, per_cu = 0;
        (void)hipGetDevice(&dev); (void)hipDeviceGetAttribute(&cus, hipDeviceAttributeMultiprocessorCount, dev);
        (void)hipFuncSetAttribute((const void*)mega, hipFuncAttributeMaxDynamicSharedMemorySize, LDS_BYTES);
        if (hipOccupancyMaxActiveBlocksPerMultiprocessor(&per_cu, (const void*)mega, NTHR, LDS_BYTES) != hipSuccess || per_cu < 1) { fprintf(stderr, "kernel_launch: occupancy query says %d blocks/CU\n", per_cu); per_cu = 1; }
        (void)hipGetLastError();
        grid = cus * 1;
        if (grid > cus * per_cu) grid = cus * per_cu;
    }
    if (grid < 0) return;
    (void)hipMemsetAsync((char*)d_ws + WS_CTL, 0, 1 * MiB, stream);
    Args a{};
    for (int i = 0; i < 13; ++i) a.in[i] = (const float*)d_in[i];
    a.out = (float*)d_out; a.ws = (unsigned char*)d_ws;
#ifndef PROBE_R
#define PROBE_R {1, 1, 1, 1, 1, 1, 1, 1, 1, 1, 1, 1, 1, 1, 0, 0}
#endif
    { const int rr[16] = PROBE_R; for (int i = 0; i < 16; ++i) a.rep[i] = rr[i]; }
#if MK_LAUNCHES == 1
    a.ph_lo = 0; a.ph_hi = NPH;
    void* args[] = {&a};
    hipError_t e = hipLaunchCooperativeKernel((const void*)mega, dim3(grid), dim3(NTHR), args, LDS_BYTES, stream);
    if (e != hipSuccess) fprintf(stderr, "cooperative launch failed: %s (grid %d)\n", hipGetErrorString(e), grid);
#else
    for (int p = 0; p < NPH; ++p) { a.ph_lo = p; a.ph_hi = p + 1; hipLaunchKernelGGL(mega, dim3(grid), dim3(NTHR), LDS_BYTES, stream, a); }
#endif
}
```

```cpp
#include <hip/hip_runtime.h>
#include <hip/hip_cooperative_groups.h>
#include <cstdint>
#include <cstdio>
namespace cg = cooperative_groups;

typedef unsigned short bf16_t;
#define DEV __device__ __forceinline__
#define LAS __attribute__((address_space(3)))

constexpr int NB = 8, S = 4096, D = 1024, M = NB * S;
constexpr int NH = 8, HD = 64, PC = 3584;
constexpr int NE = 16, CAP = 512, DFF = 2048, MR = NE * NB * CAP;
constexpr float EPS = 1e-6f, LOG2E = 1.4426950408889634f;
constexpr int NWAVES = 8, NTHR = 512;
constexpr int LDS_BYTES = 163840;

constexpr size_t MiB = 1u << 20;
constexpr size_t WS_CTL = 0;
constexpr size_t WS_ROPE = 1 * MiB;
constexpr size_t WS_BIAS = 2 * MiB;
constexpr size_t WS_IDX = 2 * MiB + 512 * 1024;
constexpr size_t WS_AFF = 3 * MiB;
constexpr size_t WS_INV = 5 * MiB;
constexpr size_t WS_AFFT = 9 * MiB;
constexpr size_t WS_WOUT = 7 * MiB;
constexpr size_t WS_WIN = 9 * MiB;
constexpr size_t WS_XN = 16 * MiB;
constexpr size_t WS_RQ = 80 * MiB, WS_RK = 112 * MiB, WS_RV = 144 * MiB, WS_RG = 176 * MiB;
constexpr size_t WS_AQ = 208 * MiB, WS_AK = 240 * MiB, WS_AV = 272 * MiB;
constexpr size_t WS_ATTO = 304 * MiB;
constexpr size_t WS_ATTL = 3 * MiB;
constexpr size_t WS_KF = 400 * MiB;
constexpr size_t WS_X1 = 80 * MiB;
constexpr size_t WS_ST = 208 * MiB;
constexpr size_t WS_WD = 432 * MiB;
constexpr size_t WS_WGU = 464 * MiB;
constexpr size_t WS_Y = 144 * MiB;
constexpr size_t WS_HID = 272 * MiB;
constexpr size_t WS_END = 528 * MiB;

DEV unsigned f2bf(float f) { unsigned u = __float_as_uint(f); return (u + 0x7fffu + ((u >> 16) & 1u)) >> 16; }
DEV float bf2f(unsigned h) { return __uint_as_float(h << 16); }
DEV unsigned pk2(float lo, float hi) { return f2bf(lo) | (f2bf(hi) << 16); }
DEV float wave_sum(float v) {
#pragma unroll
    for (int o = 1; o < 64; o <<= 1) v += __shfl_xor(v, o);
    return v;
}
#define LDS_WAIT() asm volatile("s_waitcnt lgkmcnt(0)" ::: "memory")
namespace pg8 {
#define PG8_LAS __attribute__((address_space(3)))
typedef short bf16x8 __attribute__((ext_vector_type(8)));
typedef float f32x4 __attribute__((ext_vector_type(4)));
typedef unsigned u32x4 __attribute__((ext_vector_type(4)));
constexpr int BM = 256, BK = 64, HALF = 128, HTB = HALF * BK * 2, STAGE_BYTES = 8 * HTB, NXCD = 8, WGM = 8;
__host__ __device__ __forceinline__ int lds_byte(int r, int c) { const int st = (r >> 4) * 2 + (c >> 5), rr = r & 15, cc = c & 31, ob = rr * 64 + cc * 2; return st * 1024 + (ob ^ (((ob >> 9) & 1) << 5)); }
__host__ __device__ __forceinline__ void stage_rc(int b, int& R, int& C) { const int st = b / 1024, sb = b % 1024, swz = sb ^ (((sb >> 9) & 1) << 5); R = (st >> 1) * 16 + swz / 64; C = (st & 1) * 32 + (swz % 64) / 2; }
__host__ __device__ __forceinline__ int perm32(int rho) { const int n = rho >> 4, i = rho & 15; return 8 * (i >> 2) + 4 * n + (i & 3); }
struct Unit { int pm, pn, ui; };
struct Gemm { const bf16_t* A; const bf16_t* Bt; int K; };
struct StaticOrder {
    int nM, nN, nwg, G, c, wgm;
    __device__ void init(int M_, int N_, int G_, int c_, int wgm_ = WGM) { nM = M_ / BM; nN = N_ / BM; nwg = nM * nN; G = G_; c = c_; wgm = wgm_; }
    __device__ bool next(int i, Unit& u) const {
        const long L = (long)i * G + c; if (L >= nwg) return false;
        int wgid = (int)L; { const int q = nwg / NXCD, r = nwg % NXCD, xcd = wgid % NXCD, off = wgid / NXCD; wgid = (xcd < r ? xcd * (q + 1) : r * (q + 1) + (xcd - r) * q) + off; }
        const int nig = wgm * nN, gid = wgid / nig, fm = gid * wgm, gsz = (nM - fm) < wgm ? (nM - fm) : wgm;
        u.pm = fm + ((wgid % nig) % gsz); u.pn = (wgid % nig) / gsz; return true;
    }
};
__device__ __forceinline__ unsigned cvt_pk_bf16(float lo, float hi) { unsigned r; asm volatile("v_cvt_pk_bf16_f32 %0, %1, %2" : "=v"(r) : "v"(lo), "v"(hi)); return r; }

typedef int v8i __attribute__((ext_vector_type(8)));
template <class Epi, class Sched, bool ALIGN_EPI, bool FP8 = false>
__device__ __forceinline__ void gemm_phase(PG8_LAS unsigned char* lds, const Gemm g, const Sched& S, const Epi& E) {
    const int tid = threadIdx.x, wid = __builtin_amdgcn_readfirstlane(tid >> 6), lane = tid & 63, wr = wid >> 2, wc = wid & 3, fr = lane & 15, fq = lane >> 4;
    const int K = g.K, RB = FP8 ? K : 2 * K, nt = RB / 128;
    unsigned voffB[2];
#pragma unroll
    for (int i = 0; i < 2; ++i) { int R, C; stage_rc(tid * 16 + i * 8192, R, C); const int Rb = Epi::PERM ? ((R & ~31) + perm32(R & 31)) : R;
        voffB[i] = (unsigned)(Rb * RB + C * 2); }
    const size_t kstep = (size_t)(BK * 2);
    const size_t hstep = (size_t)HALF * RB;
    const size_t tstep = 2 * hstep;
    const unsigned ldsw = (unsigned)wid * 1024u;
    const int aoff = FP8 ? lds_byte(wr * 64 + fr, fq * 16) : lds_byte(wr * 64 + fr, fq * 8), boff = FP8 ? lds_byte(wc * 32 + fr, fq * 16) : lds_byte(wc * 32 + fr, fq * 8);
    const int x16 = 16 * (fq & 1);
    const char* gA = (const char*)g.A;
#define PG8_SA(b, h) (((b) * 2 + (h)) * HTB)
#define PG8_SB(b, h) ((4 + (b) * 2 + (h)) * HTB)
#define PG8_STAGE(bufoff, gbase, voff) do { _Pragma("unroll") for (int _i = 0; _i < 2; ++_i) \
        __builtin_amdgcn_global_load_lds((const unsigned*)((const char*)(gbase) + (voff)[_i]), (PG8_LAS unsigned*)(lds + (bufoff) + ldsw + _i * 8192), 16, 0, 0); } while (0)
#define PG8_STAGE_A(bufoff, AO, h, kb) do { _Pragma("unroll") for (int _i = 0; _i < 2; ++_i) \
        __builtin_amdgcn_global_load_lds((const unsigned*)(gA + (size_t)((AO)[h][_i] + (unsigned)(kb))), (PG8_LAS unsigned*)(lds + (bufoff) + ldsw + _i * 8192), 16, 0, 0); } while (0)
#define PG8_LDA(dst, b, h) do { if constexpr (FP8) { _Pragma("unroll") for (int m = 0; m < 4; ++m) { dst[m][0] = *(const PG8_LAS bf16x8*)(lds + PG8_SA(b, h) + aoff + m * 2048 + x16); dst[m][1] = *(const PG8_LAS bf16x8*)(lds + PG8_SA(b, h) + aoff + m * 2048 + 16 - x16); } } \
    else { _Pragma("unroll") for (int m = 0; m < 4; ++m) _Pragma("unroll") for (int k = 0; k < 2; ++k) dst[m][k] = *(const PG8_LAS bf16x8*)(lds + PG8_SA(b, h) + aoff + m * 2048 + k * 1024); } } while (0)
#define PG8_LDB(dst, b, h) do { if constexpr (FP8) { _Pragma("unroll") for (int n = 0; n < 2; ++n) { dst[n][0] = *(const PG8_LAS bf16x8*)(lds + PG8_SB(b, h) + boff + n * 2048 + x16); dst[n][1] = *(const PG8_LAS bf16x8*)(lds + PG8_SB(b, h) + boff + n * 2048 + 16 - x16); } } \
    else { _Pragma("unroll") for (int n = 0; n < 2; ++n) _Pragma("unroll") for (int k = 0; k < 2; ++k) dst[n][k] = *(const PG8_LAS bf16x8*)(lds + PG8_SB(b, h) + boff + n * 2048 + k * 1024); } } while (0)
#define PG8_CAT8(x) __builtin_bit_cast(v8i, __builtin_shufflevector((x)[0], (x)[1], 0, 1, 2, 3, 4, 5, 6, 7, 8, 9, 10, 11, 12, 13, 14, 15))
#define PG8_MMA(ai, bj, At, Bt) do { __builtin_amdgcn_s_setprio(1); if constexpr (FP8) { _Pragma("unroll") for (int m = 0; m < 4; ++m) _Pragma("unroll") for (int n = 0; n < 2; ++n) \
        acc[ai][bj][m][n] = __builtin_amdgcn_mfma_scale_f32_16x16x128_f8f6f4(PG8_CAT8(Bt[n]), PG8_CAT8(At[m]), acc[ai][bj][m][n], 0, 0, 0, 0, 0, 0); } \
    else { _Pragma("unroll") for (int m = 0; m < 4; ++m) _Pragma("unroll") for (int n = 0; n < 2; ++n) _Pragma("unroll") for (int k = 0; k < 2; ++k) \
        acc[ai][bj][m][n] = __builtin_amdgcn_mfma_f32_16x16x32_bf16(Bt[n][k], At[m][k], acc[ai][bj][m][n], 0, 0, 0); } __builtin_amdgcn_s_setprio(0); } while (0)
#define PG8_WAIT_V(n) asm volatile("s_waitcnt vmcnt(" #n ")" ::: "memory")
#define PG8_WAIT_L(n) asm volatile("s_waitcnt lgkmcnt(" #n ")" ::: "memory")
#define PG8_BAR __builtin_amdgcn_s_barrier()
#define PG8_SCHED __builtin_amdgcn_sched_barrier(0)
#define PG8_AOFFS(AO, u) do { int _t = threadIdx.x; asm volatile("" : "+v"(_t)); _Pragma("unroll") for (int _i = 0; _i < 2; ++_i) { int _R, _C; stage_rc(_t * 16 + _i * 8192, _R, _C); \
        _Pragma("unroll") for (int _h = 0; _h < 2; ++_h) (AO)[_h][_i] = S.row_off(u, _h * HALF + _R) + (unsigned)(_C * 2); } } while (0)
    Unit cur, nxt; int ui = 0;
    if (!S.next(0, cur)) return;
    f32x4 acc[2][2][4][2];
#pragma unroll
    for (int a = 0; a < 2; ++a)
#pragma unroll
        for (int b = 0; b < 2; ++b)
#pragma unroll
            for (int m = 0; m < 4; ++m)
#pragma unroll
                for (int n = 0; n < 2; ++n) acc[a][b][m][n] = (f32x4){0.f, 0.f, 0.f, 0.f};
    bf16x8 At[4][2], B0[2][2], B1[2][2];
    unsigned aoc[2][2];
    PG8_AOFFS(aoc, cur);
    const char* cB = (const char*)g.Bt + (size_t)cur.pn * tstep;
    PG8_STAGE(PG8_SB(0, 0), cB, voffB); PG8_STAGE(PG8_SB(0, 1), cB + hstep, voffB); PG8_STAGE_A(PG8_SA(0, 0), aoc, 0, 0); PG8_STAGE_A(PG8_SA(0, 1), aoc, 1, 0);
    if (wr == 1) PG8_BAR;
    PG8_WAIT_V(2); PG8_BAR;
    PG8_STAGE(PG8_SB(1, 0), cB + kstep, voffB); PG8_STAGE_A(PG8_SA(1, 0), aoc, 0, 128); PG8_STAGE(PG8_SB(1, 1), cB + hstep + kstep, voffB);
    PG8_WAIT_V(6); PG8_BAR;
    for (;;) {
        const bool has_next = S.next(ui + 1, nxt);
        const char* nB = cB;
        if (has_next) nB = (const char*)g.Bt + (size_t)nxt.pn * tstep;
#pragma nounroll
        for (int t = 0; t < nt; t += 2) {
            const bool last = (t == nt - 2);
            const unsigned k1 = (unsigned)(t + 1) * 128u, k2 = last ? 0u : (unsigned)(t + 2) * 128u, k3 = k2 + 128u;
            const char* b2 = last ? nB : cB + (size_t)(t + 2) * kstep; const char* b3 = b2 + kstep;
            PG8_LDB(B0, 0, 0); PG8_LDB(B1, 0, 1); PG8_SCHED; PG8_LDA(At, 0, 0); PG8_STAGE_A(PG8_SA(1, 1), aoc, 1, k1);
            PG8_WAIT_V(8); PG8_WAIT_L(0); PG8_BAR; PG8_MMA(0, 0, At, B0); PG8_MMA(0, 1, At, B1); PG8_BAR; PG8_SCHED;
            if (last && has_next) { PG8_AOFFS(aoc, nxt); }
            PG8_LDA(At, 0, 1); PG8_STAGE(PG8_SB(0, 0), b2, voffB); PG8_STAGE(PG8_SB(0, 1), b2 + hstep, voffB); PG8_STAGE_A(PG8_SA(0, 0), aoc, 0, k2);
            PG8_WAIT_V(8); PG8_WAIT_L(0); PG8_BAR; PG8_MMA(1, 0, At, B0); PG8_MMA(1, 1, At, B1); PG8_BAR; PG8_SCHED;
            PG8_LDB(B0, 1, 0); PG8_LDB(B1, 1, 1); PG8_SCHED; PG8_LDA(At, 1, 0); PG8_STAGE_A(PG8_SA(0, 1), aoc, 1, k2);
            PG8_WAIT_V(8); PG8_WAIT_L(0); PG8_BAR; PG8_MMA(0, 0, At, B0); PG8_MMA(0, 1, At, B1); PG8_BAR; PG8_SCHED;
            PG8_LDA(At, 1, 1); PG8_STAGE(PG8_SB(1, 0), b3, voffB); PG8_STAGE(PG8_SB(1, 1), b3 + hstep, voffB); PG8_STAGE_A(PG8_SA(1, 0), aoc, 0, k3);
            PG8_WAIT_V(8); PG8_WAIT_L(0); PG8_BAR; PG8_MMA(1, 0, At, B0); PG8_MMA(1, 1, At, B1); PG8_BAR; PG8_SCHED;
        }
        if constexpr (ALIGN_EPI) { if (wr == 0) PG8_BAR; }
        { int t2 = threadIdx.x; asm volatile("" : "+v"(t2));
          const int w2 = __builtin_amdgcn_readfirstlane(t2 >> 6), l2 = t2 & 63; E(acc, cur, w2 >> 2, w2 & 3, l2 & 15, l2 >> 4); }
        if (!has_next) break;
#pragma unroll
        for (int a = 0; a < 2; ++a)
#pragma unroll
            for (int b = 0; b < 2; ++b)
#pragma unroll
                for (int m = 0; m < 4; ++m)
#pragma unroll
                    for (int n = 0; n < 2; ++n) acc[a][b][m][n] = (f32x4){0.f, 0.f, 0.f, 0.f};
        cur = nxt; cB = nB; ++ui;
        if constexpr (ALIGN_EPI) { if (wr == 1) PG8_BAR; }
    }
    PG8_WAIT_V(0);
    if constexpr (!ALIGN_EPI) { if (wr == 0) PG8_BAR; }
    PG8_BAR;
#undef PG8_SA
#undef PG8_SB
#undef PG8_STAGE
#undef PG8_STAGE_A
#undef PG8_LDA
#undef PG8_LDB
#undef PG8_MMA
#undef PG8_CAT8
#undef PG8_WAIT_V
#undef PG8_WAIT_L
#undef PG8_BAR
#undef PG8_SCHED
#undef PG8_AOFFS
}
}
struct SchedPlain : pg8::StaticOrder {
    unsigned rowbytes;
    DEV unsigned row_off(const pg8::Unit& u, int r) const { return (unsigned)(u.pm * 256 + r) * rowbytes; }
};
struct SchedMoe1 : pg8::StaticOrder {
    const LAS int* idxl;
    DEV bool next(int i, pg8::Unit& u) const { if (!pg8::StaticOrder::next(i, u)) return false; u.pn += (u.pm >> 4) * 16; u.ui = i; return true; }
    DEV unsigned row_off(const pg8::Unit& u, int r) const { const int g = u.pm * 256 + r; const int tok = ((g >> 9) & 7) * S + idxl[u.ui * 256 + r]; return (unsigned)tok * (unsigned)D; }
};
struct SchedMoe2 : pg8::StaticOrder {
    DEV bool next(int i, pg8::Unit& u) const { if (!pg8::StaticOrder::next(i, u)) return false; u.pn += (u.pm >> 4) * 4; return true; }
    DEV unsigned row_off(const pg8::Unit& u, int r) const { return (unsigned)(u.pm * 256 + r) * (unsigned)DFF; }
};
typedef pg8::f32x4 f32x4; typedef pg8::u32x4 u32x4;
struct EpiInProj {
    static constexpr bool PERM = true;
    unsigned char* ws; const float* ropeT;
    DEV void operator()(const f32x4 (&acc)[2][2][4][2], const pg8::Unit& u, int wr, int wc, int fr, int fq) const {
        const int grp = u.pn >> 1;
        bf16_t* gbase = (bf16_t*)(ws + WS_RQ + (size_t)grp * 32 * MiB);
        const int j0 = 32 * (wc & 1) + 8 * fq;
        if (grp < 2) {
            const float sc = grp == 1 ? 0.125f : 1.f;
            f32x4 cs[2][4], sn[2][4];
#pragma unroll
            for (int ai = 0; ai < 2; ++ai)
#pragma unroll
                for (int m = 0; m < 4; ++m) { const int s = (u.pm * 256 + ai * 128 + wr * 64 + m * 16 + fr) & 4095;
                    cs[ai][m] = *(const f32x4*)(ropeT + s * 32 + (j0 >> 1)); sn[ai][m] = *(const f32x4*)(ropeT + S * 32 + s * 32 + (j0 >> 1)); }
#pragma unroll
            for (int ai = 0; ai < 2; ++ai)
#pragma unroll
                for (int m = 0; m < 4; ++m) {
                    const int row = u.pm * 256 + ai * 128 + wr * 64 + m * 16 + fr, b = row >> 12, s = row & 4095;
#pragma unroll
                    for (int bj = 0; bj < 2; ++bj) {
                        const int hd = 4 * (u.pn & 1) + 2 * bj + (wc >> 1);
                        const f32x4 lo = (acc[ai][bj][m][0] * cs[ai][m] - acc[ai][bj][m][1] * sn[ai][m]) * sc, hi = (acc[ai][bj][m][1] * cs[ai][m] + acc[ai][bj][m][0] * sn[ai][m]) * sc;
                        u32x4 w; w.x = pg8::cvt_pk_bf16(lo[0], lo[1]); w.y = pg8::cvt_pk_bf16(lo[2], lo[3]); w.z = pg8::cvt_pk_bf16(hi[0], hi[1]); w.w = pg8::cvt_pk_bf16(hi[2], hi[3]);
                        *(u32x4*)(gbase + ((size_t)(b * NH + hd) * S + s) * HD + j0) = w;
                    }
                }
        } else {
            const float sc = grp == 4 ? 0.125f * LOG2E : 1.f;
#pragma unroll
            for (int ai = 0; ai < 2; ++ai)
#pragma unroll
                for (int m = 0; m < 4; ++m) {
                    const int row = u.pm * 256 + ai * 128 + wr * 64 + m * 16 + fr, b = row >> 12, s = row & 4095;
#pragma unroll
                    for (int bj = 0; bj < 2; ++bj) {
                        const int hd = 4 * (u.pn & 1) + 2 * bj + (wc >> 1);
                        const f32x4 lo = acc[ai][bj][m][0] * sc, hi = acc[ai][bj][m][1] * sc;
                        u32x4 w; w.x = pg8::cvt_pk_bf16(lo[0], lo[1]); w.y = pg8::cvt_pk_bf16(lo[2], lo[3]); w.z = pg8::cvt_pk_bf16(hi[0], hi[1]); w.w = pg8::cvt_pk_bf16(hi[2], hi[3]);
                        *(u32x4*)(gbase + ((size_t)(b * NH + hd) * S + s) * HD + j0) = w;
                    }
                }
        }
    }
};
struct EpiOutProj {
    static constexpr bool PERM = true;
    const float* x; bf16_t* x1;
    DEV void operator()(const f32x4 (&acc)[2][2][4][2], const pg8::Unit& u, int wr, int wc, int fr, int fq) const {
#pragma unroll
        for (int ai = 0; ai < 2; ++ai)
#pragma unroll
            for (int m = 0; m < 4; ++m) {
                const int row = u.pm * 256 + ai * 128 + wr * 64 + m * 16 + fr;
                f32x4 xa[2], xb[2];
#pragma unroll
                for (int bj = 0; bj < 2; ++bj) { const size_t off = (size_t)row * D + u.pn * 256 + bj * 128 + wc * 32 + 8 * fq; xa[bj] = *(const f32x4*)(x + off); xb[bj] = *(const f32x4*)(x + off + 4); }
#pragma unroll
                for (int bj = 0; bj < 2; ++bj) { const size_t off = (size_t)row * D + u.pn * 256 + bj * 128 + wc * 32 + 8 * fq;
                    const f32x4 lo = xa[bj] + acc[ai][bj][m][0], hi = xb[bj] + acc[ai][bj][m][1];
                    u32x4 w; w.x = pg8::cvt_pk_bf16(lo[0], lo[1]); w.y = pg8::cvt_pk_bf16(lo[2], lo[3]); w.z = pg8::cvt_pk_bf16(hi[0], hi[1]); w.w = pg8::cvt_pk_bf16(hi[2], hi[3]);
                    *(u32x4*)(x1 + off) = w; }
            }
    }
};
DEV unsigned pk4_fp8e(float a, float b, float c, float d) { unsigned w = 0u; w = __builtin_amdgcn_cvt_pk_fp8_f32(a, b, w, false); w = __builtin_amdgcn_cvt_pk_fp8_f32(c, d, w, true); return w; }
struct EpiSwiGLU {
    static constexpr bool PERM = true;
    unsigned char* hid;
    DEV void operator()(const f32x4 (&acc)[2][2][4][2], const pg8::Unit& u, int wr, int wc, int fr, int fq) const {
        const int pnl = u.pn & 15;
#pragma unroll
        for (int ai = 0; ai < 2; ++ai)
#pragma unroll
            for (int m = 0; m < 4; ++m) {
                const int row = u.pm * 256 + ai * 128 + wr * 64 + m * 16 + fr;
                float o[8];
#pragma unroll
                for (int n = 0; n < 2; ++n)
#pragma unroll
                    for (int i = 0; i < 4; ++i) { const float ga = acc[ai][0][m][n][i], ua = acc[ai][1][m][n][i];
                        o[4 * n + i] = (ga * ua) * ((1.f / 1024.f) * __builtin_amdgcn_rcpf(1.f + __builtin_amdgcn_exp2f(ga * (-LOG2E / 32.f)))); }
                *(uint2*)(hid + (size_t)row * DFF + pnl * 128 + wc * 32 + 8 * fq) = make_uint2(pk4_fp8e(o[0], o[1], o[2], o[3]), pk4_fp8e(o[4], o[5], o[6], o[7]));
            }
    }
};
struct EpiDown {
    static constexpr bool PERM = true;
    unsigned char* y;
    DEV void operator()(const f32x4 (&acc)[2][2][4][2], const pg8::Unit& u, int wr, int wc, int fr, int fq) const {
        const int pnl = u.pn & 3;
#pragma unroll
        for (int ai = 0; ai < 2; ++ai)
#pragma unroll
            for (int m = 0; m < 4; ++m) {
                const int row = u.pm * 256 + ai * 128 + wr * 64 + m * 16 + fr;
#pragma unroll
                for (int bj = 0; bj < 2; ++bj) { const f32x4 lo = acc[ai][bj][m][0] * (1.f / 32.f), hi = acc[ai][bj][m][1] * (1.f / 32.f);
                    *(uint2*)(y + (size_t)row * D + pnl * 256 + bj * 128 + wc * 32 + 8 * fq) = make_uint2(pk4_fp8e(lo[0], lo[1], lo[2], lo[3]), pk4_fp8e(hi[0], hi[1], hi[2], hi[3])); }
            }
    }
};
struct Args { const float* in[13]; float* out; unsigned char* ws; int ph_lo, ph_hi; int rep[16]; };
enum { IN_X = 0, IN_G1, IN_WIN, IN_DECAY, IN_GN, IN_RELB, IN_WOUT, IN_G2, IN_WR, IN_WG, IN_WU, IN_WDN, IN_FG };

struct TrItem { const float* src; bf16_t* dst; int K, N, k0, n0, mode, fp8; };
DEV unsigned pk4_fp8(float a, float b, float c, float d) { unsigned w = 0u; w = __builtin_amdgcn_cvt_pk_fp8_f32(a, b, w, false); w = __builtin_amdgcn_cvt_pk_fp8_f32(c, d, w, true); return w; }
DEV void tr_load(const TrItem& t, f32x4 (&v)[16], int lane) {
#pragma unroll
    for (int i = 0; i < 16; ++i) { const int kk = (lane >> 4) + 4 * i, c = (lane & 15) * 4; v[i] = *(const f32x4*)(t.src + (size_t)(t.k0 + kk) * t.N + t.n0 + c); }
}
DEV int rowmap_rt(int mode, int n) {
    if (mode == 0) return n;
    if (mode == 1) { if (n >= 1024) return n; const int base = n & ~63, d = n & 63, nn = d >> 5, dd = d & 31; return base + 8 * (dd >> 2) + 4 * nn + (dd & 3); }
    return (n >> 7) * 256 + (mode == 3 ? 128 : 0) + (n & 127);
}
DEV void tr_finish(const TrItem& t, const f32x4 (&v)[16], LAS float* scr, int lane) {
#pragma unroll
    for (int i = 0; i < 16; ++i) { const int kk = (lane >> 4) + 4 * i, c = (lane & 15) * 4;
        scr[kk * 65 + c] = v[i][0]; scr[kk * 65 + c + 1] = v[i][1]; scr[kk * 65 + c + 2] = v[i][2]; scr[kk * 65 + c + 3] = v[i][3]; }
    LDS_WAIT();
#pragma unroll
    for (int i = 0; i < 8; ++i) { const int n = (lane >> 3) + 8 * i, c = (lane & 7) * 8; const LAS float* sp = scr + c * 65 + n;
        if (t.fp8) {
            const unsigned lo = pk4_fp8(sp[0] * 32.f, sp[65] * 32.f, sp[2 * 65] * 32.f, sp[3 * 65] * 32.f), hi = pk4_fp8(sp[4 * 65] * 32.f, sp[5 * 65] * 32.f, sp[6 * 65] * 32.f, sp[7 * 65] * 32.f);
            *(uint2*)((unsigned char*)t.dst + (size_t)rowmap_rt(t.mode, t.n0 + n) * t.K + t.k0 + c) = make_uint2(lo, hi);
        } else {
        u32x4 o; o.x = pk2(sp[0], sp[65]); o.y = pk2(sp[2 * 65], sp[3 * 65]); o.z = pk2(sp[4 * 65], sp[5 * 65]); o.w = pk2(sp[6 * 65], sp[7 * 65]);
        *(u32x4*)(t.dst + (size_t)rowmap_rt(t.mode, t.n0 + n) * t.K + t.k0 + c) = o; } }
    LDS_WAIT();
}
template <class Dec> DEV void tr_run(const Dec& dec, int nitems, int gw, int NGW, LAS float* scr, int lane) {
    for (int it = gw; it < nitems; it += NGW) { TrItem cur; f32x4 va[16]; dec(it, cur); tr_load(cur, va, lane); tr_finish(cur, va, scr, lane); }
}
template <class Dec> DEV void tr_run2(const Dec& dec, int nitems, int gw, int NGW, LAS float* scr, int lane) {
    int it = gw; if (it >= nitems) return;
    TrItem cur, nxt; f32x4 va[16], vb[16];
    dec(it, cur); tr_load(cur, va, lane);
    for (;;) {
        const int n1 = it + NGW; const bool h1 = n1 < nitems;
        if (h1) { dec(n1, nxt); tr_load(nxt, vb, lane); }
        tr_finish(cur, va, scr, lane);
        if (!h1) break;
        const int n2 = n1 + NGW; const bool h2 = n2 < nitems;
        if (h2) { dec(n2, cur); tr_load(cur, va, lane); }
        tr_finish(nxt, vb, scr, lane);
        if (!h2) break;
        it = n2;
    }
}
DEV void rms_row_to_bf16(const float* xrow, const float* g, bf16_t* orow, int lane) {
    const float4* xr = (const float4*)xrow + lane;
    float4 v[4]; float s = 0.f;
#pragma unroll
    for (int j = 0; j < 4; ++j) { v[j] = xr[64 * j]; s += v[j].x * v[j].x + v[j].y * v[j].y + v[j].z * v[j].z + v[j].w * v[j].w; }
    const float rs = rsqrtf(wave_sum(s) * (1.f / D) + EPS);
    uint2* o = (uint2*)orow + lane;
#pragma unroll
    for (int j = 0; j < 4; ++j) { const float4 gg = ((const float4*)g)[lane + 64 * j];
        o[64 * j] = make_uint2(pk2(v[j].x * rs * gg.x, v[j].y * rs * gg.y), pk2(v[j].z * rs * gg.z, v[j].w * rs * gg.w)); }
}
DEV void phase_prep(const Args& a, unsigned char* lds, int gw, int NGW, int lane, int wave) {
    unsigned char* ws = a.ws;
    float* ropeT = (float*)(ws + WS_ROPE); float* biasT = (float*)(ws + WS_BIAS);
    for (int t = gw * 64 + lane; t < S * 32; t += NGW * 64) {
        const int pos = t >> 5, i = t & 31; const double inv = pow(10000.0, -(double)i / 32.0), ang = (double)pos * inv;
        ropeT[t] = (float)cos(ang); ropeT[S * 32 + t] = (float)sin(ang);
        if (t < 3 * NH * 129) { const int p = t / (NH * 129), h = (t / 129) % NH, o = t % 129 - 64, dil = p == 0 ? 1 : (p == 1 ? 4 : 16), rel = o * dil, n = rel < 0 ? -rel : rel;
            int bucket = rel > 0 ? 16 : 0;
            if (n < 8) bucket += n; else { int large = 8 + (int)(log((double)n / 8.0) / log(128.0) * 8.0); if (large > 15) large = 15; bucket += large; }
            biasT[t] = a.in[IN_RELB][bucket * NH + h] * LOG2E; }
    }
    LAS float* scr = (LAS float*)((LAS unsigned char*)lds + wave * 16640);
    constexpr int I_IN = (D / 64) * (PC / 64), I_OUT = (D / 64) * (D / 64);
    { const float* w_in = a.in[IN_WIN]; const float* w_out = a.in[IN_WOUT]; bf16_t* Win = (bf16_t*)(ws + WS_WIN); bf16_t* Wout = (bf16_t*)(ws + WS_WOUT);
      auto dec = [=](int it, TrItem& t) { if (it < I_IN) { t.src = w_in; t.dst = Win; t.K = D; t.N = PC; t.k0 = (it / (PC / 64)) * 64; t.n0 = (it % (PC / 64)) * 64; t.mode = 1; t.fp8 = 0; }
          else { const int r = it - I_IN; t.src = w_out; t.dst = Wout; t.K = D; t.N = D; t.k0 = (r / (D / 64)) * 64; t.n0 = (r % (D / 64)) * 64; t.mode = 0; t.fp8 = 0; } };
      tr_run(dec, I_IN + I_OUT, gw, NGW, scr, lane); }
    for (int m = gw; m < M; m += NGW) rms_row_to_bf16(a.in[IN_X] + (size_t)m * D, a.in[IN_G1], (bf16_t*)(ws + WS_XN) + (size_t)m * D, lane);
}
DEV void phase_latew(const Args& a, unsigned char* lds, int gw, int NGW, int lane, int wave) {
    unsigned char* ws = a.ws; LAS float* scr = (LAS float*)((LAS unsigned char*)lds + wave * 16640);
    constexpr int I_G = (D / 64) * (DFF / 64);
    const float* wg_ = a.in[IN_WG]; const float* wu_ = a.in[IN_WU]; const float* wd_ = a.in[IN_WDN]; bf16_t* Wgu = (bf16_t*)(ws + WS_WGU); bf16_t* Wd = (bf16_t*)(ws + WS_WD);
    auto dec = [=](int it, TrItem& t) { const int which = it / (NE * I_G), r = it % (NE * I_G), e = r / I_G, q = r % I_G;
        t.fp8 = 1;
        if (which < 2) { t.src = (which == 0 ? wg_ : wu_) + (size_t)e * D * DFF; t.dst = (bf16_t*)((unsigned char*)Wgu + (size_t)e * 4096 * D); t.K = D; t.N = DFF; t.k0 = (q / (DFF / 64)) * 64; t.n0 = (q % (DFF / 64)) * 64; t.mode = 2 + which; }
        else { t.src = wd_ + (size_t)e * DFF * D; t.dst = (bf16_t*)((unsigned char*)Wd + (size_t)e * D * DFF); t.K = DFF; t.N = D; t.k0 = (q / (D / 64)) * 64; t.n0 = (q % (D / 64)) * 64; t.mode = 0; } };
    tr_run2(dec, 3 * NE * I_G, gw, NGW, scr, lane);
}
DEV void phase_router(const Args& a, unsigned char* lds, int gw, int NGW, int lane, int tid) {
    unsigned char* ws = a.ws; const bf16_t* x1 = (const bf16_t*)(ws + WS_X1); const float* g2 = a.in[IN_G2]; const float* wr = a.in[IN_WR];
    bf16_t* H2b = (bf16_t*)(ws + WS_XN); float* aff = (float*)(ws + WS_AFF); float* affT = (float*)(ws + WS_AFFT); int* inv = (int*)(ws + WS_INV);
    LAS f32x4* wl = (LAS f32x4*)(LAS unsigned char*)lds;
    for (int i = tid; i < D * 4; i += NTHR) { const int k = i >> 2, c = i & 3, slot = (k & 3) * 256 + (k >> 2); wl[slot * 4 + ((c + (slot >> 2)) & 3)] = *(const f32x4*)(wr + (size_t)k * NE + 4 * c); }
    __syncthreads();
    uint2 xw[4], xn[4];
    { const uint2* xr = (const uint2*)(x1 + (size_t)gw * D) + lane;
#pragma unroll
      for (int j = 0; j < 4; ++j) xw[j] = xr[64 * j]; }
    for (int row = gw; row < M; row += NGW) {
        if (row + NGW < M) { const uint2* xr = (const uint2*)(x1 + (size_t)(row + NGW) * D) + lane;
#pragma unroll
            for (int j = 0; j < 4; ++j) xn[j] = xr[64 * j]; }
        float4 v[4]; float s = 0.f;
#pragma unroll
        for (int j = 0; j < 4; ++j) { v[j] = make_float4(bf2f(xw[j].x & 0xffffu), bf2f(xw[j].x >> 16), bf2f(xw[j].y & 0xffffu), bf2f(xw[j].y >> 16)); s += v[j].x * v[j].x + v[j].y * v[j].y + v[j].z * v[j].z + v[j].w * v[j].w; }
#pragma unroll
        for (int j = 0; j < 4; ++j) xw[j] = xn[j];
        const float rs = rsqrtf(wave_sum(s) * (1.f / D) + EPS);
        f32x4 lg[4];
#pragma unroll
        for (int c = 0; c < 4; ++c) lg[c] = (f32x4){0.f, 0.f, 0.f, 0.f};
        unsigned* o = (unsigned*)((unsigned char*)H2b + (size_t)row * D) + lane;
#pragma unroll
        for (int j = 0; j < 4; ++j) { const float4 gg = ((const float4*)g2)[lane + 64 * j];
            const float hv[4] = {v[j].x * rs * gg.x, v[j].y * rs * gg.y, v[j].z * rs * gg.z, v[j].w * rs * gg.w};
            o[64 * j] = pk4_fp8(hv[0], hv[1], hv[2], hv[3]);
#pragma unroll
            for (int t = 0; t < 4; ++t) { const int slot = t * 256 + lane + 64 * j, rot = (lane >> 2) & 3;
#pragma unroll
                for (int c = 0; c < 4; ++c) lg[c] += hv[t] * wl[slot * 4 + ((c + rot) & 3)];
                __builtin_amdgcn_sched_barrier(0); } }
        float r8[8], r4[4], r2[2], r1;
        { const bool up = lane & 32;
#pragma unroll
          for (int i = 0; i < 8; ++i) { const float mine = up ? lg[(i + 8) >> 2][(i + 8) & 3] : lg[i >> 2][i & 3], send = up ? lg[i >> 2][i & 3] : lg[(i + 8) >> 2][(i + 8) & 3]; r8[i] = mine + __shfl_xor(send, 32); } }
        { const bool up = lane & 16;
#pragma unroll
          for (int i = 0; i < 4; ++i) { const float mine = up ? r8[i + 4] : r8[i], send = up ? r8[i] : r8[i + 4]; r4[i] = mine + __shfl_xor(send, 16); } }
        { const bool up = lane & 8;
#pragma unroll
          for (int i = 0; i < 2; ++i) { const float mine = up ? r4[i + 2] : r4[i], send = up ? r4[i] : r4[i + 2]; r2[i] = mine + __shfl_xor(send, 8); } }
        { const bool up = lane & 4; const float mine = up ? r2[1] : r2[0], send = up ? r2[0] : r2[1]; r1 = mine + __shfl_xor(send, 4); }
        r1 += __shfl_xor(r1, 2); r1 += __shfl_xor(r1, 1);
        float mx = r1;
#pragma unroll
        for (int o = 4; o < 64; o <<= 1) mx = fmaxf(mx, __shfl_xor(mx, o));
        const float ex = __expf(r1 - mx); float sum = ex;
#pragma unroll
        for (int o = 4; o < 64; o <<= 1) sum += __shfl_xor(sum, o);
        const float av = ex / sum; const int e = lane >> 2;
        if ((lane & 3) == 0) { aff[(size_t)row * NE + e] = av; inv[(size_t)row * NE + e] = -1; affT[((size_t)(row >> 12) * NE + e) * S + (row & 4095)] = av; }
    }
    __syncthreads();
}
DEV void phase_topk(const Args& a, unsigned char* lds, int wg, int G, int tid, int lane, int wave) {
    unsigned char* ws = a.ws; const float* affT = (const float*)(ws + WS_AFFT); int* idx = (int*)(ws + WS_IDX); int* inv = (int*)(ws + WS_INV);
    LAS unsigned* hist = (LAS unsigned*)(LAS unsigned char*)lds; LAS unsigned* wsum = hist + 256; LAS unsigned* bc = hist + 272;
    for (int it = wg; it < NE * NB; it += G) {
        const int e = it & 15, b = it >> 4;
        unsigned u[8];
        { const uint4* src = (const uint4*)(affT + ((size_t)b * NE + e) * S + 8 * tid); const uint4 p = src[0], q = src[1]; u[0] = p.x; u[1] = p.y; u[2] = p.z; u[3] = p.w; u[4] = q.x; u[5] = q.y; u[6] = q.z; u[7] = q.w; }
        unsigned prefix = 0u, kk = CAP;
#pragma unroll
        for (int pass = 0; pass < 4; ++pass) {
            const int shift = 24 - 8 * pass;
            __syncthreads();
            if (tid < 256) hist[tid] = 0u;
            __syncthreads();
#pragma unroll
            for (int j = 0; j < 8; ++j) if (pass == 0 || (u[j] >> (shift + 8)) == prefix) atomicAdd((unsigned*)&hist[(u[j] >> shift) & 255u], 1u);
            __syncthreads();
            if (wave == 0) {
                const unsigned c0 = hist[4 * lane], c1 = hist[4 * lane + 1], c2 = hist[4 * lane + 2], c3 = hist[4 * lane + 3], tot = c0 + c1 + c2 + c3;
                unsigned incl = tot;
#pragma unroll
                for (int o = 1; o < 64; o <<= 1) { const unsigned t = __shfl_down(incl, o); if (lane + o < 64) incl += t; }
                const unsigned excl = incl - tot;
                if (excl < kk && kk <= incl) { unsigned acc = excl; int bin;
                    if (acc + c3 >= kk) bin = 3; else { acc += c3; if (acc + c2 >= kk) bin = 2; else { acc += c2; if (acc + c1 >= kk) bin = 1; else { acc += c1; bin = 0; } } }
                    bc[0] = 4 * lane + bin; bc[1] = kk - acc; }
            }
            __syncthreads();
            prefix = (prefix << 8) | bc[0]; kk = bc[1];
        }
        const unsigned T = prefix, need = kk;
        unsigned cg_ = 0u, ce = 0u;
#pragma unroll
        for (int j = 0; j < 8; ++j) { cg_ += u[j] > T; ce += u[j] == T; }
        unsigned pk = cg_ | (ce << 16), incl = pk;
#pragma unroll
        for (int o = 1; o < 64; o <<= 1) { const unsigned t = __shfl_up(incl, o); if (lane >= o) incl += t; }
        if (lane == 63) wsum[wave] = incl;
        __syncthreads();
        unsigned base = 0u;
#pragma unroll
        for (int w = 0; w < NWAVES; ++w) base += w < wave ? wsum[w] : 0u;
        const unsigned ex = base + incl - pk; unsigned gtb = ex & 0xffffu, eqb = ex >> 16;
#pragma unroll
        for (int j = 0; j < 8; ++j) { const bool g = u[j] > T, q = u[j] == T; const unsigned slot = gtb + (eqb < need ? eqb : need);
            if (g || (q && eqb < need)) { const int s = 8 * tid + j; idx[(e * NB + b) * CAP + slot] = s; inv[((size_t)b * S + s) * NE + e] = (int)slot; }
            gtb += g; eqb += q; }
    }
}
DEV void phase_final(const Args& a, int gw, int NGW, int lane) {
    unsigned char* ws = a.ws; float* xo = a.out; const bf16_t* x1 = (const bf16_t*)(ws + WS_X1); const float* aff = (const float*)(ws + WS_AFF); const int* inv = (const int*)(ws + WS_INV);
    const unsigned char* y = ws + WS_Y; const float* fg = a.in[IN_FG];
    uint2 xw[4], xn[4]; int iv = -1, ivn = -1; float av = 0.f, avn = 0.f;
    { const uint2* xr = (const uint2*)(x1 + (size_t)gw * D) + lane;
#pragma unroll
      for (int j = 0; j < 4; ++j) xw[j] = xr[64 * j];
      if (lane < NE) { iv = inv[(size_t)gw * NE + lane]; av = aff[(size_t)gw * NE + lane]; } }
    for (int row = gw; row < M; row += NGW) {
        const int b = row >> 12;
        if (row + NGW < M) { const uint2* xr = (const uint2*)(x1 + (size_t)(row + NGW) * D) + lane;
#pragma unroll
            for (int j = 0; j < 4; ++j) xn[j] = xr[64 * j];
            if (lane < NE) { ivn = inv[(size_t)(row + NGW) * NE + lane]; avn = aff[(size_t)(row + NGW) * NE + lane]; } }
        float4 v[4];
#pragma unroll
        for (int j = 0; j < 4; ++j) v[j] = make_float4(bf2f(xw[j].x & 0xffffu), bf2f(xw[j].x >> 16), bf2f(xw[j].y & 0xffffu), bf2f(xw[j].y >> 16));
        unsigned long long msk = __ballot(lane < NE && iv >= 0);
        while (msk) {
            unsigned w[4][4]; float gq[4];
#pragma unroll
            for (int q = 0; q < 4; ++q) { const bool on = msk != 0ull; const int e = on ? __builtin_ctzll(msk) : 0; msk = on ? (msk & (msk - 1)) : 0ull;
                const int sl = __builtin_amdgcn_readlane(iv, e); const float g = __builtin_bit_cast(float, __builtin_amdgcn_readlane(__builtin_bit_cast(int, av), e));
                gq[q] = on ? g : 0.f;
                const unsigned* yr = (const unsigned*)(y + ((size_t)e * 4096 + b * CAP + (on ? sl : 0)) * D) + lane;
#pragma unroll
                for (int j = 0; j < 4; ++j) w[q][j] = yr[64 * j]; }
#pragma unroll
            for (int q = 0; q < 4; ++q)
#pragma unroll
                for (int j = 0; j < 4; ++j) { const auto lo = __builtin_amdgcn_cvt_pk_f32_fp8((int)w[q][j], false), hi = __builtin_amdgcn_cvt_pk_f32_fp8((int)w[q][j], true);
                    v[j].x += gq[q] * lo[0]; v[j].y += gq[q] * lo[1]; v[j].z += gq[q] * hi[0]; v[j].w += gq[q] * hi[1]; }
        }
        float s = 0.f;
#pragma unroll
        for (int j = 0; j < 4; ++j) s += v[j].x * v[j].x + v[j].y * v[j].y + v[j].z * v[j].z + v[j].w * v[j].w;
        const float rs = rsqrtf(wave_sum(s) * (1.f / D) + EPS);
        float4* orow = (float4*)(xo + (size_t)row * D) + lane;
#pragma unroll
        for (int j = 0; j < 4; ++j) { const float4 gg = ((const float4*)fg)[lane + 64 * j]; orow[64 * j] = make_float4(v[j].x * rs * gg.x, v[j].y * rs * gg.y, v[j].z * rs * gg.z, v[j].w * rs * gg.w); }
#pragma unroll
        for (int j = 0; j < 4; ++j) xw[j] = xn[j];
        iv = ivn; av = avn;
    }
}
typedef short bf16x8 __attribute__((ext_vector_type(8)));
typedef float f32x16 __attribute__((ext_vector_type(16)));
typedef short s16x4 __attribute__((ext_vector_type(4)));
typedef LAS const char* lds_cptr;
typedef unsigned u32x2 __attribute__((ext_vector_type(2)));
constexpr int VROW = 192;
constexpr int VSLOT = 32 * VROW;
constexpr int KROW = 144;
constexpr int KSLOT = 32 * KROW;
constexpr int MIX_WAVE_LDS = 16640;
constexpr int NWM = 6;
constexpr int MIX_BIAS_OFF = NWAVES * MIX_WAVE_LDS;
DEV int crow(int r, int hi) { return (r & 3) + 8 * (r >> 2) + 4 * hi; }
DEV s16x4 vtr(lds_cptr p) { return __builtin_bit_cast(s16x4, __builtin_amdgcn_ds_read_tr16_b64_v4i16((LAS s16x4*)p)); }
DEV bf16x8 tr_frag(lds_cptr slot, int s, int blk, int lane) {
    const int h = lane >> 5; lds_cptr p = slot + (16 * s + 4 * h + ((lane & 15) >> 2)) * VROW + (32 * blk + 16 * ((lane >> 4) & 1) + 4 * (lane & 3)) * 2;
    const s16x4 lo = vtr(p), hi = vtr(p + 8 * VROW);
    return (bf16x8){lo[0], lo[1], lo[2], lo[3], hi[0], hi[1], hi[2], hi[3]};
}
DEV void load_frags(bf16x8 (&f)[4], const bf16_t* rowp, int lane) {
    const int h = lane >> 5;
#pragma unroll
    for (int st = 0; st < 4; ++st) f[st] = *(const bf16x8*)(rowp + 16 * st + 8 * h);
}
DEV bf16x8 pack_p(const f32x16& p, int s) {
    u32x4 w; w.x = pg8::cvt_pk_bf16(p[8 * s], p[8 * s + 1]); w.y = pg8::cvt_pk_bf16(p[8 * s + 2], p[8 * s + 3]); w.z = pg8::cvt_pk_bf16(p[8 * s + 4], p[8 * s + 5]); w.w = pg8::cvt_pk_bf16(p[8 * s + 6], p[8 * s + 7]);
    return __builtin_bit_cast(bf16x8, w);
}

DEV void stage_rows_k(LAS unsigned char* ks, const u32x4 (&raw)[4], int lane) {
    const int rr = lane >> 3, ch = lane & 7;
#pragma unroll
    for (int i = 0; i < 4; ++i) *(LAS u32x4*)(ks + (rr + 8 * i) * KROW + ch * 16) = raw[i];
}
DEV void read_row_frags(bf16x8 (&f)[4], const LAS unsigned char* ks, int lane) {
    const LAS unsigned char* p = ks + (lane & 31) * KROW + (lane >> 5) * 16;
#pragma unroll
    for (int st = 0; st < 4; ++st) f[st] = *(const LAS bf16x8*)(p + st * 32);
}

DEV float other_half(float x) { const auto r = __builtin_amdgcn_permlane32_swap(__float_as_uint(x), __float_as_uint(x), false, false); return (threadIdx.x & 32) ? __uint_as_float(r[0]) : __uint_as_float(r[1]); }
DEV float max_halves(float x) { const auto r = __builtin_amdgcn_permlane32_swap(__float_as_uint(x), __float_as_uint(x), false, false); return fmaxf(__uint_as_float(r[0]), __uint_as_float(r[1])); }
DEV float sum_halves(float x) { const auto r = __builtin_amdgcn_permlane32_swap(__float_as_uint(x), __float_as_uint(x), false, false); return __uint_as_float(r[0]) + __uint_as_float(r[1]); }
#define MFMA32(a, b, c) __builtin_amdgcn_mfma_f32_32x32x16_bf16((a), (b), (c), 0, 0, 0)
DEV float ex2(float x) { return __builtin_amdgcn_exp2f(x); }

struct AttnIt { int p, bh, sh, L, r, q0, kmin, kmax; };
DEV void attn_decode(int li, int x, AttnIt& d) {
    d.p = li >> 9; d.bh = 8 * x + ((li >> 6) & 7); const int qblk = li & 63;
    d.sh = 2 * d.p; d.L = S >> d.sh; const int bpr = d.L >> 6;
    d.r = qblk / bpr; d.q0 = (qblk % bpr) * 64;
    d.kmin = d.q0 >= 64 ? 0 : 2; const int km = (d.L + 63 - d.q0) >> 5; d.kmax = km > 5 ? 5 : km;
}
DEV int med3i(int v, int lo, int hi) { return v < lo ? lo : (v > hi ? hi : v); }
DEV void attn_ldrows(const bf16_t* base, const AttnIt& d, int i0, u32x4 (&v)[4], int lane) {
    const int rr = lane >> 3, ch = lane & 7; const char* hb = (const char*)(base + (size_t)d.bh * S * HD); const unsigned cst = (unsigned)(d.r * 128 + ch * 16);
#pragma unroll
    for (int i = 0; i < 4; ++i) v[i] = *(const u32x4*)(hb + (((unsigned)med3i(i0 + rr + 8 * i, 0, d.L - 1) << (d.sh + 7)) + cst));
}
DEV void attn_ldkv(const Args& a, const AttnIt& d, int kk, u32x4 (&k)[4], u32x4 (&v)[4], int lane) {
    const int rr = lane >> 3, ch = lane & 7, i0 = d.q0 - 64 + 32 * kk; const unsigned cst = (unsigned)(d.r * 128 + ch * 16);
    const char* kb = (const char*)((const bf16_t*)(a.ws + WS_AK) + (size_t)d.bh * S * HD); const char* vb = (const char*)((const bf16_t*)(a.ws + WS_AV) + (size_t)d.bh * S * HD);
#pragma unroll
    for (int i = 0; i < 4; ++i) { const unsigned off = ((unsigned)med3i(i0 + rr + 8 * i, 0, d.L - 1) << (d.sh + 7)) + cst; k[i] = *(const u32x4*)(kb + off); v[i] = *(const u32x4*)(vb + off); }
}
DEV void attn_items(const Args& a, unsigned char* lds, int wg, int G, int lane, int wave) {
    unsigned char* ws = a.ws;
    constexpr int NIT = 3 * 512; constexpr float THR = 6.f;
    const int x = wg & 7, NGW = (G >> 3) * NWM;
    int item = (wg >> 3) * NWM + wave; if (item >= NIT) return;
    LAS unsigned char* slot = (LAS unsigned char*)lds + wave * MIX_WAVE_LDS; lds_cptr slot3 = (lds_cptr)slot; LAS unsigned char* kslot = slot + VSLOT;
    const int t = lane & 31, hi = lane >> 5, rr = lane >> 3, ch = lane & 7;
    AttnIt d; attn_decode(item, x, d);
    bf16x8 qf[2][4], kf[4]; u32x4 kraw[4], vv[4];
    attn_ldkv(a, d, d.kmin, kraw, vv, lane);
    for (;;) {
        const LAS float* tph = (const LAS float*)((LAS unsigned char*)lds + MIX_BIAS_OFF) + (d.p * NH + (d.bh & 7)) * 192 + (32 + 4 * hi - t);
        f32x16 o[2][2] = {}; float m[2] = {0.f, 0.f}, l[2] = {0.f, 0.f};
        const int nitem = item + NGW; const bool hasn = nitem < NIT;
        AttnIt dn = d; if (hasn) attn_decode(nitem, x, dn);
#pragma unroll
        for (int j = 0; j < 2; ++j) { u32x4 qraw[4]; attn_ldrows((const bf16_t*)(ws + WS_AQ), d, d.q0 + 32 * j, qraw, lane); stage_rows_k(kslot, qraw, lane); asm volatile("" ::: "memory"); read_row_frags(qf[j], kslot, lane); asm volatile("" ::: "memory"); }
        for (int kk = d.kmin; kk <= d.kmax; ++kk) {
            const int kbase = d.q0 - 64 + 32 * kk;
#pragma unroll
            for (int i = 0; i < 4; ++i) *(LAS u32x4*)(slot + (rr + 8 * i) * VROW + ch * 16) = vv[i];
            stage_rows_k(kslot, kraw, lane);
            asm volatile("" ::: "memory");
            read_row_frags(kf, kslot, lane);
            const bf16x8 v00 = tr_frag(slot3, 0, 0, lane), v10 = tr_frag(slot3, 1, 0, lane), v01 = tr_frag(slot3, 0, 1, lane), v11 = tr_frag(slot3, 1, 1, lane);
            asm volatile("" ::: "memory");
            if (kk < d.kmax) attn_ldkv(a, d, kk + 1, kraw, vv, lane);
            else if (hasn) attn_ldkv(a, dn, dn.kmin, kraw, vv, lane);
            const bool edge = kbase < 0 || kbase + 31 >= d.L;
            f32x16 sc[2] = {};
#pragma unroll
            for (int st = 0; st < 4; ++st) { sc[0] = MFMA32(kf[st], qf[0][st], sc[0]); sc[1] = MFMA32(kf[st], qf[1][st], sc[1]); }
            float mx[2]; bool mv = false;
#pragma unroll
            for (int j = 0; j < 2; ++j) {
                const int kj = kk - j; const bool act = kj >= 0 && kj <= 4; const LAS float* tb = tph + 32 * (act ? kj : 0); const float moff = act ? m[j] : 1e30f;
#pragma unroll
                for (int rg = 0; rg < 16; ++rg) sc[j][rg] = (sc[j][rg] - moff) + tb[(rg & 3) + 8 * (rg >> 2)];
                if (edge) {
#pragma unroll
                    for (int rg = 0; rg < 16; ++rg) { const int ki = kbase + crow(rg, hi); sc[j][rg] = (ki >= 0 && ki < d.L) ? sc[j][rg] : -1e30f; } }
                float t0 = fmaxf(fmaxf(sc[j][0], sc[j][1]), fmaxf(sc[j][2], sc[j][3]));
#pragma unroll
                for (int rg = 4; rg < 16; rg += 4) t0 = fmaxf(t0, fmaxf(fmaxf(sc[j][rg], sc[j][rg + 1]), fmaxf(sc[j][rg + 2], sc[j][rg + 3])));
                mx[j] = max_halves(t0);
                const bool first = act && (kj == 0 || kk == d.kmin);
                mv = mv || first || (act && __any(mx[j] > THR));
            }
            if (mv) {
#pragma unroll
                for (int j = 0; j < 2; ++j) { const int kj = kk - j; const bool act = kj >= 0 && kj <= 4, first = act && (kj == 0 || kk == d.kmin);
                    const float dl = !act ? 0.f : (first ? mx[j] : fmaxf(mx[j], 0.f)), f = ex2(-dl); m[j] += dl; l[j] *= f;
#pragma unroll
                    for (int rg = 0; rg < 16; ++rg) { sc[j][rg] -= dl; o[j][0][rg] *= f; o[j][1][rg] *= f; } }
            }
#pragma unroll
            for (int j = 0; j < 2; ++j) { float ps0 = 0.f, ps1 = 0.f;
#pragma unroll
                for (int rg = 0; rg < 16; rg += 2) { sc[j][rg] = ex2(sc[j][rg]); sc[j][rg + 1] = ex2(sc[j][rg + 1]); ps0 += sc[j][rg]; ps1 += sc[j][rg + 1]; }
                l[j] += ps0 + ps1; }
            { const bf16x8 p00 = pack_p(sc[0], 0), p01 = pack_p(sc[0], 1), p10 = pack_p(sc[1], 0), p11 = pack_p(sc[1], 1);
              o[0][0] = MFMA32(v00, p00, o[0][0]); o[0][1] = MFMA32(v01, p00, o[0][1]); o[1][0] = MFMA32(v00, p10, o[1][0]); o[1][1] = MFMA32(v01, p10, o[1][1]);
              o[0][0] = MFMA32(v10, p01, o[0][0]); o[0][1] = MFMA32(v11, p01, o[0][1]); o[1][0] = MFMA32(v10, p11, o[1][0]); o[1][1] = MFMA32(v11, p11, o[1][1]); }
        }
#pragma unroll
        for (int j = 0; j < 2; ++j) {
            float lt = sum_halves(l[j]);
            const float il = 1.f / lt;
            const size_t orow = ((size_t)d.p * NB * NH + d.bh) * S + (size_t)(((d.q0 + 32 * j + t) << d.sh) + d.r);
#pragma unroll
            for (int g4 = 0; g4 < 4; ++g4) {
                *(LAS u32x2*)(kslot + t * KROW + (8 * g4 + 4 * hi) * 2) = (u32x2){pg8::cvt_pk_bf16(o[j][0][4 * g4] * il, o[j][0][4 * g4 + 1] * il), pg8::cvt_pk_bf16(o[j][0][4 * g4 + 2] * il, o[j][0][4 * g4 + 3] * il)};
                *(LAS u32x2*)(kslot + t * KROW + (32 + 8 * g4 + 4 * hi) * 2) = (u32x2){pg8::cvt_pk_bf16(o[j][1][4 * g4] * il, o[j][1][4 * g4 + 1] * il), pg8::cvt_pk_bf16(o[j][1][4 * g4 + 2] * il, o[j][1][4 * g4 + 3] * il)};
            }
            asm volatile("" ::: "memory");
            { bf16_t* ob = (bf16_t*)(ws + WS_ATTO) + ((size_t)d.p * NB * NH + d.bh) * S * HD;
#pragma unroll
              for (int i = 0; i < 4; ++i) { const u32x4 w = *(const LAS u32x4*)(kslot + (rr + 8 * i) * KROW + ch * 16);
                  *(u32x4*)(ob + (size_t)(((d.q0 + 32 * j + rr + 8 * i) << d.sh) + d.r) * HD + ch * 8) = w; } }
            asm volatile("" ::: "memory");
            if (hi == 0) ((float*)(ws + WS_ATTL))[orow] = m[j] + __log2f(lt);
        }
        if (!hasn) break;
        item = nitem; d = dn;
    }
}
DEV void retstate_item(const Args& a, unsigned char* lds, int item, int xg, int lane, int wave) {
    unsigned char* ws = a.ws;
    const int dir = item & 1, n = (item >> 1) & 31, bh = 8 * xg + (item >> 6), h = bh & 7;
    const bf16_t* Kc = (const bf16_t*)(ws + WS_RK) + ((size_t)bh * S + n * 128) * HD; const bf16_t* Vc = (const bf16_t*)(ws + WS_RV) + ((size_t)bh * S + n * 128) * HD;
    const float lg = a.in[IN_DECAY][dir * NH + h] * LOG2E;
    LAS unsigned char* vs = (LAS unsigned char*)lds + wave * MIX_WAVE_LDS; LAS unsigned char* ks = vs + VSLOT; lds_cptr vs3 = (lds_cptr)vs, ks3 = (lds_cptr)ks;
    f32x16 acc[2][2] = {};
    for (int blk = 0; blk < 4; ++blk) {
        { const int rr = lane >> 3, ch = lane & 7;
          u32x4 v[4], k[4];
#pragma unroll
          for (int i = 0; i < 4; ++i) { const int mrow = 32 * blk + rr + 8 * i; v[i] = *(const u32x4*)(Vc + (size_t)mrow * HD + ch * 8); k[i] = *(const u32x4*)(Kc + (size_t)mrow * HD + ch * 8); }
#pragma unroll
          for (int i = 0; i < 4; ++i) { const int mrow = 32 * blk + rr + 8 * i; const float z = ex2(lg * (float)(dir == 0 ? 127 - mrow : mrow));
              const unsigned kw[4] = {k[i].x, k[i].y, k[i].z, k[i].w}; u32x4 o;
              o.x = pg8::cvt_pk_bf16(bf2f(kw[0] & 0xffffu) * z, bf2f(kw[0] >> 16) * z); o.y = pg8::cvt_pk_bf16(bf2f(kw[1] & 0xffffu) * z, bf2f(kw[1] >> 16) * z);
              o.z = pg8::cvt_pk_bf16(bf2f(kw[2] & 0xffffu) * z, bf2f(kw[2] >> 16) * z); o.w = pg8::cvt_pk_bf16(bf2f(kw[3] & 0xffffu) * z, bf2f(kw[3] >> 16) * z);
              *(LAS u32x4*)(vs + (rr + 8 * i) * VROW + ch * 16) = v[i]; *(LAS u32x4*)(ks + (rr + 8 * i) * VROW + ch * 16) = o; } }
        LDS_WAIT();
#pragma unroll
        for (int s = 0; s < 2; ++s) {
            const bf16x8 v0 = tr_frag(vs3, s, 0, lane), v1 = tr_frag(vs3, s, 1, lane), k0 = tr_frag(ks3, s, 0, lane), k1 = tr_frag(ks3, s, 1, lane);
            acc[0][0] = MFMA32(v0, k0, acc[0][0]); acc[0][1] = MFMA32(v0, k1, acc[0][1]); acc[1][0] = MFMA32(v1, k0, acc[1][0]); acc[1][1] = MFMA32(v1, k1, acc[1][1]);
        }
        LDS_WAIT();
    }
    bf16_t* KT = (bf16_t*)(ws + WS_KF) + (((size_t)dir * NB * NH + bh) * 32 + n) * 4096;
    const int c = lane & 31, hi = lane >> 5;
#pragma unroll
    for (int eb = 0; eb < 2; ++eb)
#pragma unroll
        for (int db = 0; db < 2; ++db)
#pragma unroll
            for (int rg = 0; rg < 16; ++rg) KT[(32 * eb + crow(rg, hi)) * 64 + 32 * db + c] = (bf16_t)f2bf(acc[eb][db][rg]);
}
DEV void phase_scan(const Args& a, int gtid, int NT) {
    unsigned char* ws = a.ws;
    for (int sl = gtid; sl < 2 * NB * NH * 1024; sl += NT) {
        const int dir = sl >> 16, bh = (sl >> 10) & 63, q = sl & 1023, h = bh & 7;
        const float gC = ex2(a.in[IN_DECAY][dir * NH + h] * LOG2E * 128.f);
        const uint2* kt = (const uint2*)(ws + WS_KF) + ((size_t)dir * NB * NH + bh) * 32 * 1024 + q;
        uint2* st = (uint2*)(ws + WS_ST) + ((size_t)dir * NB * NH + bh) * 32 * 1024 + q;
        float4 s = make_float4(0.f, 0.f, 0.f, 0.f);
        for (int i = 0; i < 32; ++i) { const int n = dir == 0 ? i : 31 - i;
            st[(size_t)n * 1024] = make_uint2(pg8::cvt_pk_bf16(s.x, s.y), pg8::cvt_pk_bf16(s.z, s.w));
            const uint2 kv = kt[(size_t)n * 1024];
            s.x = gC * s.x + bf2f(kv.x & 0xffffu); s.y = gC * s.y + bf2f(kv.x >> 16); s.z = gC * s.z + bf2f(kv.y & 0xffffu); s.w = gC * s.w + bf2f(kv.y >> 16); }
    }
}
DEV void ld_rows32(const bf16_t* base, u32x4 (&v)[4], int lane) {
    const char* b = (const char*)base; const unsigned off = (unsigned)((lane >> 3) * 128 + (lane & 7) * 16);
#pragma unroll
    for (int i = 0; i < 4; ++i) v[i] = *(const u32x4*)(b + off + i * 1024);
}
DEV void retout_item(const Args& a, unsigned char* lds, int item, int xg, int lane, int wave) {
    unsigned char* ws = a.ws;
    const int hq = item & 1, n = (item >> 1) & 31, bh = 8 * xg + (item >> 6), h = bh & 7, b = bh >> 3;
    const bf16_t* Qc = (const bf16_t*)(ws + WS_RQ) + ((size_t)bh * S + n * 128) * HD; const bf16_t* Kc = (const bf16_t*)(ws + WS_RK) + ((size_t)bh * S + n * 128) * HD;
    const bf16_t* Vc = (const bf16_t*)(ws + WS_RV) + ((size_t)bh * S + n * 128) * HD; const bf16_t* Gc = (const bf16_t*)(ws + WS_RG) + ((size_t)bh * S + n * 128) * HD;
    const bf16_t* SF = (const bf16_t*)(ws + WS_ST) + (((size_t)0 * NB * NH + bh) * 32 + n) * 4096; const bf16_t* SB = (const bf16_t*)(ws + WS_ST) + (((size_t)1 * NB * NH + bh) * 32 + n) * 4096;
    const float lg0 = a.in[IN_DECAY][h] * LOG2E, lg1 = a.in[IN_DECAY][NH + h] * LOG2E;
    LAS unsigned char* slot = (LAS unsigned char*)lds + wave * MIX_WAVE_LDS; lds_cptr slot3 = (lds_cptr)slot; LAS unsigned char* kslot = slot + VSLOT;
    const int t = lane & 31, hi = lane >> 5, rr = lane >> 3, ch = lane & 7;
    bf16x8 qf[2][4];
#pragma unroll
    for (int j = 0; j < 2; ++j) { u32x4 raw[4]; ld_rows32(Qc + (size_t)(64 * hq + 32 * j) * HD, raw, lane); stage_rows_k(kslot, raw, lane); asm volatile("" ::: "memory"); read_row_frags(qf[j], kslot, lane); asm volatile("" ::: "memory"); }
    f32x16 o[2][2] = {};
#pragma unroll
    for (int dir = 0; dir < 2; ++dir) {
#pragma unroll
        for (int eb = 0; eb < 2; ++eb) { u32x4 raw[4]; bf16x8 sf[4]; ld_rows32((dir == 0 ? SF : SB) + (size_t)(32 * eb) * 64, raw, lane); stage_rows_k(kslot, raw, lane); asm volatile("" ::: "memory"); read_row_frags(sf, kslot, lane); asm volatile("" ::: "memory");
#pragma unroll
            for (int j = 0; j < 2; ++j)
#pragma unroll
                for (int st = 0; st < 4; ++st) o[j][eb] = MFMA32(sf[st], qf[j][st], o[j][eb]); }
#pragma unroll
        for (int j = 0; j < 2; ++j) { const int c = 64 * hq + 32 * j + t; const float f = dir == 0 ? ex2(lg0 * (float)(c + 1) - lg1 * (float)(128 - c)) : ex2(lg1 * (float)(128 - c));
#pragma unroll
            for (int rg = 0; rg < 16; ++rg) { o[j][0][rg] *= f; o[j][1][rg] *= f; } }
    }
    float f1[4], f2[4], b1[4], b2[4];
#pragma unroll
    for (int i = 0; i < 4; ++i) { f1[i] = __builtin_bit_cast(float, __builtin_amdgcn_readfirstlane(__builtin_bit_cast(int, ex2(-lg0 * (float)i)))); f2[i] = __builtin_bit_cast(float, __builtin_amdgcn_readfirstlane(__builtin_bit_cast(int, ex2(-lg0 * (float)(8 * i)))));
        b1[i] = __builtin_bit_cast(float, __builtin_amdgcn_readfirstlane(__builtin_bit_cast(int, ex2(lg1 * (float)i)))); b2[i] = __builtin_bit_cast(float, __builtin_amdgcn_readfirstlane(__builtin_bit_cast(int, ex2(lg1 * (float)(8 * i))))); }
#pragma nounroll
    for (int kb = 0; kb < 4; ++kb) {
        { u32x4 kraw[4], vv[4]; ld_rows32(Kc + (size_t)(32 * kb) * HD, kraw, lane); ld_rows32(Vc + (size_t)(32 * kb) * HD, vv, lane);
#pragma unroll
        for (int i = 0; i < 4; ++i) *(LAS u32x4*)(slot + (rr + 8 * i) * VROW + ch * 16) = vv[i];
        stage_rows_k(kslot, kraw, lane); }
        asm volatile("" ::: "memory");
        bf16x8 kf[4]; read_row_frags(kf, kslot, lane);
        const bf16x8 v00 = tr_frag(slot3, 0, 0, lane), v10 = tr_frag(slot3, 1, 0, lane), v01 = tr_frag(slot3, 0, 1, lane), v11 = tr_frag(slot3, 1, 1, lane);
        asm volatile("" ::: "memory");
#pragma unroll
        for (int j = 0; j < 2; ++j) {
            const int qbi = 2 * hq + j;
            f32x16 sc = {};
#pragma unroll
            for (int st = 0; st < 4; ++st) sc = MFMA32(kf[st], qf[j][st], sc);
            if (kb < qbi) { const float A = ex2(lg0 * (float)(32 * (qbi - kb) + t - 4 * hi)); float a2[4];
#pragma unroll
                for (int q = 0; q < 4; ++q) a2[q] = A * f2[q];
#pragma unroll
                for (int rg = 0; rg < 16; ++rg) sc[rg] *= a2[rg >> 2] * f1[rg & 3];
            } else if (kb > qbi) { const float A = ex2(lg1 * (float)(32 * (kb - qbi) - t + 4 * hi)); float a2[4];
#pragma unroll
                for (int q = 0; q < 4; ++q) a2[q] = A * b2[q];
#pragma unroll
                for (int rg = 0; rg < 16; ++rg) sc[rg] *= a2[rg >> 2] * b1[rg & 3];
            } else {
                int tt = t - 4 * hi; asm volatile("" : "+v"(tt));
#pragma unroll
                for (int rg = 0; rg < 16; ++rg) { const int df = tt - ((rg & 3) + 8 * (rg >> 2)); sc[rg] *= df >= 0 ? ex2(lg0 * (float)df) : ex2(lg1 * (float)(-df)); }
            }
            const bf16x8 p0 = pack_p(sc, 0), p1 = pack_p(sc, 1);
            o[j][0] = MFMA32(v00, p0, o[j][0]); o[j][0] = MFMA32(v10, p1, o[j][0]);
            o[j][1] = MFMA32(v01, p0, o[j][1]); o[j][1] = MFMA32(v11, p1, o[j][1]);
        }
    }
    const float* gn = a.in[IN_GN] + h * HD; const unsigned gnoff = (unsigned)(16 * hi); LAS unsigned char* kq = kslot + t * KROW + 8 * hi;
#pragma unroll
    for (int j = 0; j < 2; ++j) {
        const int r0 = n * 128 + 64 * hq + 32 * j;
        { u32x4 raw[4]; ld_rows32(Gc + (size_t)(64 * hq + 32 * j) * HD, raw, lane); stage_rows_k(kslot, raw, lane); asm volatile("" ::: "memory"); }
        float sm = 0.f;
#pragma unroll
        for (int rg = 0; rg < 16; ++rg) sm += o[j][0][rg] + o[j][1][rg];
        sm = sum_halves(sm); const float mu = sm * (1.f / 64.f); float vq = 0.f;
#pragma unroll
        for (int rg = 0; rg < 16; ++rg) { const float d0 = o[j][0][rg] - mu, d1 = o[j][1][rg] - mu; vq += d0 * d0 + d1 * d1; }
        vq = sum_halves(vq); const float rstd = rsqrtf(vq * (1.f / 64.f) + EPS);
        u32x2 ow[2][4];
#pragma unroll
        for (int db = 0; db < 2; ++db)
#pragma unroll
            for (int g4 = 0; g4 < 4; ++g4) { const u32x2 gw = *(const LAS u32x2*)(kq + (32 * db + 8 * g4) * 2); const float4 gg = *(const float4*)((const char*)gn + gnoff + (32 * db + 8 * g4) * 4);
                const float gate[4] = {bf2f(gw[0] & 0xffffu), bf2f(gw[0] >> 16), bf2f(gw[1] & 0xffffu), bf2f(gw[1] >> 16)}; const float gv[4] = {gg.x, gg.y, gg.z, gg.w}; float ov[4];
#pragma unroll
                for (int i = 0; i < 4; ++i) ov[i] = (o[j][db][4 * g4 + i] - mu) * rstd * gv[i] * (gate[i] * __builtin_amdgcn_rcpf(1.f + ex2(-gate[i] * LOG2E)));
                ow[db][g4] = (u32x2){pg8::cvt_pk_bf16(ov[0], ov[1]), pg8::cvt_pk_bf16(ov[2], ov[3])}; }
        asm volatile("" ::: "memory");
#pragma unroll
        for (int db = 0; db < 2; ++db)
#pragma unroll
            for (int g4 = 0; g4 < 4; ++g4) *(LAS u32x2*)(kq + (32 * db + 8 * g4) * 2) = ow[db][g4];
        asm volatile("" ::: "memory");
        { bf16_t* ob = (bf16_t*)(ws + WS_XN) + ((size_t)b * S + r0) * D + h * HD;
#pragma unroll
          for (int i = 0; i < 4; ++i) { const u32x4 w = *(const LAS u32x4*)(kslot + (rr + 8 * i) * KROW + ch * 16); *(u32x4*)(ob + (size_t)(rr + 8 * i) * D + ch * 8) = w; } }
        asm volatile("" ::: "memory");
    }
}
DEV void phase_attn_merge(const Args& a, int gtid, int NT) {
    unsigned char* ws = a.ws; const float* L = (const float*)(ws + WS_ATTL); const bf16_t* O = (const bf16_t*)(ws + WS_ATTO); bf16_t* mixed = (bf16_t*)(ws + WS_XN);
    for (int it = gtid; it < NB * NH * S * 8; it += NT) {
        const int ch = it & 7, row = it >> 3;
        const int bh = row >> 12, pos = row & 4095, b = bh >> 3, h = bh & 7;
        const float l0 = L[row], l1 = L[(size_t)NB * NH * S + row], l2 = L[(size_t)2 * NB * NH * S + row];
        const float mx = fmaxf(l0, fmaxf(l1, l2)); float w0 = ex2(l0 - mx), w1 = ex2(l1 - mx), w2 = ex2(l2 - mx); const float is = 1.f / (w0 + w1 + w2); w0 *= is; w1 *= is; w2 *= is;
        const uint4 a0 = *(const uint4*)(O + (size_t)row * HD + ch * 8), a1 = *(const uint4*)(O + ((size_t)NB * NH * S + row) * HD + ch * 8), a2 = *(const uint4*)(O + ((size_t)2 * NB * NH * S + row) * HD + ch * 8);
        const unsigned x0[4] = {a0.x, a0.y, a0.z, a0.w}, x1[4] = {a1.x, a1.y, a1.z, a1.w}, x2[4] = {a2.x, a2.y, a2.z, a2.w}; unsigned o[4];
#pragma unroll
        for (int j = 0; j < 4; ++j) o[j] = pg8::cvt_pk_bf16(w0 * bf2f(x0[j] & 0xffffu) + w1 * bf2f(x1[j] & 0xffffu) + w2 * bf2f(x2[j] & 0xffffu), w0 * bf2f(x0[j] >> 16) + w1 * bf2f(x1[j] >> 16) + w2 * bf2f(x2[j] >> 16));
        *(uint4*)(mixed + ((size_t)b * S + pos) * D + 512 + h * HD + ch * 8) = make_uint4(o[0], o[1], o[2], o[3]);
    }
}
DEV void phase_mix_a(const Args& a, unsigned char* lds, int wg, int G, int lane, int wave, int tid) {
    { const float* bt = (const float*)(a.ws + WS_BIAS); LAS float* bl = (LAS float*)((LAS unsigned char*)lds + MIX_BIAS_OFF);
      for (int i = tid; i < 3 * NH * 192; i += NTHR) { const int ph = i / 192, bi = i % 192 - 32; bl[i] = (bi >= 0 && bi <= 128) ? bt[ph * 129 + bi] : -1e30f; } }
    __syncthreads();
    if (wave >= NWM) {
        for (int rep = 0; rep < a.rep[5]; ++rep) { asm volatile("" : "+v"(lane)); phase_latew(a, lds, wg * (NWAVES - NWM) + (wave - NWM), G * (NWAVES - NWM), lane, wave); }
        return;
    }
    const int x = wg & 7, wq = (wg >> 3) * NWM + wave, WPX = (G >> 3) * NWM;
    for (int rep = 0; rep < a.rep[0]; ++rep) { asm volatile("" : "+v"(lane)); for (int it = wq; it < 2 * 32 * NH; it += WPX) retstate_item(a, lds, it, x, lane, wave); }
    for (int rep = 0; rep < a.rep[1]; ++rep) { asm volatile("" : "+v"(lane)); attn_items(a, lds, wg, G, lane, wave); }
}
DEV void phase_mix_b(const Args& a, unsigned char* lds, int wg, int G, int lane, int wave, int tid) {
    const int x = wg & 7, wq = (wg >> 3) * NWAVES + wave, WPX = (G >> 3) * NWAVES;
    for (int rep = 0; rep < a.rep[2]; ++rep) { asm volatile("" : "+v"(lane)); for (int it = wq; it < NH * 32 * 2; it += WPX) retout_item(a, lds, it, x, lane, wave); }
    for (int rep = 0; rep < a.rep[3]; ++rep) { asm volatile("" : "+v"(tid)); phase_attn_merge(a, wg * NTHR + tid, G * NTHR); }
}
#define XB_TMO      128
#define XB_XCNT(j)  (256  + 64 * (j))
#define XB_XSUB(j)  (1280 + 64 * (j))
#define XB_XGEN(j)  (2304 + 64 * (j))
#define XB_TOP      3328
#define XB_TOPGEN   3392
#define XCD_BAR_WORDS 3456
#define XB_SPIN_CAP (1u << 18)

__device__ __forceinline__ unsigned xb_ld(unsigned* p)              { return __hip_atomic_load(p, __ATOMIC_RELAXED, __HIP_MEMORY_SCOPE_AGENT); }
__device__ __forceinline__ unsigned xb_add(unsigned* p, unsigned v) { return __hip_atomic_fetch_add(p, v, __ATOMIC_RELAXED, __HIP_MEMORY_SCOPE_AGENT); }
__device__ __forceinline__ unsigned xb_xcc_id() { return (unsigned)__builtin_amdgcn_s_getreg((3 << 11) | 20) & 0xFu; }
#define XB_SPIN(cond, bar) do { unsigned _sp = 0; while (cond) { __builtin_amdgcn_s_sleep(1); \
    if ((++_sp & 255u) == 0u) { if (xb_ld(&(bar)[XB_TMO])) break; if (_sp > XB_SPIN_CAP) { atomicAdd(&(bar)[XB_TMO], 1u); break; } } } } while (0)

struct XcdBarrier {
    unsigned* bar; unsigned x;
    volatile LAS unsigned* st;
};

__device__ __forceinline__ XcdBarrier xcd_barrier_post(unsigned* bar, volatile LAS unsigned* st) {
    XcdBarrier b; b.bar = bar; b.x = xb_xcc_id(); b.st = st;
    if (threadIdx.x == 0) (void)xb_add(&bar[XB_XCNT(b.x)], 1u);
    return b;
}
__device__ __forceinline__ void xcd_barrier_complete(unsigned* bar, unsigned x, unsigned& nloc, unsigned& nx) {
    const unsigned G = gridDim.x * gridDim.y * gridDim.z;
    unsigned sum, cnt, mine, sp = 0u;
    for (;;) {
        sum = 0u; cnt = 0u; mine = 0u;
#pragma unroll
        for (unsigned j = 0; j < 16; ++j) { const unsigned c = xb_ld(&bar[XB_XCNT(j)]); sum += c; cnt += (c > 0u) ? 1u : 0u; mine = (j == x) ? c : mine; }
        if (sum == G) break;
        __builtin_amdgcn_s_sleep(1);
        if ((++sp & 255u) == 0u) { if (xb_ld(&bar[XB_TMO])) break; if (sp > XB_SPIN_CAP) { atomicAdd(&bar[XB_TMO], 1u); break; } }
    }
    nloc = mine > 0u ? mine : 1u; nx = cnt > 0u ? cnt : 1u;
}

__device__ __forceinline__ void xcd_barrier(const XcdBarrier& b) {
    asm volatile("s_waitcnt vmcnt(0)" ::: "memory");
    __syncthreads();
    if (threadIdx.x == 0) {
        unsigned* bar = b.bar;
        __builtin_amdgcn_s_waitcnt(0);
        unsigned nloc = b.st[0], nx = b.st[1];
        if (nloc == 0u) { xcd_barrier_complete(bar, b.x, nloc, nx); b.st[0] = nloc; b.st[1] = nx; }
        const unsigned old = xb_add(&bar[XB_XSUB(b.x)], 1u);
        const unsigned gen = old / nloc;
        if (old + 1u == (gen + 1u) * nloc) {
            __builtin_amdgcn_fence(__ATOMIC_RELEASE, "agent");
            asm volatile("s_waitcnt vmcnt(0)" ::: "memory");
            const unsigned og = xb_add(&bar[XB_TOP], 1u);
            const unsigned tg = og / nx;
            if (og + 1u == (tg + 1u) * nx) xb_add(&bar[XB_TOPGEN], 1u);
            else XB_SPIN(xb_ld(&bar[XB_TOPGEN]) == tg, bar);
            __builtin_amdgcn_fence(__ATOMIC_ACQUIRE, "agent");
            xb_add(&bar[XB_XGEN(b.x)], 1u);
            asm volatile("s_waitcnt vmcnt(0)" ::: "memory");
        } else {
            XB_SPIN(xb_ld(&bar[XB_XGEN(b.x)]) == gen, bar);
            __builtin_amdgcn_fence(__ATOMIC_ACQUIRE, "agent");
            asm volatile("s_waitcnt vmcnt(0)" ::: "memory");
        }
    }
    __syncthreads();
}

#ifndef MK_LAUNCHES
#define MK_LAUNCHES 1
#endif
#ifndef WGM_MOE1
#define WGM_MOE1 8
#endif
#ifndef WGM_MOE2
#define WGM_MOE2 8
#endif
constexpr int NPH = 11;
typedef const __attribute__((address_space(4))) Args* kargs_t;
DEV Args load_args(kargs_t kp) { Args a;
#pragma unroll
    for (int i = 0; i < 13; ++i) a.in[i] = kp->in[i];
    a.out = kp->out; a.ws = kp->ws; a.ph_lo = kp->ph_lo; a.ph_hi = kp->ph_hi;
#pragma unroll
    for (int i = 0; i < 16; ++i) a.rep[i] = kp->rep[i];
    return a; }
#ifndef PROBE_REP
#define PROBE_REP 0
#endif
#define REP(k) if (((PROBE_REP) >> (k)) & 1) for (int _r = 0; _r < 2; ++_r, cg::this_grid().sync())
__global__ void __launch_bounds__(NTHR, 2) mega(Args a_) {
    kargs_t kp = (kargs_t)__builtin_amdgcn_kernarg_segment_ptr();
    extern __shared__ __attribute__((aligned(16))) unsigned char lds[];
    int tid = threadIdx.x, lane = tid & 63, wave = __builtin_amdgcn_readfirstlane(tid >> 6);
    const int G = gridDim.x, wg = blockIdx.x, NGW = G * NWAVES; int gw = wg * NWAVES + wave;
#define FRESH_IDS() do { tid = threadIdx.x; asm volatile("" : "+v"(tid)); lane = tid & 63; wave = __builtin_amdgcn_readfirstlane(tid >> 6); gw = wg * NWAVES + wave; } while (0)
    const int lo = kp->ph_lo, hi = kp->ph_hi;
    unsigned char* ws = kp->ws;
    volatile LAS unsigned* bst = (volatile LAS unsigned*)((LAS unsigned char*)lds + LDS_BYTES - 64);
    if (tid < 2) bst[tid] = 0u;
    __syncthreads();
    XcdBarrier bar = xcd_barrier_post((unsigned*)(ws + WS_CTL) + 4096, bst);
#define IN(k) (lo <= (k) && (k) < hi)
#define SEAM(k) do { if (IN(k) && IN((k) + 1)) { xcd_barrier(bar); } } while (0)
    if (IN(0)) { FRESH_IDS(); const Args a = load_args(kp); unsigned char* ws = a.ws; for (int r = 0; r < a.rep[6]; ++r) { FRESH_IDS(); phase_prep(a, lds, gw, NGW, lane, wave); } }
    SEAM(0);
    if (IN(1)) { FRESH_IDS(); const Args a = load_args(kp); unsigned char* ws = a.ws; pg8::Gemm g{(const bf16_t*)(ws + WS_XN), (const bf16_t*)(ws + WS_WIN), D}; SchedPlain Sc; Sc.init(M, PC, G, wg); Sc.rowbytes = D * 2;
        EpiInProj E{ws, (const float*)(ws + WS_ROPE)};
        for (int r = 0; r < a.rep[8]; ++r) { FRESH_IDS(); pg8::Gemm g2 = g; asm volatile("" : "+s"(g2.A), "+s"(g2.Bt)); pg8::gemm_phase<EpiInProj, SchedPlain, true>((LAS unsigned char*)lds, g2, Sc, E); } }
    SEAM(1);
    if (IN(2)) { FRESH_IDS(); const Args a = load_args(kp); unsigned char* ws = a.ws; phase_mix_a(a, lds, wg, G, lane, wave, tid); }
    SEAM(2);
    if (IN(3)) { FRESH_IDS(); const Args a = load_args(kp); unsigned char* ws = a.ws; for (int r = 0; r < a.rep[13]; ++r) { FRESH_IDS(); phase_scan(a, wg * NTHR + tid, G * NTHR); } }
    SEAM(3);
    if (IN(4)) { FRESH_IDS(); const Args a = load_args(kp); unsigned char* ws = a.ws; phase_mix_b(a, lds, wg, G, lane, wave, tid); }
    SEAM(4);
    { const Args a = load_args(kp); for (int r = 0; r < a.rep[14]; ++r) xcd_barrier(bar); for (int r = 0; r < a.rep[15]; ++r) cg::this_grid().sync(); }
    if (IN(5)) { FRESH_IDS(); const Args a = load_args(kp); unsigned char* ws = a.ws; pg8::Gemm g{(const bf16_t*)(ws + WS_XN), (const bf16_t*)(ws + WS_WOUT), D}; SchedPlain Sc; Sc.init(M, D, G, wg); Sc.rowbytes = D * 2;
        EpiOutProj E{a.in[IN_X], (bf16_t*)(ws + WS_X1)};
        for (int r = 0; r < a.rep[9]; ++r) { FRESH_IDS(); pg8::Gemm g2 = g; asm volatile("" : "+s"(g2.A), "+s"(g2.Bt)); pg8::gemm_phase<EpiOutProj, SchedPlain, true>((LAS unsigned char*)lds, g2, Sc, E); } }
    SEAM(5);
    if (IN(6)) { FRESH_IDS(); const Args a = load_args(kp); unsigned char* ws = a.ws; for (int r = 0; r < a.rep[4]; ++r) { FRESH_IDS(); phase_router(a, lds, gw, NGW, lane, tid); } }
    SEAM(6);
    if (IN(7)) { FRESH_IDS(); const Args a = load_args(kp); unsigned char* ws = a.ws; for (int r = 0; r < a.rep[7]; ++r) { FRESH_IDS(); phase_topk(a, lds, wg, G, tid, lane, wave); } }
    SEAM(7);
    if (IN(8)) { FRESH_IDS(); const Args a = load_args(kp); unsigned char* ws = a.ws; pg8::Gemm g{(const bf16_t*)(ws + WS_XN), (const bf16_t*)(ws + WS_WGU), D}; SchedMoe1 Sc; Sc.init(MR, 4096, G, wg, WGM_MOE1); Sc.idxl = (const LAS int*)((LAS unsigned char*)lds + 131072);
        { const int* idxg = (const int*)(ws + WS_IDX); LAS int* il = (LAS int*)((LAS unsigned char*)lds + 131072); pg8::Unit uu;
          for (int i = 0; i < 16; ++i) if (Sc.next(i, uu) && tid < 256) il[i * 256 + tid] = idxg[uu.pm * 256 + tid];
          __syncthreads(); }
        EpiSwiGLU E{ws + WS_HID};
        for (int r = 0; r < a.rep[10]; ++r) { FRESH_IDS(); pg8::Gemm g2 = g; asm volatile("" : "+s"(g2.A), "+s"(g2.Bt)); pg8::gemm_phase<EpiSwiGLU, SchedMoe1, true, true>((LAS unsigned char*)lds, g2, Sc, E); } }
    SEAM(8);
    if (IN(9)) { FRESH_IDS(); const Args a = load_args(kp); unsigned char* ws = a.ws; pg8::Gemm g{(const bf16_t*)(ws + WS_HID), (const bf16_t*)(ws + WS_WD), DFF}; SchedMoe2 Sc; Sc.init(MR, D, G, wg, WGM_MOE2);
        EpiDown E{ws + WS_Y};
        for (int r = 0; r < a.rep[11]; ++r) { FRESH_IDS(); pg8::Gemm g2 = g; asm volatile("" : "+s"(g2.A), "+s"(g2.Bt)); pg8::gemm_phase<EpiDown, SchedMoe2, true, true>((LAS unsigned char*)lds, g2, Sc, E); } }
    SEAM(9);
    if (IN(10)) { FRESH_IDS(); const Args a = load_args(kp); unsigned char* ws = a.ws; for (int r = 0; r < a.rep[12]; ++r) { FRESH_IDS(); phase_final(a, gw, NGW, lane); } }
#undef IN
#undef SEAM
}

extern "C" void kernel_launch(void* const* d_in, const int* in_sizes, int n_in, void* d_out, int out_size, void* d_ws, size_t ws_size, hipStream_t stream) {
    static int grid = 0;
    if (grid == 0) {
        if (n_in != 13 || in_sizes[0] != M * D || out_size != M * D || ws_size < WS_END) { fprintf(stderr, "kernel_launch: unexpected shapes n_in %d in0 %d out %d ws %zu (need %zu)\n", n_in, n_in > 0 ? in_sizes[0] : -1, out_size, ws_size, (size_t)WS_END); grid = -1; return; }
        int dev = 0, cus = 0, per_cu = 0;
        (void)hipGetDevice(&dev); (void)hipDeviceGetAttribute(&cus, hipDeviceAttributeMultiprocessorCount, dev);
        (void)hipFuncSetAttribute((const void*)mega, hipFuncAttributeMaxDynamicSharedMemorySize, LDS_BYTES);
        if (hipOccupancyMaxActiveBlocksPerMultiprocessor(&per_cu, (const void*)mega, NTHR, LDS_BYTES) != hipSuccess || per_cu < 1) { fprintf(stderr, "kernel_launch: occupancy query says %d blocks/CU\n", per_cu); per_cu = 1; }
        (void)hipGetLastError();
        grid = cus * 1;
        if (grid > cus * per_cu) grid = cus * per_cu;
    }
    if (grid < 0) return;
    (void)hipMemsetAsync((char*)d_ws + WS_CTL, 0, 1 * MiB, stream);
    Args a{};
    for (int i = 0; i < 13; ++i) a.in[i] = (const float*)d_in[i];
    a.out = (float*)d_out; a.ws = (unsigned char*)d_ws;
#ifndef PROBE_R
#define PROBE_R {1, 1, 1, 1, 1, 1, 1, 1, 1, 1, 1, 1, 1, 1, 0, 0}
#endif
    { const int rr[16] = PROBE_R; for (int i = 0; i < 16; ++i) a.rep[i] = rr[i]; }
#if MK_LAUNCHES == 1
    a.ph_lo = 0; a.ph_hi = NPH;
    void* args[] = {&a};
    hipError_t e = hipLaunchCooperativeKernel((const void*)mega, dim3(grid), dim3(NTHR), args, LDS_BYTES, stream);
    if (e != hipSuccess) fprintf(stderr, "cooperative launch failed: %s (grid %d)\n", hipGetErrorString(e), grid);
#else
    for (int p = 0; p < NPH; ++p) { a.ph_lo = p; a.ph_hi = p + 1; hipLaunchKernelGGL(mega, dim3(grid), dim3(NTHR), LDS_BYTES, stream, a); }
#endif
}
```

```cpp
#include <hip/hip_runtime.h>
#include <hip/hip_cooperative_groups.h>
#include <cstdint>
#include <cstdio>
namespace cg = cooperative_groups;

typedef unsigned short bf16_t;
#define DEV __device__ __forceinline__
#define LAS __attribute__((address_space(3)))

constexpr int NB = 8, S = 4096, D = 1024, M = NB * S;
constexpr int NH = 8, HD = 64, PC = 3584;
constexpr int NE = 16, CAP = 512, DFF = 2048, MR = NE * NB * CAP;
constexpr float EPS = 1e-6f, LOG2E = 1.4426950408889634f;
constexpr int NWAVES = 8, NTHR = 512;
constexpr int LDS_BYTES = 163840;

constexpr size_t MiB = 1u << 20;
constexpr size_t WS_CTL = 0;
constexpr size_t WS_ROPE = 1 * MiB;
constexpr size_t WS_BIAS = 2 * MiB;
constexpr size_t WS_IDX = 2 * MiB + 512 * 1024;
constexpr size_t WS_AFF = 3 * MiB;
constexpr size_t WS_INV = 5 * MiB;
constexpr size_t WS_AFFT = 9 * MiB;
constexpr size_t WS_WOUT = 7 * MiB;
constexpr size_t WS_WIN = 9 * MiB;
constexpr size_t WS_XN = 16 * MiB;
constexpr size_t WS_RQ = 80 * MiB, WS_RK = 112 * MiB, WS_RV = 144 * MiB, WS_RG = 176 * MiB;
constexpr size_t WS_AQ = 208 * MiB, WS_AK = 240 * MiB, WS_AV = 272 * MiB;
constexpr size_t WS_ATTO = 304 * MiB;
constexpr size_t WS_ATTL = 3 * MiB;
constexpr size_t WS_KF = 400 * MiB;
constexpr size_t WS_X1 = 80 * MiB;
constexpr size_t WS_ST = 208 * MiB;
constexpr size_t WS_WD = 432 * MiB;
constexpr size_t WS_WGU = 464 * MiB;
constexpr size_t WS_Y = 144 * MiB;
constexpr size_t WS_HID = 272 * MiB;
constexpr size_t WS_END = 528 * MiB;

DEV unsigned f2bf(float f) { unsigned u = __float_as_uint(f); return (u + 0x7fffu + ((u >> 16) & 1u)) >> 16; }
DEV float bf2f(unsigned h) { return __uint_as_float(h << 16); }
DEV unsigned pk2(float lo, float hi) { return f2bf(lo) | (f2bf(hi) << 16); }
#define DPPF(x, ctrl) __builtin_bit_cast(float, __builtin_amdgcn_update_dpp(__builtin_bit_cast(int, (x)), __builtin_bit_cast(int, (x)), (ctrl), 0xF, 0xF, false))
DEV float lane_x1(float x) { return DPPF(x, 0xB1); }
DEV float lane_x2(float x) { return DPPF(x, 0x4E); }
DEV float lane_m8(float x) { return DPPF(x, 0x141); }
DEV float lane_x8(float x) { return DPPF(x, 0x128); }
DEV float lane_x16(float x) { const auto r = __builtin_amdgcn_permlane16_swap(__float_as_uint(x), __float_as_uint(x), false, false); return (threadIdx.x & 16) ? __uint_as_float(r[0]) : __uint_as_float(r[1]); }
DEV float lane_x32(float x) { const auto r = __builtin_amdgcn_permlane32_swap(__float_as_uint(x), __float_as_uint(x), false, false); return (threadIdx.x & 32) ? __uint_as_float(r[0]) : __uint_as_float(r[1]); }
DEV float wave_sum(float v) {
    v += lane_x1(v); v += lane_x2(v); v += lane_m8(v); v += lane_x8(v); v += lane_x16(v); v += lane_x32(v);
    return v;
}
#define LDS_WAIT() asm volatile("s_waitcnt lgkmcnt(0)" ::: "memory")
namespace pg8 {
#define PG8_LAS __attribute__((address_space(3)))
typedef short bf16x8 __attribute__((ext_vector_type(8)));
typedef float f32x4 __attribute__((ext_vector_type(4)));
typedef unsigned u32x4 __attribute__((ext_vector_type(4)));
constexpr int BM = 256, BK = 64, HALF = 128, HTB = HALF * BK * 2, STAGE_BYTES = 8 * HTB, NXCD = 8, WGM = 8;
__host__ __device__ __forceinline__ int lds_byte(int r, int c) { const int st = (r >> 4) * 2 + (c >> 5), rr = r & 15, cc = c & 31, ob = rr * 64 + cc * 2; return st * 1024 + (ob ^ (((ob >> 9) & 1) << 5)); }
__host__ __device__ __forceinline__ void stage_rc(int b, int& R, int& C) { const int st = b / 1024, sb = b % 1024, swz = sb ^ (((sb >> 9) & 1) << 5); R = (st >> 1) * 16 + swz / 64; C = (st & 1) * 32 + (swz % 64) / 2; }
__host__ __device__ __forceinline__ int perm32(int rho) { const int n = rho >> 4, i = rho & 15; return 8 * (i >> 2) + 4 * n + (i & 3); }
struct Unit { int pm, pn, ui; };
struct Gemm { const bf16_t* A; const bf16_t* Bt; int K; };
struct StaticOrder {
    int nM, nN, nwg, G, c, wgm;
    __device__ void init(int M_, int N_, int G_, int c_, int wgm_ = WGM) { nM = M_ / BM; nN = N_ / BM; nwg = nM * nN; G = G_; c = c_; wgm = wgm_; }
    __device__ bool next(int i, Unit& u) const {
        const long L = (long)i * G + c; if (L >= nwg) return false;
        int wgid = (int)L; { const int q = nwg / NXCD, r = nwg % NXCD, xcd = wgid % NXCD, off = wgid / NXCD; wgid = (xcd < r ? xcd * (q + 1) : r * (q + 1) + (xcd - r) * q) + off; }
        const int nig = wgm * nN, gid = wgid / nig, fm = gid * wgm, gsz = (nM - fm) < wgm ? (nM - fm) : wgm;
        u.pm = fm + ((wgid % nig) % gsz); u.pn = (wgid % nig) / gsz; return true;
    }
};
__device__ __forceinline__ unsigned cvt_pk_bf16(float lo, float hi) { unsigned r; asm volatile("v_cvt_pk_bf16_f32 %0, %1, %2" : "=v"(r) : "v"(lo), "v"(hi)); return r; }

typedef int v8i __attribute__((ext_vector_type(8)));
template <class Epi, class Sched, bool ALIGN_EPI, bool FP8 = false>
__device__ __forceinline__ void gemm_phase(PG8_LAS unsigned char* lds, const Gemm g, const Sched& S, const Epi& E) {
    const int tid = threadIdx.x, wid = __builtin_amdgcn_readfirstlane(tid >> 6), lane = tid & 63, wr = wid >> 2, wc = wid & 3, fr = lane & 15, fq = lane >> 4;
    const int K = g.K, RB = FP8 ? K : 2 * K, nt = RB / 128;
    unsigned voffB[2];
#pragma unroll
    for (int i = 0; i < 2; ++i) { int R, C; stage_rc(tid * 16 + i * 8192, R, C); const int Rb = Epi::PERM ? ((R & ~31) + perm32(R & 31)) : R;
        voffB[i] = (unsigned)(Rb * RB + C * 2); }
    const size_t kstep = (size_t)(BK * 2);
    const size_t hstep = (size_t)HALF * RB;
    const size_t tstep = 2 * hstep;
    const unsigned ldsw = (unsigned)wid * 1024u;
    const int aoff = FP8 ? lds_byte(wr * 64 + fr, fq * 16) : lds_byte(wr * 64 + fr, fq * 8), boff = FP8 ? lds_byte(wc * 32 + fr, fq * 16) : lds_byte(wc * 32 + fr, fq * 8);
    const int x16 = 16 * (fq & 1);
    const char* gA = (const char*)g.A;
#define PG8_SA(b, h) (((b) * 2 + (h)) * HTB)
#define PG8_SB(b, h) ((4 + (b) * 2 + (h)) * HTB)
#define PG8_STAGE(bufoff, gbase, voff) do { _Pragma("unroll") for (int _i = 0; _i < 2; ++_i) \
        __builtin_amdgcn_global_load_lds((const unsigned*)((const char*)(gbase) + (voff)[_i]), (PG8_LAS unsigned*)(lds + (bufoff) + ldsw + _i * 8192), 16, 0, 0); } while (0)
#define PG8_STAGE_A(bufoff, AO, h, kb) do { _Pragma("unroll") for (int _i = 0; _i < 2; ++_i) \
        __builtin_amdgcn_global_load_lds((const unsigned*)(gA + (size_t)((AO)[h][_i] + (unsigned)(kb))), (PG8_LAS unsigned*)(lds + (bufoff) + ldsw + _i * 8192), 16, 0, 0); } while (0)
#define PG8_LDA(dst, b, h) do { if constexpr (FP8) { _Pragma("unroll") for (int m = 0; m < 4; ++m) { dst[m][0] = *(const PG8_LAS bf16x8*)(lds + PG8_SA(b, h) + aoff + m * 2048 + x16); dst[m][1] = *(const PG8_LAS bf16x8*)(lds + PG8_SA(b, h) + aoff + m * 2048 + 16 - x16); } } \
    else { _Pragma("unroll") for (int m = 0; m < 4; ++m) _Pragma("unroll") for (int k = 0; k < 2; ++k) dst[m][k] = *(const PG8_LAS bf16x8*)(lds + PG8_SA(b, h) + aoff + m * 2048 + k * 1024); } } while (0)
#define PG8_LDB(dst, b, h) do { if constexpr (FP8) { _Pragma("unroll") for (int n = 0; n < 2; ++n) { dst[n][0] = *(const PG8_LAS bf16x8*)(lds + PG8_SB(b, h) + boff + n * 2048 + x16); dst[n][1] = *(const PG8_LAS bf16x8*)(lds + PG8_SB(b, h) + boff + n * 2048 + 16 - x16); } } \
    else { _Pragma("unroll") for (int n = 0; n < 2; ++n) _Pragma("unroll") for (int k = 0; k < 2; ++k) dst[n][k] = *(const PG8_LAS bf16x8*)(lds + PG8_SB(b, h) + boff + n * 2048 + k * 1024); } } while (0)
#define PG8_CAT8(x) __builtin_bit_cast(v8i, __builtin_shufflevector((x)[0], (x)[1], 0, 1, 2, 3, 4, 5, 6, 7, 8, 9, 10, 11, 12, 13, 14, 15))
#define PG8_MMA(ai, bj, At, Bt) do { __builtin_amdgcn_s_setprio(1); if constexpr (FP8) { _Pragma("unroll") for (int m = 0; m < 4; ++m) _Pragma("unroll") for (int n = 0; n < 2; ++n) \
        acc[ai][bj][m][n] = __builtin_amdgcn_mfma_scale_f32_16x16x128_f8f6f4(PG8_CAT8(Bt[n]), PG8_CAT8(At[m]), acc[ai][bj][m][n], 0, 0, 0, 0, 0, 0); } \
    else { _Pragma("unroll") for (int m = 0; m < 4; ++m) _Pragma("unroll") for (int n = 0; n < 2; ++n) _Pragma("unroll") for (int k = 0; k < 2; ++k) \
        acc[ai][bj][m][n] = __builtin_amdgcn_mfma_f32_16x16x32_bf16(Bt[n][k], At[m][k], acc[ai][bj][m][n], 0, 0, 0); } __builtin_amdgcn_s_setprio(0); } while (0)
#define PG8_WAIT_V(n) asm volatile("s_waitcnt vmcnt(" #n ")" ::: "memory")
#define PG8_WAIT_L(n) asm volatile("s_waitcnt lgkmcnt(" #n ")" ::: "memory")
#define PG8_BAR __builtin_amdgcn_s_barrier()
#define PG8_SCHED __builtin_amdgcn_sched_barrier(0)
#define PG8_AOFFS(AO, u) do { int _t = threadIdx.x; asm volatile("" : "+v"(_t)); _Pragma("unroll") for (int _i = 0; _i < 2; ++_i) { int _R, _C; stage_rc(_t * 16 + _i * 8192, _R, _C); \
        _Pragma("unroll") for (int _h = 0; _h < 2; ++_h) (AO)[_h][_i] = S.row_off(u, _h * HALF + _R) + (unsigned)(_C * 2); } } while (0)
    Unit cur, nxt; int ui = 0;
    if (!S.next(0, cur)) return;
    f32x4 acc[2][2][4][2];
#pragma unroll
    for (int a = 0; a < 2; ++a)
#pragma unroll
        for (int b = 0; b < 2; ++b)
#pragma unroll
            for (int m = 0; m < 4; ++m)
#pragma unroll
                for (int n = 0; n < 2; ++n) acc[a][b][m][n] = (f32x4){0.f, 0.f, 0.f, 0.f};
    bf16x8 At[4][2], B0[2][2], B1[2][2];
    unsigned aoc[2][2];
    PG8_AOFFS(aoc, cur);
    const char* cB = (const char*)g.Bt + (size_t)cur.pn * tstep;
    PG8_STAGE(PG8_SB(0, 0), cB, voffB); PG8_STAGE(PG8_SB(0, 1), cB + hstep, voffB); PG8_STAGE_A(PG8_SA(0, 0), aoc, 0, 0); PG8_STAGE_A(PG8_SA(0, 1), aoc, 1, 0);
    if (wr == 1) PG8_BAR;
    PG8_WAIT_V(2); PG8_BAR;
    PG8_STAGE(PG8_SB(1, 0), cB + kstep, voffB); PG8_STAGE_A(PG8_SA(1, 0), aoc, 0, 128); PG8_STAGE(PG8_SB(1, 1), cB + hstep + kstep, voffB);
    PG8_WAIT_V(6); PG8_BAR;
    for (;;) {
        const bool has_next = S.next(ui + 1, nxt);
        const char* nB = cB;
        if (has_next) nB = (const char*)g.Bt + (size_t)nxt.pn * tstep;
#pragma nounroll
        for (int t = 0; t < nt; t += 2) {
            const bool last = (t == nt - 2);
            const unsigned k1 = (unsigned)(t + 1) * 128u, k2 = last ? 0u : (unsigned)(t + 2) * 128u, k3 = k2 + 128u;
            const char* b2 = last ? nB : cB + (size_t)(t + 2) * kstep; const char* b3 = b2 + kstep;
            PG8_LDB(B0, 0, 0); PG8_LDB(B1, 0, 1); PG8_SCHED; PG8_LDA(At, 0, 0); PG8_STAGE_A(PG8_SA(1, 1), aoc, 1, k1);
            PG8_WAIT_V(8); PG8_WAIT_L(0); PG8_BAR; PG8_MMA(0, 0, At, B0); PG8_MMA(0, 1, At, B1); PG8_BAR; PG8_SCHED;
            if (last && has_next) { PG8_AOFFS(aoc, nxt); }
            PG8_LDA(At, 0, 1); PG8_STAGE(PG8_SB(0, 0), b2, voffB); PG8_STAGE(PG8_SB(0, 1), b2 + hstep, voffB); PG8_STAGE_A(PG8_SA(0, 0), aoc, 0, k2);
            PG8_WAIT_V(8); PG8_WAIT_L(0); PG8_BAR; PG8_MMA(1, 0, At, B0); PG8_MMA(1, 1, At, B1); PG8_BAR; PG8_SCHED;
            PG8_LDB(B0, 1, 0); PG8_LDB(B1, 1, 1); PG8_SCHED; PG8_LDA(At, 1, 0); PG8_STAGE_A(PG8_SA(0, 1), aoc, 1, k2);
            PG8_WAIT_V(8); PG8_WAIT_L(0); PG8_BAR; PG8_MMA(0, 0, At, B0); PG8_MMA(0, 1, At, B1); PG8_BAR; PG8_SCHED;
            PG8_LDA(At, 1, 1); PG8_STAGE(PG8_SB(1, 0), b3, voffB); PG8_STAGE(PG8_SB(1, 1), b3 + hstep, voffB); PG8_STAGE_A(PG8_SA(1, 0), aoc, 0, k3);
            PG8_WAIT_V(8); PG8_WAIT_L(0); PG8_BAR; PG8_MMA(1, 0, At, B0); PG8_MMA(1, 1, At, B1); PG8_BAR; PG8_SCHED;
        }
        if constexpr (ALIGN_EPI) { if (wr == 0) PG8_BAR; }
        { int t2 = threadIdx.x; asm volatile("" : "+v"(t2));
          const int w2 = __builtin_amdgcn_readfirstlane(t2 >> 6), l2 = t2 & 63; E(acc, cur, w2 >> 2, w2 & 3, l2 & 15, l2 >> 4); }
        if (!has_next) break;
#pragma unroll
        for (int a = 0; a < 2; ++a)
#pragma unroll
            for (int b = 0; b < 2; ++b)
#pragma unroll
                for (int m = 0; m < 4; ++m)
#pragma unroll
                    for (int n = 0; n < 2; ++n) acc[a][b][m][n] = (f32x4){0.f, 0.f, 0.f, 0.f};
        cur = nxt; cB = nB; ++ui;
        if constexpr (ALIGN_EPI) { if (wr == 1) PG8_BAR; }
    }
    PG8_WAIT_V(0);
    if constexpr (!ALIGN_EPI) { if (wr == 0) PG8_BAR; }
    PG8_BAR;
#undef PG8_SA
#undef PG8_SB
#undef PG8_STAGE
#undef PG8_STAGE_A
#undef PG8_LDA
#undef PG8_LDB
#undef PG8_MMA
#undef PG8_CAT8
#undef PG8_WAIT_V
#undef PG8_WAIT_L
#undef PG8_BAR
#undef PG8_SCHED
#undef PG8_AOFFS
}
}
struct SchedPlain : pg8::StaticOrder {
    unsigned rowbytes;
    DEV unsigned row_off(const pg8::Unit& u, int r) const { return (unsigned)(u.pm * 256 + r) * rowbytes; }
};
struct SchedMoe1 : pg8::StaticOrder {
    const LAS int* idxl;
    DEV bool next(int i, pg8::Unit& u) const { if (!pg8::StaticOrder::next(i, u)) return false; u.pn += (u.pm >> 4) * 16; u.ui = i; return true; }
    DEV unsigned row_off(const pg8::Unit& u, int r) const { const int g = u.pm * 256 + r; const int tok = ((g >> 9) & 7) * S + idxl[u.ui * 256 + r]; return (unsigned)tok * (unsigned)D; }
};
struct SchedMoe2 : pg8::StaticOrder {
    DEV bool next(int i, pg8::Unit& u) const { if (!pg8::StaticOrder::next(i, u)) return false; u.pn += (u.pm >> 4) * 4; return true; }
    DEV unsigned row_off(const pg8::Unit& u, int r) const { return (unsigned)(u.pm * 256 + r) * (unsigned)DFF; }
};
typedef pg8::f32x4 f32x4; typedef pg8::u32x4 u32x4;
struct EpiInProj {
    static constexpr bool PERM = true;
    unsigned char* ws; const float* ropeT;
    DEV void operator()(const f32x4 (&acc)[2][2][4][2], const pg8::Unit& u, int wr, int wc, int fr, int fq) const {
        const int grp = u.pn >> 1;
        bf16_t* gbase = (bf16_t*)(ws + WS_RQ + (size_t)grp * 32 * MiB);
        const int j0 = 32 * (wc & 1) + 8 * fq;
        if (grp < 2) {
            const float sc = grp == 1 ? 0.125f : 1.f;
            f32x4 cs[2][4], sn[2][4];
#pragma unroll
            for (int ai = 0; ai < 2; ++ai)
#pragma unroll
                for (int m = 0; m < 4; ++m) { const int s = (u.pm * 256 + ai * 128 + wr * 64 + m * 16 + fr) & 4095;
                    cs[ai][m] = *(const f32x4*)(ropeT + s * 32 + (j0 >> 1)); sn[ai][m] = *(const f32x4*)(ropeT + S * 32 + s * 32 + (j0 >> 1)); }
#pragma unroll
            for (int ai = 0; ai < 2; ++ai)
#pragma unroll
                for (int m = 0; m < 4; ++m) {
                    const int row = u.pm * 256 + ai * 128 + wr * 64 + m * 16 + fr, b = row >> 12, s = row & 4095;
#pragma unroll
                    for (int bj = 0; bj < 2; ++bj) {
                        const int hd = 4 * (u.pn & 1) + 2 * bj + (wc >> 1);
                        const f32x4 lo = (acc[ai][bj][m][0] * cs[ai][m] - acc[ai][bj][m][1] * sn[ai][m]) * sc, hi = (acc[ai][bj][m][1] * cs[ai][m] + acc[ai][bj][m][0] * sn[ai][m]) * sc;
                        u32x4 w; w.x = pg8::cvt_pk_bf16(lo[0], lo[1]); w.y = pg8::cvt_pk_bf16(lo[2], lo[3]); w.z = pg8::cvt_pk_bf16(hi[0], hi[1]); w.w = pg8::cvt_pk_bf16(hi[2], hi[3]);
                        *(u32x4*)(gbase + ((size_t)(b * NH + hd) * S + s) * HD + j0) = w;
                    }
                }
        } else {
            const float sc = grp == 4 ? 0.125f * LOG2E : 1.f;
#pragma unroll
            for (int ai = 0; ai < 2; ++ai)
#pragma unroll
                for (int m = 0; m < 4; ++m) {
                    const int row = u.pm * 256 + ai * 128 + wr * 64 + m * 16 + fr, b = row >> 12, s = row & 4095;
#pragma unroll
                    for (int bj = 0; bj < 2; ++bj) {
                        const int hd = 4 * (u.pn & 1) + 2 * bj + (wc >> 1);
                        const f32x4 lo = acc[ai][bj][m][0] * sc, hi = acc[ai][bj][m][1] * sc;
                        u32x4 w; w.x = pg8::cvt_pk_bf16(lo[0], lo[1]); w.y = pg8::cvt_pk_bf16(lo[2], lo[3]); w.z = pg8::cvt_pk_bf16(hi[0], hi[1]); w.w = pg8::cvt_pk_bf16(hi[2], hi[3]);
                        *(u32x4*)(gbase + ((size_t)(b * NH + hd) * S + s) * HD + j0) = w;
                    }
                }
        }
    }
};
struct EpiOutProj {
    static constexpr bool PERM = true;
    const float* x; bf16_t* x1;
    DEV void operator()(const f32x4 (&acc)[2][2][4][2], const pg8::Unit& u, int wr, int wc, int fr, int fq) const {
#pragma unroll
        for (int ai = 0; ai < 2; ++ai)
#pragma unroll
            for (int m = 0; m < 4; ++m) {
                const int row = u.pm * 256 + ai * 128 + wr * 64 + m * 16 + fr;
                f32x4 xa[2], xb[2];
#pragma unroll
                for (int bj = 0; bj < 2; ++bj) { const size_t off = (size_t)row * D + u.pn * 256 + bj * 128 + wc * 32 + 8 * fq; xa[bj] = *(const f32x4*)(x + off); xb[bj] = *(const f32x4*)(x + off + 4); }
#pragma unroll
                for (int bj = 0; bj < 2; ++bj) { const size_t off = (size_t)row * D + u.pn * 256 + bj * 128 + wc * 32 + 8 * fq;
                    const f32x4 lo = xa[bj] + acc[ai][bj][m][0], hi = xb[bj] + acc[ai][bj][m][1];
                    u32x4 w; w.x = pg8::cvt_pk_bf16(lo[0], lo[1]); w.y = pg8::cvt_pk_bf16(lo[2], lo[3]); w.z = pg8::cvt_pk_bf16(hi[0], hi[1]); w.w = pg8::cvt_pk_bf16(hi[2], hi[3]);
                    *(u32x4*)(x1 + off) = w; }
            }
    }
};
DEV unsigned pk4_fp8e(float a, float b, float c, float d) { unsigned w = 0u; w = __builtin_amdgcn_cvt_pk_fp8_f32(a, b, w, false); w = __builtin_amdgcn_cvt_pk_fp8_f32(c, d, w, true); return w; }
struct EpiSwiGLU {
    static constexpr bool PERM = true;
    unsigned char* hid;
    DEV void operator()(const f32x4 (&acc)[2][2][4][2], const pg8::Unit& u, int wr, int wc, int fr, int fq) const {
        const int pnl = u.pn & 15;
#pragma unroll
        for (int ai = 0; ai < 2; ++ai)
#pragma unroll
            for (int m = 0; m < 4; ++m) {
                const int row = u.pm * 256 + ai * 128 + wr * 64 + m * 16 + fr;
                float o[8];
#pragma unroll
                for (int n = 0; n < 2; ++n)
#pragma unroll
                    for (int i = 0; i < 4; ++i) { const float ga = acc[ai][0][m][n][i], ua = acc[ai][1][m][n][i];
                        o[4 * n + i] = (ga * ua) * ((1.f / 1024.f) * __builtin_amdgcn_rcpf(1.f + __builtin_amdgcn_exp2f(ga * (-LOG2E / 32.f)))); }
                *(uint2*)(hid + (size_t)row * DFF + pnl * 128 + wc * 32 + 8 * fq) = make_uint2(pk4_fp8e(o[0], o[1], o[2], o[3]), pk4_fp8e(o[4], o[5], o[6], o[7]));
            }
    }
};
struct EpiDown {
    static constexpr bool PERM = true;
    unsigned char* y;
    DEV void operator()(const f32x4 (&acc)[2][2][4][2], const pg8::Unit& u, int wr, int wc, int fr, int fq) const {
        const int pnl = u.pn & 3;
#pragma unroll
        for (int ai = 0; ai < 2; ++ai)
#pragma unroll
            for (int m = 0; m < 4; ++m) {
                const int row = u.pm * 256 + ai * 128 + wr * 64 + m * 16 + fr;
#pragma unroll
                for (int bj = 0; bj < 2; ++bj) { const f32x4 lo = acc[ai][bj][m][0] * (1.f / 32.f), hi = acc[ai][bj][m][1] * (1.f / 32.f);
                    *(uint2*)(y + (size_t)row * D + pnl * 256 + bj * 128 + wc * 32 + 8 * fq) = make_uint2(pk4_fp8e(lo[0], lo[1], lo[2], lo[3]), pk4_fp8e(hi[0], hi[1], hi[2], hi[3])); }
            }
    }
};
struct Args { const float* in[13]; float* out; unsigned char* ws; int ph_lo, ph_hi; int rep[16]; };
enum { IN_X = 0, IN_G1, IN_WIN, IN_DECAY, IN_GN, IN_RELB, IN_WOUT, IN_G2, IN_WR, IN_WG, IN_WU, IN_WDN, IN_FG };

struct TrItem { const float* src; bf16_t* dst; int K, N, k0, n0, mode, fp8; };
DEV unsigned pk4_fp8(float a, float b, float c, float d) { unsigned w = 0u; w = __builtin_amdgcn_cvt_pk_fp8_f32(a, b, w, false); w = __builtin_amdgcn_cvt_pk_fp8_f32(c, d, w, true); return w; }
DEV void tr_load(const TrItem& t, f32x4 (&v)[16], int lane) {
#pragma unroll
    for (int i = 0; i < 16; ++i) { const int kk = (lane >> 4) + 4 * i, c = (lane & 15) * 4; v[i] = *(const f32x4*)(t.src + (size_t)(t.k0 + kk) * t.N + t.n0 + c); }
}
DEV int rowmap_rt(int mode, int n) {
    if (mode == 0) return n;
    if (mode == 1) { if (n >= 1024) return n; const int base = n & ~63, d = n & 63, nn = d >> 5, dd = d & 31; return base + 8 * (dd >> 2) + 4 * nn + (dd & 3); }
    return (n >> 7) * 256 + (mode == 3 ? 128 : 0) + (n & 127);
}
DEV void tr_finish(const TrItem& t, const f32x4 (&v)[16], LAS float* scr, int lane) {
#pragma unroll
    for (int i = 0; i < 16; ++i) { const int kk = (lane >> 4) + 4 * i, c = (lane & 15) * 4;
        scr[kk * 65 + c] = v[i][0]; scr[kk * 65 + c + 1] = v[i][1]; scr[kk * 65 + c + 2] = v[i][2]; scr[kk * 65 + c + 3] = v[i][3]; }
    LDS_WAIT();
#pragma unroll
    for (int i = 0; i < 8; ++i) { const int n = (lane >> 3) + 8 * i, c = (lane & 7) * 8; const LAS float* sp = scr + c * 65 + n;
        if (t.fp8) {
            const unsigned lo = pk4_fp8(sp[0] * 32.f, sp[65] * 32.f, sp[2 * 65] * 32.f, sp[3 * 65] * 32.f), hi = pk4_fp8(sp[4 * 65] * 32.f, sp[5 * 65] * 32.f, sp[6 * 65] * 32.f, sp[7 * 65] * 32.f);
            *(uint2*)((unsigned char*)t.dst + (size_t)rowmap_rt(t.mode, t.n0 + n) * t.K + t.k0 + c) = make_uint2(lo, hi);
        } else {
        u32x4 o; o.x = pk2(sp[0], sp[65]); o.y = pk2(sp[2 * 65], sp[3 * 65]); o.z = pk2(sp[4 * 65], sp[5 * 65]); o.w = pk2(sp[6 * 65], sp[7 * 65]);
        *(u32x4*)(t.dst + (size_t)rowmap_rt(t.mode, t.n0 + n) * t.K + t.k0 + c) = o; } }
    LDS_WAIT();
}
template <class Dec> DEV void tr_run(const Dec& dec, int nitems, int gw, int NGW, LAS float* scr, int lane) {
    for (int it = gw; it < nitems; it += NGW) { TrItem cur; f32x4 va[16]; dec(it, cur); tr_load(cur, va, lane); tr_finish(cur, va, scr, lane); }
}
template <class Dec> DEV void tr_run2(const Dec& dec, int nitems, int gw, int NGW, LAS float* scr, int lane) {
    int it = gw; if (it >= nitems) return;
    TrItem cur, nxt; f32x4 va[16], vb[16];
    dec(it, cur); tr_load(cur, va, lane);
    for (;;) {
        const int n1 = it + NGW; const bool h1 = n1 < nitems;
        if (h1) { dec(n1, nxt); tr_load(nxt, vb, lane); }
        tr_finish(cur, va, scr, lane);
        if (!h1) break;
        const int n2 = n1 + NGW; const bool h2 = n2 < nitems;
        if (h2) { dec(n2, cur); tr_load(cur, va, lane); }
        tr_finish(nxt, vb, scr, lane);
        if (!h2) break;
        it = n2;
    }
}
DEV void rms_row_to_bf16(const float* xrow, const float* g, bf16_t* orow, int lane) {
    const float4* xr = (const float4*)xrow + lane;
    float4 v[4]; float s = 0.f;
#pragma unroll
    for (int j = 0; j < 4; ++j) { v[j] = xr[64 * j]; s += v[j].x * v[j].x + v[j].y * v[j].y + v[j].z * v[j].z + v[j].w * v[j].w; }
    const float rs = rsqrtf(wave_sum(s) * (1.f / D) + EPS);
    uint2* o = (uint2*)orow + lane;
#pragma unroll
    for (int j = 0; j < 4; ++j) { const float4 gg = ((const float4*)g)[lane + 64 * j];
        o[64 * j] = make_uint2(pk2(v[j].x * rs * gg.x, v[j].y * rs * gg.y), pk2(v[j].z * rs * gg.z, v[j].w * rs * gg.w)); }
}
DEV void phase_prep(const Args& a, unsigned char* lds, int gw, int NGW, int lane, int wave) {
    unsigned char* ws = a.ws;
    float* ropeT = (float*)(ws + WS_ROPE); float* biasT = (float*)(ws + WS_BIAS);
    for (int t = gw * 64 + lane; t < S * 32; t += NGW * 64) {
        const int pos = t >> 5, i = t & 31; const double inv = pow(10000.0, -(double)i / 32.0), ang = (double)pos * inv;
        ropeT[t] = (float)cos(ang); ropeT[S * 32 + t] = (float)sin(ang);
        if (t < 3 * NH * 129) { const int p = t / (NH * 129), h = (t / 129) % NH, o = t % 129 - 64, dil = p == 0 ? 1 : (p == 1 ? 4 : 16), rel = o * dil, n = rel < 0 ? -rel : rel;
            int bucket = rel > 0 ? 16 : 0;
            if (n < 8) bucket += n; else { int large = 8 + (int)(log((double)n / 8.0) / log(128.0) * 8.0); if (large > 15) large = 15; bucket += large; }
            biasT[t] = a.in[IN_RELB][bucket * NH + h] * LOG2E; }
    }
    LAS float* scr = (LAS float*)((LAS unsigned char*)lds + wave * 16640);
    constexpr int I_IN = (D / 64) * (PC / 64), I_OUT = (D / 64) * (D / 64);
    { const float* w_in = a.in[IN_WIN]; const float* w_out = a.in[IN_WOUT]; bf16_t* Win = (bf16_t*)(ws + WS_WIN); bf16_t* Wout = (bf16_t*)(ws + WS_WOUT);
      auto dec = [=](int it, TrItem& t) { if (it < I_IN) { t.src = w_in; t.dst = Win; t.K = D; t.N = PC; t.k0 = (it / (PC / 64)) * 64; t.n0 = (it % (PC / 64)) * 64; t.mode = 1; t.fp8 = 0; }
          else { const int r = it - I_IN; t.src = w_out; t.dst = Wout; t.K = D; t.N = D; t.k0 = (r / (D / 64)) * 64; t.n0 = (r % (D / 64)) * 64; t.mode = 0; t.fp8 = 0; } };
      tr_run(dec, I_IN + I_OUT, gw, NGW, scr, lane); }
    {
      const float* x = a.in[IN_X]; const float* g = a.in[IN_G1]; bf16_t* XN = (bf16_t*)(ws + WS_XN);
      float4 va[4], vb[4], vc[4];
      { const float4* xr = (const float4*)(x + (size_t)gw * D) + lane;
#pragma unroll
        for (int j = 0; j < 4; ++j) va[j] = xr[64 * j];
        if (gw + NGW < M) { const float4* xs = (const float4*)(x + (size_t)(gw + NGW) * D) + lane;
#pragma unroll
          for (int j = 0; j < 4; ++j) vb[j] = xs[64 * j]; } }
      for (int m = gw; m < M; m += NGW) {
          if (m + 2 * NGW < M) { const float4* xr = (const float4*)(x + (size_t)(m + 2 * NGW) * D) + lane;
#pragma unroll
              for (int j = 0; j < 4; ++j) vc[j] = xr[64 * j]; }
          float s = 0.f;
#pragma unroll
          for (int j = 0; j < 4; ++j) s += va[j].x * va[j].x + va[j].y * va[j].y + va[j].z * va[j].z + va[j].w * va[j].w;
          const float rs = rsqrtf(wave_sum(s) * (1.f / D) + EPS);
          uint2* o = (uint2*)(XN + (size_t)m * D) + lane;
#pragma unroll
          for (int j = 0; j < 4; ++j) { const float4 gg = ((const float4*)g)[lane + 64 * j];
              o[64 * j] = make_uint2(pk2(va[j].x * rs * gg.x, va[j].y * rs * gg.y), pk2(va[j].z * rs * gg.z, va[j].w * rs * gg.w)); }
#pragma unroll
          for (int j = 0; j < 4; ++j) { va[j] = vb[j]; vb[j] = vc[j]; }
      } }
}
DEV void phase_latew(const Args& a, unsigned char* lds, int gw, int NGW, int lane, int wave) {
    unsigned char* ws = a.ws; LAS float* scr = (LAS float*)((LAS unsigned char*)lds + wave * 16640);
    constexpr int I_G = (D / 64) * (DFF / 64);
    const float* wg_ = a.in[IN_WG]; const float* wu_ = a.in[IN_WU]; const float* wd_ = a.in[IN_WDN]; bf16_t* Wgu = (bf16_t*)(ws + WS_WGU); bf16_t* Wd = (bf16_t*)(ws + WS_WD);
    auto dec = [=](int it, TrItem& t) { const int which = it / (NE * I_G), r = it % (NE * I_G), e = r / I_G, q = r % I_G;
        t.fp8 = 1;
        if (which < 2) { t.src = (which == 0 ? wg_ : wu_) + (size_t)e * D * DFF; t.dst = (bf16_t*)((unsigned char*)Wgu + (size_t)e * 4096 * D); t.K = D; t.N = DFF; t.n0 = (q / (D / 64)) * 64; t.k0 = (q % (D / 64)) * 64; t.mode = 2 + which; }
        else { t.src = wd_ + (size_t)e * DFF * D; t.dst = (bf16_t*)((unsigned char*)Wd + (size_t)e * D * DFF); t.K = DFF; t.N = D; t.n0 = (q / (DFF / 64)) * 64; t.k0 = (q % (DFF / 64)) * 64; t.mode = 0; } };
    tr_run2(dec, 3 * NE * I_G, gw, NGW, scr, lane);
}
DEV void phase_router(const Args& a, unsigned char* lds, int gw, int NGW, int lane, int tid) {
    unsigned char* ws = a.ws; const bf16_t* x1 = (const bf16_t*)(ws + WS_X1); const float* g2 = a.in[IN_G2]; const float* wr = a.in[IN_WR];
    bf16_t* H2b = (bf16_t*)(ws + WS_XN); float* aff = (float*)(ws + WS_AFF); float* affT = (float*)(ws + WS_AFFT); int* inv = (int*)(ws + WS_INV);
    LAS f32x4* wl = (LAS f32x4*)(LAS unsigned char*)lds;
    for (int i = tid; i < D * 4; i += NTHR) { const int k = i >> 2, c = i & 3, slot = (k & 3) * 256 + (k >> 2); wl[slot * 4 + ((c + (slot >> 2)) & 3)] = *(const f32x4*)(wr + (size_t)k * NE + 4 * c); }
    __syncthreads();
    uint2 xq[4][4], xp[4][4];
#pragma unroll
    for (int q = 0; q < 4; ++q) { const int r = gw + q * NGW; if (r < M) { const uint2* xr = (const uint2*)(x1 + (size_t)r * D) + lane;
#pragma unroll
        for (int j = 0; j < 4; ++j) xp[q][j] = xr[64 * j]; } }
    for (int row4 = gw; row4 < M; row4 += 4 * NGW) {
#pragma unroll
      for (int q = 0; q < 4; ++q)
#pragma unroll
        for (int j = 0; j < 4; ++j) xq[q][j] = xp[q][j];
#pragma unroll
      for (int q = 0; q < 4; ++q) { const int r = row4 + (4 + q) * NGW; if (r < M) { const uint2* xr = (const uint2*)(x1 + (size_t)r * D) + lane;
#pragma unroll
          for (int j = 0; j < 4; ++j) xp[q][j] = xr[64 * j]; } }
#pragma unroll
      for (int q = 0; q < 4; ++q) {
        const int row = row4 + q * NGW; if (row >= M) break;
        float4 v[4]; float s = 0.f;
#pragma unroll
        for (int j = 0; j < 4; ++j) { v[j] = make_float4(bf2f(xq[q][j].x & 0xffffu), bf2f(xq[q][j].x >> 16), bf2f(xq[q][j].y & 0xffffu), bf2f(xq[q][j].y >> 16)); s += v[j].x * v[j].x + v[j].y * v[j].y + v[j].z * v[j].z + v[j].w * v[j].w; }
        const float rs = rsqrtf(wave_sum(s) * (1.f / D) + EPS);
        f32x4 lg[4];
#pragma unroll
        for (int c = 0; c < 4; ++c) lg[c] = (f32x4){0.f, 0.f, 0.f, 0.f};
        unsigned* o = (unsigned*)((unsigned char*)H2b + (size_t)row * D) + lane;
        float hv[4][4];
#pragma unroll
        for (int j = 0; j < 4; ++j) { const float4 gg = ((const float4*)g2)[lane + 64 * j];
            hv[j][0] = v[j].x * rs * gg.x; hv[j][1] = v[j].y * rs * gg.y; hv[j][2] = v[j].z * rs * gg.z; hv[j][3] = v[j].w * rs * gg.w;
            o[64 * j] = pk4_fp8(hv[j][0], hv[j][1], hv[j][2], hv[j][3]); }
        const int rot = (lane >> 2) & 3; f32x4 wa[4], wb[4];
#pragma unroll
        for (int c = 0; c < 4; ++c) wa[c] = wl[(0 * 256 + lane) * 4 + ((c + rot) & 3)];
#pragma unroll
        for (int st = 0; st < 16; st += 2) {
            { const int j = (st + 1) >> 2, t = (st + 1) & 3, slot = t * 256 + lane + 64 * j;
#pragma unroll
              for (int c = 0; c < 4; ++c) wb[c] = wl[slot * 4 + ((c + rot) & 3)]; }
#pragma unroll
            for (int c = 0; c < 4; ++c) lg[c] += hv[st >> 2][st & 3] * wa[c];
            __builtin_amdgcn_sched_barrier(0);
            if (st + 2 < 16) { const int j = (st + 2) >> 2, t = (st + 2) & 3, slot = t * 256 + lane + 64 * j;
#pragma unroll
              for (int c = 0; c < 4; ++c) wa[c] = wl[slot * 4 + ((c + rot) & 3)]; }
#pragma unroll
            for (int c = 0; c < 4; ++c) lg[c] += hv[(st + 1) >> 2][(st + 1) & 3] * wb[c];
            __builtin_amdgcn_sched_barrier(0);
        }
        float r8[8], r4[4], r2[2], r1;
        { const bool up = lane & 32;
#pragma unroll
          for (int i = 0; i < 8; ++i) { const float mine = up ? lg[(i + 8) >> 2][(i + 8) & 3] : lg[i >> 2][i & 3], send = up ? lg[i >> 2][i & 3] : lg[(i + 8) >> 2][(i + 8) & 3]; r8[i] = mine + lane_x32(send); } }
        { const bool up = lane & 16;
#pragma unroll
          for (int i = 0; i < 4; ++i) { const float mine = up ? r8[i + 4] : r8[i], send = up ? r8[i] : r8[i + 4]; r4[i] = mine + lane_x16(send); } }
        { const bool up = lane & 8;
#pragma unroll
          for (int i = 0; i < 2; ++i) { const float mine = up ? r4[i + 2] : r4[i], send = up ? r4[i] : r4[i + 2]; r2[i] = mine + lane_x8(send); } }
        { const bool up = lane & 4; const float mine = up ? r2[1] : r2[0], send = up ? r2[0] : r2[1]; r1 = mine + lane_m8(send); }
        r1 += lane_x2(r1); r1 += lane_x1(r1);
        float mx = r1; mx = fmaxf(mx, lane_m8(mx)); mx = fmaxf(mx, lane_x8(mx)); mx = fmaxf(mx, lane_x16(mx)); mx = fmaxf(mx, lane_x32(mx));
        const float ex = __expf(r1 - mx); float sum = ex; sum += lane_m8(sum); sum += lane_x8(sum); sum += lane_x16(sum); sum += lane_x32(sum);
        const float av = ex / sum; const int e = lane >> 2;
        if ((lane & 3) == 0) { aff[(size_t)row * NE + e] = av; inv[(size_t)row * NE + e] = -1; affT[((size_t)(row >> 12) * NE + e) * S + (row & 4095)] = av; }
      }
    }
    __syncthreads();
}
DEV void phase_topk(const Args& a, unsigned char* lds, int wg, int G, int tid, int lane, int wave) {
    unsigned char* ws = a.ws; const float* affT = (const float*)(ws + WS_AFFT); int* idx = (int*)(ws + WS_IDX); int* inv = (int*)(ws + WS_INV);
    LAS unsigned* hist = (LAS unsigned*)(LAS unsigned char*)lds; LAS unsigned* wsum = hist + 256; LAS unsigned* bc = hist + 272;
    for (int it = wg; it < NE * NB; it += G) {
        const int e = it & 15, b = it >> 4;
        unsigned u[8];
        { const uint4* src = (const uint4*)(affT + ((size_t)b * NE + e) * S + 8 * tid); const uint4 p = src[0], q = src[1]; u[0] = p.x; u[1] = p.y; u[2] = p.z; u[3] = p.w; u[4] = q.x; u[5] = q.y; u[6] = q.z; u[7] = q.w; }
        unsigned prefix = 0u, kk = CAP;
#pragma unroll
        for (int pass = 0; pass < 4; ++pass) {
            const int shift = 24 - 8 * pass;
            __syncthreads();
            if (tid < 256) hist[tid] = 0u;
            __syncthreads();
#pragma unroll
            for (int j = 0; j < 8; ++j) if (pass == 0 || (u[j] >> (shift + 8)) == prefix) atomicAdd((unsigned*)&hist[(u[j] >> shift) & 255u], 1u);
            __syncthreads();
            if (wave == 0) {
                const unsigned c0 = hist[4 * lane], c1 = hist[4 * lane + 1], c2 = hist[4 * lane + 2], c3 = hist[4 * lane + 3], tot = c0 + c1 + c2 + c3;
                unsigned incl = tot;
#pragma unroll
                for (int o = 1; o < 64; o <<= 1) { const unsigned t = __shfl_down(incl, o); if (lane + o < 64) incl += t; }
                const unsigned excl = incl - tot;
                if (excl < kk && kk <= incl) { unsigned acc = excl; int bin;
                    if (acc + c3 >= kk) bin = 3; else { acc += c3; if (acc + c2 >= kk) bin = 2; else { acc += c2; if (acc + c1 >= kk) bin = 1; else { acc += c1; bin = 0; } } }
                    bc[0] = 4 * lane + bin; bc[1] = kk - acc; }
            }
            __syncthreads();
            prefix = (prefix << 8) | bc[0]; kk = bc[1];
        }
        const unsigned T = prefix, need = kk;
        unsigned cg_ = 0u, ce = 0u;
#pragma unroll
        for (int j = 0; j < 8; ++j) { cg_ += u[j] > T; ce += u[j] == T; }
        unsigned pk = cg_ | (ce << 16), incl = pk;
#pragma unroll
        for (int o = 1; o < 64; o <<= 1) { const unsigned t = __shfl_up(incl, o); if (lane >= o) incl += t; }
        if (lane == 63) wsum[wave] = incl;
        __syncthreads();
        unsigned base = 0u;
#pragma unroll
        for (int w = 0; w < NWAVES; ++w) base += w < wave ? wsum[w] : 0u;
        const unsigned ex = base + incl - pk; unsigned gtb = ex & 0xffffu, eqb = ex >> 16;
#pragma unroll
        for (int j = 0; j < 8; ++j) { const bool g = u[j] > T, q = u[j] == T; const unsigned slot = gtb + (eqb < need ? eqb : need);
            if (g || (q && eqb < need)) { const int s = 8 * tid + j; idx[(e * NB + b) * CAP + slot] = s; inv[((size_t)b * S + s) * NE + e] = (int)slot; }
            gtb += g; eqb += q; }
    }
}
DEV void phase_final(const Args& a, int gw, int NGW, int lane) {
    unsigned char* ws = a.ws; float* xo = a.out; const bf16_t* x1 = (const bf16_t*)(ws + WS_X1); const float* aff = (const float*)(ws + WS_AFF); const int* inv = (const int*)(ws + WS_INV);
    const unsigned char* y = ws + WS_Y; const float* fg = a.in[IN_FG];
    uint2 xw[4], xn[4], xm[4]; int iv = -1, ivn = -1, ivm = -1; float av = 0.f, avn = 0.f, avm = 0.f;
    { const uint2* xr = (const uint2*)(x1 + (size_t)gw * D) + lane;
#pragma unroll
      for (int j = 0; j < 4; ++j) xw[j] = xr[64 * j];
      if (lane < NE) { iv = inv[(size_t)gw * NE + lane]; av = aff[(size_t)gw * NE + lane]; }
      if (gw + NGW < M) { const uint2* xs = (const uint2*)(x1 + (size_t)(gw + NGW) * D) + lane;
#pragma unroll
        for (int j = 0; j < 4; ++j) xn[j] = xs[64 * j];
        if (lane < NE) { ivn = inv[(size_t)(gw + NGW) * NE + lane]; avn = aff[(size_t)(gw + NGW) * NE + lane]; } } }
    for (int row = gw; row < M; row += NGW) {
        const int b = row >> 12;
        if (row + 2 * NGW < M) { const uint2* xr = (const uint2*)(x1 + (size_t)(row + 2 * NGW) * D) + lane;
#pragma unroll
            for (int j = 0; j < 4; ++j) xm[j] = xr[64 * j];
            if (lane < NE) { ivm = inv[(size_t)(row + 2 * NGW) * NE + lane]; avm = aff[(size_t)(row + 2 * NGW) * NE + lane]; } }
        float4 v[4];
#pragma unroll
        for (int j = 0; j < 4; ++j) v[j] = make_float4(bf2f(xw[j].x & 0xffffu), bf2f(xw[j].x >> 16), bf2f(xw[j].y & 0xffffu), bf2f(xw[j].y >> 16));
        unsigned long long msk = __ballot(lane < NE && iv >= 0);
        while (msk) {
            unsigned w[4][4]; float gq[4];
#pragma unroll
            for (int q = 0; q < 4; ++q) { const bool on = msk != 0ull; const int e = on ? __builtin_ctzll(msk) : 0; msk = on ? (msk & (msk - 1)) : 0ull;
                const int sl = __builtin_amdgcn_readlane(iv, e); const float g = __builtin_bit_cast(float, __builtin_amdgcn_readlane(__builtin_bit_cast(int, av), e));
                gq[q] = on ? g : 0.f;
                const unsigned* yr = (const unsigned*)(y + ((size_t)e * 4096 + b * CAP + (on ? sl : 0)) * D) + lane;
#pragma unroll
                for (int j = 0; j < 4; ++j) w[q][j] = yr[64 * j]; }
#pragma unroll
            for (int q = 0; q < 4; ++q)
#pragma unroll
                for (int j = 0; j < 4; ++j) { const auto lo = __builtin_amdgcn_cvt_pk_f32_fp8((int)w[q][j], false), hi = __builtin_amdgcn_cvt_pk_f32_fp8((int)w[q][j], true);
                    v[j].x += gq[q] * lo[0]; v[j].y += gq[q] * lo[1]; v[j].z += gq[q] * hi[0]; v[j].w += gq[q] * hi[1]; }
        }
        float s = 0.f;
#pragma unroll
        for (int j = 0; j < 4; ++j) s += v[j].x * v[j].x + v[j].y * v[j].y + v[j].z * v[j].z + v[j].w * v[j].w;
        const float rs = rsqrtf(wave_sum(s) * (1.f / D) + EPS);
        float4* orow = (float4*)(xo + (size_t)row * D) + lane;
#pragma unroll
        for (int j = 0; j < 4; ++j) { const float4 gg = ((const float4*)fg)[lane + 64 * j]; orow[64 * j] = make_float4(v[j].x * rs * gg.x, v[j].y * rs * gg.y, v[j].z * rs * gg.z, v[j].w * rs * gg.w); }
#pragma unroll
        for (int j = 0; j < 4; ++j) { xw[j] = xn[j]; xn[j] = xm[j]; }
        iv = ivn; av = avn; ivn = ivm; avn = avm;
    }
}
typedef short bf16x8 __attribute__((ext_vector_type(8)));
typedef float f32x16 __attribute__((ext_vector_type(16)));
typedef short s16x4 __attribute__((ext_vector_type(4)));
typedef LAS const char* lds_cptr;
typedef unsigned u32x2 __attribute__((ext_vector_type(2)));
constexpr int VROW = 192;
constexpr int VSLOT = 32 * VROW;
constexpr int KROW = 144;
constexpr int KSLOT = 32 * KROW;
constexpr int MIX_WAVE_LDS = 16640;
constexpr int NWM = 6;
constexpr int MIX_BIAS_OFF = NWAVES * MIX_WAVE_LDS;
DEV int crow(int r, int hi) { return (r & 3) + 8 * (r >> 2) + 4 * hi; }
DEV s16x4 vtr(lds_cptr p) { return __builtin_bit_cast(s16x4, __builtin_amdgcn_ds_read_tr16_b64_v4i16((LAS s16x4*)p)); }
DEV bf16x8 tr_frag(lds_cptr slot, int s, int blk, int lane) {
    const int h = lane >> 5; lds_cptr p = slot + (16 * s + 4 * h + ((lane & 15) >> 2)) * VROW + (32 * blk + 16 * ((lane >> 4) & 1) + 4 * (lane & 3)) * 2;
    const s16x4 lo = vtr(p), hi = vtr(p + 8 * VROW);
    return (bf16x8){lo[0], lo[1], lo[2], lo[3], hi[0], hi[1], hi[2], hi[3]};
}
DEV void load_frags(bf16x8 (&f)[4], const bf16_t* rowp, int lane) {
    const int h = lane >> 5;
#pragma unroll
    for (int st = 0; st < 4; ++st) f[st] = *(const bf16x8*)(rowp + 16 * st + 8 * h);
}
DEV bf16x8 pack_p(const f32x16& p, int s) {
    u32x4 w; w.x = pg8::cvt_pk_bf16(p[8 * s], p[8 * s + 1]); w.y = pg8::cvt_pk_bf16(p[8 * s + 2], p[8 * s + 3]); w.z = pg8::cvt_pk_bf16(p[8 * s + 4], p[8 * s + 5]); w.w = pg8::cvt_pk_bf16(p[8 * s + 6], p[8 * s + 7]);
    return __builtin_bit_cast(bf16x8, w);
}

DEV void stage_rows_k(LAS unsigned char* ks, const u32x4 (&raw)[4], int lane) {
    const int rr = lane >> 3, ch = lane & 7;
#pragma unroll
    for (int i = 0; i < 4; ++i) *(LAS u32x4*)(ks + (rr + 8 * i) * KROW + ch * 16) = raw[i];
}
DEV void read_row_frags(bf16x8 (&f)[4], const LAS unsigned char* ks, int lane) {
    const LAS unsigned char* p = ks + (lane & 31) * KROW + (lane >> 5) * 16;
#pragma unroll
    for (int st = 0; st < 4; ++st) f[st] = *(const LAS bf16x8*)(p + st * 32);
}

DEV float other_half(float x) { const auto r = __builtin_amdgcn_permlane32_swap(__float_as_uint(x), __float_as_uint(x), false, false); return (threadIdx.x & 32) ? __uint_as_float(r[0]) : __uint_as_float(r[1]); }
DEV float max_halves(float x) { const auto r = __builtin_amdgcn_permlane32_swap(__float_as_uint(x), __float_as_uint(x), false, false); return fmaxf(__uint_as_float(r[0]), __uint_as_float(r[1])); }
DEV float sum_halves(float x) { const auto r = __builtin_amdgcn_permlane32_swap(__float_as_uint(x), __float_as_uint(x), false, false); return __uint_as_float(r[0]) + __uint_as_float(r[1]); }
#define MFMA32(a, b, c) __builtin_amdgcn_mfma_f32_32x32x16_bf16((a), (b), (c), 0, 0, 0)
DEV float ex2(float x) { return __builtin_amdgcn_exp2f(x); }

struct AttnIt { int p, bh, sh, L, r, q0, kmin, kmax; };
DEV void attn_decode(int li, int x, AttnIt& d) {
    d.p = li >> 9; d.bh = 8 * x + ((li >> 6) & 7); const int qblk = li & 63;
    d.sh = 2 * d.p; d.L = S >> d.sh; const int bpr = d.L >> 6;
    d.r = qblk / bpr; d.q0 = (qblk % bpr) * 64;
    d.kmin = d.q0 >= 64 ? 0 : 2; const int km = (d.L + 63 - d.q0) >> 5; d.kmax = km > 5 ? 5 : km;
}
DEV int med3i(int v, int lo, int hi) { return v < lo ? lo : (v > hi ? hi : v); }
DEV void attn_ldrows(const bf16_t* base, const AttnIt& d, int i0, u32x4 (&v)[4], int lane) {
    const int rr = lane >> 3, ch = lane & 7; const char* hb = (const char*)(base + (size_t)d.bh * S * HD); const unsigned cst = (unsigned)(d.r * 128 + ch * 16);
#pragma unroll
    for (int i = 0; i < 4; ++i) v[i] = *(const u32x4*)(hb + (((unsigned)med3i(i0 + rr + 8 * i, 0, d.L - 1) << (d.sh + 7)) + cst));
}
DEV void attn_ldkv(const Args& a, const AttnIt& d, int kk, u32x4 (&k)[4], u32x4 (&v)[4], int lane) {
    const int rr = lane >> 3, ch = lane & 7, i0 = d.q0 - 64 + 32 * kk; const unsigned cst = (unsigned)(d.r * 128 + ch * 16);
    const char* kb = (const char*)((const bf16_t*)(a.ws + WS_AK) + (size_t)d.bh * S * HD); const char* vb = (const char*)((const bf16_t*)(a.ws + WS_AV) + (size_t)d.bh * S * HD);
#pragma unroll
    for (int i = 0; i < 4; ++i) { const unsigned off = ((unsigned)med3i(i0 + rr + 8 * i, 0, d.L - 1) << (d.sh + 7)) + cst; k[i] = *(const u32x4*)(kb + off); v[i] = *(const u32x4*)(vb + off); }
}
DEV void attn_items(const Args& a, unsigned char* lds, int wg, int G, int lane, int wave) {
    unsigned char* ws = a.ws;
    constexpr int NIT = 3 * 512; constexpr float THR = 6.f;
    const int x = wg & 7, NGW = (G >> 3) * NWM;
    int item = (wg >> 3) * NWM + wave; if (item >= NIT) return;
    LAS unsigned char* slot = (LAS unsigned char*)lds + wave * MIX_WAVE_LDS; lds_cptr slot3 = (lds_cptr)slot; LAS unsigned char* kslot = slot + VSLOT;
    const int t = lane & 31, hi = lane >> 5, rr = lane >> 3, ch = lane & 7;
    AttnIt d; attn_decode(item, x, d);
    bf16x8 qf[2][4], kf[4]; u32x4 kraw[4], vv[4];
    attn_ldkv(a, d, d.kmin, kraw, vv, lane);
    for (;;) {
        const LAS float* tph = (const LAS float*)((LAS unsigned char*)lds + MIX_BIAS_OFF) + (d.p * NH + (d.bh & 7)) * 192 + (32 + 4 * hi - t);
        f32x16 o[2][2] = {}; float m[2] = {0.f, 0.f}, l[2] = {0.f, 0.f};
        const int nitem = item + NGW; const bool hasn = nitem < NIT;
        AttnIt dn = d; if (hasn) attn_decode(nitem, x, dn);
#pragma unroll
        for (int j = 0; j < 2; ++j) { u32x4 qraw[4]; attn_ldrows((const bf16_t*)(ws + WS_AQ), d, d.q0 + 32 * j, qraw, lane); stage_rows_k(kslot, qraw, lane); asm volatile("" ::: "memory"); read_row_frags(qf[j], kslot, lane); asm volatile("" ::: "memory"); }
        for (int kk = d.kmin; kk <= d.kmax; ++kk) {
            const int kbase = d.q0 - 64 + 32 * kk;
#pragma unroll
            for (int i = 0; i < 4; ++i) *(LAS u32x4*)(slot + (rr + 8 * i) * VROW + ch * 16) = vv[i];
            stage_rows_k(kslot, kraw, lane);
            asm volatile("" ::: "memory");
            read_row_frags(kf, kslot, lane);
            const bf16x8 v00 = tr_frag(slot3, 0, 0, lane), v10 = tr_frag(slot3, 1, 0, lane), v01 = tr_frag(slot3, 0, 1, lane), v11 = tr_frag(slot3, 1, 1, lane);
            asm volatile("" ::: "memory");
            if (kk < d.kmax) attn_ldkv(a, d, kk + 1, kraw, vv, lane);
            else if (hasn) attn_ldkv(a, dn, dn.kmin, kraw, vv, lane);
            const bool edge = kbase < 0 || kbase + 31 >= d.L;
            f32x16 sc[2] = {};
#pragma unroll
            for (int st = 0; st < 4; ++st) { sc[0] = MFMA32(kf[st], qf[0][st], sc[0]); sc[1] = MFMA32(kf[st], qf[1][st], sc[1]); }
            float mx[2]; bool mv = false;
#pragma unroll
            for (int j = 0; j < 2; ++j) {
                const int kj = kk - j; const bool act = kj >= 0 && kj <= 4; const LAS float* tb = tph + 32 * (act ? kj : 0); const float moff = act ? m[j] : 1e30f;
#pragma unroll
                for (int rg = 0; rg < 16; ++rg) sc[j][rg] = (sc[j][rg] - moff) + tb[(rg & 3) + 8 * (rg >> 2)];
                if (edge) {
#pragma unroll
                    for (int rg = 0; rg < 16; ++rg) { const int ki = kbase + crow(rg, hi); sc[j][rg] = (ki >= 0 && ki < d.L) ? sc[j][rg] : -1e30f; } }
                float t0 = fmaxf(fmaxf(sc[j][0], sc[j][1]), fmaxf(sc[j][2], sc[j][3]));
#pragma unroll
                for (int rg = 4; rg < 16; rg += 4) t0 = fmaxf(t0, fmaxf(fmaxf(sc[j][rg], sc[j][rg + 1]), fmaxf(sc[j][rg + 2], sc[j][rg + 3])));
                mx[j] = max_halves(t0);
                const bool first = act && (kj == 0 || kk == d.kmin);
                mv = mv || first || (act && __any(mx[j] > THR));
            }
            if (mv) {
#pragma unroll
                for (int j = 0; j < 2; ++j) { const int kj = kk - j; const bool act = kj >= 0 && kj <= 4, first = act && (kj == 0 || kk == d.kmin);
                    const float dl = !act ? 0.f : (first ? mx[j] : fmaxf(mx[j], 0.f)), f = ex2(-dl); m[j] += dl; l[j] *= f;
#pragma unroll
                    for (int rg = 0; rg < 16; ++rg) { sc[j][rg] -= dl; o[j][0][rg] *= f; o[j][1][rg] *= f; } }
            }
#pragma unroll
            for (int j = 0; j < 2; ++j) { float ps0 = 0.f, ps1 = 0.f;
#pragma unroll
                for (int rg = 0; rg < 16; rg += 2) { sc[j][rg] = ex2(sc[j][rg]); sc[j][rg + 1] = ex2(sc[j][rg + 1]); ps0 += sc[j][rg]; ps1 += sc[j][rg + 1]; }
                l[j] += ps0 + ps1; }
            { const bf16x8 p00 = pack_p(sc[0], 0), p01 = pack_p(sc[0], 1), p10 = pack_p(sc[1], 0), p11 = pack_p(sc[1], 1);
              o[0][0] = MFMA32(v00, p00, o[0][0]); o[0][1] = MFMA32(v01, p00, o[0][1]); o[1][0] = MFMA32(v00, p10, o[1][0]); o[1][1] = MFMA32(v01, p10, o[1][1]);
              o[0][0] = MFMA32(v10, p01, o[0][0]); o[0][1] = MFMA32(v11, p01, o[0][1]); o[1][0] = MFMA32(v10, p11, o[1][0]); o[1][1] = MFMA32(v11, p11, o[1][1]); }
        }
#pragma unroll
        for (int j = 0; j < 2; ++j) {
            float lt = sum_halves(l[j]);
            const float il = 1.f / lt;
            const size_t orow = ((size_t)d.p * NB * NH + d.bh) * S + (size_t)(((d.q0 + 32 * j + t) << d.sh) + d.r);
#pragma unroll
            for (int g4 = 0; g4 < 4; ++g4) {
                *(LAS u32x2*)(kslot + t * KROW + (8 * g4 + 4 * hi) * 2) = (u32x2){pg8::cvt_pk_bf16(o[j][0][4 * g4] * il, o[j][0][4 * g4 + 1] * il), pg8::cvt_pk_bf16(o[j][0][4 * g4 + 2] * il, o[j][0][4 * g4 + 3] * il)};
                *(LAS u32x2*)(kslot + t * KROW + (32 + 8 * g4 + 4 * hi) * 2) = (u32x2){pg8::cvt_pk_bf16(o[j][1][4 * g4] * il, o[j][1][4 * g4 + 1] * il), pg8::cvt_pk_bf16(o[j][1][4 * g4 + 2] * il, o[j][1][4 * g4 + 3] * il)};
            }
            asm volatile("" ::: "memory");
            { bf16_t* ob = (bf16_t*)(ws + WS_ATTO) + ((size_t)d.p * NB * NH + d.bh) * S * HD;
#pragma unroll
              for (int i = 0; i < 4; ++i) { const u32x4 w = *(const LAS u32x4*)(kslot + (rr + 8 * i) * KROW + ch * 16);
                  *(u32x4*)(ob + (size_t)(((d.q0 + 32 * j + rr + 8 * i) << d.sh) + d.r) * HD + ch * 8) = w; } }
            asm volatile("" ::: "memory");
            if (hi == 0) ((float*)(ws + WS_ATTL))[orow] = m[j] + __log2f(lt);
        }
        if (!hasn) break;
        item = nitem; d = dn;
    }
}
DEV void retstate_item(const Args& a, unsigned char* lds, int item, int xg, int lane, int wave) {
    unsigned char* ws = a.ws;
    const int dir = item & 1, n = (item >> 1) & 31, bh = 8 * xg + (item >> 6), h = bh & 7;
    const bf16_t* Kc = (const bf16_t*)(ws + WS_RK) + ((size_t)bh * S + n * 128) * HD; const bf16_t* Vc = (const bf16_t*)(ws + WS_RV) + ((size_t)bh * S + n * 128) * HD;
    const float lg = a.in[IN_DECAY][dir * NH + h] * LOG2E;
    LAS unsigned char* vs = (LAS unsigned char*)lds + wave * MIX_WAVE_LDS; LAS unsigned char* ks = vs + VSLOT; lds_cptr vs3 = (lds_cptr)vs, ks3 = (lds_cptr)ks;
    f32x16 acc[2][2] = {};
    for (int blk = 0; blk < 4; ++blk) {
        { const int rr = lane >> 3, ch = lane & 7;
          u32x4 v[4], k[4];
#pragma unroll
          for (int i = 0; i < 4; ++i) { const int mrow = 32 * blk + rr + 8 * i; v[i] = *(const u32x4*)(Vc + (size_t)mrow * HD + ch * 8); k[i] = *(const u32x4*)(Kc + (size_t)mrow * HD + ch * 8); }
#pragma unroll
          for (int i = 0; i < 4; ++i) { const int mrow = 32 * blk + rr + 8 * i; const float z = ex2(lg * (float)(dir == 0 ? 127 - mrow : mrow));
              const unsigned kw[4] = {k[i].x, k[i].y, k[i].z, k[i].w}; u32x4 o;
              o.x = pg8::cvt_pk_bf16(bf2f(kw[0] & 0xffffu) * z, bf2f(kw[0] >> 16) * z); o.y = pg8::cvt_pk_bf16(bf2f(kw[1] & 0xffffu) * z, bf2f(kw[1] >> 16) * z);
              o.z = pg8::cvt_pk_bf16(bf2f(kw[2] & 0xffffu) * z, bf2f(kw[2] >> 16) * z); o.w = pg8::cvt_pk_bf16(bf2f(kw[3] & 0xffffu) * z, bf2f(kw[3] >> 16) * z);
              *(LAS u32x4*)(vs + (rr + 8 * i) * VROW + ch * 16) = v[i]; *(LAS u32x4*)(ks + (rr + 8 * i) * VROW + ch * 16) = o; } }
        LDS_WAIT();
#pragma unroll
        for (int s = 0; s < 2; ++s) {
            const bf16x8 v0 = tr_frag(vs3, s, 0, lane), v1 = tr_frag(vs3, s, 1, lane), k0 = tr_frag(ks3, s, 0, lane), k1 = tr_frag(ks3, s, 1, lane);
            acc[0][0] = MFMA32(v0, k0, acc[0][0]); acc[0][1] = MFMA32(v0, k1, acc[0][1]); acc[1][0] = MFMA32(v1, k0, acc[1][0]); acc[1][1] = MFMA32(v1, k1, acc[1][1]);
        }
        LDS_WAIT();
    }
    bf16_t* KT = (bf16_t*)(ws + WS_KF) + (((size_t)dir * NB * NH + bh) * 32 + n) * 4096;
    const int c = lane & 31, hi = lane >> 5;
#pragma unroll
    for (int eb = 0; eb < 2; ++eb)
#pragma unroll
        for (int db = 0; db < 2; ++db)
#pragma unroll
            for (int rg = 0; rg < 16; ++rg) KT[(32 * eb + crow(rg, hi)) * 64 + 32 * db + c] = (bf16_t)f2bf(acc[eb][db][rg]);
}
DEV void phase_scan(const Args& a, int gtid, int NT) {
    unsigned char* ws = a.ws;
    for (int sl = gtid; sl < 2 * NB * NH * 1024; sl += NT) {
        const int dir = sl >> 16, bh = (sl >> 10) & 63, q = sl & 1023, h = bh & 7;
        const float gC = ex2(a.in[IN_DECAY][dir * NH + h] * LOG2E * 128.f);
        const uint2* kt = (const uint2*)(ws + WS_KF) + ((size_t)dir * NB * NH + bh) * 32 * 1024 + q;
        uint2* st = (uint2*)(ws + WS_ST) + ((size_t)dir * NB * NH + bh) * 32 * 1024 + q;
        float4 s = make_float4(0.f, 0.f, 0.f, 0.f);
        for (int i = 0; i < 32; ++i) { const int n = dir == 0 ? i : 31 - i;
            st[(size_t)n * 1024] = make_uint2(pg8::cvt_pk_bf16(s.x, s.y), pg8::cvt_pk_bf16(s.z, s.w));
            const uint2 kv = kt[(size_t)n * 1024];
            s.x = gC * s.x + bf2f(kv.x & 0xffffu); s.y = gC * s.y + bf2f(kv.x >> 16); s.z = gC * s.z + bf2f(kv.y & 0xffffu); s.w = gC * s.w + bf2f(kv.y >> 16); }
    }
}
DEV void ld_rows32(const bf16_t* base, u32x4 (&v)[4], int lane) {
    const char* b = (const char*)base; const unsigned off = (unsigned)((lane >> 3) * 128 + (lane & 7) * 16);
#pragma unroll
    for (int i = 0; i < 4; ++i) v[i] = *(const u32x4*)(b + off + i * 1024);
}
DEV void retout_item(const Args& a, unsigned char* lds, int item, int xg, int lane, int wave) {
    unsigned char* ws = a.ws;
    const int hq = item & 1, n = (item >> 1) & 31, bh = 8 * xg + (item >> 6), h = bh & 7, b = bh >> 3;
    const bf16_t* Qc = (const bf16_t*)(ws + WS_RQ) + ((size_t)bh * S + n * 128) * HD; const bf16_t* Kc = (const bf16_t*)(ws + WS_RK) + ((size_t)bh * S + n * 128) * HD;
    const bf16_t* Vc = (const bf16_t*)(ws + WS_RV) + ((size_t)bh * S + n * 128) * HD; const bf16_t* Gc = (const bf16_t*)(ws + WS_RG) + ((size_t)bh * S + n * 128) * HD;
    const bf16_t* SF = (const bf16_t*)(ws + WS_ST) + (((size_t)0 * NB * NH + bh) * 32 + n) * 4096; const bf16_t* SB = (const bf16_t*)(ws + WS_ST) + (((size_t)1 * NB * NH + bh) * 32 + n) * 4096;
    const float lg0 = a.in[IN_DECAY][h] * LOG2E, lg1 = a.in[IN_DECAY][NH + h] * LOG2E;
    LAS unsigned char* slot = (LAS unsigned char*)lds + wave * MIX_WAVE_LDS; lds_cptr slot3 = (lds_cptr)slot; LAS unsigned char* kslot = slot + VSLOT;
    const int t = lane & 31, hi = lane >> 5, rr = lane >> 3, ch = lane & 7;
    bf16x8 qf[2][4];
#pragma unroll
    for (int j = 0; j < 2; ++j) { u32x4 raw[4]; ld_rows32(Qc + (size_t)(64 * hq + 32 * j) * HD, raw, lane); stage_rows_k(kslot, raw, lane); asm volatile("" ::: "memory"); read_row_frags(qf[j], kslot, lane); asm volatile("" ::: "memory"); }
    f32x16 o[2][2] = {};
#pragma unroll
    for (int dir = 0; dir < 2; ++dir) {
#pragma unroll
        for (int eb = 0; eb < 2; ++eb) { u32x4 raw[4]; bf16x8 sf[4]; ld_rows32((dir == 0 ? SF : SB) + (size_t)(32 * eb) * 64, raw, lane); stage_rows_k(kslot, raw, lane); asm volatile("" ::: "memory"); read_row_frags(sf, kslot, lane); asm volatile("" ::: "memory");
#pragma unroll
            for (int j = 0; j < 2; ++j)
#pragma unroll
                for (int st = 0; st < 4; ++st) o[j][eb] = MFMA32(sf[st], qf[j][st], o[j][eb]); }
#pragma unroll
        for (int j = 0; j < 2; ++j) { const int c = 64 * hq + 32 * j + t; const float f = dir == 0 ? ex2(lg0 * (float)(c + 1) - lg1 * (float)(128 - c)) : ex2(lg1 * (float)(128 - c));
#pragma unroll
            for (int rg = 0; rg < 16; ++rg) { o[j][0][rg] *= f; o[j][1][rg] *= f; } }
    }
    float f1[4], f2[4], b1[4], b2[4];
#pragma unroll
    for (int i = 0; i < 4; ++i) { f1[i] = __builtin_bit_cast(float, __builtin_amdgcn_readfirstlane(__builtin_bit_cast(int, ex2(-lg0 * (float)i)))); f2[i] = __builtin_bit_cast(float, __builtin_amdgcn_readfirstlane(__builtin_bit_cast(int, ex2(-lg0 * (float)(8 * i)))));
        b1[i] = __builtin_bit_cast(float, __builtin_amdgcn_readfirstlane(__builtin_bit_cast(int, ex2(lg1 * (float)i)))); b2[i] = __builtin_bit_cast(float, __builtin_amdgcn_readfirstlane(__builtin_bit_cast(int, ex2(lg1 * (float)(8 * i))))); }
#pragma nounroll
    for (int kb = 0; kb < 4; ++kb) {
        { u32x4 kraw[4], vv[4]; ld_rows32(Kc + (size_t)(32 * kb) * HD, kraw, lane); ld_rows32(Vc + (size_t)(32 * kb) * HD, vv, lane);
#pragma unroll
        for (int i = 0; i < 4; ++i) *(LAS u32x4*)(slot + (rr + 8 * i) * VROW + ch * 16) = vv[i];
        stage_rows_k(kslot, kraw, lane); }
        asm volatile("" ::: "memory");
        bf16x8 kf[4]; read_row_frags(kf, kslot, lane);
        const bf16x8 v00 = tr_frag(slot3, 0, 0, lane), v10 = tr_frag(slot3, 1, 0, lane), v01 = tr_frag(slot3, 0, 1, lane), v11 = tr_frag(slot3, 1, 1, lane);
        asm volatile("" ::: "memory");
#pragma unroll
        for (int j = 0; j < 2; ++j) {
            const int qbi = 2 * hq + j;
            f32x16 sc = {};
#pragma unroll
            for (int st = 0; st < 4; ++st) sc = MFMA32(kf[st], qf[j][st], sc);
            if (kb < qbi) { const float A = ex2(lg0 * (float)(32 * (qbi - kb) + t - 4 * hi)); float a2[4];
#pragma unroll
                for (int q = 0; q < 4; ++q) a2[q] = A * f2[q];
#pragma unroll
                for (int rg = 0; rg < 16; ++rg) sc[rg] *= a2[rg >> 2] * f1[rg & 3];
            } else if (kb > qbi) { const float A = ex2(lg1 * (float)(32 * (kb - qbi) - t + 4 * hi)); float a2[4];
#pragma unroll
                for (int q = 0; q < 4; ++q) a2[q] = A * b2[q];
#pragma unroll
                for (int rg = 0; rg < 16; ++rg) sc[rg] *= a2[rg >> 2] * b1[rg & 3];
            } else {
                int tt = t - 4 * hi; asm volatile("" : "+v"(tt));
#pragma unroll
                for (int rg = 0; rg < 16; ++rg) { const int df = tt - ((rg & 3) + 8 * (rg >> 2)); sc[rg] *= df >= 0 ? ex2(lg0 * (float)df) : ex2(lg1 * (float)(-df)); }
            }
            const bf16x8 p0 = pack_p(sc, 0), p1 = pack_p(sc, 1);
            o[j][0] = MFMA32(v00, p0, o[j][0]); o[j][0] = MFMA32(v10, p1, o[j][0]);
            o[j][1] = MFMA32(v01, p0, o[j][1]); o[j][1] = MFMA32(v11, p1, o[j][1]);
        }
    }
    const float* gn = a.in[IN_GN] + h * HD; const unsigned gnoff = (unsigned)(16 * hi); LAS unsigned char* kq = kslot + t * KROW + 8 * hi;
#pragma unroll
    for (int j = 0; j < 2; ++j) {
        const int r0 = n * 128 + 64 * hq + 32 * j;
        { u32x4 raw[4]; ld_rows32(Gc + (size_t)(64 * hq + 32 * j) * HD, raw, lane); stage_rows_k(kslot, raw, lane); asm volatile("" ::: "memory"); }
        float sm = 0.f;
#pragma unroll
        for (int rg = 0; rg < 16; ++rg) sm += o[j][0][rg] + o[j][1][rg];
        sm = sum_halves(sm); const float mu = sm * (1.f / 64.f); float vq = 0.f;
#pragma unroll
        for (int rg = 0; rg < 16; ++rg) { const float d0 = o[j][0][rg] - mu, d1 = o[j][1][rg] - mu; vq += d0 * d0 + d1 * d1; }
        vq = sum_halves(vq); const float rstd = rsqrtf(vq * (1.f / 64.f) + EPS);
        u32x2 ow[2][4];
#pragma unroll
        for (int db = 0; db < 2; ++db)
#pragma unroll
            for (int g4 = 0; g4 < 4; ++g4) { const u32x2 gw = *(const LAS u32x2*)(kq + (32 * db + 8 * g4) * 2); const float4 gg = *(const float4*)((const char*)gn + gnoff + (32 * db + 8 * g4) * 4);
                const float gate[4] = {bf2f(gw[0] & 0xffffu), bf2f(gw[0] >> 16), bf2f(gw[1] & 0xffffu), bf2f(gw[1] >> 16)}; const float gv[4] = {gg.x, gg.y, gg.z, gg.w}; float ov[4];
#pragma unroll
                for (int i = 0; i < 4; ++i) ov[i] = (o[j][db][4 * g4 + i] - mu) * rstd * gv[i] * (gate[i] * __builtin_amdgcn_rcpf(1.f + ex2(-gate[i] * LOG2E)));
                ow[db][g4] = (u32x2){pg8::cvt_pk_bf16(ov[0], ov[1]), pg8::cvt_pk_bf16(ov[2], ov[3])}; }
        asm volatile("" ::: "memory");
#pragma unroll
        for (int db = 0; db < 2; ++db)
#pragma unroll
            for (int g4 = 0; g4 < 4; ++g4) *(LAS u32x2*)(kq + (32 * db + 8 * g4) * 2) = ow[db][g4];
        asm volatile("" ::: "memory");
        { bf16_t* ob = (bf16_t*)(ws + WS_XN) + ((size_t)b * S + r0) * D + h * HD;
#pragma unroll
          for (int i = 0; i < 4; ++i) { const u32x4 w = *(const LAS u32x4*)(kslot + (rr + 8 * i) * KROW + ch * 16); *(u32x4*)(ob + (size_t)(rr + 8 * i) * D + ch * 8) = w; } }
        asm volatile("" ::: "memory");
    }
}
DEV void phase_attn_merge(const Args& a, int gtid, int NT) {
    unsigned char* ws = a.ws; const float* L = (const float*)(ws + WS_ATTL); const bf16_t* O = (const bf16_t*)(ws + WS_ATTO); bf16_t* mixed = (bf16_t*)(ws + WS_XN);
    for (int it = gtid; it < NB * NH * S * 8; it += NT) {
        const int ch = it & 7, row = it >> 3;
        const int bh = row >> 12, pos = row & 4095, b = bh >> 3, h = bh & 7;
        const float l0 = L[row], l1 = L[(size_t)NB * NH * S + row], l2 = L[(size_t)2 * NB * NH * S + row];
        const float mx = fmaxf(l0, fmaxf(l1, l2)); float w0 = ex2(l0 - mx), w1 = ex2(l1 - mx), w2 = ex2(l2 - mx); const float is = 1.f / (w0 + w1 + w2); w0 *= is; w1 *= is; w2 *= is;
        const uint4 a0 = *(const uint4*)(O + (size_t)row * HD + ch * 8), a1 = *(const uint4*)(O + ((size_t)NB * NH * S + row) * HD + ch * 8), a2 = *(const uint4*)(O + ((size_t)2 * NB * NH * S + row) * HD + ch * 8);
        const unsigned x0[4] = {a0.x, a0.y, a0.z, a0.w}, x1[4] = {a1.x, a1.y, a1.z, a1.w}, x2[4] = {a2.x, a2.y, a2.z, a2.w}; unsigned o[4];
#pragma unroll
        for (int j = 0; j < 4; ++j) o[j] = pg8::cvt_pk_bf16(w0 * bf2f(x0[j] & 0xffffu) + w1 * bf2f(x1[j] & 0xffffu) + w2 * bf2f(x2[j] & 0xffffu), w0 * bf2f(x0[j] >> 16) + w1 * bf2f(x1[j] >> 16) + w2 * bf2f(x2[j] >> 16));
        *(uint4*)(mixed + ((size_t)b * S + pos) * D + 512 + h * HD + ch * 8) = make_uint4(o[0], o[1], o[2], o[3]);
    }
}
DEV void phase_mix_a(const Args& a, unsigned char* lds, int wg, int G, int lane, int wave, int tid) {
    { const float* bt = (const float*)(a.ws + WS_BIAS); LAS float* bl = (LAS float*)((LAS unsigned char*)lds + MIX_BIAS_OFF);
      for (int i = tid; i < 3 * NH * 192; i += NTHR) { const int ph = i / 192, bi = i % 192 - 32; bl[i] = (bi >= 0 && bi <= 128) ? bt[ph * 129 + bi] : -1e30f; } }
    __syncthreads();
    if (wave >= NWM) {
        for (int rep = 0; rep < a.rep[5]; ++rep) { asm volatile("" : "+v"(lane)); phase_latew(a, lds, wg * (NWAVES - NWM) + (wave - NWM), G * (NWAVES - NWM), lane, wave); }
        return;
    }
    const int x = wg & 7, wq = (wg >> 3) * NWM + wave, WPX = (G >> 3) * NWM;
    for (int rep = 0; rep < a.rep[0]; ++rep) { asm volatile("" : "+v"(lane)); for (int it = wq; it < 2 * 32 * NH; it += WPX) retstate_item(a, lds, it, x, lane, wave); }
    for (int rep = 0; rep < a.rep[1]; ++rep) { asm volatile("" : "+v"(lane)); attn_items(a, lds, wg, G, lane, wave); }
}
DEV void phase_mix_b(const Args& a, unsigned char* lds, int wg, int G, int lane, int wave, int tid) {
    const int x = wg & 7, wq = (wg >> 3) * NWAVES + wave, WPX = (G >> 3) * NWAVES;
    for (int rep = 0; rep < a.rep[2]; ++rep) { asm volatile("" : "+v"(lane)); for (int it = wq; it < NH * 32 * 2; it += WPX) retout_item(a, lds, it, x, lane, wave); }
    for (int rep = 0; rep < a.rep[3]; ++rep) { asm volatile("" : "+v"(tid)); phase_attn_merge(a, wg * NTHR + tid, G * NTHR); }
}
#define XB_TMO      128
#define XB_XCNT(j)  (256  + 64 * (j))
#define XB_XSUB(j)  (1280 + 64 * (j))
#define XB_XGEN(j)  (2304 + 64 * (j))
#define XB_TOP      3328
#define XB_TOPGEN   3392
#define XCD_BAR_WORDS 3456
#define XB_SPIN_CAP (1u << 18)

__device__ __forceinline__ unsigned xb_ld(unsigned* p)              { return __hip_atomic_load(p, __ATOMIC_RELAXED, __HIP_MEMORY_SCOPE_AGENT); }
__device__ __forceinline__ unsigned xb_add(unsigned* p, unsigned v) { return __hip_atomic_fetch_add(p, v, __ATOMIC_RELAXED, __HIP_MEMORY_SCOPE_AGENT); }
__device__ __forceinline__ unsigned xb_xcc_id() { return (unsigned)__builtin_amdgcn_s_getreg((3 << 11) | 20) & 0xFu; }
#define XB_SPIN(cond, bar) do { unsigned _sp = 0; while (cond) { __builtin_amdgcn_s_sleep(1); \
    if ((++_sp & 255u) == 0u) { if (xb_ld(&(bar)[XB_TMO])) break; if (_sp > XB_SPIN_CAP) { atomicAdd(&(bar)[XB_TMO], 1u); break; } } } } while (0)

struct XcdBarrier {
    unsigned* bar; unsigned x;
    volatile LAS unsigned* st;
};

__device__ __forceinline__ XcdBarrier xcd_barrier_post(unsigned* bar, volatile LAS unsigned* st) {
    XcdBarrier b; b.bar = bar; b.x = xb_xcc_id(); b.st = st;
    if (threadIdx.x == 0) (void)xb_add(&bar[XB_XCNT(b.x)], 1u);
    return b;
}
__device__ __forceinline__ void xcd_barrier_complete(unsigned* bar, unsigned x, unsigned& nloc, unsigned& nx) {
    const unsigned G = gridDim.x * gridDim.y * gridDim.z;
    unsigned sum, cnt, mine, sp = 0u;
    for (;;) {
        sum = 0u; cnt = 0u; mine = 0u;
#pragma unroll
        for (unsigned j = 0; j < 16; ++j) { const unsigned c = xb_ld(&bar[XB_XCNT(j)]); sum += c; cnt += (c > 0u) ? 1u : 0u; mine = (j == x) ? c : mine; }
        if (sum == G) break;
        __builtin_amdgcn_s_sleep(1);
        if ((++sp & 255u) == 0u) { if (xb_ld(&bar[XB_TMO])) break; if (sp > XB_SPIN_CAP) { atomicAdd(&bar[XB_TMO], 1u); break; } }
    }
    nloc = mine > 0u ? mine : 1u; nx = cnt > 0u ? cnt : 1u;
}

__device__ __forceinline__ void xcd_barrier(const XcdBarrier& b) {
    asm volatile("s_waitcnt vmcnt(0)" ::: "memory");
    __syncthreads();
    if (threadIdx.x == 0) {
        unsigned* bar = b.bar;
        __builtin_amdgcn_s_waitcnt(0);
        unsigned nloc = b.st[0], nx = b.st[1];
        if (nloc == 0u) { xcd_barrier_complete(bar, b.x, nloc, nx); b.st[0] = nloc; b.st[1] = nx; }
        const unsigned old = xb_add(&bar[XB_XSUB(b.x)], 1u);
        const unsigned gen = old / nloc;
        if (old + 1u == (gen + 1u) * nloc) {
            __builtin_amdgcn_fence(__ATOMIC_RELEASE, "agent");
            asm volatile("s_waitcnt vmcnt(0)" ::: "memory");
            const unsigned og = xb_add(&bar[XB_TOP], 1u);
            const unsigned tg = og / nx;
            if (og + 1u == (tg + 1u) * nx) xb_add(&bar[XB_TOPGEN], 1u);
            else XB_SPIN(xb_ld(&bar[XB_TOPGEN]) == tg, bar);
            __builtin_amdgcn_fence(__ATOMIC_ACQUIRE, "agent");
            xb_add(&bar[XB_XGEN(b.x)], 1u);
            asm volatile("s_waitcnt vmcnt(0)" ::: "memory");
        } else {
            XB_SPIN(xb_ld(&bar[XB_XGEN(b.x)]) == gen, bar);
            __builtin_amdgcn_fence(__ATOMIC_ACQUIRE, "agent");
            asm volatile("s_waitcnt vmcnt(0)" ::: "memory");
        }
    }
    __syncthreads();
}

#ifndef MK_LAUNCHES
#define MK_LAUNCHES 1
#endif
#ifndef WGM_MOE1
#define WGM_MOE1 8
#endif
#ifndef WGM_MOE2
#define WGM_MOE2 8
#endif
constexpr int NPH = 11;
typedef const __attribute__((address_space(4))) Args* kargs_t;
DEV Args load_args(kargs_t kp) { Args a;
#pragma unroll
    for (int i = 0; i < 13; ++i) a.in[i] = kp->in[i];
    a.out = kp->out; a.ws = kp->ws; a.ph_lo = kp->ph_lo; a.ph_hi = kp->ph_hi;
#pragma unroll
    for (int i = 0; i < 16; ++i) a.rep[i] = kp->rep[i];
    return a; }
#ifndef PROBE_REP
#define PROBE_REP 0
#endif
#define REP(k) if (((PROBE_REP) >> (k)) & 1) for (int _r = 0; _r < 2; ++_r, cg::this_grid().sync())
__global__ void __launch_bounds__(NTHR, 2) mega(Args a_) {
    kargs_t kp = (kargs_t)__builtin_amdgcn_kernarg_segment_ptr();
    extern __shared__ __attribute__((aligned(16))) unsigned char lds[];
    int tid = threadIdx.x, lane = tid & 63, wave = __builtin_amdgcn_readfirstlane(tid >> 6);
    const int G = gridDim.x, wg = blockIdx.x, NGW = G * NWAVES; int gw = wg * NWAVES + wave;
#define FRESH_IDS() do { tid = threadIdx.x; asm volatile("" : "+v"(tid)); lane = tid & 63; wave = __builtin_amdgcn_readfirstlane(tid >> 6); gw = wg * NWAVES + wave; } while (0)
    const int lo = kp->ph_lo, hi = kp->ph_hi;
    unsigned char* ws = kp->ws;
    volatile LAS unsigned* bst = (volatile LAS unsigned*)((LAS unsigned char*)lds + LDS_BYTES - 64);
    if (tid < 2) bst[tid] = 0u;
    __syncthreads();
    XcdBarrier bar = xcd_barrier_post((unsigned*)(ws + WS_CTL) + 4096, bst);
#define IN(k) (lo <= (k) && (k) < hi)
#define SEAM(k) do { if (IN(k) && IN((k) + 1)) { xcd_barrier(bar); } } while (0)
    if (IN(0)) { FRESH_IDS(); const Args a = load_args(kp); unsigned char* ws = a.ws; for (int r = 0; r < a.rep[6]; ++r) { FRESH_IDS(); phase_prep(a, lds, gw, NGW, lane, wave); } }
    SEAM(0);
    if (IN(1)) { FRESH_IDS(); const Args a = load_args(kp); unsigned char* ws = a.ws; pg8::Gemm g{(const bf16_t*)(ws + WS_XN), (const bf16_t*)(ws + WS_WIN), D}; SchedPlain Sc; Sc.init(M, PC, G, wg); Sc.rowbytes = D * 2;
        EpiInProj E{ws, (const float*)(ws + WS_ROPE)};
        for (int r = 0; r < a.rep[8]; ++r) { FRESH_IDS(); pg8::Gemm g2 = g; asm volatile("" : "+s"(g2.A), "+s"(g2.Bt)); pg8::gemm_phase<EpiInProj, SchedPlain, true>((LAS unsigned char*)lds, g2, Sc, E); } }
    SEAM(1);
    if (IN(2)) { FRESH_IDS(); const Args a = load_args(kp); unsigned char* ws = a.ws; phase_mix_a(a, lds, wg, G, lane, wave, tid); }
    SEAM(2);
    if (IN(3)) { FRESH_IDS(); const Args a = load_args(kp); unsigned char* ws = a.ws; for (int r = 0; r < a.rep[13]; ++r) { FRESH_IDS(); phase_scan(a, wg * NTHR + tid, G * NTHR); } }
    SEAM(3);
    if (IN(4)) { FRESH_IDS(); const Args a = load_args(kp); unsigned char* ws = a.ws; phase_mix_b(a, lds, wg, G, lane, wave, tid); }
    SEAM(4);
    { const Args a = load_args(kp); for (int r = 0; r < a.rep[14]; ++r) xcd_barrier(bar); for (int r = 0; r < a.rep[15]; ++r) cg::this_grid().sync(); }
    if (IN(5)) { FRESH_IDS(); const Args a = load_args(kp); unsigned char* ws = a.ws; pg8::Gemm g{(const bf16_t*)(ws + WS_XN), (const bf16_t*)(ws + WS_WOUT), D}; SchedPlain Sc; Sc.init(M, D, G, wg); Sc.rowbytes = D * 2;
        EpiOutProj E{a.in[IN_X], (bf16_t*)(ws + WS_X1)};
        for (int r = 0; r < a.rep[9]; ++r) { FRESH_IDS(); pg8::Gemm g2 = g; asm volatile("" : "+s"(g2.A), "+s"(g2.Bt)); pg8::gemm_phase<EpiOutProj, SchedPlain, true>((LAS unsigned char*)lds, g2, Sc, E); } }
    SEAM(5);
    if (IN(6)) { FRESH_IDS(); const Args a = load_args(kp); unsigned char* ws = a.ws; for (int r = 0; r < a.rep[4]; ++r) { FRESH_IDS(); phase_router(a, lds, gw, NGW, lane, tid); } }
    SEAM(6);
    if (IN(7)) { FRESH_IDS(); const Args a = load_args(kp); unsigned char* ws = a.ws; for (int r = 0; r < a.rep[7]; ++r) { FRESH_IDS(); phase_topk(a, lds, wg, G, tid, lane, wave); } }
    SEAM(7);
    if (IN(8)) { FRESH_IDS(); const Args a = load_args(kp); unsigned char* ws = a.ws; pg8::Gemm g{(const bf16_t*)(ws + WS_XN), (const bf16_t*)(ws + WS_WGU), D}; SchedMoe1 Sc; Sc.init(MR, 4096, G, wg, WGM_MOE1); Sc.idxl = (const LAS int*)((LAS unsigned char*)lds + 131072);
        { const int* idxg = (const int*)(ws + WS_IDX); LAS int* il = (LAS int*)((LAS unsigned char*)lds + 131072); pg8::Unit uu;
          for (int i = 0; i < 16; ++i) if (Sc.next(i, uu) && tid < 256) il[i * 256 + tid] = idxg[uu.pm * 256 + tid];
          __syncthreads(); }
        EpiSwiGLU E{ws + WS_HID};
        for (int r = 0; r < a.rep[10]; ++r) { FRESH_IDS(); pg8::Gemm g2 = g; asm volatile("" : "+s"(g2.A), "+s"(g2.Bt)); pg8::gemm_phase<EpiSwiGLU, SchedMoe1, true, true>((LAS unsigned char*)lds, g2, Sc, E); } }
    SEAM(8);
    if (IN(9)) { FRESH_IDS(); const Args a = load_args(kp); unsigned char* ws = a.ws; pg8::Gemm g{(const bf16_t*)(ws + WS_HID), (const bf16_t*)(ws + WS_WD), DFF}; SchedMoe2 Sc; Sc.init(MR, D, G, wg, WGM_MOE2);
        EpiDown E{ws + WS_Y};
        for (int r = 0; r < a.rep[11]; ++r) { FRESH_IDS(); pg8::Gemm g2 = g; asm volatile("" : "+s"(g2.A), "+s"(g2.Bt)); pg8::gemm_phase<EpiDown, SchedMoe2, true, true>((LAS unsigned char*)lds, g2, Sc, E); } }
    SEAM(9);
    if (IN(10)) { FRESH_IDS(); const Args a = load_args(kp); unsigned char* ws = a.ws; for (int r = 0; r < a.rep[12]; ++r) { FRESH_IDS(); phase_final(a, gw, NGW, lane); } }
#undef IN
#undef SEAM
}

extern "C" void kernel_launch(void* const* d_in, const int* in_sizes, int n_in, void* d_out, int out_size, void* d_ws, size_t ws_size, hipStream_t stream) {
    static int grid = 0;
    if (grid == 0) {
        if (n_in != 13 || in_sizes[0] != M * D || out_size != M * D || ws_size < WS_END) { fprintf(stderr, "kernel_launch: unexpected shapes n_in %d in0 %d out %d ws %zu (need %zu)\n", n_in, n_in > 0 ? in_sizes[0] : -1, out_size, ws_size, (size_t)WS_END); grid = -1; return; }
        int dev = 0, cus = 0, per_cu = 0;
        (void)hipGetDevice(&dev); (void)hipDeviceGetAttribute(&cus, hipDeviceAttributeMultiprocessorCount, dev);
        (void)hipFuncSetAttribute((const void*)mega, hipFuncAttributeMaxDynamicSharedMemorySize, LDS_BYTES);
        if (hipOccupancyMaxActiveBlocksPerMultiprocessor(&per_cu, (const void*)mega, NTHR, LDS_BYTES) != hipSuccess || per_cu < 1) { fprintf(stderr, "kernel_launch: occupancy query says %d blocks/CU\n", per_cu); per_cu = 1; }
        (void)hipGetLastError();
        grid = cus * 1;
        if (grid > cus * per_cu) grid = cus * per_cu;
    }
    if (grid < 0) return;
    (void)hipMemsetAsync((char*)d_ws + WS_CTL + 16384, 0, 16384, stream);
    Args a{};
    for (int i = 0; i < 13; ++i) a.in[i] = (const float*)d_in[i];
    a.out = (float*)d_out; a.ws = (unsigned char*)d_ws;
#ifndef PROBE_R
#define PROBE_R {1, 1, 1, 1, 1, 1, 1, 1, 1, 1, 1, 1, 1, 1, 0, 0}
#endif
    { const int rr[16] = PROBE_R; for (int i = 0; i < 16; ++i) a.rep[i] = rr[i]; }
#if MK_LAUNCHES == 1
    a.ph_lo = 0; a.ph_hi = NPH;
    void* args[] = {&a};
    hipError_t e = hipLaunchCooperativeKernel((const void*)mega, dim3(grid), dim3(NTHR), args, LDS_BYTES, stream);
    if (e != hipSuccess) fprintf(stderr, "cooperative launch failed: %s (grid %d)\n", hipGetErrorString(e), grid);
#else
    for (int p = 0; p < NPH; ++p) { a.ph_lo = p; a.ph_hi = p + 1; hipLaunchKernelGGL(mega, dim3(grid), dim3(NTHR), LDS_BYTES, stream, a); }
#endif
}
```

```cpp
#include <hip/hip_runtime.h>
#include <hip/hip_cooperative_groups.h>
#include <cstdint>
#include <cstdio>
namespace cg = cooperative_groups;

typedef unsigned short bf16_t;
#define DEV __device__ __forceinline__
#define LAS __attribute__((address_space(3)))

constexpr int NB = 8, S = 4096, D = 1024, M = NB * S;
constexpr int NH = 8, HD = 64, PC = 3584;
constexpr int NE = 16, CAP = 512, DFF = 2048, MR = NE * NB * CAP;
constexpr float EPS = 1e-6f, LOG2E = 1.4426950408889634f;
constexpr int NWAVES = 8, NTHR = 512;
constexpr int LDS_BYTES = 163840;

constexpr size_t MiB = 1u << 20;
constexpr size_t WS_CTL = 0;
constexpr size_t WS_ROPE = 1 * MiB;
constexpr size_t WS_BIAS = 2 * MiB;
constexpr size_t WS_IDX = 2 * MiB + 512 * 1024;
constexpr size_t WS_AFF = 3 * MiB;
constexpr size_t WS_INV = 5 * MiB;
constexpr size_t WS_AFFT = 9 * MiB;
constexpr size_t WS_WOUT = 7 * MiB;
constexpr size_t WS_WIN = 9 * MiB;
constexpr size_t WS_XN = 16 * MiB;
constexpr size_t WS_RQ = 80 * MiB, WS_RK = 112 * MiB, WS_RV = 144 * MiB, WS_RG = 176 * MiB;
constexpr size_t WS_AQ = 208 * MiB, WS_AK = 240 * MiB, WS_AV = 272 * MiB;
constexpr size_t WS_ATTO = 304 * MiB;
constexpr size_t WS_ATTL = 3 * MiB;
constexpr size_t WS_KF = 400 * MiB;
constexpr size_t WS_X1 = 80 * MiB;
constexpr size_t WS_ST = 208 * MiB;
constexpr size_t WS_WD = 432 * MiB;
constexpr size_t WS_WGU = 464 * MiB;
constexpr size_t WS_Y = 144 * MiB;
constexpr size_t WS_HID = 272 * MiB;
constexpr size_t WS_END = 528 * MiB;

DEV unsigned f2bf(float f) { unsigned u = __float_as_uint(f); return (u + 0x7fffu + ((u >> 16) & 1u)) >> 16; }
DEV float bf2f(unsigned h) { return __uint_as_float(h << 16); }
DEV unsigned pk2(float lo, float hi) { return f2bf(lo) | (f2bf(hi) << 16); }
#define DPPF(x, ctrl) __builtin_bit_cast(float, __builtin_amdgcn_update_dpp(__builtin_bit_cast(int, (x)), __builtin_bit_cast(int, (x)), (ctrl), 0xF, 0xF, false))
DEV float lane_x1(float x) { return DPPF(x, 0xB1); }
DEV float lane_x2(float x) { return DPPF(x, 0x4E); }
DEV float lane_m8(float x) { return DPPF(x, 0x141); }
DEV float lane_x8(float x) { return DPPF(x, 0x128); }
DEV float lane_x16(float x) { const auto r = __builtin_amdgcn_permlane16_swap(__float_as_uint(x), __float_as_uint(x), false, false); return (threadIdx.x & 16) ? __uint_as_float(r[0]) : __uint_as_float(r[1]); }
DEV float lane_x32(float x) { const auto r = __builtin_amdgcn_permlane32_swap(__float_as_uint(x), __float_as_uint(x), false, false); return (threadIdx.x & 32) ? __uint_as_float(r[0]) : __uint_as_float(r[1]); }
DEV float wave_sum(float v) {
    v += lane_x1(v); v += lane_x2(v); v += lane_m8(v); v += lane_x8(v); v += lane_x16(v); v += lane_x32(v);
    return v;
}
#define LDS_WAIT() asm volatile("s_waitcnt lgkmcnt(0)" ::: "memory")
namespace pg8 {
#define PG8_LAS __attribute__((address_space(3)))
typedef short bf16x8 __attribute__((ext_vector_type(8)));
typedef float f32x4 __attribute__((ext_vector_type(4)));
typedef unsigned u32x4 __attribute__((ext_vector_type(4)));
constexpr int BM = 256, BK = 64, HALF = 128, HTB = HALF * BK * 2, STAGE_BYTES = 8 * HTB, NXCD = 8, WGM = 8;
__host__ __device__ __forceinline__ int lds_byte(int r, int c) { const int st = (r >> 4) * 2 + (c >> 5), rr = r & 15, cc = c & 31, ob = rr * 64 + cc * 2; return st * 1024 + (ob ^ (((ob >> 9) & 1) << 5)); }
__host__ __device__ __forceinline__ void stage_rc(int b, int& R, int& C) { const int st = b / 1024, sb = b % 1024, swz = sb ^ (((sb >> 9) & 1) << 5); R = (st >> 1) * 16 + swz / 64; C = (st & 1) * 32 + (swz % 64) / 2; }
__host__ __device__ __forceinline__ int perm32(int rho) { const int n = rho >> 4, i = rho & 15; return 8 * (i >> 2) + 4 * n + (i & 3); }
struct Unit { int pm, pn, ui; };
struct Gemm { const bf16_t* A; const bf16_t* Bt; int K; };
struct StaticOrder {
    int nM, nN, nwg, G, c, wgm;
    __device__ void init(int M_, int N_, int G_, int c_, int wgm_ = WGM) { nM = M_ / BM; nN = N_ / BM; nwg = nM * nN; G = G_; c = c_; wgm = wgm_; }
    __device__ bool next(int i, Unit& u) const {
        const long L = (long)i * G + c; if (L >= nwg) return false;
        int wgid = (int)L; { const int q = nwg / NXCD, r = nwg % NXCD, xcd = wgid % NXCD, off = wgid / NXCD; wgid = (xcd < r ? xcd * (q + 1) : r * (q + 1) + (xcd - r) * q) + off; }
        const int nig = wgm * nN, gid = wgid / nig, fm = gid * wgm, gsz = (nM - fm) < wgm ? (nM - fm) : wgm;
        u.pm = fm + ((wgid % nig) % gsz); u.pn = (wgid % nig) / gsz; return true;
    }
};
__device__ __forceinline__ unsigned cvt_pk_bf16(float lo, float hi) { unsigned r; asm volatile("v_cvt_pk_bf16_f32 %0, %1, %2" : "=v"(r) : "v"(lo), "v"(hi)); return r; }

typedef int v8i __attribute__((ext_vector_type(8)));
template <class Epi, class Sched, bool ALIGN_EPI, bool FP8 = false>
__device__ __forceinline__ void gemm_phase(PG8_LAS unsigned char* lds, const Gemm g, const Sched& S, const Epi& E) {
    const int tid = threadIdx.x, wid = __builtin_amdgcn_readfirstlane(tid >> 6), lane = tid & 63, wr = wid >> 2, wc = wid & 3, fr = lane & 15, fq = lane >> 4;
    const int K = g.K, RB = FP8 ? K : 2 * K, nt = RB / 128;
    unsigned voffB[2];
#pragma unroll
    for (int i = 0; i < 2; ++i) { int R, C; stage_rc(tid * 16 + i * 8192, R, C); const int Rb = Epi::PERM ? ((R & ~31) + perm32(R & 31)) : R;
        voffB[i] = (unsigned)(Rb * RB + C * 2); }
    const size_t kstep = (size_t)(BK * 2);
    const size_t hstep = (size_t)HALF * RB;
    const size_t tstep = 2 * hstep;
    const unsigned ldsw = (unsigned)wid * 1024u;
    const int aoff = FP8 ? lds_byte(wr * 64 + fr, fq * 16) : lds_byte(wr * 64 + fr, fq * 8), boff = FP8 ? lds_byte(wc * 32 + fr, fq * 16) : lds_byte(wc * 32 + fr, fq * 8);
    const int x16 = 16 * (fq & 1);
    const char* gA = (const char*)g.A;
#define PG8_SA(b, h) (((b) * 2 + (h)) * HTB)
#define PG8_SB(b, h) ((4 + (b) * 2 + (h)) * HTB)
#define PG8_STAGE(bufoff, gbase, voff) do { _Pragma("unroll") for (int _i = 0; _i < 2; ++_i) \
        __builtin_amdgcn_global_load_lds((const unsigned*)((const char*)(gbase) + (voff)[_i]), (PG8_LAS unsigned*)(lds + (bufoff) + ldsw + _i * 8192), 16, 0, 0); } while (0)
#define PG8_STAGE_A(bufoff, AO, h, kb) do { _Pragma("unroll") for (int _i = 0; _i < 2; ++_i) \
        __builtin_amdgcn_global_load_lds((const unsigned*)(gA + (size_t)((AO)[h][_i] + (unsigned)(kb))), (PG8_LAS unsigned*)(lds + (bufoff) + ldsw + _i * 8192), 16, 0, 0); } while (0)
#define PG8_LDA(dst, b, h) do { if constexpr (FP8) { _Pragma("unroll") for (int m = 0; m < 4; ++m) { dst[m][0] = *(const PG8_LAS bf16x8*)(lds + PG8_SA(b, h) + aoff + m * 2048 + x16); dst[m][1] = *(const PG8_LAS bf16x8*)(lds + PG8_SA(b, h) + aoff + m * 2048 + 16 - x16); } } \
    else { _Pragma("unroll") for (int m = 0; m < 4; ++m) _Pragma("unroll") for (int k = 0; k < 2; ++k) dst[m][k] = *(const PG8_LAS bf16x8*)(lds + PG8_SA(b, h) + aoff + m * 2048 + k * 1024); } } while (0)
#define PG8_LDB(dst, b, h) do { if constexpr (FP8) { _Pragma("unroll") for (int n = 0; n < 2; ++n) { dst[n][0] = *(const PG8_LAS bf16x8*)(lds + PG8_SB(b, h) + boff + n * 2048 + x16); dst[n][1] = *(const PG8_LAS bf16x8*)(lds + PG8_SB(b, h) + boff + n * 2048 + 16 - x16); } } \
    else { _Pragma("unroll") for (int n = 0; n < 2; ++n) _Pragma("unroll") for (int k = 0; k < 2; ++k) dst[n][k] = *(const PG8_LAS bf16x8*)(lds + PG8_SB(b, h) + boff + n * 2048 + k * 1024); } } while (0)
#define PG8_CAT8(x) __builtin_bit_cast(v8i, __builtin_shufflevector((x)[0], (x)[1], 0, 1, 2, 3, 4, 5, 6, 7, 8, 9, 10, 11, 12, 13, 14, 15))
#define PG8_MMA(ai, bj, At, Bt) do { __builtin_amdgcn_s_setprio(1); if constexpr (FP8) { _Pragma("unroll") for (int m = 0; m < 4; ++m) _Pragma("unroll") for (int n = 0; n < 2; ++n) \
        acc[ai][bj][m][n] = __builtin_amdgcn_mfma_scale_f32_16x16x128_f8f6f4(PG8_CAT8(Bt[n]), PG8_CAT8(At[m]), acc[ai][bj][m][n], 0, 0, 0, 0, 0, 0); } \
    else { _Pragma("unroll") for (int m = 0; m < 4; ++m) _Pragma("unroll") for (int n = 0; n < 2; ++n) _Pragma("unroll") for (int k = 0; k < 2; ++k) \
        acc[ai][bj][m][n] = __builtin_amdgcn_mfma_f32_16x16x32_bf16(Bt[n][k], At[m][k], acc[ai][bj][m][n], 0, 0, 0); } __builtin_amdgcn_s_setprio(0); } while (0)
#define PG8_WAIT_V(n) asm volatile("s_waitcnt vmcnt(" #n ")" ::: "memory")
#define PG8_WAIT_L(n) asm volatile("s_waitcnt lgkmcnt(" #n ")" ::: "memory")
#define PG8_BAR __builtin_amdgcn_s_barrier()
#define PG8_SCHED __builtin_amdgcn_sched_barrier(0)
#define PG8_AOFFS(AO, u) do { int _t = threadIdx.x; asm volatile("" : "+v"(_t)); _Pragma("unroll") for (int _i = 0; _i < 2; ++_i) { int _R, _C; stage_rc(_t * 16 + _i * 8192, _R, _C); \
        _Pragma("unroll") for (int _h = 0; _h < 2; ++_h) (AO)[_h][_i] = S.row_off(u, _h * HALF + _R) + (unsigned)(_C * 2); } } while (0)
    Unit cur, nxt; int ui = 0;
    if (!S.next(0, cur)) return;
    f32x4 acc[2][2][4][2];
#pragma unroll
    for (int a = 0; a < 2; ++a)
#pragma unroll
        for (int b = 0; b < 2; ++b)
#pragma unroll
            for (int m = 0; m < 4; ++m)
#pragma unroll
                for (int n = 0; n < 2; ++n) acc[a][b][m][n] = (f32x4){0.f, 0.f, 0.f, 0.f};
    bf16x8 At[4][2], B0[2][2], B1[2][2];
    unsigned aoc[2][2];
    PG8_AOFFS(aoc, cur);
    const char* cB = (const char*)g.Bt + (size_t)cur.pn * tstep;
    PG8_STAGE(PG8_SB(0, 0), cB, voffB); PG8_STAGE(PG8_SB(0, 1), cB + hstep, voffB); PG8_STAGE_A(PG8_SA(0, 0), aoc, 0, 0); PG8_STAGE_A(PG8_SA(0, 1), aoc, 1, 0);
    if (wr == 1) PG8_BAR;
    PG8_WAIT_V(2); PG8_BAR;
    PG8_STAGE(PG8_SB(1, 0), cB + kstep, voffB); PG8_STAGE_A(PG8_SA(1, 0), aoc, 0, 128); PG8_STAGE(PG8_SB(1, 1), cB + hstep + kstep, voffB);
    PG8_WAIT_V(6); PG8_BAR;
    for (;;) {
        const bool has_next = S.next(ui + 1, nxt);
        const char* nB = cB;
        if (has_next) nB = (const char*)g.Bt + (size_t)nxt.pn * tstep;
#pragma nounroll
        for (int t = 0; t < nt; t += 2) {
            const bool last = (t == nt - 2);
            const unsigned k1 = (unsigned)(t + 1) * 128u, k2 = last ? 0u : (unsigned)(t + 2) * 128u, k3 = k2 + 128u;
            const char* b2 = last ? nB : cB + (size_t)(t + 2) * kstep; const char* b3 = b2 + kstep;
            PG8_LDB(B0, 0, 0); PG8_LDB(B1, 0, 1); PG8_SCHED; PG8_LDA(At, 0, 0); PG8_STAGE_A(PG8_SA(1, 1), aoc, 1, k1);
            PG8_WAIT_V(8); PG8_WAIT_L(0); PG8_BAR; PG8_MMA(0, 0, At, B0); PG8_MMA(0, 1, At, B1); PG8_BAR; PG8_SCHED;
            if (last && has_next) { PG8_AOFFS(aoc, nxt); }
            PG8_LDA(At, 0, 1); PG8_STAGE(PG8_SB(0, 0), b2, voffB); PG8_STAGE(PG8_SB(0, 1), b2 + hstep, voffB); PG8_STAGE_A(PG8_SA(0, 0), aoc, 0, k2);
            PG8_WAIT_V(8); PG8_WAIT_L(0); PG8_BAR; PG8_MMA(1, 0, At, B0); PG8_MMA(1, 1, At, B1); PG8_BAR; PG8_SCHED;
            PG8_LDB(B0, 1, 0); PG8_LDB(B1, 1, 1); PG8_SCHED; PG8_LDA(At, 1, 0); PG8_STAGE_A(PG8_SA(0, 1), aoc, 1, k2);
            PG8_WAIT_V(8); PG8_WAIT_L(0); PG8_BAR; PG8_MMA(0, 0, At, B0); PG8_MMA(0, 1, At, B1); PG8_BAR; PG8_SCHED;
            PG8_LDA(At, 1, 1); PG8_STAGE(PG8_SB(1, 0), b3, voffB); PG8_STAGE(PG8_SB(1, 1), b3 + hstep, voffB); PG8_STAGE_A(PG8_SA(1, 0), aoc, 0, k3);
            PG8_WAIT_V(8); PG8_WAIT_L(0); PG8_BAR; PG8_MMA(1, 0, At, B0); PG8_MMA(1, 1, At, B1); PG8_BAR; PG8_SCHED;
        }
        if constexpr (ALIGN_EPI) { if (wr == 0) PG8_BAR; }
        { int t2 = threadIdx.x; asm volatile("" : "+v"(t2));
          const int w2 = __builtin_amdgcn_readfirstlane(t2 >> 6), l2 = t2 & 63; E(acc, cur, w2 >> 2, w2 & 3, l2 & 15, l2 >> 4); }
        if (!has_next) break;
#pragma unroll
        for (int a = 0; a < 2; ++a)
#pragma unroll
            for (int b = 0; b < 2; ++b)
#pragma unroll
                for (int m = 0; m < 4; ++m)
#pragma unroll
                    for (int n = 0; n < 2; ++n) acc[a][b][m][n] = (f32x4){0.f, 0.f, 0.f, 0.f};
        cur = nxt; cB = nB; ++ui;
        if constexpr (ALIGN_EPI) { if (wr == 1) PG8_BAR; }
    }
    PG8_WAIT_V(0);
    if constexpr (!ALIGN_EPI) { if (wr == 0) PG8_BAR; }
    PG8_BAR;
#undef PG8_SA
#undef PG8_SB
#undef PG8_STAGE
#undef PG8_STAGE_A
#undef PG8_LDA
#undef PG8_LDB
#undef PG8_MMA
#undef PG8_CAT8
#undef PG8_WAIT_V
#undef PG8_WAIT_L
#undef PG8_BAR
#undef PG8_SCHED
#undef PG8_AOFFS
}
}
struct SchedPlain : pg8::StaticOrder {
    unsigned rowbytes;
    DEV unsigned row_off(const pg8::Unit& u, int r) const { return (unsigned)(u.pm * 256 + r) * rowbytes; }
};
struct SchedMoe1 : pg8::StaticOrder {
    const LAS int* idxl;
    DEV bool next(int i, pg8::Unit& u) const { if (!pg8::StaticOrder::next(i, u)) return false; u.pn += (u.pm >> 4) * 16; u.ui = i; return true; }
    DEV unsigned row_off(const pg8::Unit& u, int r) const { const int g = u.pm * 256 + r; const int tok = ((g >> 9) & 7) * S + idxl[u.ui * 256 + r]; return (unsigned)tok * (unsigned)D; }
};
struct SchedMoe2 : pg8::StaticOrder {
    DEV bool next(int i, pg8::Unit& u) const { if (!pg8::StaticOrder::next(i, u)) return false; u.pn += (u.pm >> 4) * 4; return true; }
    DEV unsigned row_off(const pg8::Unit& u, int r) const { return (unsigned)(u.pm * 256 + r) * (unsigned)DFF; }
};
typedef pg8::f32x4 f32x4; typedef pg8::u32x4 u32x4;
struct EpiInProj {
    static constexpr bool PERM = true;
    unsigned char* ws; const float* ropeT;
    DEV void operator()(const f32x4 (&acc)[2][2][4][2], const pg8::Unit& u, int wr, int wc, int fr, int fq) const {
        const int grp = u.pn >> 1;
        bf16_t* gbase = (bf16_t*)(ws + WS_RQ + (size_t)grp * 32 * MiB);
        const int j0 = 32 * (wc & 1) + 8 * fq;
        if (grp < 2) {
            const float sc = grp == 1 ? 0.125f : 1.f;
            f32x4 cs[2][4], sn[2][4];
#pragma unroll
            for (int ai = 0; ai < 2; ++ai)
#pragma unroll
                for (int m = 0; m < 4; ++m) { const int s = (u.pm * 256 + ai * 128 + wr * 64 + m * 16 + fr) & 4095;
                    cs[ai][m] = *(const f32x4*)(ropeT + s * 32 + (j0 >> 1)); sn[ai][m] = *(const f32x4*)(ropeT + S * 32 + s * 32 + (j0 >> 1)); }
#pragma unroll
            for (int ai = 0; ai < 2; ++ai)
#pragma unroll
                for (int m = 0; m < 4; ++m) {
                    const int row = u.pm * 256 + ai * 128 + wr * 64 + m * 16 + fr, b = row >> 12, s = row & 4095;
#pragma unroll
                    for (int bj = 0; bj < 2; ++bj) {
                        const int hd = 4 * (u.pn & 1) + 2 * bj + (wc >> 1);
                        const f32x4 lo = (acc[ai][bj][m][0] * cs[ai][m] - acc[ai][bj][m][1] * sn[ai][m]) * sc, hi = (acc[ai][bj][m][1] * cs[ai][m] + acc[ai][bj][m][0] * sn[ai][m]) * sc;
                        u32x4 w; w.x = pg8::cvt_pk_bf16(lo[0], lo[1]); w.y = pg8::cvt_pk_bf16(lo[2], lo[3]); w.z = pg8::cvt_pk_bf16(hi[0], hi[1]); w.w = pg8::cvt_pk_bf16(hi[2], hi[3]);
                        *(u32x4*)(gbase + ((size_t)(b * NH + hd) * S + s) * HD + j0) = w;
                    }
                }
        } else {
            const float sc = grp == 4 ? 0.125f * LOG2E : 1.f;
#pragma unroll
            for (int ai = 0; ai < 2; ++ai)
#pragma unroll
                for (int m = 0; m < 4; ++m) {
                    const int row = u.pm * 256 + ai * 128 + wr * 64 + m * 16 + fr, b = row >> 12, s = row & 4095;
#pragma unroll
                    for (int bj = 0; bj < 2; ++bj) {
                        const int hd = 4 * (u.pn & 1) + 2 * bj + (wc >> 1);
                        const f32x4 lo = acc[ai][bj][m][0] * sc, hi = acc[ai][bj][m][1] * sc;
                        u32x4 w; w.x = pg8::cvt_pk_bf16(lo[0], lo[1]); w.y = pg8::cvt_pk_bf16(lo[2], lo[3]); w.z = pg8::cvt_pk_bf16(hi[0], hi[1]); w.w = pg8::cvt_pk_bf16(hi[2], hi[3]);
                        *(u32x4*)(gbase + ((size_t)(b * NH + hd) * S + s) * HD + j0) = w;
                    }
                }
        }
    }
};
struct EpiOutProj {
    static constexpr bool PERM = true;
    const float* x; bf16_t* x1;
    DEV void operator()(const f32x4 (&acc)[2][2][4][2], const pg8::Unit& u, int wr, int wc, int fr, int fq) const {
#pragma unroll
        for (int ai = 0; ai < 2; ++ai)
#pragma unroll
            for (int m = 0; m < 4; ++m) {
                const int row = u.pm * 256 + ai * 128 + wr * 64 + m * 16 + fr;
                f32x4 xa[2], xb[2];
#pragma unroll
                for (int bj = 0; bj < 2; ++bj) { const size_t off = (size_t)row * D + u.pn * 256 + bj * 128 + wc * 32 + 8 * fq; xa[bj] = *(const f32x4*)(x + off); xb[bj] = *(const f32x4*)(x + off + 4); }
#pragma unroll
                for (int bj = 0; bj < 2; ++bj) { const size_t off = (size_t)row * D + u.pn * 256 + bj * 128 + wc * 32 + 8 * fq;
                    const f32x4 lo = xa[bj] + acc[ai][bj][m][0], hi = xb[bj] + acc[ai][bj][m][1];
                    u32x4 w; w.x = pg8::cvt_pk_bf16(lo[0], lo[1]); w.y = pg8::cvt_pk_bf16(lo[2], lo[3]); w.z = pg8::cvt_pk_bf16(hi[0], hi[1]); w.w = pg8::cvt_pk_bf16(hi[2], hi[3]);
                    *(u32x4*)(x1 + off) = w; }
            }
    }
};
DEV unsigned pk4_fp8e(float a, float b, float c, float d) { unsigned w = 0u; w = __builtin_amdgcn_cvt_pk_fp8_f32(a, b, w, false); w = __builtin_amdgcn_cvt_pk_fp8_f32(c, d, w, true); return w; }
struct EpiSwiGLU {
    static constexpr bool PERM = true;
    unsigned char* hid;
    DEV void operator()(const f32x4 (&acc)[2][2][4][2], const pg8::Unit& u, int wr, int wc, int fr, int fq) const {
        const int pnl = u.pn & 15;
#pragma unroll
        for (int ai = 0; ai < 2; ++ai)
#pragma unroll
            for (int m = 0; m < 4; ++m) {
                const int row = u.pm * 256 + ai * 128 + wr * 64 + m * 16 + fr;
                float o[8];
#pragma unroll
                for (int n = 0; n < 2; ++n)
#pragma unroll
                    for (int i = 0; i < 4; ++i) { const float ga = acc[ai][0][m][n][i], ua = acc[ai][1][m][n][i];
                        o[4 * n + i] = (ga * ua) * ((1.f / 1024.f) * __builtin_amdgcn_rcpf(1.f + __builtin_amdgcn_exp2f(ga * (-LOG2E / 32.f)))); }
                *(uint2*)(hid + (size_t)row * DFF + pnl * 128 + wc * 32 + 8 * fq) = make_uint2(pk4_fp8e(o[0], o[1], o[2], o[3]), pk4_fp8e(o[4], o[5], o[6], o[7]));
            }
    }
};
struct EpiDown {
    static constexpr bool PERM = true;
    unsigned char* y;
    DEV void operator()(const f32x4 (&acc)[2][2][4][2], const pg8::Unit& u, int wr, int wc, int fr, int fq) const {
        const int pnl = u.pn & 3;
#pragma unroll
        for (int ai = 0; ai < 2; ++ai)
#pragma unroll
            for (int m = 0; m < 4; ++m) {
                const int row = u.pm * 256 + ai * 128 + wr * 64 + m * 16 + fr;
#pragma unroll
                for (int bj = 0; bj < 2; ++bj) { const f32x4 lo = acc[ai][bj][m][0] * (1.f / 32.f), hi = acc[ai][bj][m][1] * (1.f / 32.f);
                    *(uint2*)(y + (size_t)row * D + pnl * 256 + bj * 128 + wc * 32 + 8 * fq) = make_uint2(pk4_fp8e(lo[0], lo[1], lo[2], lo[3]), pk4_fp8e(hi[0], hi[1], hi[2], hi[3])); }
            }
    }
};
struct Args { const float* in[13]; float* out; unsigned char* ws; int ph_lo, ph_hi; int rep[16]; };
enum { IN_X = 0, IN_G1, IN_WIN, IN_DECAY, IN_GN, IN_RELB, IN_WOUT, IN_G2, IN_WR, IN_WG, IN_WU, IN_WDN, IN_FG };

struct TrItem { const float* src; bf16_t* dst; int K, N, k0, n0, mode, fp8; };
DEV unsigned pk4_fp8(float a, float b, float c, float d) { unsigned w = 0u; w = __builtin_amdgcn_cvt_pk_fp8_f32(a, b, w, false); w = __builtin_amdgcn_cvt_pk_fp8_f32(c, d, w, true); return w; }
DEV void tr_load(const TrItem& t, f32x4 (&v)[16], int lane) {
#pragma unroll
    for (int i = 0; i < 16; ++i) { const int kk = (lane >> 4) + 4 * i, c = (lane & 15) * 4; v[i] = *(const f32x4*)(t.src + (size_t)(t.k0 + kk) * t.N + t.n0 + c); }
}
DEV int rowmap_rt(int mode, int n) {
    if (mode == 0) return n;
    if (mode == 1) { if (n >= 1024) return n; const int base = n & ~63, d = n & 63, nn = d >> 5, dd = d & 31; return base + 8 * (dd >> 2) + 4 * nn + (dd & 3); }
    return (n >> 7) * 256 + (mode == 3 ? 128 : 0) + (n & 127);
}
DEV void tr_finish(const TrItem& t, const f32x4 (&v)[16], LAS float* scr, int lane) {
#pragma unroll
    for (int i = 0; i < 16; ++i) { const int kk = (lane >> 4) + 4 * i, c = (lane & 15) * 4;
        scr[kk * 65 + c] = v[i][0]; scr[kk * 65 + c + 1] = v[i][1]; scr[kk * 65 + c + 2] = v[i][2]; scr[kk * 65 + c + 3] = v[i][3]; }
    LDS_WAIT();
#pragma unroll
    for (int i = 0; i < 8; ++i) { const int n = (lane >> 3) + 8 * i, c = (lane & 7) * 8; const LAS float* sp = scr + c * 65 + n;
        if (t.fp8) {
            const unsigned lo = pk4_fp8(sp[0] * 32.f, sp[65] * 32.f, sp[2 * 65] * 32.f, sp[3 * 65] * 32.f), hi = pk4_fp8(sp[4 * 65] * 32.f, sp[5 * 65] * 32.f, sp[6 * 65] * 32.f, sp[7 * 65] * 32.f);
            *(uint2*)((unsigned char*)t.dst + (size_t)rowmap_rt(t.mode, t.n0 + n) * t.K + t.k0 + c) = make_uint2(lo, hi);
        } else {
        u32x4 o; o.x = pk2(sp[0], sp[65]); o.y = pk2(sp[2 * 65], sp[3 * 65]); o.z = pk2(sp[4 * 65], sp[5 * 65]); o.w = pk2(sp[6 * 65], sp[7 * 65]);
        *(u32x4*)(t.dst + (size_t)rowmap_rt(t.mode, t.n0 + n) * t.K + t.k0 + c) = o; } }
    LDS_WAIT();
}
template <class Dec> DEV void tr_run(const Dec& dec, int nitems, int gw, int NGW, LAS float* scr, int lane) {
    for (int it = gw; it < nitems; it += NGW) { TrItem cur; f32x4 va[16]; dec(it, cur); tr_load(cur, va, lane); tr_finish(cur, va, scr, lane); }
}
template <class Dec> DEV void tr_run2(const Dec& dec, int nitems, int gw, int NGW, LAS float* scr, int lane) {
    int it = gw; if (it >= nitems) return;
    TrItem cur, nxt; f32x4 va[16], vb[16];
    dec(it, cur); tr_load(cur, va, lane);
    for (;;) {
        const int n1 = it + NGW; const bool h1 = n1 < nitems;
        if (h1) { dec(n1, nxt); tr_load(nxt, vb, lane); }
        tr_finish(cur, va, scr, lane);
        if (!h1) break;
        const int n2 = n1 + NGW; const bool h2 = n2 < nitems;
        if (h2) { dec(n2, cur); tr_load(cur, va, lane); }
        tr_finish(nxt, vb, scr, lane);
        if (!h2) break;
        it = n2;
    }
}
DEV void rms_row_to_bf16(const float* xrow, const float* g, bf16_t* orow, int lane) {
    const float4* xr = (const float4*)xrow + lane;
    float4 v[4]; float s = 0.f;
#pragma unroll
    for (int j = 0; j < 4; ++j) { v[j] = xr[64 * j]; s += v[j].x * v[j].x + v[j].y * v[j].y + v[j].z * v[j].z + v[j].w * v[j].w; }
    const float rs = rsqrtf(wave_sum(s) * (1.f / D) + EPS);
    uint2* o = (uint2*)orow + lane;
#pragma unroll
    for (int j = 0; j < 4; ++j) { const float4 gg = ((const float4*)g)[lane + 64 * j];
        o[64 * j] = make_uint2(pk2(v[j].x * rs * gg.x, v[j].y * rs * gg.y), pk2(v[j].z * rs * gg.z, v[j].w * rs * gg.w)); }
}
DEV void phase_prep(const Args& a, unsigned char* lds, int gw, int NGW, int lane, int wave) {
    unsigned char* ws = a.ws;
    float* ropeT = (float*)(ws + WS_ROPE); float* biasT = (float*)(ws + WS_BIAS);
    for (int t = gw * 64 + lane; t < S * 32; t += NGW * 64) {
        const int pos = t >> 5, i = t & 31; const double inv = pow(10000.0, -(double)i / 32.0), ang = (double)pos * inv;
        ropeT[t] = (float)cos(ang); ropeT[S * 32 + t] = (float)sin(ang);
        if (t < 3 * NH * 129) { const int p = t / (NH * 129), h = (t / 129) % NH, o = t % 129 - 64, dil = p == 0 ? 1 : (p == 1 ? 4 : 16), rel = o * dil, n = rel < 0 ? -rel : rel;
            int bucket = rel > 0 ? 16 : 0;
            if (n < 8) bucket += n; else { int large = 8 + (int)(log((double)n / 8.0) / log(128.0) * 8.0); if (large > 15) large = 15; bucket += large; }
            biasT[t] = a.in[IN_RELB][bucket * NH + h] * LOG2E; }
    }
    LAS float* scr = (LAS float*)((LAS unsigned char*)lds + wave * 16640);
    constexpr int I_IN = (D / 64) * (PC / 64), I_OUT = (D / 64) * (D / 64);
    { const float* w_in = a.in[IN_WIN]; const float* w_out = a.in[IN_WOUT]; bf16_t* Win = (bf16_t*)(ws + WS_WIN); bf16_t* Wout = (bf16_t*)(ws + WS_WOUT);
      auto dec = [=](int it, TrItem& t) { if (it < I_IN) { t.src = w_in; t.dst = Win; t.K = D; t.N = PC; t.k0 = (it / (PC / 64)) * 64; t.n0 = (it % (PC / 64)) * 64; t.mode = 1; t.fp8 = 0; }
          else { const int r = it - I_IN; t.src = w_out; t.dst = Wout; t.K = D; t.N = D; t.k0 = (r / (D / 64)) * 64; t.n0 = (r % (D / 64)) * 64; t.mode = 0; t.fp8 = 0; } };
      tr_run(dec, I_IN + I_OUT, gw, NGW, scr, lane); }
    {
      const float* x = a.in[IN_X]; const float* g = a.in[IN_G1]; bf16_t* XN = (bf16_t*)(ws + WS_XN);
      float4 va[4], vb[4], vc[4];
      { const float4* xr = (const float4*)(x + (size_t)gw * D) + lane;
#pragma unroll
        for (int j = 0; j < 4; ++j) va[j] = xr[64 * j];
        if (gw + NGW < M) { const float4* xs = (const float4*)(x + (size_t)(gw + NGW) * D) + lane;
#pragma unroll
          for (int j = 0; j < 4; ++j) vb[j] = xs[64 * j]; } }
      for (int m = gw; m < M; m += NGW) {
          if (m + 2 * NGW < M) { const float4* xr = (const float4*)(x + (size_t)(m + 2 * NGW) * D) + lane;
#pragma unroll
              for (int j = 0; j < 4; ++j) vc[j] = xr[64 * j]; }
          float s = 0.f;
#pragma unroll
          for (int j = 0; j < 4; ++j) s += va[j].x * va[j].x + va[j].y * va[j].y + va[j].z * va[j].z + va[j].w * va[j].w;
          const float rs = rsqrtf(wave_sum(s) * (1.f / D) + EPS);
          uint2* o = (uint2*)(XN + (size_t)m * D) + lane;
#pragma unroll
          for (int j = 0; j < 4; ++j) { const float4 gg = ((const float4*)g)[lane + 64 * j];
              o[64 * j] = make_uint2(pk2(va[j].x * rs * gg.x, va[j].y * rs * gg.y), pk2(va[j].z * rs * gg.z, va[j].w * rs * gg.w)); }
#pragma unroll
          for (int j = 0; j < 4; ++j) { va[j] = vb[j]; vb[j] = vc[j]; }
      } }
}
DEV void phase_latew(const Args& a, unsigned char* lds, int gw, int NGW, int lane, int wave) {
    unsigned char* ws = a.ws; LAS float* scr = (LAS float*)((LAS unsigned char*)lds + wave * 16640);
    constexpr int I_G = (D / 64) * (DFF / 64);
    const float* wg_ = a.in[IN_WG]; const float* wu_ = a.in[IN_WU]; const float* wd_ = a.in[IN_WDN]; bf16_t* Wgu = (bf16_t*)(ws + WS_WGU); bf16_t* Wd = (bf16_t*)(ws + WS_WD);
    auto dec = [=](int it, TrItem& t) { const int which = it / (NE * I_G), r = it % (NE * I_G), e = r / I_G, q = r % I_G;
        t.fp8 = 1;
        if (which < 2) { t.src = (which == 0 ? wg_ : wu_) + (size_t)e * D * DFF; t.dst = (bf16_t*)((unsigned char*)Wgu + (size_t)e * 4096 * D); t.K = D; t.N = DFF; t.n0 = (q / (D / 64)) * 64; t.k0 = (q % (D / 64)) * 64; t.mode = 2 + which; }
        else { t.src = wd_ + (size_t)e * DFF * D; t.dst = (bf16_t*)((unsigned char*)Wd + (size_t)e * D * DFF); t.K = DFF; t.N = D; t.n0 = (q / (DFF / 64)) * 64; t.k0 = (q % (DFF / 64)) * 64; t.mode = 0; } };
    tr_run2(dec, 3 * NE * I_G, gw, NGW, scr, lane);
}
DEV void phase_router(const Args& a, unsigned char* lds, int gw, int NGW, int lane, int tid) {
    unsigned char* ws = a.ws; const bf16_t* x1 = (const bf16_t*)(ws + WS_X1); const float* g2 = a.in[IN_G2]; const float* wr = a.in[IN_WR];
    bf16_t* H2b = (bf16_t*)(ws + WS_XN); float* aff = (float*)(ws + WS_AFF); float* affT = (float*)(ws + WS_AFFT); int* inv = (int*)(ws + WS_INV);
    LAS f32x4* wl = (LAS f32x4*)(LAS unsigned char*)lds;
    for (int i = tid; i < D * 4; i += NTHR) { const int k = i >> 2, c = i & 3, slot = (k & 3) * 256 + (k >> 2); wl[slot * 4 + ((c + (slot >> 2)) & 3)] = *(const f32x4*)(wr + (size_t)k * NE + 4 * c); }
    __syncthreads();
    uint2 xq[4][4], xp[4][4];
#pragma unroll
    for (int q = 0; q < 4; ++q) { const int r = gw + q * NGW; if (r < M) { const uint2* xr = (const uint2*)(x1 + (size_t)r * D) + lane;
#pragma unroll
        for (int j = 0; j < 4; ++j) xp[q][j] = xr[64 * j]; } }
    for (int row4 = gw; row4 < M; row4 += 4 * NGW) {
#pragma unroll
      for (int q = 0; q < 4; ++q)
#pragma unroll
        for (int j = 0; j < 4; ++j) xq[q][j] = xp[q][j];
#pragma unroll
      for (int q = 0; q < 4; ++q) { const int r = row4 + (4 + q) * NGW; if (r < M) { const uint2* xr = (const uint2*)(x1 + (size_t)r * D) + lane;
#pragma unroll
          for (int j = 0; j < 4; ++j) xp[q][j] = xr[64 * j]; } }
#pragma unroll
      for (int q = 0; q < 4; ++q) {
        const int row = row4 + q * NGW; if (row >= M) break;
        float4 v[4]; float s = 0.f;
#pragma unroll
        for (int j = 0; j < 4; ++j) { v[j] = make_float4(bf2f(xq[q][j].x & 0xffffu), bf2f(xq[q][j].x >> 16), bf2f(xq[q][j].y & 0xffffu), bf2f(xq[q][j].y >> 16)); s += v[j].x * v[j].x + v[j].y * v[j].y + v[j].z * v[j].z + v[j].w * v[j].w; }
        const float rs = rsqrtf(wave_sum(s) * (1.f / D) + EPS);
        f32x4 lg[4];
#pragma unroll
        for (int c = 0; c < 4; ++c) lg[c] = (f32x4){0.f, 0.f, 0.f, 0.f};
        unsigned* o = (unsigned*)((unsigned char*)H2b + (size_t)row * D) + lane;
        float hv[4][4];
#pragma unroll
        for (int j = 0; j < 4; ++j) { const float4 gg = ((const float4*)g2)[lane + 64 * j];
            hv[j][0] = v[j].x * rs * gg.x; hv[j][1] = v[j].y * rs * gg.y; hv[j][2] = v[j].z * rs * gg.z; hv[j][3] = v[j].w * rs * gg.w;
            o[64 * j] = pk4_fp8(hv[j][0], hv[j][1], hv[j][2], hv[j][3]); }
        const int rot = (lane >> 2) & 3; f32x4 wa[4], wb[4];
#pragma unroll
        for (int c = 0; c < 4; ++c) wa[c] = wl[(0 * 256 + lane) * 4 + ((c + rot) & 3)];
#pragma unroll
        for (int st = 0; st < 16; st += 2) {
            { const int j = (st + 1) >> 2, t = (st + 1) & 3, slot = t * 256 + lane + 64 * j;
#pragma unroll
              for (int c = 0; c < 4; ++c) wb[c] = wl[slot * 4 + ((c + rot) & 3)]; }
#pragma unroll
            for (int c = 0; c < 4; ++c) lg[c] += hv[st >> 2][st & 3] * wa[c];
            __builtin_amdgcn_sched_barrier(0);
            if (st + 2 < 16) { const int j = (st + 2) >> 2, t = (st + 2) & 3, slot = t * 256 + lane + 64 * j;
#pragma unroll
              for (int c = 0; c < 4; ++c) wa[c] = wl[slot * 4 + ((c + rot) & 3)]; }
#pragma unroll
            for (int c = 0; c < 4; ++c) lg[c] += hv[(st + 1) >> 2][(st + 1) & 3] * wb[c];
            __builtin_amdgcn_sched_barrier(0);
        }
        float r8[8], r4[4], r2[2], r1;
        { const bool up = lane & 32;
#pragma unroll
          for (int i = 0; i < 8; ++i) { const float mine = up ? lg[(i + 8) >> 2][(i + 8) & 3] : lg[i >> 2][i & 3], send = up ? lg[i >> 2][i & 3] : lg[(i + 8) >> 2][(i + 8) & 3]; r8[i] = mine + lane_x32(send); } }
        { const bool up = lane & 16;
#pragma unroll
          for (int i = 0; i < 4; ++i) { const float mine = up ? r8[i + 4] : r8[i], send = up ? r8[i] : r8[i + 4]; r4[i] = mine + lane_x16(send); } }
        { const bool up = lane & 8;
#pragma unroll
          for (int i = 0; i < 2; ++i) { const float mine = up ? r4[i + 2] : r4[i], send = up ? r4[i] : r4[i + 2]; r2[i] = mine + lane_x8(send); } }
        { const bool up = lane & 4; const float mine = up ? r2[1] : r2[0], send = up ? r2[0] : r2[1]; r1 = mine + lane_m8(send); }
        r1 += lane_x2(r1); r1 += lane_x1(r1);
        float mx = r1; mx = fmaxf(mx, lane_m8(mx)); mx = fmaxf(mx, lane_x8(mx)); mx = fmaxf(mx, lane_x16(mx)); mx = fmaxf(mx, lane_x32(mx));
        const float ex = __expf(r1 - mx); float sum = ex; sum += lane_m8(sum); sum += lane_x8(sum); sum += lane_x16(sum); sum += lane_x32(sum);
        const float av = ex / sum; const int e = lane >> 2;
        if ((lane & 3) == 0) { aff[(size_t)row * NE + e] = av; inv[(size_t)row * NE + e] = -1; affT[((size_t)(row >> 12) * NE + e) * S + (row & 4095)] = av; }
      }
    }
    __syncthreads();
}
DEV void phase_topk(const Args& a, unsigned char* lds, int wg, int G, int tid, int lane, int wave) {
    unsigned char* ws = a.ws; const float* affT = (const float*)(ws + WS_AFFT); int* idx = (int*)(ws + WS_IDX); int* inv = (int*)(ws + WS_INV);
    LAS unsigned* hist = (LAS unsigned*)(LAS unsigned char*)lds; LAS unsigned* wsum = hist + 256; LAS unsigned* bc = hist + 272;
    for (int it = wg; it < NE * NB; it += G) {
        const int e = it & 15, b = it >> 4;
        unsigned u[8];
        { const uint4* src = (const uint4*)(affT + ((size_t)b * NE + e) * S + 8 * tid); const uint4 p = src[0], q = src[1]; u[0] = p.x; u[1] = p.y; u[2] = p.z; u[3] = p.w; u[4] = q.x; u[5] = q.y; u[6] = q.z; u[7] = q.w; }
        unsigned prefix = 0u, kk = CAP;
#pragma unroll
        for (int pass = 0; pass < 4; ++pass) {
            const int shift = 24 - 8 * pass;
            __syncthreads();
            if (tid < 256) hist[tid] = 0u;
            __syncthreads();
#pragma unroll
            for (int j = 0; j < 8; ++j) if (pass == 0 || (u[j] >> (shift + 8)) == prefix) atomicAdd((unsigned*)&hist[(u[j] >> shift) & 255u], 1u);
            __syncthreads();
            if (wave == 0) {
                const unsigned c0 = hist[4 * lane], c1 = hist[4 * lane + 1], c2 = hist[4 * lane + 2], c3 = hist[4 * lane + 3], tot = c0 + c1 + c2 + c3;
                unsigned incl = tot;
#pragma unroll
                for (int o = 1; o < 64; o <<= 1) { const unsigned t = __shfl_down(incl, o); if (lane + o < 64) incl += t; }
                const unsigned excl = incl - tot;
                if (excl < kk && kk <= incl) { unsigned acc = excl; int bin;
                    if (acc + c3 >= kk) bin = 3; else { acc += c3; if (acc + c2 >= kk) bin = 2; else { acc += c2; if (acc + c1 >= kk) bin = 1; else { acc += c1; bin = 0; } } }
                    bc[0] = 4 * lane + bin; bc[1] = kk - acc; }
            }
            __syncthreads();
            prefix = (prefix << 8) | bc[0]; kk = bc[1];
        }
        const unsigned T = prefix, need = kk;
        unsigned cg_ = 0u, ce = 0u;
#pragma unroll
        for (int j = 0; j < 8; ++j) { cg_ += u[j] > T; ce += u[j] == T; }
        unsigned pk = cg_ | (ce << 16), incl = pk;
#pragma unroll
        for (int o = 1; o < 64; o <<= 1) { const unsigned t = __shfl_up(incl, o); if (lane >= o) incl += t; }
        if (lane == 63) wsum[wave] = incl;
        __syncthreads();
        unsigned base = 0u;
#pragma unroll
        for (int w = 0; w < NWAVES; ++w) base += w < wave ? wsum[w] : 0u;
        const unsigned ex = base + incl - pk; unsigned gtb = ex & 0xffffu, eqb = ex >> 16;
#pragma unroll
        for (int j = 0; j < 8; ++j) { const bool g = u[j] > T, q = u[j] == T; const unsigned slot = gtb + (eqb < need ? eqb : need);
            if (g || (q && eqb < need)) { const int s = 8 * tid + j; idx[(e * NB + b) * CAP + slot] = s; inv[((size_t)b * S + s) * NE + e] = (int)slot; }
            gtb += g; eqb += q; }
    }
}
DEV void phase_final(const Args& a, int gw, int NGW, int lane) {
    unsigned char* ws = a.ws; float* xo = a.out; const bf16_t* x1 = (const bf16_t*)(ws + WS_X1); const float* aff = (const float*)(ws + WS_AFF); const int* inv = (const int*)(ws + WS_INV);
    const unsigned char* y = ws + WS_Y; const float* fg = a.in[IN_FG];
    uint2 xw[4], xn[4], xm[4]; int iv = -1, ivn = -1, ivm = -1; float av = 0.f, avn = 0.f, avm = 0.f;
    { const uint2* xr = (const uint2*)(x1 + (size_t)gw * D) + lane;
#pragma unroll
      for (int j = 0; j < 4; ++j) xw[j] = xr[64 * j];
      if (lane < NE) { iv = inv[(size_t)gw * NE + lane]; av = aff[(size_t)gw * NE + lane]; }
      if (gw + NGW < M) { const uint2* xs = (const uint2*)(x1 + (size_t)(gw + NGW) * D) + lane;
#pragma unroll
        for (int j = 0; j < 4; ++j) xn[j] = xs[64 * j];
        if (lane < NE) { ivn = inv[(size_t)(gw + NGW) * NE + lane]; avn = aff[(size_t)(gw + NGW) * NE + lane]; } } }
    for (int row = gw; row < M; row += NGW) {
        const int b = row >> 12;
        if (row + 2 * NGW < M) { const uint2* xr = (const uint2*)(x1 + (size_t)(row + 2 * NGW) * D) + lane;
#pragma unroll
            for (int j = 0; j < 4; ++j) xm[j] = xr[64 * j];
            if (lane < NE) { ivm = inv[(size_t)(row + 2 * NGW) * NE + lane]; avm = aff[(size_t)(row + 2 * NGW) * NE + lane]; } }
        float4 v[4];
#pragma unroll
        for (int j = 0; j < 4; ++j) v[j] = make_float4(bf2f(xw[j].x & 0xffffu), bf2f(xw[j].x >> 16), bf2f(xw[j].y & 0xffffu), bf2f(xw[j].y >> 16));
        unsigned long long msk = __ballot(lane < NE && iv >= 0);
        while (msk) {
            unsigned w[4][4]; float gq[4];
#pragma unroll
            for (int q = 0; q < 4; ++q) { const bool on = msk != 0ull; const int e = on ? __builtin_ctzll(msk) : 0; msk = on ? (msk & (msk - 1)) : 0ull;
                const int sl = __builtin_amdgcn_readlane(iv, e); const float g = __builtin_bit_cast(float, __builtin_amdgcn_readlane(__builtin_bit_cast(int, av), e));
                gq[q] = on ? g : 0.f;
                const unsigned* yr = (const unsigned*)(y + ((size_t)e * 4096 + b * CAP + (on ? sl : 0)) * D) + lane;
#pragma unroll
                for (int j = 0; j < 4; ++j) w[q][j] = yr[64 * j]; }
#pragma unroll
            for (int q = 0; q < 4; ++q)
#pragma unroll
                for (int j = 0; j < 4; ++j) { const auto lo = __builtin_amdgcn_cvt_pk_f32_fp8((int)w[q][j], false), hi = __builtin_amdgcn_cvt_pk_f32_fp8((int)w[q][j], true);
                    v[j].x += gq[q] * lo[0]; v[j].y += gq[q] * lo[1]; v[j].z += gq[q] * hi[0]; v[j].w += gq[q] * hi[1]; }
        }
        float s = 0.f;
#pragma unroll
        for (int j = 0; j < 4; ++j) s += v[j].x * v[j].x + v[j].y * v[j].y + v[j].z * v[j].z + v[j].w * v[j].w;
        const float rs = rsqrtf(wave_sum(s) * (1.f / D) + EPS);
        float4* orow = (float4*)(xo + (size_t)row * D) + lane;
#pragma unroll
        for (int j = 0; j < 4; ++j) { const float4 gg = ((const float4*)fg)[lane + 64 * j]; orow[64 * j] = make_float4(v[j].x * rs * gg.x, v[j].y * rs * gg.y, v[j].z * rs * gg.z, v[j].w * rs * gg.w); }
#pragma unroll
        for (int j = 0; j < 4; ++j) { xw[j] = xn[j]; xn[j] = xm[j]; }
        iv = ivn; av = avn; ivn = ivm; avn = avm;
    }
}
typedef short bf16x8 __attribute__((ext_vector_type(8)));
typedef float f32x16 __attribute__((ext_vector_type(16)));
typedef short s16x4 __attribute__((ext_vector_type(4)));
typedef LAS const char* lds_cptr;
typedef unsigned u32x2 __attribute__((ext_vector_type(2)));
constexpr int VROW = 192;
constexpr int VSLOT = 32 * VROW;
constexpr int KROW = 144;
constexpr int KSLOT = 32 * KROW;
constexpr int MIX_WAVE_LDS = 16640;
constexpr int NWM = 6;
constexpr int MIX_BIAS_OFF = NWAVES * MIX_WAVE_LDS;
DEV int crow(int r, int hi) { return (r & 3) + 8 * (r >> 2) + 4 * hi; }
DEV s16x4 vtr(lds_cptr p) { return __builtin_bit_cast(s16x4, __builtin_amdgcn_ds_read_tr16_b64_v4i16((LAS s16x4*)p)); }
DEV bf16x8 tr_frag(lds_cptr slot, int s, int blk, int lane) {
    const int h = lane >> 5; lds_cptr p = slot + (16 * s + 4 * h + ((lane & 15) >> 2)) * VROW + (32 * blk + 16 * ((lane >> 4) & 1) + 4 * (lane & 3)) * 2;
    const s16x4 lo = vtr(p), hi = vtr(p + 8 * VROW);
    return (bf16x8){lo[0], lo[1], lo[2], lo[3], hi[0], hi[1], hi[2], hi[3]};
}
DEV void load_frags(bf16x8 (&f)[4], const bf16_t* rowp, int lane) {
    const int h = lane >> 5;
#pragma unroll
    for (int st = 0; st < 4; ++st) f[st] = *(const bf16x8*)(rowp + 16 * st + 8 * h);
}
DEV bf16x8 pack_p(const f32x16& p, int s) {
    u32x4 w; w.x = pg8::cvt_pk_bf16(p[8 * s], p[8 * s + 1]); w.y = pg8::cvt_pk_bf16(p[8 * s + 2], p[8 * s + 3]); w.z = pg8::cvt_pk_bf16(p[8 * s + 4], p[8 * s + 5]); w.w = pg8::cvt_pk_bf16(p[8 * s + 6], p[8 * s + 7]);
    return __builtin_bit_cast(bf16x8, w);
}

DEV void stage_rows_k(LAS unsigned char* ks, const u32x4 (&raw)[4], int lane) {
    const int rr = lane >> 3, ch = lane & 7;
#pragma unroll
    for (int i = 0; i < 4; ++i) *(LAS u32x4*)(ks + (rr + 8 * i) * KROW + ch * 16) = raw[i];
}
DEV void read_row_frags(bf16x8 (&f)[4], const LAS unsigned char* ks, int lane) {
    const LAS unsigned char* p = ks + (lane & 31) * KROW + (lane >> 5) * 16;
#pragma unroll
    for (int st = 0; st < 4; ++st) f[st] = *(const LAS bf16x8*)(p + st * 32);
}

DEV float other_half(float x) { const auto r = __builtin_amdgcn_permlane32_swap(__float_as_uint(x), __float_as_uint(x), false, false); return (threadIdx.x & 32) ? __uint_as_float(r[0]) : __uint_as_float(r[1]); }
DEV float max_halves(float x) { const auto r = __builtin_amdgcn_permlane32_swap(__float_as_uint(x), __float_as_uint(x), false, false); return fmaxf(__uint_as_float(r[0]), __uint_as_float(r[1])); }
DEV float sum_halves(float x) { const auto r = __builtin_amdgcn_permlane32_swap(__float_as_uint(x), __float_as_uint(x), false, false); return __uint_as_float(r[0]) + __uint_as_float(r[1]); }
#define MFMA32(a, b, c) __builtin_amdgcn_mfma_f32_32x32x16_bf16((a), (b), (c), 0, 0, 0)
DEV float ex2(float x) { return __builtin_amdgcn_exp2f(x); }

struct AttnIt { int p, bh, sh, L, r, q0, kmin, kmax; };
DEV void attn_decode(int li, int x, AttnIt& d) {
    d.p = li >> 9; d.bh = 8 * x + ((li >> 6) & 7); const int qblk = li & 63;
    d.sh = 2 * d.p; d.L = S >> d.sh; const int bpr = d.L >> 6;
    d.r = qblk / bpr; d.q0 = (qblk % bpr) * 64;
    d.kmin = d.q0 >= 64 ? 0 : 2; const int km = (d.L + 63 - d.q0) >> 5; d.kmax = km > 5 ? 5 : km;
}
DEV int med3i(int v, int lo, int hi) { return v < lo ? lo : (v > hi ? hi : v); }
DEV void attn_ldrows(const bf16_t* base, const AttnIt& d, int i0, u32x4 (&v)[4], int lane) {
    const int rr = lane >> 3, ch = lane & 7; const char* hb = (const char*)(base + (size_t)d.bh * S * HD); const unsigned cst = (unsigned)(d.r * 128 + ch * 16);
#pragma unroll
    for (int i = 0; i < 4; ++i) v[i] = *(const u32x4*)(hb + (((unsigned)med3i(i0 + rr + 8 * i, 0, d.L - 1) << (d.sh + 7)) + cst));
}
DEV void attn_ldkv(const Args& a, const AttnIt& d, int kk, u32x4 (&k)[4], u32x4 (&v)[4], int lane) {
    const int rr = lane >> 3, ch = lane & 7, i0 = d.q0 - 64 + 32 * kk; const unsigned cst = (unsigned)(d.r * 128 + ch * 16);
    const char* kb = (const char*)((const bf16_t*)(a.ws + WS_AK) + (size_t)d.bh * S * HD); const char* vb = (const char*)((const bf16_t*)(a.ws + WS_AV) + (size_t)d.bh * S * HD);
#pragma unroll
    for (int i = 0; i < 4; ++i) { const unsigned off = ((unsigned)med3i(i0 + rr + 8 * i, 0, d.L - 1) << (d.sh + 7)) + cst; k[i] = *(const u32x4*)(kb + off); v[i] = *(const u32x4*)(vb + off); }
}
DEV void attn_items(const Args& a, unsigned char* lds, int wg, int G, int lane, int wave) {
    unsigned char* ws = a.ws;
    constexpr int NIT = 3 * 512; constexpr float THR = 6.f;
    const int x = wg & 7, NGW = (G >> 3) * NWM;
    int item = (wg >> 3) * NWM + wave; if (item >= NIT) return;
    LAS unsigned char* slot = (LAS unsigned char*)lds + wave * MIX_WAVE_LDS; lds_cptr slot3 = (lds_cptr)slot; LAS unsigned char* kslot = slot + VSLOT;
    const int t = lane & 31, hi = lane >> 5, rr = lane >> 3, ch = lane & 7;
    AttnIt d; attn_decode(item, x, d);
    bf16x8 qf[2][4], kf[4]; u32x4 kraw[4], vv[4];
    attn_ldkv(a, d, d.kmin, kraw, vv, lane);
    for (;;) {
        const LAS float* tph = (const LAS float*)((LAS unsigned char*)lds + MIX_BIAS_OFF) + (d.p * NH + (d.bh & 7)) * 192 + (32 + 4 * hi - t);
        f32x16 o[2][2] = {}; float m[2] = {0.f, 0.f}, l[2] = {0.f, 0.f};
        const int nitem = item + NGW; const bool hasn = nitem < NIT;
        AttnIt dn = d; if (hasn) attn_decode(nitem, x, dn);
#pragma unroll
        for (int j = 0; j < 2; ++j) { u32x4 qraw[4]; attn_ldrows((const bf16_t*)(ws + WS_AQ), d, d.q0 + 32 * j, qraw, lane); stage_rows_k(kslot, qraw, lane); asm volatile("" ::: "memory"); read_row_frags(qf[j], kslot, lane); asm volatile("" ::: "memory"); }
        for (int kk = d.kmin; kk <= d.kmax; ++kk) {
            const int kbase = d.q0 - 64 + 32 * kk;
#pragma unroll
            for (int i = 0; i < 4; ++i) *(LAS u32x4*)(slot + (rr + 8 * i) * VROW + ch * 16) = vv[i];
            stage_rows_k(kslot, kraw, lane);
            asm volatile("" ::: "memory");
            read_row_frags(kf, kslot, lane);
            const bf16x8 v00 = tr_frag(slot3, 0, 0, lane), v10 = tr_frag(slot3, 1, 0, lane), v01 = tr_frag(slot3, 0, 1, lane), v11 = tr_frag(slot3, 1, 1, lane);
            asm volatile("" ::: "memory");
            if (kk < d.kmax) attn_ldkv(a, d, kk + 1, kraw, vv, lane);
            else if (hasn) attn_ldkv(a, dn, dn.kmin, kraw, vv, lane);
            const bool edge = kbase < 0 || kbase + 31 >= d.L;
            f32x16 sc[2] = {};
#pragma unroll
            for (int st = 0; st < 4; ++st) { sc[0] = MFMA32(kf[st], qf[0][st], sc[0]); sc[1] = MFMA32(kf[st], qf[1][st], sc[1]); }
            float mx[2]; bool mv = false;
#pragma unroll
            for (int j = 0; j < 2; ++j) {
                const int kj = kk - j; const bool act = kj >= 0 && kj <= 4; const LAS float* tb = tph + 32 * (act ? kj : 0); const float moff = act ? m[j] : 1e30f;
#pragma unroll
                for (int rg = 0; rg < 16; ++rg) sc[j][rg] = (sc[j][rg] - moff) + tb[(rg & 3) + 8 * (rg >> 2)];
                if (edge) {
#pragma unroll
                    for (int rg = 0; rg < 16; ++rg) { const int ki = kbase + crow(rg, hi); sc[j][rg] = (ki >= 0 && ki < d.L) ? sc[j][rg] : -1e30f; } }
                float t0 = fmaxf(fmaxf(sc[j][0], sc[j][1]), fmaxf(sc[j][2], sc[j][3]));
#pragma unroll
                for (int rg = 4; rg < 16; rg += 4) t0 = fmaxf(t0, fmaxf(fmaxf(sc[j][rg], sc[j][rg + 1]), fmaxf(sc[j][rg + 2], sc[j][rg + 3])));
                mx[j] = max_halves(t0);
                const bool first = act && (kj == 0 || kk == d.kmin);
                mv = mv || first || (act && __any(mx[j] > THR));
            }
            if (mv) {
#pragma unroll
                for (int j = 0; j < 2; ++j) { const int kj = kk - j; const bool act = kj >= 0 && kj <= 4, first = act && (kj == 0 || kk == d.kmin);
                    const float dl = !act ? 0.f : (first ? mx[j] : fmaxf(mx[j], 0.f)), f = ex2(-dl); m[j] += dl; l[j] *= f;
#pragma unroll
                    for (int rg = 0; rg < 16; ++rg) { sc[j][rg] -= dl; o[j][0][rg] *= f; o[j][1][rg] *= f; } }
            }
#pragma unroll
            for (int j = 0; j < 2; ++j) { float ps0 = 0.f, ps1 = 0.f;
#pragma unroll
                for (int rg = 0; rg < 16; rg += 2) { sc[j][rg] = ex2(sc[j][rg]); sc[j][rg + 1] = ex2(sc[j][rg + 1]); ps0 += sc[j][rg]; ps1 += sc[j][rg + 1]; }
                l[j] += ps0 + ps1; }
            { const bf16x8 p00 = pack_p(sc[0], 0), p01 = pack_p(sc[0], 1), p10 = pack_p(sc[1], 0), p11 = pack_p(sc[1], 1);
              o[0][0] = MFMA32(v00, p00, o[0][0]); o[0][1] = MFMA32(v01, p00, o[0][1]); o[1][0] = MFMA32(v00, p10, o[1][0]); o[1][1] = MFMA32(v01, p10, o[1][1]);
              o[0][0] = MFMA32(v10, p01, o[0][0]); o[0][1] = MFMA32(v11, p01, o[0][1]); o[1][0] = MFMA32(v10, p11, o[1][0]); o[1][1] = MFMA32(v11, p11, o[1][1]); }
        }
#pragma unroll
        for (int j = 0; j < 2; ++j) {
            float lt = sum_halves(l[j]);
            const float il = 1.f / lt;
            const size_t orow = ((size_t)d.p * NB * NH + d.bh) * S + (size_t)(((d.q0 + 32 * j + t) << d.sh) + d.r);
#pragma unroll
            for (int g4 = 0; g4 < 4; ++g4) {
                *(LAS u32x2*)(kslot + t * KROW + (8 * g4 + 4 * hi) * 2) = (u32x2){pg8::cvt_pk_bf16(o[j][0][4 * g4] * il, o[j][0][4 * g4 + 1] * il), pg8::cvt_pk_bf16(o[j][0][4 * g4 + 2] * il, o[j][0][4 * g4 + 3] * il)};
                *(LAS u32x2*)(kslot + t * KROW + (32 + 8 * g4 + 4 * hi) * 2) = (u32x2){pg8::cvt_pk_bf16(o[j][1][4 * g4] * il, o[j][1][4 * g4 + 1] * il), pg8::cvt_pk_bf16(o[j][1][4 * g4 + 2] * il, o[j][1][4 * g4 + 3] * il)};
            }
            asm volatile("" ::: "memory");
            { bf16_t* ob = (bf16_t*)(ws + WS_ATTO) + ((size_t)d.p * NB * NH + d.bh) * S * HD;
#pragma unroll
              for (int i = 0; i < 4; ++i) { const u32x4 w = *(const LAS u32x4*)(kslot + (rr + 8 * i) * KROW + ch * 16);
                  *(u32x4*)(ob + (size_t)(((d.q0 + 32 * j + rr + 8 * i) << d.sh) + d.r) * HD + ch * 8) = w; } }
            asm volatile("" ::: "memory");
            if (hi == 0) ((float*)(ws + WS_ATTL))[orow] = m[j] + __log2f(lt);
        }
        if (!hasn) break;
        item = nitem; d = dn;
    }
}
DEV void retstate_item(const Args& a, unsigned char* lds, int item, int xg, int lane, int wave) {
    unsigned char* ws = a.ws;
    const int dir = item & 1, n = (item >> 1) & 31, bh = 8 * xg + (item >> 6), h = bh & 7;
    const bf16_t* Kc = (const bf16_t*)(ws + WS_RK) + ((size_t)bh * S + n * 128) * HD; const bf16_t* Vc = (const bf16_t*)(ws + WS_RV) + ((size_t)bh * S + n * 128) * HD;
    const float lg = a.in[IN_DECAY][dir * NH + h] * LOG2E;
    LAS unsigned char* vs = (LAS unsigned char*)lds + wave * MIX_WAVE_LDS; LAS unsigned char* ks = vs + VSLOT; lds_cptr vs3 = (lds_cptr)vs, ks3 = (lds_cptr)ks;
    f32x16 acc[2][2] = {};
    for (int blk = 0; blk < 4; ++blk) {
        { const int rr = lane >> 3, ch = lane & 7;
          u32x4 v[4], k[4];
#pragma unroll
          for (int i = 0; i < 4; ++i) { const int mrow = 32 * blk + rr + 8 * i; v[i] = *(const u32x4*)(Vc + (size_t)mrow * HD + ch * 8); k[i] = *(const u32x4*)(Kc + (size_t)mrow * HD + ch * 8); }
#pragma unroll
          for (int i = 0; i < 4; ++i) { const int mrow = 32 * blk + rr + 8 * i; const float z = ex2(lg * (float)(dir == 0 ? 127 - mrow : mrow));
              const unsigned kw[4] = {k[i].x, k[i].y, k[i].z, k[i].w}; u32x4 o;
              o.x = pg8::cvt_pk_bf16(bf2f(kw[0] & 0xffffu) * z, bf2f(kw[0] >> 16) * z); o.y = pg8::cvt_pk_bf16(bf2f(kw[1] & 0xffffu) * z, bf2f(kw[1] >> 16) * z);
              o.z = pg8::cvt_pk_bf16(bf2f(kw[2] & 0xffffu) * z, bf2f(kw[2] >> 16) * z); o.w = pg8::cvt_pk_bf16(bf2f(kw[3] & 0xffffu) * z, bf2f(kw[3] >> 16) * z);
              *(LAS u32x4*)(vs + (rr + 8 * i) * VROW + ch * 16) = v[i]; *(LAS u32x4*)(ks + (rr + 8 * i) * VROW + ch * 16) = o; } }
        LDS_WAIT();
#pragma unroll
        for (int s = 0; s < 2; ++s) {
            const bf16x8 v0 = tr_frag(vs3, s, 0, lane), v1 = tr_frag(vs3, s, 1, lane), k0 = tr_frag(ks3, s, 0, lane), k1 = tr_frag(ks3, s, 1, lane);
            acc[0][0] = MFMA32(v0, k0, acc[0][0]); acc[0][1] = MFMA32(v0, k1, acc[0][1]); acc[1][0] = MFMA32(v1, k0, acc[1][0]); acc[1][1] = MFMA32(v1, k1, acc[1][1]);
        }
        LDS_WAIT();
    }
    bf16_t* KT = (bf16_t*)(ws + WS_KF) + (((size_t)dir * NB * NH + bh) * 32 + n) * 4096;
    const int c = lane & 31, hi = lane >> 5;
#pragma unroll
    for (int eb = 0; eb < 2; ++eb)
#pragma unroll
        for (int db = 0; db < 2; ++db)
#pragma unroll
            for (int rg = 0; rg < 16; ++rg) KT[(32 * eb + crow(rg, hi)) * 64 + 32 * db + c] = (bf16_t)f2bf(acc[eb][db][rg]);
}
DEV void phase_scan(const Args& a, int gtid, int NT) {
    unsigned char* ws = a.ws;
    for (int sl = gtid; sl < 2 * NB * NH * 1024; sl += NT) {
        const int dir = sl >> 16, bh = (sl >> 10) & 63, q = sl & 1023, h = bh & 7;
        const float gC = ex2(a.in[IN_DECAY][dir * NH + h] * LOG2E * 128.f);
        const uint2* kt = (const uint2*)(ws + WS_KF) + ((size_t)dir * NB * NH + bh) * 32 * 1024 + q;
        uint2* st = (uint2*)(ws + WS_ST) + ((size_t)dir * NB * NH + bh) * 32 * 1024 + q;
        float4 s = make_float4(0.f, 0.f, 0.f, 0.f);
        for (int i = 0; i < 32; ++i) { const int n = dir == 0 ? i : 31 - i;
            st[(size_t)n * 1024] = make_uint2(pg8::cvt_pk_bf16(s.x, s.y), pg8::cvt_pk_bf16(s.z, s.w));
            const uint2 kv = kt[(size_t)n * 1024];
            s.x = gC * s.x + bf2f(kv.x & 0xffffu); s.y = gC * s.y + bf2f(kv.x >> 16); s.z = gC * s.z + bf2f(kv.y & 0xffffu); s.w = gC * s.w + bf2f(kv.y >> 16); }
    }
}
DEV void ld_rows32(const bf16_t* base, u32x4 (&v)[4], int lane) {
    const char* b = (const char*)base; const unsigned off = (unsigned)((lane >> 3) * 128 + (lane & 7) * 16);
#pragma unroll
    for (int i = 0; i < 4; ++i) v[i] = *(const u32x4*)(b + off + i * 1024);
}
DEV void retout_item(const Args& a, unsigned char* lds, int item, int xg, int lane, int wave) {
    unsigned char* ws = a.ws;
    const int hq = item & 1, n = (item >> 1) & 31, bh = 8 * xg + (item >> 6), h = bh & 7, b = bh >> 3;
    const bf16_t* Qc = (const bf16_t*)(ws + WS_RQ) + ((size_t)bh * S + n * 128) * HD; const bf16_t* Kc = (const bf16_t*)(ws + WS_RK) + ((size_t)bh * S + n * 128) * HD;
    const bf16_t* Vc = (const bf16_t*)(ws + WS_RV) + ((size_t)bh * S + n * 128) * HD; const bf16_t* Gc = (const bf16_t*)(ws + WS_RG) + ((size_t)bh * S + n * 128) * HD;
    const bf16_t* SF = (const bf16_t*)(ws + WS_ST) + (((size_t)0 * NB * NH + bh) * 32 + n) * 4096; const bf16_t* SB = (const bf16_t*)(ws + WS_ST) + (((size_t)1 * NB * NH + bh) * 32 + n) * 4096;
    const float lg0 = a.in[IN_DECAY][h] * LOG2E, lg1 = a.in[IN_DECAY][NH + h] * LOG2E;
    LAS unsigned char* slot = (LAS unsigned char*)lds + wave * MIX_WAVE_LDS; lds_cptr slot3 = (lds_cptr)slot; LAS unsigned char* kslot = slot + VSLOT;
    const int t = lane & 31, hi = lane >> 5, rr = lane >> 3, ch = lane & 7;
    bf16x8 qf[2][4];
#pragma unroll
    for (int j = 0; j < 2; ++j) { u32x4 raw[4]; ld_rows32(Qc + (size_t)(64 * hq + 32 * j) * HD, raw, lane); stage_rows_k(kslot, raw, lane); asm volatile("" ::: "memory"); read_row_frags(qf[j], kslot, lane); asm volatile("" ::: "memory"); }
    f32x16 o[2][2] = {};
#pragma unroll
    for (int dir = 0; dir < 2; ++dir) {
#pragma unroll
        for (int eb = 0; eb < 2; ++eb) { u32x4 raw[4]; bf16x8 sf[4]; ld_rows32((dir == 0 ? SF : SB) + (size_t)(32 * eb) * 64, raw, lane); stage_rows_k(kslot, raw, lane); asm volatile("" ::: "memory"); read_row_frags(sf, kslot, lane); asm volatile("" ::: "memory");
#pragma unroll
            for (int j = 0; j < 2; ++j)
#pragma unroll
                for (int st = 0; st < 4; ++st) o[j][eb] = MFMA32(sf[st], qf[j][st], o[j][eb]); }
#pragma unroll
        for (int j = 0; j < 2; ++j) { const int c = 64 * hq + 32 * j + t; const float f = dir == 0 ? ex2(lg0 * (float)(c + 1) - lg1 * (float)(128 - c)) : ex2(lg1 * (float)(128 - c));
#pragma unroll
            for (int rg = 0; rg < 16; ++rg) { o[j][0][rg] *= f; o[j][1][rg] *= f; } }
    }
    float f1[4], f2[4], b1[4], b2[4];
#pragma unroll
    for (int i = 0; i < 4; ++i) { f1[i] = __builtin_bit_cast(float, __builtin_amdgcn_readfirstlane(__builtin_bit_cast(int, ex2(-lg0 * (float)i)))); f2[i] = __builtin_bit_cast(float, __builtin_amdgcn_readfirstlane(__builtin_bit_cast(int, ex2(-lg0 * (float)(8 * i)))));
        b1[i] = __builtin_bit_cast(float, __builtin_amdgcn_readfirstlane(__builtin_bit_cast(int, ex2(lg1 * (float)i)))); b2[i] = __builtin_bit_cast(float, __builtin_amdgcn_readfirstlane(__builtin_bit_cast(int, ex2(lg1 * (float)(8 * i))))); }
#pragma nounroll
    for (int kb = 0; kb < 4; ++kb) {
        { u32x4 kraw[4], vv[4]; ld_rows32(Kc + (size_t)(32 * kb) * HD, kraw, lane); ld_rows32(Vc + (size_t)(32 * kb) * HD, vv, lane);
#pragma unroll
        for (int i = 0; i < 4; ++i) *(LAS u32x4*)(slot + (rr + 8 * i) * VROW + ch * 16) = vv[i];
        stage_rows_k(kslot, kraw, lane); }
        asm volatile("" ::: "memory");
        bf16x8 kf[4]; read_row_frags(kf, kslot, lane);
        const bf16x8 v00 = tr_frag(slot3, 0, 0, lane), v10 = tr_frag(slot3, 1, 0, lane), v01 = tr_frag(slot3, 0, 1, lane), v11 = tr_frag(slot3, 1, 1, lane);
        asm volatile("" ::: "memory");
#pragma unroll
        for (int j = 0; j < 2; ++j) {
            const int qbi = 2 * hq + j;
            f32x16 sc = {};
#pragma unroll
            for (int st = 0; st < 4; ++st) sc = MFMA32(kf[st], qf[j][st], sc);
            if (kb < qbi) { const float A = ex2(lg0 * (float)(32 * (qbi - kb) + t - 4 * hi)); float a2[4];
#pragma unroll
                for (int q = 0; q < 4; ++q) a2[q] = A * f2[q];
#pragma unroll
                for (int rg = 0; rg < 16; ++rg) sc[rg] *= a2[rg >> 2] * f1[rg & 3];
            } else if (kb > qbi) { const float A = ex2(lg1 * (float)(32 * (kb - qbi) - t + 4 * hi)); float a2[4];
#pragma unroll
                for (int q = 0; q < 4; ++q) a2[q] = A * b2[q];
#pragma unroll
                for (int rg = 0; rg < 16; ++rg) sc[rg] *= a2[rg >> 2] * b1[rg & 3];
            } else {
                int tt = t - 4 * hi; asm volatile("" : "+v"(tt));
#pragma unroll
                for (int rg = 0; rg < 16; ++rg) { const int df = tt - ((rg & 3) + 8 * (rg >> 2)); sc[rg] *= df >= 0 ? ex2(lg0 * (float)df) : ex2(lg1 * (float)(-df)); }
            }
            const bf16x8 p0 = pack_p(sc, 0), p1 = pack_p(sc, 1);
            o[j][0] = MFMA32(v00, p0, o[j][0]); o[j][0] = MFMA32(v10, p1, o[j][0]);
            o[j][1] = MFMA32(v01, p0, o[j][1]); o[j][1] = MFMA32(v11, p1, o[j][1]);
        }
    }
    const float* gn = a.in[IN_GN] + h * HD; const unsigned gnoff = (unsigned)(16 * hi); LAS unsigned char* kq = kslot + t * KROW + 8 * hi;
#pragma unroll
    for (int j = 0; j < 2; ++j) {
        const int r0 = n * 128 + 64 * hq + 32 * j;
        { u32x4 raw[4]; ld_rows32(Gc + (size_t)(64 * hq + 32 * j) * HD, raw, lane); stage_rows_k(kslot, raw, lane); asm volatile("" ::: "memory"); }
        float sm = 0.f;
#pragma unroll
        for (int rg = 0; rg < 16; ++rg) sm += o[j][0][rg] + o[j][1][rg];
        sm = sum_halves(sm); const float mu = sm * (1.f / 64.f); float vq = 0.f;
#pragma unroll
        for (int rg = 0; rg < 16; ++rg) { const float d0 = o[j][0][rg] - mu, d1 = o[j][1][rg] - mu; vq += d0 * d0 + d1 * d1; }
        vq = sum_halves(vq); const float rstd = rsqrtf(vq * (1.f / 64.f) + EPS);
        u32x2 ow[2][4];
#pragma unroll
        for (int db = 0; db < 2; ++db)
#pragma unroll
            for (int g4 = 0; g4 < 4; ++g4) { const u32x2 gw = *(const LAS u32x2*)(kq + (32 * db + 8 * g4) * 2); const float4 gg = *(const float4*)((const char*)gn + gnoff + (32 * db + 8 * g4) * 4);
                const float gate[4] = {bf2f(gw[0] & 0xffffu), bf2f(gw[0] >> 16), bf2f(gw[1] & 0xffffu), bf2f(gw[1] >> 16)}; const float gv[4] = {gg.x, gg.y, gg.z, gg.w}; float ov[4];
#pragma unroll
                for (int i = 0; i < 4; ++i) ov[i] = (o[j][db][4 * g4 + i] - mu) * rstd * gv[i] * (gate[i] * __builtin_amdgcn_rcpf(1.f + ex2(-gate[i] * LOG2E)));
                ow[db][g4] = (u32x2){pg8::cvt_pk_bf16(ov[0], ov[1]), pg8::cvt_pk_bf16(ov[2], ov[3])}; }
        asm volatile("" ::: "memory");
#pragma unroll
        for (int db = 0; db < 2; ++db)
#pragma unroll
            for (int g4 = 0; g4 < 4; ++g4) *(LAS u32x2*)(kq + (32 * db + 8 * g4) * 2) = ow[db][g4];
        asm volatile("" ::: "memory");
        { bf16_t* ob = (bf16_t*)(ws + WS_XN) + ((size_t)b * S + r0) * D + h * HD;
#pragma unroll
          for (int i = 0; i < 4; ++i) { const u32x4 w = *(const LAS u32x4*)(kslot + (rr + 8 * i) * KROW + ch * 16); *(u32x4*)(ob + (size_t)(rr + 8 * i) * D + ch * 8) = w; } }
        asm volatile("" ::: "memory");
    }
}
DEV void phase_attn_merge(const Args& a, int gtid, int NT) {
    unsigned char* ws = a.ws; const float* L = (const float*)(ws + WS_ATTL); const bf16_t* O = (const bf16_t*)(ws + WS_ATTO); bf16_t* mixed = (bf16_t*)(ws + WS_XN);
    for (int it = gtid; it < NB * NH * S * 8; it += NT) {
        const int ch = it & 7, row = it >> 3;
        const int bh = row >> 12, pos = row & 4095, b = bh >> 3, h = bh & 7;
        const float l0 = L[row], l1 = L[(size_t)NB * NH * S + row], l2 = L[(size_t)2 * NB * NH * S + row];
        const float mx = fmaxf(l0, fmaxf(l1, l2)); float w0 = ex2(l0 - mx), w1 = ex2(l1 - mx), w2 = ex2(l2 - mx); const float is = 1.f / (w0 + w1 + w2); w0 *= is; w1 *= is; w2 *= is;
        const uint4 a0 = *(const uint4*)(O + (size_t)row * HD + ch * 8), a1 = *(const uint4*)(O + ((size_t)NB * NH * S + row) * HD + ch * 8), a2 = *(const uint4*)(O + ((size_t)2 * NB * NH * S + row) * HD + ch * 8);
        const unsigned x0[4] = {a0.x, a0.y, a0.z, a0.w}, x1[4] = {a1.x, a1.y, a1.z, a1.w}, x2[4] = {a2.x, a2.y, a2.z, a2.w}; unsigned o[4];
#pragma unroll
        for (int j = 0; j < 4; ++j) o[j] = pg8::cvt_pk_bf16(w0 * bf2f(x0[j] & 0xffffu) + w1 * bf2f(x1[j] & 0xffffu) + w2 * bf2f(x2[j] & 0xffffu), w0 * bf2f(x0[j] >> 16) + w1 * bf2f(x1[j] >> 16) + w2 * bf2f(x2[j] >> 16));
        *(uint4*)(mixed + ((size_t)b * S + pos) * D + 512 + h * HD + ch * 8) = make_uint4(o[0], o[1], o[2], o[3]);
    }
}
DEV void phase_mix_a(const Args& a, unsigned char* lds, int wg, int G, int lane, int wave, int tid) {
    { const float* bt = (const float*)(a.ws + WS_BIAS); LAS float* bl = (LAS float*)((LAS unsigned char*)lds + MIX_BIAS_OFF);
      for (int i = tid; i < 3 * NH * 192; i += NTHR) { const int ph = i / 192, bi = i % 192 - 32; bl[i] = (bi >= 0 && bi <= 128) ? bt[ph * 129 + bi] : -1e30f; } }
    __syncthreads();
    if (wave >= NWM) {
        for (int rep = 0; rep < a.rep[5]; ++rep) { asm volatile("" : "+v"(lane)); phase_latew(a, lds, wg * (NWAVES - NWM) + (wave - NWM), G * (NWAVES - NWM), lane, wave); }
        return;
    }
    const int x = wg & 7, wq = (wg >> 3) * NWM + wave, WPX = (G >> 3) * NWM;
    for (int rep = 0; rep < a.rep[0]; ++rep) { asm volatile("" : "+v"(lane)); for (int it = wq; it < 2 * 32 * NH; it += WPX) retstate_item(a, lds, it, x, lane, wave); }
    for (int rep = 0; rep < a.rep[1]; ++rep) { asm volatile("" : "+v"(lane)); attn_items(a, lds, wg, G, lane, wave); }
}
DEV void phase_mix_b(const Args& a, unsigned char* lds, int wg, int G, int lane, int wave, int tid) {
    const int x = wg & 7, wq = (wg >> 3) * NWAVES + wave, WPX = (G >> 3) * NWAVES;
    for (int rep = 0; rep < a.rep[2]; ++rep) { asm volatile("" : "+v"(lane)); for (int it = wq; it < NH * 32 * 2; it += WPX) retout_item(a, lds, it, x, lane, wave); }
    for (int rep = 0; rep < a.rep[3]; ++rep) { asm volatile("" : "+v"(tid)); phase_attn_merge(a, wg * NTHR + tid, G * NTHR); }
}
#define XB_TMO      128
#define XB_XCNT(j)  (256  + 64 * (j))
#define XB_XSUB(j)  (1280 + 64 * (j))
#define XB_XGEN(j)  (2304 + 64 * (j))
#define XB_TOP      3328
#define XB_TOPGEN   3392
#define XCD_BAR_WORDS 3456
#define XB_SPIN_CAP (1u << 18)

__device__ __forceinline__ unsigned xb_ld(unsigned* p)              { return __hip_atomic_load(p, __ATOMIC_RELAXED, __HIP_MEMORY_SCOPE_AGENT); }
__device__ __forceinline__ unsigned xb_add(unsigned* p, unsigned v) { return __hip_atomic_fetch_add(p, v, __ATOMIC_RELAXED, __HIP_MEMORY_SCOPE_AGENT); }
__device__ __forceinline__ unsigned xb_xcc_id() { return (unsigned)__builtin_amdgcn_s_getreg((3 << 11) | 20) & 0xFu; }
#define XB_SPIN(cond, bar) do { unsigned _sp = 0; while (cond) { __builtin_amdgcn_s_sleep(1); \
    if ((++_sp & 255u) == 0u) { if (xb_ld(&(bar)[XB_TMO])) break; if (_sp > XB_SPIN_CAP) { atomicAdd(&(bar)[XB_TMO], 1u); break; } } } } while (0)

struct XcdBarrier {
    unsigned* bar; unsigned x;
    volatile LAS unsigned* st;
};

__device__ __forceinline__ XcdBarrier xcd_barrier_post(unsigned* bar, volatile LAS unsigned* st) {
    XcdBarrier b; b.bar = bar; b.x = xb_xcc_id(); b.st = st;
    if (threadIdx.x == 0) (void)xb_add(&bar[XB_XCNT(b.x)], 1u);
    return b;
}
__device__ __forceinline__ void xcd_barrier_complete(unsigned* bar, unsigned x, unsigned& nloc, unsigned& nx) {
    const unsigned G = gridDim.x * gridDim.y * gridDim.z;
    unsigned sum, cnt, mine, sp = 0u;
    for (;;) {
        sum = 0u; cnt = 0u; mine = 0u;
#pragma unroll
        for (unsigned j = 0; j < 16; ++j) { const unsigned c = xb_ld(&bar[XB_XCNT(j)]); sum += c; cnt += (c > 0u) ? 1u : 0u; mine = (j == x) ? c : mine; }
        if (sum == G) break;
        __builtin_amdgcn_s_sleep(1);
        if ((++sp & 255u) == 0u) { if (xb_ld(&bar[XB_TMO])) break; if (sp > XB_SPIN_CAP) { atomicAdd(&bar[XB_TMO], 1u); break; } }
    }
    nloc = mine > 0u ? mine : 1u; nx = cnt > 0u ? cnt : 1u;
}

__device__ __forceinline__ void xcd_barrier(const XcdBarrier& b) {
    asm volatile("s_waitcnt vmcnt(0)" ::: "memory");
    __syncthreads();
    if (threadIdx.x == 0) {
        unsigned* bar = b.bar;
        __builtin_amdgcn_s_waitcnt(0);
        unsigned nloc = b.st[0], nx = b.st[1];
        if (nloc == 0u) { xcd_barrier_complete(bar, b.x, nloc, nx); b.st[0] = nloc; b.st[1] = nx; }
        const unsigned old = xb_add(&bar[XB_XSUB(b.x)], 1u);
        const unsigned gen = old / nloc;
        if (old + 1u == (gen + 1u) * nloc) {
            __builtin_amdgcn_fence(__ATOMIC_RELEASE, "agent");
            asm volatile("s_waitcnt vmcnt(0)" ::: "memory");
            const unsigned og = xb_add(&bar[XB_TOP], 1u);
            const unsigned tg = og / nx;
            if (og + 1u == (tg + 1u) * nx) xb_add(&bar[XB_TOPGEN], 1u);
            else XB_SPIN(xb_ld(&bar[XB_TOPGEN]) == tg, bar);
            __builtin_amdgcn_fence(__ATOMIC_ACQUIRE, "agent");
            xb_add(&bar[XB_XGEN(b.x)], 1u);
            asm volatile("s_waitcnt vmcnt(0)" ::: "memory");
        } else {
            XB_SPIN(xb_ld(&bar[XB_XGEN(b.x)]) == gen, bar);
            __builtin_amdgcn_fence(__ATOMIC_ACQUIRE, "agent");
            asm volatile("s_waitcnt vmcnt(0)" ::: "memory");
        }
    }
    __syncthreads();
}

#ifndef MK_LAUNCHES
#define MK_LAUNCHES 1
#endif
#ifndef WGM_MOE1
#define WGM_MOE1 8
#endif
#ifndef WGM_MOE2
#define WGM_MOE2 8
#endif
constexpr int NPH = 11;
typedef const __attribute__((address_space(4))) Args* kargs_t;
DEV Args load_args(kargs_t kp) { Args a;
#pragma unroll
    for (int i = 0; i < 13; ++i) a.in[i] = kp->in[i];
    a.out = kp->out; a.ws = kp->ws; a.ph_lo = kp->ph_lo; a.ph_hi = kp->ph_hi;
#pragma unroll
    for (int i = 0; i < 16; ++i) a.rep[i] = kp->rep[i];
    return a; }
__global__ void __launch_bounds__(NTHR, 2) mega(Args a_) {
    kargs_t kp = (kargs_t)__builtin_amdgcn_kernarg_segment_ptr();
    extern __shared__ __attribute__((aligned(16))) unsigned char lds[];
    int tid = threadIdx.x, lane = tid & 63, wave = __builtin_amdgcn_readfirstlane(tid >> 6);
    const int G = gridDim.x, wg = blockIdx.x, NGW = G * NWAVES; int gw = wg * NWAVES + wave;
#define FRESH_IDS() do { tid = threadIdx.x; asm volatile("" : "+v"(tid)); lane = tid & 63; wave = __builtin_amdgcn_readfirstlane(tid >> 6); gw = wg * NWAVES + wave; } while (0)
    const int lo = kp->ph_lo, hi = kp->ph_hi;
    unsigned char* ws = kp->ws;
    volatile LAS unsigned* bst = (volatile LAS unsigned*)((LAS unsigned char*)lds + LDS_BYTES - 64);
    if (tid < 2) bst[tid] = 0u;
    __syncthreads();
    XcdBarrier bar = xcd_barrier_post((unsigned*)(ws + WS_CTL) + 4096, bst);
#define IN(k) (lo <= (k) && (k) < hi)
#define SEAM(k) do { if (IN(k) && IN((k) + 1)) { xcd_barrier(bar); } } while (0)
    if (IN(0)) { FRESH_IDS(); const Args a = load_args(kp); unsigned char* ws = a.ws; for (int r = 0; r < a.rep[6]; ++r) { FRESH_IDS(); phase_prep(a, lds, gw, NGW, lane, wave); } }
    SEAM(0);
    if (IN(1)) { FRESH_IDS(); const Args a = load_args(kp); unsigned char* ws = a.ws; pg8::Gemm g{(const bf16_t*)(ws + WS_XN), (const bf16_t*)(ws + WS_WIN), D}; SchedPlain Sc; Sc.init(M, PC, G, wg); Sc.rowbytes = D * 2;
        EpiInProj E{ws, (const float*)(ws + WS_ROPE)};
        for (int r = 0; r < a.rep[8]; ++r) { FRESH_IDS(); pg8::Gemm g2 = g; asm volatile("" : "+s"(g2.A), "+s"(g2.Bt)); pg8::gemm_phase<EpiInProj, SchedPlain, true>((LAS unsigned char*)lds, g2, Sc, E); } }
    SEAM(1);
    if (IN(2)) { FRESH_IDS(); const Args a = load_args(kp); unsigned char* ws = a.ws; phase_mix_a(a, lds, wg, G, lane, wave, tid); }
    SEAM(2);
    if (IN(3)) { FRESH_IDS(); const Args a = load_args(kp); unsigned char* ws = a.ws; for (int r = 0; r < a.rep[13]; ++r) { FRESH_IDS(); phase_scan(a, wg * NTHR + tid, G * NTHR); } }
    SEAM(3);
    if (IN(4)) { FRESH_IDS(); const Args a = load_args(kp); unsigned char* ws = a.ws; phase_mix_b(a, lds, wg, G, lane, wave, tid); }
    SEAM(4);
    { const Args a = load_args(kp); for (int r = 0; r < a.rep[14]; ++r) xcd_barrier(bar); for (int r = 0; r < a.rep[15]; ++r) cg::this_grid().sync(); }
    if (IN(5)) { FRESH_IDS(); const Args a = load_args(kp); unsigned char* ws = a.ws; pg8::Gemm g{(const bf16_t*)(ws + WS_XN), (const bf16_t*)(ws + WS_WOUT), D}; SchedPlain Sc; Sc.init(M, D, G, wg); Sc.rowbytes = D * 2;
        EpiOutProj E{a.in[IN_X], (bf16_t*)(ws + WS_X1)};
        for (int r = 0; r < a.rep[9]; ++r) { FRESH_IDS(); pg8::Gemm g2 = g; asm volatile("" : "+s"(g2.A), "+s"(g2.Bt)); pg8::gemm_phase<EpiOutProj, SchedPlain, true>((LAS unsigned char*)lds, g2, Sc, E); } }
    SEAM(5);
    if (IN(6)) { FRESH_IDS(); const Args a = load_args(kp); unsigned char* ws = a.ws; for (int r = 0; r < a.rep[4]; ++r) { FRESH_IDS(); phase_router(a, lds, gw, NGW, lane, tid); } }
    SEAM(6);
    if (IN(7)) { FRESH_IDS(); const Args a = load_args(kp); unsigned char* ws = a.ws; for (int r = 0; r < a.rep[7]; ++r) { FRESH_IDS(); phase_topk(a, lds, wg, G, tid, lane, wave); } }
    SEAM(7);
    if (IN(8)) { FRESH_IDS(); const Args a = load_args(kp); unsigned char* ws = a.ws; pg8::Gemm g{(const bf16_t*)(ws + WS_XN), (const bf16_t*)(ws + WS_WGU), D}; SchedMoe1 Sc; Sc.init(MR, 4096, G, wg, WGM_MOE1); Sc.idxl = (const LAS int*)((LAS unsigned char*)lds + 131072);
        { const int* idxg = (const int*)(ws + WS_IDX); LAS int* il = (LAS int*)((LAS unsigned char*)lds + 131072); pg8::Unit uu;
          for (int i = 0; i < 16; ++i) if (Sc.next(i, uu) && tid < 256) il[i * 256 + tid] = idxg[uu.pm * 256 + tid];
          __syncthreads(); }
        EpiSwiGLU E{ws + WS_HID};
        for (int r = 0; r < a.rep[10]; ++r) { FRESH_IDS(); pg8::Gemm g2 = g; asm volatile("" : "+s"(g2.A), "+s"(g2.Bt)); pg8::gemm_phase<EpiSwiGLU, SchedMoe1, true, true>((LAS unsigned char*)lds, g2, Sc, E); } }
    SEAM(8);
    if (IN(9)) { FRESH_IDS(); const Args a = load_args(kp); unsigned char* ws = a.ws; pg8::Gemm g{(const bf16_t*)(ws + WS_HID), (const bf16_t*)(ws + WS_WD), DFF}; SchedMoe2 Sc; Sc.init(MR, D, G, wg, WGM_MOE2);
        EpiDown E{ws + WS_Y};
        for (int r = 0; r < a.rep[11]; ++r) { FRESH_IDS(); pg8::Gemm g2 = g; asm volatile("" : "+s"(g2.A), "+s"(g2.Bt)); pg8::gemm_phase<EpiDown, SchedMoe2, true, true>((LAS unsigned char*)lds, g2, Sc, E); } }
    SEAM(9);
    if (IN(10)) { FRESH_IDS(); const Args a = load_args(kp); unsigned char* ws = a.ws; for (int r = 0; r < a.rep[12]; ++r) { FRESH_IDS(); phase_final(a, gw, NGW, lane); } }
#undef IN
#undef SEAM
}

extern "C" void kernel_launch(void* const* d_in, const int* in_sizes, int n_in, void* d_out, int out_size, void* d_ws, size_t ws_size, hipStream_t stream) {
    static int grid = 0;
    if (grid == 0) {
        if (n_in != 13 || in_sizes[0] != M * D || out_size != M * D || ws_size < WS_END) { fprintf(stderr, "kernel_launch: unexpected shapes n_in %d in0 %d out %d ws %zu (need %zu)\n", n_in, n_in > 0 ? in_sizes[0] : -1, out_size, ws_size, (size_t)WS_END); grid = -1; return; }
        int dev = 0, cus = 0, per_cu = 0;
        (void)hipGetDevice(&dev); (void)hipDeviceGetAttribute(&cus, hipDeviceAttributeMultiprocessorCount, dev);
        (void)hipFuncSetAttribute((const void*)mega, hipFuncAttributeMaxDynamicSharedMemorySize, LDS_BYTES);
        if (hipOccupancyMaxActiveBlocksPerMultiprocessor(&per_cu, (const void*)mega, NTHR, LDS_BYTES) != hipSuccess || per_cu < 1) { fprintf(stderr, "kernel_launch: occupancy query says %d blocks/CU\n", per_cu); per_cu = 1; }
        (void)hipGetLastError();
        grid = cus * 1;
        if (grid > cus * per_cu) grid = cus * per_cu;
    }
    if (grid < 0) return;
    (void)hipMemsetAsync((char*)d_ws + WS_CTL + 16384, 0, 16384, stream);
    Args a{};
    for (int i = 0; i < 13; ++i) a.in[i] = (const float*)d_in[i];
    a.out = (float*)d_out; a.ws = (unsigned char*)d_ws;
#ifndef PROBE_R
#define PROBE_R {1, 1, 1, 1, 1, 1, 1, 1, 1, 1, 1, 1, 1, 1, 0, 0}
#endif
    { const int rr[16] = PROBE_R; for (int i = 0; i < 16; ++i) a.rep[i] = rr[i]; }
#if MK_LAUNCHES == 1
    a.ph_lo = 0; a.ph_hi = NPH;
    void* args[] = {&a};
    hipError_t e = hipLaunchCooperativeKernel((const void*)mega, dim3(grid), dim3(NTHR), args, LDS_BYTES, stream);
    if (e != hipSuccess) fprintf(stderr, "cooperative launch failed: %s (grid %d)\n", hipGetErrorString(e), grid);
#else
    for (int p = 0; p < NPH; ++p) { a.ph_lo = p; a.ph_hi = p + 1; hipLaunchKernelGGL(mega, dim3(grid), dim3(NTHR), LDS_BYTES, stream, a); }
#endif
}
```

```cpp
#include <hip/hip_runtime.h>
#include <hip/hip_cooperative_groups.h>
#include <cstdint>
#include <cstdio>
namespace cg = cooperative_groups;

typedef unsigned short bf16_t;
#define DEV __device__ __forceinline__
#define LAS __attribute__((address_space(3)))

constexpr int NB = 8, S = 4096, D = 1024, M = NB * S;
constexpr int NH = 8, HD = 64, PC = 3584;
constexpr int NE = 16, CAP = 512, DFF = 2048, MR = NE * NB * CAP;
constexpr float EPS = 1e-6f, LOG2E = 1.4426950408889634f;
constexpr int NWAVES = 8, NTHR = 512;
constexpr int LDS_BYTES = 163840;

constexpr size_t MiB = 1u << 20;
constexpr size_t WS_CTL = 0;
constexpr size_t WS_ROPE = 1 * MiB;
constexpr size_t WS_BIAS = 64 * 1024;
constexpr size_t WS_IDX = 128 * 1024;
constexpr size_t WS_AFF = 3 * MiB;
constexpr size_t WS_INV = 5 * MiB;
constexpr size_t WS_WOUT = 7 * MiB;
constexpr size_t WS_WIN = 9 * MiB;
constexpr size_t WS_XN = 16 * MiB;
constexpr size_t WS_RQ = 80 * MiB, WS_RK = 112 * MiB, WS_RV = 144 * MiB, WS_RG = 176 * MiB;
constexpr size_t WS_AQ = 208 * MiB, WS_AK = 240 * MiB, WS_AV = 272 * MiB;
constexpr size_t WS_ATTO = 304 * MiB;
constexpr size_t WS_ATTL0 = 528 * MiB, WS_ATTL1 = 529 * MiB, WS_ATTL2 = 2 * MiB;
constexpr size_t WS_KF = 400 * MiB;
constexpr size_t WS_WD = 432 * MiB;
constexpr size_t WS_WGU = 464 * MiB;
constexpr size_t WS_Y = 144 * MiB;
constexpr size_t WS_HID = 272 * MiB;
constexpr size_t WS_END = 530 * MiB;
DEV size_t x1_off(int row) { const int b = row >> 12, s = row & 4095; return (s < 2048 ? WS_RQ : WS_RK) + (size_t)b * 4 * MiB + (size_t)(s & 2047) * 2048; }
DEV size_t afft_off(int b, int e) { return WS_AQ + (size_t)b * 4 * MiB + (size_t)e * S * 4; }
DEV size_t st_off(int dir, int bh, int n) { return WS_AQ + (size_t)(bh >> 3) * 4 * MiB + ((size_t)((dir * NH + (bh & 7)) * 32 + n)) * 8192; }

DEV unsigned f2bf(float f) { unsigned u = __float_as_uint(f); return (u + 0x7fffu + ((u >> 16) & 1u)) >> 16; }
DEV float bf2f(unsigned h) { return __uint_as_float(h << 16); }
DEV unsigned pk2(float lo, float hi) { return f2bf(lo) | (f2bf(hi) << 16); }
#define DPPF(x, ctrl) __builtin_bit_cast(float, __builtin_amdgcn_update_dpp(__builtin_bit_cast(int, (x)), __builtin_bit_cast(int, (x)), (ctrl), 0xF, 0xF, false))
DEV float lane_x1(float x) { return DPPF(x, 0xB1); }
DEV float lane_x2(float x) { return DPPF(x, 0x4E); }
DEV float lane_m8(float x) { return DPPF(x, 0x141); }
DEV float lane_x8(float x) { return DPPF(x, 0x128); }
DEV float lane_x16(float x) { const auto r = __builtin_amdgcn_permlane16_swap(__float_as_uint(x), __float_as_uint(x), false, false); return (threadIdx.x & 16) ? __uint_as_float(r[0]) : __uint_as_float(r[1]); }
DEV float lane_x32(float x) { const auto r = __builtin_amdgcn_permlane32_swap(__float_as_uint(x), __float_as_uint(x), false, false); return (threadIdx.x & 32) ? __uint_as_float(r[0]) : __uint_as_float(r[1]); }
DEV float wave_sum(float v) {
    v += lane_x1(v); v += lane_x2(v); v += lane_m8(v); v += lane_x8(v); v += lane_x16(v); v += lane_x32(v);
    return v;
}
#define LDS_WAIT() asm volatile("s_waitcnt lgkmcnt(0)" ::: "memory")
namespace pg8 {
#define PG8_LAS __attribute__((address_space(3)))
typedef short bf16x8 __attribute__((ext_vector_type(8)));
typedef float f32x4 __attribute__((ext_vector_type(4)));
typedef unsigned u32x4 __attribute__((ext_vector_type(4)));
constexpr int BM = 256, BK = 64, HALF = 128, HTB = HALF * BK * 2, STAGE_BYTES = 8 * HTB, NXCD = 8, WGM = 8;
__host__ __device__ __forceinline__ int lds_byte(int r, int c) { const int st = (r >> 4) * 2 + (c >> 5), rr = r & 15, cc = c & 31, ob = rr * 64 + cc * 2; return st * 1024 + (ob ^ (((ob >> 9) & 1) << 5)); }
__host__ __device__ __forceinline__ void stage_rc(int b, int& R, int& C) { const int st = b / 1024, sb = b % 1024, swz = sb ^ (((sb >> 9) & 1) << 5); R = (st >> 1) * 16 + swz / 64; C = (st & 1) * 32 + (swz % 64) / 2; }
__host__ __device__ __forceinline__ int perm32(int rho) { const int n = rho >> 4, i = rho & 15; return 8 * (i >> 2) + 4 * n + (i & 3); }
struct Unit { int pm, pn, ui; };
struct Gemm { const bf16_t* A; const bf16_t* Bt; int K; };
struct StaticOrder {
    int nM, nN, nwg, G, c, wgm;
    __device__ void init(int M_, int N_, int G_, int c_, int wgm_ = WGM) { nM = M_ / BM; nN = N_ / BM; nwg = nM * nN; G = G_; c = c_; wgm = wgm_; }
    __device__ bool next(int i, Unit& u) const {
        const long L = (long)i * G + c; if (L >= nwg) return false;
        int wgid = (int)L; { const int q = nwg / NXCD, r = nwg % NXCD, xcd = wgid % NXCD, off = wgid / NXCD; wgid = (xcd < r ? xcd * (q + 1) : r * (q + 1) + (xcd - r) * q) + off; }
        const int nig = wgm * nN, gid = wgid / nig, fm = gid * wgm, gsz = (nM - fm) < wgm ? (nM - fm) : wgm;
        u.pm = fm + ((wgid % nig) % gsz); u.pn = (wgid % nig) / gsz; return true;
    }
};
__device__ __forceinline__ unsigned cvt_pk_bf16(float lo, float hi) { unsigned r; asm volatile("v_cvt_pk_bf16_f32 %0, %1, %2" : "=v"(r) : "v"(lo), "v"(hi)); return r; }

typedef int v8i __attribute__((ext_vector_type(8)));
template <class Epi, class Sched, bool ALIGN_EPI, bool FP8 = false>
__device__ __forceinline__ void gemm_phase(PG8_LAS unsigned char* lds, const Gemm g, const Sched& S, const Epi& E) {
    const int tid = threadIdx.x, wid = __builtin_amdgcn_readfirstlane(tid >> 6), lane = tid & 63, wr = wid >> 2, wc = wid & 3, fr = lane & 15, fq = lane >> 4;
    const int K = g.K, RB = FP8 ? K : 2 * K, nt = RB / 128;
    unsigned voffB;
    { int R, C; stage_rc(tid * 16, R, C); const int Rb = Epi::PERM ? ((R & ~31) + perm32(R & 31)) : R; voffB = (unsigned)(Rb * RB + C * 2); }
    const size_t kstep = (size_t)(BK * 2);
    const size_t hstep = (size_t)HALF * RB;
    const size_t tstep = 2 * hstep;
    const unsigned ldsw = (unsigned)wid * 1024u;
    const int aoff = FP8 ? lds_byte(wr * 64 + fr, fq * 16) : lds_byte(wr * 64 + fr, fq * 8), boff = FP8 ? lds_byte(wc * 32 + fr, fq * 16) : lds_byte(wc * 32 + fr, fq * 8);
    const int x16 = 16 * (fq & 1);
    const char* gA = (const char*)g.A;
#define PG8_SA(b, h) (((b) * 2 + (h)) * HTB)
#define PG8_SB(b, h) ((4 + (b) * 2 + (h)) * HTB)
#define PG8_STAGE(bufoff, gbase, voff) do { _Pragma("unroll") for (int _i = 0; _i < 2; ++_i) \
        __builtin_amdgcn_global_load_lds((const unsigned*)((const char*)(gbase) + (size_t)_i * 64 * RB + (voff)), (PG8_LAS unsigned*)(lds + (bufoff) + ldsw + _i * 8192), 16, 0, 0); } while (0)
#define PG8_STAGE_A(bufoff, AO, h, kb) do { _Pragma("unroll") for (int _i = 0; _i < 2; ++_i) \
        __builtin_amdgcn_global_load_lds((const unsigned*)(gA + (size_t)((AO)[h][_i] + (unsigned)(kb))), (PG8_LAS unsigned*)(lds + (bufoff) + ldsw + _i * 8192), 16, 0, 0); } while (0)
#define PG8_LDA(dst, b, h) do { if constexpr (FP8) { _Pragma("unroll") for (int m = 0; m < 4; ++m) { dst[m][0] = *(const PG8_LAS bf16x8*)(lds + PG8_SA(b, h) + aoff + m * 2048 + x16); dst[m][1] = *(const PG8_LAS bf16x8*)(lds + PG8_SA(b, h) + aoff + m * 2048 + 16 - x16); } } \
    else { _Pragma("unroll") for (int m = 0; m < 4; ++m) _Pragma("unroll") for (int k = 0; k < 2; ++k) dst[m][k] = *(const PG8_LAS bf16x8*)(lds + PG8_SA(b, h) + aoff + m * 2048 + k * 1024); } } while (0)
#define PG8_LDB(dst, b, h) do { if constexpr (FP8) { _Pragma("unroll") for (int n = 0; n < 2; ++n) { dst[n][0] = *(const PG8_LAS bf16x8*)(lds + PG8_SB(b, h) + boff + n * 2048 + x16); dst[n][1] = *(const PG8_LAS bf16x8*)(lds + PG8_SB(b, h) + boff + n * 2048 + 16 - x16); } } \
    else { _Pragma("unroll") for (int n = 0; n < 2; ++n) _Pragma("unroll") for (int k = 0; k < 2; ++k) dst[n][k] = *(const PG8_LAS bf16x8*)(lds + PG8_SB(b, h) + boff + n * 2048 + k * 1024); } } while (0)
#define PG8_CAT8(x) __builtin_bit_cast(v8i, __builtin_shufflevector((x)[0], (x)[1], 0, 1, 2, 3, 4, 5, 6, 7, 8, 9, 10, 11, 12, 13, 14, 15))
#define PG8_MMA(ai, bj, At, Bt) do { __builtin_amdgcn_s_setprio(1); if constexpr (FP8) { _Pragma("unroll") for (int m = 0; m < 4; ++m) _Pragma("unroll") for (int n = 0; n < 2; ++n) \
        acc[ai][bj][m][n] = __builtin_amdgcn_mfma_scale_f32_16x16x128_f8f6f4(PG8_CAT8(Bt[n]), PG8_CAT8(At[m]), acc[ai][bj][m][n], 0, 0, 0, 0, 0, 0); } \
    else { _Pragma("unroll") for (int m = 0; m < 4; ++m) _Pragma("unroll") for (int n = 0; n < 2; ++n) _Pragma("unroll") for (int k = 0; k < 2; ++k) \
        acc[ai][bj][m][n] = __builtin_amdgcn_mfma_f32_16x16x32_bf16(Bt[n][k], At[m][k], acc[ai][bj][m][n], 0, 0, 0); } __builtin_amdgcn_s_setprio(0); } while (0)
#define PG8_WAIT_V(n) asm volatile("s_waitcnt vmcnt(" #n ")" ::: "memory")
#define PG8_WAIT_L(n) asm volatile("s_waitcnt lgkmcnt(" #n ")" ::: "memory")
#define PG8_BAR __builtin_amdgcn_s_barrier()
#define PG8_SCHED __builtin_amdgcn_sched_barrier(0)
#define PG8_AOFFS(AO, u) do { int _t = threadIdx.x; asm volatile("" : "+v"(_t)); _Pragma("unroll") for (int _i = 0; _i < 2; ++_i) { int _R, _C; stage_rc(_t * 16 + _i * 8192, _R, _C); \
        _Pragma("unroll") for (int _h = 0; _h < 2; ++_h) (AO)[_h][_i] = S.row_off(u, _h * HALF + _R) + (unsigned)(_C * 2); } } while (0)
    Unit cur, nxt; int ui = 0;
    if (!S.next(0, cur)) return;
    f32x4 acc[2][2][4][2];
#pragma unroll
    for (int a = 0; a < 2; ++a)
#pragma unroll
        for (int b = 0; b < 2; ++b)
#pragma unroll
            for (int m = 0; m < 4; ++m)
#pragma unroll
                for (int n = 0; n < 2; ++n) acc[a][b][m][n] = (f32x4){0.f, 0.f, 0.f, 0.f};
    bf16x8 At[4][2], B0[2][2], B1[2][2];
    unsigned aoc[2][2];
    PG8_AOFFS(aoc, cur);
    const char* cB = (const char*)g.Bt + (size_t)cur.pn * tstep;
    PG8_STAGE(PG8_SB(0, 0), cB, voffB); PG8_STAGE(PG8_SB(0, 1), cB + hstep, voffB); PG8_STAGE_A(PG8_SA(0, 0), aoc, 0, 0); PG8_STAGE_A(PG8_SA(0, 1), aoc, 1, 0);
    if (wr == 1) PG8_BAR;
    PG8_WAIT_V(2); PG8_BAR;
    PG8_STAGE(PG8_SB(1, 0), cB + kstep, voffB); PG8_STAGE_A(PG8_SA(1, 0), aoc, 0, 128); PG8_STAGE(PG8_SB(1, 1), cB + hstep + kstep, voffB);
    PG8_WAIT_V(6); PG8_BAR;
    for (;;) {
        const bool has_next = S.next(ui + 1, nxt);
        const char* nB = cB;
        if (has_next) nB = (const char*)g.Bt + (size_t)nxt.pn * tstep;
#pragma nounroll
        for (int t = 0; t < nt; t += 2) {
            const bool last = (t == nt - 2);
            const unsigned k1 = (unsigned)(t + 1) * 128u, k2 = last ? 0u : (unsigned)(t + 2) * 128u, k3 = k2 + 128u;
            const char* b2 = last ? nB : cB + (size_t)(t + 2) * kstep; const char* b3 = b2 + kstep;
            PG8_LDB(B0, 0, 0); PG8_LDB(B1, 0, 1); PG8_SCHED; PG8_LDA(At, 0, 0); PG8_STAGE_A(PG8_SA(1, 1), aoc, 1, k1);
            PG8_WAIT_V(8); PG8_WAIT_L(0); PG8_BAR; PG8_MMA(0, 0, At, B0); PG8_MMA(0, 1, At, B1); PG8_BAR; PG8_SCHED;
            if (last && has_next) { PG8_AOFFS(aoc, nxt); }
            PG8_LDA(At, 0, 1); PG8_STAGE(PG8_SB(0, 0), b2, voffB); PG8_STAGE(PG8_SB(0, 1), b2 + hstep, voffB); PG8_STAGE_A(PG8_SA(0, 0), aoc, 0, k2);
            PG8_WAIT_V(8); PG8_WAIT_L(0); PG8_BAR; PG8_MMA(1, 0, At, B0); PG8_MMA(1, 1, At, B1); PG8_BAR; PG8_SCHED;
            PG8_LDB(B0, 1, 0); PG8_LDB(B1, 1, 1); PG8_SCHED; PG8_LDA(At, 1, 0); PG8_STAGE_A(PG8_SA(0, 1), aoc, 1, k2);
            PG8_WAIT_V(8); PG8_WAIT_L(0); PG8_BAR; PG8_MMA(0, 0, At, B0); PG8_MMA(0, 1, At, B1); PG8_BAR; PG8_SCHED;
            PG8_LDA(At, 1, 1); PG8_STAGE(PG8_SB(1, 0), b3, voffB); PG8_STAGE(PG8_SB(1, 1), b3 + hstep, voffB); PG8_STAGE_A(PG8_SA(1, 0), aoc, 0, k3);
            PG8_WAIT_V(8); PG8_WAIT_L(0); PG8_BAR; PG8_MMA(1, 0, At, B0); PG8_MMA(1, 1, At, B1); PG8_BAR; PG8_SCHED;
        }
        if constexpr (ALIGN_EPI) { if (wr == 0) PG8_BAR; }
        { int t2 = threadIdx.x; asm volatile("" : "+v"(t2));
          const int w2 = __builtin_amdgcn_readfirstlane(t2 >> 6), l2 = t2 & 63; E(acc, cur, w2 >> 2, w2 & 3, l2 & 15, l2 >> 4); }
        if (!has_next) break;
#pragma unroll
        for (int a = 0; a < 2; ++a)
#pragma unroll
            for (int b = 0; b < 2; ++b)
#pragma unroll
                for (int m = 0; m < 4; ++m)
#pragma unroll
                    for (int n = 0; n < 2; ++n) acc[a][b][m][n] = (f32x4){0.f, 0.f, 0.f, 0.f};
        cur = nxt; cB = nB; ++ui;
        if constexpr (ALIGN_EPI) { if (wr == 1) PG8_BAR; }
    }
    PG8_WAIT_V(0);
    if constexpr (!ALIGN_EPI) { if (wr == 0) PG8_BAR; }
    PG8_BAR;
#undef PG8_SA
#undef PG8_SB
#undef PG8_STAGE
#undef PG8_STAGE_A
#undef PG8_LDA
#undef PG8_LDB
#undef PG8_MMA
#undef PG8_CAT8
#undef PG8_WAIT_V
#undef PG8_WAIT_L
#undef PG8_BAR
#undef PG8_SCHED
#undef PG8_AOFFS
}
}
struct SchedPlain : pg8::StaticOrder {
    unsigned rowbytes;
    DEV unsigned row_off(const pg8::Unit& u, int r) const { return (unsigned)(u.pm * 256 + r) * rowbytes; }
};
struct SchedMoe1 : pg8::StaticOrder {
    const LAS int* idxl;
    DEV bool next(int i, pg8::Unit& u) const { if (!pg8::StaticOrder::next(i, u)) return false; u.pn += (u.pm >> 4) * 16; u.ui = i; return true; }
    DEV unsigned row_off(const pg8::Unit& u, int r) const { const int g = u.pm * 256 + r; const int tok = ((g >> 9) & 7) * S + idxl[u.ui * 256 + r]; return (unsigned)tok * 2048u; }
};
struct SchedMoe2 : pg8::StaticOrder {
    DEV bool next(int i, pg8::Unit& u) const { if (!pg8::StaticOrder::next(i, u)) return false; u.pn += (u.pm >> 4) * 4; return true; }
    DEV unsigned row_off(const pg8::Unit& u, int r) const { return (unsigned)(u.pm * 256 + r) * (unsigned)DFF; }
};
typedef pg8::f32x4 f32x4; typedef pg8::u32x4 u32x4;
struct EpiInProj {
    static constexpr bool PERM = true;
    unsigned char* ws; const float* ropeT;
    DEV void operator()(const f32x4 (&acc)[2][2][4][2], const pg8::Unit& u, int wr, int wc, int fr, int fq) const {
        const int grp = u.pn >> 1;
        bf16_t* gbase = (bf16_t*)(ws + WS_RQ + (size_t)grp * 32 * MiB);
        const int j0 = 32 * (wc & 1) + 8 * fq;
        if (grp < 2) {
            const float sc = grp == 1 ? 0.125f : 1.f;
            f32x4 cs[2][4], sn[2][4];
#pragma unroll
            for (int ai = 0; ai < 2; ++ai)
#pragma unroll
                for (int m = 0; m < 4; ++m) { const int s = (u.pm * 256 + ai * 128 + wr * 64 + m * 16 + fr) & 4095;
                    cs[ai][m] = *(const f32x4*)(ropeT + s * 32 + (j0 >> 1)); sn[ai][m] = *(const f32x4*)(ropeT + S * 32 + s * 32 + (j0 >> 1)); }
#pragma unroll
            for (int ai = 0; ai < 2; ++ai)
#pragma unroll
                for (int m = 0; m < 4; ++m) {
                    const int row = u.pm * 256 + ai * 128 + wr * 64 + m * 16 + fr, b = row >> 12, s = row & 4095;
#pragma unroll
                    for (int bj = 0; bj < 2; ++bj) {
                        const int hd = 4 * (u.pn & 1) + 2 * bj + (wc >> 1);
                        const f32x4 lo = (acc[ai][bj][m][0] * cs[ai][m] - acc[ai][bj][m][1] * sn[ai][m]) * sc, hi = (acc[ai][bj][m][1] * cs[ai][m] + acc[ai][bj][m][0] * sn[ai][m]) * sc;
                        u32x4 w; w.x = pg8::cvt_pk_bf16(lo[0], lo[1]); w.y = pg8::cvt_pk_bf16(lo[2], lo[3]); w.z = pg8::cvt_pk_bf16(hi[0], hi[1]); w.w = pg8::cvt_pk_bf16(hi[2], hi[3]);
                        *(u32x4*)(gbase + ((size_t)(b * NH + hd) * S + s) * HD + j0) = w;
                    }
                }
        } else {
            const float sc = grp == 4 ? 0.125f * LOG2E : 1.f;
#pragma unroll
            for (int ai = 0; ai < 2; ++ai)
#pragma unroll
                for (int m = 0; m < 4; ++m) {
                    const int row = u.pm * 256 + ai * 128 + wr * 64 + m * 16 + fr, b = row >> 12, s = row & 4095;
#pragma unroll
                    for (int bj = 0; bj < 2; ++bj) {
                        const int hd = 4 * (u.pn & 1) + 2 * bj + (wc >> 1);
                        const f32x4 lo = acc[ai][bj][m][0] * sc, hi = acc[ai][bj][m][1] * sc;
                        u32x4 w; w.x = pg8::cvt_pk_bf16(lo[0], lo[1]); w.y = pg8::cvt_pk_bf16(lo[2], lo[3]); w.z = pg8::cvt_pk_bf16(hi[0], hi[1]); w.w = pg8::cvt_pk_bf16(hi[2], hi[3]);
                        *(u32x4*)(gbase + ((size_t)(b * NH + hd) * S + s) * HD + j0) = w;
                    }
                }
        }
    }
};
struct EpiOutProj {
    static constexpr bool PERM = true;
    const float* x; unsigned char* ws;
    DEV void operator()(const f32x4 (&acc)[2][2][4][2], const pg8::Unit& u, int wr, int wc, int fr, int fq) const {
#pragma unroll
        for (int ai = 0; ai < 2; ++ai)
#pragma unroll
            for (int m = 0; m < 4; ++m) {
                const int row = u.pm * 256 + ai * 128 + wr * 64 + m * 16 + fr;
                bf16_t* x1r = (bf16_t*)(ws + x1_off(row));
                f32x4 xa[2], xb[2];
#pragma unroll
                for (int bj = 0; bj < 2; ++bj) { const size_t off = (size_t)row * D + u.pn * 256 + bj * 128 + wc * 32 + 8 * fq; xa[bj] = *(const f32x4*)(x + off); xb[bj] = *(const f32x4*)(x + off + 4); }
#pragma unroll
                for (int bj = 0; bj < 2; ++bj) { const int col = u.pn * 256 + bj * 128 + wc * 32 + 8 * fq;
                    const f32x4 lo = xa[bj] + acc[ai][bj][m][0], hi = xb[bj] + acc[ai][bj][m][1];
                    u32x4 w; w.x = pg8::cvt_pk_bf16(lo[0], lo[1]); w.y = pg8::cvt_pk_bf16(lo[2], lo[3]); w.z = pg8::cvt_pk_bf16(hi[0], hi[1]); w.w = pg8::cvt_pk_bf16(hi[2], hi[3]);
                    *(u32x4*)(x1r + col) = w; }
            }
    }
};
DEV unsigned pk4_fp8e(float a, float b, float c, float d) { unsigned w = 0u; w = __builtin_amdgcn_cvt_pk_fp8_f32(a, b, w, false); w = __builtin_amdgcn_cvt_pk_fp8_f32(c, d, w, true); return w; }
struct EpiSwiGLU {
    static constexpr bool PERM = true;
    unsigned char* hid;
    DEV void operator()(const f32x4 (&acc)[2][2][4][2], const pg8::Unit& u, int wr, int wc, int fr, int fq) const {
        const int pnl = u.pn & 15;
#pragma unroll
        for (int ai = 0; ai < 2; ++ai)
#pragma unroll
            for (int m = 0; m < 4; ++m) {
                const int row = u.pm * 256 + ai * 128 + wr * 64 + m * 16 + fr;
                float o[8];
#pragma unroll
                for (int n = 0; n < 2; ++n)
#pragma unroll
                    for (int i = 0; i < 4; ++i) { const float ga = acc[ai][0][m][n][i], ua = acc[ai][1][m][n][i];
                        o[4 * n + i] = (ga * ua) * ((1.f / 1024.f) * __builtin_amdgcn_rcpf(1.f + __builtin_amdgcn_exp2f(ga * (-LOG2E / 32.f)))); }
                *(uint2*)(hid + (size_t)row * DFF + pnl * 128 + wc * 32 + 8 * fq) = make_uint2(pk4_fp8e(o[0], o[1], o[2], o[3]), pk4_fp8e(o[4], o[5], o[6], o[7]));
            }
    }
};
struct EpiDown {
    static constexpr bool PERM = true;
    unsigned char* y;
    DEV void operator()(const f32x4 (&acc)[2][2][4][2], const pg8::Unit& u, int wr, int wc, int fr, int fq) const {
        const int pnl = u.pn & 3;
#pragma unroll
        for (int ai = 0; ai < 2; ++ai)
#pragma unroll
            for (int m = 0; m < 4; ++m) {
                const int row = u.pm * 256 + ai * 128 + wr * 64 + m * 16 + fr;
#pragma unroll
                for (int bj = 0; bj < 2; ++bj) { const f32x4 lo = acc[ai][bj][m][0] * (1.f / 32.f), hi = acc[ai][bj][m][1] * (1.f / 32.f);
                    *(uint2*)(y + (size_t)row * D + pnl * 256 + bj * 128 + wc * 32 + 8 * fq) = make_uint2(pk4_fp8e(lo[0], lo[1], lo[2], lo[3]), pk4_fp8e(hi[0], hi[1], hi[2], hi[3])); }
            }
    }
};
struct Args { const float* in[13]; float* out; unsigned char* ws; int ph_lo, ph_hi; int rep[16]; };
enum { IN_X = 0, IN_G1, IN_WIN, IN_DECAY, IN_GN, IN_RELB, IN_WOUT, IN_G2, IN_WR, IN_WG, IN_WU, IN_WDN, IN_FG };

struct TrItem { const float* src; bf16_t* dst; int K, N, k0, n0, mode, fp8; };
DEV unsigned pk4_fp8(float a, float b, float c, float d) { unsigned w = 0u; w = __builtin_amdgcn_cvt_pk_fp8_f32(a, b, w, false); w = __builtin_amdgcn_cvt_pk_fp8_f32(c, d, w, true); return w; }
DEV void tr_load(const TrItem& t, f32x4 (&v)[16], int lane) {
#pragma unroll
    for (int i = 0; i < 16; ++i) { const int kk = (lane >> 4) + 4 * i, c = (lane & 15) * 4; v[i] = *(const f32x4*)(t.src + (size_t)(t.k0 + kk) * t.N + t.n0 + c); }
}
DEV int rowmap_rt(int mode, int n) {
    if (mode == 0) return n;
    if (mode == 1) { if (n >= 1024) return n; const int base = n & ~63, d = n & 63, nn = d >> 5, dd = d & 31; return base + 8 * (dd >> 2) + 4 * nn + (dd & 3); }
    return (n >> 7) * 256 + (mode == 3 ? 128 : 0) + (n & 127);
}
DEV void tr_finish(const TrItem& t, const f32x4 (&v)[16], LAS float* scr, int lane) {
#pragma unroll
    for (int i = 0; i < 16; ++i) { const int kk = (lane >> 4) + 4 * i, c = (lane & 15) * 4;
        scr[kk * 65 + c] = v[i][0]; scr[kk * 65 + c + 1] = v[i][1]; scr[kk * 65 + c + 2] = v[i][2]; scr[kk * 65 + c + 3] = v[i][3]; }
    LDS_WAIT();
#pragma unroll
    for (int i = 0; i < 8; ++i) { const int n = (lane >> 3) + 8 * i, c = (lane & 7) * 8; const LAS float* sp = scr + c * 65 + n;
        if (t.fp8) {
            const unsigned lo = pk4_fp8(sp[0] * 32.f, sp[65] * 32.f, sp[2 * 65] * 32.f, sp[3 * 65] * 32.f), hi = pk4_fp8(sp[4 * 65] * 32.f, sp[5 * 65] * 32.f, sp[6 * 65] * 32.f, sp[7 * 65] * 32.f);
            *(uint2*)((unsigned char*)t.dst + (size_t)rowmap_rt(t.mode, t.n0 + n) * t.K + t.k0 + c) = make_uint2(lo, hi);
        } else {
        u32x4 o; o.x = pk2(sp[0], sp[65]); o.y = pk2(sp[2 * 65], sp[3 * 65]); o.z = pk2(sp[4 * 65], sp[5 * 65]); o.w = pk2(sp[6 * 65], sp[7 * 65]);
        *(u32x4*)(t.dst + (size_t)rowmap_rt(t.mode, t.n0 + n) * t.K + t.k0 + c) = o; } }
    LDS_WAIT();
}
template <class Dec> DEV void tr_run(const Dec& dec, int nitems, int gw, int NGW, LAS float* scr, int lane) {
    for (int it = gw; it < nitems; it += NGW) { TrItem cur; f32x4 va[16]; dec(it, cur); tr_load(cur, va, lane); tr_finish(cur, va, scr, lane); }
}
template <class Dec> DEV void tr_run2(const Dec& dec, int nitems, int gw, int NGW, LAS float* scr, int lane) {
    int it = gw; if (it >= nitems) return;
    TrItem cur, nxt; f32x4 va[16], vb[16];
    dec(it, cur); tr_load(cur, va, lane);
    for (;;) {
        const int n1 = it + NGW; const bool h1 = n1 < nitems;
        if (h1) { dec(n1, nxt); tr_load(nxt, vb, lane); }
        tr_finish(cur, va, scr, lane);
        if (!h1) break;
        const int n2 = n1 + NGW; const bool h2 = n2 < nitems;
        if (h2) { dec(n2, cur); tr_load(cur, va, lane); }
        tr_finish(nxt, vb, scr, lane);
        if (!h2) break;
        it = n2;
    }
}
DEV void rms_row_to_bf16(const float* xrow, const float* g, bf16_t* orow, int lane) {
    const float4* xr = (const float4*)xrow + lane;
    float4 v[4]; float s = 0.f;
#pragma unroll
    for (int j = 0; j < 4; ++j) { v[j] = xr[64 * j]; s += v[j].x * v[j].x + v[j].y * v[j].y + v[j].z * v[j].z + v[j].w * v[j].w; }
    const float rs = rsqrtf(wave_sum(s) * (1.f / D) + EPS);
    uint2* o = (uint2*)orow + lane;
#pragma unroll
    for (int j = 0; j < 4; ++j) { const float4 gg = ((const float4*)g)[lane + 64 * j];
        o[64 * j] = make_uint2(pk2(v[j].x * rs * gg.x, v[j].y * rs * gg.y), pk2(v[j].z * rs * gg.z, v[j].w * rs * gg.w)); }
}
DEV void phase_prep(const Args& a, unsigned char* lds, int gw, int NGW, int lane, int wave) {
    unsigned char* ws = a.ws;
    float* ropeT = (float*)(ws + WS_ROPE); float* biasT = (float*)(ws + WS_BIAS);
    for (int t = gw * 64 + lane; t < S * 32; t += NGW * 64) {
        const int pos = t >> 5, i = t & 31; const double inv = pow(10000.0, -(double)i / 32.0), ang = (double)pos * inv;
        ropeT[t] = (float)cos(ang); ropeT[S * 32 + t] = (float)sin(ang);
        if (t < 3 * NH * 129) { const int p = t / (NH * 129), h = (t / 129) % NH, o = t % 129 - 64, dil = p == 0 ? 1 : (p == 1 ? 4 : 16), rel = o * dil, n = rel < 0 ? -rel : rel;
            int bucket = rel > 0 ? 16 : 0;
            if (n < 8) bucket += n; else { int large = 8 + (int)(log((double)n / 8.0) / log(128.0) * 8.0); if (large > 15) large = 15; bucket += large; }
            biasT[t] = a.in[IN_RELB][bucket * NH + h] * LOG2E; }
    }
    LAS float* scr = (LAS float*)((LAS unsigned char*)lds + wave * 16640);
    constexpr int I_IN = (D / 64) * (PC / 64), I_OUT = (D / 64) * (D / 64);
    { const float* w_in = a.in[IN_WIN]; const float* w_out = a.in[IN_WOUT]; bf16_t* Win = (bf16_t*)(ws + WS_WIN); bf16_t* Wout = (bf16_t*)(ws + WS_WOUT);
      auto dec = [=](int it, TrItem& t) { if (it < I_IN) { t.src = w_in; t.dst = Win; t.K = D; t.N = PC; t.k0 = (it / (PC / 64)) * 64; t.n0 = (it % (PC / 64)) * 64; t.mode = 1; t.fp8 = 0; }
          else { const int r = it - I_IN; t.src = w_out; t.dst = Wout; t.K = D; t.N = D; t.k0 = (r / (D / 64)) * 64; t.n0 = (r % (D / 64)) * 64; t.mode = 0; t.fp8 = 0; } };
      tr_run(dec, I_IN + I_OUT, gw, NGW, scr, lane); }
    {
      const float* x = a.in[IN_X]; const float* g = a.in[IN_G1]; bf16_t* XN = (bf16_t*)(ws + WS_XN);
      float4 va[4], vb[4], vc[4];
      { const float4* xr = (const float4*)(x + (size_t)gw * D) + lane;
#pragma unroll
        for (int j = 0; j < 4; ++j) va[j] = xr[64 * j];
        if (gw + NGW < M) { const float4* xs = (const float4*)(x + (size_t)(gw + NGW) * D) + lane;
#pragma unroll
          for (int j = 0; j < 4; ++j) vb[j] = xs[64 * j]; } }
      for (int m = gw; m < M; m += NGW) {
          if (m + 2 * NGW < M) { const float4* xr = (const float4*)(x + (size_t)(m + 2 * NGW) * D) + lane;
#pragma unroll
              for (int j = 0; j < 4; ++j) vc[j] = xr[64 * j]; }
          float s = 0.f;
#pragma unroll
          for (int j = 0; j < 4; ++j) s += va[j].x * va[j].x + va[j].y * va[j].y + va[j].z * va[j].z + va[j].w * va[j].w;
          const float rs = rsqrtf(wave_sum(s) * (1.f / D) + EPS);
          uint2* o = (uint2*)(XN + (size_t)m * D) + lane;
#pragma unroll
          for (int j = 0; j < 4; ++j) { const float4 gg = ((const float4*)g)[lane + 64 * j];
              o[64 * j] = make_uint2(pk2(va[j].x * rs * gg.x, va[j].y * rs * gg.y), pk2(va[j].z * rs * gg.z, va[j].w * rs * gg.w)); }
#pragma unroll
          for (int j = 0; j < 4; ++j) { va[j] = vb[j]; vb[j] = vc[j]; }
      } }
}
DEV void phase_latew(const Args& a, unsigned char* lds, int gw, int NGW, int lane, int wave) {
    unsigned char* ws = a.ws; LAS float* scr = (LAS float*)((LAS unsigned char*)lds + wave * 16640);
    constexpr int I_G = (D / 64) * (DFF / 64);
    const float* wg_ = a.in[IN_WG]; const float* wu_ = a.in[IN_WU]; const float* wd_ = a.in[IN_WDN]; bf16_t* Wgu = (bf16_t*)(ws + WS_WGU); bf16_t* Wd = (bf16_t*)(ws + WS_WD);
    auto dec = [=](int it, TrItem& t) { const int which = it / (NE * I_G), r = it % (NE * I_G), e = r / I_G, q = r % I_G;
        t.fp8 = 1;
        if (which < 2) { t.src = (which == 0 ? wg_ : wu_) + (size_t)e * D * DFF; t.dst = (bf16_t*)((unsigned char*)Wgu + (size_t)e * 4096 * D); t.K = D; t.N = DFF; t.n0 = (q / (D / 64)) * 64; t.k0 = (q % (D / 64)) * 64; t.mode = 2 + which; }
        else { t.src = wd_ + (size_t)e * DFF * D; t.dst = (bf16_t*)((unsigned char*)Wd + (size_t)e * D * DFF); t.K = DFF; t.N = D; t.n0 = (q / (DFF / 64)) * 64; t.k0 = (q % (DFF / 64)) * 64; t.mode = 0; } };
    tr_run2(dec, 3 * NE * I_G, gw, NGW, scr, lane);
}
DEV void phase_router(const Args& a, unsigned char* lds, int xg, int gwl, int NGW, int lane, int tid) {
    const int gw = xg * S + gwl, M = (xg + 1) * S;
    unsigned char* ws = a.ws; const float* g2 = a.in[IN_G2]; const float* wr = a.in[IN_WR];
    bf16_t* H2b = (bf16_t*)(ws + WS_XN); float* aff = (float*)(ws + WS_AFF); int* inv = (int*)(ws + WS_INV);
    LAS f32x4* wl = (LAS f32x4*)(LAS unsigned char*)lds;
    for (int i = tid; i < D * 4; i += NTHR) { const int k = i >> 2, c = i & 3, slot = (k & 3) * 256 + (k >> 2); wl[slot * 4 + ((c + (slot >> 2)) & 3)] = *(const f32x4*)(wr + (size_t)k * NE + 4 * c); }
    __syncthreads();
    uint2 xq[4][4], xp[4][4];
#pragma unroll
    for (int q = 0; q < 4; ++q) { const int r = gw + q * NGW; if (r < M) { const uint2* xr = (const uint2*)(ws + x1_off(r)) + lane;
#pragma unroll
        for (int j = 0; j < 4; ++j) xp[q][j] = xr[64 * j]; } }
    for (int row4 = gw; row4 < M; row4 += 4 * NGW) {
#pragma unroll
      for (int q = 0; q < 4; ++q)
#pragma unroll
        for (int j = 0; j < 4; ++j) xq[q][j] = xp[q][j];
#pragma unroll
      for (int q = 0; q < 4; ++q) { const int r = row4 + (4 + q) * NGW; if (r < M) { const uint2* xr = (const uint2*)(ws + x1_off(r)) + lane;
#pragma unroll
          for (int j = 0; j < 4; ++j) xp[q][j] = xr[64 * j]; } }
#pragma unroll
      for (int q = 0; q < 4; ++q) {
        const int row = row4 + q * NGW; if (row >= M) break;
        float4 v[4]; float s = 0.f;
#pragma unroll
        for (int j = 0; j < 4; ++j) { v[j] = make_float4(bf2f(xq[q][j].x & 0xffffu), bf2f(xq[q][j].x >> 16), bf2f(xq[q][j].y & 0xffffu), bf2f(xq[q][j].y >> 16)); s += v[j].x * v[j].x + v[j].y * v[j].y + v[j].z * v[j].z + v[j].w * v[j].w; }
        const float rs = rsqrtf(wave_sum(s) * (1.f / D) + EPS);
        f32x4 lg[4];
#pragma unroll
        for (int c = 0; c < 4; ++c) lg[c] = (f32x4){0.f, 0.f, 0.f, 0.f};
        unsigned* o = (unsigned*)((unsigned char*)H2b + (size_t)row * 2048) + lane;
        float hv[4][4];
#pragma unroll
        for (int j = 0; j < 4; ++j) { const float4 gg = ((const float4*)g2)[lane + 64 * j];
            hv[j][0] = v[j].x * rs * gg.x; hv[j][1] = v[j].y * rs * gg.y; hv[j][2] = v[j].z * rs * gg.z; hv[j][3] = v[j].w * rs * gg.w;
            o[64 * j] = pk4_fp8(hv[j][0], hv[j][1], hv[j][2], hv[j][3]); }
        const int rot = (lane >> 2) & 3; f32x4 wa[4], wb[4];
#pragma unroll
        for (int c = 0; c < 4; ++c) wa[c] = wl[(0 * 256 + lane) * 4 + ((c + rot) & 3)];
#pragma unroll
        for (int st = 0; st < 16; st += 2) {
            { const int j = (st + 1) >> 2, t = (st + 1) & 3, slot = t * 256 + lane + 64 * j;
#pragma unroll
              for (int c = 0; c < 4; ++c) wb[c] = wl[slot * 4 + ((c + rot) & 3)]; }
#pragma unroll
            for (int c = 0; c < 4; ++c) lg[c] += hv[st >> 2][st & 3] * wa[c];
            __builtin_amdgcn_sched_barrier(0);
            if (st + 2 < 16) { const int j = (st + 2) >> 2, t = (st + 2) & 3, slot = t * 256 + lane + 64 * j;
#pragma unroll
              for (int c = 0; c < 4; ++c) wa[c] = wl[slot * 4 + ((c + rot) & 3)]; }
#pragma unroll
            for (int c = 0; c < 4; ++c) lg[c] += hv[(st + 1) >> 2][(st + 1) & 3] * wb[c];
            __builtin_amdgcn_sched_barrier(0);
        }
        float r8[8], r4[4], r2[2], r1;
        { const bool up = lane & 32;
#pragma unroll
          for (int i = 0; i < 8; ++i) { const float mine = up ? lg[(i + 8) >> 2][(i + 8) & 3] : lg[i >> 2][i & 3], send = up ? lg[i >> 2][i & 3] : lg[(i + 8) >> 2][(i + 8) & 3]; r8[i] = mine + lane_x32(send); } }
        { const bool up = lane & 16;
#pragma unroll
          for (int i = 0; i < 4; ++i) { const float mine = up ? r8[i + 4] : r8[i], send = up ? r8[i] : r8[i + 4]; r4[i] = mine + lane_x16(send); } }
        { const bool up = lane & 8;
#pragma unroll
          for (int i = 0; i < 2; ++i) { const float mine = up ? r4[i + 2] : r4[i], send = up ? r4[i] : r4[i + 2]; r2[i] = mine + lane_x8(send); } }
        { const bool up = lane & 4; const float mine = up ? r2[1] : r2[0], send = up ? r2[0] : r2[1]; r1 = mine + lane_m8(send); }
        r1 += lane_x2(r1); r1 += lane_x1(r1);
        float mx = r1; mx = fmaxf(mx, lane_m8(mx)); mx = fmaxf(mx, lane_x8(mx)); mx = fmaxf(mx, lane_x16(mx)); mx = fmaxf(mx, lane_x32(mx));
        const float ex = __expf(r1 - mx); float sum = ex; sum += lane_m8(sum); sum += lane_x8(sum); sum += lane_x16(sum); sum += lane_x32(sum);
        const float av = ex / sum; const int e = lane >> 2;
        if ((lane & 3) == 0) { aff[(size_t)row * NE + e] = av; inv[(size_t)row * NE + e] = -1; ((float*)(ws + afft_off(row >> 12, e)))[row & 4095] = av; }
      }
    }
    __syncthreads();
}
DEV void phase_topk(const Args& a, unsigned char* lds, int wg, int G, int tid, int lane, int wave) {
    unsigned char* ws = a.ws; int* idx = (int*)(ws + WS_IDX); int* inv = (int*)(ws + WS_INV);
    LAS unsigned* hist = (LAS unsigned*)(LAS unsigned char*)lds; LAS unsigned* wsum = hist + 256; LAS unsigned* bc = hist + 272;
    for (int it = wg >> 3; it < NE; it += G >> 3) {
        const int e = it, b = wg & 7;
        unsigned u[8];
        { const uint4* src = (const uint4*)((const float*)(ws + afft_off(b, e)) + 8 * tid); const uint4 p = src[0], q = src[1]; u[0] = p.x; u[1] = p.y; u[2] = p.z; u[3] = p.w; u[4] = q.x; u[5] = q.y; u[6] = q.z; u[7] = q.w; }
        unsigned prefix = 0u, kk = CAP;
#pragma unroll
        for (int pass = 0; pass < 4; ++pass) {
            const int shift = 24 - 8 * pass;
            __syncthreads();
            if (tid < 256) hist[tid] = 0u;
            __syncthreads();
#pragma unroll
            for (int j = 0; j < 8; ++j) if (pass == 0 || (u[j] >> (shift + 8)) == prefix) atomicAdd((unsigned*)&hist[(u[j] >> shift) & 255u], 1u);
            __syncthreads();
            if (wave == 0) {
                const unsigned c0 = hist[4 * lane], c1 = hist[4 * lane + 1], c2 = hist[4 * lane + 2], c3 = hist[4 * lane + 3], tot = c0 + c1 + c2 + c3;
                unsigned incl = tot;
#pragma unroll
                for (int o = 1; o < 64; o <<= 1) { const unsigned t = __shfl_down(incl, o); if (lane + o < 64) incl += t; }
                const unsigned excl = incl - tot;
                if (excl < kk && kk <= incl) { unsigned acc = excl; int bin;
                    if (acc + c3 >= kk) bin = 3; else { acc += c3; if (acc + c2 >= kk) bin = 2; else { acc += c2; if (acc + c1 >= kk) bin = 1; else { acc += c1; bin = 0; } } }
                    bc[0] = 4 * lane + bin; bc[1] = kk - acc; }
            }
            __syncthreads();
            prefix = (prefix << 8) | bc[0]; kk = bc[1];
        }
        const unsigned T = prefix, need = kk;
        unsigned cg_ = 0u, ce = 0u;
#pragma unroll
        for (int j = 0; j < 8; ++j) { cg_ += u[j] > T; ce += u[j] == T; }
        unsigned pk = cg_ | (ce << 16), incl = pk;
#pragma unroll
        for (int o = 1; o < 64; o <<= 1) { const unsigned t = __shfl_up(incl, o); if (lane >= o) incl += t; }
        if (lane == 63) wsum[wave] = incl;
        __syncthreads();
        unsigned base = 0u;
#pragma unroll
        for (int w = 0; w < NWAVES; ++w) base += w < wave ? wsum[w] : 0u;
        const unsigned ex = base + incl - pk; unsigned gtb = ex & 0xffffu, eqb = ex >> 16;
#pragma unroll
        for (int j = 0; j < 8; ++j) { const bool g = u[j] > T, q = u[j] == T; const unsigned slot = gtb + (eqb < need ? eqb : need);
            if (g || (q && eqb < need)) { const int s = 8 * tid + j; idx[(e * NB + b) * CAP + slot] = s; inv[((size_t)b * S + s) * NE + e] = (int)slot; }
            gtb += g; eqb += q; }
    }
}
DEV void phase_final(const Args& a, int gw, int NGW, int lane) {
    unsigned char* ws = a.ws; float* xo = a.out; const float* aff = (const float*)(ws + WS_AFF); const int* inv = (const int*)(ws + WS_INV);
    const unsigned char* y = ws + WS_Y; const float* fg = a.in[IN_FG];
    uint2 xw[4], xn[4], xm[4]; int iv = -1, ivn = -1, ivm = -1; float av = 0.f, avn = 0.f, avm = 0.f;
    { const uint2* xr = (const uint2*)(ws + x1_off(gw)) + lane;
#pragma unroll
      for (int j = 0; j < 4; ++j) xw[j] = xr[64 * j];
      if (lane < NE) { iv = inv[(size_t)gw * NE + lane]; av = aff[(size_t)gw * NE + lane]; }
      if (gw + NGW < M) { const uint2* xs = (const uint2*)(ws + x1_off(gw + NGW)) + lane;
#pragma unroll
        for (int j = 0; j < 4; ++j) xn[j] = xs[64 * j];
        if (lane < NE) { ivn = inv[(size_t)(gw + NGW) * NE + lane]; avn = aff[(size_t)(gw + NGW) * NE + lane]; } } }
    for (int row = gw; row < M; row += NGW) {
        const int b = row >> 12;
        if (row + 2 * NGW < M) { const uint2* xr = (const uint2*)(ws + x1_off(row + 2 * NGW)) + lane;
#pragma unroll
            for (int j = 0; j < 4; ++j) xm[j] = xr[64 * j];
            if (lane < NE) { ivm = inv[(size_t)(row + 2 * NGW) * NE + lane]; avm = aff[(size_t)(row + 2 * NGW) * NE + lane]; } }
        float4 v[4];
#pragma unroll
        for (int j = 0; j < 4; ++j) v[j] = make_float4(bf2f(xw[j].x & 0xffffu), bf2f(xw[j].x >> 16), bf2f(xw[j].y & 0xffffu), bf2f(xw[j].y >> 16));
        unsigned long long msk = __ballot(lane < NE && iv >= 0);
        while (msk) {
            unsigned w[4][4]; float gq[4];
#pragma unroll
            for (int q = 0; q < 4; ++q) { const bool on = msk != 0ull; const int e = on ? __builtin_ctzll(msk) : 0; msk = on ? (msk & (msk - 1)) : 0ull;
                const int sl = __builtin_amdgcn_readlane(iv, e); const float g = __builtin_bit_cast(float, __builtin_amdgcn_readlane(__builtin_bit_cast(int, av), e));
                gq[q] = on ? g : 0.f;
                const unsigned* yr = (const unsigned*)(y + ((size_t)e * 4096 + b * CAP + (on ? sl : 0)) * D) + lane;
#pragma unroll
                for (int j = 0; j < 4; ++j) w[q][j] = yr[64 * j]; }
#pragma unroll
            for (int q = 0; q < 4; ++q)
#pragma unroll
                for (int j = 0; j < 4; ++j) { const auto lo = __builtin_amdgcn_cvt_pk_f32_fp8((int)w[q][j], false), hi = __builtin_amdgcn_cvt_pk_f32_fp8((int)w[q][j], true);
                    v[j].x += gq[q] * lo[0]; v[j].y += gq[q] * lo[1]; v[j].z += gq[q] * hi[0]; v[j].w += gq[q] * hi[1]; }
        }
        float s = 0.f;
#pragma unroll
        for (int j = 0; j < 4; ++j) s += v[j].x * v[j].x + v[j].y * v[j].y + v[j].z * v[j].z + v[j].w * v[j].w;
        const float rs = rsqrtf(wave_sum(s) * (1.f / D) + EPS);
        float4* orow = (float4*)(xo + (size_t)row * D) + lane;
#pragma unroll
        for (int j = 0; j < 4; ++j) { const float4 gg = ((const float4*)fg)[lane + 64 * j]; orow[64 * j] = make_float4(v[j].x * rs * gg.x, v[j].y * rs * gg.y, v[j].z * rs * gg.z, v[j].w * rs * gg.w); }
#pragma unroll
        for (int j = 0; j < 4; ++j) { xw[j] = xn[j]; xn[j] = xm[j]; }
        iv = ivn; av = avn; ivn = ivm; avn = avm;
    }
}
typedef short bf16x8 __attribute__((ext_vector_type(8)));
typedef float f32x16 __attribute__((ext_vector_type(16)));
typedef short s16x4 __attribute__((ext_vector_type(4)));
typedef LAS const char* lds_cptr;
typedef unsigned u32x2 __attribute__((ext_vector_type(2)));
constexpr int VROW = 192;
constexpr int VSLOT = 32 * VROW;
constexpr int KROW = 144;
constexpr int KSLOT = 32 * KROW;
constexpr int MIX_WAVE_LDS = 16640;
constexpr int NWM = 6;
constexpr int MIX_BIAS_OFF = NWAVES * MIX_WAVE_LDS;
DEV int crow(int r, int hi) { return (r & 3) + 8 * (r >> 2) + 4 * hi; }
DEV s16x4 vtr(lds_cptr p) { return __builtin_bit_cast(s16x4, __builtin_amdgcn_ds_read_tr16_b64_v4i16((LAS s16x4*)p)); }
DEV bf16x8 tr_frag(lds_cptr slot, int s, int blk, int lane) {
    const int h = lane >> 5; lds_cptr p = slot + (16 * s + 4 * h + ((lane & 15) >> 2)) * VROW + (32 * blk + 16 * ((lane >> 4) & 1) + 4 * (lane & 3)) * 2;
    const s16x4 lo = vtr(p), hi = vtr(p + 8 * VROW);
    return (bf16x8){lo[0], lo[1], lo[2], lo[3], hi[0], hi[1], hi[2], hi[3]};
}
DEV void load_frags(bf16x8 (&f)[4], const bf16_t* rowp, int lane) {
    const int h = lane >> 5;
#pragma unroll
    for (int st = 0; st < 4; ++st) f[st] = *(const bf16x8*)(rowp + 16 * st + 8 * h);
}
DEV bf16x8 pack_p(const f32x16& p, int s) {
    u32x4 w; w.x = pg8::cvt_pk_bf16(p[8 * s], p[8 * s + 1]); w.y = pg8::cvt_pk_bf16(p[8 * s + 2], p[8 * s + 3]); w.z = pg8::cvt_pk_bf16(p[8 * s + 4], p[8 * s + 5]); w.w = pg8::cvt_pk_bf16(p[8 * s + 6], p[8 * s + 7]);
    return __builtin_bit_cast(bf16x8, w);
}

DEV void stage_rows_k(LAS unsigned char* ks, const u32x4 (&raw)[4], int lane) {
    const int rr = lane >> 3, ch = lane & 7;
#pragma unroll
    for (int i = 0; i < 4; ++i) *(LAS u32x4*)(ks + (rr + 8 * i) * KROW + ch * 16) = raw[i];
}
DEV void read_row_frags(bf16x8 (&f)[4], const LAS unsigned char* ks, int lane) {
    const LAS unsigned char* p = ks + (lane & 31) * KROW + (lane >> 5) * 16;
#pragma unroll
    for (int st = 0; st < 4; ++st) f[st] = *(const LAS bf16x8*)(p + st * 32);
}

DEV float other_half(float x) { const auto r = __builtin_amdgcn_permlane32_swap(__float_as_uint(x), __float_as_uint(x), false, false); return (threadIdx.x & 32) ? __uint_as_float(r[0]) : __uint_as_float(r[1]); }
DEV float max_halves(float x) { const auto r = __builtin_amdgcn_permlane32_swap(__float_as_uint(x), __float_as_uint(x), false, false); return fmaxf(__uint_as_float(r[0]), __uint_as_float(r[1])); }
DEV float sum_halves(float x) { const auto r = __builtin_amdgcn_permlane32_swap(__float_as_uint(x), __float_as_uint(x), false, false); return __uint_as_float(r[0]) + __uint_as_float(r[1]); }
#define MFMA32(a, b, c) __builtin_amdgcn_mfma_f32_32x32x16_bf16((a), (b), (c), 0, 0, 0)
DEV float ex2(float x) { return __builtin_amdgcn_exp2f(x); }

struct AttnIt { int p, bh, sh, L, r, q0, kmin, kmax; };
DEV void attn_decode(int li, int x, AttnIt& d) {
    d.p = li >> 9; d.bh = 8 * x + ((li >> 6) & 7); const int qblk = li & 63;
    d.sh = 2 * d.p; d.L = S >> d.sh; const int bpr = d.L >> 6;
    d.r = qblk / bpr; d.q0 = (qblk % bpr) * 64;
    d.kmin = d.q0 >= 64 ? 0 : 2; const int km = (d.L + 63 - d.q0) >> 5; d.kmax = km > 5 ? 5 : km;
}
DEV int med3i(int v, int lo, int hi) { return v < lo ? lo : (v > hi ? hi : v); }
DEV void attn_ldrows(const bf16_t* base, const AttnIt& d, int i0, u32x4 (&v)[4], int lane) {
    const int rr = lane >> 3, ch = lane & 7; const char* hb = (const char*)(base + (size_t)d.bh * S * HD); const unsigned cst = (unsigned)(d.r * 128 + ch * 16);
#pragma unroll
    for (int i = 0; i < 4; ++i) v[i] = *(const u32x4*)(hb + (((unsigned)med3i(i0 + rr + 8 * i, 0, d.L - 1) << (d.sh + 7)) + cst));
}
DEV void attn_ldkv(const Args& a, const AttnIt& d, int kk, u32x4 (&k)[4], u32x4 (&v)[4], int lane) {
    const int rr = lane >> 3, ch = lane & 7, i0 = d.q0 - 64 + 32 * kk; const unsigned cst = (unsigned)(d.r * 128 + ch * 16);
    const char* kb = (const char*)((const bf16_t*)(a.ws + WS_AK) + (size_t)d.bh * S * HD); const char* vb = (const char*)((const bf16_t*)(a.ws + WS_AV) + (size_t)d.bh * S * HD);
#pragma unroll
    for (int i = 0; i < 4; ++i) { const unsigned off = ((unsigned)med3i(i0 + rr + 8 * i, 0, d.L - 1) << (d.sh + 7)) + cst; k[i] = *(const u32x4*)(kb + off); v[i] = *(const u32x4*)(vb + off); }
}
DEV void attn_items(const Args& a, unsigned char* lds, int wg, int G, int lane, int wave) {
    unsigned char* ws = a.ws;
    constexpr int NIT = 3 * 512; constexpr float THR = 6.f;
    const int x = wg & 7, NGW = (G >> 3) * NWM;
    int item = (wg >> 3) * NWM + wave; if (item >= NIT) return;
    LAS unsigned char* slot = (LAS unsigned char*)lds + wave * MIX_WAVE_LDS; lds_cptr slot3 = (lds_cptr)slot; LAS unsigned char* kslot = slot + VSLOT;
    const int t = lane & 31, hi = lane >> 5, rr = lane >> 3, ch = lane & 7;
    AttnIt d; attn_decode(item, x, d);
    bf16x8 qf[2][4], kf[4]; u32x4 kraw[4], vv[4];
    attn_ldkv(a, d, d.kmin, kraw, vv, lane);
    for (;;) {
        const LAS float* tph = (const LAS float*)((LAS unsigned char*)lds + MIX_BIAS_OFF) + (d.p * NH + (d.bh & 7)) * 192 + (32 + 4 * hi - t);
        f32x16 o[2][2] = {}; float m[2] = {0.f, 0.f}, l[2] = {0.f, 0.f};
        const int nitem = item + NGW; const bool hasn = nitem < NIT;
        AttnIt dn = d; if (hasn) attn_decode(nitem, x, dn);
#pragma unroll
        for (int j = 0; j < 2; ++j) { u32x4 qraw[4]; attn_ldrows((const bf16_t*)(ws + WS_AQ), d, d.q0 + 32 * j, qraw, lane); stage_rows_k(kslot, qraw, lane); asm volatile("" ::: "memory"); read_row_frags(qf[j], kslot, lane); asm volatile("" ::: "memory"); }
        for (int kk = d.kmin; kk <= d.kmax; ++kk) {
            const int kbase = d.q0 - 64 + 32 * kk;
#pragma unroll
            for (int i = 0; i < 4; ++i) *(LAS u32x4*)(slot + (rr + 8 * i) * VROW + ch * 16) = vv[i];
            stage_rows_k(kslot, kraw, lane);
            asm volatile("" ::: "memory");
            read_row_frags(kf, kslot, lane);
            const bf16x8 v00 = tr_frag(slot3, 0, 0, lane), v10 = tr_frag(slot3, 1, 0, lane), v01 = tr_frag(slot3, 0, 1, lane), v11 = tr_frag(slot3, 1, 1, lane);
            asm volatile("" ::: "memory");
            if (kk < d.kmax) attn_ldkv(a, d, kk + 1, kraw, vv, lane);
            else if (hasn) attn_ldkv(a, dn, dn.kmin, kraw, vv, lane);
            const bool edge = kbase < 0 || kbase + 31 >= d.L;
            f32x16 sc[2] = {};
#pragma unroll
            for (int st = 0; st < 4; ++st) { sc[0] = MFMA32(kf[st], qf[0][st], sc[0]); sc[1] = MFMA32(kf[st], qf[1][st], sc[1]); }
            float mx[2]; bool mv = false;
#pragma unroll
            for (int j = 0; j < 2; ++j) {
                const int kj = kk - j; const bool act = kj >= 0 && kj <= 4; const LAS float* tb = tph + 32 * (act ? kj : 0); const float moff = act ? m[j] : 1e30f;
#pragma unroll
                for (int rg = 0; rg < 16; ++rg) sc[j][rg] = (sc[j][rg] - moff) + tb[(rg & 3) + 8 * (rg >> 2)];
                if (edge) {
#pragma unroll
                    for (int rg = 0; rg < 16; ++rg) { const int ki = kbase + crow(rg, hi); sc[j][rg] = (ki >= 0 && ki < d.L) ? sc[j][rg] : -1e30f; } }
                float t0 = fmaxf(fmaxf(sc[j][0], sc[j][1]), fmaxf(sc[j][2], sc[j][3]));
#pragma unroll
                for (int rg = 4; rg < 16; rg += 4) t0 = fmaxf(t0, fmaxf(fmaxf(sc[j][rg], sc[j][rg + 1]), fmaxf(sc[j][rg + 2], sc[j][rg + 3])));
                mx[j] = max_halves(t0);
                const bool first = act && (kj == 0 || kk == d.kmin);
                mv = mv || first || (act && __any(mx[j] > THR));
            }
            if (mv) {
#pragma unroll
                for (int j = 0; j < 2; ++j) { const int kj = kk - j; const bool act = kj >= 0 && kj <= 4, first = act && (kj == 0 || kk == d.kmin);
                    const float dl = !act ? 0.f : (first ? mx[j] : fmaxf(mx[j], 0.f)), f = ex2(-dl); m[j] += dl; l[j] *= f;
#pragma unroll
                    for (int rg = 0; rg < 16; ++rg) { sc[j][rg] -= dl; o[j][0][rg] *= f; o[j][1][rg] *= f; } }
            }
#pragma unroll
            for (int j = 0; j < 2; ++j) { float ps0 = 0.f, ps1 = 0.f;
#pragma unroll
                for (int rg = 0; rg < 16; rg += 2) { sc[j][rg] = ex2(sc[j][rg]); sc[j][rg + 1] = ex2(sc[j][rg + 1]); ps0 += sc[j][rg]; ps1 += sc[j][rg + 1]; }
                l[j] += ps0 + ps1; }
            { const bf16x8 p00 = pack_p(sc[0], 0), p01 = pack_p(sc[0], 1), p10 = pack_p(sc[1], 0), p11 = pack_p(sc[1], 1);
              o[0][0] = MFMA32(v00, p00, o[0][0]); o[0][1] = MFMA32(v01, p00, o[0][1]); o[1][0] = MFMA32(v00, p10, o[1][0]); o[1][1] = MFMA32(v01, p10, o[1][1]);
              o[0][0] = MFMA32(v10, p01, o[0][0]); o[0][1] = MFMA32(v11, p01, o[0][1]); o[1][0] = MFMA32(v10, p11, o[1][0]); o[1][1] = MFMA32(v11, p11, o[1][1]); }
        }
#pragma unroll
        for (int j = 0; j < 2; ++j) {
            float lt = sum_halves(l[j]);
            const float il = 1.f / lt;
            const size_t orow = ((size_t)d.p * NB * NH + d.bh) * S + (size_t)(((d.q0 + 32 * j + t) << d.sh) + d.r);
#pragma unroll
            for (int g4 = 0; g4 < 4; ++g4) {
                *(LAS u32x2*)(kslot + t * KROW + (8 * g4 + 4 * hi) * 2) = (u32x2){pg8::cvt_pk_bf16(o[j][0][4 * g4] * il, o[j][0][4 * g4 + 1] * il), pg8::cvt_pk_bf16(o[j][0][4 * g4 + 2] * il, o[j][0][4 * g4 + 3] * il)};
                *(LAS u32x2*)(kslot + t * KROW + (32 + 8 * g4 + 4 * hi) * 2) = (u32x2){pg8::cvt_pk_bf16(o[j][1][4 * g4] * il, o[j][1][4 * g4 + 1] * il), pg8::cvt_pk_bf16(o[j][1][4 * g4 + 2] * il, o[j][1][4 * g4 + 3] * il)};
            }
            asm volatile("" ::: "memory");
            { bf16_t* ob = (bf16_t*)(ws + WS_ATTO) + ((size_t)d.p * NB * NH + d.bh) * S * HD;
#pragma unroll
              for (int i = 0; i < 4; ++i) { const u32x4 w = *(const LAS u32x4*)(kslot + (rr + 8 * i) * KROW + ch * 16);
                  *(u32x4*)(ob + (size_t)(((d.q0 + 32 * j + rr + 8 * i) << d.sh) + d.r) * HD + ch * 8) = w; } }
            asm volatile("" ::: "memory");
            if (hi == 0) ((float*)(ws + (d.p == 0 ? WS_ATTL0 : (d.p == 1 ? WS_ATTL1 : WS_ATTL2))))[(size_t)d.bh * S + (size_t)(((d.q0 + 32 * j + t) << d.sh) + d.r)] = m[j] + __log2f(lt);
        }
        if (!hasn) break;
        item = nitem; d = dn;
    }
}
DEV void retstate_item(const Args& a, unsigned char* lds, int item, int xg, int lane, int wave) {
    unsigned char* ws = a.ws;
    const int dir = item & 1, n = (item >> 1) & 31, bh = 8 * xg + (item >> 6), h = bh & 7;
    const bf16_t* Kc = (const bf16_t*)(ws + WS_RK) + ((size_t)bh * S + n * 128) * HD; const bf16_t* Vc = (const bf16_t*)(ws + WS_RV) + ((size_t)bh * S + n * 128) * HD;
    const float lg = a.in[IN_DECAY][dir * NH + h] * LOG2E;
    LAS unsigned char* vs = (LAS unsigned char*)lds + wave * MIX_WAVE_LDS; LAS unsigned char* ks = vs + VSLOT; lds_cptr vs3 = (lds_cptr)vs, ks3 = (lds_cptr)ks;
    f32x16 acc[2][2] = {};
    for (int blk = 0; blk < 4; ++blk) {
        { const int rr = lane >> 3, ch = lane & 7;
          u32x4 v[4], k[4];
#pragma unroll
          for (int i = 0; i < 4; ++i) { const int mrow = 32 * blk + rr + 8 * i; v[i] = *(const u32x4*)(Vc + (size_t)mrow * HD + ch * 8); k[i] = *(const u32x4*)(Kc + (size_t)mrow * HD + ch * 8); }
#pragma unroll
          for (int i = 0; i < 4; ++i) { const int mrow = 32 * blk + rr + 8 * i; const float z = ex2(lg * (float)(dir == 0 ? 127 - mrow : mrow));
              const unsigned kw[4] = {k[i].x, k[i].y, k[i].z, k[i].w}; u32x4 o;
              o.x = pg8::cvt_pk_bf16(bf2f(kw[0] & 0xffffu) * z, bf2f(kw[0] >> 16) * z); o.y = pg8::cvt_pk_bf16(bf2f(kw[1] & 0xffffu) * z, bf2f(kw[1] >> 16) * z);
              o.z = pg8::cvt_pk_bf16(bf2f(kw[2] & 0xffffu) * z, bf2f(kw[2] >> 16) * z); o.w = pg8::cvt_pk_bf16(bf2f(kw[3] & 0xffffu) * z, bf2f(kw[3] >> 16) * z);
              *(LAS u32x4*)(vs + (rr + 8 * i) * VROW + ch * 16) = v[i]; *(LAS u32x4*)(ks + (rr + 8 * i) * VROW + ch * 16) = o; } }
        LDS_WAIT();
#pragma unroll
        for (int s = 0; s < 2; ++s) {
            const bf16x8 v0 = tr_frag(vs3, s, 0, lane), v1 = tr_frag(vs3, s, 1, lane), k0 = tr_frag(ks3, s, 0, lane), k1 = tr_frag(ks3, s, 1, lane);
            acc[0][0] = MFMA32(v0, k0, acc[0][0]); acc[0][1] = MFMA32(v0, k1, acc[0][1]); acc[1][0] = MFMA32(v1, k0, acc[1][0]); acc[1][1] = MFMA32(v1, k1, acc[1][1]);
        }
        LDS_WAIT();
    }
    bf16_t* KT = (bf16_t*)(ws + WS_KF) + (((size_t)dir * NB * NH + bh) * 32 + n) * 4096;
    const int c = lane & 31, hi = lane >> 5;
#pragma unroll
    for (int eb = 0; eb < 2; ++eb)
#pragma unroll
        for (int db = 0; db < 2; ++db)
#pragma unroll
            for (int rg = 0; rg < 16; ++rg) KT[(32 * eb + crow(rg, hi)) * 64 + 32 * db + c] = (bf16_t)f2bf(acc[eb][db][rg]);
}
DEV void phase_scan(const Args& a, int xg, int gtid, int NT) {
    unsigned char* ws = a.ws;
    for (int sl = gtid; sl < 2 * NH * 1024; sl += NT) {
        const int dir = sl >> 13, bh = 8 * xg + ((sl >> 10) & 7), q = sl & 1023, h = bh & 7;
        const float gC = ex2(a.in[IN_DECAY][dir * NH + h] * LOG2E * 128.f);
        const uint2* kt = (const uint2*)(ws + WS_KF) + ((size_t)dir * NB * NH + bh) * 32 * 1024 + q;
        uint2* st = (uint2*)(ws + st_off(dir, bh, 0)) + q;
        float4 s = make_float4(0.f, 0.f, 0.f, 0.f);
        for (int i = 0; i < 32; ++i) { const int n = dir == 0 ? i : 31 - i;
            st[(size_t)n * 1024] = make_uint2(pg8::cvt_pk_bf16(s.x, s.y), pg8::cvt_pk_bf16(s.z, s.w));
            const uint2 kv = kt[(size_t)n * 1024];
            s.x = gC * s.x + bf2f(kv.x & 0xffffu); s.y = gC * s.y + bf2f(kv.x >> 16); s.z = gC * s.z + bf2f(kv.y & 0xffffu); s.w = gC * s.w + bf2f(kv.y >> 16); }
    }
}
DEV void ld_rows32(const bf16_t* base, u32x4 (&v)[4], int lane) {
    const char* b = (const char*)base; const unsigned off = (unsigned)((lane >> 3) * 128 + (lane & 7) * 16);
#pragma unroll
    for (int i = 0; i < 4; ++i) v[i] = *(const u32x4*)(b + off + i * 1024);
}
DEV void retout_item(const Args& a, unsigned char* lds, int item, int xg, int lane, int wave) {
    unsigned char* ws = a.ws;
    const int hq = item & 1, n = (item >> 1) & 31, bh = 8 * xg + (item >> 6), h = bh & 7, b = bh >> 3;
    const bf16_t* Qc = (const bf16_t*)(ws + WS_RQ) + ((size_t)bh * S + n * 128) * HD; const bf16_t* Kc = (const bf16_t*)(ws + WS_RK) + ((size_t)bh * S + n * 128) * HD;
    const bf16_t* Vc = (const bf16_t*)(ws + WS_RV) + ((size_t)bh * S + n * 128) * HD; const bf16_t* Gc = (const bf16_t*)(ws + WS_RG) + ((size_t)bh * S + n * 128) * HD;
    const bf16_t* SF = (const bf16_t*)(ws + st_off(0, bh, n)); const bf16_t* SB = (const bf16_t*)(ws + st_off(1, bh, n));
    const float lg0 = a.in[IN_DECAY][h] * LOG2E, lg1 = a.in[IN_DECAY][NH + h] * LOG2E;
    LAS unsigned char* slot = (LAS unsigned char*)lds + wave * MIX_WAVE_LDS; lds_cptr slot3 = (lds_cptr)slot; LAS unsigned char* kslot = slot + VSLOT;
    const int t = lane & 31, hi = lane >> 5, rr = lane >> 3, ch = lane & 7;
    bf16x8 qf[2][4];
#pragma unroll
    for (int j = 0; j < 2; ++j) { u32x4 raw[4]; ld_rows32(Qc + (size_t)(64 * hq + 32 * j) * HD, raw, lane); stage_rows_k(kslot, raw, lane); asm volatile("" ::: "memory"); read_row_frags(qf[j], kslot, lane); asm volatile("" ::: "memory"); }
    f32x16 o[2][2] = {};
#pragma unroll
    for (int dir = 0; dir < 2; ++dir) {
#pragma unroll
        for (int eb = 0; eb < 2; ++eb) { u32x4 raw[4]; bf16x8 sf[4]; ld_rows32((dir == 0 ? SF : SB) + (size_t)(32 * eb) * 64, raw, lane); stage_rows_k(kslot, raw, lane); asm volatile("" ::: "memory"); read_row_frags(sf, kslot, lane); asm volatile("" ::: "memory");
#pragma unroll
            for (int j = 0; j < 2; ++j)
#pragma unroll
                for (int st = 0; st < 4; ++st) o[j][eb] = MFMA32(sf[st], qf[j][st], o[j][eb]); }
#pragma unroll
        for (int j = 0; j < 2; ++j) { const int c = 64 * hq + 32 * j + t; const float f = dir == 0 ? ex2(lg0 * (float)(c + 1) - lg1 * (float)(128 - c)) : ex2(lg1 * (float)(128 - c));
#pragma unroll
            for (int rg = 0; rg < 16; ++rg) { o[j][0][rg] *= f; o[j][1][rg] *= f; } }
    }
    float f1[4], f2[4], b1[4], b2[4];
#pragma unroll
    for (int i = 0; i < 4; ++i) { f1[i] = __builtin_bit_cast(float, __builtin_amdgcn_readfirstlane(__builtin_bit_cast(int, ex2(-lg0 * (float)i)))); f2[i] = __builtin_bit_cast(float, __builtin_amdgcn_readfirstlane(__builtin_bit_cast(int, ex2(-lg0 * (float)(8 * i)))));
        b1[i] = __builtin_bit_cast(float, __builtin_amdgcn_readfirstlane(__builtin_bit_cast(int, ex2(lg1 * (float)i)))); b2[i] = __builtin_bit_cast(float, __builtin_amdgcn_readfirstlane(__builtin_bit_cast(int, ex2(lg1 * (float)(8 * i))))); }
#pragma nounroll
    for (int kb = 0; kb < 4; ++kb) {
        { u32x4 kraw[4], vv[4]; ld_rows32(Kc + (size_t)(32 * kb) * HD, kraw, lane); ld_rows32(Vc + (size_t)(32 * kb) * HD, vv, lane);
#pragma unroll
        for (int i = 0; i < 4; ++i) *(LAS u32x4*)(slot + (rr + 8 * i) * VROW + ch * 16) = vv[i];
        stage_rows_k(kslot, kraw, lane); }
        asm volatile("" ::: "memory");
        bf16x8 kf[4]; read_row_frags(kf, kslot, lane);
        const bf16x8 v00 = tr_frag(slot3, 0, 0, lane), v10 = tr_frag(slot3, 1, 0, lane), v01 = tr_frag(slot3, 0, 1, lane), v11 = tr_frag(slot3, 1, 1, lane);
        asm volatile("" ::: "memory");
#pragma unroll
        for (int j = 0; j < 2; ++j) {
            const int qbi = 2 * hq + j;
            f32x16 sc = {};
#pragma unroll
            for (int st = 0; st < 4; ++st) sc = MFMA32(kf[st], qf[j][st], sc);
            if (kb < qbi) { const float A = ex2(lg0 * (float)(32 * (qbi - kb) + t - 4 * hi)); float a2[4];
#pragma unroll
                for (int q = 0; q < 4; ++q) a2[q] = A * f2[q];
#pragma unroll
                for (int rg = 0; rg < 16; ++rg) sc[rg] *= a2[rg >> 2] * f1[rg & 3];
            } else if (kb > qbi) { const float A = ex2(lg1 * (float)(32 * (kb - qbi) - t + 4 * hi)); float a2[4];
#pragma unroll
                for (int q = 0; q < 4; ++q) a2[q] = A * b2[q];
#pragma unroll
                for (int rg = 0; rg < 16; ++rg) sc[rg] *= a2[rg >> 2] * b1[rg & 3];
            } else {
                int tt = t - 4 * hi; asm volatile("" : "+v"(tt));
#pragma unroll
                for (int rg = 0; rg < 16; ++rg) { const int df = tt - ((rg & 3) + 8 * (rg >> 2)); sc[rg] *= df >= 0 ? ex2(lg0 * (float)df) : ex2(lg1 * (float)(-df)); }
            }
            const bf16x8 p0 = pack_p(sc, 0), p1 = pack_p(sc, 1);
            o[j][0] = MFMA32(v00, p0, o[j][0]); o[j][0] = MFMA32(v10, p1, o[j][0]);
            o[j][1] = MFMA32(v01, p0, o[j][1]); o[j][1] = MFMA32(v11, p1, o[j][1]);
        }
    }
    const float* gn = a.in[IN_GN] + h * HD; const unsigned gnoff = (unsigned)(16 * hi); LAS unsigned char* kq = kslot + t * KROW + 8 * hi;
#pragma unroll
    for (int j = 0; j < 2; ++j) {
        const int r0 = n * 128 + 64 * hq + 32 * j;
        { u32x4 raw[4]; ld_rows32(Gc + (size_t)(64 * hq + 32 * j) * HD, raw, lane); stage_rows_k(kslot, raw, lane); asm volatile("" ::: "memory"); }
        float sm = 0.f;
#pragma unroll
        for (int rg = 0; rg < 16; ++rg) sm += o[j][0][rg] + o[j][1][rg];
        sm = sum_halves(sm); const float mu = sm * (1.f / 64.f); float vq = 0.f;
#pragma unroll
        for (int rg = 0; rg < 16; ++rg) { const float d0 = o[j][0][rg] - mu, d1 = o[j][1][rg] - mu; vq += d0 * d0 + d1 * d1; }
        vq = sum_halves(vq); const float rstd = rsqrtf(vq * (1.f / 64.f) + EPS);
        u32x2 ow[2][4];
#pragma unroll
        for (int db = 0; db < 2; ++db)
#pragma unroll
            for (int g4 = 0; g4 < 4; ++g4) { const u32x2 gw = *(const LAS u32x2*)(kq + (32 * db + 8 * g4) * 2); const float4 gg = *(const float4*)((const char*)gn + gnoff + (32 * db + 8 * g4) * 4);
                const float gate[4] = {bf2f(gw[0] & 0xffffu), bf2f(gw[0] >> 16), bf2f(gw[1] & 0xffffu), bf2f(gw[1] >> 16)}; const float gv[4] = {gg.x, gg.y, gg.z, gg.w}; float ov[4];
#pragma unroll
                for (int i = 0; i < 4; ++i) ov[i] = (o[j][db][4 * g4 + i] - mu) * rstd * gv[i] * (gate[i] * __builtin_amdgcn_rcpf(1.f + ex2(-gate[i] * LOG2E)));
                ow[db][g4] = (u32x2){pg8::cvt_pk_bf16(ov[0], ov[1]), pg8::cvt_pk_bf16(ov[2], ov[3])}; }
        asm volatile("" ::: "memory");
#pragma unroll
        for (int db = 0; db < 2; ++db)
#pragma unroll
            for (int g4 = 0; g4 < 4; ++g4) *(LAS u32x2*)(kq + (32 * db + 8 * g4) * 2) = ow[db][g4];
        asm volatile("" ::: "memory");
        { bf16_t* ob = (bf16_t*)(ws + WS_XN) + ((size_t)b * S + r0) * D + h * HD;
#pragma unroll
          for (int i = 0; i < 4; ++i) { const u32x4 w = *(const LAS u32x4*)(kslot + (rr + 8 * i) * KROW + ch * 16); *(u32x4*)(ob + (size_t)(rr + 8 * i) * D + ch * 8) = w; } }
        asm volatile("" ::: "memory");
    }
}
DEV void phase_attn_merge(const Args& a, int xg, int gtid, int NT) {
    unsigned char* ws = a.ws; const bf16_t* O = (const bf16_t*)(ws + WS_ATTO); bf16_t* mixed = (bf16_t*)(ws + WS_XN);
    for (int it = gtid; it < NH * S * 8; it += NT) {
        const int ch = it & 7, row = xg * NH * S + (it >> 3);
        const int bh = row >> 12, pos = row & 4095, b = bh >> 3, h = bh & 7;
        const float l0 = ((const float*)(ws + WS_ATTL0))[row], l1 = ((const float*)(ws + WS_ATTL1))[row], l2 = ((const float*)(ws + WS_ATTL2))[row];
        const float mx = fmaxf(l0, fmaxf(l1, l2)); float w0 = ex2(l0 - mx), w1 = ex2(l1 - mx), w2 = ex2(l2 - mx); const float is = 1.f / (w0 + w1 + w2); w0 *= is; w1 *= is; w2 *= is;
        const uint4 a0 = *(const uint4*)(O + (size_t)row * HD + ch * 8), a1 = *(const uint4*)(O + ((size_t)NB * NH * S + row) * HD + ch * 8), a2 = *(const uint4*)(O + ((size_t)2 * NB * NH * S + row) * HD + ch * 8);
        const unsigned x0[4] = {a0.x, a0.y, a0.z, a0.w}, x1[4] = {a1.x, a1.y, a1.z, a1.w}, x2[4] = {a2.x, a2.y, a2.z, a2.w}; unsigned o[4];
#pragma unroll
        for (int j = 0; j < 4; ++j) o[j] = pg8::cvt_pk_bf16(w0 * bf2f(x0[j] & 0xffffu) + w1 * bf2f(x1[j] & 0xffffu) + w2 * bf2f(x2[j] & 0xffffu), w0 * bf2f(x0[j] >> 16) + w1 * bf2f(x1[j] >> 16) + w2 * bf2f(x2[j] >> 16));
        *(uint4*)(mixed + ((size_t)b * S + pos) * D + 512 + h * HD + ch * 8) = make_uint4(o[0], o[1], o[2], o[3]);
    }
}
DEV void phase_mix_a(const Args& a, unsigned char* lds, int wg, int G, int lane, int wave, int tid) {
    { const float* bt = (const float*)(a.ws + WS_BIAS); LAS float* bl = (LAS float*)((LAS unsigned char*)lds + MIX_BIAS_OFF);
      for (int i = tid; i < 3 * NH * 192; i += NTHR) { const int ph = i / 192, bi = i % 192 - 32; bl[i] = (bi >= 0 && bi <= 128) ? bt[ph * 129 + bi] : -1e30f; } }
    __syncthreads();
    if (wave >= NWM) {
        for (int rep = 0; rep < a.rep[5]; ++rep) { asm volatile("" : "+v"(lane)); phase_latew(a, lds, wg * (NWAVES - NWM) + (wave - NWM), G * (NWAVES - NWM), lane, wave); }
        return;
    }
    const int x = wg & 7, wq = (wg >> 3) * NWM + wave, WPX = (G >> 3) * NWM;
    for (int rep = 0; rep < a.rep[0]; ++rep) { asm volatile("" : "+v"(lane)); for (int it = wq; it < 2 * 32 * NH; it += WPX) retstate_item(a, lds, it, x, lane, wave); }
    for (int rep = 0; rep < a.rep[1]; ++rep) { asm volatile("" : "+v"(lane)); attn_items(a, lds, wg, G, lane, wave); }
}
DEV void phase_mix_b(const Args& a, unsigned char* lds, int wg, int G, int lane, int wave, int tid) {
    const int x = wg & 7, wq = (wg >> 3) * NWAVES + wave, WPX = (G >> 3) * NWAVES;
    for (int rep = 0; rep < a.rep[2]; ++rep) { asm volatile("" : "+v"(lane)); for (int it = wq; it < NH * 32 * 2; it += WPX) retout_item(a, lds, it, x, lane, wave); }
    for (int rep = 0; rep < a.rep[3]; ++rep) { asm volatile("" : "+v"(tid)); phase_attn_merge(a, x, (wg >> 3) * NTHR + tid, (G >> 3) * NTHR); }
}
#define XB_TMO      128
#define XB_XCNT(j)  (256  + 64 * (j))
#define XB_XSUB(j)  (1280 + 64 * (j))
#define XB_XGEN(j)  (2304 + 64 * (j))
#define XB_TOP      3328
#define XB_TOPGEN   3392
#define XCD_BAR_WORDS 3456
#define XB_SPIN_CAP (1u << 18)

__device__ __forceinline__ unsigned xb_ld(unsigned* p)              { return __hip_atomic_load(p, __ATOMIC_RELAXED, __HIP_MEMORY_SCOPE_AGENT); }
__device__ __forceinline__ unsigned xb_add(unsigned* p, unsigned v) { return __hip_atomic_fetch_add(p, v, __ATOMIC_RELAXED, __HIP_MEMORY_SCOPE_AGENT); }
__device__ __forceinline__ unsigned xb_xcc_id() { return (unsigned)__builtin_amdgcn_s_getreg((3 << 11) | 20) & 0xFu; }
#define XB_SPIN(cond, bar) do { unsigned _sp = 0; while (cond) { __builtin_amdgcn_s_sleep(1); \
    if ((++_sp & 255u) == 0u) { if (xb_ld(&(bar)[XB_TMO])) break; if (_sp > XB_SPIN_CAP) { atomicAdd(&(bar)[XB_TMO], 1u); break; } } } } while (0)

struct XcdBarrier {
    unsigned* bar; unsigned x;
    volatile LAS unsigned* st;
};

__device__ __forceinline__ XcdBarrier xcd_barrier_post(unsigned* bar, volatile LAS unsigned* st) {
    XcdBarrier b; b.bar = bar; b.x = xb_xcc_id(); b.st = st;
    if (threadIdx.x == 0) (void)xb_add(&bar[XB_XCNT(b.x)], 1u);
    return b;
}
__device__ __forceinline__ void xcd_barrier_complete(unsigned* bar, unsigned x, unsigned& nloc, unsigned& nx) {
    const unsigned G = gridDim.x * gridDim.y * gridDim.z;
    unsigned sum, cnt, mine, sp = 0u;
    for (;;) {
        sum = 0u; cnt = 0u; mine = 0u;
#pragma unroll
        for (unsigned j = 0; j < 16; ++j) { const unsigned c = xb_ld(&bar[XB_XCNT(j)]); sum += c; cnt += (c > 0u) ? 1u : 0u; mine = (j == x) ? c : mine; }
        if (sum == G) break;
        __builtin_amdgcn_s_sleep(1);
        if ((++sp & 255u) == 0u) { if (xb_ld(&bar[XB_TMO])) break; if (sp > XB_SPIN_CAP) { atomicAdd(&bar[XB_TMO], 1u); break; } }
    }
    nloc = mine > 0u ? mine : 1u; nx = cnt > 0u ? cnt : 1u;
}

__device__ __forceinline__ void xcd_barrier(const XcdBarrier& b) {
    asm volatile("s_waitcnt vmcnt(0)" ::: "memory");
    __syncthreads();
    if (threadIdx.x == 0) {
        unsigned* bar = b.bar;
        __builtin_amdgcn_s_waitcnt(0);
        unsigned nloc = b.st[0], nx = b.st[1];
        if (nloc == 0u) { xcd_barrier_complete(bar, b.x, nloc, nx); b.st[0] = nloc; b.st[1] = nx; }
        const unsigned old = xb_add(&bar[XB_XSUB(b.x)], 1u);
        const unsigned gen = old / nloc;
        if (old + 1u == (gen + 1u) * nloc) {
            __builtin_amdgcn_fence(__ATOMIC_RELEASE, "agent");
            asm volatile("s_waitcnt vmcnt(0)" ::: "memory");
            const unsigned og = xb_add(&bar[XB_TOP], 1u);
            const unsigned tg = og / nx;
            if (og + 1u == (tg + 1u) * nx) xb_add(&bar[XB_TOPGEN], 1u);
            else XB_SPIN(xb_ld(&bar[XB_TOPGEN]) == tg, bar);
            __builtin_amdgcn_fence(__ATOMIC_ACQUIRE, "agent");
            xb_add(&bar[XB_XGEN(b.x)], 1u);
            asm volatile("s_waitcnt vmcnt(0)" ::: "memory");
        } else {
            XB_SPIN(xb_ld(&bar[XB_XGEN(b.x)]) == gen, bar);
            __builtin_amdgcn_fence(__ATOMIC_ACQUIRE, "agent");
            asm volatile("s_waitcnt vmcnt(0)" ::: "memory");
        }
    }
    __syncthreads();
}


__device__ __forceinline__ void group_barrier(unsigned* cnt, unsigned target) {
    asm volatile("s_waitcnt vmcnt(0)" ::: "memory");
    __syncthreads();
    if (threadIdx.x == 0) {
        __builtin_amdgcn_fence(__ATOMIC_RELEASE, "agent");
        asm volatile("s_waitcnt vmcnt(0)" ::: "memory");
        (void)xb_add(cnt, 1u);
        unsigned sp = 0u;
        while (xb_ld(cnt) < target) { __builtin_amdgcn_s_sleep(1); if (++sp > (1u << 22)) break; }
        __builtin_amdgcn_fence(__ATOMIC_ACQUIRE, "agent");
        asm volatile("s_waitcnt vmcnt(0)" ::: "memory");
    }
    __syncthreads();
}
#ifndef MK_LAUNCHES
#define MK_LAUNCHES 1
#endif
#ifndef WGM_MOE1
#define WGM_MOE1 8
#endif
#ifndef WGM_MOE2
#define WGM_MOE2 8
#endif
constexpr int NPH = 11;
typedef const __attribute__((address_space(4))) Args* kargs_t;
DEV Args load_args(kargs_t kp) { Args a;
#pragma unroll
    for (int i = 0; i < 13; ++i) a.in[i] = kp->in[i];
    a.out = kp->out; a.ws = kp->ws; a.ph_lo = kp->ph_lo; a.ph_hi = kp->ph_hi;
#pragma unroll
    for (int i = 0; i < 16; ++i) a.rep[i] = kp->rep[i];
    return a; }
__global__ void __launch_bounds__(NTHR, 2) mega(Args a_) {
    kargs_t kp = (kargs_t)__builtin_amdgcn_kernarg_segment_ptr();
    extern __shared__ __attribute__((aligned(16))) unsigned char lds[];
    int tid = threadIdx.x, lane = tid & 63, wave = __builtin_amdgcn_readfirstlane(tid >> 6);
    const int G = gridDim.x, wg = blockIdx.x, NGW = G * NWAVES; int gw = wg * NWAVES + wave;
#define FRESH_IDS() do { tid = threadIdx.x; asm volatile("" : "+v"(tid)); lane = tid & 63; wave = __builtin_amdgcn_readfirstlane(tid >> 6); gw = wg * NWAVES + wave; } while (0)
    const int lo = kp->ph_lo, hi = kp->ph_hi;
    unsigned char* ws = kp->ws;
    volatile LAS unsigned* bst = (volatile LAS unsigned*)((LAS unsigned char*)lds + LDS_BYTES - 64);
    if (tid < 2) bst[tid] = 0u;
    __syncthreads();
    XcdBarrier bar = xcd_barrier_post((unsigned*)(ws + WS_CTL) + 4096, bst);
#define IN(k) (lo <= (k) && (k) < hi)
#define SEAM(k) do { if (IN(k) && IN((k) + 1)) { if ((k) >= 1 && (k) <= 6) group_barrier((unsigned*)(kp->ws + WS_CTL) + 7616 + 64 * (wg & 7), (unsigned)(k) * (unsigned)(G >> 3)); else xcd_barrier(bar); } } while (0)
    if (IN(0)) { FRESH_IDS(); const Args a = load_args(kp); unsigned char* ws = a.ws; for (int r = 0; r < a.rep[6]; ++r) { FRESH_IDS(); phase_prep(a, lds, gw, NGW, lane, wave); } }
    SEAM(0);
    if (IN(1)) { FRESH_IDS(); const Args a = load_args(kp); unsigned char* ws = a.ws; pg8::Gemm g{(const bf16_t*)(ws + WS_XN), (const bf16_t*)(ws + WS_WIN), D}; SchedPlain Sc; Sc.init(M, PC, G, wg); Sc.rowbytes = D * 2;
        EpiInProj E{ws, (const float*)(ws + WS_ROPE)};
        for (int r = 0; r < a.rep[8]; ++r) { FRESH_IDS(); pg8::Gemm g2 = g; asm volatile("" : "+s"(g2.A), "+s"(g2.Bt)); pg8::gemm_phase<EpiInProj, SchedPlain, true>((LAS unsigned char*)lds, g2, Sc, E); } }
    SEAM(1);
    if (IN(2)) { FRESH_IDS(); const Args a = load_args(kp); unsigned char* ws = a.ws; phase_mix_a(a, lds, wg, G, lane, wave, tid); }
    SEAM(2);
    if (IN(3)) { FRESH_IDS(); const Args a = load_args(kp); unsigned char* ws = a.ws; for (int r = 0; r < a.rep[13]; ++r) { FRESH_IDS(); phase_scan(a, wg & 7, (wg >> 3) * NTHR + tid, (G >> 3) * NTHR); } }
    SEAM(3);
    if (IN(4)) { FRESH_IDS(); const Args a = load_args(kp); unsigned char* ws = a.ws; phase_mix_b(a, lds, wg, G, lane, wave, tid); }
    SEAM(4);
    { const Args a = load_args(kp); for (int r = 0; r < a.rep[14]; ++r) xcd_barrier(bar); for (int r = 0; r < a.rep[15]; ++r) cg::this_grid().sync(); }
    if (IN(5)) { FRESH_IDS(); const Args a = load_args(kp); unsigned char* ws = a.ws; pg8::Gemm g{(const bf16_t*)(ws + WS_XN), (const bf16_t*)(ws + WS_WOUT), D}; SchedPlain Sc; Sc.init(M, D, G, wg); Sc.rowbytes = D * 2;
        EpiOutProj E{a.in[IN_X], ws};
        for (int r = 0; r < a.rep[9]; ++r) { FRESH_IDS(); pg8::Gemm g2 = g; asm volatile("" : "+s"(g2.A), "+s"(g2.Bt)); pg8::gemm_phase<EpiOutProj, SchedPlain, true>((LAS unsigned char*)lds, g2, Sc, E); } }
    SEAM(5);
    if (IN(6)) { FRESH_IDS(); const Args a = load_args(kp); unsigned char* ws = a.ws; for (int r = 0; r < a.rep[4]; ++r) { FRESH_IDS(); phase_router(a, lds, wg & 7, (wg >> 3) * NWAVES + wave, (G >> 3) * NWAVES, lane, tid); } }
    SEAM(6);
    if (IN(7)) { FRESH_IDS(); const Args a = load_args(kp); unsigned char* ws = a.ws; for (int r = 0; r < a.rep[7]; ++r) { FRESH_IDS(); phase_topk(a, lds, wg, G, tid, lane, wave); } }
    SEAM(7);
    if (IN(8)) { FRESH_IDS(); const Args a = load_args(kp); unsigned char* ws = a.ws; pg8::Gemm g{(const bf16_t*)(ws + WS_XN), (const bf16_t*)(ws + WS_WGU), D}; SchedMoe1 Sc; Sc.init(MR, 4096, G, wg, WGM_MOE1); Sc.idxl = (const LAS int*)((LAS unsigned char*)lds + 131072);
        { const int* idxg = (const int*)(ws + WS_IDX); LAS int* il = (LAS int*)((LAS unsigned char*)lds + 131072); pg8::Unit uu;
          for (int i = 0; i < 16; ++i) if (Sc.next(i, uu) && tid < 256) il[i * 256 + tid] = idxg[uu.pm * 256 + tid];
          __syncthreads(); }
        EpiSwiGLU E{ws + WS_HID};
        for (int r = 0; r < a.rep[10]; ++r) { FRESH_IDS(); pg8::Gemm g2 = g; asm volatile("" : "+s"(g2.A), "+s"(g2.Bt)); pg8::gemm_phase<EpiSwiGLU, SchedMoe1, true, true>((LAS unsigned char*)lds, g2, Sc, E); } }
    SEAM(8);
    if (IN(9)) { FRESH_IDS(); const Args a = load_args(kp); unsigned char* ws = a.ws; pg8::Gemm g{(const bf16_t*)(ws + WS_HID), (const bf16_t*)(ws + WS_WD), DFF}; SchedMoe2 Sc; Sc.init(MR, D, G, wg, WGM_MOE2);
        EpiDown E{ws + WS_Y};
        for (int r = 0; r < a.rep[11]; ++r) { FRESH_IDS(); pg8::Gemm g2 = g; asm volatile("" : "+s"(g2.A), "+s"(g2.Bt)); pg8::gemm_phase<EpiDown, SchedMoe2, true, true>((LAS unsigned char*)lds, g2, Sc, E); } }
    SEAM(9);
    if (IN(10)) { FRESH_IDS(); const Args a = load_args(kp); unsigned char* ws = a.ws; for (int r = 0; r < a.rep[12]; ++r) { FRESH_IDS(); phase_final(a, gw, NGW, lane); } }
#undef IN
#undef SEAM
}

extern "C" void kernel_launch(void* const* d_in, const int* in_sizes, int n_in, void* d_out, int out_size, void* d_ws, size_t ws_size, hipStream_t stream) {
    static int grid = 0;
    if (grid == 0) {
        if (n_in != 13 || in_sizes[0] != M * D || out_size != M * D || ws_size < WS_END) { fprintf(stderr, "kernel_launch: unexpected shapes n_in %d in0 %d out %d ws %zu (need %zu)\n", n_in, n_in > 0 ? in_sizes[0] : -1, out_size, ws_size, (size_t)WS_END); grid = -1; return; }
        int dev = 0, cus = 0, per_cu = 0;
        (void)hipGetDevice(&dev); (void)hipDeviceGetAttribute(&cus, hipDeviceAttributeMultiprocessorCount, dev);
        (void)hipFuncSetAttribute((const void*)mega, hipFuncAttributeMaxDynamicSharedMemorySize, LDS_BYTES);
        if (hipOccupancyMaxActiveBlocksPerMultiprocessor(&per_cu, (const void*)mega, NTHR, LDS_BYTES) != hipSuccess || per_cu < 1) { fprintf(stderr, "kernel_launch: occupancy query says %d blocks/CU\n", per_cu); per_cu = 1; }
        (void)hipGetLastError();
        grid = cus * 1;
        if (grid > cus * per_cu) grid = cus * per_cu;
    }
    if (grid < 0) return;
    (void)hipMemsetAsync((char*)d_ws + WS_CTL + 16384, 0, 16384, stream);
    Args a{};
    for (int i = 0; i < 13; ++i) a.in[i] = (const float*)d_in[i];
    a.out = (float*)d_out; a.ws = (unsigned char*)d_ws;
#ifndef PROBE_R
#define PROBE_R {1, 1, 1, 1, 1, 1, 1, 1, 1, 1, 1, 1, 1, 1, 0, 0}
#endif
    { const int rr[16] = PROBE_R; for (int i = 0; i < 16; ++i) a.rep[i] = rr[i]; }
#if MK_LAUNCHES == 1
    a.ph_lo = 0; a.ph_hi = NPH;
    void* args[] = {&a};
    hipError_t e = hipLaunchCooperativeKernel((const void*)mega, dim3(grid), dim3(NTHR), args, LDS_BYTES, stream);
    if (e != hipSuccess) fprintf(stderr, "cooperative launch failed: %s (grid %d)\n", hipGetErrorString(e), grid);
#else
    for (int p = 0; p < NPH; ++p) { a.ph_lo = p; a.ph_hi = p + 1; hipLaunchKernelGGL(mega, dim3(grid), dim3(NTHR), LDS_BYTES, stream, a); }
#endif
}
```

```cpp
#include <hip/hip_runtime.h>
#include <hip/hip_cooperative_groups.h>
#include <cstdint>
#include <cstdio>
namespace cg = cooperative_groups;

typedef unsigned short bf16_t;
#define DEV __device__ __forceinline__
#define LAS __attribute__((address_space(3)))

constexpr int NB = 8, S = 4096, D = 1024, M = NB * S;
constexpr int NH = 8, HD = 64, PC = 3584;
constexpr int NE = 16, CAP = 512, DFF = 2048, MR = NE * NB * CAP;
constexpr float EPS = 1e-6f, LOG2E = 1.4426950408889634f;
constexpr int NWAVES = 8, NTHR = 512;
constexpr int LDS_BYTES = 163840;

constexpr size_t MiB = 1u << 20;
constexpr size_t WS_CTL = 0;
constexpr size_t WS_ROPE = 1 * MiB;
constexpr size_t WS_BIAS = 64 * 1024;
constexpr size_t WS_IDX = 128 * 1024;
constexpr size_t WS_AFF = 3 * MiB;
constexpr size_t WS_INV = 5 * MiB;
constexpr size_t WS_WOUT = 7 * MiB;
constexpr size_t WS_WIN = 9 * MiB;
constexpr size_t WS_XN = 16 * MiB;
constexpr size_t WS_RQ = 80 * MiB, WS_RK = 112 * MiB, WS_RV = 144 * MiB, WS_RG = 176 * MiB;
constexpr size_t WS_AQ = 208 * MiB, WS_AK = 240 * MiB, WS_AV = 272 * MiB;
constexpr size_t WS_ATTO = 304 * MiB;
constexpr size_t WS_ATTL0 = 528 * MiB, WS_ATTL1 = 529 * MiB, WS_ATTL2 = 2 * MiB;
constexpr size_t WS_KF = 400 * MiB;
constexpr size_t WS_WD = 432 * MiB;
constexpr size_t WS_WGU = 464 * MiB;
constexpr size_t WS_Y = 144 * MiB;
constexpr size_t WS_HID = 272 * MiB;
constexpr size_t WS_END = 530 * MiB;
DEV size_t x1_off(int row) { const int b = row >> 12, s = row & 4095; return (s < 2048 ? WS_RQ : WS_RK) + (size_t)b * 4 * MiB + (size_t)(s & 2047) * 2048; }
DEV size_t afft_off(int b, int e) { return WS_AQ + (size_t)b * 4 * MiB + (size_t)e * S * 4; }
DEV size_t st_off(int dir, int bh, int n) { return WS_AQ + (size_t)(bh >> 3) * 4 * MiB + ((size_t)((dir * NH + (bh & 7)) * 32 + n)) * 8192; }

DEV unsigned f2bf(float f) { unsigned u = __float_as_uint(f); return (u + 0x7fffu + ((u >> 16) & 1u)) >> 16; }
DEV float bf2f(unsigned h) { return __uint_as_float(h << 16); }
DEV unsigned pk2(float lo, float hi) { return f2bf(lo) | (f2bf(hi) << 16); }
#define DPPF(x, ctrl) __builtin_bit_cast(float, __builtin_amdgcn_update_dpp(__builtin_bit_cast(int, (x)), __builtin_bit_cast(int, (x)), (ctrl), 0xF, 0xF, false))
DEV float lane_x1(float x) { return DPPF(x, 0xB1); }
DEV float lane_x2(float x) { return DPPF(x, 0x4E); }
DEV float lane_m8(float x) { return DPPF(x, 0x141); }
DEV float lane_x8(float x) { return DPPF(x, 0x128); }
DEV float lane_x16(float x) { const auto r = __builtin_amdgcn_permlane16_swap(__float_as_uint(x), __float_as_uint(x), false, false); return (threadIdx.x & 16) ? __uint_as_float(r[0]) : __uint_as_float(r[1]); }
DEV float lane_x32(float x) { const auto r = __builtin_amdgcn_permlane32_swap(__float_as_uint(x), __float_as_uint(x), false, false); return (threadIdx.x & 32) ? __uint_as_float(r[0]) : __uint_as_float(r[1]); }
DEV float wave_sum(float v) {
    v += lane_x1(v); v += lane_x2(v); v += lane_m8(v); v += lane_x8(v); v += lane_x16(v); v += lane_x32(v);
    return v;
}
#define LDS_WAIT() asm volatile("s_waitcnt lgkmcnt(0)" ::: "memory")
namespace pg8 {
#define PG8_LAS __attribute__((address_space(3)))
typedef short bf16x8 __attribute__((ext_vector_type(8)));
typedef float f32x4 __attribute__((ext_vector_type(4)));
typedef unsigned u32x4 __attribute__((ext_vector_type(4)));
constexpr int BM = 256, BK = 64, HALF = 128, HTB = HALF * BK * 2, STAGE_BYTES = 8 * HTB, NXCD = 8, WGM = 8;
__host__ __device__ __forceinline__ int lds_byte(int r, int c) { const int st = (r >> 4) * 2 + (c >> 5), rr = r & 15, cc = c & 31, ob = rr * 64 + cc * 2; return st * 1024 + (ob ^ (((ob >> 9) & 1) << 5)); }
__host__ __device__ __forceinline__ void stage_rc(int b, int& R, int& C) { const int st = b / 1024, sb = b % 1024, swz = sb ^ (((sb >> 9) & 1) << 5); R = (st >> 1) * 16 + swz / 64; C = (st & 1) * 32 + (swz % 64) / 2; }
__host__ __device__ __forceinline__ int perm32(int rho) { const int n = rho >> 4, i = rho & 15; return 8 * (i >> 2) + 4 * n + (i & 3); }
struct Unit { int pm, pn, ui; };
struct Gemm { const bf16_t* A; const bf16_t* Bt; int K; };
struct StaticOrder {
    int nM, nN, nwg, G, c, wgm;
    __device__ void init(int M_, int N_, int G_, int c_, int wgm_ = WGM) { nM = M_ / BM; nN = N_ / BM; nwg = nM * nN; G = G_; c = c_; wgm = wgm_; }
    __device__ bool next(int i, Unit& u) const {
        const long L = (long)i * G + c; if (L >= nwg) return false;
        int wgid = (int)L; { const int q = nwg / NXCD, r = nwg % NXCD, xcd = wgid % NXCD, off = wgid / NXCD; wgid = (xcd < r ? xcd * (q + 1) : r * (q + 1) + (xcd - r) * q) + off; }
        const int nig = wgm * nN, gid = wgid / nig, fm = gid * wgm, gsz = (nM - fm) < wgm ? (nM - fm) : wgm;
        u.pm = fm + ((wgid % nig) % gsz); u.pn = (wgid % nig) / gsz; return true;
    }
};
__device__ __forceinline__ unsigned cvt_pk_bf16(float lo, float hi) { unsigned r; asm volatile("v_cvt_pk_bf16_f32 %0, %1, %2" : "=v"(r) : "v"(lo), "v"(hi)); return r; }

typedef int v8i __attribute__((ext_vector_type(8)));
template <class Epi, class Sched, bool ALIGN_EPI, bool FP8 = false>
__device__ __forceinline__ void gemm_phase(PG8_LAS unsigned char* lds, const Gemm g, const Sched& S, const Epi& E) {
    const int tid = threadIdx.x, wid = __builtin_amdgcn_readfirstlane(tid >> 6), lane = tid & 63, wr = wid >> 2, wc = wid & 3, fr = lane & 15, fq = lane >> 4;
    const int K = g.K, RB = FP8 ? K : 2 * K, nt = RB / 128;
    unsigned voffB;
    { int R, C; stage_rc(tid * 16, R, C); const int Rb = Epi::PERM ? ((R & ~31) + perm32(R & 31)) : R; voffB = (unsigned)(Rb * RB + C * 2); }
    const size_t kstep = (size_t)(BK * 2);
    const size_t hstep = (size_t)HALF * RB;
    const size_t tstep = 2 * hstep;
    const unsigned ldsw = (unsigned)wid * 1024u;
    const int aoff = FP8 ? lds_byte(wr * 64 + fr, fq * 16) : lds_byte(wr * 64 + fr, fq * 8), boff = FP8 ? lds_byte(wc * 32 + fr, fq * 16) : lds_byte(wc * 32 + fr, fq * 8);
    const int x16 = 16 * (fq & 1);
    const char* gA = (const char*)g.A;
#define PG8_SA(b, h) (((b) * 2 + (h)) * HTB)
#define PG8_SB(b, h) ((4 + (b) * 2 + (h)) * HTB)
#define PG8_STAGE(bufoff, gbase, voff) do { _Pragma("unroll") for (int _i = 0; _i < 2; ++_i) \
        __builtin_amdgcn_global_load_lds((const unsigned*)((const char*)(gbase) + (size_t)_i * 64 * RB + (voff)), (PG8_LAS unsigned*)(lds + (bufoff) + ldsw + _i * 8192), 16, 0, 0); } while (0)
#define PG8_STAGE_A(bufoff, AO, h, kb) do { _Pragma("unroll") for (int _i = 0; _i < 2; ++_i) \
        __builtin_amdgcn_global_load_lds((const unsigned*)(gA + (size_t)((AO)[h][_i] + (unsigned)(kb))), (PG8_LAS unsigned*)(lds + (bufoff) + ldsw + _i * 8192), 16, 0, 0); } while (0)
#define PG8_LDA(dst, b, h) do { if constexpr (FP8) { _Pragma("unroll") for (int m = 0; m < 4; ++m) { dst[m][0] = *(const PG8_LAS bf16x8*)(lds + PG8_SA(b, h) + aoff + m * 2048 + x16); dst[m][1] = *(const PG8_LAS bf16x8*)(lds + PG8_SA(b, h) + aoff + m * 2048 + 16 - x16); } } \
    else { _Pragma("unroll") for (int m = 0; m < 4; ++m) _Pragma("unroll") for (int k = 0; k < 2; ++k) dst[m][k] = *(const PG8_LAS bf16x8*)(lds + PG8_SA(b, h) + aoff + m * 2048 + k * 1024); } } while (0)
#define PG8_LDB(dst, b, h) do { if constexpr (FP8) { _Pragma("unroll") for (int n = 0; n < 2; ++n) { dst[n][0] = *(const PG8_LAS bf16x8*)(lds + PG8_SB(b, h) + boff + n * 2048 + x16); dst[n][1] = *(const PG8_LAS bf16x8*)(lds + PG8_SB(b, h) + boff + n * 2048 + 16 - x16); } } \
    else { _Pragma("unroll") for (int n = 0; n < 2; ++n) _Pragma("unroll") for (int k = 0; k < 2; ++k) dst[n][k] = *(const PG8_LAS bf16x8*)(lds + PG8_SB(b, h) + boff + n * 2048 + k * 1024); } } while (0)
#define PG8_CAT8(x) __builtin_bit_cast(v8i, __builtin_shufflevector((x)[0], (x)[1], 0, 1, 2, 3, 4, 5, 6, 7, 8, 9, 10, 11, 12, 13, 14, 15))
#define PG8_MMA(ai, bj, At, Bt) do { __builtin_amdgcn_s_setprio(1); if constexpr (FP8) { _Pragma("unroll") for (int m = 0; m < 4; ++m) _Pragma("unroll") for (int n = 0; n < 2; ++n) \
        acc[ai][bj][m][n] = __builtin_amdgcn_mfma_scale_f32_16x16x128_f8f6f4(PG8_CAT8(Bt[n]), PG8_CAT8(At[m]), acc[ai][bj][m][n], 0, 0, 0, 0, 0, 0); } \
    else { _Pragma("unroll") for (int m = 0; m < 4; ++m) _Pragma("unroll") for (int n = 0; n < 2; ++n) _Pragma("unroll") for (int k = 0; k < 2; ++k) \
        acc[ai][bj][m][n] = __builtin_amdgcn_mfma_f32_16x16x32_bf16(Bt[n][k], At[m][k], acc[ai][bj][m][n], 0, 0, 0); } __builtin_amdgcn_s_setprio(0); } while (0)
#define PG8_WAIT_V(n) asm volatile("s_waitcnt vmcnt(" #n ")" ::: "memory")
#define PG8_WAIT_L(n) asm volatile("s_waitcnt lgkmcnt(" #n ")" ::: "memory")
#define PG8_BAR __builtin_amdgcn_s_barrier()
#define PG8_SCHED __builtin_amdgcn_sched_barrier(0)
#define PG8_AOFFS(AO, u) do { int _t = threadIdx.x; asm volatile("" : "+v"(_t)); _Pragma("unroll") for (int _i = 0; _i < 2; ++_i) { int _R, _C; stage_rc(_t * 16 + _i * 8192, _R, _C); \
        _Pragma("unroll") for (int _h = 0; _h < 2; ++_h) (AO)[_h][_i] = S.row_off(u, _h * HALF + _R) + (unsigned)(_C * 2); } } while (0)
    Unit cur, nxt; int ui = 0;
    if (!S.next(0, cur)) return;
    f32x4 acc[2][2][4][2];
#pragma unroll
    for (int a = 0; a < 2; ++a)
#pragma unroll
        for (int b = 0; b < 2; ++b)
#pragma unroll
            for (int m = 0; m < 4; ++m)
#pragma unroll
                for (int n = 0; n < 2; ++n) acc[a][b][m][n] = (f32x4){0.f, 0.f, 0.f, 0.f};
    bf16x8 At[4][2], B0[2][2], B1[2][2];
    unsigned aoc[2][2];
    PG8_AOFFS(aoc, cur);
    const char* cB = (const char*)g.Bt + (size_t)cur.pn * tstep;
    PG8_STAGE(PG8_SB(0, 0), cB, voffB); PG8_STAGE(PG8_SB(0, 1), cB + hstep, voffB); PG8_STAGE_A(PG8_SA(0, 0), aoc, 0, 0); PG8_STAGE_A(PG8_SA(0, 1), aoc, 1, 0);
    if (wr == 1) PG8_BAR;
    PG8_WAIT_V(2); PG8_BAR;
    PG8_STAGE(PG8_SB(1, 0), cB + kstep, voffB); PG8_STAGE_A(PG8_SA(1, 0), aoc, 0, 128); PG8_STAGE(PG8_SB(1, 1), cB + hstep + kstep, voffB);
    PG8_WAIT_V(6); PG8_BAR;
    for (;;) {
        const bool has_next = S.next(ui + 1, nxt);
        const char* nB = cB;
        if (has_next) nB = (const char*)g.Bt + (size_t)nxt.pn * tstep;
#pragma nounroll
        for (int t = 0; t < nt; t += 2) {
            const bool last = (t == nt - 2);
            const unsigned k1 = (unsigned)(t + 1) * 128u, k2 = last ? 0u : (unsigned)(t + 2) * 128u, k3 = k2 + 128u;
            const char* b2 = last ? nB : cB + (size_t)(t + 2) * kstep; const char* b3 = b2 + kstep;
            PG8_LDB(B0, 0, 0); PG8_LDB(B1, 0, 1); PG8_SCHED; PG8_LDA(At, 0, 0); PG8_STAGE_A(PG8_SA(1, 1), aoc, 1, k1);
            PG8_WAIT_V(8); PG8_WAIT_L(0); PG8_BAR; PG8_MMA(0, 0, At, B0); PG8_MMA(0, 1, At, B1); PG8_BAR; PG8_SCHED;
            if (last && has_next) { PG8_AOFFS(aoc, nxt); }
            PG8_LDA(At, 0, 1); PG8_STAGE(PG8_SB(0, 0), b2, voffB); PG8_STAGE(PG8_SB(0, 1), b2 + hstep, voffB); PG8_STAGE_A(PG8_SA(0, 0), aoc, 0, k2);
            PG8_WAIT_V(8); PG8_WAIT_L(0); PG8_BAR; PG8_MMA(1, 0, At, B0); PG8_MMA(1, 1, At, B1); PG8_BAR; PG8_SCHED;
            PG8_LDB(B0, 1, 0); PG8_LDB(B1, 1, 1); PG8_SCHED; PG8_LDA(At, 1, 0); PG8_STAGE_A(PG8_SA(0, 1), aoc, 1, k2);
            PG8_WAIT_V(8); PG8_WAIT_L(0); PG8_BAR; PG8_MMA(0, 0, At, B0); PG8_MMA(0, 1, At, B1); PG8_BAR; PG8_SCHED;
            PG8_LDA(At, 1, 1); PG8_STAGE(PG8_SB(1, 0), b3, voffB); PG8_STAGE(PG8_SB(1, 1), b3 + hstep, voffB); PG8_STAGE_A(PG8_SA(1, 0), aoc, 0, k3);
            PG8_WAIT_V(8); PG8_WAIT_L(0); PG8_BAR; PG8_MMA(1, 0, At, B0); PG8_MMA(1, 1, At, B1); PG8_BAR; PG8_SCHED;
        }
        if constexpr (ALIGN_EPI) { if (wr == 0) PG8_BAR; }
        { int t2 = threadIdx.x; asm volatile("" : "+v"(t2));
          const int w2 = __builtin_amdgcn_readfirstlane(t2 >> 6), l2 = t2 & 63; E(acc, cur, w2 >> 2, w2 & 3, l2 & 15, l2 >> 4); }
        if (!has_next) break;
#pragma unroll
        for (int a = 0; a < 2; ++a)
#pragma unroll
            for (int b = 0; b < 2; ++b)
#pragma unroll
                for (int m = 0; m < 4; ++m)
#pragma unroll
                    for (int n = 0; n < 2; ++n) acc[a][b][m][n] = (f32x4){0.f, 0.f, 0.f, 0.f};
        cur = nxt; cB = nB; ++ui;
        if constexpr (ALIGN_EPI) { if (wr == 1) PG8_BAR; }
    }
    PG8_WAIT_V(0);
    if constexpr (!ALIGN_EPI) { if (wr == 0) PG8_BAR; }
    PG8_BAR;
#undef PG8_SA
#undef PG8_SB
#undef PG8_STAGE
#undef PG8_STAGE_A
#undef PG8_LDA
#undef PG8_LDB
#undef PG8_MMA
#undef PG8_CAT8
#undef PG8_WAIT_V
#undef PG8_WAIT_L
#undef PG8_BAR
#undef PG8_SCHED
#undef PG8_AOFFS
}
}
struct SchedPlain : pg8::StaticOrder {
    unsigned rowbytes;
    DEV unsigned row_off(const pg8::Unit& u, int r) const { return (unsigned)(u.pm * 256 + r) * rowbytes; }
};
struct SchedMoe1 : pg8::StaticOrder {
    const LAS int* idxl;
    DEV bool next(int i, pg8::Unit& u) const { if (!pg8::StaticOrder::next(i, u)) return false; u.pn += (u.pm >> 4) * 16; u.ui = i; return true; }
    DEV unsigned row_off(const pg8::Unit& u, int r) const { const int g = u.pm * 256 + r; const int tok = ((g >> 9) & 7) * S + idxl[u.ui * 256 + r]; return (unsigned)tok * 2048u; }
};
struct SchedMoe2 : pg8::StaticOrder {
    DEV bool next(int i, pg8::Unit& u) const { if (!pg8::StaticOrder::next(i, u)) return false; u.pn += (u.pm >> 4) * 4; return true; }
    DEV unsigned row_off(const pg8::Unit& u, int r) const { return (unsigned)(u.pm * 256 + r) * (unsigned)DFF; }
};
typedef pg8::f32x4 f32x4; typedef pg8::u32x4 u32x4;
struct EpiInProj {
    static constexpr bool PERM = true;
    unsigned char* ws; const float* ropeT;
    DEV void operator()(const f32x4 (&acc)[2][2][4][2], const pg8::Unit& u, int wr, int wc, int fr, int fq) const {
        const int grp = u.pn >> 1;
        bf16_t* gbase = (bf16_t*)(ws + WS_RQ + (size_t)grp * 32 * MiB);
        const int j0 = 32 * (wc & 1) + 8 * fq;
        if (grp < 2) {
            const float sc = grp == 1 ? 0.125f : 1.f;
            f32x4 cs[2][4], sn[2][4];
#pragma unroll
            for (int ai = 0; ai < 2; ++ai)
#pragma unroll
                for (int m = 0; m < 4; ++m) { const int s = (u.pm * 256 + ai * 128 + wr * 64 + m * 16 + fr) & 4095;
                    cs[ai][m] = *(const f32x4*)(ropeT + s * 32 + (j0 >> 1)); sn[ai][m] = *(const f32x4*)(ropeT + S * 32 + s * 32 + (j0 >> 1)); }
#pragma unroll
            for (int ai = 0; ai < 2; ++ai)
#pragma unroll
                for (int m = 0; m < 4; ++m) {
                    const int row = u.pm * 256 + ai * 128 + wr * 64 + m * 16 + fr, b = row >> 12, s = row & 4095;
#pragma unroll
                    for (int bj = 0; bj < 2; ++bj) {
                        const int hd = 4 * (u.pn & 1) + 2 * bj + (wc >> 1);
                        const f32x4 lo = (acc[ai][bj][m][0] * cs[ai][m] - acc[ai][bj][m][1] * sn[ai][m]) * sc, hi = (acc[ai][bj][m][1] * cs[ai][m] + acc[ai][bj][m][0] * sn[ai][m]) * sc;
                        u32x4 w; w.x = pg8::cvt_pk_bf16(lo[0], lo[1]); w.y = pg8::cvt_pk_bf16(lo[2], lo[3]); w.z = pg8::cvt_pk_bf16(hi[0], hi[1]); w.w = pg8::cvt_pk_bf16(hi[2], hi[3]);
                        *(u32x4*)(gbase + ((size_t)(b * NH + hd) * S + s) * HD + j0) = w;
                    }
                }
        } else {
            const float sc = grp == 4 ? 0.125f * LOG2E : 1.f;
#pragma unroll
            for (int ai = 0; ai < 2; ++ai)
#pragma unroll
                for (int m = 0; m < 4; ++m) {
                    const int row = u.pm * 256 + ai * 128 + wr * 64 + m * 16 + fr, b = row >> 12, s = row & 4095;
#pragma unroll
                    for (int bj = 0; bj < 2; ++bj) {
                        const int hd = 4 * (u.pn & 1) + 2 * bj + (wc >> 1);
                        const f32x4 lo = acc[ai][bj][m][0] * sc, hi = acc[ai][bj][m][1] * sc;
                        u32x4 w; w.x = pg8::cvt_pk_bf16(lo[0], lo[1]); w.y = pg8::cvt_pk_bf16(lo[2], lo[3]); w.z = pg8::cvt_pk_bf16(hi[0], hi[1]); w.w = pg8::cvt_pk_bf16(hi[2], hi[3]);
                        *(u32x4*)(gbase + ((size_t)(b * NH + hd) * S + s) * HD + j0) = w;
                    }
                }
        }
    }
};
struct EpiOutProj {
    static constexpr bool PERM = true;
    const float* x; unsigned char* ws;
    DEV void operator()(const f32x4 (&acc)[2][2][4][2], const pg8::Unit& u, int wr, int wc, int fr, int fq) const {
#pragma unroll
        for (int ai = 0; ai < 2; ++ai)
#pragma unroll
            for (int m = 0; m < 4; ++m) {
                const int row = u.pm * 256 + ai * 128 + wr * 64 + m * 16 + fr;
                bf16_t* x1r = (bf16_t*)(ws + x1_off(row));
                f32x4 xa[2], xb[2];
#pragma unroll
                for (int bj = 0; bj < 2; ++bj) { const size_t off = (size_t)row * D + u.pn * 256 + bj * 128 + wc * 32 + 8 * fq; xa[bj] = *(const f32x4*)(x + off); xb[bj] = *(const f32x4*)(x + off + 4); }
#pragma unroll
                for (int bj = 0; bj < 2; ++bj) { const int col = u.pn * 256 + bj * 128 + wc * 32 + 8 * fq;
                    const f32x4 lo = xa[bj] + acc[ai][bj][m][0], hi = xb[bj] + acc[ai][bj][m][1];
                    u32x4 w; w.x = pg8::cvt_pk_bf16(lo[0], lo[1]); w.y = pg8::cvt_pk_bf16(lo[2], lo[3]); w.z = pg8::cvt_pk_bf16(hi[0], hi[1]); w.w = pg8::cvt_pk_bf16(hi[2], hi[3]);
                    *(u32x4*)(x1r + col) = w; }
            }
    }
};
DEV unsigned pk4_fp8e(float a, float b, float c, float d) { unsigned w = 0u; w = __builtin_amdgcn_cvt_pk_fp8_f32(a, b, w, false); w = __builtin_amdgcn_cvt_pk_fp8_f32(c, d, w, true); return w; }
struct EpiSwiGLU {
    static constexpr bool PERM = true;
    unsigned char* hid;
    DEV void operator()(const f32x4 (&acc)[2][2][4][2], const pg8::Unit& u, int wr, int wc, int fr, int fq) const {
        const int pnl = u.pn & 15;
#pragma unroll
        for (int ai = 0; ai < 2; ++ai)
#pragma unroll
            for (int m = 0; m < 4; ++m) {
                const int row = u.pm * 256 + ai * 128 + wr * 64 + m * 16 + fr;
                float o[8];
#pragma unroll
                for (int n = 0; n < 2; ++n)
#pragma unroll
                    for (int i = 0; i < 4; ++i) { const float ga = acc[ai][0][m][n][i], ua = acc[ai][1][m][n][i];
                        o[4 * n + i] = (ga * ua) * ((1.f / 1024.f) * __builtin_amdgcn_rcpf(1.f + __builtin_amdgcn_exp2f(ga * (-LOG2E / 32.f)))); }
                *(uint2*)(hid + (size_t)row * DFF + pnl * 128 + wc * 32 + 8 * fq) = make_uint2(pk4_fp8e(o[0], o[1], o[2], o[3]), pk4_fp8e(o[4], o[5], o[6], o[7]));
            }
    }
};
struct EpiDown {
    static constexpr bool PERM = true;
    unsigned char* y;
    DEV void operator()(const f32x4 (&acc)[2][2][4][2], const pg8::Unit& u, int wr, int wc, int fr, int fq) const {
        const int pnl = u.pn & 3;
#pragma unroll
        for (int ai = 0; ai < 2; ++ai)
#pragma unroll
            for (int m = 0; m < 4; ++m) {
                const int row = u.pm * 256 + ai * 128 + wr * 64 + m * 16 + fr;
#pragma unroll
                for (int bj = 0; bj < 2; ++bj) { const f32x4 lo = acc[ai][bj][m][0] * (1.f / 32.f), hi = acc[ai][bj][m][1] * (1.f / 32.f);
                    *(uint2*)(y + (size_t)row * D + pnl * 256 + bj * 128 + wc * 32 + 8 * fq) = make_uint2(pk4_fp8e(lo[0], lo[1], lo[2], lo[3]), pk4_fp8e(hi[0], hi[1], hi[2], hi[3])); }
            }
    }
};
struct Args { const float* in[13]; float* out; unsigned char* ws; int ph_lo, ph_hi; int rep[16]; };
enum { IN_X = 0, IN_G1, IN_WIN, IN_DECAY, IN_GN, IN_RELB, IN_WOUT, IN_G2, IN_WR, IN_WG, IN_WU, IN_WDN, IN_FG };

struct TrItem { const float* src; bf16_t* dst; int K, N, k0, n0, mode, fp8; };
DEV unsigned pk4_fp8(float a, float b, float c, float d) { unsigned w = 0u; w = __builtin_amdgcn_cvt_pk_fp8_f32(a, b, w, false); w = __builtin_amdgcn_cvt_pk_fp8_f32(c, d, w, true); return w; }
DEV void tr_load(const TrItem& t, f32x4 (&v)[16], int lane) {
#pragma unroll
    for (int i = 0; i < 16; ++i) { const int kk = (lane >> 4) + 4 * i, c = (lane & 15) * 4; v[i] = *(const f32x4*)(t.src + (size_t)(t.k0 + kk) * t.N + t.n0 + c); }
}
DEV int rowmap_rt(int mode, int n) {
    if (mode == 0) return n;
    if (mode == 1) { if (n >= 1024) return n; const int base = n & ~63, d = n & 63, nn = d >> 5, dd = d & 31; return base + 8 * (dd >> 2) + 4 * nn + (dd & 3); }
    return (n >> 7) * 256 + (mode == 3 ? 128 : 0) + (n & 127);
}
DEV void tr_finish(const TrItem& t, const f32x4 (&v)[16], LAS float* scr, int lane) {
#pragma unroll
    for (int i = 0; i < 16; ++i) { const int kk = (lane >> 4) + 4 * i, c = (lane & 15) * 4;
        scr[kk * 65 + c] = v[i][0]; scr[kk * 65 + c + 1] = v[i][1]; scr[kk * 65 + c + 2] = v[i][2]; scr[kk * 65 + c + 3] = v[i][3]; }
    LDS_WAIT();
#pragma unroll
    for (int i = 0; i < 8; ++i) { const int n = (lane >> 3) + 8 * i, c = (lane & 7) * 8; const LAS float* sp = scr + c * 65 + n;
        if (t.fp8) {
            const unsigned lo = pk4_fp8(sp[0] * 32.f, sp[65] * 32.f, sp[2 * 65] * 32.f, sp[3 * 65] * 32.f), hi = pk4_fp8(sp[4 * 65] * 32.f, sp[5 * 65] * 32.f, sp[6 * 65] * 32.f, sp[7 * 65] * 32.f);
            *(uint2*)((unsigned char*)t.dst + (size_t)rowmap_rt(t.mode, t.n0 + n) * t.K + t.k0 + c) = make_uint2(lo, hi);
        } else {
        u32x4 o; o.x = pk2(sp[0], sp[65]); o.y = pk2(sp[2 * 65], sp[3 * 65]); o.z = pk2(sp[4 * 65], sp[5 * 65]); o.w = pk2(sp[6 * 65], sp[7 * 65]);
        *(u32x4*)(t.dst + (size_t)rowmap_rt(t.mode, t.n0 + n) * t.K + t.k0 + c) = o; } }
    LDS_WAIT();
}
template <class Dec> DEV void tr_run(const Dec& dec, int nitems, int gw, int NGW, LAS float* scr, int lane) {
    for (int it = gw; it < nitems; it += NGW) { TrItem cur; f32x4 va[16]; dec(it, cur); tr_load(cur, va, lane); tr_finish(cur, va, scr, lane); }
}
template <class Dec> DEV void tr_run2(const Dec& dec, int nitems, int gw, int NGW, LAS float* scr, int lane) {
    int it = gw; if (it >= nitems) return;
    TrItem cur, nxt; f32x4 va[16], vb[16];
    dec(it, cur); tr_load(cur, va, lane);
    for (;;) {
        const int n1 = it + NGW; const bool h1 = n1 < nitems;
        if (h1) { dec(n1, nxt); tr_load(nxt, vb, lane); }
        tr_finish(cur, va, scr, lane);
        if (!h1) break;
        const int n2 = n1 + NGW; const bool h2 = n2 < nitems;
        if (h2) { dec(n2, cur); tr_load(cur, va, lane); }
        tr_finish(nxt, vb, scr, lane);
        if (!h2) break;
        it = n2;
    }
}
DEV void rms_row_to_bf16(const float* xrow, const float* g, bf16_t* orow, int lane) {
    const float4* xr = (const float4*)xrow + lane;
    float4 v[4]; float s = 0.f;
#pragma unroll
    for (int j = 0; j < 4; ++j) { v[j] = xr[64 * j]; s += v[j].x * v[j].x + v[j].y * v[j].y + v[j].z * v[j].z + v[j].w * v[j].w; }
    const float rs = rsqrtf(wave_sum(s) * (1.f / D) + EPS);
    uint2* o = (uint2*)orow + lane;
#pragma unroll
    for (int j = 0; j < 4; ++j) { const float4 gg = ((const float4*)g)[lane + 64 * j];
        o[64 * j] = make_uint2(pk2(v[j].x * rs * gg.x, v[j].y * rs * gg.y), pk2(v[j].z * rs * gg.z, v[j].w * rs * gg.w)); }
}
DEV void phase_prep(const Args& a, unsigned char* lds, int gw, int NGW, int lane, int wave) {
    unsigned char* ws = a.ws;
    float* ropeT = (float*)(ws + WS_ROPE); float* biasT = (float*)(ws + WS_BIAS);
    for (int t = gw * 64 + lane; t < S * 32; t += NGW * 64) {
        const int pos = t >> 5, i = t & 31; const double inv = pow(10000.0, -(double)i / 32.0), ang = (double)pos * inv;
        ropeT[t] = (float)cos(ang); ropeT[S * 32 + t] = (float)sin(ang);
        if (t < 3 * NH * 129) { const int p = t / (NH * 129), h = (t / 129) % NH, o = t % 129 - 64, dil = p == 0 ? 1 : (p == 1 ? 4 : 16), rel = o * dil, n = rel < 0 ? -rel : rel;
            int bucket = rel > 0 ? 16 : 0;
            if (n < 8) bucket += n; else { int large = 8 + (int)(log((double)n / 8.0) / log(128.0) * 8.0); if (large > 15) large = 15; bucket += large; }
            biasT[t] = a.in[IN_RELB][bucket * NH + h] * LOG2E; }
    }
    LAS float* scr = (LAS float*)((LAS unsigned char*)lds + wave * 16640);
    constexpr int I_IN = (D / 64) * (PC / 64), I_OUT = (D / 64) * (D / 64);
    { const float* w_in = a.in[IN_WIN]; const float* w_out = a.in[IN_WOUT]; bf16_t* Win = (bf16_t*)(ws + WS_WIN); bf16_t* Wout = (bf16_t*)(ws + WS_WOUT);
      auto dec = [=](int it, TrItem& t) { if (it < I_IN) { t.src = w_in; t.dst = Win; t.K = D; t.N = PC; t.k0 = (it / (PC / 64)) * 64; t.n0 = (it % (PC / 64)) * 64; t.mode = 1; t.fp8 = 0; }
          else { const int r = it - I_IN; t.src = w_out; t.dst = Wout; t.K = D; t.N = D; t.k0 = (r / (D / 64)) * 64; t.n0 = (r % (D / 64)) * 64; t.mode = 0; t.fp8 = 0; } };
      tr_run(dec, I_IN + I_OUT, gw, NGW, scr, lane); }
    {
      const float* x = a.in[IN_X]; const float* g = a.in[IN_G1]; bf16_t* XN = (bf16_t*)(ws + WS_XN);
      float4 va[4], vb[4], vc[4];
      { const float4* xr = (const float4*)(x + (size_t)gw * D) + lane;
#pragma unroll
        for (int j = 0; j < 4; ++j) va[j] = xr[64 * j];
        if (gw + NGW < M) { const float4* xs = (const float4*)(x + (size_t)(gw + NGW) * D) + lane;
#pragma unroll
          for (int j = 0; j < 4; ++j) vb[j] = xs[64 * j]; } }
      for (int m = gw; m < M; m += NGW) {
          if (m + 2 * NGW < M) { const float4* xr = (const float4*)(x + (size_t)(m + 2 * NGW) * D) + lane;
#pragma unroll
              for (int j = 0; j < 4; ++j) vc[j] = xr[64 * j]; }
          float s = 0.f;
#pragma unroll
          for (int j = 0; j < 4; ++j) s += va[j].x * va[j].x + va[j].y * va[j].y + va[j].z * va[j].z + va[j].w * va[j].w;
          const float rs = rsqrtf(wave_sum(s) * (1.f / D) + EPS);
          uint2* o = (uint2*)(XN + (size_t)m * D) + lane;
#pragma unroll
          for (int j = 0; j < 4; ++j) { const float4 gg = ((const float4*)g)[lane + 64 * j];
              o[64 * j] = make_uint2(pk2(va[j].x * rs * gg.x, va[j].y * rs * gg.y), pk2(va[j].z * rs * gg.z, va[j].w * rs * gg.w)); }
#pragma unroll
          for (int j = 0; j < 4; ++j) { va[j] = vb[j]; vb[j] = vc[j]; }
      } }
}
DEV void phase_latew(const Args& a, unsigned char* lds, int gw, int NGW, int lane, int wave) {
    unsigned char* ws = a.ws; LAS float* scr = (LAS float*)((LAS unsigned char*)lds + wave * 16640);
    constexpr int I_G = (D / 64) * (DFF / 64);
    const float* wg_ = a.in[IN_WG]; const float* wu_ = a.in[IN_WU]; const float* wd_ = a.in[IN_WDN]; bf16_t* Wgu = (bf16_t*)(ws + WS_WGU); bf16_t* Wd = (bf16_t*)(ws + WS_WD);
    auto dec = [=](int it, TrItem& t) { const int which = it / (NE * I_G), r = it % (NE * I_G), e = r / I_G, q = r % I_G;
        t.fp8 = 1;
        if (which < 2) { t.src = (which == 0 ? wg_ : wu_) + (size_t)e * D * DFF; t.dst = (bf16_t*)((unsigned char*)Wgu + (size_t)e * 4096 * D); t.K = D; t.N = DFF; t.n0 = (q / (D / 64)) * 64; t.k0 = (q % (D / 64)) * 64; t.mode = 2 + which; }
        else { t.src = wd_ + (size_t)e * DFF * D; t.dst = (bf16_t*)((unsigned char*)Wd + (size_t)e * D * DFF); t.K = DFF; t.N = D; t.n0 = (q / (DFF / 64)) * 64; t.k0 = (q % (DFF / 64)) * 64; t.mode = 0; } };
    tr_run2(dec, 3 * NE * I_G, gw, NGW, scr, lane);
}
DEV void phase_router(const Args& a, unsigned char* lds, int xg, int gwl, int NGW, int lane, int tid) {
    const int gw = xg * S + gwl, M = (xg + 1) * S;
    unsigned char* ws = a.ws; const float* g2 = a.in[IN_G2]; const float* wr = a.in[IN_WR];
    bf16_t* H2b = (bf16_t*)(ws + WS_XN); float* aff = (float*)(ws + WS_AFF); int* inv = (int*)(ws + WS_INV);
    LAS f32x4* wl = (LAS f32x4*)(LAS unsigned char*)lds;
    for (int i = tid; i < D * 4; i += NTHR) { const int k = i >> 2, c = i & 3, slot = (k & 3) * 256 + (k >> 2); wl[slot * 4 + ((c + (slot >> 2)) & 3)] = *(const f32x4*)(wr + (size_t)k * NE + 4 * c); }
    __syncthreads();
    uint2 xq[4][4], xp[4][4];
#pragma unroll
    for (int q = 0; q < 4; ++q) { const int r = gw + q * NGW; if (r < M) { const uint2* xr = (const uint2*)(ws + x1_off(r)) + lane;
#pragma unroll
        for (int j = 0; j < 4; ++j) xp[q][j] = xr[64 * j]; } }
    for (int row4 = gw; row4 < M; row4 += 4 * NGW) {
#pragma unroll
      for (int q = 0; q < 4; ++q)
#pragma unroll
        for (int j = 0; j < 4; ++j) xq[q][j] = xp[q][j];
#pragma unroll
      for (int q = 0; q < 4; ++q) { const int r = row4 + (4 + q) * NGW; if (r < M) { const uint2* xr = (const uint2*)(ws + x1_off(r)) + lane;
#pragma unroll
          for (int j = 0; j < 4; ++j) xp[q][j] = xr[64 * j]; } }
#pragma unroll
      for (int q = 0; q < 4; ++q) {
        const int row = row4 + q * NGW; if (row >= M) break;
        float4 v[4]; float s = 0.f;
#pragma unroll
        for (int j = 0; j < 4; ++j) { v[j] = make_float4(bf2f(xq[q][j].x & 0xffffu), bf2f(xq[q][j].x >> 16), bf2f(xq[q][j].y & 0xffffu), bf2f(xq[q][j].y >> 16)); s += v[j].x * v[j].x + v[j].y * v[j].y + v[j].z * v[j].z + v[j].w * v[j].w; }
        const float rs = rsqrtf(wave_sum(s) * (1.f / D) + EPS);
        f32x4 lg[4];
#pragma unroll
        for (int c = 0; c < 4; ++c) lg[c] = (f32x4){0.f, 0.f, 0.f, 0.f};
        unsigned* o = (unsigned*)((unsigned char*)H2b + (size_t)row * 2048) + lane;
        float hv[4][4];
#pragma unroll
        for (int j = 0; j < 4; ++j) { const float4 gg = ((const float4*)g2)[lane + 64 * j];
            hv[j][0] = v[j].x * rs * gg.x; hv[j][1] = v[j].y * rs * gg.y; hv[j][2] = v[j].z * rs * gg.z; hv[j][3] = v[j].w * rs * gg.w;
            o[64 * j] = pk4_fp8(hv[j][0], hv[j][1], hv[j][2], hv[j][3]); }
        const int rot = (lane >> 2) & 3; f32x4 wa[4], wb[4];
#pragma unroll
        for (int c = 0; c < 4; ++c) wa[c] = wl[(0 * 256 + lane) * 4 + ((c + rot) & 3)];
#pragma unroll
        for (int st = 0; st < 16; st += 2) {
            { const int j = (st + 1) >> 2, t = (st + 1) & 3, slot = t * 256 + lane + 64 * j;
#pragma unroll
              for (int c = 0; c < 4; ++c) wb[c] = wl[slot * 4 + ((c + rot) & 3)]; }
#pragma unroll
            for (int c = 0; c < 4; ++c) lg[c] += hv[st >> 2][st & 3] * wa[c];
            __builtin_amdgcn_sched_barrier(0);
            if (st + 2 < 16) { const int j = (st + 2) >> 2, t = (st + 2) & 3, slot = t * 256 + lane + 64 * j;
#pragma unroll
              for (int c = 0; c < 4; ++c) wa[c] = wl[slot * 4 + ((c + rot) & 3)]; }
#pragma unroll
            for (int c = 0; c < 4; ++c) lg[c] += hv[(st + 1) >> 2][(st + 1) & 3] * wb[c];
            __builtin_amdgcn_sched_barrier(0);
        }
        float r8[8], r4[4], r2[2], r1;
        { const bool up = lane & 32;
#pragma unroll
          for (int i = 0; i < 8; ++i) { const float mine = up ? lg[(i + 8) >> 2][(i + 8) & 3] : lg[i >> 2][i & 3], send = up ? lg[i >> 2][i & 3] : lg[(i + 8) >> 2][(i + 8) & 3]; r8[i] = mine + lane_x32(send); } }
        { const bool up = lane & 16;
#pragma unroll
          for (int i = 0; i < 4; ++i) { const float mine = up ? r8[i + 4] : r8[i], send = up ? r8[i] : r8[i + 4]; r4[i] = mine + lane_x16(send); } }
        { const bool up = lane & 8;
#pragma unroll
          for (int i = 0; i < 2; ++i) { const float mine = up ? r4[i + 2] : r4[i], send = up ? r4[i] : r4[i + 2]; r2[i] = mine + lane_x8(send); } }
        { const bool up = lane & 4; const float mine = up ? r2[1] : r2[0], send = up ? r2[0] : r2[1]; r1 = mine + lane_m8(send); }
        r1 += lane_x2(r1); r1 += lane_x1(r1);
        float mx = r1; mx = fmaxf(mx, lane_m8(mx)); mx = fmaxf(mx, lane_x8(mx)); mx = fmaxf(mx, lane_x16(mx)); mx = fmaxf(mx, lane_x32(mx));
        const float ex = __expf(r1 - mx); float sum = ex; sum += lane_m8(sum); sum += lane_x8(sum); sum += lane_x16(sum); sum += lane_x32(sum);
        const float av = ex / sum; const int e = lane >> 2;
        if ((lane & 3) == 0) { aff[(size_t)row * NE + e] = av; inv[(size_t)row * NE + e] = -1; ((float*)(ws + afft_off(row >> 12, e)))[row & 4095] = av; }
      }
    }
    __syncthreads();
}
DEV void phase_topk(const Args& a, unsigned char* lds, int wg, int G, int tid, int lane, int wave) {
    unsigned char* ws = a.ws; int* idx = (int*)(ws + WS_IDX); int* inv = (int*)(ws + WS_INV);
    LAS unsigned* hist = (LAS unsigned*)(LAS unsigned char*)lds; LAS unsigned* wsum = hist + 256; LAS unsigned* bc = hist + 272;
    for (int it = wg >> 3; it < NE; it += G >> 3) {
        const int e = it, b = wg & 7;
        unsigned u[8];
        { const uint4* src = (const uint4*)((const float*)(ws + afft_off(b, e)) + 8 * tid); const uint4 p = src[0], q = src[1]; u[0] = p.x; u[1] = p.y; u[2] = p.z; u[3] = p.w; u[4] = q.x; u[5] = q.y; u[6] = q.z; u[7] = q.w; }
        unsigned prefix = 0u, kk = CAP;
#pragma unroll
        for (int pass = 0; pass < 4; ++pass) {
            const int shift = 24 - 8 * pass;
            __syncthreads();
            if (tid < 256) hist[tid] = 0u;
            __syncthreads();
#pragma unroll
            for (int j = 0; j < 8; ++j) if (pass == 0 || (u[j] >> (shift + 8)) == prefix) atomicAdd((unsigned*)&hist[(u[j] >> shift) & 255u], 1u);
            __syncthreads();
            if (wave == 0) {
                const unsigned c0 = hist[4 * lane], c1 = hist[4 * lane + 1], c2 = hist[4 * lane + 2], c3 = hist[4 * lane + 3], tot = c0 + c1 + c2 + c3;
                unsigned incl = tot;
#pragma unroll
                for (int o = 1; o < 64; o <<= 1) { const unsigned t = __shfl_down(incl, o); if (lane + o < 64) incl += t; }
                const unsigned excl = incl - tot;
                if (excl < kk && kk <= incl) { unsigned acc = excl; int bin;
                    if (acc + c3 >= kk) bin = 3; else { acc += c3; if (acc + c2 >= kk) bin = 2; else { acc += c2; if (acc + c1 >= kk) bin = 1; else { acc += c1; bin = 0; } } }
                    bc[0] = 4 * lane + bin; bc[1] = kk - acc; }
            }
            __syncthreads();
            prefix = (prefix << 8) | bc[0]; kk = bc[1];
        }
        const unsigned T = prefix, need = kk;
        unsigned cg_ = 0u, ce = 0u;
#pragma unroll
        for (int j = 0; j < 8; ++j) { cg_ += u[j] > T; ce += u[j] == T; }
        unsigned pk = cg_ | (ce << 16), incl = pk;
#pragma unroll
        for (int o = 1; o < 64; o <<= 1) { const unsigned t = __shfl_up(incl, o); if (lane >= o) incl += t; }
        if (lane == 63) wsum[wave] = incl;
        __syncthreads();
        unsigned base = 0u;
#pragma unroll
        for (int w = 0; w < NWAVES; ++w) base += w < wave ? wsum[w] : 0u;
        const unsigned ex = base + incl - pk; unsigned gtb = ex & 0xffffu, eqb = ex >> 16;
#pragma unroll
        for (int j = 0; j < 8; ++j) { const bool g = u[j] > T, q = u[j] == T; const unsigned slot = gtb + (eqb < need ? eqb : need);
            if (g || (q && eqb < need)) { const int s = 8 * tid + j; idx[(e * NB + b) * CAP + slot] = s; inv[((size_t)b * S + s) * NE + e] = (int)slot; }
            gtb += g; eqb += q; }
    }
}
DEV void phase_final(const Args& a, int gw, int NGW, int lane) {
    unsigned char* ws = a.ws; float* xo = a.out; const float* aff = (const float*)(ws + WS_AFF); const int* inv = (const int*)(ws + WS_INV);
    const unsigned char* y = ws + WS_Y; const float* fg = a.in[IN_FG];
    uint2 xw[4], xn[4], xm[4]; int iv = -1, ivn = -1, ivm = -1; float av = 0.f, avn = 0.f, avm = 0.f;
    { const uint2* xr = (const uint2*)(ws + x1_off(gw)) + lane;
#pragma unroll
      for (int j = 0; j < 4; ++j) xw[j] = xr[64 * j];
      if (lane < NE) { iv = inv[(size_t)gw * NE + lane]; av = aff[(size_t)gw * NE + lane]; }
      if (gw + NGW < M) { const uint2* xs = (const uint2*)(ws + x1_off(gw + NGW)) + lane;
#pragma unroll
        for (int j = 0; j < 4; ++j) xn[j] = xs[64 * j];
        if (lane < NE) { ivn = inv[(size_t)(gw + NGW) * NE + lane]; avn = aff[(size_t)(gw + NGW) * NE + lane]; } } }
    for (int row = gw; row < M; row += NGW) {
        const int b = row >> 12;
        if (row + 2 * NGW < M) { const uint2* xr = (const uint2*)(ws + x1_off(row + 2 * NGW)) + lane;
#pragma unroll
            for (int j = 0; j < 4; ++j) xm[j] = xr[64 * j];
            if (lane < NE) { ivm = inv[(size_t)(row + 2 * NGW) * NE + lane]; avm = aff[(size_t)(row + 2 * NGW) * NE + lane]; } }
        float4 v[4];
#pragma unroll
        for (int j = 0; j < 4; ++j) v[j] = make_float4(bf2f(xw[j].x & 0xffffu), bf2f(xw[j].x >> 16), bf2f(xw[j].y & 0xffffu), bf2f(xw[j].y >> 16));
        unsigned long long msk = __ballot(lane < NE && iv >= 0);
        while (msk) {
            unsigned w[4][4]; float gq[4];
#pragma unroll
            for (int q = 0; q < 4; ++q) { const bool on = msk != 0ull; const int e = on ? __builtin_ctzll(msk) : 0; msk = on ? (msk & (msk - 1)) : 0ull;
                const int sl = __builtin_amdgcn_readlane(iv, e); const float g = __builtin_bit_cast(float, __builtin_amdgcn_readlane(__builtin_bit_cast(int, av), e));
                gq[q] = on ? g : 0.f;
                const unsigned* yr = (const unsigned*)(y + ((size_t)e * 4096 + b * CAP + (on ? sl : 0)) * D) + lane;
#pragma unroll
                for (int j = 0; j < 4; ++j) w[q][j] = yr[64 * j]; }
#pragma unroll
            for (int q = 0; q < 4; ++q)
#pragma unroll
                for (int j = 0; j < 4; ++j) { const auto lo = __builtin_amdgcn_cvt_pk_f32_fp8((int)w[q][j], false), hi = __builtin_amdgcn_cvt_pk_f32_fp8((int)w[q][j], true);
                    v[j].x += gq[q] * lo[0]; v[j].y += gq[q] * lo[1]; v[j].z += gq[q] * hi[0]; v[j].w += gq[q] * hi[1]; }
        }
        float s = 0.f;
#pragma unroll
        for (int j = 0; j < 4; ++j) s += v[j].x * v[j].x + v[j].y * v[j].y + v[j].z * v[j].z + v[j].w * v[j].w;
        const float rs = rsqrtf(wave_sum(s) * (1.f / D) + EPS);
        float4* orow = (float4*)(xo + (size_t)row * D) + lane;
#pragma unroll
        for (int j = 0; j < 4; ++j) { const float4 gg = ((const float4*)fg)[lane + 64 * j]; orow[64 * j] = make_float4(v[j].x * rs * gg.x, v[j].y * rs * gg.y, v[j].z * rs * gg.z, v[j].w * rs * gg.w); }
#pragma unroll
        for (int j = 0; j < 4; ++j) { xw[j] = xn[j]; xn[j] = xm[j]; }
        iv = ivn; av = avn; ivn = ivm; avn = avm;
    }
}
typedef short bf16x8 __attribute__((ext_vector_type(8)));
typedef float f32x16 __attribute__((ext_vector_type(16)));
typedef short s16x4 __attribute__((ext_vector_type(4)));
typedef LAS const char* lds_cptr;
typedef unsigned u32x2 __attribute__((ext_vector_type(2)));
constexpr int VROW = 192;
constexpr int VSLOT = 32 * VROW;
constexpr int KROW = 144;
constexpr int KSLOT = 32 * KROW;
constexpr int MIX_WAVE_LDS = 16640;
constexpr int NWM = 6;
constexpr int MIX_BIAS_OFF = NWAVES * MIX_WAVE_LDS;
DEV int crow(int r, int hi) { return (r & 3) + 8 * (r >> 2) + 4 * hi; }
DEV s16x4 vtr(lds_cptr p) { return __builtin_bit_cast(s16x4, __builtin_amdgcn_ds_read_tr16_b64_v4i16((LAS s16x4*)p)); }
DEV bf16x8 tr_frag(lds_cptr slot, int s, int blk, int lane) {
    const int h = lane >> 5; lds_cptr p = slot + (16 * s + 4 * h + ((lane & 15) >> 2)) * VROW + (32 * blk + 16 * ((lane >> 4) & 1) + 4 * (lane & 3)) * 2;
    const s16x4 lo = vtr(p), hi = vtr(p + 8 * VROW);
    return (bf16x8){lo[0], lo[1], lo[2], lo[3], hi[0], hi[1], hi[2], hi[3]};
}
DEV void load_frags(bf16x8 (&f)[4], const bf16_t* rowp, int lane) {
    const int h = lane >> 5;
#pragma unroll
    for (int st = 0; st < 4; ++st) f[st] = *(const bf16x8*)(rowp + 16 * st + 8 * h);
}
DEV bf16x8 pack_p(const f32x16& p, int s) {
    u32x4 w; w.x = pg8::cvt_pk_bf16(p[8 * s], p[8 * s + 1]); w.y = pg8::cvt_pk_bf16(p[8 * s + 2], p[8 * s + 3]); w.z = pg8::cvt_pk_bf16(p[8 * s + 4], p[8 * s + 5]); w.w = pg8::cvt_pk_bf16(p[8 * s + 6], p[8 * s + 7]);
    return __builtin_bit_cast(bf16x8, w);
}

DEV void stage_rows_k(LAS unsigned char* ks, const u32x4 (&raw)[4], int lane) {
    const int rr = lane >> 3, ch = lane & 7;
#pragma unroll
    for (int i = 0; i < 4; ++i) *(LAS u32x4*)(ks + (rr + 8 * i) * KROW + ch * 16) = raw[i];
}
DEV void read_row_frags(bf16x8 (&f)[4], const LAS unsigned char* ks, int lane) {
    const LAS unsigned char* p = ks + (lane & 31) * KROW + (lane >> 5) * 16;
#pragma unroll
    for (int st = 0; st < 4; ++st) f[st] = *(const LAS bf16x8*)(p + st * 32);
}

DEV float other_half(float x) { const auto r = __builtin_amdgcn_permlane32_swap(__float_as_uint(x), __float_as_uint(x), false, false); return (threadIdx.x & 32) ? __uint_as_float(r[0]) : __uint_as_float(r[1]); }
DEV float max_halves(float x) { const auto r = __builtin_amdgcn_permlane32_swap(__float_as_uint(x), __float_as_uint(x), false, false); return fmaxf(__uint_as_float(r[0]), __uint_as_float(r[1])); }
DEV float sum_halves(float x) { const auto r = __builtin_amdgcn_permlane32_swap(__float_as_uint(x), __float_as_uint(x), false, false); return __uint_as_float(r[0]) + __uint_as_float(r[1]); }
#define MFMA32(a, b, c) __builtin_amdgcn_mfma_f32_32x32x16_bf16((a), (b), (c), 0, 0, 0)
DEV float ex2(float x) { return __builtin_amdgcn_exp2f(x); }

struct AttnIt { int p, bh, sh, L, r, q0, kmin, kmax; };
DEV void attn_decode(int li, int x, AttnIt& d) {
    d.p = li >> 9; d.bh = 8 * x + ((li >> 6) & 7); const int qblk = li & 63;
    d.sh = 2 * d.p; d.L = S >> d.sh; const int bpr = d.L >> 6;
    d.r = qblk / bpr; d.q0 = (qblk % bpr) * 64;
    d.kmin = d.q0 >= 64 ? 0 : 2; const int km = (d.L + 63 - d.q0) >> 5; d.kmax = km > 5 ? 5 : km;
}
DEV int med3i(int v, int lo, int hi) { return v < lo ? lo : (v > hi ? hi : v); }
DEV void attn_ldrows(const bf16_t* base, const AttnIt& d, int i0, u32x4 (&v)[4], int lane) {
    const int rr = lane >> 3, ch = lane & 7; const char* hb = (const char*)(base + (size_t)d.bh * S * HD); const unsigned cst = (unsigned)(d.r * 128 + ch * 16);
#pragma unroll
    for (int i = 0; i < 4; ++i) v[i] = *(const u32x4*)(hb + (((unsigned)med3i(i0 + rr + 8 * i, 0, d.L - 1) << (d.sh + 7)) + cst));
}
DEV void attn_ldkv(const Args& a, const AttnIt& d, int kk, u32x4 (&k)[4], u32x4 (&v)[4], int lane) {
    const int rr = lane >> 3, ch = lane & 7, i0 = d.q0 - 64 + 32 * kk; const unsigned cst = (unsigned)(d.r * 128 + ch * 16);
    const char* kb = (const char*)((const bf16_t*)(a.ws + WS_AK) + (size_t)d.bh * S * HD); const char* vb = (const char*)((const bf16_t*)(a.ws + WS_AV) + (size_t)d.bh * S * HD);
#pragma unroll
    for (int i = 0; i < 4; ++i) { const unsigned off = ((unsigned)med3i(i0 + rr + 8 * i, 0, d.L - 1) << (d.sh + 7)) + cst; k[i] = *(const u32x4*)(kb + off); v[i] = *(const u32x4*)(vb + off); }
}
DEV void attn_items(const Args& a, unsigned char* lds, int wg, int G, int lane, int wave) {
    unsigned char* ws = a.ws;
    constexpr int NIT = 3 * 512; constexpr float THR = 6.f;
    const int x = wg & 7, NGW = (G >> 3) * NWM;
    int item = (wg >> 3) * NWM + wave; if (item >= NIT) return;
    LAS unsigned char* slot = (LAS unsigned char*)lds + wave * MIX_WAVE_LDS; lds_cptr slot3 = (lds_cptr)slot; LAS unsigned char* kslot = slot + VSLOT;
    const int t = lane & 31, hi = lane >> 5, rr = lane >> 3, ch = lane & 7;
    AttnIt d; attn_decode(item, x, d);
    bf16x8 qf[2][4], kf[4]; u32x4 kraw[4], vv[4];
    attn_ldkv(a, d, d.kmin, kraw, vv, lane);
    for (;;) {
        const LAS float* tph = (const LAS float*)((LAS unsigned char*)lds + MIX_BIAS_OFF) + (d.p * NH + (d.bh & 7)) * 192 + (32 + 4 * hi - t);
        f32x16 o[2][2] = {}; float m[2] = {0.f, 0.f}, l[2] = {0.f, 0.f};
        const int nitem = item + NGW; const bool hasn = nitem < NIT;
        AttnIt dn = d; if (hasn) attn_decode(nitem, x, dn);
#pragma unroll
        for (int j = 0; j < 2; ++j) { u32x4 qraw[4]; attn_ldrows((const bf16_t*)(ws + WS_AQ), d, d.q0 + 32 * j, qraw, lane); stage_rows_k(kslot, qraw, lane); asm volatile("" ::: "memory"); read_row_frags(qf[j], kslot, lane); asm volatile("" ::: "memory"); }
        for (int kk = d.kmin; kk <= d.kmax; ++kk) {
            const int kbase = d.q0 - 64 + 32 * kk;
#pragma unroll
            for (int i = 0; i < 4; ++i) *(LAS u32x4*)(slot + (rr + 8 * i) * VROW + ch * 16) = vv[i];
            stage_rows_k(kslot, kraw, lane);
            asm volatile("" ::: "memory");
            read_row_frags(kf, kslot, lane);
            const bf16x8 v00 = tr_frag(slot3, 0, 0, lane), v10 = tr_frag(slot3, 1, 0, lane), v01 = tr_frag(slot3, 0, 1, lane), v11 = tr_frag(slot3, 1, 1, lane);
            asm volatile("" ::: "memory");
            if (kk < d.kmax) attn_ldkv(a, d, kk + 1, kraw, vv, lane);
            else if (hasn) attn_ldkv(a, dn, dn.kmin, kraw, vv, lane);
            const bool edge = kbase < 0 || kbase + 31 >= d.L;
            f32x16 sc[2] = {};
#pragma unroll
            for (int st = 0; st < 4; ++st) { sc[0] = MFMA32(kf[st], qf[0][st], sc[0]); sc[1] = MFMA32(kf[st], qf[1][st], sc[1]); }
            float mx[2]; bool mv = false;
#pragma unroll
            for (int j = 0; j < 2; ++j) {
                const int kj = kk - j; const bool act = kj >= 0 && kj <= 4; const LAS float* tb = tph + 32 * (act ? kj : 0); const float moff = act ? m[j] : 1e30f;
#pragma unroll
                for (int rg = 0; rg < 16; ++rg) sc[j][rg] = (sc[j][rg] - moff) + tb[(rg & 3) + 8 * (rg >> 2)];
                if (edge) {
#pragma unroll
                    for (int rg = 0; rg < 16; ++rg) { const int ki = kbase + crow(rg, hi); sc[j][rg] = (ki >= 0 && ki < d.L) ? sc[j][rg] : -1e30f; } }
                float t0 = fmaxf(fmaxf(sc[j][0], sc[j][1]), fmaxf(sc[j][2], sc[j][3]));
#pragma unroll
                for (int rg = 4; rg < 16; rg += 4) t0 = fmaxf(t0, fmaxf(fmaxf(sc[j][rg], sc[j][rg + 1]), fmaxf(sc[j][rg + 2], sc[j][rg + 3])));
                mx[j] = max_halves(t0);
                const bool first = act && (kj == 0 || kk == d.kmin);
                mv = mv || first || (act && __any(mx[j] > THR));
            }
            if (mv) {
#pragma unroll
                for (int j = 0; j < 2; ++j) { const int kj = kk - j; const bool act = kj >= 0 && kj <= 4, first = act && (kj == 0 || kk == d.kmin);
                    const float dl = !act ? 0.f : (first ? mx[j] : fmaxf(mx[j], 0.f)), f = ex2(-dl); m[j] += dl; l[j] *= f;
#pragma unroll
                    for (int rg = 0; rg < 16; ++rg) { sc[j][rg] -= dl; o[j][0][rg] *= f; o[j][1][rg] *= f; } }
            }
#pragma unroll
            for (int j = 0; j < 2; ++j) { float ps0 = 0.f, ps1 = 0.f;
#pragma unroll
                for (int rg = 0; rg < 16; rg += 2) { sc[j][rg] = ex2(sc[j][rg]); sc[j][rg + 1] = ex2(sc[j][rg + 1]); ps0 += sc[j][rg]; ps1 += sc[j][rg + 1]; }
                l[j] += ps0 + ps1; }
            { const bf16x8 p00 = pack_p(sc[0], 0), p01 = pack_p(sc[0], 1), p10 = pack_p(sc[1], 0), p11 = pack_p(sc[1], 1);
              o[0][0] = MFMA32(v00, p00, o[0][0]); o[0][1] = MFMA32(v01, p00, o[0][1]); o[1][0] = MFMA32(v00, p10, o[1][0]); o[1][1] = MFMA32(v01, p10, o[1][1]);
              o[0][0] = MFMA32(v10, p01, o[0][0]); o[0][1] = MFMA32(v11, p01, o[0][1]); o[1][0] = MFMA32(v10, p11, o[1][0]); o[1][1] = MFMA32(v11, p11, o[1][1]); }
        }
#pragma unroll
        for (int j = 0; j < 2; ++j) {
            float lt = sum_halves(l[j]);
            const float il = 1.f / lt;
            const size_t orow = ((size_t)d.p * NB * NH + d.bh) * S + (size_t)(((d.q0 + 32 * j + t) << d.sh) + d.r);
#pragma unroll
            for (int g4 = 0; g4 < 4; ++g4) {
                *(LAS u32x2*)(kslot + t * KROW + (8 * g4 + 4 * hi) * 2) = (u32x2){pg8::cvt_pk_bf16(o[j][0][4 * g4] * il, o[j][0][4 * g4 + 1] * il), pg8::cvt_pk_bf16(o[j][0][4 * g4 + 2] * il, o[j][0][4 * g4 + 3] * il)};
                *(LAS u32x2*)(kslot + t * KROW + (32 + 8 * g4 + 4 * hi) * 2) = (u32x2){pg8::cvt_pk_bf16(o[j][1][4 * g4] * il, o[j][1][4 * g4 + 1] * il), pg8::cvt_pk_bf16(o[j][1][4 * g4 + 2] * il, o[j][1][4 * g4 + 3] * il)};
            }
            asm volatile("" ::: "memory");
            { bf16_t* ob = (bf16_t*)(ws + WS_ATTO) + ((size_t)d.p * NB * NH + d.bh) * S * HD;
#pragma unroll
              for (int i = 0; i < 4; ++i) { const u32x4 w = *(const LAS u32x4*)(kslot + (rr + 8 * i) * KROW + ch * 16);
                  *(u32x4*)(ob + (size_t)(((d.q0 + 32 * j + rr + 8 * i) << d.sh) + d.r) * HD + ch * 8) = w; } }
            asm volatile("" ::: "memory");
            if (hi == 0) ((float*)(ws + (d.p == 0 ? WS_ATTL0 : (d.p == 1 ? WS_ATTL1 : WS_ATTL2))))[(size_t)d.bh * S + (size_t)(((d.q0 + 32 * j + t) << d.sh) + d.r)] = m[j] + __log2f(lt);
        }
        if (!hasn) break;
        item = nitem; d = dn;
    }
}
DEV void retstate_item(const Args& a, unsigned char* lds, int item, int xg, int lane, int wave) {
    unsigned char* ws = a.ws;
    const int dir = item & 1, n = (item >> 1) & 31, bh = 8 * xg + (item >> 6), h = bh & 7;
    const bf16_t* Kc = (const bf16_t*)(ws + WS_RK) + ((size_t)bh * S + n * 128) * HD; const bf16_t* Vc = (const bf16_t*)(ws + WS_RV) + ((size_t)bh * S + n * 128) * HD;
    const float lg = a.in[IN_DECAY][dir * NH + h] * LOG2E;
    LAS unsigned char* vs = (LAS unsigned char*)lds + wave * MIX_WAVE_LDS; LAS unsigned char* ks = vs + VSLOT; lds_cptr vs3 = (lds_cptr)vs, ks3 = (lds_cptr)ks;
    f32x16 acc[2][2] = {};
    for (int blk = 0; blk < 4; ++blk) {
        { const int rr = lane >> 3, ch = lane & 7;
          u32x4 v[4], k[4];
#pragma unroll
          for (int i = 0; i < 4; ++i) { const int mrow = 32 * blk + rr + 8 * i; v[i] = *(const u32x4*)(Vc + (size_t)mrow * HD + ch * 8); k[i] = *(const u32x4*)(Kc + (size_t)mrow * HD + ch * 8); }
#pragma unroll
          for (int i = 0; i < 4; ++i) { const int mrow = 32 * blk + rr + 8 * i; const float z = ex2(lg * (float)(dir == 0 ? 127 - mrow : mrow));
              const unsigned kw[4] = {k[i].x, k[i].y, k[i].z, k[i].w}; u32x4 o;
              o.x = pg8::cvt_pk_bf16(bf2f(kw[0] & 0xffffu) * z, bf2f(kw[0] >> 16) * z); o.y = pg8::cvt_pk_bf16(bf2f(kw[1] & 0xffffu) * z, bf2f(kw[1] >> 16) * z);
              o.z = pg8::cvt_pk_bf16(bf2f(kw[2] & 0xffffu) * z, bf2f(kw[2] >> 16) * z); o.w = pg8::cvt_pk_bf16(bf2f(kw[3] & 0xffffu) * z, bf2f(kw[3] >> 16) * z);
              *(LAS u32x4*)(vs + (rr + 8 * i) * VROW + ch * 16) = v[i]; *(LAS u32x4*)(ks + (rr + 8 * i) * VROW + ch * 16) = o; } }
        LDS_WAIT();
#pragma unroll
        for (int s = 0; s < 2; ++s) {
            const bf16x8 v0 = tr_frag(vs3, s, 0, lane), v1 = tr_frag(vs3, s, 1, lane), k0 = tr_frag(ks3, s, 0, lane), k1 = tr_frag(ks3, s, 1, lane);
            acc[0][0] = MFMA32(v0, k0, acc[0][0]); acc[0][1] = MFMA32(v0, k1, acc[0][1]); acc[1][0] = MFMA32(v1, k0, acc[1][0]); acc[1][1] = MFMA32(v1, k1, acc[1][1]);
        }
        LDS_WAIT();
    }
    bf16_t* KT = (bf16_t*)(ws + WS_KF) + (((size_t)dir * NB * NH + bh) * 32 + n) * 4096;
    const int c = lane & 31, hi = lane >> 5;
#pragma unroll
    for (int eb = 0; eb < 2; ++eb)
#pragma unroll
        for (int db = 0; db < 2; ++db)
#pragma unroll
            for (int rg = 0; rg < 16; ++rg) KT[(32 * eb + crow(rg, hi)) * 64 + 32 * db + c] = (bf16_t)f2bf(acc[eb][db][rg]);
}
DEV void phase_scan(const Args& a, int xg, int gtid, int NT) {
    unsigned char* ws = a.ws;
    for (int sl = gtid; sl < 2 * NH * 1024; sl += NT) {
        const int dir = sl >> 13, bh = 8 * xg + ((sl >> 10) & 7), q = sl & 1023, h = bh & 7;
        const float gC = ex2(a.in[IN_DECAY][dir * NH + h] * LOG2E * 128.f);
        const uint2* kt = (const uint2*)(ws + WS_KF) + ((size_t)dir * NB * NH + bh) * 32 * 1024 + q;
        uint2* st = (uint2*)(ws + st_off(dir, bh, 0)) + q;
        float4 s = make_float4(0.f, 0.f, 0.f, 0.f);
        for (int i = 0; i < 32; ++i) { const int n = dir == 0 ? i : 31 - i;
            st[(size_t)n * 1024] = make_uint2(pg8::cvt_pk_bf16(s.x, s.y), pg8::cvt_pk_bf16(s.z, s.w));
            const uint2 kv = kt[(size_t)n * 1024];
            s.x = gC * s.x + bf2f(kv.x & 0xffffu); s.y = gC * s.y + bf2f(kv.x >> 16); s.z = gC * s.z + bf2f(kv.y & 0xffffu); s.w = gC * s.w + bf2f(kv.y >> 16); }
    }
}
DEV void ld_rows32(const bf16_t* base, u32x4 (&v)[4], int lane) {
    const char* b = (const char*)base; const unsigned off = (unsigned)((lane >> 3) * 128 + (lane & 7) * 16);
#pragma unroll
    for (int i = 0; i < 4; ++i) v[i] = *(const u32x4*)(b + off + i * 1024);
}
DEV void retout_item(const Args& a, unsigned char* lds, int item, int xg, int lane, int wave) {
    unsigned char* ws = a.ws;
    const int hq = item & 1, n = (item >> 1) & 31, bh = 8 * xg + (item >> 6), h = bh & 7, b = bh >> 3;
    const bf16_t* Qc = (const bf16_t*)(ws + WS_RQ) + ((size_t)bh * S + n * 128) * HD; const bf16_t* Kc = (const bf16_t*)(ws + WS_RK) + ((size_t)bh * S + n * 128) * HD;
    const bf16_t* Vc = (const bf16_t*)(ws + WS_RV) + ((size_t)bh * S + n * 128) * HD; const bf16_t* Gc = (const bf16_t*)(ws + WS_RG) + ((size_t)bh * S + n * 128) * HD;
    const bf16_t* SF = (const bf16_t*)(ws + st_off(0, bh, n)); const bf16_t* SB = (const bf16_t*)(ws + st_off(1, bh, n));
    const float lg0 = a.in[IN_DECAY][h] * LOG2E, lg1 = a.in[IN_DECAY][NH + h] * LOG2E;
    LAS unsigned char* slot = (LAS unsigned char*)lds + wave * MIX_WAVE_LDS; lds_cptr slot3 = (lds_cptr)slot; LAS unsigned char* kslot = slot + VSLOT;
    const int t = lane & 31, hi = lane >> 5, rr = lane >> 3, ch = lane & 7;
    bf16x8 qf[2][4];
#pragma unroll
    for (int j = 0; j < 2; ++j) { u32x4 raw[4]; ld_rows32(Qc + (size_t)(64 * hq + 32 * j) * HD, raw, lane); stage_rows_k(kslot, raw, lane); asm volatile("" ::: "memory"); read_row_frags(qf[j], kslot, lane); asm volatile("" ::: "memory"); }
    f32x16 o[2][2] = {};
#pragma unroll
    for (int dir = 0; dir < 2; ++dir) {
#pragma unroll
        for (int eb = 0; eb < 2; ++eb) { u32x4 raw[4]; bf16x8 sf[4]; ld_rows32((dir == 0 ? SF : SB) + (size_t)(32 * eb) * 64, raw, lane); stage_rows_k(kslot, raw, lane); asm volatile("" ::: "memory"); read_row_frags(sf, kslot, lane); asm volatile("" ::: "memory");
#pragma unroll
            for (int j = 0; j < 2; ++j)
#pragma unroll
                for (int st = 0; st < 4; ++st) o[j][eb] = MFMA32(sf[st], qf[j][st], o[j][eb]); }
#pragma unroll
        for (int j = 0; j < 2; ++j) { const int c = 64 * hq + 32 * j + t; const float f = dir == 0 ? ex2(lg0 * (float)(c + 1) - lg1 * (float)(128 - c)) : ex2(lg1 * (float)(128 - c));
#pragma unroll
            for (int rg = 0; rg < 16; ++rg) { o[j][0][rg] *= f; o[j][1][rg] *= f; } }
    }
    float f1[4], f2[4], b1[4], b2[4];
#pragma unroll
    for (int i = 0; i < 4; ++i) { f1[i] = __builtin_bit_cast(float, __builtin_amdgcn_readfirstlane(__builtin_bit_cast(int, ex2(-lg0 * (float)i)))); f2[i] = __builtin_bit_cast(float, __builtin_amdgcn_readfirstlane(__builtin_bit_cast(int, ex2(-lg0 * (float)(8 * i)))));
        b1[i] = __builtin_bit_cast(float, __builtin_amdgcn_readfirstlane(__builtin_bit_cast(int, ex2(lg1 * (float)i)))); b2[i] = __builtin_bit_cast(float, __builtin_amdgcn_readfirstlane(__builtin_bit_cast(int, ex2(lg1 * (float)(8 * i))))); }
#pragma nounroll
    for (int kb = 0; kb < 4; ++kb) {
        { u32x4 kraw[4], vv[4]; ld_rows32(Kc + (size_t)(32 * kb) * HD, kraw, lane); ld_rows32(Vc + (size_t)(32 * kb) * HD, vv, lane);
#pragma unroll
        for (int i = 0; i < 4; ++i) *(LAS u32x4*)(slot + (rr + 8 * i) * VROW + ch * 16) = vv[i];
        stage_rows_k(kslot, kraw, lane); }
        asm volatile("" ::: "memory");
        bf16x8 kf[4]; read_row_frags(kf, kslot, lane);
        const bf16x8 v00 = tr_frag(slot3, 0, 0, lane), v10 = tr_frag(slot3, 1, 0, lane), v01 = tr_frag(slot3, 0, 1, lane), v11 = tr_frag(slot3, 1, 1, lane);
        asm volatile("" ::: "memory");
#pragma unroll
        for (int j = 0; j < 2; ++j) {
            const int qbi = 2 * hq + j;
            f32x16 sc = {};
#pragma unroll
            for (int st = 0; st < 4; ++st) sc = MFMA32(kf[st], qf[j][st], sc);
            if (kb < qbi) { const float A = ex2(lg0 * (float)(32 * (qbi - kb) + t - 4 * hi)); float a2[4];
#pragma unroll
                for (int q = 0; q < 4; ++q) a2[q] = A * f2[q];
#pragma unroll
                for (int rg = 0; rg < 16; ++rg) sc[rg] *= a2[rg >> 2] * f1[rg & 3];
            } else if (kb > qbi) { const float A = ex2(lg1 * (float)(32 * (kb - qbi) - t + 4 * hi)); float a2[4];
#pragma unroll
                for (int q = 0; q < 4; ++q) a2[q] = A * b2[q];
#pragma unroll
                for (int rg = 0; rg < 16; ++rg) sc[rg] *= a2[rg >> 2] * b1[rg & 3];
            } else {
                int tt = t - 4 * hi; asm volatile("" : "+v"(tt));
#pragma unroll
                for (int rg = 0; rg < 16; ++rg) { const int df = tt - ((rg & 3) + 8 * (rg >> 2)); sc[rg] *= df >= 0 ? ex2(lg0 * (float)df) : ex2(lg1 * (float)(-df)); }
            }
            const bf16x8 p0 = pack_p(sc, 0), p1 = pack_p(sc, 1);
            o[j][0] = MFMA32(v00, p0, o[j][0]); o[j][0] = MFMA32(v10, p1, o[j][0]);
            o[j][1] = MFMA32(v01, p0, o[j][1]); o[j][1] = MFMA32(v11, p1, o[j][1]);
        }
    }
    const float* gn = a.in[IN_GN] + h * HD; const unsigned gnoff = (unsigned)(16 * hi); LAS unsigned char* kq = kslot + t * KROW + 8 * hi;
#pragma unroll
    for (int j = 0; j < 2; ++j) {
        const int r0 = n * 128 + 64 * hq + 32 * j;
        { u32x4 raw[4]; ld_rows32(Gc + (size_t)(64 * hq + 32 * j) * HD, raw, lane); stage_rows_k(kslot, raw, lane); asm volatile("" ::: "memory"); }
        float sm = 0.f;
#pragma unroll
        for (int rg = 0; rg < 16; ++rg) sm += o[j][0][rg] + o[j][1][rg];
        sm = sum_halves(sm); const float mu = sm * (1.f / 64.f); float vq = 0.f;
#pragma unroll
        for (int rg = 0; rg < 16; ++rg) { const float d0 = o[j][0][rg] - mu, d1 = o[j][1][rg] - mu; vq += d0 * d0 + d1 * d1; }
        vq = sum_halves(vq); const float rstd = rsqrtf(vq * (1.f / 64.f) + EPS);
        u32x2 ow[2][4];
#pragma unroll
        for (int db = 0; db < 2; ++db)
#pragma unroll
            for (int g4 = 0; g4 < 4; ++g4) { const u32x2 gw = *(const LAS u32x2*)(kq + (32 * db + 8 * g4) * 2); const float4 gg = *(const float4*)((const char*)gn + gnoff + (32 * db + 8 * g4) * 4);
                const float gate[4] = {bf2f(gw[0] & 0xffffu), bf2f(gw[0] >> 16), bf2f(gw[1] & 0xffffu), bf2f(gw[1] >> 16)}; const float gv[4] = {gg.x, gg.y, gg.z, gg.w}; float ov[4];
#pragma unroll
                for (int i = 0; i < 4; ++i) ov[i] = (o[j][db][4 * g4 + i] - mu) * rstd * gv[i] * (gate[i] * __builtin_amdgcn_rcpf(1.f + ex2(-gate[i] * LOG2E)));
                ow[db][g4] = (u32x2){pg8::cvt_pk_bf16(ov[0], ov[1]), pg8::cvt_pk_bf16(ov[2], ov[3])}; }
        asm volatile("" ::: "memory");
#pragma unroll
        for (int db = 0; db < 2; ++db)
#pragma unroll
            for (int g4 = 0; g4 < 4; ++g4) *(LAS u32x2*)(kq + (32 * db + 8 * g4) * 2) = ow[db][g4];
        asm volatile("" ::: "memory");
        { bf16_t* ob = (bf16_t*)(ws + WS_XN) + ((size_t)b * S + r0) * D + h * HD;
#pragma unroll
          for (int i = 0; i < 4; ++i) { const u32x4 w = *(const LAS u32x4*)(kslot + (rr + 8 * i) * KROW + ch * 16); *(u32x4*)(ob + (size_t)(rr + 8 * i) * D + ch * 8) = w; } }
        asm volatile("" ::: "memory");
    }
}
DEV void phase_attn_merge(const Args& a, int xg, int gtid, int NT) {
    unsigned char* ws = a.ws; const bf16_t* O = (const bf16_t*)(ws + WS_ATTO); bf16_t* mixed = (bf16_t*)(ws + WS_XN);
    for (int it = gtid; it < NH * S * 8; it += NT) {
        const int ch = it & 7, row = xg * NH * S + (it >> 3);
        const int bh = row >> 12, pos = row & 4095, b = bh >> 3, h = bh & 7;
        const float l0 = ((const float*)(ws + WS_ATTL0))[row], l1 = ((const float*)(ws + WS_ATTL1))[row], l2 = ((const float*)(ws + WS_ATTL2))[row];
        const float mx = fmaxf(l0, fmaxf(l1, l2)); float w0 = ex2(l0 - mx), w1 = ex2(l1 - mx), w2 = ex2(l2 - mx); const float is = 1.f / (w0 + w1 + w2); w0 *= is; w1 *= is; w2 *= is;
        const uint4 a0 = *(const uint4*)(O + (size_t)row * HD + ch * 8), a1 = *(const uint4*)(O + ((size_t)NB * NH * S + row) * HD + ch * 8), a2 = *(const uint4*)(O + ((size_t)2 * NB * NH * S + row) * HD + ch * 8);
        const unsigned x0[4] = {a0.x, a0.y, a0.z, a0.w}, x1[4] = {a1.x, a1.y, a1.z, a1.w}, x2[4] = {a2.x, a2.y, a2.z, a2.w}; unsigned o[4];
#pragma unroll
        for (int j = 0; j < 4; ++j) o[j] = pg8::cvt_pk_bf16(w0 * bf2f(x0[j] & 0xffffu) + w1 * bf2f(x1[j] & 0xffffu) + w2 * bf2f(x2[j] & 0xffffu), w0 * bf2f(x0[j] >> 16) + w1 * bf2f(x1[j] >> 16) + w2 * bf2f(x2[j] >> 16));
        *(uint4*)(mixed + ((size_t)b * S + pos) * D + 512 + h * HD + ch * 8) = make_uint4(o[0], o[1], o[2], o[3]);
    }
}
DEV void phase_mix_a(const Args& a, unsigned char* lds, int wg, int G, int lane, int wave, int tid) {
    { const float* bt = (const float*)(a.ws + WS_BIAS); LAS float* bl = (LAS float*)((LAS unsigned char*)lds + MIX_BIAS_OFF);
      for (int i = tid; i < 3 * NH * 192; i += NTHR) { const int ph = i / 192, bi = i % 192 - 32; bl[i] = (bi >= 0 && bi <= 128) ? bt[ph * 129 + bi] : -1e30f; } }
    __syncthreads();
    if (wave >= NWM) {
        for (int rep = 0; rep < a.rep[5]; ++rep) { asm volatile("" : "+v"(lane)); phase_latew(a, lds, wg * (NWAVES - NWM) + (wave - NWM), G * (NWAVES - NWM), lane, wave); }
        return;
    }
    const int x = wg & 7, wq = (wg >> 3) * NWM + wave, WPX = (G >> 3) * NWM;
    for (int rep = 0; rep < a.rep[0]; ++rep) { asm volatile("" : "+v"(lane)); for (int it = wq; it < 2 * 32 * NH; it += WPX) retstate_item(a, lds, it, x, lane, wave); }
    for (int rep = 0; rep < a.rep[1]; ++rep) { asm volatile("" : "+v"(lane)); attn_items(a, lds, wg, G, lane, wave); }
}
DEV void phase_mix_b(const Args& a, unsigned char* lds, int wg, int G, int lane, int wave, int tid) {
    const int x = wg & 7, wq = (wg >> 3) * NWAVES + wave, WPX = (G >> 3) * NWAVES;
    for (int rep = 0; rep < a.rep[2]; ++rep) { asm volatile("" : "+v"(lane)); for (int it = wq; it < NH * 32 * 2; it += WPX) retout_item(a, lds, it, x, lane, wave); }
    for (int rep = 0; rep < a.rep[3]; ++rep) { asm volatile("" : "+v"(tid)); phase_attn_merge(a, x, (wg >> 3) * NTHR + tid, (G >> 3) * NTHR); }
}
#define XB_TMO      128
#define XB_XCNT(j)  (256  + 64 * (j))
#define XB_XSUB(j)  (1280 + 64 * (j))
#define XB_XGEN(j)  (2304 + 64 * (j))
#define XB_TOP      3328
#define XB_TOPGEN   3392
#define XCD_BAR_WORDS 3456
#define XB_SPIN_CAP (1u << 18)

__device__ __forceinline__ unsigned xb_ld(unsigned* p)              { return __hip_atomic_load(p, __ATOMIC_RELAXED, __HIP_MEMORY_SCOPE_AGENT); }
__device__ __forceinline__ unsigned xb_add(unsigned* p, unsigned v) { return __hip_atomic_fetch_add(p, v, __ATOMIC_RELAXED, __HIP_MEMORY_SCOPE_AGENT); }
__device__ __forceinline__ unsigned xb_xcc_id() { return (unsigned)__builtin_amdgcn_s_getreg((3 << 11) | 20) & 0xFu; }
#define XB_SPIN(cond, bar) do { unsigned _sp = 0; while (cond) { __builtin_amdgcn_s_sleep(1); \
    if ((++_sp & 255u) == 0u) { if (xb_ld(&(bar)[XB_TMO])) break; if (_sp > XB_SPIN_CAP) { atomicAdd(&(bar)[XB_TMO], 1u); break; } } } } while (0)

struct XcdBarrier {
    unsigned* bar; unsigned x;
    volatile LAS unsigned* st;
};

__device__ __forceinline__ XcdBarrier xcd_barrier_post(unsigned* bar, volatile LAS unsigned* st) {
    XcdBarrier b; b.bar = bar; b.x = xb_xcc_id(); b.st = st;
    if (threadIdx.x == 0) (void)xb_add(&bar[XB_XCNT(b.x)], 1u);
    return b;
}
__device__ __forceinline__ void xcd_barrier_complete(unsigned* bar, unsigned x, unsigned& nloc, unsigned& nx) {
    const unsigned G = gridDim.x * gridDim.y * gridDim.z;
    unsigned sum, cnt, mine, sp = 0u;
    for (;;) {
        sum = 0u; cnt = 0u; mine = 0u;
#pragma unroll
        for (unsigned j = 0; j < 16; ++j) { const unsigned c = xb_ld(&bar[XB_XCNT(j)]); sum += c; cnt += (c > 0u) ? 1u : 0u; mine = (j == x) ? c : mine; }
        if (sum == G) break;
        __builtin_amdgcn_s_sleep(1);
        if ((++sp & 255u) == 0u) { if (xb_ld(&bar[XB_TMO])) break; if (sp > XB_SPIN_CAP) { atomicAdd(&bar[XB_TMO], 1u); break; } }
    }
    nloc = mine > 0u ? mine : 1u; nx = cnt > 0u ? cnt : 1u;
}

__device__ __forceinline__ void xcd_barrier(const XcdBarrier& b) {
    asm volatile("s_waitcnt vmcnt(0)" ::: "memory");
    __syncthreads();
    if (threadIdx.x == 0) {
        unsigned* bar = b.bar;
        __builtin_amdgcn_s_waitcnt(0);
        unsigned nloc = b.st[0], nx = b.st[1];
        if (nloc == 0u) { xcd_barrier_complete(bar, b.x, nloc, nx); b.st[0] = nloc; b.st[1] = nx; }
        const unsigned old = xb_add(&bar[XB_XSUB(b.x)], 1u);
        const unsigned gen = old / nloc;
        if (old + 1u == (gen + 1u) * nloc) {
            __builtin_amdgcn_fence(__ATOMIC_RELEASE, "agent");
            asm volatile("s_waitcnt vmcnt(0)" ::: "memory");
            const unsigned og = xb_add(&bar[XB_TOP], 1u);
            const unsigned tg = og / nx;
            if (og + 1u == (tg + 1u) * nx) xb_add(&bar[XB_TOPGEN], 1u);
            else XB_SPIN(xb_ld(&bar[XB_TOPGEN]) == tg, bar);
            __builtin_amdgcn_fence(__ATOMIC_ACQUIRE, "agent");
            xb_add(&bar[XB_XGEN(b.x)], 1u);
            asm volatile("s_waitcnt vmcnt(0)" ::: "memory");
        } else {
            XB_SPIN(xb_ld(&bar[XB_XGEN(b.x)]) == gen, bar);
            __builtin_amdgcn_fence(__ATOMIC_ACQUIRE, "agent");
            asm volatile("s_waitcnt vmcnt(0)" ::: "memory");
        }
    }
    __syncthreads();
}


#define GB_GC(g)     (8192 + 64 * (g))
#define GB_N(g, j)   (9216 + 16 * (16 * (g) + (j)))
#define GB_A(g, j)   (11264 + 16 * (16 * (g) + (j)))
struct GroupBarrier { unsigned* ctl; unsigned g, x, ng; volatile LAS unsigned* st; };
__device__ __forceinline__ GroupBarrier group_barrier_post(unsigned* ctl, unsigned g, unsigned ng, volatile LAS unsigned* st) {
    GroupBarrier b; b.ctl = ctl; b.g = g; b.x = xb_xcc_id(); b.ng = ng; b.st = st;
    if (threadIdx.x == 0) (void)xb_add(&ctl[GB_N(g, b.x)], 1u);
    return b;
}
__device__ __forceinline__ void group_barrier(const GroupBarrier& b, unsigned epoch) {
    asm volatile("s_waitcnt vmcnt(0)" ::: "memory");
    __syncthreads();
    if (threadIdx.x == 0) {
        unsigned* ctl = b.ctl; unsigned n = b.st[0];
        if (n == 0u) {
            unsigned sp = 0u;
            for (;;) { unsigned sum = 0u, mine = 0u;
#pragma unroll
                for (unsigned j = 0; j < 16; ++j) { const unsigned c = xb_ld(&ctl[GB_N(b.g, j)]); sum += c; mine = (j == b.x) ? c : mine; }
                n = mine; if (sum == b.ng) break;
                __builtin_amdgcn_s_sleep(1); if (++sp > (1u << 22)) break; }
            n = n ? n : 1u; b.st[0] = n;
        }
        const unsigned old = xb_add(&ctl[GB_A(b.g, b.x)], 1u);
        if (old + 1u == epoch * n) {
            __builtin_amdgcn_fence(__ATOMIC_RELEASE, "agent");
            asm volatile("s_waitcnt vmcnt(0)" ::: "memory");
            (void)xb_add(&ctl[GB_GC(b.g)], n);
        }
        unsigned sp = 0u; const unsigned target = epoch * b.ng;
        while (xb_ld(&ctl[GB_GC(b.g)]) < target) { __builtin_amdgcn_s_sleep(1); if (++sp > (1u << 22)) break; }
        __builtin_amdgcn_fence(__ATOMIC_ACQUIRE, "agent");
        asm volatile("s_waitcnt vmcnt(0)" ::: "memory");
    }
    __syncthreads();
}
#ifndef MK_LAUNCHES
#define MK_LAUNCHES 1
#endif
#ifndef WGM_MOE1
#define WGM_MOE1 8
#endif
#ifndef WGM_MOE2
#define WGM_MOE2 8
#endif
constexpr int NPH = 11;
typedef const __attribute__((address_space(4))) Args* kargs_t;
DEV Args load_args(kargs_t kp) { Args a;
#pragma unroll
    for (int i = 0; i < 13; ++i) a.in[i] = kp->in[i];
    a.out = kp->out; a.ws = kp->ws; a.ph_lo = kp->ph_lo; a.ph_hi = kp->ph_hi;
#pragma unroll
    for (int i = 0; i < 16; ++i) a.rep[i] = kp->rep[i];
    return a; }
__global__ void __launch_bounds__(NTHR, 2) mega(Args a_) {
    kargs_t kp = (kargs_t)__builtin_amdgcn_kernarg_segment_ptr();
    extern __shared__ __attribute__((aligned(16))) unsigned char lds[];
    int tid = threadIdx.x, lane = tid & 63, wave = __builtin_amdgcn_readfirstlane(tid >> 6);
    const int G = gridDim.x, wg = blockIdx.x, NGW = G * NWAVES; int gw = wg * NWAVES + wave;
#define FRESH_IDS() do { tid = threadIdx.x; asm volatile("" : "+v"(tid)); lane = tid & 63; wave = __builtin_amdgcn_readfirstlane(tid >> 6); gw = wg * NWAVES + wave; } while (0)
    const int lo = kp->ph_lo, hi = kp->ph_hi;
    unsigned char* ws = kp->ws;
    volatile LAS unsigned* bst = (volatile LAS unsigned*)((LAS unsigned char*)lds + LDS_BYTES - 64);
    if (tid < 4) bst[tid] = 0u;
    __syncthreads();
    XcdBarrier bar = xcd_barrier_post((unsigned*)(ws + WS_CTL) + 4096, bst);
    const GroupBarrier gbar = group_barrier_post((unsigned*)(ws + WS_CTL), (unsigned)(wg & 7), (unsigned)(G >> 3), bst + 2);
#define IN(k) (lo <= (k) && (k) < hi)
#define SEAM(k) do { if (IN(k) && IN((k) + 1)) { if ((k) >= 1 && (k) <= 6) group_barrier(gbar, (unsigned)(k)); else xcd_barrier(bar); } } while (0)
    if (IN(0)) { FRESH_IDS(); const Args a = load_args(kp); unsigned char* ws = a.ws; for (int r = 0; r < a.rep[6]; ++r) { FRESH_IDS(); phase_prep(a, lds, gw, NGW, lane, wave); } }
    SEAM(0);
    if (IN(1)) { FRESH_IDS(); const Args a = load_args(kp); unsigned char* ws = a.ws; pg8::Gemm g{(const bf16_t*)(ws + WS_XN), (const bf16_t*)(ws + WS_WIN), D}; SchedPlain Sc; Sc.init(M, PC, G, wg); Sc.rowbytes = D * 2;
        EpiInProj E{ws, (const float*)(ws + WS_ROPE)};
        for (int r = 0; r < a.rep[8]; ++r) { FRESH_IDS(); pg8::Gemm g2 = g; asm volatile("" : "+s"(g2.A), "+s"(g2.Bt)); pg8::gemm_phase<EpiInProj, SchedPlain, true>((LAS unsigned char*)lds, g2, Sc, E); } }
    SEAM(1);
    if (IN(2)) { FRESH_IDS(); const Args a = load_args(kp); unsigned char* ws = a.ws; phase_mix_a(a, lds, wg, G, lane, wave, tid); }
    SEAM(2);
    if (IN(3)) { FRESH_IDS(); const Args a = load_args(kp); unsigned char* ws = a.ws; for (int r = 0; r < a.rep[13]; ++r) { FRESH_IDS(); phase_scan(a, wg & 7, (wg >> 3) * NTHR + tid, (G >> 3) * NTHR); } }
    SEAM(3);
    if (IN(4)) { FRESH_IDS(); const Args a = load_args(kp); unsigned char* ws = a.ws; phase_mix_b(a, lds, wg, G, lane, wave, tid); }
    SEAM(4);
    { const Args a = load_args(kp); for (int r = 0; r < a.rep[14]; ++r) xcd_barrier(bar); for (int r = 0; r < a.rep[15]; ++r) cg::this_grid().sync(); }
    if (IN(5)) { FRESH_IDS(); const Args a = load_args(kp); unsigned char* ws = a.ws; pg8::Gemm g{(const bf16_t*)(ws + WS_XN), (const bf16_t*)(ws + WS_WOUT), D}; SchedPlain Sc; Sc.init(M, D, G, wg); Sc.rowbytes = D * 2;
        EpiOutProj E{a.in[IN_X], ws};
        for (int r = 0; r < a.rep[9]; ++r) { FRESH_IDS(); pg8::Gemm g2 = g; asm volatile("" : "+s"(g2.A), "+s"(g2.Bt)); pg8::gemm_phase<EpiOutProj, SchedPlain, true>((LAS unsigned char*)lds, g2, Sc, E); } }
    SEAM(5);
    if (IN(6)) { FRESH_IDS(); const Args a = load_args(kp); unsigned char* ws = a.ws; for (int r = 0; r < a.rep[4]; ++r) { FRESH_IDS(); phase_router(a, lds, wg & 7, (wg >> 3) * NWAVES + wave, (G >> 3) * NWAVES, lane, tid); } }
    SEAM(6);
    if (IN(7)) { FRESH_IDS(); const Args a = load_args(kp); unsigned char* ws = a.ws; for (int r = 0; r < a.rep[7]; ++r) { FRESH_IDS(); phase_topk(a, lds, wg, G, tid, lane, wave); } }
    SEAM(7);
    if (IN(8)) { FRESH_IDS(); const Args a = load_args(kp); unsigned char* ws = a.ws; pg8::Gemm g{(const bf16_t*)(ws + WS_XN), (const bf16_t*)(ws + WS_WGU), D}; SchedMoe1 Sc; Sc.init(MR, 4096, G, wg, WGM_MOE1); Sc.idxl = (const LAS int*)((LAS unsigned char*)lds + 131072);
        { const int* idxg = (const int*)(ws + WS_IDX); LAS int* il = (LAS int*)((LAS unsigned char*)lds + 131072); pg8::Unit uu;
          for (int i = 0; i < 16; ++i) if (Sc.next(i, uu) && tid < 256) il[i * 256 + tid] = idxg[uu.pm * 256 + tid];
          __syncthreads(); }
        EpiSwiGLU E{ws + WS_HID};
        for (int r = 0; r < a.rep[10]; ++r) { FRESH_IDS(); pg8::Gemm g2 = g; asm volatile("" : "+s"(g2.A), "+s"(g2.Bt)); pg8::gemm_phase<EpiSwiGLU, SchedMoe1, true, true>((LAS unsigned char*)lds, g2, Sc, E); } }
    SEAM(8);
    if (IN(9)) { FRESH_IDS(); const Args a = load_args(kp); unsigned char* ws = a.ws; pg8::Gemm g{(const bf16_t*)(ws + WS_HID), (const bf16_t*)(ws + WS_WD), DFF}; SchedMoe2 Sc; Sc.init(MR, D, G, wg, WGM_MOE2);
        EpiDown E{ws + WS_Y};
        for (int r = 0; r < a.rep[11]; ++r) { FRESH_IDS(); pg8::Gemm g2 = g; asm volatile("" : "+s"(g2.A), "+s"(g2.Bt)); pg8::gemm_phase<EpiDown, SchedMoe2, true, true>((LAS unsigned char*)lds, g2, Sc, E); } }
    SEAM(9);
    if (IN(10)) { FRESH_IDS(); const Args a = load_args(kp); unsigned char* ws = a.ws; for (int r = 0; r < a.rep[12]; ++r) { FRESH_IDS(); phase_final(a, gw, NGW, lane); } }
#undef IN
#undef SEAM
}

extern "C" void kernel_launch(void* const* d_in, const int* in_sizes, int n_in, void* d_out, int out_size, void* d_ws, size_t ws_size, hipStream_t stream) {
    static int grid = 0;
    if (grid == 0) {
        if (n_in != 13 || in_sizes[0] != M * D || out_size != M * D || ws_size < WS_END) { fprintf(stderr, "kernel_launch: unexpected shapes n_in %d in0 %d out %d ws %zu (need %zu)\n", n_in, n_in > 0 ? in_sizes[0] : -1, out_size, ws_size, (size_t)WS_END); grid = -1; return; }
        int dev = 0, cus = 0, per_cu = 0;
        (void)hipGetDevice(&dev); (void)hipDeviceGetAttribute(&cus, hipDeviceAttributeMultiprocessorCount, dev);
        (void)hipFuncSetAttribute((const void*)mega, hipFuncAttributeMaxDynamicSharedMemorySize, LDS_BYTES);
        if (hipOccupancyMaxActiveBlocksPerMultiprocessor(&per_cu, (const void*)mega, NTHR, LDS_BYTES) != hipSuccess || per_cu < 1) { fprintf(stderr, "kernel_launch: occupancy query says %d blocks/CU\n", per_cu); per_cu = 1; }
        (void)hipGetLastError();
        grid = cus * 1;
        if (grid > cus * per_cu) grid = cus * per_cu;
    }
    if (grid < 0) return;
    (void)hipMemsetAsync((char*)d_ws + WS_CTL + 16384, 0, 49152, stream);
    Args a{};
    for (int i = 0; i < 13; ++i) a.in[i] = (const float*)d_in[i];
    a.out = (float*)d_out; a.ws = (unsigned char*)d_ws;
#ifndef PROBE_R
#define PROBE_R {1, 1, 1, 1, 1, 1, 1, 1, 1, 1, 1, 1, 1, 1, 0, 0}
#endif
    { const int rr[16] = PROBE_R; for (int i = 0; i < 16; ++i) a.rep[i] = rr[i]; }
#if MK_LAUNCHES == 1
    a.ph_lo = 0; a.ph_hi = NPH;
    void* args[] = {&a};
    hipError_t e = hipLaunchCooperativeKernel((const void*)mega, dim3(grid), dim3(NTHR), args, LDS_BYTES, stream);
    if (e != hipSuccess) fprintf(stderr, "cooperative launch failed: %s (grid %d)\n", hipGetErrorString(e), grid);
#else
    for (int p = 0; p < NPH; ++p) { a.ph_lo = p; a.ph_hi = p + 1; hipLaunchKernelGGL(mega, dim3(grid), dim3(NTHR), LDS_BYTES, stream, a); }
#endif
}
```

```cpp
#include <hip/hip_runtime.h>
#include <hip/hip_cooperative_groups.h>
#include <cstdint>
#include <cstdio>
namespace cg = cooperative_groups;

typedef unsigned short bf16_t;
#define DEV __device__ __forceinline__
#define LAS __attribute__((address_space(3)))

constexpr int NB = 8, S = 4096, D = 1024, M = NB * S;
constexpr int NH = 8, HD = 64, PC = 3584;
constexpr int NE = 16, CAP = 512, DFF = 2048, MR = NE * NB * CAP;
constexpr float EPS = 1e-6f, LOG2E = 1.4426950408889634f;
constexpr int NWAVES = 8, NTHR = 512;
constexpr int LDS_BYTES = 163840;

constexpr size_t MiB = 1u << 20;
constexpr size_t WS_CTL = 0;
constexpr size_t WS_ROPE = 1 * MiB;
constexpr size_t WS_BIAS = 64 * 1024;
constexpr size_t WS_IDX = 128 * 1024;
constexpr size_t WS_AFF = 3 * MiB;
constexpr size_t WS_INV = 5 * MiB;
constexpr size_t WS_WOUT = 7 * MiB;
constexpr size_t WS_WIN = 9 * MiB;
constexpr size_t WS_XN = 16 * MiB;
constexpr size_t WS_RQ = 80 * MiB, WS_RK = 112 * MiB, WS_RV = 144 * MiB, WS_RG = 176 * MiB;
constexpr size_t WS_AQ = 208 * MiB, WS_AK = 240 * MiB, WS_AV = 272 * MiB;
constexpr size_t WS_ATTO = 304 * MiB;
constexpr size_t WS_ATTL0 = 528 * MiB, WS_ATTL1 = 529 * MiB, WS_ATTL2 = 2 * MiB;
constexpr size_t WS_KF = 400 * MiB;
constexpr size_t WS_WD = 432 * MiB;
constexpr size_t WS_WGU = 464 * MiB;
constexpr size_t WS_Y = 144 * MiB;
constexpr size_t WS_HID = 272 * MiB;
constexpr size_t WS_END = 530 * MiB;
DEV size_t x1_off(int row) { const int b = row >> 12, s = row & 4095; return (s < 2048 ? WS_RQ : WS_RK) + (size_t)b * 4 * MiB + (size_t)(s & 2047) * 2048; }
DEV size_t afft_off(int b, int e) { return WS_AQ + (size_t)b * 4 * MiB + (size_t)e * S * 4; }
DEV size_t st_off(int dir, int bh, int n) { return WS_AQ + (size_t)(bh >> 3) * 4 * MiB + ((size_t)((dir * NH + (bh & 7)) * 32 + n)) * 8192; }

DEV unsigned f2bf(float f) { unsigned u = __float_as_uint(f); return (u + 0x7fffu + ((u >> 16) & 1u)) >> 16; }
DEV float bf2f(unsigned h) { return __uint_as_float(h << 16); }
DEV unsigned pk2(float lo, float hi) { return f2bf(lo) | (f2bf(hi) << 16); }
#define DPPF(x, ctrl) __builtin_bit_cast(float, __builtin_amdgcn_update_dpp(__builtin_bit_cast(int, (x)), __builtin_bit_cast(int, (x)), (ctrl), 0xF, 0xF, false))
DEV float lane_x1(float x) { return DPPF(x, 0xB1); }
DEV float lane_x2(float x) { return DPPF(x, 0x4E); }
DEV float lane_m8(float x) { return DPPF(x, 0x141); }
DEV float lane_x8(float x) { return DPPF(x, 0x128); }
DEV float lane_x16(float x) { const auto r = __builtin_amdgcn_permlane16_swap(__float_as_uint(x), __float_as_uint(x), false, false); return (threadIdx.x & 16) ? __uint_as_float(r[0]) : __uint_as_float(r[1]); }
DEV float lane_x32(float x) { const auto r = __builtin_amdgcn_permlane32_swap(__float_as_uint(x), __float_as_uint(x), false, false); return (threadIdx.x & 32) ? __uint_as_float(r[0]) : __uint_as_float(r[1]); }
DEV float wave_sum(float v) {
    v += lane_x1(v); v += lane_x2(v); v += lane_m8(v); v += lane_x8(v); v += lane_x16(v); v += lane_x32(v);
    return v;
}
#define LDS_WAIT() asm volatile("s_waitcnt lgkmcnt(0)" ::: "memory")
namespace pg8 {
#define PG8_LAS __attribute__((address_space(3)))
typedef short bf16x8 __attribute__((ext_vector_type(8)));
typedef float f32x4 __attribute__((ext_vector_type(4)));
typedef unsigned u32x4 __attribute__((ext_vector_type(4)));
constexpr int BM = 256, BK = 64, HALF = 128, HTB = HALF * BK * 2, STAGE_BYTES = 8 * HTB, NXCD = 8, WGM = 8;
__host__ __device__ __forceinline__ int lds_byte(int r, int c) { const int st = (r >> 4) * 2 + (c >> 5), rr = r & 15, cc = c & 31, ob = rr * 64 + cc * 2; return st * 1024 + (ob ^ (((ob >> 9) & 1) << 5)); }
__host__ __device__ __forceinline__ void stage_rc(int b, int& R, int& C) { const int st = b / 1024, sb = b % 1024, swz = sb ^ (((sb >> 9) & 1) << 5); R = (st >> 1) * 16 + swz / 64; C = (st & 1) * 32 + (swz % 64) / 2; }
__host__ __device__ __forceinline__ int perm32(int rho) { const int n = rho >> 4, i = rho & 15; return 8 * (i >> 2) + 4 * n + (i & 3); }
struct Unit { int pm, pn, ui; };
struct Gemm { const bf16_t* A; const bf16_t* Bt; int K; };
struct StaticOrder {
    int nM, nN, nwg, G, c, wgm;
    __device__ void init(int M_, int N_, int G_, int c_, int wgm_ = WGM) { nM = M_ / BM; nN = N_ / BM; nwg = nM * nN; G = G_; c = c_; wgm = wgm_; }
    __device__ bool next(int i, Unit& u) const {
        const long L = (long)i * G + c; if (L >= nwg) return false;
        int wgid = (int)L; { const int q = nwg / NXCD, r = nwg % NXCD, xcd = wgid % NXCD, off = wgid / NXCD; wgid = (xcd < r ? xcd * (q + 1) : r * (q + 1) + (xcd - r) * q) + off; }
        const int nig = wgm * nN, gid = wgid / nig, fm = gid * wgm, gsz = (nM - fm) < wgm ? (nM - fm) : wgm;
        u.pm = fm + ((wgid % nig) % gsz); u.pn = (wgid % nig) / gsz; return true;
    }
};
__device__ __forceinline__ unsigned cvt_pk_bf16(float lo, float hi) { unsigned r; asm volatile("v_cvt_pk_bf16_f32 %0, %1, %2" : "=v"(r) : "v"(lo), "v"(hi)); return r; }

typedef int v8i __attribute__((ext_vector_type(8)));
template <class Epi, class Sched, bool ALIGN_EPI, bool FP8 = false>
__device__ __forceinline__ void gemm_phase(PG8_LAS unsigned char* lds, const Gemm g, const Sched& S, const Epi& E) {
    const int tid = threadIdx.x, wid = __builtin_amdgcn_readfirstlane(tid >> 6), lane = tid & 63, wr = wid >> 2, wc = wid & 3, fr = lane & 15, fq = lane >> 4;
    const int K = g.K, RB = FP8 ? K : 2 * K, nt = RB / 128;
    unsigned voffB;
    { int R, C; stage_rc(tid * 16, R, C); const int Rb = Epi::PERM ? ((R & ~31) + perm32(R & 31)) : R; voffB = (unsigned)(Rb * RB + C * 2); }
    const size_t kstep = (size_t)(BK * 2);
    const size_t hstep = (size_t)HALF * RB;
    const size_t tstep = 2 * hstep;
    const unsigned ldsw = (unsigned)wid * 1024u;
    const int aoff = FP8 ? lds_byte(wr * 64 + fr, fq * 16) : lds_byte(wr * 64 + fr, fq * 8), boff = FP8 ? lds_byte(wc * 32 + fr, fq * 16) : lds_byte(wc * 32 + fr, fq * 8);
    const int x16 = 16 * (fq & 1);
    const char* gA = (const char*)g.A;
#define PG8_SA(b, h) (((b) * 2 + (h)) * HTB)
#define PG8_SB(b, h) ((4 + (b) * 2 + (h)) * HTB)
#define PG8_STAGE(bufoff, gbase, voff) do { _Pragma("unroll") for (int _i = 0; _i < 2; ++_i) \
        __builtin_amdgcn_global_load_lds((const unsigned*)((const char*)(gbase) + (size_t)_i * 64 * RB + (voff)), (PG8_LAS unsigned*)(lds + (bufoff) + ldsw + _i * 8192), 16, 0, 0); } while (0)
#define PG8_STAGE_A(bufoff, AO, h, kb) do { _Pragma("unroll") for (int _i = 0; _i < 2; ++_i) \
        __builtin_amdgcn_global_load_lds((const unsigned*)(gA + (size_t)((AO)[h][_i] + (unsigned)(kb))), (PG8_LAS unsigned*)(lds + (bufoff) + ldsw + _i * 8192), 16, 0, 0); } while (0)
#define PG8_LDA(dst, b, h) do { if constexpr (FP8) { _Pragma("unroll") for (int m = 0; m < 4; ++m) { dst[m][0] = *(const PG8_LAS bf16x8*)(lds + PG8_SA(b, h) + aoff + m * 2048 + x16); dst[m][1] = *(const PG8_LAS bf16x8*)(lds + PG8_SA(b, h) + aoff + m * 2048 + 16 - x16); } } \
    else { _Pragma("unroll") for (int m = 0; m < 4; ++m) _Pragma("unroll") for (int k = 0; k < 2; ++k) dst[m][k] = *(const PG8_LAS bf16x8*)(lds + PG8_SA(b, h) + aoff + m * 2048 + k * 1024); } } while (0)
#define PG8_LDB(dst, b, h) do { if constexpr (FP8) { _Pragma("unroll") for (int n = 0; n < 2; ++n) { dst[n][0] = *(const PG8_LAS bf16x8*)(lds + PG8_SB(b, h) + boff + n * 2048 + x16); dst[n][1] = *(const PG8_LAS bf16x8*)(lds + PG8_SB(b, h) + boff + n * 2048 + 16 - x16); } } \
    else { _Pragma("unroll") for (int n = 0; n < 2; ++n) _Pragma("unroll") for (int k = 0; k < 2; ++k) dst[n][k] = *(const PG8_LAS bf16x8*)(lds + PG8_SB(b, h) + boff + n * 2048 + k * 1024); } } while (0)
#define PG8_CAT8(x) __builtin_bit_cast(v8i, __builtin_shufflevector((x)[0], (x)[1], 0, 1, 2, 3, 4, 5, 6, 7, 8, 9, 10, 11, 12, 13, 14, 15))
#define PG8_MMA(ai, bj, At, Bt) do { __builtin_amdgcn_s_setprio(1); if constexpr (FP8) { _Pragma("unroll") for (int m = 0; m < 4; ++m) _Pragma("unroll") for (int n = 0; n < 2; ++n) \
        acc[ai][bj][m][n] = __builtin_amdgcn_mfma_scale_f32_16x16x128_f8f6f4(PG8_CAT8(Bt[n]), PG8_CAT8(At[m]), acc[ai][bj][m][n], 0, 0, 0, 0, 0, 0); } \
    else { _Pragma("unroll") for (int m = 0; m < 4; ++m) _Pragma("unroll") for (int n = 0; n < 2; ++n) _Pragma("unroll") for (int k = 0; k < 2; ++k) \
        acc[ai][bj][m][n] = __builtin_amdgcn_mfma_f32_16x16x32_bf16(Bt[n][k], At[m][k], acc[ai][bj][m][n], 0, 0, 0); } __builtin_amdgcn_s_setprio(0); } while (0)
#define PG8_WAIT_V(n) asm volatile("s_waitcnt vmcnt(" #n ")" ::: "memory")
#define PG8_WAIT_L(n) asm volatile("s_waitcnt lgkmcnt(" #n ")" ::: "memory")
#define PG8_BAR __builtin_amdgcn_s_barrier()
#define PG8_SCHED __builtin_amdgcn_sched_barrier(0)
#define PG8_AOFFS(AO, u) do { int _t = threadIdx.x; asm volatile("" : "+v"(_t)); _Pragma("unroll") for (int _i = 0; _i < 2; ++_i) { int _R, _C; stage_rc(_t * 16 + _i * 8192, _R, _C); \
        _Pragma("unroll") for (int _h = 0; _h < 2; ++_h) (AO)[_h][_i] = S.row_off(u, _h * HALF + _R) + (unsigned)(_C * 2); } } while (0)
    Unit cur, nxt; int ui = 0;
    if (!S.next(0, cur)) return;
    f32x4 acc[2][2][4][2];
#pragma unroll
    for (int a = 0; a < 2; ++a)
#pragma unroll
        for (int b = 0; b < 2; ++b)
#pragma unroll
            for (int m = 0; m < 4; ++m)
#pragma unroll
                for (int n = 0; n < 2; ++n) acc[a][b][m][n] = (f32x4){0.f, 0.f, 0.f, 0.f};
    bf16x8 At[4][2], B0[2][2], B1[2][2];
    unsigned aoc[2][2];
    PG8_AOFFS(aoc, cur);
    const char* cB = (const char*)g.Bt + (size_t)cur.pn * tstep;
    PG8_STAGE(PG8_SB(0, 0), cB, voffB); PG8_STAGE(PG8_SB(0, 1), cB + hstep, voffB); PG8_STAGE_A(PG8_SA(0, 0), aoc, 0, 0); PG8_STAGE_A(PG8_SA(0, 1), aoc, 1, 0);
    if (wr == 1) PG8_BAR;
    PG8_WAIT_V(2); PG8_BAR;
    PG8_STAGE(PG8_SB(1, 0), cB + kstep, voffB); PG8_STAGE_A(PG8_SA(1, 0), aoc, 0, 128); PG8_STAGE(PG8_SB(1, 1), cB + hstep + kstep, voffB);
    PG8_WAIT_V(6); PG8_BAR;
    for (;;) {
        const bool has_next = S.next(ui + 1, nxt);
        const char* nB = cB;
        if (has_next) nB = (const char*)g.Bt + (size_t)nxt.pn * tstep;
#pragma nounroll
        for (int t = 0; t < nt; t += 2) {
            const bool last = (t == nt - 2);
            const unsigned k1 = (unsigned)(t + 1) * 128u, k2 = last ? 0u : (unsigned)(t + 2) * 128u, k3 = k2 + 128u;
            const char* b2 = last ? nB : cB + (size_t)(t + 2) * kstep; const char* b3 = b2 + kstep;
            PG8_LDB(B0, 0, 0); PG8_LDB(B1, 0, 1); PG8_SCHED; PG8_LDA(At, 0, 0); PG8_STAGE_A(PG8_SA(1, 1), aoc, 1, k1);
            PG8_WAIT_V(8); PG8_WAIT_L(0); PG8_BAR; PG8_MMA(0, 0, At, B0); PG8_MMA(0, 1, At, B1); PG8_BAR; PG8_SCHED;
            if (last && has_next) { PG8_AOFFS(aoc, nxt); }
            PG8_LDA(At, 0, 1); PG8_STAGE(PG8_SB(0, 0), b2, voffB); PG8_STAGE(PG8_SB(0, 1), b2 + hstep, voffB); PG8_STAGE_A(PG8_SA(0, 0), aoc, 0, k2);
            PG8_WAIT_V(8); PG8_WAIT_L(0); PG8_BAR; PG8_MMA(1, 0, At, B0); PG8_MMA(1, 1, At, B1); PG8_BAR; PG8_SCHED;
            PG8_LDB(B0, 1, 0); PG8_LDB(B1, 1, 1); PG8_SCHED; PG8_LDA(At, 1, 0); PG8_STAGE_A(PG8_SA(0, 1), aoc, 1, k2);
            PG8_WAIT_V(8); PG8_WAIT_L(0); PG8_BAR; PG8_MMA(0, 0, At, B0); PG8_MMA(0, 1, At, B1); PG8_BAR; PG8_SCHED;
            PG8_LDA(At, 1, 1); PG8_STAGE(PG8_SB(1, 0), b3, voffB); PG8_STAGE(PG8_SB(1, 1), b3 + hstep, voffB); PG8_STAGE_A(PG8_SA(1, 0), aoc, 0, k3);
            PG8_WAIT_V(8); PG8_WAIT_L(0); PG8_BAR; PG8_MMA(1, 0, At, B0); PG8_MMA(1, 1, At, B1); PG8_BAR; PG8_SCHED;
        }
        if constexpr (ALIGN_EPI) { if (wr == 0) PG8_BAR; }
        { int t2 = threadIdx.x; asm volatile("" : "+v"(t2));
          const int w2 = __builtin_amdgcn_readfirstlane(t2 >> 6), l2 = t2 & 63; E(acc, cur, w2 >> 2, w2 & 3, l2 & 15, l2 >> 4); }
        if (!has_next) break;
#pragma unroll
        for (int a = 0; a < 2; ++a)
#pragma unroll
            for (int b = 0; b < 2; ++b)
#pragma unroll
                for (int m = 0; m < 4; ++m)
#pragma unroll
                    for (int n = 0; n < 2; ++n) acc[a][b][m][n] = (f32x4){0.f, 0.f, 0.f, 0.f};
        cur = nxt; cB = nB; ++ui;
        if constexpr (ALIGN_EPI) { if (wr == 1) PG8_BAR; }
    }
    PG8_WAIT_V(0);
    if constexpr (!ALIGN_EPI) { if (wr == 0) PG8_BAR; }
    PG8_BAR;
#undef PG8_SA
#undef PG8_SB
#undef PG8_STAGE
#undef PG8_STAGE_A
#undef PG8_LDA
#undef PG8_LDB
#undef PG8_MMA
#undef PG8_CAT8
#undef PG8_WAIT_V
#undef PG8_WAIT_L
#undef PG8_BAR
#undef PG8_SCHED
#undef PG8_AOFFS
}
}
struct SchedPlain : pg8::StaticOrder {
    unsigned rowbytes;
    DEV unsigned row_off(const pg8::Unit& u, int r) const { return (unsigned)(u.pm * 256 + r) * rowbytes; }
};
struct SchedMoe1 : pg8::StaticOrder {
    const LAS int* idxl;
    DEV bool next(int i, pg8::Unit& u) const { if (!pg8::StaticOrder::next(i, u)) return false; u.pn += (u.pm >> 4) * 16; u.ui = i; return true; }
    DEV unsigned row_off(const pg8::Unit& u, int r) const { const int g = u.pm * 256 + r; const int tok = ((g >> 9) & 7) * S + idxl[u.ui * 256 + r]; return (unsigned)tok * 2048u; }
};
struct SchedMoe2 : pg8::StaticOrder {
    DEV bool next(int i, pg8::Unit& u) const { if (!pg8::StaticOrder::next(i, u)) return false; u.pn += (u.pm >> 4) * 4; return true; }
    DEV unsigned row_off(const pg8::Unit& u, int r) const { return (unsigned)(u.pm * 256 + r) * (unsigned)DFF; }
};
typedef pg8::f32x4 f32x4; typedef pg8::u32x4 u32x4;
struct EpiInProj {
    static constexpr bool PERM = true;
    unsigned char* ws; const float* ropeT;
    DEV void operator()(const f32x4 (&acc)[2][2][4][2], const pg8::Unit& u, int wr, int wc, int fr, int fq) const {
        const int grp = u.pn >> 1;
        bf16_t* gbase = (bf16_t*)(ws + WS_RQ + (size_t)grp * 32 * MiB);
        const int j0 = 32 * (wc & 1) + 8 * fq;
        if (grp < 2) {
            const float sc = grp == 1 ? 0.125f : 1.f;
            f32x4 cs[2][4], sn[2][4];
#pragma unroll
            for (int ai = 0; ai < 2; ++ai)
#pragma unroll
                for (int m = 0; m < 4; ++m) { const int s = (u.pm * 256 + ai * 128 + wr * 64 + m * 16 + fr) & 4095;
                    cs[ai][m] = *(const f32x4*)(ropeT + s * 32 + (j0 >> 1)); sn[ai][m] = *(const f32x4*)(ropeT + S * 32 + s * 32 + (j0 >> 1)); }
#pragma unroll
            for (int ai = 0; ai < 2; ++ai)
#pragma unroll
                for (int m = 0; m < 4; ++m) {
                    const int row = u.pm * 256 + ai * 128 + wr * 64 + m * 16 + fr, b = row >> 12, s = row & 4095;
#pragma unroll
                    for (int bj = 0; bj < 2; ++bj) {
                        const int hd = 4 * (u.pn & 1) + 2 * bj + (wc >> 1);
                        const f32x4 lo = (acc[ai][bj][m][0] * cs[ai][m] - acc[ai][bj][m][1] * sn[ai][m]) * sc, hi = (acc[ai][bj][m][1] * cs[ai][m] + acc[ai][bj][m][0] * sn[ai][m]) * sc;
                        u32x4 w; w.x = pg8::cvt_pk_bf16(lo[0], lo[1]); w.y = pg8::cvt_pk_bf16(lo[2], lo[3]); w.z = pg8::cvt_pk_bf16(hi[0], hi[1]); w.w = pg8::cvt_pk_bf16(hi[2], hi[3]);
                        *(u32x4*)(gbase + ((size_t)(b * NH + hd) * S + s) * HD + j0) = w;
                    }
                }
        } else {
            const float sc = grp == 4 ? 0.125f * LOG2E : 1.f;
#pragma unroll
            for (int ai = 0; ai < 2; ++ai)
#pragma unroll
                for (int m = 0; m < 4; ++m) {
                    const int row = u.pm * 256 + ai * 128 + wr * 64 + m * 16 + fr, b = row >> 12, s = row & 4095;
#pragma unroll
                    for (int bj = 0; bj < 2; ++bj) {
                        const int hd = 4 * (u.pn & 1) + 2 * bj + (wc >> 1);
                        const f32x4 lo = acc[ai][bj][m][0] * sc, hi = acc[ai][bj][m][1] * sc;
                        u32x4 w; w.x = pg8::cvt_pk_bf16(lo[0], lo[1]); w.y = pg8::cvt_pk_bf16(lo[2], lo[3]); w.z = pg8::cvt_pk_bf16(hi[0], hi[1]); w.w = pg8::cvt_pk_bf16(hi[2], hi[3]);
                        *(u32x4*)(gbase + ((size_t)(b * NH + hd) * S + s) * HD + j0) = w;
                    }
                }
        }
    }
};
struct EpiOutProj {
    static constexpr bool PERM = true;
    const float* x; unsigned char* ws;
    DEV void operator()(const f32x4 (&acc)[2][2][4][2], const pg8::Unit& u, int wr, int wc, int fr, int fq) const {
#pragma unroll
        for (int ai = 0; ai < 2; ++ai)
#pragma unroll
            for (int m = 0; m < 4; ++m) {
                const int row = u.pm * 256 + ai * 128 + wr * 64 + m * 16 + fr;
                bf16_t* x1r = (bf16_t*)(ws + x1_off(row));
                f32x4 xa[2], xb[2];
#pragma unroll
                for (int bj = 0; bj < 2; ++bj) { const size_t off = (size_t)row * D + u.pn * 256 + bj * 128 + wc * 32 + 8 * fq; xa[bj] = *(const f32x4*)(x + off); xb[bj] = *(const f32x4*)(x + off + 4); }
#pragma unroll
                for (int bj = 0; bj < 2; ++bj) { const int col = u.pn * 256 + bj * 128 + wc * 32 + 8 * fq;
                    const f32x4 lo = xa[bj] + acc[ai][bj][m][0], hi = xb[bj] + acc[ai][bj][m][1];
                    u32x4 w; w.x = pg8::cvt_pk_bf16(lo[0], lo[1]); w.y = pg8::cvt_pk_bf16(lo[2], lo[3]); w.z = pg8::cvt_pk_bf16(hi[0], hi[1]); w.w = pg8::cvt_pk_bf16(hi[2], hi[3]);
                    *(u32x4*)(x1r + col) = w; }
            }
    }
};
DEV unsigned pk4_fp8e(float a, float b, float c, float d) { unsigned w = 0u; w = __builtin_amdgcn_cvt_pk_fp8_f32(a, b, w, false); w = __builtin_amdgcn_cvt_pk_fp8_f32(c, d, w, true); return w; }
struct EpiSwiGLU {
    static constexpr bool PERM = true;
    unsigned char* hid;
    DEV void operator()(const f32x4 (&acc)[2][2][4][2], const pg8::Unit& u, int wr, int wc, int fr, int fq) const {
        const int pnl = u.pn & 15;
#pragma unroll
        for (int ai = 0; ai < 2; ++ai)
#pragma unroll
            for (int m = 0; m < 4; ++m) {
                const int row = u.pm * 256 + ai * 128 + wr * 64 + m * 16 + fr;
                float o[8];
#pragma unroll
                for (int n = 0; n < 2; ++n)
#pragma unroll
                    for (int i = 0; i < 4; ++i) { const float ga = acc[ai][0][m][n][i], ua = acc[ai][1][m][n][i];
                        o[4 * n + i] = (ga * ua) * ((1.f / 1024.f) * __builtin_amdgcn_rcpf(1.f + __builtin_amdgcn_exp2f(ga * (-LOG2E / 32.f)))); }
                *(uint2*)(hid + (size_t)row * DFF + pnl * 128 + wc * 32 + 8 * fq) = make_uint2(pk4_fp8e(o[0], o[1], o[2], o[3]), pk4_fp8e(o[4], o[5], o[6], o[7]));
            }
    }
};
struct EpiDown {
    static constexpr bool PERM = true;
    unsigned char* y;
    DEV void operator()(const f32x4 (&acc)[2][2][4][2], const pg8::Unit& u, int wr, int wc, int fr, int fq) const {
        const int pnl = u.pn & 3;
#pragma unroll
        for (int ai = 0; ai < 2; ++ai)
#pragma unroll
            for (int m = 0; m < 4; ++m) {
                const int row = u.pm * 256 + ai * 128 + wr * 64 + m * 16 + fr;
#pragma unroll
                for (int bj = 0; bj < 2; ++bj) { const f32x4 lo = acc[ai][bj][m][0] * (1.f / 32.f), hi = acc[ai][bj][m][1] * (1.f / 32.f);
                    *(uint2*)(y + (size_t)row * D + pnl * 256 + bj * 128 + wc * 32 + 8 * fq) = make_uint2(pk4_fp8e(lo[0], lo[1], lo[2], lo[3]), pk4_fp8e(hi[0], hi[1], hi[2], hi[3])); }
            }
    }
};
struct Args { const float* in[13]; float* out; unsigned char* ws; int ph_lo, ph_hi; int rep[16]; };
enum { IN_X = 0, IN_G1, IN_WIN, IN_DECAY, IN_GN, IN_RELB, IN_WOUT, IN_G2, IN_WR, IN_WG, IN_WU, IN_WDN, IN_FG };

struct TrItem { const float* src; bf16_t* dst; int K, N, k0, n0, mode, fp8; };
DEV unsigned pk4_fp8(float a, float b, float c, float d) { unsigned w = 0u; w = __builtin_amdgcn_cvt_pk_fp8_f32(a, b, w, false); w = __builtin_amdgcn_cvt_pk_fp8_f32(c, d, w, true); return w; }
DEV void tr_load(const TrItem& t, f32x4 (&v)[16], int lane) {
#pragma unroll
    for (int i = 0; i < 16; ++i) { const int kk = (lane >> 4) + 4 * i, c = (lane & 15) * 4; v[i] = __builtin_nontemporal_load((const f32x4*)(t.src + (size_t)(t.k0 + kk) * t.N + t.n0 + c)); }
}
DEV int rowmap_rt(int mode, int n) {
    if (mode == 0) return n;
    if (mode == 1) { if (n >= 1024) return n; const int base = n & ~63, d = n & 63, nn = d >> 5, dd = d & 31; return base + 8 * (dd >> 2) + 4 * nn + (dd & 3); }
    return (n >> 7) * 256 + (mode == 3 ? 128 : 0) + (n & 127);
}
DEV void tr_finish(const TrItem& t, const f32x4 (&v)[16], LAS float* scr, int lane) {
#pragma unroll
    for (int i = 0; i < 16; ++i) { const int kk = (lane >> 4) + 4 * i, c = (lane & 15) * 4;
        scr[kk * 65 + c] = v[i][0]; scr[kk * 65 + c + 1] = v[i][1]; scr[kk * 65 + c + 2] = v[i][2]; scr[kk * 65 + c + 3] = v[i][3]; }
    LDS_WAIT();
#pragma unroll
    for (int i = 0; i < 8; ++i) { const int n = (lane >> 3) + 8 * i, c = (lane & 7) * 8; const LAS float* sp = scr + c * 65 + n;
        if (t.fp8) {
            const unsigned lo = pk4_fp8(sp[0] * 32.f, sp[65] * 32.f, sp[2 * 65] * 32.f, sp[3 * 65] * 32.f), hi = pk4_fp8(sp[4 * 65] * 32.f, sp[5 * 65] * 32.f, sp[6 * 65] * 32.f, sp[7 * 65] * 32.f);
            *(uint2*)((unsigned char*)t.dst + (size_t)rowmap_rt(t.mode, t.n0 + n) * t.K + t.k0 + c) = make_uint2(lo, hi);
        } else {
        u32x4 o; o.x = pk2(sp[0], sp[65]); o.y = pk2(sp[2 * 65], sp[3 * 65]); o.z = pk2(sp[4 * 65], sp[5 * 65]); o.w = pk2(sp[6 * 65], sp[7 * 65]);
        *(u32x4*)(t.dst + (size_t)rowmap_rt(t.mode, t.n0 + n) * t.K + t.k0 + c) = o; } }
    LDS_WAIT();
}
template <class Dec> DEV void tr_run(const Dec& dec, int nitems, int gw, int NGW, LAS float* scr, int lane) {
    for (int it = gw; it < nitems; it += NGW) { TrItem cur; f32x4 va[16]; dec(it, cur); tr_load(cur, va, lane); tr_finish(cur, va, scr, lane); }
}
template <class Dec> DEV void tr_run2(const Dec& dec, int nitems, int gw, int NGW, LAS float* scr, int lane) {
    int it = gw; if (it >= nitems) return;
    TrItem cur, nxt; f32x4 va[16], vb[16];
    dec(it, cur); tr_load(cur, va, lane);
    for (;;) {
        const int n1 = it + NGW; const bool h1 = n1 < nitems;
        if (h1) { dec(n1, nxt); tr_load(nxt, vb, lane); }
        tr_finish(cur, va, scr, lane);
        if (!h1) break;
        const int n2 = n1 + NGW; const bool h2 = n2 < nitems;
        if (h2) { dec(n2, cur); tr_load(cur, va, lane); }
        tr_finish(nxt, vb, scr, lane);
        if (!h2) break;
        it = n2;
    }
}
DEV void rms_row_to_bf16(const float* xrow, const float* g, bf16_t* orow, int lane) {
    const float4* xr = (const float4*)xrow + lane;
    float4 v[4]; float s = 0.f;
#pragma unroll
    for (int j = 0; j < 4; ++j) { v[j] = xr[64 * j]; s += v[j].x * v[j].x + v[j].y * v[j].y + v[j].z * v[j].z + v[j].w * v[j].w; }
    const float rs = rsqrtf(wave_sum(s) * (1.f / D) + EPS);
    uint2* o = (uint2*)orow + lane;
#pragma unroll
    for (int j = 0; j < 4; ++j) { const float4 gg = ((const float4*)g)[lane + 64 * j];
        o[64 * j] = make_uint2(pk2(v[j].x * rs * gg.x, v[j].y * rs * gg.y), pk2(v[j].z * rs * gg.z, v[j].w * rs * gg.w)); }
}
DEV void phase_prep(const Args& a, unsigned char* lds, int gw, int NGW, int lane, int wave) {
    unsigned char* ws = a.ws;
    float* ropeT = (float*)(ws + WS_ROPE); float* biasT = (float*)(ws + WS_BIAS);
    for (int t = gw * 64 + lane; t < S * 32; t += NGW * 64) {
        const int pos = t >> 5, i = t & 31; const double inv = pow(10000.0, -(double)i / 32.0), ang = (double)pos * inv;
        ropeT[t] = (float)cos(ang); ropeT[S * 32 + t] = (float)sin(ang);
        if (t < 3 * NH * 129) { const int p = t / (NH * 129), h = (t / 129) % NH, o = t % 129 - 64, dil = p == 0 ? 1 : (p == 1 ? 4 : 16), rel = o * dil, n = rel < 0 ? -rel : rel;
            int bucket = rel > 0 ? 16 : 0;
            if (n < 8) bucket += n; else { int large = 8 + (int)(log((double)n / 8.0) / log(128.0) * 8.0); if (large > 15) large = 15; bucket += large; }
            biasT[t] = a.in[IN_RELB][bucket * NH + h] * LOG2E; }
    }
    LAS float* scr = (LAS float*)((LAS unsigned char*)lds + wave * 16640);
    constexpr int I_IN = (D / 64) * (PC / 64), I_OUT = (D / 64) * (D / 64);
    { const float* w_in = a.in[IN_WIN]; const float* w_out = a.in[IN_WOUT]; bf16_t* Win = (bf16_t*)(ws + WS_WIN); bf16_t* Wout = (bf16_t*)(ws + WS_WOUT);
      auto dec = [=](int it, TrItem& t) { if (it < I_IN) { t.src = w_in; t.dst = Win; t.K = D; t.N = PC; t.k0 = (it / (PC / 64)) * 64; t.n0 = (it % (PC / 64)) * 64; t.mode = 1; t.fp8 = 0; }
          else { const int r = it - I_IN; t.src = w_out; t.dst = Wout; t.K = D; t.N = D; t.k0 = (r / (D / 64)) * 64; t.n0 = (r % (D / 64)) * 64; t.mode = 0; t.fp8 = 0; } };
      tr_run(dec, I_IN + I_OUT, gw, NGW, scr, lane); }
    {
      const float* x = a.in[IN_X]; const float* g = a.in[IN_G1]; bf16_t* XN = (bf16_t*)(ws + WS_XN);
      float4 va[4], vb[4], vc[4];
      { const float4* xr = (const float4*)(x + (size_t)gw * D) + lane;
#pragma unroll
        for (int j = 0; j < 4; ++j) va[j] = xr[64 * j];
        if (gw + NGW < M) { const float4* xs = (const float4*)(x + (size_t)(gw + NGW) * D) + lane;
#pragma unroll
          for (int j = 0; j < 4; ++j) vb[j] = xs[64 * j]; } }
      for (int m = gw; m < M; m += NGW) {
          if (m + 2 * NGW < M) { const float4* xr = (const float4*)(x + (size_t)(m + 2 * NGW) * D) + lane;
#pragma unroll
              for (int j = 0; j < 4; ++j) vc[j] = xr[64 * j]; }
          float s = 0.f;
#pragma unroll
          for (int j = 0; j < 4; ++j) s += va[j].x * va[j].x + va[j].y * va[j].y + va[j].z * va[j].z + va[j].w * va[j].w;
          const float rs = rsqrtf(wave_sum(s) * (1.f / D) + EPS);
          uint2* o = (uint2*)(XN + (size_t)m * D) + lane;
#pragma unroll
          for (int j = 0; j < 4; ++j) { const float4 gg = ((const float4*)g)[lane + 64 * j];
              o[64 * j] = make_uint2(pk2(va[j].x * rs * gg.x, va[j].y * rs * gg.y), pk2(va[j].z * rs * gg.z, va[j].w * rs * gg.w)); }
#pragma unroll
          for (int j = 0; j < 4; ++j) { va[j] = vb[j]; vb[j] = vc[j]; }
      } }
}
DEV void phase_latew(const Args& a, unsigned char* lds, int gw, int NGW, int lane, int wave) {
    unsigned char* ws = a.ws; LAS float* scr = (LAS float*)((LAS unsigned char*)lds + wave * 16640);
    constexpr int I_G = (D / 64) * (DFF / 64);
    const float* wg_ = a.in[IN_WG]; const float* wu_ = a.in[IN_WU]; const float* wd_ = a.in[IN_WDN]; bf16_t* Wgu = (bf16_t*)(ws + WS_WGU); bf16_t* Wd = (bf16_t*)(ws + WS_WD);
    auto dec = [=](int it, TrItem& t) { const int which = it / (NE * I_G), r = it % (NE * I_G), e = r / I_G, q = r % I_G;
        t.fp8 = 1;
        if (which < 2) { t.src = (which == 0 ? wg_ : wu_) + (size_t)e * D * DFF; t.dst = (bf16_t*)((unsigned char*)Wgu + (size_t)e * 4096 * D); t.K = D; t.N = DFF; t.n0 = (q / (D / 64)) * 64; t.k0 = (q % (D / 64)) * 64; t.mode = 2 + which; }
        else { t.src = wd_ + (size_t)e * DFF * D; t.dst = (bf16_t*)((unsigned char*)Wd + (size_t)e * D * DFF); t.K = DFF; t.N = D; t.n0 = (q / (DFF / 64)) * 64; t.k0 = (q % (DFF / 64)) * 64; t.mode = 0; } };
    tr_run2(dec, 3 * NE * I_G, gw, NGW, scr, lane);
}
DEV void phase_router(const Args& a, unsigned char* lds, int xg, int gwl, int NGW, int lane, int tid) {
    const int gw = xg * S + gwl, M = (xg + 1) * S;
    unsigned char* ws = a.ws; const float* g2 = a.in[IN_G2]; const float* wr = a.in[IN_WR];
    bf16_t* H2b = (bf16_t*)(ws + WS_XN); float* aff = (float*)(ws + WS_AFF); int* inv = (int*)(ws + WS_INV);
    LAS f32x4* wl = (LAS f32x4*)(LAS unsigned char*)lds;
    for (int i = tid; i < D * 4; i += NTHR) { const int k = i >> 2, c = i & 3, slot = (k & 3) * 256 + (k >> 2); wl[slot * 4 + ((c + (slot >> 2)) & 3)] = *(const f32x4*)(wr + (size_t)k * NE + 4 * c); }
    __syncthreads();
    uint2 xq[4][4], xp[4][4];
#pragma unroll
    for (int q = 0; q < 4; ++q) { const int r = gw + q * NGW; if (r < M) { const uint2* xr = (const uint2*)(ws + x1_off(r)) + lane;
#pragma unroll
        for (int j = 0; j < 4; ++j) xp[q][j] = xr[64 * j]; } }
    for (int row4 = gw; row4 < M; row4 += 4 * NGW) {
#pragma unroll
      for (int q = 0; q < 4; ++q)
#pragma unroll
        for (int j = 0; j < 4; ++j) xq[q][j] = xp[q][j];
#pragma unroll
      for (int q = 0; q < 4; ++q) { const int r = row4 + (4 + q) * NGW; if (r < M) { const uint2* xr = (const uint2*)(ws + x1_off(r)) + lane;
#pragma unroll
          for (int j = 0; j < 4; ++j) xp[q][j] = xr[64 * j]; } }
#pragma unroll
      for (int q = 0; q < 4; ++q) {
        const int row = row4 + q * NGW; if (row >= M) break;
        float4 v[4]; float s = 0.f;
#pragma unroll
        for (int j = 0; j < 4; ++j) { v[j] = make_float4(bf2f(xq[q][j].x & 0xffffu), bf2f(xq[q][j].x >> 16), bf2f(xq[q][j].y & 0xffffu), bf2f(xq[q][j].y >> 16)); s += v[j].x * v[j].x + v[j].y * v[j].y + v[j].z * v[j].z + v[j].w * v[j].w; }
        const float rs = rsqrtf(wave_sum(s) * (1.f / D) + EPS);
        f32x4 lg[4];
#pragma unroll
        for (int c = 0; c < 4; ++c) lg[c] = (f32x4){0.f, 0.f, 0.f, 0.f};
        unsigned* o = (unsigned*)((unsigned char*)H2b + (size_t)row * 2048) + lane;
        float hv[4][4];
#pragma unroll
        for (int j = 0; j < 4; ++j) { const float4 gg = ((const float4*)g2)[lane + 64 * j];
            hv[j][0] = v[j].x * rs * gg.x; hv[j][1] = v[j].y * rs * gg.y; hv[j][2] = v[j].z * rs * gg.z; hv[j][3] = v[j].w * rs * gg.w;
            o[64 * j] = pk4_fp8(hv[j][0], hv[j][1], hv[j][2], hv[j][3]); }
        const int rot = (lane >> 2) & 3; f32x4 wa[4], wb[4];
#pragma unroll
        for (int c = 0; c < 4; ++c) wa[c] = wl[(0 * 256 + lane) * 4 + ((c + rot) & 3)];
#pragma unroll
        for (int st = 0; st < 16; st += 2) {
            { const int j = (st + 1) >> 2, t = (st + 1) & 3, slot = t * 256 + lane + 64 * j;
#pragma unroll
              for (int c = 0; c < 4; ++c) wb[c] = wl[slot * 4 + ((c + rot) & 3)]; }
#pragma unroll
            for (int c = 0; c < 4; ++c) lg[c] += hv[st >> 2][st & 3] * wa[c];
            __builtin_amdgcn_sched_barrier(0);
            if (st + 2 < 16) { const int j = (st + 2) >> 2, t = (st + 2) & 3, slot = t * 256 + lane + 64 * j;
#pragma unroll
              for (int c = 0; c < 4; ++c) wa[c] = wl[slot * 4 + ((c + rot) & 3)]; }
#pragma unroll
            for (int c = 0; c < 4; ++c) lg[c] += hv[(st + 1) >> 2][(st + 1) & 3] * wb[c];
            __builtin_amdgcn_sched_barrier(0);
        }
        float r8[8], r4[4], r2[2], r1;
        { const bool up = lane & 32;
#pragma unroll
          for (int i = 0; i < 8; ++i) { const float mine = up ? lg[(i + 8) >> 2][(i + 8) & 3] : lg[i >> 2][i & 3], send = up ? lg[i >> 2][i & 3] : lg[(i + 8) >> 2][(i + 8) & 3]; r8[i] = mine + lane_x32(send); } }
        { const bool up = lane & 16;
#pragma unroll
          for (int i = 0; i < 4; ++i) { const float mine = up ? r8[i + 4] : r8[i], send = up ? r8[i] : r8[i + 4]; r4[i] = mine + lane_x16(send); } }
        { const bool up = lane & 8;
#pragma unroll
          for (int i = 0; i < 2; ++i) { const float mine = up ? r4[i + 2] : r4[i], send = up ? r4[i] : r4[i + 2]; r2[i] = mine + lane_x8(send); } }
        { const bool up = lane & 4; const float mine = up ? r2[1] : r2[0], send = up ? r2[0] : r2[1]; r1 = mine + lane_m8(send); }
        r1 += lane_x2(r1); r1 += lane_x1(r1);
        float mx = r1; mx = fmaxf(mx, lane_m8(mx)); mx = fmaxf(mx, lane_x8(mx)); mx = fmaxf(mx, lane_x16(mx)); mx = fmaxf(mx, lane_x32(mx));
        const float ex = __expf(r1 - mx); float sum = ex; sum += lane_m8(sum); sum += lane_x8(sum); sum += lane_x16(sum); sum += lane_x32(sum);
        const float av = ex / sum; const int e = lane >> 2;
        if ((lane & 3) == 0) { aff[(size_t)row * NE + e] = av; inv[(size_t)row * NE + e] = -1; ((float*)(ws + afft_off(row >> 12, e)))[row & 4095] = av; }
      }
    }
    __syncthreads();
}
DEV void phase_topk(const Args& a, unsigned char* lds, int wg, int G, int tid, int lane, int wave) {
    unsigned char* ws = a.ws; int* idx = (int*)(ws + WS_IDX); int* inv = (int*)(ws + WS_INV);
    LAS unsigned* hist = (LAS unsigned*)(LAS unsigned char*)lds; LAS unsigned* wsum = hist + 256; LAS unsigned* bc = hist + 272;
    for (int it = wg >> 3; it < NE; it += G >> 3) {
        const int e = it, b = wg & 7;
        unsigned u[8];
        { const uint4* src = (const uint4*)((const float*)(ws + afft_off(b, e)) + 8 * tid); const uint4 p = src[0], q = src[1]; u[0] = p.x; u[1] = p.y; u[2] = p.z; u[3] = p.w; u[4] = q.x; u[5] = q.y; u[6] = q.z; u[7] = q.w; }
        unsigned prefix = 0u, kk = CAP;
#pragma unroll
        for (int pass = 0; pass < 4; ++pass) {
            const int shift = 24 - 8 * pass;
            __syncthreads();
            if (tid < 256) hist[tid] = 0u;
            __syncthreads();
#pragma unroll
            for (int j = 0; j < 8; ++j) if (pass == 0 || (u[j] >> (shift + 8)) == prefix) atomicAdd((unsigned*)&hist[(u[j] >> shift) & 255u], 1u);
            __syncthreads();
            if (wave == 0) {
                const unsigned c0 = hist[4 * lane], c1 = hist[4 * lane + 1], c2 = hist[4 * lane + 2], c3 = hist[4 * lane + 3], tot = c0 + c1 + c2 + c3;
                unsigned incl = tot;
#pragma unroll
                for (int o = 1; o < 64; o <<= 1) { const unsigned t = __shfl_down(incl, o); if (lane + o < 64) incl += t; }
                const unsigned excl = incl - tot;
                if (excl < kk && kk <= incl) { unsigned acc = excl; int bin;
                    if (acc + c3 >= kk) bin = 3; else { acc += c3; if (acc + c2 >= kk) bin = 2; else { acc += c2; if (acc + c1 >= kk) bin = 1; else { acc += c1; bin = 0; } } }
                    bc[0] = 4 * lane + bin; bc[1] = kk - acc; }
            }
            __syncthreads();
            prefix = (prefix << 8) | bc[0]; kk = bc[1];
        }
        const unsigned T = prefix, need = kk;
        unsigned cg_ = 0u, ce = 0u;
#pragma unroll
        for (int j = 0; j < 8; ++j) { cg_ += u[j] > T; ce += u[j] == T; }
        unsigned pk = cg_ | (ce << 16), incl = pk;
#pragma unroll
        for (int o = 1; o < 64; o <<= 1) { const unsigned t = __shfl_up(incl, o); if (lane >= o) incl += t; }
        if (lane == 63) wsum[wave] = incl;
        __syncthreads();
        unsigned base = 0u;
#pragma unroll
        for (int w = 0; w < NWAVES; ++w) base += w < wave ? wsum[w] : 0u;
        const unsigned ex = base + incl - pk; unsigned gtb = ex & 0xffffu, eqb = ex >> 16;
#pragma unroll
        for (int j = 0; j < 8; ++j) { const bool g = u[j] > T, q = u[j] == T; const unsigned slot = gtb + (eqb < need ? eqb : need);
            if (g || (q && eqb < need)) { const int s = 8 * tid + j; idx[(e * NB + b) * CAP + slot] = s; inv[((size_t)b * S + s) * NE + e] = (int)slot; }
            gtb += g; eqb += q; }
    }
}
DEV void phase_final(const Args& a, int gw, int NGW, int lane) {
    unsigned char* ws = a.ws; float* xo = a.out; const float* aff = (const float*)(ws + WS_AFF); const int* inv = (const int*)(ws + WS_INV);
    const unsigned char* y = ws + WS_Y; const float* fg = a.in[IN_FG];
    uint2 xw[4], xn[4], xm[4]; int iv = -1, ivn = -1, ivm = -1; float av = 0.f, avn = 0.f, avm = 0.f;
    { const uint2* xr = (const uint2*)(ws + x1_off(gw)) + lane;
#pragma unroll
      for (int j = 0; j < 4; ++j) xw[j] = xr[64 * j];
      if (lane < NE) { iv = inv[(size_t)gw * NE + lane]; av = aff[(size_t)gw * NE + lane]; }
      if (gw + NGW < M) { const uint2* xs = (const uint2*)(ws + x1_off(gw + NGW)) + lane;
#pragma unroll
        for (int j = 0; j < 4; ++j) xn[j] = xs[64 * j];
        if (lane < NE) { ivn = inv[(size_t)(gw + NGW) * NE + lane]; avn = aff[(size_t)(gw + NGW) * NE + lane]; } } }
    for (int row = gw; row < M; row += NGW) {
        const int b = row >> 12;
        if (row + 2 * NGW < M) { const uint2* xr = (const uint2*)(ws + x1_off(row + 2 * NGW)) + lane;
#pragma unroll
            for (int j = 0; j < 4; ++j) xm[j] = xr[64 * j];
            if (lane < NE) { ivm = inv[(size_t)(row + 2 * NGW) * NE + lane]; avm = aff[(size_t)(row + 2 * NGW) * NE + lane]; } }
        float4 v[4];
#pragma unroll
        for (int j = 0; j < 4; ++j) v[j] = make_float4(bf2f(xw[j].x & 0xffffu), bf2f(xw[j].x >> 16), bf2f(xw[j].y & 0xffffu), bf2f(xw[j].y >> 16));
        unsigned long long msk = __ballot(lane < NE && iv >= 0);
        while (msk) {
            unsigned w[4][4]; float gq[4];
#pragma unroll
            for (int q = 0; q < 4; ++q) { const bool on = msk != 0ull; const int e = on ? __builtin_ctzll(msk) : 0; msk = on ? (msk & (msk - 1)) : 0ull;
                const int sl = __builtin_amdgcn_readlane(iv, e); const float g = __builtin_bit_cast(float, __builtin_amdgcn_readlane(__builtin_bit_cast(int, av), e));
                gq[q] = on ? g : 0.f;
                const unsigned* yr = (const unsigned*)(y + ((size_t)e * 4096 + b * CAP + (on ? sl : 0)) * D) + lane;
#pragma unroll
                for (int j = 0; j < 4; ++j) w[q][j] = yr[64 * j]; }
#pragma unroll
            for (int q = 0; q < 4; ++q)
#pragma unroll
                for (int j = 0; j < 4; ++j) { const auto lo = __builtin_amdgcn_cvt_pk_f32_fp8((int)w[q][j], false), hi = __builtin_amdgcn_cvt_pk_f32_fp8((int)w[q][j], true);
                    v[j].x += gq[q] * lo[0]; v[j].y += gq[q] * lo[1]; v[j].z += gq[q] * hi[0]; v[j].w += gq[q] * hi[1]; }
        }
        float s = 0.f;
#pragma unroll
        for (int j = 0; j < 4; ++j) s += v[j].x * v[j].x + v[j].y * v[j].y + v[j].z * v[j].z + v[j].w * v[j].w;
        const float rs = rsqrtf(wave_sum(s) * (1.f / D) + EPS);
        float4* orow = (float4*)(xo + (size_t)row * D) + lane;
#pragma unroll
        for (int j = 0; j < 4; ++j) { const float4 gg = ((const float4*)fg)[lane + 64 * j]; orow[64 * j] = make_float4(v[j].x * rs * gg.x, v[j].y * rs * gg.y, v[j].z * rs * gg.z, v[j].w * rs * gg.w); }
#pragma unroll
        for (int j = 0; j < 4; ++j) { xw[j] = xn[j]; xn[j] = xm[j]; }
        iv = ivn; av = avn; ivn = ivm; avn = avm;
    }
}
typedef short bf16x8 __attribute__((ext_vector_type(8)));
typedef float f32x16 __attribute__((ext_vector_type(16)));
typedef short s16x4 __attribute__((ext_vector_type(4)));
typedef LAS const char* lds_cptr;
typedef unsigned u32x2 __attribute__((ext_vector_type(2)));
constexpr int VROW = 192;
constexpr int VSLOT = 32 * VROW;
constexpr int KROW = 144;
constexpr int KSLOT = 32 * KROW;
constexpr int MIX_WAVE_LDS = 16640;
constexpr int NWM = 6;
constexpr int MIX_BIAS_OFF = NWAVES * MIX_WAVE_LDS;
DEV int crow(int r, int hi) { return (r & 3) + 8 * (r >> 2) + 4 * hi; }
DEV s16x4 vtr(lds_cptr p) { return __builtin_bit_cast(s16x4, __builtin_amdgcn_ds_read_tr16_b64_v4i16((LAS s16x4*)p)); }
DEV bf16x8 tr_frag(lds_cptr slot, int s, int blk, int lane) {
    const int h = lane >> 5; lds_cptr p = slot + (16 * s + 4 * h + ((lane & 15) >> 2)) * VROW + (32 * blk + 16 * ((lane >> 4) & 1) + 4 * (lane & 3)) * 2;
    const s16x4 lo = vtr(p), hi = vtr(p + 8 * VROW);
    return (bf16x8){lo[0], lo[1], lo[2], lo[3], hi[0], hi[1], hi[2], hi[3]};
}
DEV void load_frags(bf16x8 (&f)[4], const bf16_t* rowp, int lane) {
    const int h = lane >> 5;
#pragma unroll
    for (int st = 0; st < 4; ++st) f[st] = *(const bf16x8*)(rowp + 16 * st + 8 * h);
}
DEV bf16x8 pack_p(const f32x16& p, int s) {
    u32x4 w; w.x = pg8::cvt_pk_bf16(p[8 * s], p[8 * s + 1]); w.y = pg8::cvt_pk_bf16(p[8 * s + 2], p[8 * s + 3]); w.z = pg8::cvt_pk_bf16(p[8 * s + 4], p[8 * s + 5]); w.w = pg8::cvt_pk_bf16(p[8 * s + 6], p[8 * s + 7]);
    return __builtin_bit_cast(bf16x8, w);
}

DEV void stage_rows_k(LAS unsigned char* ks, const u32x4 (&raw)[4], int lane) {
    const int rr = lane >> 3, ch = lane & 7;
#pragma unroll
    for (int i = 0; i < 4; ++i) *(LAS u32x4*)(ks + (rr + 8 * i) * KROW + ch * 16) = raw[i];
}
DEV void read_row_frags(bf16x8 (&f)[4], const LAS unsigned char* ks, int lane) {
    const LAS unsigned char* p = ks + (lane & 31) * KROW + (lane >> 5) * 16;
#pragma unroll
    for (int st = 0; st < 4; ++st) f[st] = *(const LAS bf16x8*)(p + st * 32);
}

DEV float other_half(float x) { const auto r = __builtin_amdgcn_permlane32_swap(__float_as_uint(x), __float_as_uint(x), false, false); return (threadIdx.x & 32) ? __uint_as_float(r[0]) : __uint_as_float(r[1]); }
DEV float max_halves(float x) { const auto r = __builtin_amdgcn_permlane32_swap(__float_as_uint(x), __float_as_uint(x), false, false); return fmaxf(__uint_as_float(r[0]), __uint_as_float(r[1])); }
DEV float sum_halves(float x) { const auto r = __builtin_amdgcn_permlane32_swap(__float_as_uint(x), __float_as_uint(x), false, false); return __uint_as_float(r[0]) + __uint_as_float(r[1]); }
#define MFMA32(a, b, c) __builtin_amdgcn_mfma_f32_32x32x16_bf16((a), (b), (c), 0, 0, 0)
DEV float ex2(float x) { return __builtin_amdgcn_exp2f(x); }

struct AttnIt { int p, bh, sh, L, r, q0, kmin, kmax; };
DEV void attn_decode(int li, int x, AttnIt& d) {
    d.p = li >> 9; d.bh = 8 * x + ((li >> 6) & 7); const int qblk = li & 63;
    d.sh = 2 * d.p; d.L = S >> d.sh; const int bpr = d.L >> 6;
    d.r = qblk / bpr; d.q0 = (qblk % bpr) * 64;
    d.kmin = d.q0 >= 64 ? 0 : 2; const int km = (d.L + 63 - d.q0) >> 5; d.kmax = km > 5 ? 5 : km;
}
DEV int med3i(int v, int lo, int hi) { return v < lo ? lo : (v > hi ? hi : v); }
DEV void attn_ldrows(const bf16_t* base, const AttnIt& d, int i0, u32x4 (&v)[4], int lane) {
    const int rr = lane >> 3, ch = lane & 7; const char* hb = (const char*)(base + (size_t)d.bh * S * HD); const unsigned cst = (unsigned)(d.r * 128 + ch * 16);
#pragma unroll
    for (int i = 0; i < 4; ++i) v[i] = *(const u32x4*)(hb + (((unsigned)med3i(i0 + rr + 8 * i, 0, d.L - 1) << (d.sh + 7)) + cst));
}
DEV void attn_ldkv(const Args& a, const AttnIt& d, int kk, u32x4 (&k)[4], u32x4 (&v)[4], int lane) {
    const int rr = lane >> 3, ch = lane & 7, i0 = d.q0 - 64 + 32 * kk; const unsigned cst = (unsigned)(d.r * 128 + ch * 16);
    const char* kb = (const char*)((const bf16_t*)(a.ws + WS_AK) + (size_t)d.bh * S * HD); const char* vb = (const char*)((const bf16_t*)(a.ws + WS_AV) + (size_t)d.bh * S * HD);
#pragma unroll
    for (int i = 0; i < 4; ++i) { const unsigned off = ((unsigned)med3i(i0 + rr + 8 * i, 0, d.L - 1) << (d.sh + 7)) + cst; k[i] = *(const u32x4*)(kb + off); v[i] = *(const u32x4*)(vb + off); }
}
DEV void attn_items(const Args& a, unsigned char* lds, int wg, int G, int lane, int wave) {
    unsigned char* ws = a.ws;
    constexpr int NIT = 3 * 512; constexpr float THR = 6.f;
    const int x = wg & 7, NGW = (G >> 3) * NWM;
    int item = (wg >> 3) * NWM + wave; if (item >= NIT) return;
    LAS unsigned char* slot = (LAS unsigned char*)lds + wave * MIX_WAVE_LDS; lds_cptr slot3 = (lds_cptr)slot; LAS unsigned char* kslot = slot + VSLOT;
    const int t = lane & 31, hi = lane >> 5, rr = lane >> 3, ch = lane & 7;
    AttnIt d; attn_decode(item, x, d);
    bf16x8 qf[2][4], kf[4]; u32x4 kraw[4], vv[4];
    attn_ldkv(a, d, d.kmin, kraw, vv, lane);
    for (;;) {
        const LAS float* tph = (const LAS float*)((LAS unsigned char*)lds + MIX_BIAS_OFF) + (d.p * NH + (d.bh & 7)) * 192 + (32 + 4 * hi - t);
        f32x16 o[2][2] = {}; float m[2] = {0.f, 0.f}, l[2] = {0.f, 0.f};
        const int nitem = item + NGW; const bool hasn = nitem < NIT;
        AttnIt dn = d; if (hasn) attn_decode(nitem, x, dn);
#pragma unroll
        for (int j = 0; j < 2; ++j) { u32x4 qraw[4]; attn_ldrows((const bf16_t*)(ws + WS_AQ), d, d.q0 + 32 * j, qraw, lane); stage_rows_k(kslot, qraw, lane); asm volatile("" ::: "memory"); read_row_frags(qf[j], kslot, lane); asm volatile("" ::: "memory"); }
        for (int kk = d.kmin; kk <= d.kmax; ++kk) {
            const int kbase = d.q0 - 64 + 32 * kk;
#pragma unroll
            for (int i = 0; i < 4; ++i) *(LAS u32x4*)(slot + (rr + 8 * i) * VROW + ch * 16) = vv[i];
            stage_rows_k(kslot, kraw, lane);
            asm volatile("" ::: "memory");
            read_row_frags(kf, kslot, lane);
            const bf16x8 v00 = tr_frag(slot3, 0, 0, lane), v10 = tr_frag(slot3, 1, 0, lane), v01 = tr_frag(slot3, 0, 1, lane), v11 = tr_frag(slot3, 1, 1, lane);
            asm volatile("" ::: "memory");
            if (kk < d.kmax) attn_ldkv(a, d, kk + 1, kraw, vv, lane);
            else if (hasn) attn_ldkv(a, dn, dn.kmin, kraw, vv, lane);
            const bool edge = kbase < 0 || kbase + 31 >= d.L;
            f32x16 sc[2] = {};
#pragma unroll
            for (int st = 0; st < 4; ++st) { sc[0] = MFMA32(kf[st], qf[0][st], sc[0]); sc[1] = MFMA32(kf[st], qf[1][st], sc[1]); }
            float mx[2]; bool mv = false;
#pragma unroll
            for (int j = 0; j < 2; ++j) {
                const int kj = kk - j; const bool act = kj >= 0 && kj <= 4; const LAS float* tb = tph + 32 * (act ? kj : 0); const float moff = act ? m[j] : 1e30f;
#pragma unroll
                for (int rg = 0; rg < 16; ++rg) sc[j][rg] = (sc[j][rg] - moff) + tb[(rg & 3) + 8 * (rg >> 2)];
                if (edge) {
#pragma unroll
                    for (int rg = 0; rg < 16; ++rg) { const int ki = kbase + crow(rg, hi); sc[j][rg] = (ki >= 0 && ki < d.L) ? sc[j][rg] : -1e30f; } }
                float t0 = fmaxf(fmaxf(sc[j][0], sc[j][1]), fmaxf(sc[j][2], sc[j][3]));
#pragma unroll
                for (int rg = 4; rg < 16; rg += 4) t0 = fmaxf(t0, fmaxf(fmaxf(sc[j][rg], sc[j][rg + 1]), fmaxf(sc[j][rg + 2], sc[j][rg + 3])));
                mx[j] = max_halves(t0);
                const bool first = act && (kj == 0 || kk == d.kmin);
                mv = mv || first || (act && __any(mx[j] > THR));
            }
            if (mv) {
#pragma unroll
                for (int j = 0; j < 2; ++j) { const int kj = kk - j; const bool act = kj >= 0 && kj <= 4, first = act && (kj == 0 || kk == d.kmin);
                    const float dl = !act ? 0.f : (first ? mx[j] : fmaxf(mx[j], 0.f)), f = ex2(-dl); m[j] += dl; l[j] *= f;
#pragma unroll
                    for (int rg = 0; rg < 16; ++rg) { sc[j][rg] -= dl; o[j][0][rg] *= f; o[j][1][rg] *= f; } }
            }
#pragma unroll
            for (int j = 0; j < 2; ++j) { float ps0 = 0.f, ps1 = 0.f;
#pragma unroll
                for (int rg = 0; rg < 16; rg += 2) { sc[j][rg] = ex2(sc[j][rg]); sc[j][rg + 1] = ex2(sc[j][rg + 1]); ps0 += sc[j][rg]; ps1 += sc[j][rg + 1]; }
                l[j] += ps0 + ps1; }
            { const bf16x8 p00 = pack_p(sc[0], 0), p01 = pack_p(sc[0], 1), p10 = pack_p(sc[1], 0), p11 = pack_p(sc[1], 1);
              o[0][0] = MFMA32(v00, p00, o[0][0]); o[0][1] = MFMA32(v01, p00, o[0][1]); o[1][0] = MFMA32(v00, p10, o[1][0]); o[1][1] = MFMA32(v01, p10, o[1][1]);
              o[0][0] = MFMA32(v10, p01, o[0][0]); o[0][1] = MFMA32(v11, p01, o[0][1]); o[1][0] = MFMA32(v10, p11, o[1][0]); o[1][1] = MFMA32(v11, p11, o[1][1]); }
        }
#pragma unroll
        for (int j = 0; j < 2; ++j) {
            float lt = sum_halves(l[j]);
            const float il = 1.f / lt;
            const size_t orow = ((size_t)d.p * NB * NH + d.bh) * S + (size_t)(((d.q0 + 32 * j + t) << d.sh) + d.r);
#pragma unroll
            for (int g4 = 0; g4 < 4; ++g4) {
                *(LAS u32x2*)(kslot + t * KROW + (8 * g4 + 4 * hi) * 2) = (u32x2){pg8::cvt_pk_bf16(o[j][0][4 * g4] * il, o[j][0][4 * g4 + 1] * il), pg8::cvt_pk_bf16(o[j][0][4 * g4 + 2] * il, o[j][0][4 * g4 + 3] * il)};
                *(LAS u32x2*)(kslot + t * KROW + (32 + 8 * g4 + 4 * hi) * 2) = (u32x2){pg8::cvt_pk_bf16(o[j][1][4 * g4] * il, o[j][1][4 * g4 + 1] * il), pg8::cvt_pk_bf16(o[j][1][4 * g4 + 2] * il, o[j][1][4 * g4 + 3] * il)};
            }
            asm volatile("" ::: "memory");
            { bf16_t* ob = (bf16_t*)(ws + WS_ATTO) + ((size_t)d.p * NB * NH + d.bh) * S * HD;
#pragma unroll
              for (int i = 0; i < 4; ++i) { const u32x4 w = *(const LAS u32x4*)(kslot + (rr + 8 * i) * KROW + ch * 16);
                  *(u32x4*)(ob + (size_t)(((d.q0 + 32 * j + rr + 8 * i) << d.sh) + d.r) * HD + ch * 8) = w; } }
            asm volatile("" ::: "memory");
            if (hi == 0) ((float*)(ws + (d.p == 0 ? WS_ATTL0 : (d.p == 1 ? WS_ATTL1 : WS_ATTL2))))[(size_t)d.bh * S + (size_t)(((d.q0 + 32 * j + t) << d.sh) + d.r)] = m[j] + __log2f(lt);
        }
        if (!hasn) break;
        item = nitem; d = dn;
    }
}
DEV void retstate_item(const Args& a, unsigned char* lds, int item, int xg, int lane, int wave) {
    unsigned char* ws = a.ws;
    const int dir = item & 1, n = (item >> 1) & 31, bh = 8 * xg + (item >> 6), h = bh & 7;
    const bf16_t* Kc = (const bf16_t*)(ws + WS_RK) + ((size_t)bh * S + n * 128) * HD; const bf16_t* Vc = (const bf16_t*)(ws + WS_RV) + ((size_t)bh * S + n * 128) * HD;
    const float lg = a.in[IN_DECAY][dir * NH + h] * LOG2E;
    LAS unsigned char* vs = (LAS unsigned char*)lds + wave * MIX_WAVE_LDS; LAS unsigned char* ks = vs + VSLOT; lds_cptr vs3 = (lds_cptr)vs, ks3 = (lds_cptr)ks;
    f32x16 acc[2][2] = {};
    for (int blk = 0; blk < 4; ++blk) {
        { const int rr = lane >> 3, ch = lane & 7;
          u32x4 v[4], k[4];
#pragma unroll
          for (int i = 0; i < 4; ++i) { const int mrow = 32 * blk + rr + 8 * i; v[i] = *(const u32x4*)(Vc + (size_t)mrow * HD + ch * 8); k[i] = *(const u32x4*)(Kc + (size_t)mrow * HD + ch * 8); }
#pragma unroll
          for (int i = 0; i < 4; ++i) { const int mrow = 32 * blk + rr + 8 * i; const float z = ex2(lg * (float)(dir == 0 ? 127 - mrow : mrow));
              const unsigned kw[4] = {k[i].x, k[i].y, k[i].z, k[i].w}; u32x4 o;
              o.x = pg8::cvt_pk_bf16(bf2f(kw[0] & 0xffffu) * z, bf2f(kw[0] >> 16) * z); o.y = pg8::cvt_pk_bf16(bf2f(kw[1] & 0xffffu) * z, bf2f(kw[1] >> 16) * z);
              o.z = pg8::cvt_pk_bf16(bf2f(kw[2] & 0xffffu) * z, bf2f(kw[2] >> 16) * z); o.w = pg8::cvt_pk_bf16(bf2f(kw[3] & 0xffffu) * z, bf2f(kw[3] >> 16) * z);
              *(LAS u32x4*)(vs + (rr + 8 * i) * VROW + ch * 16) = v[i]; *(LAS u32x4*)(ks + (rr + 8 * i) * VROW + ch * 16) = o; } }
        LDS_WAIT();
#pragma unroll
        for (int s = 0; s < 2; ++s) {
            const bf16x8 v0 = tr_frag(vs3, s, 0, lane), v1 = tr_frag(vs3, s, 1, lane), k0 = tr_frag(ks3, s, 0, lane), k1 = tr_frag(ks3, s, 1, lane);
            acc[0][0] = MFMA32(v0, k0, acc[0][0]); acc[0][1] = MFMA32(v0, k1, acc[0][1]); acc[1][0] = MFMA32(v1, k0, acc[1][0]); acc[1][1] = MFMA32(v1, k1, acc[1][1]);
        }
        LDS_WAIT();
    }
    bf16_t* KT = (bf16_t*)(ws + WS_KF) + (((size_t)dir * NB * NH + bh) * 32 + n) * 4096;
    const int c = lane & 31, hi = lane >> 5;
#pragma unroll
    for (int eb = 0; eb < 2; ++eb)
#pragma unroll
        for (int db = 0; db < 2; ++db)
#pragma unroll
            for (int rg = 0; rg < 16; ++rg) KT[(32 * eb + crow(rg, hi)) * 64 + 32 * db + c] = (bf16_t)f2bf(acc[eb][db][rg]);
}
DEV void phase_scan(const Args& a, int xg, int gtid, int NT) {
    unsigned char* ws = a.ws;
    for (int sl = gtid; sl < 2 * NH * 1024; sl += NT) {
        const int dir = sl >> 13, bh = 8 * xg + ((sl >> 10) & 7), q = sl & 1023, h = bh & 7;
        const float gC = ex2(a.in[IN_DECAY][dir * NH + h] * LOG2E * 128.f);
        const uint2* kt = (const uint2*)(ws + WS_KF) + ((size_t)dir * NB * NH + bh) * 32 * 1024 + q;
        uint2* st = (uint2*)(ws + st_off(dir, bh, 0)) + q;
        float4 s = make_float4(0.f, 0.f, 0.f, 0.f);
        for (int i = 0; i < 32; ++i) { const int n = dir == 0 ? i : 31 - i;
            st[(size_t)n * 1024] = make_uint2(pg8::cvt_pk_bf16(s.x, s.y), pg8::cvt_pk_bf16(s.z, s.w));
            const uint2 kv = kt[(size_t)n * 1024];
            s.x = gC * s.x + bf2f(kv.x & 0xffffu); s.y = gC * s.y + bf2f(kv.x >> 16); s.z = gC * s.z + bf2f(kv.y & 0xffffu); s.w = gC * s.w + bf2f(kv.y >> 16); }
    }
}
DEV void ld_rows32(const bf16_t* base, u32x4 (&v)[4], int lane) {
    const char* b = (const char*)base; const unsigned off = (unsigned)((lane >> 3) * 128 + (lane & 7) * 16);
#pragma unroll
    for (int i = 0; i < 4; ++i) v[i] = *(const u32x4*)(b + off + i * 1024);
}
DEV void retout_item(const Args& a, unsigned char* lds, int item, int xg, int lane, int wave) {
    unsigned char* ws = a.ws;
    const int hq = item & 1, n = (item >> 1) & 31, bh = 8 * xg + (item >> 6), h = bh & 7, b = bh >> 3;
    const bf16_t* Qc = (const bf16_t*)(ws + WS_RQ) + ((size_t)bh * S + n * 128) * HD; const bf16_t* Kc = (const bf16_t*)(ws + WS_RK) + ((size_t)bh * S + n * 128) * HD;
    const bf16_t* Vc = (const bf16_t*)(ws + WS_RV) + ((size_t)bh * S + n * 128) * HD; const bf16_t* Gc = (const bf16_t*)(ws + WS_RG) + ((size_t)bh * S + n * 128) * HD;
    const bf16_t* SF = (const bf16_t*)(ws + st_off(0, bh, n)); const bf16_t* SB = (const bf16_t*)(ws + st_off(1, bh, n));
    const float lg0 = a.in[IN_DECAY][h] * LOG2E, lg1 = a.in[IN_DECAY][NH + h] * LOG2E;
    LAS unsigned char* slot = (LAS unsigned char*)lds + wave * MIX_WAVE_LDS; lds_cptr slot3 = (lds_cptr)slot; LAS unsigned char* kslot = slot + VSLOT;
    const int t = lane & 31, hi = lane >> 5, rr = lane >> 3, ch = lane & 7;
    bf16x8 qf[2][4];
#pragma unroll
    for (int j = 0; j < 2; ++j) { u32x4 raw[4]; ld_rows32(Qc + (size_t)(64 * hq + 32 * j) * HD, raw, lane); stage_rows_k(kslot, raw, lane); asm volatile("" ::: "memory"); read_row_frags(qf[j], kslot, lane); asm volatile("" ::: "memory"); }
    f32x16 o[2][2] = {};
#pragma unroll
    for (int dir = 0; dir < 2; ++dir) {
#pragma unroll
        for (int eb = 0; eb < 2; ++eb) { u32x4 raw[4]; bf16x8 sf[4]; ld_rows32((dir == 0 ? SF : SB) + (size_t)(32 * eb) * 64, raw, lane); stage_rows_k(kslot, raw, lane); asm volatile("" ::: "memory"); read_row_frags(sf, kslot, lane); asm volatile("" ::: "memory");
#pragma unroll
            for (int j = 0; j < 2; ++j)
#pragma unroll
                for (int st = 0; st < 4; ++st) o[j][eb] = MFMA32(sf[st], qf[j][st], o[j][eb]); }
#pragma unroll
        for (int j = 0; j < 2; ++j) { const int c = 64 * hq + 32 * j + t; const float f = dir == 0 ? ex2(lg0 * (float)(c + 1) - lg1 * (float)(128 - c)) : ex2(lg1 * (float)(128 - c));
#pragma unroll
            for (int rg = 0; rg < 16; ++rg) { o[j][0][rg] *= f; o[j][1][rg] *= f; } }
    }
    float f1[4], f2[4], b1[4], b2[4];
#pragma unroll
    for (int i = 0; i < 4; ++i) { f1[i] = __builtin_bit_cast(float, __builtin_amdgcn_readfirstlane(__builtin_bit_cast(int, ex2(-lg0 * (float)i)))); f2[i] = __builtin_bit_cast(float, __builtin_amdgcn_readfirstlane(__builtin_bit_cast(int, ex2(-lg0 * (float)(8 * i)))));
        b1[i] = __builtin_bit_cast(float, __builtin_amdgcn_readfirstlane(__builtin_bit_cast(int, ex2(lg1 * (float)i)))); b2[i] = __builtin_bit_cast(float, __builtin_amdgcn_readfirstlane(__builtin_bit_cast(int, ex2(lg1 * (float)(8 * i))))); }
#pragma nounroll
    for (int kb = 0; kb < 4; ++kb) {
        { u32x4 kraw[4], vv[4]; ld_rows32(Kc + (size_t)(32 * kb) * HD, kraw, lane); ld_rows32(Vc + (size_t)(32 * kb) * HD, vv, lane);
#pragma unroll
        for (int i = 0; i < 4; ++i) *(LAS u32x4*)(slot + (rr + 8 * i) * VROW + ch * 16) = vv[i];
        stage_rows_k(kslot, kraw, lane); }
        asm volatile("" ::: "memory");
        bf16x8 kf[4]; read_row_frags(kf, kslot, lane);
        const bf16x8 v00 = tr_frag(slot3, 0, 0, lane), v10 = tr_frag(slot3, 1, 0, lane), v01 = tr_frag(slot3, 0, 1, lane), v11 = tr_frag(slot3, 1, 1, lane);
        asm volatile("" ::: "memory");
#pragma unroll
        for (int j = 0; j < 2; ++j) {
            const int qbi = 2 * hq + j;
            f32x16 sc = {};
#pragma unroll
            for (int st = 0; st < 4; ++st) sc = MFMA32(kf[st], qf[j][st], sc);
            if (kb < qbi) { const float A = ex2(lg0 * (float)(32 * (qbi - kb) + t - 4 * hi)); float a2[4];
#pragma unroll
                for (int q = 0; q < 4; ++q) a2[q] = A * f2[q];
#pragma unroll
                for (int rg = 0; rg < 16; ++rg) sc[rg] *= a2[rg >> 2] * f1[rg & 3];
            } else if (kb > qbi) { const float A = ex2(lg1 * (float)(32 * (kb - qbi) - t + 4 * hi)); float a2[4];
#pragma unroll
                for (int q = 0; q < 4; ++q) a2[q] = A * b2[q];
#pragma unroll
                for (int rg = 0; rg < 16; ++rg) sc[rg] *= a2[rg >> 2] * b1[rg & 3];
            } else {
                int tt = t - 4 * hi; asm volatile("" : "+v"(tt));
#pragma unroll
                for (int rg = 0; rg < 16; ++rg) { const int df = tt - ((rg & 3) + 8 * (rg >> 2)); sc[rg] *= df >= 0 ? ex2(lg0 * (float)df) : ex2(lg1 * (float)(-df)); }
            }
            const bf16x8 p0 = pack_p(sc, 0), p1 = pack_p(sc, 1);
            o[j][0] = MFMA32(v00, p0, o[j][0]); o[j][0] = MFMA32(v10, p1, o[j][0]);
            o[j][1] = MFMA32(v01, p0, o[j][1]); o[j][1] = MFMA32(v11, p1, o[j][1]);
        }
    }
    const float* gn = a.in[IN_GN] + h * HD; const unsigned gnoff = (unsigned)(16 * hi); LAS unsigned char* kq = kslot + t * KROW + 8 * hi;
#pragma unroll
    for (int j = 0; j < 2; ++j) {
        const int r0 = n * 128 + 64 * hq + 32 * j;
        { u32x4 raw[4]; ld_rows32(Gc + (size_t)(64 * hq + 32 * j) * HD, raw, lane); stage_rows_k(kslot, raw, lane); asm volatile("" ::: "memory"); }
        float sm = 0.f;
#pragma unroll
        for (int rg = 0; rg < 16; ++rg) sm += o[j][0][rg] + o[j][1][rg];
        sm = sum_halves(sm); const float mu = sm * (1.f / 64.f); float vq = 0.f;
#pragma unroll
        for (int rg = 0; rg < 16; ++rg) { const float d0 = o[j][0][rg] - mu, d1 = o[j][1][rg] - mu; vq += d0 * d0 + d1 * d1; }
        vq = sum_halves(vq); const float rstd = rsqrtf(vq * (1.f / 64.f) + EPS);
        u32x2 ow[2][4];
#pragma unroll
        for (int db = 0; db < 2; ++db)
#pragma unroll
            for (int g4 = 0; g4 < 4; ++g4) { const u32x2 gw = *(const LAS u32x2*)(kq + (32 * db + 8 * g4) * 2); const float4 gg = *(const float4*)((const char*)gn + gnoff + (32 * db + 8 * g4) * 4);
                const float gate[4] = {bf2f(gw[0] & 0xffffu), bf2f(gw[0] >> 16), bf2f(gw[1] & 0xffffu), bf2f(gw[1] >> 16)}; const float gv[4] = {gg.x, gg.y, gg.z, gg.w}; float ov[4];
#pragma unroll
                for (int i = 0; i < 4; ++i) ov[i] = (o[j][db][4 * g4 + i] - mu) * rstd * gv[i] * (gate[i] * __builtin_amdgcn_rcpf(1.f + ex2(-gate[i] * LOG2E)));
                ow[db][g4] = (u32x2){pg8::cvt_pk_bf16(ov[0], ov[1]), pg8::cvt_pk_bf16(ov[2], ov[3])}; }
        asm volatile("" ::: "memory");
#pragma unroll
        for (int db = 0; db < 2; ++db)
#pragma unroll
            for (int g4 = 0; g4 < 4; ++g4) *(LAS u32x2*)(kq + (32 * db + 8 * g4) * 2) = ow[db][g4];
        asm volatile("" ::: "memory");
        { bf16_t* ob = (bf16_t*)(ws + WS_XN) + ((size_t)b * S + r0) * D + h * HD;
#pragma unroll
          for (int i = 0; i < 4; ++i) { const u32x4 w = *(const LAS u32x4*)(kslot + (rr + 8 * i) * KROW + ch * 16); *(u32x4*)(ob + (size_t)(rr + 8 * i) * D + ch * 8) = w; } }
        asm volatile("" ::: "memory");
    }
}
DEV void phase_attn_merge(const Args& a, int xg, int gtid, int NT) {
    unsigned char* ws = a.ws; const bf16_t* O = (const bf16_t*)(ws + WS_ATTO); bf16_t* mixed = (bf16_t*)(ws + WS_XN);
    for (int it = gtid; it < NH * S * 8; it += NT) {
        const int ch = it & 7, row = xg * NH * S + (it >> 3);
        const int bh = row >> 12, pos = row & 4095, b = bh >> 3, h = bh & 7;
        const float l0 = ((const float*)(ws + WS_ATTL0))[row], l1 = ((const float*)(ws + WS_ATTL1))[row], l2 = ((const float*)(ws + WS_ATTL2))[row];
        const float mx = fmaxf(l0, fmaxf(l1, l2)); float w0 = ex2(l0 - mx), w1 = ex2(l1 - mx), w2 = ex2(l2 - mx); const float is = 1.f / (w0 + w1 + w2); w0 *= is; w1 *= is; w2 *= is;
        const uint4 a0 = *(const uint4*)(O + (size_t)row * HD + ch * 8), a1 = *(const uint4*)(O + ((size_t)NB * NH * S + row) * HD + ch * 8), a2 = *(const uint4*)(O + ((size_t)2 * NB * NH * S + row) * HD + ch * 8);
        const unsigned x0[4] = {a0.x, a0.y, a0.z, a0.w}, x1[4] = {a1.x, a1.y, a1.z, a1.w}, x2[4] = {a2.x, a2.y, a2.z, a2.w}; unsigned o[4];
#pragma unroll
        for (int j = 0; j < 4; ++j) o[j] = pg8::cvt_pk_bf16(w0 * bf2f(x0[j] & 0xffffu) + w1 * bf2f(x1[j] & 0xffffu) + w2 * bf2f(x2[j] & 0xffffu), w0 * bf2f(x0[j] >> 16) + w1 * bf2f(x1[j] >> 16) + w2 * bf2f(x2[j] >> 16));
        *(uint4*)(mixed + ((size_t)b * S + pos) * D + 512 + h * HD + ch * 8) = make_uint4(o[0], o[1], o[2], o[3]);
    }
}
DEV void phase_mix_a(const Args& a, unsigned char* lds, int wg, int G, int lane, int wave, int tid) {
    { const float* bt = (const float*)(a.ws + WS_BIAS); LAS float* bl = (LAS float*)((LAS unsigned char*)lds + MIX_BIAS_OFF);
      for (int i = tid; i < 3 * NH * 192; i += NTHR) { const int ph = i / 192, bi = i % 192 - 32; bl[i] = (bi >= 0 && bi <= 128) ? bt[ph * 129 + bi] : -1e30f; } }
    __syncthreads();
    if (wave >= NWM) {
        for (int rep = 0; rep < a.rep[5]; ++rep) { asm volatile("" : "+v"(lane)); phase_latew(a, lds, wg * (NWAVES - NWM) + (wave - NWM), G * (NWAVES - NWM), lane, wave); }
        return;
    }
    const int x = wg & 7, wq = (wg >> 3) * NWM + wave, WPX = (G >> 3) * NWM;
    for (int rep = 0; rep < a.rep[0]; ++rep) { asm volatile("" : "+v"(lane)); for (int it = wq; it < 2 * 32 * NH; it += WPX) retstate_item(a, lds, it, x, lane, wave); }
    for (int rep = 0; rep < a.rep[1]; ++rep) { asm volatile("" : "+v"(lane)); attn_items(a, lds, wg, G, lane, wave); }
}
DEV void phase_mix_b(const Args& a, unsigned char* lds, int wg, int G, int lane, int wave, int tid) {
    const int x = wg & 7, wq = (wg >> 3) * NWAVES + wave, WPX = (G >> 3) * NWAVES;
    for (int rep = 0; rep < a.rep[2]; ++rep) { asm volatile("" : "+v"(lane)); for (int it = wq; it < NH * 32 * 2; it += WPX) retout_item(a, lds, it, x, lane, wave); }
    for (int rep = 0; rep < a.rep[3]; ++rep) { asm volatile("" : "+v"(tid)); phase_attn_merge(a, x, (wg >> 3) * NTHR + tid, (G >> 3) * NTHR); }
}
#define XB_TMO      128
#define XB_XCNT(j)  (256  + 64 * (j))
#define XB_XSUB(j)  (1280 + 64 * (j))
#define XB_XGEN(j)  (2304 + 64 * (j))
#define XB_TOP      3328
#define XB_TOPGEN   3392
#define XCD_BAR_WORDS 3456
#define XB_SPIN_CAP (1u << 18)

__device__ __forceinline__ unsigned xb_ld(unsigned* p)              { return __hip_atomic_load(p, __ATOMIC_RELAXED, __HIP_MEMORY_SCOPE_AGENT); }
__device__ __forceinline__ unsigned xb_add(unsigned* p, unsigned v) { return __hip_atomic_fetch_add(p, v, __ATOMIC_RELAXED, __HIP_MEMORY_SCOPE_AGENT); }
__device__ __forceinline__ unsigned xb_xcc_id() { return (unsigned)__builtin_amdgcn_s_getreg((3 << 11) | 20) & 0xFu; }
#define XB_SPIN(cond, bar) do { unsigned _sp = 0; while (cond) { __builtin_amdgcn_s_sleep(1); \
    if ((++_sp & 255u) == 0u) { if (xb_ld(&(bar)[XB_TMO])) break; if (_sp > XB_SPIN_CAP) { atomicAdd(&(bar)[XB_TMO], 1u); break; } } } } while (0)

struct XcdBarrier {
    unsigned* bar; unsigned x;
    volatile LAS unsigned* st;
};

__device__ __forceinline__ XcdBarrier xcd_barrier_post(unsigned* bar, volatile LAS unsigned* st) {
    XcdBarrier b; b.bar = bar; b.x = xb_xcc_id(); b.st = st;
    if (threadIdx.x == 0) (void)xb_add(&bar[XB_XCNT(b.x)], 1u);
    return b;
}
__device__ __forceinline__ void xcd_barrier_complete(unsigned* bar, unsigned x, unsigned& nloc, unsigned& nx) {
    const unsigned G = gridDim.x * gridDim.y * gridDim.z;
    unsigned sum, cnt, mine, sp = 0u;
    for (;;) {
        sum = 0u; cnt = 0u; mine = 0u;
#pragma unroll
        for (unsigned j = 0; j < 16; ++j) { const unsigned c = xb_ld(&bar[XB_XCNT(j)]); sum += c; cnt += (c > 0u) ? 1u : 0u; mine = (j == x) ? c : mine; }
        if (sum == G) break;
        __builtin_amdgcn_s_sleep(1);
        if ((++sp & 255u) == 0u) { if (xb_ld(&bar[XB_TMO])) break; if (sp > XB_SPIN_CAP) { atomicAdd(&bar[XB_TMO], 1u); break; } }
    }
    nloc = mine > 0u ? mine : 1u; nx = cnt > 0u ? cnt : 1u;
}

__device__ __forceinline__ void xcd_barrier(const XcdBarrier& b) {
    asm volatile("s_waitcnt vmcnt(0)" ::: "memory");
    __syncthreads();
    if (threadIdx.x == 0) {
        unsigned* bar = b.bar;
        __builtin_amdgcn_s_waitcnt(0);
        unsigned nloc = b.st[0], nx = b.st[1];
        if (nloc == 0u) { xcd_barrier_complete(bar, b.x, nloc, nx); b.st[0] = nloc; b.st[1] = nx; }
        const unsigned old = xb_add(&bar[XB_XSUB(b.x)], 1u);
        const unsigned gen = old / nloc;
        if (old + 1u == (gen + 1u) * nloc) {
            __builtin_amdgcn_fence(__ATOMIC_RELEASE, "agent");
            asm volatile("s_waitcnt vmcnt(0)" ::: "memory");
            const unsigned og = xb_add(&bar[XB_TOP], 1u);
            const unsigned tg = og / nx;
            if (og + 1u == (tg + 1u) * nx) xb_add(&bar[XB_TOPGEN], 1u);
            else XB_SPIN(xb_ld(&bar[XB_TOPGEN]) == tg, bar);
            __builtin_amdgcn_fence(__ATOMIC_ACQUIRE, "agent");
            xb_add(&bar[XB_XGEN(b.x)], 1u);
            asm volatile("s_waitcnt vmcnt(0)" ::: "memory");
        } else {
            XB_SPIN(xb_ld(&bar[XB_XGEN(b.x)]) == gen, bar);
            __builtin_amdgcn_fence(__ATOMIC_ACQUIRE, "agent");
            asm volatile("s_waitcnt vmcnt(0)" ::: "memory");
        }
    }
    __syncthreads();
}


#define GB_GC(g)     (8192 + 64 * (g))
#define GB_N(g, j)   (9216 + 16 * (16 * (g) + (j)))
#define GB_A(g, j)   (11264 + 16 * (16 * (g) + (j)))
struct GroupBarrier { unsigned* ctl; unsigned g, x, ng; volatile LAS unsigned* st; };
__device__ __forceinline__ GroupBarrier group_barrier_post(unsigned* ctl, unsigned g, unsigned ng, volatile LAS unsigned* st) {
    GroupBarrier b; b.ctl = ctl; b.g = g; b.x = xb_xcc_id(); b.ng = ng; b.st = st;
    if (threadIdx.x == 0) (void)xb_add(&ctl[GB_N(g, b.x)], 1u);
    return b;
}
__device__ __forceinline__ void group_barrier(const GroupBarrier& b, unsigned epoch) {
    asm volatile("s_waitcnt vmcnt(0)" ::: "memory");
    __syncthreads();
    if (threadIdx.x == 0) {
        unsigned* ctl = b.ctl; unsigned n = b.st[0];
        if (n == 0u) {
            unsigned sp = 0u;
            for (;;) { unsigned sum = 0u, mine = 0u;
#pragma unroll
                for (unsigned j = 0; j < 16; ++j) { const unsigned c = xb_ld(&ctl[GB_N(b.g, j)]); sum += c; mine = (j == b.x) ? c : mine; }
                n = mine; if (sum == b.ng) break;
                __builtin_amdgcn_s_sleep(1); if (++sp > (1u << 22)) break; }
            n = n ? n : 1u; b.st[0] = n;
        }
        const unsigned old = xb_add(&ctl[GB_A(b.g, b.x)], 1u);
        if (old + 1u == epoch * n) {
            __builtin_amdgcn_fence(__ATOMIC_RELEASE, "agent");
            asm volatile("s_waitcnt vmcnt(0)" ::: "memory");
            (void)xb_add(&ctl[GB_GC(b.g)], n);
        }
        unsigned sp = 0u; const unsigned target = epoch * b.ng;
        while (xb_ld(&ctl[GB_GC(b.g)]) < target) { __builtin_amdgcn_s_sleep(1); if (++sp > (1u << 22)) break; }
        __builtin_amdgcn_fence(__ATOMIC_ACQUIRE, "agent");
        asm volatile("s_waitcnt vmcnt(0)" ::: "memory");
    }
    __syncthreads();
}
#ifndef MK_LAUNCHES
#define MK_LAUNCHES 1
#endif
#ifndef WGM_MOE1
#define WGM_MOE1 8
#endif
#ifndef WGM_MOE2
#define WGM_MOE2 8
#endif
constexpr int NPH = 11;
typedef const __attribute__((address_space(4))) Args* kargs_t;
DEV Args load_args(kargs_t kp) { Args a;
#pragma unroll
    for (int i = 0; i < 13; ++i) a.in[i] = kp->in[i];
    a.out = kp->out; a.ws = kp->ws; a.ph_lo = kp->ph_lo; a.ph_hi = kp->ph_hi;
#pragma unroll
    for (int i = 0; i < 16; ++i) a.rep[i] = kp->rep[i];
    return a; }
__global__ void __launch_bounds__(NTHR, 2) mega(Args a_) {
    kargs_t kp = (kargs_t)__builtin_amdgcn_kernarg_segment_ptr();
    extern __shared__ __attribute__((aligned(16))) unsigned char lds[];
    int tid = threadIdx.x, lane = tid & 63, wave = __builtin_amdgcn_readfirstlane(tid >> 6);
    const int G = gridDim.x, wg = blockIdx.x, NGW = G * NWAVES; int gw = wg * NWAVES + wave;
#define FRESH_IDS() do { tid = threadIdx.x; asm volatile("" : "+v"(tid)); lane = tid & 63; wave = __builtin_amdgcn_readfirstlane(tid >> 6); gw = wg * NWAVES + wave; } while (0)
    const int lo = kp->ph_lo, hi = kp->ph_hi;
    unsigned char* ws = kp->ws;
    volatile LAS unsigned* bst = (volatile LAS unsigned*)((LAS unsigned char*)lds + LDS_BYTES - 64);
    if (tid < 4) bst[tid] = 0u;
    __syncthreads();
    XcdBarrier bar = xcd_barrier_post((unsigned*)(ws + WS_CTL) + 4096, bst);
    const GroupBarrier gbar = group_barrier_post((unsigned*)(ws + WS_CTL), (unsigned)(wg & 7), (unsigned)(G >> 3), bst + 2);
#define IN(k) (lo <= (k) && (k) < hi)
#define SEAM(k) do { if (IN(k) && IN((k) + 1)) { if ((k) >= 1 && (k) <= 6) group_barrier(gbar, (unsigned)(k)); else xcd_barrier(bar); } } while (0)
    if (IN(0)) { FRESH_IDS(); const Args a = load_args(kp); unsigned char* ws = a.ws; for (int r = 0; r < a.rep[6]; ++r) { FRESH_IDS(); phase_prep(a, lds, gw, NGW, lane, wave); } }
    SEAM(0);
    if (IN(1)) { FRESH_IDS(); const Args a = load_args(kp); unsigned char* ws = a.ws; pg8::Gemm g{(const bf16_t*)(ws + WS_XN), (const bf16_t*)(ws + WS_WIN), D}; SchedPlain Sc; Sc.init(M, PC, G, wg); Sc.rowbytes = D * 2;
        EpiInProj E{ws, (const float*)(ws + WS_ROPE)};
        for (int r = 0; r < a.rep[8]; ++r) { FRESH_IDS(); pg8::Gemm g2 = g; asm volatile("" : "+s"(g2.A), "+s"(g2.Bt)); pg8::gemm_phase<EpiInProj, SchedPlain, true>((LAS unsigned char*)lds, g2, Sc, E); } }
    SEAM(1);
    if (IN(2)) { FRESH_IDS(); const Args a = load_args(kp); unsigned char* ws = a.ws; phase_mix_a(a, lds, wg, G, lane, wave, tid); }
    SEAM(2);
    if (IN(3)) { FRESH_IDS(); const Args a = load_args(kp); unsigned char* ws = a.ws; for (int r = 0; r < a.rep[13]; ++r) { FRESH_IDS(); phase_scan(a, wg & 7, (wg >> 3) * NTHR + tid, (G >> 3) * NTHR); } }
    SEAM(3);
    if (IN(4)) { FRESH_IDS(); const Args a = load_args(kp); unsigned char* ws = a.ws; phase_mix_b(a, lds, wg, G, lane, wave, tid); }
    SEAM(4);
    { const Args a = load_args(kp); for (int r = 0; r < a.rep[14]; ++r) xcd_barrier(bar); for (int r = 0; r < a.rep[15]; ++r) cg::this_grid().sync(); }
    if (IN(5)) { FRESH_IDS(); const Args a = load_args(kp); unsigned char* ws = a.ws; pg8::Gemm g{(const bf16_t*)(ws + WS_XN), (const bf16_t*)(ws + WS_WOUT), D}; SchedPlain Sc; Sc.init(M, D, G, wg); Sc.rowbytes = D * 2;
        EpiOutProj E{a.in[IN_X], ws};
        for (int r = 0; r < a.rep[9]; ++r) { FRESH_IDS(); pg8::Gemm g2 = g; asm volatile("" : "+s"(g2.A), "+s"(g2.Bt)); pg8::gemm_phase<EpiOutProj, SchedPlain, true>((LAS unsigned char*)lds, g2, Sc, E); } }
    SEAM(5);
    if (IN(6)) { FRESH_IDS(); const Args a = load_args(kp); unsigned char* ws = a.ws; for (int r = 0; r < a.rep[4]; ++r) { FRESH_IDS(); phase_router(a, lds, wg & 7, (wg >> 3) * NWAVES + wave, (G >> 3) * NWAVES, lane, tid); } }
    SEAM(6);
    if (IN(7)) { FRESH_IDS(); const Args a = load_args(kp); unsigned char* ws = a.ws; for (int r = 0; r < a.rep[7]; ++r) { FRESH_IDS(); phase_topk(a, lds, wg, G, tid, lane, wave); } }
    SEAM(7);
    if (IN(8)) { FRESH_IDS(); const Args a = load_args(kp); unsigned char* ws = a.ws; pg8::Gemm g{(const bf16_t*)(ws + WS_XN), (const bf16_t*)(ws + WS_WGU), D}; SchedMoe1 Sc; Sc.init(MR, 4096, G, wg, WGM_MOE1); Sc.idxl = (const LAS int*)((LAS unsigned char*)lds + 131072);
        { const int* idxg = (const int*)(ws + WS_IDX); LAS int* il = (LAS int*)((LAS unsigned char*)lds + 131072); pg8::Unit uu;
          for (int i = 0; i < 16; ++i) if (Sc.next(i, uu) && tid < 256) il[i * 256 + tid] = idxg[uu.pm * 256 + tid];
          __syncthreads(); }
        EpiSwiGLU E{ws + WS_HID};
        for (int r = 0; r < a.rep[10]; ++r) { FRESH_IDS(); pg8::Gemm g2 = g; asm volatile("" : "+s"(g2.A), "+s"(g2.Bt)); pg8::gemm_phase<EpiSwiGLU, SchedMoe1, true, true>((LAS unsigned char*)lds, g2, Sc, E); } }
    SEAM(8);
    if (IN(9)) { FRESH_IDS(); const Args a = load_args(kp); unsigned char* ws = a.ws; pg8::Gemm g{(const bf16_t*)(ws + WS_HID), (const bf16_t*)(ws + WS_WD), DFF}; SchedMoe2 Sc; Sc.init(MR, D, G, wg, WGM_MOE2);
        EpiDown E{ws + WS_Y};
        for (int r = 0; r < a.rep[11]; ++r) { FRESH_IDS(); pg8::Gemm g2 = g; asm volatile("" : "+s"(g2.A), "+s"(g2.Bt)); pg8::gemm_phase<EpiDown, SchedMoe2, true, true>((LAS unsigned char*)lds, g2, Sc, E); } }
    SEAM(9);
    if (IN(10)) { FRESH_IDS(); const Args a = load_args(kp); unsigned char* ws = a.ws; for (int r = 0; r < a.rep[12]; ++r) { FRESH_IDS(); phase_final(a, gw, NGW, lane); } }
#undef IN
#undef SEAM
}

extern "C" void kernel_launch(void* const* d_in, const int* in_sizes, int n_in, void* d_out, int out_size, void* d_ws, size_t ws_size, hipStream_t stream) {
    static int grid = 0;
    if (grid == 0) {
        if (n_in != 13 || in_sizes[0] != M * D || out_size != M * D || ws_size < WS_END) { fprintf(stderr, "kernel_launch: unexpected shapes n_in %d in0 %d out %d ws %zu (need %zu)\n", n_in, n_in > 0 ? in_sizes[0] : -1, out_size, ws_size, (size_t)WS_END); grid = -1; return; }
        int dev = 0, cus = 0, per_cu = 0;
        (void)hipGetDevice(&dev); (void)hipDeviceGetAttribute(&cus, hipDeviceAttributeMultiprocessorCount, dev);
        (void)hipFuncSetAttribute((const void*)mega, hipFuncAttributeMaxDynamicSharedMemorySize, LDS_BYTES);
        if (hipOccupancyMaxActiveBlocksPerMultiprocessor(&per_cu, (const void*)mega, NTHR, LDS_BYTES) != hipSuccess || per_cu < 1) { fprintf(stderr, "kernel_launch: occupancy query says %d blocks/CU\n", per_cu); per_cu = 1; }
        (void)hipGetLastError();
        grid = cus * 1;
        if (grid > cus * per_cu) grid = cus * per_cu;
    }
    if (grid < 0) return;
    (void)hipMemsetAsync((char*)d_ws + WS_CTL + 16384, 0, 49152, stream);
    Args a{};
    for (int i = 0; i < 13; ++i) a.in[i] = (const float*)d_in[i];
    a.out = (float*)d_out; a.ws = (unsigned char*)d_ws;
#ifndef PROBE_R
#define PROBE_R {1, 1, 1, 1, 1, 1, 1, 1, 1, 1, 1, 1, 1, 1, 0, 0}
#endif
    { const int rr[16] = PROBE_R; for (int i = 0; i < 16; ++i) a.rep[i] = rr[i]; }
#if MK_LAUNCHES == 1
    a.ph_lo = 0; a.ph_hi = NPH;
    void* args[] = {&a};
    hipError_t e = hipLaunchCooperativeKernel((const void*)mega, dim3(grid), dim3(NTHR), args, LDS_BYTES, stream);
    if (e != hipSuccess) fprintf(stderr, "cooperative launch failed: %s (grid %d)\n", hipGetErrorString(e), grid);
#else
    for (int p = 0; p < NPH; ++p) { a.ph_lo = p; a.ph_hi = p + 1; hipLaunchKernelGGL(mega, dim3(grid), dim3(NTHR), LDS_BYTES, stream, a); }
#endif
}
```

```cpp
#include <hip/hip_runtime.h>
#include <hip/hip_cooperative_groups.h>
#include <cstdint>
#include <cstdio>
namespace cg = cooperative_groups;

typedef unsigned short bf16_t;
#define DEV __device__ __forceinline__
#define LAS __attribute__((address_space(3)))

constexpr int NB = 8, S = 4096, D = 1024, M = NB * S;
constexpr int NH = 8, HD = 64, PC = 3584;
constexpr int NE = 16, CAP = 512, DFF = 2048, MR = NE * NB * CAP;
constexpr float EPS = 1e-6f, LOG2E = 1.4426950408889634f;
constexpr int NWAVES = 8, NTHR = 512;
constexpr int LDS_BYTES = 163840;

constexpr size_t MiB = 1u << 20;
constexpr size_t WS_CTL = 0;
constexpr size_t WS_ROPE = 1 * MiB;
constexpr size_t WS_BIAS = 64 * 1024;
constexpr size_t WS_IDX = 128 * 1024;
constexpr size_t WS_AFF = 3 * MiB;
constexpr size_t WS_INV = 5 * MiB;
constexpr size_t WS_WOUT = 7 * MiB;
constexpr size_t WS_WIN = 9 * MiB;
constexpr size_t WS_XN = 16 * MiB;
constexpr size_t WS_RQ = 80 * MiB, WS_RK = 112 * MiB, WS_RV = 144 * MiB, WS_RG = 176 * MiB;
constexpr size_t WS_AQ = 208 * MiB, WS_AK = 240 * MiB, WS_AV = 272 * MiB;
constexpr size_t WS_ATTO = 304 * MiB;
constexpr size_t WS_ATTL0 = 528 * MiB, WS_ATTL1 = 529 * MiB, WS_ATTL2 = 2 * MiB;
constexpr size_t WS_KF = 400 * MiB;
constexpr size_t WS_WD = 432 * MiB;
constexpr size_t WS_WGU = 464 * MiB;
constexpr size_t WS_Y = 144 * MiB;
constexpr size_t WS_HID = 272 * MiB;
constexpr size_t WS_END = 530 * MiB;
DEV size_t x1_off(int row) { const int b = row >> 12, s = row & 4095; return (s < 2048 ? WS_RQ : WS_RK) + (size_t)b * 4 * MiB + (size_t)(s & 2047) * 2048; }
DEV size_t afft_off(int b, int e) { return WS_AQ + (size_t)b * 4 * MiB + (size_t)e * S * 4; }
DEV size_t st_off(int dir, int bh, int n) { return WS_AQ + (size_t)(bh >> 3) * 4 * MiB + ((size_t)((dir * NH + (bh & 7)) * 32 + n)) * 8192; }

DEV unsigned f2bf(float f) { unsigned u = __float_as_uint(f); return (u + 0x7fffu + ((u >> 16) & 1u)) >> 16; }
DEV float bf2f(unsigned h) { return __uint_as_float(h << 16); }
DEV unsigned pk2(float lo, float hi) { return f2bf(lo) | (f2bf(hi) << 16); }
#define DPPF(x, ctrl) __builtin_bit_cast(float, __builtin_amdgcn_update_dpp(__builtin_bit_cast(int, (x)), __builtin_bit_cast(int, (x)), (ctrl), 0xF, 0xF, false))
DEV float lane_x1(float x) { return DPPF(x, 0xB1); }
DEV float lane_x2(float x) { return DPPF(x, 0x4E); }
DEV float lane_m8(float x) { return DPPF(x, 0x141); }
DEV float lane_x8(float x) { return DPPF(x, 0x128); }
DEV float lane_x16(float x) { const auto r = __builtin_amdgcn_permlane16_swap(__float_as_uint(x), __float_as_uint(x), false, false); return (threadIdx.x & 16) ? __uint_as_float(r[0]) : __uint_as_float(r[1]); }
DEV float lane_x32(float x) { const auto r = __builtin_amdgcn_permlane32_swap(__float_as_uint(x), __float_as_uint(x), false, false); return (threadIdx.x & 32) ? __uint_as_float(r[0]) : __uint_as_float(r[1]); }
DEV float wave_sum(float v) {
    v += lane_x1(v); v += lane_x2(v); v += lane_m8(v); v += lane_x8(v); v += lane_x16(v); v += lane_x32(v);
    return v;
}
#define LDS_WAIT() asm volatile("s_waitcnt lgkmcnt(0)" ::: "memory")
namespace pg8 {
#define PG8_LAS __attribute__((address_space(3)))
typedef short bf16x8 __attribute__((ext_vector_type(8)));
typedef float f32x4 __attribute__((ext_vector_type(4)));
typedef unsigned u32x4 __attribute__((ext_vector_type(4)));
constexpr int BM = 256, BK = 64, HALF = 128, HTB = HALF * BK * 2, STAGE_BYTES = 8 * HTB, NXCD = 8, WGM = 8;
__host__ __device__ __forceinline__ int lds_byte(int r, int c) { const int st = (r >> 4) * 2 + (c >> 5), rr = r & 15, cc = c & 31, ob = rr * 64 + cc * 2; return st * 1024 + (ob ^ (((ob >> 9) & 1) << 5)); }
__host__ __device__ __forceinline__ void stage_rc(int b, int& R, int& C) { const int st = b / 1024, sb = b % 1024, swz = sb ^ (((sb >> 9) & 1) << 5); R = (st >> 1) * 16 + swz / 64; C = (st & 1) * 32 + (swz % 64) / 2; }
__host__ __device__ __forceinline__ int perm32(int rho) { const int n = rho >> 4, i = rho & 15; return 8 * (i >> 2) + 4 * n + (i & 3); }
struct Unit { int pm, pn, ui; };
struct Gemm { const bf16_t* A; const bf16_t* Bt; int K; };
struct StaticOrder {
    int nM, nN, nwg, G, c, wgm;
    __device__ void init(int M_, int N_, int G_, int c_, int wgm_ = WGM) { nM = M_ / BM; nN = N_ / BM; nwg = nM * nN; G = G_; c = c_; wgm = wgm_; }
    __device__ bool next(int i, Unit& u) const {
        const long L = (long)i * G + c; if (L >= nwg) return false;
        int wgid = (int)L; { const int q = nwg / NXCD, r = nwg % NXCD, xcd = wgid % NXCD, off = wgid / NXCD; wgid = (xcd < r ? xcd * (q + 1) : r * (q + 1) + (xcd - r) * q) + off; }
        const int nig = wgm * nN, gid = wgid / nig, fm = gid * wgm, gsz = (nM - fm) < wgm ? (nM - fm) : wgm;
        u.pm = fm + ((wgid % nig) % gsz); u.pn = (wgid % nig) / gsz; return true;
    }
};
__device__ __forceinline__ unsigned cvt_pk_bf16(float lo, float hi) { unsigned r; asm volatile("v_cvt_pk_bf16_f32 %0, %1, %2" : "=v"(r) : "v"(lo), "v"(hi)); return r; }

typedef int v8i __attribute__((ext_vector_type(8)));
template <class Epi, class Sched, bool ALIGN_EPI, bool FP8 = false>
__device__ __forceinline__ void gemm_phase(PG8_LAS unsigned char* lds, const Gemm g, const Sched& S, const Epi& E) {
    const int tid = threadIdx.x, wid = __builtin_amdgcn_readfirstlane(tid >> 6), lane = tid & 63, wr = wid >> 2, wc = wid & 3, fr = lane & 15, fq = lane >> 4;
    const int K = g.K, RB = FP8 ? K : 2 * K, nt = RB / 128;
    unsigned voffB;
    { int R, C; stage_rc(tid * 16, R, C); const int Rb = Epi::PERM ? ((R & ~31) + perm32(R & 31)) : R; voffB = (unsigned)(Rb * RB + C * 2); }
    const size_t kstep = (size_t)(BK * 2);
    const size_t hstep = (size_t)HALF * RB;
    const size_t tstep = 2 * hstep;
    const unsigned ldsw = (unsigned)wid * 1024u;
    const int aoff = FP8 ? lds_byte(wr * 64 + fr, fq * 16) : lds_byte(wr * 64 + fr, fq * 8), boff = FP8 ? lds_byte(wc * 32 + fr, fq * 16) : lds_byte(wc * 32 + fr, fq * 8);
    const int x16 = 16 * (fq & 1);
    const char* gA = (const char*)g.A;
#define PG8_SA(b, h) (((b) * 2 + (h)) * HTB)
#define PG8_SB(b, h) ((4 + (b) * 2 + (h)) * HTB)
#define PG8_STAGE(bufoff, gbase, voff) do { _Pragma("unroll") for (int _i = 0; _i < 2; ++_i) \
        __builtin_amdgcn_global_load_lds((const unsigned*)((const char*)(gbase) + (size_t)_i * 64 * RB + (voff)), (PG8_LAS unsigned*)(lds + (bufoff) + ldsw + _i * 8192), 16, 0, 0); } while (0)
#define PG8_STAGE_A(bufoff, AO, h, kb) do { _Pragma("unroll") for (int _i = 0; _i < 2; ++_i) \
        __builtin_amdgcn_global_load_lds((const unsigned*)(gA + (size_t)((AO)[h][_i] + (unsigned)(kb))), (PG8_LAS unsigned*)(lds + (bufoff) + ldsw + _i * 8192), 16, 0, 0); } while (0)
#define PG8_LDA(dst, b, h) do { if constexpr (FP8) { _Pragma("unroll") for (int m = 0; m < 4; ++m) { dst[m][0] = *(const PG8_LAS bf16x8*)(lds + PG8_SA(b, h) + aoff + m * 2048 + x16); dst[m][1] = *(const PG8_LAS bf16x8*)(lds + PG8_SA(b, h) + aoff + m * 2048 + 16 - x16); } } \
    else { _Pragma("unroll") for (int m = 0; m < 4; ++m) _Pragma("unroll") for (int k = 0; k < 2; ++k) dst[m][k] = *(const PG8_LAS bf16x8*)(lds + PG8_SA(b, h) + aoff + m * 2048 + k * 1024); } } while (0)
#define PG8_LDB(dst, b, h) do { if constexpr (FP8) { _Pragma("unroll") for (int n = 0; n < 2; ++n) { dst[n][0] = *(const PG8_LAS bf16x8*)(lds + PG8_SB(b, h) + boff + n * 2048 + x16); dst[n][1] = *(const PG8_LAS bf16x8*)(lds + PG8_SB(b, h) + boff + n * 2048 + 16 - x16); } } \
    else { _Pragma("unroll") for (int n = 0; n < 2; ++n) _Pragma("unroll") for (int k = 0; k < 2; ++k) dst[n][k] = *(const PG8_LAS bf16x8*)(lds + PG8_SB(b, h) + boff + n * 2048 + k * 1024); } } while (0)
#define PG8_CAT8(x) __builtin_bit_cast(v8i, __builtin_shufflevector((x)[0], (x)[1], 0, 1, 2, 3, 4, 5, 6, 7, 8, 9, 10, 11, 12, 13, 14, 15))
#define PG8_MMA(ai, bj, At, Bt) do { __builtin_amdgcn_s_setprio(1); if constexpr (FP8) { _Pragma("unroll") for (int m = 0; m < 4; ++m) _Pragma("unroll") for (int n = 0; n < 2; ++n) \
        acc[ai][bj][m][n] = __builtin_amdgcn_mfma_scale_f32_16x16x128_f8f6f4(PG8_CAT8(Bt[n]), PG8_CAT8(At[m]), acc[ai][bj][m][n], 0, 0, 0, 0, 0, 0); } \
    else { _Pragma("unroll") for (int m = 0; m < 4; ++m) _Pragma("unroll") for (int n = 0; n < 2; ++n) _Pragma("unroll") for (int k = 0; k < 2; ++k) \
        acc[ai][bj][m][n] = __builtin_amdgcn_mfma_f32_16x16x32_bf16(Bt[n][k], At[m][k], acc[ai][bj][m][n], 0, 0, 0); } __builtin_amdgcn_s_setprio(0); } while (0)
#define PG8_WAIT_V(n) asm volatile("s_waitcnt vmcnt(" #n ")" ::: "memory")
#define PG8_WAIT_L(n) asm volatile("s_waitcnt lgkmcnt(" #n ")" ::: "memory")
#define PG8_BAR __builtin_amdgcn_s_barrier()
#define PG8_SCHED __builtin_amdgcn_sched_barrier(0)
#define PG8_AOFFS(AO, u) do { int _t = threadIdx.x; asm volatile("" : "+v"(_t)); _Pragma("unroll") for (int _i = 0; _i < 2; ++_i) { int _R, _C; stage_rc(_t * 16 + _i * 8192, _R, _C); \
        _Pragma("unroll") for (int _h = 0; _h < 2; ++_h) (AO)[_h][_i] = S.row_off(u, _h * HALF + _R) + (unsigned)(_C * 2); } } while (0)
    Unit cur, nxt; int ui = 0;
    if (!S.next(0, cur)) return;
    f32x4 acc[2][2][4][2];
#pragma unroll
    for (int a = 0; a < 2; ++a)
#pragma unroll
        for (int b = 0; b < 2; ++b)
#pragma unroll
            for (int m = 0; m < 4; ++m)
#pragma unroll
                for (int n = 0; n < 2; ++n) acc[a][b][m][n] = (f32x4){0.f, 0.f, 0.f, 0.f};
    bf16x8 At[4][2], B0[2][2], B1[2][2];
    unsigned aoc[2][2];
    PG8_AOFFS(aoc, cur);
    const char* cB = (const char*)g.Bt + (size_t)cur.pn * tstep;
    PG8_STAGE(PG8_SB(0, 0), cB, voffB); PG8_STAGE(PG8_SB(0, 1), cB + hstep, voffB); PG8_STAGE_A(PG8_SA(0, 0), aoc, 0, 0); PG8_STAGE_A(PG8_SA(0, 1), aoc, 1, 0);
    if (wr == 1) PG8_BAR;
    PG8_WAIT_V(2); PG8_BAR;
    PG8_STAGE(PG8_SB(1, 0), cB + kstep, voffB); PG8_STAGE_A(PG8_SA(1, 0), aoc, 0, 128); PG8_STAGE(PG8_SB(1, 1), cB + hstep + kstep, voffB);
    PG8_WAIT_V(6); PG8_BAR;
    for (;;) {
        const bool has_next = S.next(ui + 1, nxt);
        const char* nB = cB;
        if (has_next) nB = (const char*)g.Bt + (size_t)nxt.pn * tstep;
#pragma nounroll
        for (int t = 0; t < nt; t += 2) {
            const bool last = (t == nt - 2);
            const unsigned k1 = (unsigned)(t + 1) * 128u, k2 = last ? 0u : (unsigned)(t + 2) * 128u, k3 = k2 + 128u;
            const char* b2 = last ? nB : cB + (size_t)(t + 2) * kstep; const char* b3 = b2 + kstep;
            PG8_LDB(B0, 0, 0); PG8_LDB(B1, 0, 1); PG8_SCHED; PG8_LDA(At, 0, 0); PG8_STAGE_A(PG8_SA(1, 1), aoc, 1, k1);
            PG8_WAIT_V(8); PG8_WAIT_L(0); PG8_BAR; PG8_MMA(0, 0, At, B0); PG8_MMA(0, 1, At, B1); PG8_BAR; PG8_SCHED;
            if (last && has_next) { PG8_AOFFS(aoc, nxt); }
            PG8_LDA(At, 0, 1); PG8_STAGE(PG8_SB(0, 0), b2, voffB); PG8_STAGE(PG8_SB(0, 1), b2 + hstep, voffB); PG8_STAGE_A(PG8_SA(0, 0), aoc, 0, k2);
            PG8_WAIT_V(8); PG8_WAIT_L(0); PG8_BAR; PG8_MMA(1, 0, At, B0); PG8_MMA(1, 1, At, B1); PG8_BAR; PG8_SCHED;
            PG8_LDB(B0, 1, 0); PG8_LDB(B1, 1, 1); PG8_SCHED; PG8_LDA(At, 1, 0); PG8_STAGE_A(PG8_SA(0, 1), aoc, 1, k2);
            PG8_WAIT_V(8); PG8_WAIT_L(0); PG8_BAR; PG8_MMA(0, 0, At, B0); PG8_MMA(0, 1, At, B1); PG8_BAR; PG8_SCHED;
            PG8_LDA(At, 1, 1); PG8_STAGE(PG8_SB(1, 0), b3, voffB); PG8_STAGE(PG8_SB(1, 1), b3 + hstep, voffB); PG8_STAGE_A(PG8_SA(1, 0), aoc, 0, k3);
            PG8_WAIT_V(8); PG8_WAIT_L(0); PG8_BAR; PG8_MMA(1, 0, At, B0); PG8_MMA(1, 1, At, B1); PG8_BAR; PG8_SCHED;
        }
        if constexpr (ALIGN_EPI) { if (wr == 0) PG8_BAR; }
        { int t2 = threadIdx.x; asm volatile("" : "+v"(t2));
          const int w2 = __builtin_amdgcn_readfirstlane(t2 >> 6), l2 = t2 & 63; E(acc, cur, w2 >> 2, w2 & 3, l2 & 15, l2 >> 4); }
        if (!has_next) break;
#pragma unroll
        for (int a = 0; a < 2; ++a)
#pragma unroll
            for (int b = 0; b < 2; ++b)
#pragma unroll
                for (int m = 0; m < 4; ++m)
#pragma unroll
                    for (int n = 0; n < 2; ++n) acc[a][b][m][n] = (f32x4){0.f, 0.f, 0.f, 0.f};
        cur = nxt; cB = nB; ++ui;
        if constexpr (ALIGN_EPI) { if (wr == 1) PG8_BAR; }
    }
    PG8_WAIT_V(0);
    if constexpr (!ALIGN_EPI) { if (wr == 0) PG8_BAR; }
    PG8_BAR;
#undef PG8_SA
#undef PG8_SB
#undef PG8_STAGE
#undef PG8_STAGE_A
#undef PG8_LDA
#undef PG8_LDB
#undef PG8_MMA
#undef PG8_CAT8
#undef PG8_WAIT_V
#undef PG8_WAIT_L
#undef PG8_BAR
#undef PG8_SCHED
#undef PG8_AOFFS
}
}
struct SchedPlain : pg8::StaticOrder {
    unsigned rowbytes;
    DEV unsigned row_off(const pg8::Unit& u, int r) const { return (unsigned)(u.pm * 256 + r) * rowbytes; }
};
struct SchedMoe1 : pg8::StaticOrder {
    const LAS int* idxl;
    DEV bool next(int i, pg8::Unit& u) const { if (!pg8::StaticOrder::next(i, u)) return false; u.pn += (u.pm >> 4) * 16; u.ui = i; return true; }
    DEV unsigned row_off(const pg8::Unit& u, int r) const { const int g = u.pm * 256 + r; const int tok = ((g >> 9) & 7) * S + idxl[u.ui * 256 + r]; return (unsigned)tok * 2048u; }
};
struct SchedMoe2 : pg8::StaticOrder {
    DEV bool next(int i, pg8::Unit& u) const { if (!pg8::StaticOrder::next(i, u)) return false; u.pn += (u.pm >> 4) * 4; return true; }
    DEV unsigned row_off(const pg8::Unit& u, int r) const { return (unsigned)(u.pm * 256 + r) * (unsigned)DFF; }
};
typedef pg8::f32x4 f32x4; typedef pg8::u32x4 u32x4;
struct EpiInProj {
    static constexpr bool PERM = true;
    unsigned char* ws; const float* ropeT;
    DEV void operator()(const f32x4 (&acc)[2][2][4][2], const pg8::Unit& u, int wr, int wc, int fr, int fq) const {
        const int grp = u.pn >> 1;
        bf16_t* gbase = (bf16_t*)(ws + WS_RQ + (size_t)grp * 32 * MiB);
        const int j0 = 32 * (wc & 1) + 8 * fq;
        if (grp < 2) {
            const float sc = grp == 1 ? 0.125f : 1.f;
            f32x4 cs[2][4], sn[2][4];
#pragma unroll
            for (int ai = 0; ai < 2; ++ai)
#pragma unroll
                for (int m = 0; m < 4; ++m) { const int s = (u.pm * 256 + ai * 128 + wr * 64 + m * 16 + fr) & 4095;
                    cs[ai][m] = *(const f32x4*)(ropeT + s * 32 + (j0 >> 1)); sn[ai][m] = *(const f32x4*)(ropeT + S * 32 + s * 32 + (j0 >> 1)); }
#pragma unroll
            for (int ai = 0; ai < 2; ++ai)
#pragma unroll
                for (int m = 0; m < 4; ++m) {
                    const int row = u.pm * 256 + ai * 128 + wr * 64 + m * 16 + fr, b = row >> 12, s = row & 4095;
#pragma unroll
                    for (int bj = 0; bj < 2; ++bj) {
                        const int hd = 4 * (u.pn & 1) + 2 * bj + (wc >> 1);
                        const f32x4 lo = (acc[ai][bj][m][0] * cs[ai][m] - acc[ai][bj][m][1] * sn[ai][m]) * sc, hi = (acc[ai][bj][m][1] * cs[ai][m] + acc[ai][bj][m][0] * sn[ai][m]) * sc;
                        u32x4 w; w.x = pg8::cvt_pk_bf16(lo[0], lo[1]); w.y = pg8::cvt_pk_bf16(lo[2], lo[3]); w.z = pg8::cvt_pk_bf16(hi[0], hi[1]); w.w = pg8::cvt_pk_bf16(hi[2], hi[3]);
                        *(u32x4*)(gbase + ((size_t)(b * NH + hd) * S + s) * HD + j0) = w;
                    }
                }
        } else {
            const float sc = grp == 4 ? 0.125f * LOG2E : 1.f;
#pragma unroll
            for (int ai = 0; ai < 2; ++ai)
#pragma unroll
                for (int m = 0; m < 4; ++m) {
                    const int row = u.pm * 256 + ai * 128 + wr * 64 + m * 16 + fr, b = row >> 12, s = row & 4095;
#pragma unroll
                    for (int bj = 0; bj < 2; ++bj) {
                        const int hd = 4 * (u.pn & 1) + 2 * bj + (wc >> 1);
                        const f32x4 lo = acc[ai][bj][m][0] * sc, hi = acc[ai][bj][m][1] * sc;
                        u32x4 w; w.x = pg8::cvt_pk_bf16(lo[0], lo[1]); w.y = pg8::cvt_pk_bf16(lo[2], lo[3]); w.z = pg8::cvt_pk_bf16(hi[0], hi[1]); w.w = pg8::cvt_pk_bf16(hi[2], hi[3]);
                        *(u32x4*)(gbase + ((size_t)(b * NH + hd) * S + s) * HD + j0) = w;
                    }
                }
        }
    }
};
struct EpiOutProj {
    static constexpr bool PERM = true;
    const float* x; unsigned char* ws;
    DEV void operator()(const f32x4 (&acc)[2][2][4][2], const pg8::Unit& u, int wr, int wc, int fr, int fq) const {
#pragma unroll
        for (int ai = 0; ai < 2; ++ai)
#pragma unroll
            for (int m = 0; m < 4; ++m) {
                const int row = u.pm * 256 + ai * 128 + wr * 64 + m * 16 + fr;
                bf16_t* x1r = (bf16_t*)(ws + x1_off(row));
                f32x4 xa[2], xb[2];
#pragma unroll
                for (int bj = 0; bj < 2; ++bj) { const size_t off = (size_t)row * D + u.pn * 256 + bj * 128 + wc * 32 + 8 * fq; xa[bj] = *(const f32x4*)(x + off); xb[bj] = *(const f32x4*)(x + off + 4); }
#pragma unroll
                for (int bj = 0; bj < 2; ++bj) { const int col = u.pn * 256 + bj * 128 + wc * 32 + 8 * fq;
                    const f32x4 lo = xa[bj] + acc[ai][bj][m][0], hi = xb[bj] + acc[ai][bj][m][1];
                    u32x4 w; w.x = pg8::cvt_pk_bf16(lo[0], lo[1]); w.y = pg8::cvt_pk_bf16(lo[2], lo[3]); w.z = pg8::cvt_pk_bf16(hi[0], hi[1]); w.w = pg8::cvt_pk_bf16(hi[2], hi[3]);
                    *(u32x4*)(x1r + col) = w; }
            }
    }
};
DEV unsigned pk4_fp8e(float a, float b, float c, float d) { unsigned w = 0u; w = __builtin_amdgcn_cvt_pk_fp8_f32(a, b, w, false); w = __builtin_amdgcn_cvt_pk_fp8_f32(c, d, w, true); return w; }
struct EpiSwiGLU {
    static constexpr bool PERM = true;
    unsigned char* hid;
    DEV void operator()(const f32x4 (&acc)[2][2][4][2], const pg8::Unit& u, int wr, int wc, int fr, int fq) const {
        const int pnl = u.pn & 15;
#pragma unroll
        for (int ai = 0; ai < 2; ++ai)
#pragma unroll
            for (int m = 0; m < 4; ++m) {
                const int row = u.pm * 256 + ai * 128 + wr * 64 + m * 16 + fr;
                float o[8];
#pragma unroll
                for (int n = 0; n < 2; ++n)
#pragma unroll
                    for (int i = 0; i < 4; ++i) { const float ga = acc[ai][0][m][n][i], ua = acc[ai][1][m][n][i];
                        o[4 * n + i] = (ga * ua) * ((1.f / 1024.f) * __builtin_amdgcn_rcpf(1.f + __builtin_amdgcn_exp2f(ga * (-LOG2E / 32.f)))); }
                *(uint2*)(hid + (size_t)row * DFF + pnl * 128 + wc * 32 + 8 * fq) = make_uint2(pk4_fp8e(o[0], o[1], o[2], o[3]), pk4_fp8e(o[4], o[5], o[6], o[7]));
            }
    }
};
struct EpiDown {
    static constexpr bool PERM = true;
    unsigned char* y;
    DEV void operator()(const f32x4 (&acc)[2][2][4][2], const pg8::Unit& u, int wr, int wc, int fr, int fq) const {
        const int pnl = u.pn & 3;
#pragma unroll
        for (int ai = 0; ai < 2; ++ai)
#pragma unroll
            for (int m = 0; m < 4; ++m) {
                const int row = u.pm * 256 + ai * 128 + wr * 64 + m * 16 + fr;
#pragma unroll
                for (int bj = 0; bj < 2; ++bj) { const f32x4 lo = acc[ai][bj][m][0] * (1.f / 32.f), hi = acc[ai][bj][m][1] * (1.f / 32.f);
                    *(uint2*)(y + (size_t)row * D + pnl * 256 + bj * 128 + wc * 32 + 8 * fq) = make_uint2(pk4_fp8e(lo[0], lo[1], lo[2], lo[3]), pk4_fp8e(hi[0], hi[1], hi[2], hi[3])); }
            }
    }
};
struct Args { const float* in[13]; float* out; unsigned char* ws; int ph_lo, ph_hi; int rep[16]; };
enum { IN_X = 0, IN_G1, IN_WIN, IN_DECAY, IN_GN, IN_RELB, IN_WOUT, IN_G2, IN_WR, IN_WG, IN_WU, IN_WDN, IN_FG };

struct TrItem { const float* src; bf16_t* dst; int K, N, k0, n0, mode, fp8; };
DEV unsigned pk4_fp8(float a, float b, float c, float d) { unsigned w = 0u; w = __builtin_amdgcn_cvt_pk_fp8_f32(a, b, w, false); w = __builtin_amdgcn_cvt_pk_fp8_f32(c, d, w, true); return w; }
DEV void tr_load(const TrItem& t, f32x4 (&v)[16], int lane) {
#pragma unroll
    for (int i = 0; i < 16; ++i) { const int kk = (lane >> 4) + 4 * i, c = (lane & 15) * 4; v[i] = __builtin_nontemporal_load((const f32x4*)(t.src + (size_t)(t.k0 + kk) * t.N + t.n0 + c)); }
}
DEV int rowmap_rt(int mode, int n) {
    if (mode == 0) return n;
    if (mode == 1) { if (n >= 1024) return n; const int base = n & ~63, d = n & 63, nn = d >> 5, dd = d & 31; return base + 8 * (dd >> 2) + 4 * nn + (dd & 3); }
    return (n >> 7) * 256 + (mode == 3 ? 128 : 0) + (n & 127);
}
DEV void tr_finish(const TrItem& t, const f32x4 (&v)[16], LAS float* scr, int lane) {
#pragma unroll
    for (int i = 0; i < 16; ++i) { const int kk = (lane >> 4) + 4 * i, c = (lane & 15) * 4;
        scr[kk * 65 + c] = v[i][0]; scr[kk * 65 + c + 1] = v[i][1]; scr[kk * 65 + c + 2] = v[i][2]; scr[kk * 65 + c + 3] = v[i][3]; }
    LDS_WAIT();
#pragma unroll
    for (int i = 0; i < 8; ++i) { const int n = (lane >> 3) + 8 * i, c = (lane & 7) * 8; const LAS float* sp = scr + c * 65 + n;
        if (t.fp8) {
            const unsigned lo = pk4_fp8(sp[0] * 32.f, sp[65] * 32.f, sp[2 * 65] * 32.f, sp[3 * 65] * 32.f), hi = pk4_fp8(sp[4 * 65] * 32.f, sp[5 * 65] * 32.f, sp[6 * 65] * 32.f, sp[7 * 65] * 32.f);
            *(uint2*)((unsigned char*)t.dst + (size_t)rowmap_rt(t.mode, t.n0 + n) * t.K + t.k0 + c) = make_uint2(lo, hi);
        } else {
        u32x4 o; o.x = pk2(sp[0], sp[65]); o.y = pk2(sp[2 * 65], sp[3 * 65]); o.z = pk2(sp[4 * 65], sp[5 * 65]); o.w = pk2(sp[6 * 65], sp[7 * 65]);
        *(u32x4*)(t.dst + (size_t)rowmap_rt(t.mode, t.n0 + n) * t.K + t.k0 + c) = o; } }
    LDS_WAIT();
}
template <class Dec> DEV void tr_run(const Dec& dec, int nitems, int gw, int NGW, LAS float* scr, int lane) {
    for (int it = gw; it < nitems; it += NGW) { TrItem cur; f32x4 va[16]; dec(it, cur); tr_load(cur, va, lane); tr_finish(cur, va, scr, lane); }
}
template <class Dec> DEV void tr_run2(const Dec& dec, int nitems, int gw, int NGW, LAS float* scr, int lane) {
    int it = gw; if (it >= nitems) return;
    TrItem cur, nxt; f32x4 va[16], vb[16];
    dec(it, cur); tr_load(cur, va, lane);
    for (;;) {
        const int n1 = it + NGW; const bool h1 = n1 < nitems;
        if (h1) { dec(n1, nxt); tr_load(nxt, vb, lane); }
        tr_finish(cur, va, scr, lane);
        if (!h1) break;
        const int n2 = n1 + NGW; const bool h2 = n2 < nitems;
        if (h2) { dec(n2, cur); tr_load(cur, va, lane); }
        tr_finish(nxt, vb, scr, lane);
        if (!h2) break;
        it = n2;
    }
}
DEV void rms_row_to_bf16(const float* xrow, const float* g, bf16_t* orow, int lane) {
    const float4* xr = (const float4*)xrow + lane;
    float4 v[4]; float s = 0.f;
#pragma unroll
    for (int j = 0; j < 4; ++j) { v[j] = xr[64 * j]; s += v[j].x * v[j].x + v[j].y * v[j].y + v[j].z * v[j].z + v[j].w * v[j].w; }
    const float rs = rsqrtf(wave_sum(s) * (1.f / D) + EPS);
    uint2* o = (uint2*)orow + lane;
#pragma unroll
    for (int j = 0; j < 4; ++j) { const float4 gg = ((const float4*)g)[lane + 64 * j];
        o[64 * j] = make_uint2(pk2(v[j].x * rs * gg.x, v[j].y * rs * gg.y), pk2(v[j].z * rs * gg.z, v[j].w * rs * gg.w)); }
}
DEV void phase_prep(const Args& a, unsigned char* lds, int gw, int NGW, int lane, int wave) {
    unsigned char* ws = a.ws;
    float* ropeT = (float*)(ws + WS_ROPE); float* biasT = (float*)(ws + WS_BIAS);
    for (int t = gw * 64 + lane; t < S * 32; t += NGW * 64) {
        const int pos = t >> 5, i = t & 31; const double inv = pow(10000.0, -(double)i / 32.0), ang = (double)pos * inv;
        ropeT[t] = (float)cos(ang); ropeT[S * 32 + t] = (float)sin(ang);
        if (t < 3 * NH * 129) { const int p = t / (NH * 129), h = (t / 129) % NH, o = t % 129 - 64, dil = p == 0 ? 1 : (p == 1 ? 4 : 16), rel = o * dil, n = rel < 0 ? -rel : rel;
            int bucket = rel > 0 ? 16 : 0;
            if (n < 8) bucket += n; else { int large = 8 + (int)(log((double)n / 8.0) / log(128.0) * 8.0); if (large > 15) large = 15; bucket += large; }
            biasT[t] = a.in[IN_RELB][bucket * NH + h] * LOG2E; }
    }
    LAS float* scr = (LAS float*)((LAS unsigned char*)lds + wave * 16640);
    constexpr int I_IN = (D / 64) * (PC / 64), I_OUT = (D / 64) * (D / 64);
    { const float* w_in = a.in[IN_WIN]; const float* w_out = a.in[IN_WOUT]; bf16_t* Win = (bf16_t*)(ws + WS_WIN); bf16_t* Wout = (bf16_t*)(ws + WS_WOUT);
      auto dec = [=](int it, TrItem& t) { if (it < I_IN) { t.src = w_in; t.dst = Win; t.K = D; t.N = PC; t.k0 = (it / (PC / 64)) * 64; t.n0 = (it % (PC / 64)) * 64; t.mode = 1; t.fp8 = 0; }
          else { const int r = it - I_IN; t.src = w_out; t.dst = Wout; t.K = D; t.N = D; t.k0 = (r / (D / 64)) * 64; t.n0 = (r % (D / 64)) * 64; t.mode = 0; t.fp8 = 0; } };
      tr_run(dec, I_IN + I_OUT, gw, NGW, scr, lane); }
    {
      const float* x = a.in[IN_X]; const float* g = a.in[IN_G1]; bf16_t* XN = (bf16_t*)(ws + WS_XN);
      float4 va[4], vb[4], vc[4];
      { const float4* xr = (const float4*)(x + (size_t)gw * D) + lane;
#pragma unroll
        for (int j = 0; j < 4; ++j) va[j] = xr[64 * j];
        if (gw + NGW < M) { const float4* xs = (const float4*)(x + (size_t)(gw + NGW) * D) + lane;
#pragma unroll
          for (int j = 0; j < 4; ++j) vb[j] = xs[64 * j]; } }
      for (int m = gw; m < M; m += NGW) {
          if (m + 2 * NGW < M) { const float4* xr = (const float4*)(x + (size_t)(m + 2 * NGW) * D) + lane;
#pragma unroll
              for (int j = 0; j < 4; ++j) vc[j] = xr[64 * j]; }
          float s = 0.f;
#pragma unroll
          for (int j = 0; j < 4; ++j) s += va[j].x * va[j].x + va[j].y * va[j].y + va[j].z * va[j].z + va[j].w * va[j].w;
          const float rs = rsqrtf(wave_sum(s) * (1.f / D) + EPS);
          uint2* o = (uint2*)(XN + (size_t)m * D) + lane;
#pragma unroll
          for (int j = 0; j < 4; ++j) { const float4 gg = ((const float4*)g)[lane + 64 * j];
              o[64 * j] = make_uint2(pk2(va[j].x * rs * gg.x, va[j].y * rs * gg.y), pk2(va[j].z * rs * gg.z, va[j].w * rs * gg.w)); }
#pragma unroll
          for (int j = 0; j < 4; ++j) { va[j] = vb[j]; vb[j] = vc[j]; }
      } }
}
DEV void phase_latew(const Args& a, unsigned char* lds, int gw, int NGW, int lane, int wave) {
    unsigned char* ws = a.ws; LAS float* scr = (LAS float*)((LAS unsigned char*)lds + wave * 16640);
    constexpr int I_G = (D / 64) * (DFF / 64);
    const float* wg_ = a.in[IN_WG]; const float* wu_ = a.in[IN_WU]; const float* wd_ = a.in[IN_WDN]; bf16_t* Wgu = (bf16_t*)(ws + WS_WGU); bf16_t* Wd = (bf16_t*)(ws + WS_WD);
    auto dec = [=](int it, TrItem& t) { const int which = it / (NE * I_G), r = it % (NE * I_G), e = r / I_G, q = r % I_G;
        t.fp8 = 1;
        if (which < 2) { t.src = (which == 0 ? wg_ : wu_) + (size_t)e * D * DFF; t.dst = (bf16_t*)((unsigned char*)Wgu + (size_t)e * 4096 * D); t.K = D; t.N = DFF; t.n0 = (q / (D / 64)) * 64; t.k0 = (q % (D / 64)) * 64; t.mode = 2 + which; }
        else { t.src = wd_ + (size_t)e * DFF * D; t.dst = (bf16_t*)((unsigned char*)Wd + (size_t)e * D * DFF); t.K = DFF; t.N = D; t.n0 = (q / (DFF / 64)) * 64; t.k0 = (q % (DFF / 64)) * 64; t.mode = 0; } };
    tr_run2(dec, 3 * NE * I_G, gw, NGW, scr, lane);
}
constexpr int RT_WROW = 2080, RT_LO = 16 * RT_WROW, RT_G2 = 2 * RT_LO;
DEV void phase_router(const Args& a, unsigned char* lds, int xg, int gwl, int NGW, int lane, int tid) {
    unsigned char* ws = a.ws; const float* g2 = a.in[IN_G2]; const float* wr = a.in[IN_WR];
    unsigned char* H2q = ws + WS_XN; float* aff = (float*)(ws + WS_AFF); int* inv = (int*)(ws + WS_INV);
    LAS unsigned char* L = (LAS unsigned char*)lds;
    for (int i = tid; i < D * NE; i += NTHR) { const int k = i >> 4, e = i & 15; const float w = wr[i] * g2[k]; const unsigned hi = f2bf(w); const unsigned lo = f2bf(w - bf2f(hi));
        *(LAS bf16_t*)(L + e * RT_WROW + k * 2) = (bf16_t)hi; *(LAS bf16_t*)(L + RT_LO + e * RT_WROW + k * 2) = (bf16_t)lo; }
    for (int i = tid; i < D; i += NTHR) *(LAS float*)(L + RT_G2 + i * 4) = g2[i];
    __syncthreads();
    const int r = lane & 15, g = lane >> 4;
    for (int tile = gwl; tile < S / 16; tile += NGW) {
        const int row0 = xg * S + tile * 16;
        const unsigned char* xrow = ws + x1_off(row0 + r) + 16 * g;
        f32x4 acc = {0.f, 0.f, 0.f, 0.f}; float ss = 0.f;
        const LAS unsigned char* bh = L + r * RT_WROW + 16 * g;
#pragma unroll 1
        for (int s0 = 0; s0 < 32; s0 += 8) {
            pg8::bf16x8 xa[8];
#pragma unroll
            for (int s = 0; s < 8; ++s) xa[s] = *(const pg8::bf16x8*)(xrow + 64 * (s0 + s));
#pragma unroll
            for (int s = 0; s < 8; ++s) {
                const pg8::bf16x8 bhi = *(const LAS pg8::bf16x8*)(bh + 64 * (s0 + s)), blo = *(const LAS pg8::bf16x8*)(bh + RT_LO + 64 * (s0 + s));
                acc = __builtin_amdgcn_mfma_f32_16x16x32_bf16(xa[s], bhi, acc, 0, 0, 0);
                acc = __builtin_amdgcn_mfma_f32_16x16x32_bf16(xa[s], blo, acc, 0, 0, 0);
#pragma unroll
                for (int j = 0; j < 8; ++j) { const float v = bf2f((unsigned short)xa[s][j]); ss += v * v; }
            }
        }
        ss += lane_x16(ss); ss += lane_x32(ss);
        const float rs = rsqrtf(ss * (1.f / D) + EPS);
        unsigned char* hrow = H2q + (size_t)(row0 + r) * 2048 + 8 * g;
#pragma unroll 1
        for (int s0 = 0; s0 < 32; s0 += 8) {
            pg8::bf16x8 xa[8];
#pragma unroll
            for (int s = 0; s < 8; ++s) xa[s] = *(const pg8::bf16x8*)(xrow + 64 * (s0 + s));
#pragma unroll
            for (int s = 0; s < 8; ++s) { const f32x4 ga = *(const LAS f32x4*)(L + RT_G2 + (32 * (s0 + s) + 8 * g) * 4), gb = *(const LAS f32x4*)(L + RT_G2 + (32 * (s0 + s) + 8 * g + 4) * 4);
                float h[8];
#pragma unroll
                for (int j = 0; j < 8; ++j) h[j] = bf2f((unsigned short)xa[s][j]) * rs * (j < 4 ? ga[j] : gb[j - 4]);
                *(uint2*)(hrow + 32 * (s0 + s)) = make_uint2(pk4_fp8(h[0], h[1], h[2], h[3]), pk4_fp8(h[4], h[5], h[6], h[7])); }
        }
        float av[4];
#pragma unroll
        for (int q = 0; q < 4; ++q) { const float rq = __shfl(rs, 4 * g + q); const float lgt = acc[q] * rq;
            float mx = lgt; mx = fmaxf(mx, lane_x1(mx)); mx = fmaxf(mx, lane_x2(mx)); mx = fmaxf(mx, lane_m8(mx)); mx = fmaxf(mx, lane_x8(mx));
            const float ex = __expf(lgt - mx); float sum = ex; sum += lane_x1(sum); sum += lane_x2(sum); sum += lane_m8(sum); sum += lane_x8(sum);
            av[q] = ex / sum; }
#pragma unroll
        for (int q = 0; q < 4; ++q) { const int row = row0 + 4 * g + q; aff[(size_t)row * NE + r] = av[q]; inv[(size_t)row * NE + r] = -1; }
        *(float4*)((float*)(ws + afft_off(xg, r)) + tile * 16 + 4 * g) = make_float4(av[0], av[1], av[2], av[3]);
    }
    __syncthreads();
}
DEV void phase_topk(const Args& a, unsigned char* lds, int wg, int G, int tid, int lane, int wave) {
    unsigned char* ws = a.ws; int* idx = (int*)(ws + WS_IDX); int* inv = (int*)(ws + WS_INV);
    LAS unsigned* hist = (LAS unsigned*)(LAS unsigned char*)lds; LAS unsigned* wsum = hist + 256; LAS unsigned* bc = hist + 272;
    for (int it = wg >> 3; it < NE; it += G >> 3) {
        const int e = it, b = wg & 7;
        unsigned u[8];
        { const uint4* src = (const uint4*)((const float*)(ws + afft_off(b, e)) + 8 * tid); const uint4 p = src[0], q = src[1]; u[0] = p.x; u[1] = p.y; u[2] = p.z; u[3] = p.w; u[4] = q.x; u[5] = q.y; u[6] = q.z; u[7] = q.w; }
        unsigned prefix = 0u, kk = CAP;
#pragma unroll
        for (int pass = 0; pass < 4; ++pass) {
            const int shift = 24 - 8 * pass;
            __syncthreads();
            if (tid < 256) hist[tid] = 0u;
            __syncthreads();
#pragma unroll
            for (int j = 0; j < 8; ++j) if (pass == 0 || (u[j] >> (shift + 8)) == prefix) atomicAdd((unsigned*)&hist[(u[j] >> shift) & 255u], 1u);
            __syncthreads();
            if (wave == 0) {
                const unsigned c0 = hist[4 * lane], c1 = hist[4 * lane + 1], c2 = hist[4 * lane + 2], c3 = hist[4 * lane + 3], tot = c0 + c1 + c2 + c3;
                unsigned incl = tot;
#pragma unroll
                for (int o = 1; o < 64; o <<= 1) { const unsigned t = __shfl_down(incl, o); if (lane + o < 64) incl += t; }
                const unsigned excl = incl - tot;
                if (excl < kk && kk <= incl) { unsigned acc = excl; int bin;
                    if (acc + c3 >= kk) bin = 3; else { acc += c3; if (acc + c2 >= kk) bin = 2; else { acc += c2; if (acc + c1 >= kk) bin = 1; else { acc += c1; bin = 0; } } }
                    bc[0] = 4 * lane + bin; bc[1] = kk - acc; }
            }
            __syncthreads();
            prefix = (prefix << 8) | bc[0]; kk = bc[1];
        }
        const unsigned T = prefix, need = kk;
        unsigned cg_ = 0u, ce = 0u;
#pragma unroll
        for (int j = 0; j < 8; ++j) { cg_ += u[j] > T; ce += u[j] == T; }
        unsigned pk = cg_ | (ce << 16), incl = pk;
#pragma unroll
        for (int o = 1; o < 64; o <<= 1) { const unsigned t = __shfl_up(incl, o); if (lane >= o) incl += t; }
        if (lane == 63) wsum[wave] = incl;
        __syncthreads();
        unsigned base = 0u;
#pragma unroll
        for (int w = 0; w < NWAVES; ++w) base += w < wave ? wsum[w] : 0u;
        const unsigned ex = base + incl - pk; unsigned gtb = ex & 0xffffu, eqb = ex >> 16;
#pragma unroll
        for (int j = 0; j < 8; ++j) { const bool g = u[j] > T, q = u[j] == T; const unsigned slot = gtb + (eqb < need ? eqb : need);
            if (g || (q && eqb < need)) { const int s = 8 * tid + j; idx[(e * NB + b) * CAP + slot] = s; inv[((size_t)b * S + s) * NE + e] = (int)slot; }
            gtb += g; eqb += q; }
    }
}
DEV void phase_final(const Args& a, int gw, int NGW, int lane) {
    unsigned char* ws = a.ws; float* xo = a.out; const float* aff = (const float*)(ws + WS_AFF); const int* inv = (const int*)(ws + WS_INV);
    const unsigned char* y = ws + WS_Y; const float* fg = a.in[IN_FG];
    uint2 xw[4], xn[4], xm[4]; int iv = -1, ivn = -1, ivm = -1; float av = 0.f, avn = 0.f, avm = 0.f;
    { const uint2* xr = (const uint2*)(ws + x1_off(gw)) + lane;
#pragma unroll
      for (int j = 0; j < 4; ++j) xw[j] = xr[64 * j];
      if (lane < NE) { iv = inv[(size_t)gw * NE + lane]; av = aff[(size_t)gw * NE + lane]; }
      if (gw + NGW < M) { const uint2* xs = (const uint2*)(ws + x1_off(gw + NGW)) + lane;
#pragma unroll
        for (int j = 0; j < 4; ++j) xn[j] = xs[64 * j];
        if (lane < NE) { ivn = inv[(size_t)(gw + NGW) * NE + lane]; avn = aff[(size_t)(gw + NGW) * NE + lane]; } } }
    for (int row = gw; row < M; row += NGW) {
        const int b = row >> 12;
        if (row + 2 * NGW < M) { const uint2* xr = (const uint2*)(ws + x1_off(row + 2 * NGW)) + lane;
#pragma unroll
            for (int j = 0; j < 4; ++j) xm[j] = xr[64 * j];
            if (lane < NE) { ivm = inv[(size_t)(row + 2 * NGW) * NE + lane]; avm = aff[(size_t)(row + 2 * NGW) * NE + lane]; } }
        float4 v[4];
#pragma unroll
        for (int j = 0; j < 4; ++j) v[j] = make_float4(bf2f(xw[j].x & 0xffffu), bf2f(xw[j].x >> 16), bf2f(xw[j].y & 0xffffu), bf2f(xw[j].y >> 16));
        unsigned long long msk = __ballot(lane < NE && iv >= 0);
        while (msk) {
            unsigned w[4][4]; float gq[4];
#pragma unroll
            for (int q = 0; q < 4; ++q) { const bool on = msk != 0ull; const int e = on ? __builtin_ctzll(msk) : 0; msk = on ? (msk & (msk - 1)) : 0ull;
                const int sl = __builtin_amdgcn_readlane(iv, e); const float g = __builtin_bit_cast(float, __builtin_amdgcn_readlane(__builtin_bit_cast(int, av), e));
                gq[q] = on ? g : 0.f;
                const unsigned* yr = (const unsigned*)(y + ((size_t)e * 4096 + b * CAP + (on ? sl : 0)) * D) + lane;
#pragma unroll
                for (int j = 0; j < 4; ++j) w[q][j] = yr[64 * j]; }
#pragma unroll
            for (int q = 0; q < 4; ++q)
#pragma unroll
                for (int j = 0; j < 4; ++j) { const auto lo = __builtin_amdgcn_cvt_pk_f32_fp8((int)w[q][j], false), hi = __builtin_amdgcn_cvt_pk_f32_fp8((int)w[q][j], true);
                    v[j].x += gq[q] * lo[0]; v[j].y += gq[q] * lo[1]; v[j].z += gq[q] * hi[0]; v[j].w += gq[q] * hi[1]; }
        }
        float s = 0.f;
#pragma unroll
        for (int j = 0; j < 4; ++j) s += v[j].x * v[j].x + v[j].y * v[j].y + v[j].z * v[j].z + v[j].w * v[j].w;
        const float rs = rsqrtf(wave_sum(s) * (1.f / D) + EPS);
        float4* orow = (float4*)(xo + (size_t)row * D) + lane;
#pragma unroll
        for (int j = 0; j < 4; ++j) { const float4 gg = ((const float4*)fg)[lane + 64 * j]; orow[64 * j] = make_float4(v[j].x * rs * gg.x, v[j].y * rs * gg.y, v[j].z * rs * gg.z, v[j].w * rs * gg.w); }
#pragma unroll
        for (int j = 0; j < 4; ++j) { xw[j] = xn[j]; xn[j] = xm[j]; }
        iv = ivn; av = avn; ivn = ivm; avn = avm;
    }
}
typedef short bf16x8 __attribute__((ext_vector_type(8)));
typedef float f32x16 __attribute__((ext_vector_type(16)));
typedef short s16x4 __attribute__((ext_vector_type(4)));
typedef LAS const char* lds_cptr;
typedef unsigned u32x2 __attribute__((ext_vector_type(2)));
constexpr int VROW = 192;
constexpr int VSLOT = 32 * VROW;
constexpr int KROW = 144;
constexpr int KSLOT = 32 * KROW;
constexpr int MIX_WAVE_LDS = 16640;
constexpr int NWM = 6;
constexpr int MIX_BIAS_OFF = NWAVES * MIX_WAVE_LDS;
DEV int crow(int r, int hi) { return (r & 3) + 8 * (r >> 2) + 4 * hi; }
DEV s16x4 vtr(lds_cptr p) { return __builtin_bit_cast(s16x4, __builtin_amdgcn_ds_read_tr16_b64_v4i16((LAS s16x4*)p)); }
DEV bf16x8 tr_frag(lds_cptr slot, int s, int blk, int lane) {
    const int h = lane >> 5; lds_cptr p = slot + (16 * s + 4 * h + ((lane & 15) >> 2)) * VROW + (32 * blk + 16 * ((lane >> 4) & 1) + 4 * (lane & 3)) * 2;
    const s16x4 lo = vtr(p), hi = vtr(p + 8 * VROW);
    return (bf16x8){lo[0], lo[1], lo[2], lo[3], hi[0], hi[1], hi[2], hi[3]};
}
DEV void load_frags(bf16x8 (&f)[4], const bf16_t* rowp, int lane) {
    const int h = lane >> 5;
#pragma unroll
    for (int st = 0; st < 4; ++st) f[st] = *(const bf16x8*)(rowp + 16 * st + 8 * h);
}
DEV bf16x8 pack_p(const f32x16& p, int s) {
    u32x4 w; w.x = pg8::cvt_pk_bf16(p[8 * s], p[8 * s + 1]); w.y = pg8::cvt_pk_bf16(p[8 * s + 2], p[8 * s + 3]); w.z = pg8::cvt_pk_bf16(p[8 * s + 4], p[8 * s + 5]); w.w = pg8::cvt_pk_bf16(p[8 * s + 6], p[8 * s + 7]);
    return __builtin_bit_cast(bf16x8, w);
}

DEV void stage_rows_k(LAS unsigned char* ks, const u32x4 (&raw)[4], int lane) {
    const int rr = lane >> 3, ch = lane & 7;
#pragma unroll
    for (int i = 0; i < 4; ++i) *(LAS u32x4*)(ks + (rr + 8 * i) * KROW + ch * 16) = raw[i];
}
DEV void read_row_frags(bf16x8 (&f)[4], const LAS unsigned char* ks, int lane) {
    const LAS unsigned char* p = ks + (lane & 31) * KROW + (lane >> 5) * 16;
#pragma unroll
    for (int st = 0; st < 4; ++st) f[st] = *(const LAS bf16x8*)(p + st * 32);
}

DEV float other_half(float x) { const auto r = __builtin_amdgcn_permlane32_swap(__float_as_uint(x), __float_as_uint(x), false, false); return (threadIdx.x & 32) ? __uint_as_float(r[0]) : __uint_as_float(r[1]); }
DEV float max_halves(float x) { const auto r = __builtin_amdgcn_permlane32_swap(__float_as_uint(x), __float_as_uint(x), false, false); return fmaxf(__uint_as_float(r[0]), __uint_as_float(r[1])); }
DEV float sum_halves(float x) { const auto r = __builtin_amdgcn_permlane32_swap(__float_as_uint(x), __float_as_uint(x), false, false); return __uint_as_float(r[0]) + __uint_as_float(r[1]); }
#define MFMA32(a, b, c) __builtin_amdgcn_mfma_f32_32x32x16_bf16((a), (b), (c), 0, 0, 0)
DEV float ex2(float x) { return __builtin_amdgcn_exp2f(x); }

struct AttnIt { int p, bh, sh, L, r, q0, kmin, kmax; };
DEV void attn_decode(int li, int x, AttnIt& d) {
    d.p = li >> 9; d.bh = 8 * x + ((li >> 6) & 7); const int qblk = li & 63;
    d.sh = 2 * d.p; d.L = S >> d.sh; const int bpr = d.L >> 6;
    d.r = qblk / bpr; d.q0 = (qblk % bpr) * 64;
    d.kmin = d.q0 >= 64 ? 0 : 2; const int km = (d.L + 63 - d.q0) >> 5; d.kmax = km > 5 ? 5 : km;
}
DEV int med3i(int v, int lo, int hi) { return v < lo ? lo : (v > hi ? hi : v); }
DEV void attn_ldrows(const bf16_t* base, const AttnIt& d, int i0, u32x4 (&v)[4], int lane) {
    const int rr = lane >> 3, ch = lane & 7; const char* hb = (const char*)(base + (size_t)d.bh * S * HD); const unsigned cst = (unsigned)(d.r * 128 + ch * 16);
#pragma unroll
    for (int i = 0; i < 4; ++i) v[i] = *(const u32x4*)(hb + (((unsigned)med3i(i0 + rr + 8 * i, 0, d.L - 1) << (d.sh + 7)) + cst));
}
DEV void attn_ldkv(const Args& a, const AttnIt& d, int kk, u32x4 (&k)[4], u32x4 (&v)[4], int lane) {
    const int rr = lane >> 3, ch = lane & 7, i0 = d.q0 - 64 + 32 * kk; const unsigned cst = (unsigned)(d.r * 128 + ch * 16);
    const char* kb = (const char*)((const bf16_t*)(a.ws + WS_AK) + (size_t)d.bh * S * HD); const char* vb = (const char*)((const bf16_t*)(a.ws + WS_AV) + (size_t)d.bh * S * HD);
#pragma unroll
    for (int i = 0; i < 4; ++i) { const unsigned off = ((unsigned)med3i(i0 + rr + 8 * i, 0, d.L - 1) << (d.sh + 7)) + cst; k[i] = *(const u32x4*)(kb + off); v[i] = *(const u32x4*)(vb + off); }
}
DEV void attn_items(const Args& a, unsigned char* lds, int wg, int G, int lane, int wave) {
    unsigned char* ws = a.ws;
    constexpr int NIT = 3 * 512; constexpr float THR = 6.f;
    const int x = wg & 7, NGW = (G >> 3) * NWM;
    int item = (wg >> 3) * NWM + wave; if (item >= NIT) return;
    LAS unsigned char* slot = (LAS unsigned char*)lds + wave * MIX_WAVE_LDS; lds_cptr slot3 = (lds_cptr)slot; LAS unsigned char* kslot = slot + VSLOT;
    const int t = lane & 31, hi = lane >> 5, rr = lane >> 3, ch = lane & 7;
    AttnIt d; attn_decode(item, x, d);
    bf16x8 qf[2][4], kf[4]; u32x4 kraw[4], vv[4];
    attn_ldkv(a, d, d.kmin, kraw, vv, lane);
    for (;;) {
        const LAS float* tph = (const LAS float*)((LAS unsigned char*)lds + MIX_BIAS_OFF) + (d.p * NH + (d.bh & 7)) * 192 + (32 + 4 * hi - t);
        f32x16 o[2][2] = {}; float m[2] = {0.f, 0.f}, l[2] = {0.f, 0.f};
        const int nitem = item + NGW; const bool hasn = nitem < NIT;
        AttnIt dn = d; if (hasn) attn_decode(nitem, x, dn);
#pragma unroll
        for (int j = 0; j < 2; ++j) { u32x4 qraw[4]; attn_ldrows((const bf16_t*)(ws + WS_AQ), d, d.q0 + 32 * j, qraw, lane); stage_rows_k(kslot, qraw, lane); asm volatile("" ::: "memory"); read_row_frags(qf[j], kslot, lane); asm volatile("" ::: "memory"); }
        for (int kk = d.kmin; kk <= d.kmax; ++kk) {
            const int kbase = d.q0 - 64 + 32 * kk;
#pragma unroll
            for (int i = 0; i < 4; ++i) *(LAS u32x4*)(slot + (rr + 8 * i) * VROW + ch * 16) = vv[i];
            stage_rows_k(kslot, kraw, lane);
            asm volatile("" ::: "memory");
            read_row_frags(kf, kslot, lane);
            const bf16x8 v00 = tr_frag(slot3, 0, 0, lane), v10 = tr_frag(slot3, 1, 0, lane), v01 = tr_frag(slot3, 0, 1, lane), v11 = tr_frag(slot3, 1, 1, lane);
            asm volatile("" ::: "memory");
            if (kk < d.kmax) attn_ldkv(a, d, kk + 1, kraw, vv, lane);
            else if (hasn) attn_ldkv(a, dn, dn.kmin, kraw, vv, lane);
            const bool edge = kbase < 0 || kbase + 31 >= d.L;
            f32x16 sc[2] = {};
#pragma unroll
            for (int st = 0; st < 4; ++st) { sc[0] = MFMA32(kf[st], qf[0][st], sc[0]); sc[1] = MFMA32(kf[st], qf[1][st], sc[1]); }
            float mx[2]; bool mv = false;
#pragma unroll
            for (int j = 0; j < 2; ++j) {
                const int kj = kk - j; const bool act = kj >= 0 && kj <= 4; const LAS float* tb = tph + 32 * (act ? kj : 0); const float moff = act ? m[j] : 1e30f;
#pragma unroll
                for (int rg = 0; rg < 16; ++rg) sc[j][rg] = (sc[j][rg] - moff) + tb[(rg & 3) + 8 * (rg >> 2)];
                if (edge) {
#pragma unroll
                    for (int rg = 0; rg < 16; ++rg) { const int ki = kbase + crow(rg, hi); sc[j][rg] = (ki >= 0 && ki < d.L) ? sc[j][rg] : -1e30f; } }
                float t0 = fmaxf(fmaxf(sc[j][0], sc[j][1]), fmaxf(sc[j][2], sc[j][3]));
#pragma unroll
                for (int rg = 4; rg < 16; rg += 4) t0 = fmaxf(t0, fmaxf(fmaxf(sc[j][rg], sc[j][rg + 1]), fmaxf(sc[j][rg + 2], sc[j][rg + 3])));
                mx[j] = max_halves(t0);
                const bool first = act && (kj == 0 || kk == d.kmin);
                mv = mv || first || (act && __any(mx[j] > THR));
            }
            if (mv) {
#pragma unroll
                for (int j = 0; j < 2; ++j) { const int kj = kk - j; const bool act = kj >= 0 && kj <= 4, first = act && (kj == 0 || kk == d.kmin);
                    const float dl = !act ? 0.f : (first ? mx[j] : fmaxf(mx[j], 0.f)), f = ex2(-dl); m[j] += dl; l[j] *= f;
#pragma unroll
                    for (int rg = 0; rg < 16; ++rg) { sc[j][rg] -= dl; o[j][0][rg] *= f; o[j][1][rg] *= f; } }
            }
#pragma unroll
            for (int j = 0; j < 2; ++j) { float ps0 = 0.f, ps1 = 0.f;
#pragma unroll
                for (int rg = 0; rg < 16; rg += 2) { sc[j][rg] = ex2(sc[j][rg]); sc[j][rg + 1] = ex2(sc[j][rg + 1]); ps0 += sc[j][rg]; ps1 += sc[j][rg + 1]; }
                l[j] += ps0 + ps1; }
            { const bf16x8 p00 = pack_p(sc[0], 0), p01 = pack_p(sc[0], 1), p10 = pack_p(sc[1], 0), p11 = pack_p(sc[1], 1);
              o[0][0] = MFMA32(v00, p00, o[0][0]); o[0][1] = MFMA32(v01, p00, o[0][1]); o[1][0] = MFMA32(v00, p10, o[1][0]); o[1][1] = MFMA32(v01, p10, o[1][1]);
              o[0][0] = MFMA32(v10, p01, o[0][0]); o[0][1] = MFMA32(v11, p01, o[0][1]); o[1][0] = MFMA32(v10, p11, o[1][0]); o[1][1] = MFMA32(v11, p11, o[1][1]); }
        }
#pragma unroll
        for (int j = 0; j < 2; ++j) {
            float lt = sum_halves(l[j]);
            const float il = 1.f / lt;
            const size_t orow = ((size_t)d.p * NB * NH + d.bh) * S + (size_t)(((d.q0 + 32 * j + t) << d.sh) + d.r);
#pragma unroll
            for (int g4 = 0; g4 < 4; ++g4) {
                *(LAS u32x2*)(kslot + t * KROW + (8 * g4 + 4 * hi) * 2) = (u32x2){pg8::cvt_pk_bf16(o[j][0][4 * g4] * il, o[j][0][4 * g4 + 1] * il), pg8::cvt_pk_bf16(o[j][0][4 * g4 + 2] * il, o[j][0][4 * g4 + 3] * il)};
                *(LAS u32x2*)(kslot + t * KROW + (32 + 8 * g4 + 4 * hi) * 2) = (u32x2){pg8::cvt_pk_bf16(o[j][1][4 * g4] * il, o[j][1][4 * g4 + 1] * il), pg8::cvt_pk_bf16(o[j][1][4 * g4 + 2] * il, o[j][1][4 * g4 + 3] * il)};
            }
            asm volatile("" ::: "memory");
            { bf16_t* ob = (bf16_t*)(ws + WS_ATTO) + ((size_t)d.p * NB * NH + d.bh) * S * HD;
#pragma unroll
              for (int i = 0; i < 4; ++i) { const u32x4 w = *(const LAS u32x4*)(kslot + (rr + 8 * i) * KROW + ch * 16);
                  *(u32x4*)(ob + (size_t)(((d.q0 + 32 * j + rr + 8 * i) << d.sh) + d.r) * HD + ch * 8) = w; } }
            asm volatile("" ::: "memory");
            if (hi == 0) ((float*)(ws + (d.p == 0 ? WS_ATTL0 : (d.p == 1 ? WS_ATTL1 : WS_ATTL2))))[(size_t)d.bh * S + (size_t)(((d.q0 + 32 * j + t) << d.sh) + d.r)] = m[j] + __log2f(lt);
        }
        if (!hasn) break;
        item = nitem; d = dn;
    }
}
DEV void retstate_item(const Args& a, unsigned char* lds, int item, int xg, int lane, int wave) {
    unsigned char* ws = a.ws;
    const int dir = item & 1, n = (item >> 1) & 31, bh = 8 * xg + (item >> 6), h = bh & 7;
    const bf16_t* Kc = (const bf16_t*)(ws + WS_RK) + ((size_t)bh * S + n * 128) * HD; const bf16_t* Vc = (const bf16_t*)(ws + WS_RV) + ((size_t)bh * S + n * 128) * HD;
    const float lg = a.in[IN_DECAY][dir * NH + h] * LOG2E;
    LAS unsigned char* vs = (LAS unsigned char*)lds + wave * MIX_WAVE_LDS; LAS unsigned char* ks = vs + VSLOT; lds_cptr vs3 = (lds_cptr)vs, ks3 = (lds_cptr)ks;
    f32x16 acc[2][2] = {};
    for (int blk = 0; blk < 4; ++blk) {
        { const int rr = lane >> 3, ch = lane & 7;
          u32x4 v[4], k[4];
#pragma unroll
          for (int i = 0; i < 4; ++i) { const int mrow = 32 * blk + rr + 8 * i; v[i] = *(const u32x4*)(Vc + (size_t)mrow * HD + ch * 8); k[i] = *(const u32x4*)(Kc + (size_t)mrow * HD + ch * 8); }
#pragma unroll
          for (int i = 0; i < 4; ++i) { const int mrow = 32 * blk + rr + 8 * i; const float z = ex2(lg * (float)(dir == 0 ? 127 - mrow : mrow));
              const unsigned kw[4] = {k[i].x, k[i].y, k[i].z, k[i].w}; u32x4 o;
              o.x = pg8::cvt_pk_bf16(bf2f(kw[0] & 0xffffu) * z, bf2f(kw[0] >> 16) * z); o.y = pg8::cvt_pk_bf16(bf2f(kw[1] & 0xffffu) * z, bf2f(kw[1] >> 16) * z);
              o.z = pg8::cvt_pk_bf16(bf2f(kw[2] & 0xffffu) * z, bf2f(kw[2] >> 16) * z); o.w = pg8::cvt_pk_bf16(bf2f(kw[3] & 0xffffu) * z, bf2f(kw[3] >> 16) * z);
              *(LAS u32x4*)(vs + (rr + 8 * i) * VROW + ch * 16) = v[i]; *(LAS u32x4*)(ks + (rr + 8 * i) * VROW + ch * 16) = o; } }
        LDS_WAIT();
#pragma unroll
        for (int s = 0; s < 2; ++s) {
            const bf16x8 v0 = tr_frag(vs3, s, 0, lane), v1 = tr_frag(vs3, s, 1, lane), k0 = tr_frag(ks3, s, 0, lane), k1 = tr_frag(ks3, s, 1, lane);
            acc[0][0] = MFMA32(v0, k0, acc[0][0]); acc[0][1] = MFMA32(v0, k1, acc[0][1]); acc[1][0] = MFMA32(v1, k0, acc[1][0]); acc[1][1] = MFMA32(v1, k1, acc[1][1]);
        }
        LDS_WAIT();
    }
    bf16_t* KT = (bf16_t*)(ws + WS_KF) + (((size_t)dir * NB * NH + bh) * 32 + n) * 4096;
    const int c = lane & 31, hi = lane >> 5;
#pragma unroll
    for (int eb = 0; eb < 2; ++eb)
#pragma unroll
        for (int db = 0; db < 2; ++db)
#pragma unroll
            for (int rg = 0; rg < 16; ++rg) KT[(32 * eb + crow(rg, hi)) * 64 + 32 * db + c] = (bf16_t)f2bf(acc[eb][db][rg]);
}
DEV void phase_scan(const Args& a, int xg, int gtid, int NT) {
    unsigned char* ws = a.ws;
    for (int sl = gtid; sl < 2 * NH * 1024; sl += NT) {
        const int dir = sl >> 13, bh = 8 * xg + ((sl >> 10) & 7), q = sl & 1023, h = bh & 7;
        const float gC = ex2(a.in[IN_DECAY][dir * NH + h] * LOG2E * 128.f);
        const uint2* kt = (const uint2*)(ws + WS_KF) + ((size_t)dir * NB * NH + bh) * 32 * 1024 + q;
        uint2* st = (uint2*)(ws + st_off(dir, bh, 0)) + q;
        float4 s = make_float4(0.f, 0.f, 0.f, 0.f);
        for (int i = 0; i < 32; ++i) { const int n = dir == 0 ? i : 31 - i;
            st[(size_t)n * 1024] = make_uint2(pg8::cvt_pk_bf16(s.x, s.y), pg8::cvt_pk_bf16(s.z, s.w));
            const uint2 kv = kt[(size_t)n * 1024];
            s.x = gC * s.x + bf2f(kv.x & 0xffffu); s.y = gC * s.y + bf2f(kv.x >> 16); s.z = gC * s.z + bf2f(kv.y & 0xffffu); s.w = gC * s.w + bf2f(kv.y >> 16); }
    }
}
DEV void ld_rows32(const bf16_t* base, u32x4 (&v)[4], int lane) {
    const char* b = (const char*)base; const unsigned off = (unsigned)((lane >> 3) * 128 + (lane & 7) * 16);
#pragma unroll
    for (int i = 0; i < 4; ++i) v[i] = *(const u32x4*)(b + off + i * 1024);
}
DEV void retout_item(const Args& a, unsigned char* lds, int item, int xg, int lane, int wave) {
    unsigned char* ws = a.ws;
    const int hq = item & 1, n = (item >> 1) & 31, bh = 8 * xg + (item >> 6), h = bh & 7, b = bh >> 3;
    const bf16_t* Qc = (const bf16_t*)(ws + WS_RQ) + ((size_t)bh * S + n * 128) * HD; const bf16_t* Kc = (const bf16_t*)(ws + WS_RK) + ((size_t)bh * S + n * 128) * HD;
    const bf16_t* Vc = (const bf16_t*)(ws + WS_RV) + ((size_t)bh * S + n * 128) * HD; const bf16_t* Gc = (const bf16_t*)(ws + WS_RG) + ((size_t)bh * S + n * 128) * HD;
    const bf16_t* SF = (const bf16_t*)(ws + st_off(0, bh, n)); const bf16_t* SB = (const bf16_t*)(ws + st_off(1, bh, n));
    const float lg0 = a.in[IN_DECAY][h] * LOG2E, lg1 = a.in[IN_DECAY][NH + h] * LOG2E;
    LAS unsigned char* slot = (LAS unsigned char*)lds + wave * MIX_WAVE_LDS; lds_cptr slot3 = (lds_cptr)slot; LAS unsigned char* kslot = slot + VSLOT;
    const int t = lane & 31, hi = lane >> 5, rr = lane >> 3, ch = lane & 7;
    bf16x8 qf[2][4];
#pragma unroll
    for (int j = 0; j < 2; ++j) { u32x4 raw[4]; ld_rows32(Qc + (size_t)(64 * hq + 32 * j) * HD, raw, lane); stage_rows_k(kslot, raw, lane); asm volatile("" ::: "memory"); read_row_frags(qf[j], kslot, lane); asm volatile("" ::: "memory"); }
    f32x16 o[2][2] = {};
#pragma unroll
    for (int dir = 0; dir < 2; ++dir) {
#pragma unroll
        for (int eb = 0; eb < 2; ++eb) { u32x4 raw[4]; bf16x8 sf[4]; ld_rows32((dir == 0 ? SF : SB) + (size_t)(32 * eb) * 64, raw, lane); stage_rows_k(kslot, raw, lane); asm volatile("" ::: "memory"); read_row_frags(sf, kslot, lane); asm volatile("" ::: "memory");
#pragma unroll
            for (int j = 0; j < 2; ++j)
#pragma unroll
                for (int st = 0; st < 4; ++st) o[j][eb] = MFMA32(sf[st], qf[j][st], o[j][eb]); }
#pragma unroll
        for (int j = 0; j < 2; ++j) { const int c = 64 * hq + 32 * j + t; const float f = dir == 0 ? ex2(lg0 * (float)(c + 1) - lg1 * (float)(128 - c)) : ex2(lg1 * (float)(128 - c));
#pragma unroll
            for (int rg = 0; rg < 16; ++rg) { o[j][0][rg] *= f; o[j][1][rg] *= f; } }
    }
    float f1[4], f2[4], b1[4], b2[4];
#pragma unroll
    for (int i = 0; i < 4; ++i) { f1[i] = __builtin_bit_cast(float, __builtin_amdgcn_readfirstlane(__builtin_bit_cast(int, ex2(-lg0 * (float)i)))); f2[i] = __builtin_bit_cast(float, __builtin_amdgcn_readfirstlane(__builtin_bit_cast(int, ex2(-lg0 * (float)(8 * i)))));
        b1[i] = __builtin_bit_cast(float, __builtin_amdgcn_readfirstlane(__builtin_bit_cast(int, ex2(lg1 * (float)i)))); b2[i] = __builtin_bit_cast(float, __builtin_amdgcn_readfirstlane(__builtin_bit_cast(int, ex2(lg1 * (float)(8 * i))))); }
#pragma nounroll
    for (int kb = 0; kb < 4; ++kb) {
        { u32x4 kraw[4], vv[4]; ld_rows32(Kc + (size_t)(32 * kb) * HD, kraw, lane); ld_rows32(Vc + (size_t)(32 * kb) * HD, vv, lane);
#pragma unroll
        for (int i = 0; i < 4; ++i) *(LAS u32x4*)(slot + (rr + 8 * i) * VROW + ch * 16) = vv[i];
        stage_rows_k(kslot, kraw, lane); }
        asm volatile("" ::: "memory");
        bf16x8 kf[4]; read_row_frags(kf, kslot, lane);
        const bf16x8 v00 = tr_frag(slot3, 0, 0, lane), v10 = tr_frag(slot3, 1, 0, lane), v01 = tr_frag(slot3, 0, 1, lane), v11 = tr_frag(slot3, 1, 1, lane);
        asm volatile("" ::: "memory");
#pragma unroll
        for (int j = 0; j < 2; ++j) {
            const int qbi = 2 * hq + j;
            f32x16 sc = {};
#pragma unroll
            for (int st = 0; st < 4; ++st) sc = MFMA32(kf[st], qf[j][st], sc);
            if (kb < qbi) { const float A = ex2(lg0 * (float)(32 * (qbi - kb) + t - 4 * hi)); float a2[4];
#pragma unroll
                for (int q = 0; q < 4; ++q) a2[q] = A * f2[q];
#pragma unroll
                for (int rg = 0; rg < 16; ++rg) sc[rg] *= a2[rg >> 2] * f1[rg & 3];
            } else if (kb > qbi) { const float A = ex2(lg1 * (float)(32 * (kb - qbi) - t + 4 * hi)); float a2[4];
#pragma unroll
                for (int q = 0; q < 4; ++q) a2[q] = A * b2[q];
#pragma unroll
                for (int rg = 0; rg < 16; ++rg) sc[rg] *= a2[rg >> 2] * b1[rg & 3];
            } else {
                int tt = t - 4 * hi; asm volatile("" : "+v"(tt));
#pragma unroll
                for (int rg = 0; rg < 16; ++rg) { const int df = tt - ((rg & 3) + 8 * (rg >> 2)); sc[rg] *= df >= 0 ? ex2(lg0 * (float)df) : ex2(lg1 * (float)(-df)); }
            }
            const bf16x8 p0 = pack_p(sc, 0), p1 = pack_p(sc, 1);
            o[j][0] = MFMA32(v00, p0, o[j][0]); o[j][0] = MFMA32(v10, p1, o[j][0]);
            o[j][1] = MFMA32(v01, p0, o[j][1]); o[j][1] = MFMA32(v11, p1, o[j][1]);
        }
    }
    const float* gn = a.in[IN_GN] + h * HD; const unsigned gnoff = (unsigned)(16 * hi); LAS unsigned char* kq = kslot + t * KROW + 8 * hi;
#pragma unroll
    for (int j = 0; j < 2; ++j) {
        const int r0 = n * 128 + 64 * hq + 32 * j;
        { u32x4 raw[4]; ld_rows32(Gc + (size_t)(64 * hq + 32 * j) * HD, raw, lane); stage_rows_k(kslot, raw, lane); asm volatile("" ::: "memory"); }
        float sm = 0.f;
#pragma unroll
        for (int rg = 0; rg < 16; ++rg) sm += o[j][0][rg] + o[j][1][rg];
        sm = sum_halves(sm); const float mu = sm * (1.f / 64.f); float vq = 0.f;
#pragma unroll
        for (int rg = 0; rg < 16; ++rg) { const float d0 = o[j][0][rg] - mu, d1 = o[j][1][rg] - mu; vq += d0 * d0 + d1 * d1; }
        vq = sum_halves(vq); const float rstd = rsqrtf(vq * (1.f / 64.f) + EPS);
        u32x2 ow[2][4];
#pragma unroll
        for (int db = 0; db < 2; ++db)
#pragma unroll
            for (int g4 = 0; g4 < 4; ++g4) { const u32x2 gw = *(const LAS u32x2*)(kq + (32 * db + 8 * g4) * 2); const float4 gg = *(const float4*)((const char*)gn + gnoff + (32 * db + 8 * g4) * 4);
                const float gate[4] = {bf2f(gw[0] & 0xffffu), bf2f(gw[0] >> 16), bf2f(gw[1] & 0xffffu), bf2f(gw[1] >> 16)}; const float gv[4] = {gg.x, gg.y, gg.z, gg.w}; float ov[4];
#pragma unroll
                for (int i = 0; i < 4; ++i) ov[i] = (o[j][db][4 * g4 + i] - mu) * rstd * gv[i] * (gate[i] * __builtin_amdgcn_rcpf(1.f + ex2(-gate[i] * LOG2E)));
                ow[db][g4] = (u32x2){pg8::cvt_pk_bf16(ov[0], ov[1]), pg8::cvt_pk_bf16(ov[2], ov[3])}; }
        asm volatile("" ::: "memory");
#pragma unroll
        for (int db = 0; db < 2; ++db)
#pragma unroll
            for (int g4 = 0; g4 < 4; ++g4) *(LAS u32x2*)(kq + (32 * db + 8 * g4) * 2) = ow[db][g4];
        asm volatile("" ::: "memory");
        { bf16_t* ob = (bf16_t*)(ws + WS_XN) + ((size_t)b * S + r0) * D + h * HD;
#pragma unroll
          for (int i = 0; i < 4; ++i) { const u32x4 w = *(const LAS u32x4*)(kslot + (rr + 8 * i) * KROW + ch * 16); *(u32x4*)(ob + (size_t)(rr + 8 * i) * D + ch * 8) = w; } }
        asm volatile("" ::: "memory");
    }
}
DEV void phase_attn_merge(const Args& a, int xg, int gtid, int NT) {
    unsigned char* ws = a.ws; const bf16_t* O = (const bf16_t*)(ws + WS_ATTO); bf16_t* mixed = (bf16_t*)(ws + WS_XN);
    for (int it = gtid; it < NH * S * 8; it += NT) {
        const int ch = it & 7, row = xg * NH * S + (it >> 3);
        const int bh = row >> 12, pos = row & 4095, b = bh >> 3, h = bh & 7;
        const float l0 = ((const float*)(ws + WS_ATTL0))[row], l1 = ((const float*)(ws + WS_ATTL1))[row], l2 = ((const float*)(ws + WS_ATTL2))[row];
        const float mx = fmaxf(l0, fmaxf(l1, l2)); float w0 = ex2(l0 - mx), w1 = ex2(l1 - mx), w2 = ex2(l2 - mx); const float is = 1.f / (w0 + w1 + w2); w0 *= is; w1 *= is; w2 *= is;
        const uint4 a0 = *(const uint4*)(O + (size_t)row * HD + ch * 8), a1 = *(const uint4*)(O + ((size_t)NB * NH * S + row) * HD + ch * 8), a2 = *(const uint4*)(O + ((size_t)2 * NB * NH * S + row) * HD + ch * 8);
        const unsigned x0[4] = {a0.x, a0.y, a0.z, a0.w}, x1[4] = {a1.x, a1.y, a1.z, a1.w}, x2[4] = {a2.x, a2.y, a2.z, a2.w}; unsigned o[4];
#pragma unroll
        for (int j = 0; j < 4; ++j) o[j] = pg8::cvt_pk_bf16(w0 * bf2f(x0[j] & 0xffffu) + w1 * bf2f(x1[j] & 0xffffu) + w2 * bf2f(x2[j] & 0xffffu), w0 * bf2f(x0[j] >> 16) + w1 * bf2f(x1[j] >> 16) + w2 * bf2f(x2[j] >> 16));
        *(uint4*)(mixed + ((size_t)b * S + pos) * D + 512 + h * HD + ch * 8) = make_uint4(o[0], o[1], o[2], o[3]);
    }
}
DEV void phase_mix_a(const Args& a, unsigned char* lds, int wg, int G, int lane, int wave, int tid) {
    { const float* bt = (const float*)(a.ws + WS_BIAS); LAS float* bl = (LAS float*)((LAS unsigned char*)lds + MIX_BIAS_OFF);
      for (int i = tid; i < 3 * NH * 192; i += NTHR) { const int ph = i / 192, bi = i % 192 - 32; bl[i] = (bi >= 0 && bi <= 128) ? bt[ph * 129 + bi] : -1e30f; } }
    __syncthreads();
    if (wave >= NWM) {
        for (int rep = 0; rep < a.rep[5]; ++rep) { asm volatile("" : "+v"(lane)); phase_latew(a, lds, wg * (NWAVES - NWM) + (wave - NWM), G * (NWAVES - NWM), lane, wave); }
        return;
    }
    const int x = wg & 7, wq = (wg >> 3) * NWM + wave, WPX = (G >> 3) * NWM;
    for (int rep = 0; rep < a.rep[0]; ++rep) { asm volatile("" : "+v"(lane)); for (int it = wq; it < 2 * 32 * NH; it += WPX) retstate_item(a, lds, it, x, lane, wave); }
    for (int rep = 0; rep < a.rep[1]; ++rep) { asm volatile("" : "+v"(lane)); attn_items(a, lds, wg, G, lane, wave); }
}
DEV void phase_mix_b(const Args& a, unsigned char* lds, int wg, int G, int lane, int wave, int tid) {
    const int x = wg & 7, wq = (wg >> 3) * NWAVES + wave, WPX = (G >> 3) * NWAVES;
    for (int rep = 0; rep < a.rep[2]; ++rep) { asm volatile("" : "+v"(lane)); for (int it = wq; it < NH * 32 * 2; it += WPX) retout_item(a, lds, it, x, lane, wave); }
    for (int rep = 0; rep < a.rep[3]; ++rep) { asm volatile("" : "+v"(tid)); phase_attn_merge(a, x, (wg >> 3) * NTHR + tid, (G >> 3) * NTHR); }
}
#define XB_TMO      128
#define XB_XCNT(j)  (256  + 64 * (j))
#define XB_XSUB(j)  (1280 + 64 * (j))
#define XB_XGEN(j)  (2304 + 64 * (j))
#define XB_TOP      3328
#define XB_TOPGEN   3392
#define XCD_BAR_WORDS 3456
#define XB_SPIN_CAP (1u << 18)

__device__ __forceinline__ unsigned xb_ld(unsigned* p)              { return __hip_atomic_load(p, __ATOMIC_RELAXED, __HIP_MEMORY_SCOPE_AGENT); }
__device__ __forceinline__ unsigned xb_add(unsigned* p, unsigned v) { return __hip_atomic_fetch_add(p, v, __ATOMIC_RELAXED, __HIP_MEMORY_SCOPE_AGENT); }
__device__ __forceinline__ unsigned xb_xcc_id() { return (unsigned)__builtin_amdgcn_s_getreg((3 << 11) | 20) & 0xFu; }
#define XB_SPIN(cond, bar) do { unsigned _sp = 0; while (cond) { __builtin_amdgcn_s_sleep(1); \
    if ((++_sp & 255u) == 0u) { if (xb_ld(&(bar)[XB_TMO])) break; if (_sp > XB_SPIN_CAP) { atomicAdd(&(bar)[XB_TMO], 1u); break; } } } } while (0)

struct XcdBarrier {
    unsigned* bar; unsigned x;
    volatile LAS unsigned* st;
};

__device__ __forceinline__ XcdBarrier xcd_barrier_post(unsigned* bar, volatile LAS unsigned* st) {
    XcdBarrier b; b.bar = bar; b.x = xb_xcc_id(); b.st = st;
    if (threadIdx.x == 0) (void)xb_add(&bar[XB_XCNT(b.x)], 1u);
    return b;
}
__device__ __forceinline__ void xcd_barrier_complete(unsigned* bar, unsigned x, unsigned& nloc, unsigned& nx) {
    const unsigned G = gridDim.x * gridDim.y * gridDim.z;
    unsigned sum, cnt, mine, sp = 0u;
    for (;;) {
        sum = 0u; cnt = 0u; mine = 0u;
#pragma unroll
        for (unsigned j = 0; j < 16; ++j) { const unsigned c = xb_ld(&bar[XB_XCNT(j)]); sum += c; cnt += (c > 0u) ? 1u : 0u; mine = (j == x) ? c : mine; }
        if (sum == G) break;
        __builtin_amdgcn_s_sleep(1);
        if ((++sp & 255u) == 0u) { if (xb_ld(&bar[XB_TMO])) break; if (sp > XB_SPIN_CAP) { atomicAdd(&bar[XB_TMO], 1u); break; } }
    }
    nloc = mine > 0u ? mine : 1u; nx = cnt > 0u ? cnt : 1u;
}

__device__ __forceinline__ void xcd_barrier(const XcdBarrier& b) {
    asm volatile("s_waitcnt vmcnt(0)" ::: "memory");
    __syncthreads();
    if (threadIdx.x == 0) {
        unsigned* bar = b.bar;
        __builtin_amdgcn_s_waitcnt(0);
        unsigned nloc = b.st[0], nx = b.st[1];
        if (nloc == 0u) { xcd_barrier_complete(bar, b.x, nloc, nx); b.st[0] = nloc; b.st[1] = nx; }
        const unsigned old = xb_add(&bar[XB_XSUB(b.x)], 1u);
        const unsigned gen = old / nloc;
        if (old + 1u == (gen + 1u) * nloc) {
            __builtin_amdgcn_fence(__ATOMIC_RELEASE, "agent");
            asm volatile("s_waitcnt vmcnt(0)" ::: "memory");
            const unsigned og = xb_add(&bar[XB_TOP], 1u);
            const unsigned tg = og / nx;
            if (og + 1u == (tg + 1u) * nx) xb_add(&bar[XB_TOPGEN], 1u);
            else XB_SPIN(xb_ld(&bar[XB_TOPGEN]) == tg, bar);
            __builtin_amdgcn_fence(__ATOMIC_ACQUIRE, "agent");
            xb_add(&bar[XB_XGEN(b.x)], 1u);
            asm volatile("s_waitcnt vmcnt(0)" ::: "memory");
        } else {
            XB_SPIN(xb_ld(&bar[XB_XGEN(b.x)]) == gen, bar);
            __builtin_amdgcn_fence(__ATOMIC_ACQUIRE, "agent");
            asm volatile("s_waitcnt vmcnt(0)" ::: "memory");
        }
    }
    __syncthreads();
}


#define GB_GC(g)     (8192 + 64 * (g))
#define GB_N(g, j)   (9216 + 16 * (16 * (g) + (j)))
#define GB_A(g, j)   (11264 + 16 * (16 * (g) + (j)))
struct GroupBarrier { unsigned* ctl; unsigned g, x, ng; volatile LAS unsigned* st; };
__device__ __forceinline__ GroupBarrier group_barrier_post(unsigned* ctl, unsigned g, unsigned ng, volatile LAS unsigned* st) {
    GroupBarrier b; b.ctl = ctl; b.g = g; b.x = xb_xcc_id(); b.ng = ng; b.st = st;
    if (threadIdx.x == 0) (void)xb_add(&ctl[GB_N(g, b.x)], 1u);
    return b;
}
__device__ __forceinline__ void group_barrier(const GroupBarrier& b, unsigned epoch) {
    asm volatile("s_waitcnt vmcnt(0)" ::: "memory");
    __syncthreads();
    if (threadIdx.x == 0) {
        unsigned* ctl = b.ctl; unsigned n = b.st[0];
        if (n == 0u) {
            unsigned sp = 0u;
            for (;;) { unsigned sum = 0u, mine = 0u;
#pragma unroll
                for (unsigned j = 0; j < 16; ++j) { const unsigned c = xb_ld(&ctl[GB_N(b.g, j)]); sum += c; mine = (j == b.x) ? c : mine; }
                n = mine; if (sum == b.ng) break;
                __builtin_amdgcn_s_sleep(1); if (++sp > (1u << 22)) break; }
            n = n ? n : 1u; b.st[0] = n;
        }
        const unsigned old = xb_add(&ctl[GB_A(b.g, b.x)], 1u);
        if (old + 1u == epoch * n) {
            __builtin_amdgcn_fence(__ATOMIC_RELEASE, "agent");
            asm volatile("s_waitcnt vmcnt(0)" ::: "memory");
            (void)xb_add(&ctl[GB_GC(b.g)], n);
        }
        unsigned sp = 0u; const unsigned target = epoch * b.ng;
        while (xb_ld(&ctl[GB_GC(b.g)]) < target) { __builtin_amdgcn_s_sleep(1); if (++sp > (1u << 22)) break; }
        __builtin_amdgcn_fence(__ATOMIC_ACQUIRE, "agent");
        asm volatile("s_waitcnt vmcnt(0)" ::: "memory");
    }
    __syncthreads();
}
#ifndef MK_LAUNCHES
#define MK_LAUNCHES 1
#endif
#ifndef WGM_MOE1
#define WGM_MOE1 8
#endif
#ifndef WGM_MOE2
#define WGM_MOE2 8
#endif
constexpr int NPH = 11;
typedef const __attribute__((address_space(4))) Args* kargs_t;
DEV Args load_args(kargs_t kp) { Args a;
#pragma unroll
    for (int i = 0; i < 13; ++i) a.in[i] = kp->in[i];
    a.out = kp->out; a.ws = kp->ws; a.ph_lo = kp->ph_lo; a.ph_hi = kp->ph_hi;
#pragma unroll
    for (int i = 0; i < 16; ++i) a.rep[i] = kp->rep[i];
    return a; }
__global__ void __launch_bounds__(NTHR, 2) mega(Args a_) {
    kargs_t kp = (kargs_t)__builtin_amdgcn_kernarg_segment_ptr();
    extern __shared__ __attribute__((aligned(16))) unsigned char lds[];
    int tid = threadIdx.x, lane = tid & 63, wave = __builtin_amdgcn_readfirstlane(tid >> 6);
    const int G = gridDim.x, wg = blockIdx.x, NGW = G * NWAVES; int gw = wg * NWAVES + wave;
#define FRESH_IDS() do { tid = threadIdx.x; asm volatile("" : "+v"(tid)); lane = tid & 63; wave = __builtin_amdgcn_readfirstlane(tid >> 6); gw = wg * NWAVES + wave; } while (0)
    const int lo = kp->ph_lo, hi = kp->ph_hi;
    unsigned char* ws = kp->ws;
    volatile LAS unsigned* bst = (volatile LAS unsigned*)((LAS unsigned char*)lds + LDS_BYTES - 64);
    if (tid < 4) bst[tid] = 0u;
    __syncthreads();
    XcdBarrier bar = xcd_barrier_post((unsigned*)(ws + WS_CTL) + 4096, bst);
    const GroupBarrier gbar = group_barrier_post((unsigned*)(ws + WS_CTL), (unsigned)(wg & 7), (unsigned)(G >> 3), bst + 2);
#define IN(k) (lo <= (k) && (k) < hi)
#define SEAM(k) do { if (IN(k) && IN((k) + 1)) { if ((k) >= 1 && (k) <= 6) group_barrier(gbar, (unsigned)(k)); else xcd_barrier(bar); } } while (0)
    if (IN(0)) { FRESH_IDS(); const Args a = load_args(kp); unsigned char* ws = a.ws; for (int r = 0; r < a.rep[6]; ++r) { FRESH_IDS(); phase_prep(a, lds, gw, NGW, lane, wave); } }
    SEAM(0);
    if (IN(1)) { FRESH_IDS(); const Args a = load_args(kp); unsigned char* ws = a.ws; pg8::Gemm g{(const bf16_t*)(ws + WS_XN), (const bf16_t*)(ws + WS_WIN), D}; SchedPlain Sc; Sc.init(M, PC, G, wg); Sc.rowbytes = D * 2;
        EpiInProj E{ws, (const float*)(ws + WS_ROPE)};
        for (int r = 0; r < a.rep[8]; ++r) { FRESH_IDS(); pg8::Gemm g2 = g; asm volatile("" : "+s"(g2.A), "+s"(g2.Bt)); pg8::gemm_phase<EpiInProj, SchedPlain, true>((LAS unsigned char*)lds, g2, Sc, E); } }
    SEAM(1);
    if (IN(2)) { FRESH_IDS(); const Args a = load_args(kp); unsigned char* ws = a.ws; phase_mix_a(a, lds, wg, G, lane, wave, tid); }
    SEAM(2);
    if (IN(3)) { FRESH_IDS(); const Args a = load_args(kp); unsigned char* ws = a.ws; for (int r = 0; r < a.rep[13]; ++r) { FRESH_IDS(); phase_scan(a, wg & 7, (wg >> 3) * NTHR + tid, (G >> 3) * NTHR); } }
    SEAM(3);
    if (IN(4)) { FRESH_IDS(); const Args a = load_args(kp); unsigned char* ws = a.ws; phase_mix_b(a, lds, wg, G, lane, wave, tid); }
    SEAM(4);
    { const Args a = load_args(kp); for (int r = 0; r < a.rep[14]; ++r) xcd_barrier(bar); for (int r = 0; r < a.rep[15]; ++r) cg::this_grid().sync(); }
    if (IN(5)) { FRESH_IDS(); const Args a = load_args(kp); unsigned char* ws = a.ws; pg8::Gemm g{(const bf16_t*)(ws + WS_XN), (const bf16_t*)(ws + WS_WOUT), D}; SchedPlain Sc; Sc.init(M, D, G, wg); Sc.rowbytes = D * 2;
        EpiOutProj E{a.in[IN_X], ws};
        for (int r = 0; r < a.rep[9]; ++r) { FRESH_IDS(); pg8::Gemm g2 = g; asm volatile("" : "+s"(g2.A), "+s"(g2.Bt)); pg8::gemm_phase<EpiOutProj, SchedPlain, true>((LAS unsigned char*)lds, g2, Sc, E); } }
    SEAM(5);
    if (IN(6)) { FRESH_IDS(); const Args a = load_args(kp); unsigned char* ws = a.ws; for (int r = 0; r < a.rep[4]; ++r) { FRESH_IDS(); phase_router(a, lds, wg & 7, (wg >> 3) * NWAVES + wave, (G >> 3) * NWAVES, lane, tid); } }
    SEAM(6);
    if (IN(7)) { FRESH_IDS(); const Args a = load_args(kp); unsigned char* ws = a.ws; for (int r = 0; r < a.rep[7]; ++r) { FRESH_IDS(); phase_topk(a, lds, wg, G, tid, lane, wave); } }
    SEAM(7);
    if (IN(8)) { FRESH_IDS(); const Args a = load_args(kp); unsigned char* ws = a.ws; pg8::Gemm g{(const bf16_t*)(ws + WS_XN), (const bf16_t*)(ws + WS_WGU), D}; SchedMoe1 Sc; Sc.init(MR, 4096, G, wg, WGM_MOE1); Sc.idxl = (const LAS int*)((LAS unsigned char*)lds + 131072);
        { const int* idxg = (const int*)(ws + WS_IDX); LAS int* il = (LAS int*)((LAS unsigned char*)lds + 131072); pg8::Unit uu;
          for (int i = 0; i < 16; ++i) if (Sc.next(i, uu) && tid < 256) il[i * 256 + tid] = idxg[uu.pm * 256 + tid];
          __syncthreads(); }
        EpiSwiGLU E{ws + WS_HID};
        for (int r = 0; r < a.rep[10]; ++r) { FRESH_IDS(); pg8::Gemm g2 = g; asm volatile("" : "+s"(g2.A), "+s"(g2.Bt)); pg8::gemm_phase<EpiSwiGLU, SchedMoe1, true, true>((LAS unsigned char*)lds, g2, Sc, E); } }
    SEAM(8);
    if (IN(9)) { FRESH_IDS(); const Args a = load_args(kp); unsigned char* ws = a.ws; pg8::Gemm g{(const bf16_t*)(ws + WS_HID), (const bf16_t*)(ws + WS_WD), DFF}; SchedMoe2 Sc; Sc.init(MR, D, G, wg, WGM_MOE2);
        EpiDown E{ws + WS_Y};
        for (int r = 0; r < a.rep[11]; ++r) { FRESH_IDS(); pg8::Gemm g2 = g; asm volatile("" : "+s"(g2.A), "+s"(g2.Bt)); pg8::gemm_phase<EpiDown, SchedMoe2, true, true>((LAS unsigned char*)lds, g2, Sc, E); } }
    SEAM(9);
    if (IN(10)) { FRESH_IDS(); const Args a = load_args(kp); unsigned char* ws = a.ws; for (int r = 0; r < a.rep[12]; ++r) { FRESH_IDS(); phase_final(a, gw, NGW, lane); } }
#undef IN
#undef SEAM
}

extern "C" void kernel_launch(void* const* d_in, const int* in_sizes, int n_in, void* d_out, int out_size, void* d_ws, size_t ws_size, hipStream_t stream) {
    static int grid = 0;
    if (grid == 0) {
        if (n_in != 13 || in_sizes[0] != M * D || out_size != M * D || ws_size < WS_END) { fprintf(stderr, "kernel_launch: unexpected shapes n_in %d in0 %d out %d ws %zu (need %zu)\n", n_in, n_in > 0 ? in_sizes[0] : -1, out_size, ws_size, (size_t)WS_END); grid = -1; return; }
        int dev = 0, cus = 0, per_cu = 0;
        (void)hipGetDevice(&dev); (void)hipDeviceGetAttribute(&cus, hipDeviceAttributeMultiprocessorCount, dev);
        (void)hipFuncSetAttribute((const void*)mega, hipFuncAttributeMaxDynamicSharedMemorySize, LDS_BYTES);
        if (hipOccupancyMaxActiveBlocksPerMultiprocessor(&per_cu, (const void*)mega, NTHR, LDS_BYTES) != hipSuccess || per_cu < 1) { fprintf(stderr, "kernel_launch: occupancy query says %d blocks/CU\n", per_cu); per_cu = 1; }
        (void)hipGetLastError();
        grid = cus * 1;
        if (grid > cus * per_cu) grid = cus * per_cu;
    }
    if (grid < 0) return;
    (void)hipMemsetAsync((char*)d_ws + WS_CTL + 16384, 0, 49152, stream);
    Args a{};
    for (int i = 0; i < 13; ++i) a.in[i] = (const float*)d_in[i];
    a.out = (float*)d_out; a.ws = (unsigned char*)d_ws;
#ifndef PROBE_R
#define PROBE_R {1, 1, 1, 1, 1, 1, 1, 1, 1, 1, 1, 1, 1, 1, 0, 0}
#endif
    { const int rr[16] = PROBE_R; for (int i = 0; i < 16; ++i) a.rep[i] = rr[i]; }
#if MK_LAUNCHES == 1
    a.ph_lo = 0; a.ph_hi = NPH;
    void* args[] = {&a};
    hipError_t e = hipLaunchCooperativeKernel((const void*)mega, dim3(grid), dim3(NTHR), args, LDS_BYTES, stream);
    if (e != hipSuccess) fprintf(stderr, "cooperative launch failed: %s (grid %d)\n", hipGetErrorString(e), grid);
#else
    for (int p = 0; p < NPH; ++p) { a.ph_lo = p; a.ph_hi = p + 1; hipLaunchKernelGGL(mega, dim3(grid), dim3(NTHR), LDS_BYTES, stream, a); }
#endif
}
```

```cpp
#include <hip/hip_runtime.h>
#include <hip/hip_cooperative_groups.h>
#include <cstdint>
#include <cstdio>
namespace cg = cooperative_groups;

typedef unsigned short bf16_t;
#define DEV __device__ __forceinline__
#define LAS __attribute__((address_space(3)))

constexpr int NB = 8, S = 4096, D = 1024, M = NB * S;
constexpr int NH = 8, HD = 64, PC = 3584;
constexpr int NE = 16, CAP = 512, DFF = 2048, MR = NE * NB * CAP;
constexpr float EPS = 1e-6f, LOG2E = 1.4426950408889634f;
constexpr int NWAVES = 8, NTHR = 512;
constexpr int LDS_BYTES = 163840;

constexpr size_t MiB = 1u << 20;
constexpr size_t WS_CTL = 0;
constexpr size_t WS_ROPE = 1 * MiB;
constexpr size_t WS_BIAS = 64 * 1024;
constexpr size_t WS_IDX = 128 * 1024;
constexpr size_t WS_AFF = 3 * MiB;
constexpr size_t WS_INV = 5 * MiB;
constexpr size_t WS_WOUT = 7 * MiB;
constexpr size_t WS_WIN = 9 * MiB;
constexpr size_t WS_XN = 16 * MiB;
constexpr size_t WS_RQ = 80 * MiB, WS_RK = 112 * MiB, WS_RV = 144 * MiB, WS_RG = 176 * MiB;
constexpr size_t WS_AQ = 208 * MiB, WS_AK = 240 * MiB, WS_AV = 272 * MiB;
constexpr size_t WS_ATTO = 304 * MiB;
constexpr size_t WS_ATTL0 = 528 * MiB, WS_ATTL1 = 529 * MiB, WS_ATTL2 = 2 * MiB;
constexpr size_t WS_KF = 400 * MiB;
constexpr size_t WS_WD = 432 * MiB;
constexpr size_t WS_WGU = 464 * MiB;
constexpr size_t WS_Y = 144 * MiB;
constexpr size_t WS_HID = 272 * MiB;
constexpr size_t WS_END = 530 * MiB;
DEV size_t x1_off(int row) { const int b = row >> 12, s = row & 4095; return (s < 2048 ? WS_RQ : WS_RK) + (size_t)b * 4 * MiB + (size_t)(s & 2047) * 2048; }
constexpr size_t WS_WIN8 = 13 * MiB;
DEV unsigned xn8_rel(int row) { const int b = row >> 12, s = row & 4095; return (unsigned)(s >> 11) * (unsigned)(16 * MiB) + (unsigned)b * (unsigned)(2 * MiB) + (unsigned)(s & 2047) * 1024u; }
constexpr size_t WS_RINV = 512 * 1024;
DEV unsigned mix_rel(int row) { const int b = row >> 12, s = row & 4095; return (unsigned)(s >> 11) * (unsigned)(32 * MiB) + (unsigned)b * (unsigned)(4 * MiB) + (unsigned)(s & 2047) * 2048u; }
DEV size_t afft_off(int b, int e) { return WS_AQ + (size_t)b * 4 * MiB + (size_t)e * S * 4; }
DEV size_t st_off(int dir, int bh, int n) { return WS_AQ + (size_t)(bh >> 3) * 4 * MiB + ((size_t)((dir * NH + (bh & 7)) * 32 + n)) * 4096; }

DEV unsigned f2bf(float f) { unsigned u = __float_as_uint(f); return (u + 0x7fffu + ((u >> 16) & 1u)) >> 16; }
DEV float bf2f(unsigned h) { return __uint_as_float(h << 16); }
DEV unsigned pk2(float lo, float hi) { return f2bf(lo) | (f2bf(hi) << 16); }
#define DPPF(x, ctrl) __builtin_bit_cast(float, __builtin_amdgcn_update_dpp(__builtin_bit_cast(int, (x)), __builtin_bit_cast(int, (x)), (ctrl), 0xF, 0xF, false))
DEV float lane_x1(float x) { return DPPF(x, 0xB1); }
DEV float lane_x2(float x) { return DPPF(x, 0x4E); }
DEV float lane_m8(float x) { return DPPF(x, 0x141); }
DEV float lane_x8(float x) { return DPPF(x, 0x128); }
DEV float lane_x16(float x) { const auto r = __builtin_amdgcn_permlane16_swap(__float_as_uint(x), __float_as_uint(x), false, false); return (threadIdx.x & 16) ? __uint_as_float(r[0]) : __uint_as_float(r[1]); }
DEV float lane_x32(float x) { const auto r = __builtin_amdgcn_permlane32_swap(__float_as_uint(x), __float_as_uint(x), false, false); return (threadIdx.x & 32) ? __uint_as_float(r[0]) : __uint_as_float(r[1]); }
DEV float wave_sum(float v) {
    v += lane_x1(v); v += lane_x2(v); v += lane_m8(v); v += lane_x8(v); v += lane_x16(v); v += lane_x32(v);
    return v;
}
#define LDS_WAIT() asm volatile("s_waitcnt lgkmcnt(0)" ::: "memory")
namespace pg8 {
#define PG8_LAS __attribute__((address_space(3)))
typedef short bf16x8 __attribute__((ext_vector_type(8)));
typedef float f32x4 __attribute__((ext_vector_type(4)));
typedef unsigned u32x4 __attribute__((ext_vector_type(4)));
constexpr int BM = 256, BK = 64, HALF = 128, HTB = HALF * BK * 2, STAGE_BYTES = 8 * HTB, NXCD = 8, WGM = 8;
__host__ __device__ __forceinline__ int lds_byte(int r, int c) { const int st = (r >> 4) * 2 + (c >> 5), rr = r & 15, cc = c & 31, ob = rr * 64 + cc * 2; return st * 1024 + (ob ^ (((ob >> 9) & 1) << 5)); }
__host__ __device__ __forceinline__ void stage_rc(int b, int& R, int& C) { const int st = b / 1024, sb = b % 1024, swz = sb ^ (((sb >> 9) & 1) << 5); R = (st >> 1) * 16 + swz / 64; C = (st & 1) * 32 + (swz % 64) / 2; }
__host__ __device__ __forceinline__ int perm32(int rho) { const int n = rho >> 4, i = rho & 15; return 8 * (i >> 2) + 4 * n + (i & 3); }
struct Unit { int pm, pn, ui; };
struct Gemm { const bf16_t* A; const bf16_t* Bt; int K; };
struct StaticOrder {
    int nM, nN, nwg, G, c, wgm;
    __device__ void init(int M_, int N_, int G_, int c_, int wgm_ = WGM) { nM = M_ / BM; nN = N_ / BM; nwg = nM * nN; G = G_; c = c_; wgm = wgm_; }
    __device__ bool next(int i, Unit& u) const {
        const long L = (long)i * G + c; if (L >= nwg) return false;
        int wgid = (int)L; { const int q = nwg / NXCD, r = nwg % NXCD, xcd = wgid % NXCD, off = wgid / NXCD; wgid = (xcd < r ? xcd * (q + 1) : r * (q + 1) + (xcd - r) * q) + off; }
        const int nig = wgm * nN, gid = wgid / nig, fm = gid * wgm, gsz = (nM - fm) < wgm ? (nM - fm) : wgm;
        u.pm = fm + ((wgid % nig) % gsz); u.pn = (wgid % nig) / gsz; return true;
    }
};
__device__ __forceinline__ unsigned cvt_pk_bf16(float lo, float hi) { unsigned r; asm volatile("v_cvt_pk_bf16_f32 %0, %1, %2" : "=v"(r) : "v"(lo), "v"(hi)); return r; }

typedef int v8i __attribute__((ext_vector_type(8)));
struct NoWait { __device__ __forceinline__ void operator()() const {} };
template <class Epi, class Sched, bool ALIGN_EPI, bool FP8 = false, class PreWait = NoWait>
__device__ __forceinline__ void gemm_phase(PG8_LAS unsigned char* lds, const Gemm g, const Sched& S, const Epi& E, const PreWait& pw = PreWait()) {
    const int tid = threadIdx.x, wid = __builtin_amdgcn_readfirstlane(tid >> 6), lane = tid & 63, wr = wid >> 2, wc = wid & 3, fr = lane & 15, fq = lane >> 4;
    const int K = g.K, RB = FP8 ? K : 2 * K, nt = RB / 128;
    unsigned voffB;
    { int R, C; stage_rc(tid * 16, R, C); const int Rb = Epi::PERM ? ((R & ~31) + perm32(R & 31)) : R; voffB = (unsigned)(Rb * RB + C * 2); }
    const size_t kstep = (size_t)(BK * 2);
    const size_t hstep = (size_t)HALF * RB;
    const size_t tstep = 2 * hstep;
    const unsigned ldsw = (unsigned)wid * 1024u;
    const int aoff = FP8 ? lds_byte(wr * 64 + fr, fq * 16) : lds_byte(wr * 64 + fr, fq * 8), boff = FP8 ? lds_byte(wc * 32 + fr, fq * 16) : lds_byte(wc * 32 + fr, fq * 8);
    const int x16 = 16 * (fq & 1);
    const char* gA = (const char*)g.A;
#define PG8_SA(b, h) (((b) * 2 + (h)) * HTB)
#define PG8_SB(b, h) ((4 + (b) * 2 + (h)) * HTB)
#define PG8_STAGE(bufoff, gbase, voff) do { _Pragma("unroll") for (int _i = 0; _i < 2; ++_i) \
        __builtin_amdgcn_global_load_lds((const unsigned*)((const char*)(gbase) + (size_t)_i * 64 * RB + (voff)), (PG8_LAS unsigned*)(lds + (bufoff) + ldsw + _i * 8192), 16, 0, 0); } while (0)
#define PG8_STAGE_A(bufoff, AO, h, kb) do { _Pragma("unroll") for (int _i = 0; _i < 2; ++_i) \
        __builtin_amdgcn_global_load_lds((const unsigned*)(gA + (size_t)((AO)[h][_i] + (unsigned)(kb))), (PG8_LAS unsigned*)(lds + (bufoff) + ldsw + _i * 8192), 16, 0, 0); } while (0)
#define PG8_LDA(dst, b, h) do { if constexpr (FP8) { _Pragma("unroll") for (int m = 0; m < 4; ++m) { dst[m][0] = *(const PG8_LAS bf16x8*)(lds + PG8_SA(b, h) + aoff + m * 2048 + x16); dst[m][1] = *(const PG8_LAS bf16x8*)(lds + PG8_SA(b, h) + aoff + m * 2048 + 16 - x16); } } \
    else { _Pragma("unroll") for (int m = 0; m < 4; ++m) _Pragma("unroll") for (int k = 0; k < 2; ++k) dst[m][k] = *(const PG8_LAS bf16x8*)(lds + PG8_SA(b, h) + aoff + m * 2048 + k * 1024); } } while (0)
#define PG8_LDB(dst, b, h) do { if constexpr (FP8) { _Pragma("unroll") for (int n = 0; n < 2; ++n) { dst[n][0] = *(const PG8_LAS bf16x8*)(lds + PG8_SB(b, h) + boff + n * 2048 + x16); dst[n][1] = *(const PG8_LAS bf16x8*)(lds + PG8_SB(b, h) + boff + n * 2048 + 16 - x16); } } \
    else { _Pragma("unroll") for (int n = 0; n < 2; ++n) _Pragma("unroll") for (int k = 0; k < 2; ++k) dst[n][k] = *(const PG8_LAS bf16x8*)(lds + PG8_SB(b, h) + boff + n * 2048 + k * 1024); } } while (0)
#define PG8_CAT8(x) __builtin_bit_cast(v8i, __builtin_shufflevector((x)[0], (x)[1], 0, 1, 2, 3, 4, 5, 6, 7, 8, 9, 10, 11, 12, 13, 14, 15))
#define PG8_MMA(ai, bj, At, Bt) do { __builtin_amdgcn_s_setprio(1); if constexpr (FP8) { _Pragma("unroll") for (int m = 0; m < 4; ++m) _Pragma("unroll") for (int n = 0; n < 2; ++n) \
        acc[ai][bj][m][n] = __builtin_amdgcn_mfma_scale_f32_16x16x128_f8f6f4(PG8_CAT8(Bt[n]), PG8_CAT8(At[m]), acc[ai][bj][m][n], 0, 0, 0, 0, 0, 0); } \
    else { _Pragma("unroll") for (int m = 0; m < 4; ++m) _Pragma("unroll") for (int n = 0; n < 2; ++n) _Pragma("unroll") for (int k = 0; k < 2; ++k) \
        acc[ai][bj][m][n] = __builtin_amdgcn_mfma_f32_16x16x32_bf16(Bt[n][k], At[m][k], acc[ai][bj][m][n], 0, 0, 0); } __builtin_amdgcn_s_setprio(0); } while (0)
#define PG8_WAIT_V(n) asm volatile("s_waitcnt vmcnt(" #n ")" ::: "memory")
#define PG8_WAIT_L(n) asm volatile("s_waitcnt lgkmcnt(" #n ")" ::: "memory")
#define PG8_BAR __builtin_amdgcn_s_barrier()
#define PG8_SCHED __builtin_amdgcn_sched_barrier(0)
#define PG8_AOFFS(AO, u) do { int _t = threadIdx.x; asm volatile("" : "+v"(_t)); _Pragma("unroll") for (int _i = 0; _i < 2; ++_i) { int _R, _C; stage_rc(_t * 16 + _i * 8192, _R, _C); \
        _Pragma("unroll") for (int _h = 0; _h < 2; ++_h) (AO)[_h][_i] = S.row_off(u, _h * HALF + _R) + (unsigned)(_C * 2); } } while (0)
    Unit cur, nxt; int ui = 0;
    if (!S.next(0, cur)) { pw(); return; }
    f32x4 acc[2][2][4][2];
#pragma unroll
    for (int a = 0; a < 2; ++a)
#pragma unroll
        for (int b = 0; b < 2; ++b)
#pragma unroll
            for (int m = 0; m < 4; ++m)
#pragma unroll
                for (int n = 0; n < 2; ++n) acc[a][b][m][n] = (f32x4){0.f, 0.f, 0.f, 0.f};
    bf16x8 At[4][2], B0[2][2], B1[2][2];
    unsigned aoc[2][2];
    const char* cB = (const char*)g.Bt + (size_t)cur.pn * tstep;
    PG8_STAGE(PG8_SB(0, 0), cB, voffB); PG8_STAGE(PG8_SB(0, 1), cB + hstep, voffB); pw(); PG8_AOFFS(aoc, cur); PG8_STAGE_A(PG8_SA(0, 0), aoc, 0, 0); PG8_STAGE_A(PG8_SA(0, 1), aoc, 1, 0);
    if (wr == 1) PG8_BAR;
    PG8_WAIT_V(2); PG8_BAR;
    PG8_STAGE(PG8_SB(1, 0), cB + kstep, voffB); PG8_STAGE_A(PG8_SA(1, 0), aoc, 0, 128); PG8_STAGE(PG8_SB(1, 1), cB + hstep + kstep, voffB);
    PG8_WAIT_V(6); PG8_BAR;
    for (;;) {
        const bool has_next = S.next(ui + 1, nxt);
        const char* nB = cB;
        if (has_next) nB = (const char*)g.Bt + (size_t)nxt.pn * tstep;
#pragma nounroll
        for (int t = 0; t < nt; t += 2) {
            const bool last = (t == nt - 2);
            const unsigned k1 = (unsigned)(t + 1) * 128u, k2 = last ? 0u : (unsigned)(t + 2) * 128u, k3 = k2 + 128u;
            const char* b2 = last ? nB : cB + (size_t)(t + 2) * kstep; const char* b3 = b2 + kstep;
            PG8_LDB(B0, 0, 0); PG8_LDB(B1, 0, 1); PG8_SCHED; PG8_LDA(At, 0, 0); PG8_STAGE_A(PG8_SA(1, 1), aoc, 1, k1);
            PG8_WAIT_V(8); PG8_WAIT_L(0); PG8_BAR; PG8_MMA(0, 0, At, B0); PG8_MMA(0, 1, At, B1); PG8_BAR; PG8_SCHED;
            if (last && has_next) { PG8_AOFFS(aoc, nxt); }
            PG8_LDA(At, 0, 1); PG8_STAGE(PG8_SB(0, 0), b2, voffB); PG8_STAGE(PG8_SB(0, 1), b2 + hstep, voffB); PG8_STAGE_A(PG8_SA(0, 0), aoc, 0, k2);
            PG8_WAIT_V(8); PG8_WAIT_L(0); PG8_BAR; PG8_MMA(1, 0, At, B0); PG8_MMA(1, 1, At, B1); PG8_BAR; PG8_SCHED;
            PG8_LDB(B0, 1, 0); PG8_LDB(B1, 1, 1); PG8_SCHED; PG8_LDA(At, 1, 0); PG8_STAGE_A(PG8_SA(0, 1), aoc, 1, k2);
            PG8_WAIT_V(8); PG8_WAIT_L(0); PG8_BAR; PG8_MMA(0, 0, At, B0); PG8_MMA(0, 1, At, B1); PG8_BAR; PG8_SCHED;
            PG8_LDA(At, 1, 1); PG8_STAGE(PG8_SB(1, 0), b3, voffB); PG8_STAGE(PG8_SB(1, 1), b3 + hstep, voffB); PG8_STAGE_A(PG8_SA(1, 0), aoc, 0, k3);
            PG8_WAIT_V(8); PG8_WAIT_L(0); PG8_BAR; PG8_MMA(1, 0, At, B0); PG8_MMA(1, 1, At, B1); PG8_BAR; PG8_SCHED;
        }
        if constexpr (ALIGN_EPI) { if (wr == 0) PG8_BAR; }
        { int t2 = threadIdx.x; asm volatile("" : "+v"(t2));
          const int w2 = __builtin_amdgcn_readfirstlane(t2 >> 6), l2 = t2 & 63; E(acc, cur, w2 >> 2, w2 & 3, l2 & 15, l2 >> 4); }
        if (!has_next) break;
#pragma unroll
        for (int a = 0; a < 2; ++a)
#pragma unroll
            for (int b = 0; b < 2; ++b)
#pragma unroll
                for (int m = 0; m < 4; ++m)
#pragma unroll
                    for (int n = 0; n < 2; ++n) acc[a][b][m][n] = (f32x4){0.f, 0.f, 0.f, 0.f};
        cur = nxt; cB = nB; ++ui;
        if constexpr (ALIGN_EPI) { if (wr == 1) PG8_BAR; }
    }
    PG8_WAIT_V(0);
    if constexpr (!ALIGN_EPI) { if (wr == 0) PG8_BAR; }
    PG8_BAR;
#undef PG8_SA
#undef PG8_SB
#undef PG8_STAGE
#undef PG8_STAGE_A
#undef PG8_LDA
#undef PG8_LDB
#undef PG8_MMA
#undef PG8_CAT8
#undef PG8_WAIT_V
#undef PG8_WAIT_L
#undef PG8_BAR
#undef PG8_SCHED
#undef PG8_AOFFS
}
}
struct SchedPlain : pg8::StaticOrder {
    unsigned rowbytes;
    DEV unsigned row_off(const pg8::Unit& u, int r) const { return (unsigned)(u.pm * 256 + r) * rowbytes; }
};
#ifndef CONV1_TILES
#define CONV1_TILES 13824
#endif
#ifndef P1_GW
#define P1_GW 25
#endif
#ifndef P1_UNITS
#define P1_UNITS 9
#endif
struct SchedInProj : pg8::StaticOrder {
    int upg, ncol, pn0, gw, rev, f8;
    DEV bool next(int i, pg8::Unit& u) const {
        const int ci = c >> 3; if (ci >= gw) return false;
        const int L = i * gw + (rev ? gw - 1 - ci : ci); if (L >= upg) return false;
        const int wgid = (c & 7) * upg + L, nig = wgm * ncol, gid = wgid / nig;
        u.pm = gid * wgm + ((wgid % nig) % wgm); u.pn = pn0 + (wgid % nig) / wgm; return true; }
    DEV unsigned row_off(const pg8::Unit& u, int r) const { return f8 ? xn8_rel(u.pm * 256 + r) : (unsigned)(u.pm * 256 + r) * (unsigned)(D * 2); }
};
struct SchedMix : pg8::StaticOrder {
    DEV unsigned row_off(const pg8::Unit& u, int r) const { return mix_rel(u.pm * 256 + r); }
};
struct SchedMoe1 : pg8::StaticOrder {
    const LAS int* idxl;
    DEV bool next(int i, pg8::Unit& u) const { if (!pg8::StaticOrder::next(i, u)) return false; u.pn += (u.pm >> 4) * 16; u.ui = i; return true; }
    DEV unsigned row_off(const pg8::Unit& u, int r) const { const int g = u.pm * 256 + r; const int tok = ((g >> 9) & 7) * S + idxl[u.ui * 256 + r]; return (unsigned)tok * 2048u; }
};
struct SchedMoe2 : pg8::StaticOrder {
    DEV bool next(int i, pg8::Unit& u) const { if (!pg8::StaticOrder::next(i, u)) return false; u.pn += (u.pm >> 4) * 4; return true; }
    DEV unsigned row_off(const pg8::Unit& u, int r) const { return (unsigned)(u.pm * 256 + r) * (unsigned)DFF; }
};
typedef pg8::f32x4 f32x4; typedef pg8::u32x4 u32x4;
struct EpiInProj {
    static constexpr bool PERM = true;
    unsigned char* ws; const float* ropeT; float asc;
    DEV void operator()(const f32x4 (&acc)[2][2][4][2], const pg8::Unit& u, int wr, int wc, int fr, int fq) const {
        const int grp = u.pn >> 1;
        bf16_t* gbase = (bf16_t*)(ws + WS_RQ + (size_t)grp * 32 * MiB);
        const int j0 = 32 * (wc & 1) + 8 * fq;
        if (grp < 2) {
            const float sc = grp == 1 ? 0.125f : 1.f;
            f32x4 cs[2][4], sn[2][4];
#pragma unroll
            for (int ai = 0; ai < 2; ++ai)
#pragma unroll
                for (int m = 0; m < 4; ++m) { const int s = (u.pm * 256 + ai * 128 + wr * 64 + m * 16 + fr) & 4095;
                    cs[ai][m] = *(const f32x4*)(ropeT + s * 32 + (j0 >> 1)); sn[ai][m] = *(const f32x4*)(ropeT + S * 32 + s * 32 + (j0 >> 1)); }
#pragma unroll
            for (int ai = 0; ai < 2; ++ai)
#pragma unroll
                for (int m = 0; m < 4; ++m) {
                    const int row = u.pm * 256 + ai * 128 + wr * 64 + m * 16 + fr, b = row >> 12, s = row & 4095;
#pragma unroll
                    for (int bj = 0; bj < 2; ++bj) {
                        const int hd = 4 * (u.pn & 1) + 2 * bj + (wc >> 1);
                        const f32x4 lo = (acc[ai][bj][m][0] * cs[ai][m] - acc[ai][bj][m][1] * sn[ai][m]) * sc, hi = (acc[ai][bj][m][1] * cs[ai][m] + acc[ai][bj][m][0] * sn[ai][m]) * sc;
                        u32x4 w; w.x = pg8::cvt_pk_bf16(lo[0], lo[1]); w.y = pg8::cvt_pk_bf16(lo[2], lo[3]); w.z = pg8::cvt_pk_bf16(hi[0], hi[1]); w.w = pg8::cvt_pk_bf16(hi[2], hi[3]);
                        *(u32x4*)(gbase + ((size_t)(b * NH + hd) * S + s) * HD + j0) = w;
                    }
                }
        } else {
            const float sc = (grp == 4 ? 0.125f * LOG2E : 1.f) * asc;
#pragma unroll
            for (int ai = 0; ai < 2; ++ai)
#pragma unroll
                for (int m = 0; m < 4; ++m) {
                    const int row = u.pm * 256 + ai * 128 + wr * 64 + m * 16 + fr, b = row >> 12, s = row & 4095;
#pragma unroll
                    for (int bj = 0; bj < 2; ++bj) {
                        const int hd = 4 * (u.pn & 1) + 2 * bj + (wc >> 1);
                        const f32x4 lo = acc[ai][bj][m][0] * sc, hi = acc[ai][bj][m][1] * sc;
                        u32x4 w; w.x = pg8::cvt_pk_bf16(lo[0], lo[1]); w.y = pg8::cvt_pk_bf16(lo[2], lo[3]); w.z = pg8::cvt_pk_bf16(hi[0], hi[1]); w.w = pg8::cvt_pk_bf16(hi[2], hi[3]);
                        *(u32x4*)(gbase + ((size_t)(b * NH + hd) * S + s) * HD + j0) = w;
                    }
                }
        }
    }
};
struct EpiOutProj {
    static constexpr bool PERM = true;
    const float* g1; unsigned char* ws;
    DEV void operator()(const f32x4 (&acc)[2][2][4][2], const pg8::Unit& u, int wr, int wc, int fr, int fq) const {
        const bf16_t* xn = (const bf16_t*)(ws + WS_XN); const float* rinv = (const float*)(ws + WS_RINV);
        f32x4 gi[2][2];
#pragma unroll
        for (int bj = 0; bj < 2; ++bj) { const float* gp = g1 + u.pn * 256 + bj * 128 + wc * 32 + 8 * fq; const f32x4 ga = *(const f32x4*)gp, gb = *(const f32x4*)(gp + 4);
#pragma unroll
            for (int i = 0; i < 4; ++i) { gi[bj][0][i] = __builtin_amdgcn_rcpf(ga[i]); gi[bj][1][i] = __builtin_amdgcn_rcpf(gb[i]); } }
#pragma unroll
        for (int ai = 0; ai < 2; ++ai) {
            u32x4 xa[4][2]; float ri[4];
#pragma unroll
            for (int m = 0; m < 4; ++m) { const int row = u.pm * 256 + ai * 128 + wr * 64 + m * 16 + fr; ri[m] = rinv[row];
#pragma unroll
                for (int bj = 0; bj < 2; ++bj) xa[m][bj] = *(const u32x4*)(xn + (size_t)row * D + u.pn * 256 + bj * 128 + wc * 32 + 8 * fq); }
#pragma unroll
            for (int m = 0; m < 4; ++m) {
                const int row = u.pm * 256 + ai * 128 + wr * 64 + m * 16 + fr;
                bf16_t* x1r = (bf16_t*)(ws + x1_off(row));
#pragma unroll
                for (int bj = 0; bj < 2; ++bj) { const int col = u.pn * 256 + bj * 128 + wc * 32 + 8 * fq;
                    const f32x4 xlo = {bf2f(xa[m][bj].x & 0xffffu), bf2f(xa[m][bj].x >> 16), bf2f(xa[m][bj].y & 0xffffu), bf2f(xa[m][bj].y >> 16)}, xhi = {bf2f(xa[m][bj].z & 0xffffu), bf2f(xa[m][bj].z >> 16), bf2f(xa[m][bj].w & 0xffffu), bf2f(xa[m][bj].w >> 16)};
                    const f32x4 lo = xlo * (gi[bj][0] * ri[m]) + acc[ai][bj][m][0], hi = xhi * (gi[bj][1] * ri[m]) + acc[ai][bj][m][1];
                    u32x4 w; w.x = pg8::cvt_pk_bf16(lo[0], lo[1]); w.y = pg8::cvt_pk_bf16(lo[2], lo[3]); w.z = pg8::cvt_pk_bf16(hi[0], hi[1]); w.w = pg8::cvt_pk_bf16(hi[2], hi[3]);
                    *(u32x4*)(x1r + col) = w; }
            }
        }
    }
};
DEV unsigned pk4_fp8e(float a, float b, float c, float d) { unsigned w = 0u; w = __builtin_amdgcn_cvt_pk_fp8_f32(a, b, w, false); w = __builtin_amdgcn_cvt_pk_fp8_f32(c, d, w, true); return w; }
struct EpiSwiGLU {
    static constexpr bool PERM = true;
    unsigned char* hid;
    DEV void operator()(const f32x4 (&acc)[2][2][4][2], const pg8::Unit& u, int wr, int wc, int fr, int fq) const {
        const int pnl = u.pn & 15;
#pragma unroll
        for (int ai = 0; ai < 2; ++ai)
#pragma unroll
            for (int m = 0; m < 4; ++m) {
                const int row = u.pm * 256 + ai * 128 + wr * 64 + m * 16 + fr;
                f32x4 o2[2];
#pragma unroll
                for (int n = 0; n < 2; ++n) { const f32x4 ga = acc[ai][0][m][n], ua = acc[ai][1][m][n];
                    const f32x4 t = ga * (-LOG2E / 32.f); f32x4 e;
#pragma unroll
                    for (int i = 0; i < 4; ++i) e[i] = __builtin_amdgcn_exp2f(t[i]);
                    const f32x4 d = e * 1024.f + 1024.f; f32x4 r;
#pragma unroll
                    for (int i = 0; i < 4; ++i) r[i] = __builtin_amdgcn_rcpf(d[i]);
                    o2[n] = (ga * ua) * r; }
                const float o[8] = {o2[0][0], o2[0][1], o2[0][2], o2[0][3], o2[1][0], o2[1][1], o2[1][2], o2[1][3]};
                *(uint2*)(hid + (size_t)row * DFF + pnl * 128 + wc * 32 + 8 * fq) = make_uint2(pk4_fp8e(o[0], o[1], o[2], o[3]), pk4_fp8e(o[4], o[5], o[6], o[7]));
            }
    }
};
struct EpiDown {
    static constexpr bool PERM = true;
    unsigned char* y;
    DEV void operator()(const f32x4 (&acc)[2][2][4][2], const pg8::Unit& u, int wr, int wc, int fr, int fq) const {
        const int pnl = u.pn & 3;
#pragma unroll
        for (int ai = 0; ai < 2; ++ai)
#pragma unroll
            for (int m = 0; m < 4; ++m) {
                const int row = u.pm * 256 + ai * 128 + wr * 64 + m * 16 + fr;
#pragma unroll
                for (int bj = 0; bj < 2; ++bj) { const f32x4 lo = acc[ai][bj][m][0] * (1.f / 32.f), hi = acc[ai][bj][m][1] * (1.f / 32.f);
                    *(uint2*)(y + (size_t)row * D + pnl * 256 + bj * 128 + wc * 32 + 8 * fq) = make_uint2(pk4_fp8e(lo[0], lo[1], lo[2], lo[3]), pk4_fp8e(hi[0], hi[1], hi[2], hi[3])); }
            }
    }
};
struct Args { const float* in[13]; float* out; unsigned char* ws; int ph_lo, ph_hi; int rep[16]; };
enum { IN_X = 0, IN_G1, IN_WIN, IN_DECAY, IN_GN, IN_RELB, IN_WOUT, IN_G2, IN_WR, IN_WG, IN_WU, IN_WDN, IN_FG };

struct TrItem { const float* src; bf16_t* dst; int K, N, k0, n0, mode, fp8; };
DEV unsigned pk4_fp8(float a, float b, float c, float d) { unsigned w = 0u; w = __builtin_amdgcn_cvt_pk_fp8_f32(a, b, w, false); w = __builtin_amdgcn_cvt_pk_fp8_f32(c, d, w, true); return w; }
DEV void tr_load(const TrItem& t, f32x4 (&v)[16], int lane) {
#pragma unroll
    for (int i = 0; i < 16; ++i) { const int kk = (lane >> 4) + 4 * i, c = (lane & 15) * 4; v[i] = __builtin_nontemporal_load((const f32x4*)(t.src + (size_t)(t.k0 + kk) * t.N + t.n0 + c)); }
}
DEV int rowmap_rt(int mode, int n) {
    if (mode == 0) return n;
    if (mode == 1) { if (n >= 1024) return n; const int base = n & ~63, d = n & 63, nn = d >> 5, dd = d & 31; return base + 8 * (dd >> 2) + 4 * nn + (dd & 3); }
    return (n >> 7) * 256 + (mode == 3 ? 128 : 0) + (n & 127);
}
DEV void tr_finish(const TrItem& t, const f32x4 (&v)[16], LAS float* scr, int lane) {
#pragma unroll
    for (int i = 0; i < 16; ++i) { const int kk = (lane >> 4) + 4 * i, c = (lane & 15) * 4;
        scr[kk * 65 + c] = v[i][0]; scr[kk * 65 + c + 1] = v[i][1]; scr[kk * 65 + c + 2] = v[i][2]; scr[kk * 65 + c + 3] = v[i][3]; }
    LDS_WAIT();
#pragma unroll
    for (int i = 0; i < 8; ++i) { const int n = (lane >> 3) + 8 * i, c = (lane & 7) * 8; const LAS float* sp = scr + c * 65 + n;
        if (t.fp8) {
            const unsigned lo = pk4_fp8(sp[0] * 32.f, sp[65] * 32.f, sp[2 * 65] * 32.f, sp[3 * 65] * 32.f), hi = pk4_fp8(sp[4 * 65] * 32.f, sp[5 * 65] * 32.f, sp[6 * 65] * 32.f, sp[7 * 65] * 32.f);
            *(uint2*)((unsigned char*)t.dst + (size_t)rowmap_rt(t.mode, t.n0 + n) * t.K + t.k0 + c) = make_uint2(lo, hi);
        } else {
        u32x4 o; o.x = pk2(sp[0], sp[65]); o.y = pk2(sp[2 * 65], sp[3 * 65]); o.z = pk2(sp[4 * 65], sp[5 * 65]); o.w = pk2(sp[6 * 65], sp[7 * 65]);
        *(u32x4*)(t.dst + (size_t)rowmap_rt(t.mode, t.n0 + n) * t.K + t.k0 + c) = o; } }
    LDS_WAIT();
}
template <class Dec> DEV void tr_run(const Dec& dec, int nitems, int gw, int NGW, LAS float* scr, int lane) {
    for (int it = gw; it < nitems; it += NGW) { TrItem cur; f32x4 va[16]; dec(it, cur); tr_load(cur, va, lane); tr_finish(cur, va, scr, lane); }
}
template <class Dec> DEV void tr_run2(const Dec& dec, int nitems, int gw, int NGW, LAS float* scr, int lane) {
    int it = gw; if (it >= nitems) return;
    TrItem cur, nxt; f32x4 va[16], vb[16];
    dec(it, cur); tr_load(cur, va, lane);
    for (;;) {
        const int n1 = it + NGW; const bool h1 = n1 < nitems;
        if (h1) { dec(n1, nxt); tr_load(nxt, vb, lane); }
        tr_finish(cur, va, scr, lane);
        if (!h1) break;
        const int n2 = n1 + NGW; const bool h2 = n2 < nitems;
        if (h2) { dec(n2, cur); tr_load(cur, va, lane); }
        tr_finish(nxt, vb, scr, lane);
        if (!h2) break;
        it = n2;
    }
}
DEV void rms_row_to_bf16(const float* xrow, const float* g, bf16_t* orow, int lane) {
    const float4* xr = (const float4*)xrow + lane;
    float4 v[4]; float s = 0.f;
#pragma unroll
    for (int j = 0; j < 4; ++j) { v[j] = xr[64 * j]; s += v[j].x * v[j].x + v[j].y * v[j].y + v[j].z * v[j].z + v[j].w * v[j].w; }
    const float rs = rsqrtf(wave_sum(s) * (1.f / D) + EPS);
    uint2* o = (uint2*)orow + lane;
#pragma unroll
    for (int j = 0; j < 4; ++j) { const float4 gg = ((const float4*)g)[lane + 64 * j];
        o[64 * j] = make_uint2(pk2(v[j].x * rs * gg.x, v[j].y * rs * gg.y), pk2(v[j].z * rs * gg.z, v[j].w * rs * gg.w)); }
}
DEV void phase_prep(const Args& a, unsigned char* lds, int gw, int NGW, int lane, int wave) {
    unsigned char* ws = a.ws;
    float* ropeT = (float*)(ws + WS_ROPE); float* biasT = (float*)(ws + WS_BIAS);
    const float* x = a.in[IN_X]; const float* g = a.in[IN_G1];
    float4 va[4], vb[4], vc[4], gq[4];
#pragma unroll
    for (int j = 0; j < 4; ++j) gq[j] = ((const float4*)g)[lane + 64 * j];
    { const float4* xr = (const float4*)(x + (size_t)gw * D) + lane;
#pragma unroll
      for (int j = 0; j < 4; ++j) va[j] = xr[64 * j];
      if (gw + NGW < M) { const float4* xs = (const float4*)(x + (size_t)(gw + NGW) * D) + lane;
#pragma unroll
        for (int j = 0; j < 4; ++j) vb[j] = xs[64 * j]; } }
    for (int t = gw * 64 + lane; t < S * 32; t += NGW * 64) {
        const int pos = t >> 5, i = t & 31; const double inv = pow(10000.0, -(double)i / 32.0), ang = (double)pos * inv;
        ropeT[t] = (float)cos(ang); ropeT[S * 32 + t] = (float)sin(ang);
        if (t < 3 * NH * 129) { const int p = t / (NH * 129), h = (t / 129) % NH, o = t % 129 - 64, dil = p == 0 ? 1 : (p == 1 ? 4 : 16), rel = o * dil, n = rel < 0 ? -rel : rel;
            int bucket = rel > 0 ? 16 : 0;
            if (n < 8) bucket += n; else { int large = 8 + (int)(log((double)n / 8.0) / log(128.0) * 8.0); if (large > 15) large = 15; bucket += large; }
            biasT[t] = a.in[IN_RELB][bucket * NH + h] * LOG2E; }
    }
    LAS float* scr = (LAS float*)((LAS unsigned char*)lds + wave * 16640);
    constexpr int I_IN = (D / 64) * (PC / 64), I_OUT = (D / 64) * (D / 64);
    { const float* w_in = a.in[IN_WIN]; const float* w_out = a.in[IN_WOUT]; bf16_t* Win = (bf16_t*)(ws + WS_WIN); bf16_t* Wout = (bf16_t*)(ws + WS_WOUT);
      auto dec = [=](int it, TrItem& t) { if (it < I_IN) { t.src = w_in; t.dst = Win; t.K = D; t.N = PC; t.k0 = (it / (PC / 64)) * 64; t.n0 = (it % (PC / 64)) * 64; t.mode = 1; t.fp8 = 0;
              if (t.n0 >= 2048) { t.dst = (bf16_t*)(ws + WS_WIN8 - (size_t)2048 * D); t.mode = 0; t.fp8 = 1; } }
          else { const int r = it - I_IN; t.src = w_out; t.dst = Wout; t.K = D; t.N = D; t.k0 = (r / (D / 64)) * 64; t.n0 = (r % (D / 64)) * 64; t.mode = 0; t.fp8 = 0; } };
      tr_run(dec, I_IN + I_OUT, gw, NGW, scr, lane); }
    {
      bf16_t* XN = (bf16_t*)(ws + WS_XN);
      for (int m = gw; m < M; m += NGW) {
          if (m + 2 * NGW < M) { const float4* xr = (const float4*)(x + (size_t)(m + 2 * NGW) * D) + lane;
#pragma unroll
              for (int j = 0; j < 4; ++j) vc[j] = xr[64 * j]; }
          float s = 0.f;
#pragma unroll
          for (int j = 0; j < 4; ++j) s += va[j].x * va[j].x + va[j].y * va[j].y + va[j].z * va[j].z + va[j].w * va[j].w;
          const float ms = wave_sum(s) * (1.f / D) + EPS, rs = rsqrtf(ms);
          if (lane == 0) ((float*)(ws + WS_RINV))[m] = sqrtf(ms);
          uint2* o = (uint2*)(XN + (size_t)m * D) + lane;
          unsigned* o8 = (unsigned*)(ws + WS_ATTO + xn8_rel(m)) + lane;
#pragma unroll
          for (int j = 0; j < 4; ++j) { const float4 gg = gq[j];
              o[64 * j] = make_uint2(pk2(va[j].x * rs * gg.x, va[j].y * rs * gg.y), pk2(va[j].z * rs * gg.z, va[j].w * rs * gg.w));
              o8[64 * j] = pk4_fp8(va[j].x * rs * gg.x, va[j].y * rs * gg.y, va[j].z * rs * gg.z, va[j].w * rs * gg.w); }
#pragma unroll
          for (int j = 0; j < 4; ++j) { va[j] = vb[j]; vb[j] = vc[j]; }
      } }
}
constexpr int CONV_TILES = 3 * NE * (D / 64) * (DFF / 64);
DEV void conv_item(const Args& a, int it, TrItem& t) {
    constexpr int I_G = (D / 64) * (DFF / 64);
    unsigned char* ws = a.ws; const int which = it / (NE * I_G), r = it % (NE * I_G), e = r / I_G, q = r % I_G;
    t.fp8 = 1;
    if (which < 2) { t.src = (which == 0 ? a.in[IN_WG] : a.in[IN_WU]) + (size_t)e * D * DFF; t.dst = (bf16_t*)(ws + WS_WGU + (size_t)e * 4096 * D); t.K = D; t.N = DFF; t.n0 = (q / (D / 64)) * 64; t.k0 = (q % (D / 64)) * 64; t.mode = 2 + which; }
    else { t.src = a.in[IN_WDN] + (size_t)e * DFF * D; t.dst = (bf16_t*)(ws + WS_WD + (size_t)e * D * DFF); t.K = DFF; t.N = D; t.n0 = (q / (DFF / 64)) * 64; t.k0 = (q % (DFF / 64)) * 64; t.mode = 0; }
}
DEV void phase_latew(const Args& a, unsigned char* lds, int wg, int G, int lane, int wave, LAS unsigned* ctr, int t1) {
    LAS float* scr = (LAS float*)((LAS unsigned char*)lds + wave * 16640);
    const int per = (CONV_TILES - t1) / G;
    for (;;) {
        unsigned j = 0; if (lane == 0) j = atomicAdd((unsigned*)ctr, 1u);
        j = (unsigned)__builtin_amdgcn_readfirstlane((int)j); if ((int)j >= per) break;
        const int it = t1 + wg * 2 + (int)(j & 1u) + (int)(j >> 1) * (2 * G);
        TrItem t; conv_item(a, it, t);
        f32x4 va[16]; tr_load(t, va, lane); tr_finish(t, va, scr, lane);
    }
}
DEV void phase_conv1(const Args& a, unsigned char* lds, int cw, int ncw, int lane, int wave, int t1) {
    LAS float* scr = (LAS float*)((LAS unsigned char*)lds + wave * 16640);
    int p = cw; if (2 * p >= t1) return;
    TrItem ta, tb; f32x4 va[16], vb[16];
    conv_item(a, 2 * p, ta); tr_load(ta, va, lane);
    for (;;) {
        conv_item(a, 2 * p + 1, tb); tr_load(tb, vb, lane);
        tr_finish(ta, va, scr, lane);
        p += ncw; const bool more = 2 * p < t1;
        if (more) { conv_item(a, 2 * p, ta); tr_load(ta, va, lane); }
        tr_finish(tb, vb, scr, lane);
        if (!more) break;
    }
}
constexpr int RT_WROW = 2080, RT_LO = 16 * RT_WROW, RT_G2 = 2 * RT_LO;
DEV void phase_router(const Args& a, unsigned char* lds, int xg, int gwl, int NGW, int lane, int tid) {
    unsigned char* ws = a.ws; const float* g2 = a.in[IN_G2]; const float* wr = a.in[IN_WR];
    unsigned char* H2q = ws + WS_XN; float* aff = (float*)(ws + WS_AFF); int* inv = (int*)(ws + WS_INV);
    LAS unsigned char* L = (LAS unsigned char*)lds;
    const int r = lane & 15, g = lane >> 4;
    pg8::bf16x8 xa[32]; int tile = gwl;
    if (tile < S / 16) { const unsigned char* xrow = ws + x1_off(xg * S + tile * 16 + r) + 32 * g;
#pragma unroll
        for (int s = 0; s < 32; ++s) xa[s] = *(const pg8::bf16x8*)(xrow + 128 * (s >> 1) + 16 * (s & 1)); }
    { float wv[32], gv[32];
#pragma unroll
      for (int q = 0; q < 32; ++q) { const int i = tid + q * NTHR; wv[q] = wr[i]; gv[q] = g2[i >> 4]; }
#pragma unroll
      for (int q = 0; q < 32; ++q) { const int i = tid + q * NTHR, k = i >> 4, e = i & 15; const float w = wv[q] * gv[q]; const unsigned hi = f2bf(w); const unsigned lo = f2bf(w - bf2f(hi));
        *(LAS bf16_t*)(L + e * RT_WROW + k * 2) = (bf16_t)hi; *(LAS bf16_t*)(L + RT_LO + e * RT_WROW + k * 2) = (bf16_t)lo; } }
    for (int i = tid; i < D; i += NTHR) *(LAS float*)(L + RT_G2 + i * 4) = g2[i];
    __syncthreads();
    while (tile < S / 16) {
        const int row0 = xg * S + tile * 16;
        const unsigned char* xrow = ws + x1_off(row0 + r) + 32 * g;
        f32x4 acc = {0.f, 0.f, 0.f, 0.f}; float ss = 0.f;
        const LAS unsigned char* bh = L + r * RT_WROW + 32 * g;
#pragma unroll
        for (int s = 0; s < 32; ++s) {
            if ((s & 3) == 0) __builtin_amdgcn_sched_barrier(0);
            const pg8::bf16x8 bhi = *(const LAS pg8::bf16x8*)(bh + 128 * (s >> 1) + 16 * (s & 1)), blo = *(const LAS pg8::bf16x8*)(bh + RT_LO + 128 * (s >> 1) + 16 * (s & 1));
            acc = __builtin_amdgcn_mfma_f32_16x16x32_bf16(xa[s], bhi, acc, 0, 0, 0);
            acc = __builtin_amdgcn_mfma_f32_16x16x32_bf16(xa[s], blo, acc, 0, 0, 0);
#pragma unroll
            for (int j = 0; j < 8; ++j) { const float v = bf2f((unsigned short)xa[s][j]); ss += v * v; }
        }
        ss += lane_x16(ss); ss += lane_x32(ss);
        const float rs = rsqrtf(ss * (1.f / D) + EPS);
        unsigned char* hrow = H2q + (size_t)(row0 + r) * 2048 + 16 * g;
#pragma unroll
        for (int u = 0; u < 16; ++u) {
            if ((u & 1) == 0) __builtin_amdgcn_sched_barrier(0);
            unsigned w[4];
#pragma unroll
            for (int q = 0; q < 2; ++q) {
                asm volatile("" : "+v"(xa[2 * u + q]));
                const f32x4 ga = *(const LAS f32x4*)(L + RT_G2 + (64 * u + 16 * g + 8 * q) * 4), gb = *(const LAS f32x4*)(L + RT_G2 + (64 * u + 16 * g + 8 * q + 4) * 4);
                float h[8];
#pragma unroll
                for (int j = 0; j < 8; ++j) h[j] = bf2f((unsigned short)xa[2 * u + q][j]) * rs * (j < 4 ? ga[j] : gb[j - 4]);
                w[2 * q] = pk4_fp8(h[0], h[1], h[2], h[3]); w[2 * q + 1] = pk4_fp8(h[4], h[5], h[6], h[7]); }
            *(uint4*)(hrow + 64 * u) = make_uint4(w[0], w[1], w[2], w[3]); }
        float av[4];
#pragma unroll
        for (int q = 0; q < 4; ++q) { const float rq = __shfl(rs, 4 * g + q); const float lgt = acc[q] * rq;
            float mx = lgt; mx = fmaxf(mx, lane_x1(mx)); mx = fmaxf(mx, lane_x2(mx)); mx = fmaxf(mx, lane_m8(mx)); mx = fmaxf(mx, lane_x8(mx));
            const float ex = __expf(lgt - mx); float sum = ex; sum += lane_x1(sum); sum += lane_x2(sum); sum += lane_m8(sum); sum += lane_x8(sum);
            av[q] = ex / sum; }
#pragma unroll
        for (int q = 0; q < 4; ++q) { const int row = row0 + 4 * g + q; aff[(size_t)row * NE + r] = av[q]; inv[(size_t)row * NE + r] = -1; }
        *(float4*)((float*)(ws + afft_off(xg, r)) + tile * 16 + 4 * g) = make_float4(av[0], av[1], av[2], av[3]);
        tile += NGW;
        if (tile < S / 16) { const unsigned char* xr2 = ws + x1_off(xg * S + tile * 16 + r) + 32 * g;
#pragma unroll
            for (int s = 0; s < 32; ++s) xa[s] = *(const pg8::bf16x8*)(xr2 + 128 * (s >> 1) + 16 * (s & 1)); }
    }
    __syncthreads();
}
DEV void phase_topk(const Args& a, unsigned char* lds, int wg, int G, int tid, int lane, int wave) {
    unsigned char* ws = a.ws; int* idx = (int*)(ws + WS_IDX); int* inv = (int*)(ws + WS_INV);
    LAS unsigned* hist = (LAS unsigned*)(LAS unsigned char*)lds; LAS unsigned* wsum = hist + 256; LAS unsigned* bc = hist + 272;
    for (int it = wg >> 3; it < NE; it += G >> 3) {
        const int e = it, b = wg & 7;
        unsigned u[8];
        { const uint4* src = (const uint4*)((const float*)(ws + afft_off(b, e)) + 8 * tid); const uint4 p = src[0], q = src[1]; u[0] = p.x; u[1] = p.y; u[2] = p.z; u[3] = p.w; u[4] = q.x; u[5] = q.y; u[6] = q.z; u[7] = q.w; }
        unsigned prefix = 0u, kk = CAP;
#pragma unroll
        for (int pass = 0; pass < 4; ++pass) {
            const int shift = 24 - 8 * pass;
            __syncthreads();
            if (tid < 256) hist[tid] = 0u;
            __syncthreads();
#pragma unroll
            for (int j = 0; j < 8; ++j) if (pass == 0 || (u[j] >> (shift + 8)) == prefix) atomicAdd((unsigned*)&hist[(u[j] >> shift) & 255u], 1u);
            __syncthreads();
            if (wave == 0) {
                const unsigned c0 = hist[4 * lane], c1 = hist[4 * lane + 1], c2 = hist[4 * lane + 2], c3 = hist[4 * lane + 3], tot = c0 + c1 + c2 + c3;
                unsigned incl = tot;
#pragma unroll
                for (int o = 1; o < 64; o <<= 1) { const unsigned t = __shfl_down(incl, o); if (lane + o < 64) incl += t; }
                const unsigned excl = incl - tot;
                if (excl < kk && kk <= incl) { unsigned acc = excl; int bin;
                    if (acc + c3 >= kk) bin = 3; else { acc += c3; if (acc + c2 >= kk) bin = 2; else { acc += c2; if (acc + c1 >= kk) bin = 1; else { acc += c1; bin = 0; } } }
                    bc[0] = 4 * lane + bin; bc[1] = kk - acc; }
            }
            __syncthreads();
            prefix = (prefix << 8) | bc[0]; kk = bc[1];
        }
        const unsigned T = prefix, need = kk;
        unsigned cg_ = 0u, ce = 0u;
#pragma unroll
        for (int j = 0; j < 8; ++j) { cg_ += u[j] > T; ce += u[j] == T; }
        unsigned pk = cg_ | (ce << 16), incl = pk;
#pragma unroll
        for (int o = 1; o < 64; o <<= 1) { const unsigned t = __shfl_up(incl, o); if (lane >= o) incl += t; }
        if (lane == 63) wsum[wave] = incl;
        __syncthreads();
        unsigned base = 0u;
#pragma unroll
        for (int w = 0; w < NWAVES; ++w) base += w < wave ? wsum[w] : 0u;
        const unsigned ex = base + incl - pk; unsigned gtb = ex & 0xffffu, eqb = ex >> 16;
#pragma unroll
        for (int j = 0; j < 8; ++j) { const bool g = u[j] > T, q = u[j] == T; const unsigned slot = gtb + (eqb < need ? eqb : need);
            if (g || (q && eqb < need)) { const int s = 8 * tid + j; idx[(e * NB + b) * CAP + slot] = s; inv[((size_t)b * S + s) * NE + e] = (int)slot; }
            gtb += g; eqb += q; }
    }
}
#define FIN_GATHER(W, GQ, MSK, IV, AV, BB) { \
    _Pragma("unroll") for (int q = 0; q < 4; ++q) { const bool on = MSK != 0ull; const int e = on ? __builtin_ctzll(MSK) : 0; MSK = on ? (MSK & (MSK - 1)) : 0ull; \
        const int sl = __builtin_amdgcn_readlane(IV, e); const float g = __builtin_bit_cast(float, __builtin_amdgcn_readlane(__builtin_bit_cast(int, AV), e)); \
        GQ[q] = on ? g : 0.f; \
        const unsigned* yr = (const unsigned*)(y + ((size_t)e * 4096 + (BB) * CAP + (on ? sl : 0)) * D) + lane;     \
        _Pragma("unroll") for (int j = 0; j < 4; ++j) W[q][j] = yr[64 * j]; } }
#define FIN_ACC(W, GQ) { \
    _Pragma("unroll") for (int q = 0; q < 4; ++q) \
    _Pragma("unroll") for (int j = 0; j < 4; ++j) { const auto lo = __builtin_amdgcn_cvt_pk_f32_fp8((int)W[q][j], false), hi = __builtin_amdgcn_cvt_pk_f32_fp8((int)W[q][j], true); \
        v[j].x += GQ[q] * lo[0]; v[j].y += GQ[q] * lo[1]; v[j].z += GQ[q] * hi[0]; v[j].w += GQ[q] * hi[1]; } }
template <class WaitF> DEV void phase_final(const Args& a, int gw, int NGW, int lane, const WaitF& seam_wait) {
    unsigned char* ws = a.ws; float* xo = a.out; const float* aff = (const float*)(ws + WS_AFF); const int* inv = (const int*)(ws + WS_INV);
    const unsigned char* y = ws + WS_Y; const float* fg = a.in[IN_FG];
    uint2 xw[4], xn[4], xm[4]; int iv = -1, ivn = -1, ivm = -1; float av = 0.f, avn = 0.f, avm = 0.f;
    float4 fgq[4];
#pragma unroll
    for (int j = 0; j < 4; ++j) fgq[j] = ((const float4*)fg)[lane + 64 * j];
    unsigned wc[4][4], wn[4][4]; float gc[4], gn[4]; unsigned long long mc = 0ull, mn = 0ull;
    { const uint2* xr = (const uint2*)(ws + x1_off(gw)) + lane;
#pragma unroll
      for (int j = 0; j < 4; ++j) xw[j] = xr[64 * j];
      if (lane < NE) { iv = inv[(size_t)gw * NE + lane]; av = aff[(size_t)gw * NE + lane]; }
      if (gw + NGW < M) { const uint2* xs = (const uint2*)(ws + x1_off(gw + NGW)) + lane;
#pragma unroll
        for (int j = 0; j < 4; ++j) xn[j] = xs[64 * j];
        if (lane < NE) { ivn = inv[(size_t)(gw + NGW) * NE + lane]; avn = aff[(size_t)(gw + NGW) * NE + lane]; } }
      seam_wait();
      mc = __ballot(lane < NE && iv >= 0);
      FIN_GATHER(wc, gc, mc, iv, av, gw >> 12) }
    for (int row = gw; row < M; row += NGW) {
        const int b = row >> 12;
        if (row + 2 * NGW < M) { const uint2* xr = (const uint2*)(ws + x1_off(row + 2 * NGW)) + lane;
#pragma unroll
            for (int j = 0; j < 4; ++j) xm[j] = xr[64 * j];
            if (lane < NE) { ivm = inv[(size_t)(row + 2 * NGW) * NE + lane]; avm = aff[(size_t)(row + 2 * NGW) * NE + lane]; } }
        if (row + NGW < M) { mn = __ballot(lane < NE && ivn >= 0); FIN_GATHER(wn, gn, mn, ivn, avn, (row + NGW) >> 12) }
        float4 v[4];
#pragma unroll
        for (int j = 0; j < 4; ++j) v[j] = make_float4(bf2f(xw[j].x & 0xffffu), bf2f(xw[j].x >> 16), bf2f(xw[j].y & 0xffffu), bf2f(xw[j].y >> 16));
        FIN_ACC(wc, gc)
        while (mc) {
            FIN_GATHER(wc, gc, mc, iv, av, b)
            FIN_ACC(wc, gc)
        }
        float s = 0.f;
#pragma unroll
        for (int j = 0; j < 4; ++j) s += v[j].x * v[j].x + v[j].y * v[j].y + v[j].z * v[j].z + v[j].w * v[j].w;
        const float rs = rsqrtf(wave_sum(s) * (1.f / D) + EPS);
        float4* orow = (float4*)(xo + (size_t)row * D) + lane;
#pragma unroll
        for (int j = 0; j < 4; ++j) { const float4 gg = fgq[j]; orow[64 * j] = make_float4(v[j].x * rs * gg.x, v[j].y * rs * gg.y, v[j].z * rs * gg.z, v[j].w * rs * gg.w); }
#pragma unroll
        for (int j = 0; j < 4; ++j) { xw[j] = xn[j]; xn[j] = xm[j]; }
        iv = ivn; av = avn; ivn = ivm; avn = avm; mc = mn;
#pragma unroll
        for (int q = 0; q < 4; ++q) { gc[q] = gn[q];
#pragma unroll
            for (int j = 0; j < 4; ++j) wc[q][j] = wn[q][j]; }
    }
}
typedef short bf16x8 __attribute__((ext_vector_type(8)));
typedef float f32x16 __attribute__((ext_vector_type(16)));
typedef short s16x4 __attribute__((ext_vector_type(4)));
typedef LAS const char* lds_cptr;
typedef unsigned u32x2 __attribute__((ext_vector_type(2)));
constexpr int VROW = 192;
constexpr int VSLOT = 32 * VROW;
constexpr int KROW = 144;
constexpr int KSLOT = 32 * KROW;
constexpr int MIX_WAVE_LDS = 16640;
constexpr int NWM = 8;
constexpr int MIX_BIAS_OFF = NWAVES * MIX_WAVE_LDS;
DEV int crow(int r, int hi) { return (r & 3) + 8 * (r >> 2) + 4 * hi; }
DEV s16x4 vtr(lds_cptr p) { return __builtin_bit_cast(s16x4, __builtin_amdgcn_ds_read_tr16_b64_v4i16((LAS s16x4*)p)); }
DEV bf16x8 tr_frag(lds_cptr slot, int s, int blk, int lane) {
    const int h = lane >> 5; lds_cptr p = slot + (16 * s + 4 * h + ((lane & 15) >> 2)) * VROW + (32 * blk + 16 * ((lane >> 4) & 1) + 4 * (lane & 3)) * 2;
    const s16x4 lo = vtr(p), hi = vtr(p + 8 * VROW);
    return (bf16x8){lo[0], lo[1], lo[2], lo[3], hi[0], hi[1], hi[2], hi[3]};
}
DEV void load_frags(bf16x8 (&f)[4], const bf16_t* rowp, int lane) {
    const int h = lane >> 5;
#pragma unroll
    for (int st = 0; st < 4; ++st) f[st] = *(const bf16x8*)(rowp + 16 * st + 8 * h);
}
DEV bf16x8 pack_p(const f32x16& p, int s) {
    u32x4 w; w.x = pg8::cvt_pk_bf16(p[8 * s], p[8 * s + 1]); w.y = pg8::cvt_pk_bf16(p[8 * s + 2], p[8 * s + 3]); w.z = pg8::cvt_pk_bf16(p[8 * s + 4], p[8 * s + 5]); w.w = pg8::cvt_pk_bf16(p[8 * s + 6], p[8 * s + 7]);
    return __builtin_bit_cast(bf16x8, w);
}

DEV void stage_rows_k(LAS unsigned char* ks, const u32x4 (&raw)[4], int lane) {
    const int rr = lane >> 3, ch = lane & 7;
#pragma unroll
    for (int i = 0; i < 4; ++i) *(LAS u32x4*)(ks + (rr + 8 * i) * KROW + ch * 16) = raw[i];
}
DEV void read_row_frags(bf16x8 (&f)[4], const LAS unsigned char* ks, int lane) {
    const LAS unsigned char* p = ks + (lane & 31) * KROW + (lane >> 5) * 16;
#pragma unroll
    for (int st = 0; st < 4; ++st) f[st] = *(const LAS bf16x8*)(p + st * 32);
}

DEV float other_half(float x) { const auto r = __builtin_amdgcn_permlane32_swap(__float_as_uint(x), __float_as_uint(x), false, false); return (threadIdx.x & 32) ? __uint_as_float(r[0]) : __uint_as_float(r[1]); }
DEV float max_halves(float x) { const auto r = __builtin_amdgcn_permlane32_swap(__float_as_uint(x), __float_as_uint(x), false, false); return fmaxf(__uint_as_float(r[0]), __uint_as_float(r[1])); }
DEV float sum_halves(float x) { const auto r = __builtin_amdgcn_permlane32_swap(__float_as_uint(x), __float_as_uint(x), false, false); return __uint_as_float(r[0]) + __uint_as_float(r[1]); }
#define MFMA32(a, b, c) __builtin_amdgcn_mfma_f32_32x32x16_bf16((a), (b), (c), 0, 0, 0)
DEV float ex2(float x) { return __builtin_amdgcn_exp2f(x); }

template <int V> struct IC { static constexpr int value = V; };
struct AttnIt { int p, bh, sh, L, r, q0, kmin, kmax; };
DEV void attn_decode(int li, int x, AttnIt& d) {
    const int hl = li / 192, rem = li - 192 * hl; d.p = rem >> 6; d.bh = 8 * x + hl; const int qblk = rem & 63;
    d.sh = 2 * d.p; d.L = S >> d.sh; const int bpr = d.L >> 6;
    d.r = qblk / bpr; d.q0 = (qblk % bpr) * 64;
    d.kmin = d.q0 >= 64 ? 0 : 2; const int km = (d.L + 63 - d.q0) >> 5; d.kmax = km > 5 ? 5 : km;
}
DEV int med3i(int v, int lo, int hi) { return v < lo ? lo : (v > hi ? hi : v); }
DEV void attn_ldrows(const bf16_t* base, const AttnIt& d, int i0, u32x4 (&v)[4], int lane) {
    const int rr = lane >> 3, ch = lane & 7; const char* hb = (const char*)(base + (size_t)d.bh * S * HD); const unsigned cst = (unsigned)(d.r * 128 + ch * 16);
#pragma unroll
    for (int i = 0; i < 4; ++i) v[i] = *(const u32x4*)(hb + (((unsigned)med3i(i0 + rr + 8 * i, 0, d.L - 1) << (d.sh + 7)) + cst));
}
DEV void attn_ldkv(const Args& a, const AttnIt& d, int kk, u32x4 (&k)[4], u32x4 (&v)[4], int lane) {
    const int rr = lane >> 3, ch = lane & 7, i0 = d.q0 - 64 + 32 * kk; const unsigned cst = (unsigned)(d.r * 128 + ch * 16);
    const char* kb = (const char*)((const bf16_t*)(a.ws + WS_AK) + (size_t)d.bh * S * HD); const char* vb = (const char*)((const bf16_t*)(a.ws + WS_AV) + (size_t)d.bh * S * HD);
#pragma unroll
    for (int i = 0; i < 4; ++i) { const unsigned off = ((unsigned)med3i(i0 + rr + 8 * i, 0, d.L - 1) << (d.sh + 7)) + cst; k[i] = *(const u32x4*)(kb + off); v[i] = *(const u32x4*)(vb + off); }
}
DEV void attn_items(const Args& a, unsigned char* lds, int wg, int G, int lane, int wave) {
    unsigned char* ws = a.ws;
    constexpr int NIT = 3 * 512; constexpr float THR = 6.f;
    const int x = wg & 7, NGW = (G >> 3) * NWM;
    int item = (wg >> 3) * NWM + wave; if (item >= NIT) return;
    LAS unsigned char* slot = (LAS unsigned char*)lds + wave * MIX_WAVE_LDS; lds_cptr slot3 = (lds_cptr)slot; LAS unsigned char* kslot = slot + VSLOT;
    const int t = lane & 31, hi = lane >> 5, rr = lane >> 3, ch = lane & 7;
    AttnIt d; attn_decode(item, x, d);
    bf16x8 qf[2][4], kf[4]; u32x4 kraw[4], vv[4];
    attn_ldkv(a, d, d.kmin, kraw, vv, lane);
    for (;;) {
        const LAS float* tph = (const LAS float*)((LAS unsigned char*)lds + MIX_BIAS_OFF) + (d.p * NH + (d.bh & 7)) * 192 + (32 + 4 * hi - t);
        f32x16 o[2][2] = {}; float m[2] = {0.f, 0.f}, l[2] = {0.f, 0.f};
        const int nitem = item + NGW; const bool hasn = nitem < NIT;
        AttnIt dn = d; if (hasn) attn_decode(nitem, x, dn);
#pragma unroll
        for (int j = 0; j < 2; ++j) { u32x4 qraw[4]; attn_ldrows((const bf16_t*)(ws + WS_AQ), d, d.q0 + 32 * j, qraw, lane); stage_rows_k(kslot, qraw, lane); asm volatile("" ::: "memory"); read_row_frags(qf[j], kslot, lane); asm volatile("" ::: "memory"); }
        for (int kk = d.kmin; kk <= d.kmax; ++kk) {
            const int kbase = d.q0 - 64 + 32 * kk;
#pragma unroll
            for (int i = 0; i < 4; ++i) *(LAS u32x4*)(slot + (rr + 8 * i) * VROW + ch * 16) = vv[i];
            stage_rows_k(kslot, kraw, lane);
            asm volatile("" ::: "memory");
            read_row_frags(kf, kslot, lane);
            asm volatile("" ::: "memory");
            if (kk < d.kmax) attn_ldkv(a, d, kk + 1, kraw, vv, lane);
            const bool edge = kbase < 0 || kbase + 31 >= d.L;
            auto step = [&](auto jmt) {
                constexpr int JM = decltype(jmt)::value;
                f32x16 sc[2]; float mx[2] = {0.f, 0.f}; bool first[2] = {false, false}; bool mv = false;
#pragma unroll
                for (int j = 0; j < 2; ++j) sc[j] = (f32x16){};
#pragma unroll
                for (int st = 0; st < 4; ++st) { if (JM & 1) sc[0] = MFMA32(kf[st], qf[0][st], sc[0]); if (JM & 2) sc[1] = MFMA32(kf[st], qf[1][st], sc[1]); }
#pragma unroll
                for (int j = 0; j < 2; ++j) if ((JM >> j) & 1) {
                    { const bool act = kk - j <= 4; const LAS float* tb = tph + 32 * (act ? kk - j : 0); const float moff = act ? m[j] : 1e30f;
#pragma unroll
                      for (int rg = 0; rg < 16; ++rg) sc[j][rg] = (sc[j][rg] - moff) + tb[(rg & 3) + 8 * (rg >> 2)]; }
                    if (edge) {
#pragma unroll
                        for (int rg = 0; rg < 16; ++rg) { const int ki = kbase + crow(rg, hi); sc[j][rg] = (ki >= 0 && ki < d.L) ? sc[j][rg] : -1e30f; } }
                    float t0 = fmaxf(fmaxf(sc[j][0], sc[j][1]), fmaxf(sc[j][2], sc[j][3]));
#pragma unroll
                    for (int rg = 4; rg < 16; rg += 4) t0 = fmaxf(t0, fmaxf(fmaxf(sc[j][rg], sc[j][rg + 1]), fmaxf(sc[j][rg + 2], sc[j][rg + 3])));
                    mx[j] = max_halves(t0);
                    first[j] = kk == j || kk == d.kmin;
                    mv = mv || first[j] || __any(mx[j] > THR);
                }
                if (mv) {
#pragma unroll
                    for (int j = 0; j < 2; ++j) if ((JM >> j) & 1) {
                        const float dl = first[j] ? mx[j] : fmaxf(mx[j], 0.f), f = ex2(-dl); m[j] += dl; l[j] *= f;
#pragma unroll
                        for (int rg = 0; rg < 16; ++rg) { sc[j][rg] -= dl; o[j][0][rg] *= f; o[j][1][rg] *= f; } }
                }
                const bf16x8 v00 = tr_frag(slot3, 0, 0, lane), v10 = tr_frag(slot3, 1, 0, lane), v01 = tr_frag(slot3, 0, 1, lane), v11 = tr_frag(slot3, 1, 1, lane);
#pragma unroll
                for (int j = 0; j < 2; ++j) if ((JM >> j) & 1) { float ps0 = 0.f, ps1 = 0.f;
#pragma unroll
                    for (int rg = 0; rg < 16; rg += 2) { sc[j][rg] = ex2(sc[j][rg]); sc[j][rg + 1] = ex2(sc[j][rg + 1]); ps0 += sc[j][rg]; ps1 += sc[j][rg + 1]; }
                    l[j] += ps0 + ps1; }
                bf16x8 p0[2], p1[2];
#pragma unroll
                for (int j = 0; j < 2; ++j) if ((JM >> j) & 1) { p0[j] = pack_p(sc[j], 0); p1[j] = pack_p(sc[j], 1); }
#pragma unroll
                for (int j = 0; j < 2; ++j) if ((JM >> j) & 1) { o[j][0] = MFMA32(v00, p0[j], o[j][0]); o[j][1] = MFMA32(v01, p0[j], o[j][1]); }
#pragma unroll
                for (int j = 0; j < 2; ++j) if ((JM >> j) & 1) { o[j][0] = MFMA32(v10, p1[j], o[j][0]); o[j][1] = MFMA32(v11, p1[j], o[j][1]); }
            };
            if (kk == 0) step(IC<1>{}); else step(IC<3>{});
        }
#pragma unroll
        for (int j = 0; j < 2; ++j) {
            float lt = sum_halves(l[j]);
            const float il = 16.f / lt;
            const size_t orow = ((size_t)d.p * NB * NH + d.bh) * S + (size_t)(((d.q0 + 32 * j + t) << d.sh) + d.r);
#pragma unroll
            for (int g4 = 0; g4 < 4; ++g4) {
                *(LAS u32x2*)(kslot + t * KROW + (8 * g4 + 4 * hi) * 2) = (u32x2){pg8::cvt_pk_bf16(o[j][0][4 * g4] * il, o[j][0][4 * g4 + 1] * il), pg8::cvt_pk_bf16(o[j][0][4 * g4 + 2] * il, o[j][0][4 * g4 + 3] * il)};
                *(LAS u32x2*)(kslot + t * KROW + (32 + 8 * g4 + 4 * hi) * 2) = (u32x2){pg8::cvt_pk_bf16(o[j][1][4 * g4] * il, o[j][1][4 * g4 + 1] * il), pg8::cvt_pk_bf16(o[j][1][4 * g4 + 2] * il, o[j][1][4 * g4 + 3] * il)};
            }
            asm volatile("" ::: "memory");
            { unsigned char* ob = ws + WS_ATTO + ((size_t)d.p * NB * NH + d.bh) * S * 64;
#pragma nounroll
              for (int i = 0; i < 4; ++i) { const u32x4 w = *(const LAS u32x4*)(kslot + (rr + 8 * i) * KROW + ch * 16);
                  const unsigned lo = pk4_fp8(bf2f(w.x & 0xffffu), bf2f(w.x >> 16), bf2f(w.y & 0xffffu), bf2f(w.y >> 16)), hi8 = pk4_fp8(bf2f(w.z & 0xffffu), bf2f(w.z >> 16), bf2f(w.w & 0xffffu), bf2f(w.w >> 16));
                  *(u32x2*)(ob + (size_t)(((d.q0 + 32 * j + rr + 8 * i) << d.sh) + d.r) * 64 + ch * 8) = (u32x2){lo, hi8}; } }
            asm volatile("" ::: "memory");
            if (hi == 0) ((float*)(ws + (d.p == 0 ? WS_ATTL0 : (d.p == 1 ? WS_ATTL1 : WS_ATTL2))))[(size_t)d.bh * S + (size_t)(((d.q0 + 32 * j + t) << d.sh) + d.r)] = m[j] + __log2f(lt);
        }
        if (!hasn) break;
        item = nitem; d = dn;
        attn_ldkv(a, d, d.kmin, kraw, vv, lane);
    }
}
DEV void retstate_item(const Args& a, unsigned char* lds, int item, int xg, int lane, int wave) {
    unsigned char* ws = a.ws;
    const int dir = item & 1, n = (item >> 1) & 31, bh = 8 * xg + (item >> 6), h = bh & 7;
    const bf16_t* Kc = (const bf16_t*)(ws + WS_RK) + ((size_t)bh * S + n * 128) * HD; const bf16_t* Vc = (const bf16_t*)(ws + WS_RV) + ((size_t)bh * S + n * 128) * HD;
    const float lg = a.in[IN_DECAY][dir * NH + h] * LOG2E;
    LAS unsigned char* vs = (LAS unsigned char*)lds + wave * MIX_WAVE_LDS; LAS unsigned char* ks = vs + VSLOT; lds_cptr vs3 = (lds_cptr)vs, ks3 = (lds_cptr)ks;
    f32x16 acc[2][2] = {};
    for (int blk = 0; blk < 4; ++blk) {
        { const int rr = lane >> 3, ch = lane & 7;
          u32x4 v[4], k[4];
#pragma unroll
          for (int i = 0; i < 4; ++i) { const int mrow = 32 * blk + rr + 8 * i; v[i] = *(const u32x4*)(Vc + (size_t)mrow * HD + ch * 8); k[i] = *(const u32x4*)(Kc + (size_t)mrow * HD + ch * 8); }
#pragma unroll
          for (int i = 0; i < 4; ++i) { const int mrow = 32 * blk + rr + 8 * i; const float z = ex2(lg * (float)(dir == 0 ? 127 - mrow : mrow));
              const unsigned kw[4] = {k[i].x, k[i].y, k[i].z, k[i].w}; u32x4 o;
              o.x = pg8::cvt_pk_bf16(bf2f(kw[0] & 0xffffu) * z, bf2f(kw[0] >> 16) * z); o.y = pg8::cvt_pk_bf16(bf2f(kw[1] & 0xffffu) * z, bf2f(kw[1] >> 16) * z);
              o.z = pg8::cvt_pk_bf16(bf2f(kw[2] & 0xffffu) * z, bf2f(kw[2] >> 16) * z); o.w = pg8::cvt_pk_bf16(bf2f(kw[3] & 0xffffu) * z, bf2f(kw[3] >> 16) * z);
              *(LAS u32x4*)(vs + (rr + 8 * i) * VROW + ch * 16) = v[i]; *(LAS u32x4*)(ks + (rr + 8 * i) * VROW + ch * 16) = o; } }
        LDS_WAIT();
#pragma unroll
        for (int s = 0; s < 2; ++s) {
            const bf16x8 v0 = tr_frag(vs3, s, 0, lane), v1 = tr_frag(vs3, s, 1, lane), k0 = tr_frag(ks3, s, 0, lane), k1 = tr_frag(ks3, s, 1, lane);
            acc[0][0] = MFMA32(v0, k0, acc[0][0]); acc[0][1] = MFMA32(v0, k1, acc[0][1]); acc[1][0] = MFMA32(v1, k0, acc[1][0]); acc[1][1] = MFMA32(v1, k1, acc[1][1]);
        }
        LDS_WAIT();
    }
    unsigned char* KT = ws + WS_KF + (((size_t)dir * NB * NH + bh) * 32 + n) * 4096;
    const int c = lane & 31, hi = lane >> 5;
#pragma unroll
    for (int eb = 0; eb < 2; ++eb)
#pragma unroll
        for (int db = 0; db < 2; ++db)
#pragma unroll
            for (int rg = 0; rg < 16; ++rg) { const float v4 = acc[eb][db][rg] * 4.f; KT[(32 * eb + crow(rg, hi)) * 64 + 32 * db + c] = (unsigned char)__builtin_amdgcn_cvt_pk_fp8_f32(v4, v4, 0, false); }
}
template <int DIR> DEV void scan_slice(const unsigned* kt, unsigned* st, float gC) {
    unsigned kv[32];
#pragma unroll
    for (int i = 0; i < 32; ++i) kv[i] = kt[(size_t)i * 1024];
    float4 s = make_float4(0.f, 0.f, 0.f, 0.f);
#pragma unroll
    for (int i = 0; i < 32; ++i) { const int n = DIR == 0 ? i : 31 - i;
        st[(size_t)n * 1024] = pk4_fp8(s.x, s.y, s.z, s.w);
        const auto lo = __builtin_amdgcn_cvt_pk_f32_fp8((int)kv[n], false), hi = __builtin_amdgcn_cvt_pk_f32_fp8((int)kv[n], true);
        s.x = gC * s.x + lo[0]; s.y = gC * s.y + lo[1]; s.z = gC * s.z + hi[0]; s.w = gC * s.w + hi[1]; }
}
DEV void phase_scan(const Args& a, int xg, int gtid, int NT) {
    unsigned char* ws = a.ws;
    for (int sl = gtid; sl < 2 * NH * 1024; sl += NT) {
        const int dir = sl >> 13, bh = 8 * xg + ((sl >> 10) & 7), q = sl & 1023, h = bh & 7;
        const float gC = ex2(a.in[IN_DECAY][dir * NH + h] * LOG2E * 128.f);
        const unsigned* kt = (const unsigned*)(ws + WS_KF) + ((size_t)dir * NB * NH + bh) * 32 * 1024 + q;
        unsigned* st = (unsigned*)(ws + st_off(dir, bh, 0)) + q;
        if (dir == 0) scan_slice<0>(kt, st, gC); else scan_slice<1>(kt, st, gC);
    }
}
DEV void ld_rows32(const bf16_t* base, u32x4 (&v)[4], int lane) {
    const char* b = (const char*)base; const unsigned off = (unsigned)((lane >> 3) * 128 + (lane & 7) * 16);
#pragma unroll
    for (int i = 0; i < 4; ++i) v[i] = *(const u32x4*)(b + off + i * 1024);
}
DEV void retout_item(const Args& a, unsigned char* lds, int item, int xg, int lane, int wave) {
    unsigned char* ws = a.ws;
    const int hq = item & 1, n = (item >> 1) & 31, bh = 8 * xg + (item >> 6), h = bh & 7, b = bh >> 3;
    const bf16_t* Qc = (const bf16_t*)(ws + WS_RQ) + ((size_t)bh * S + n * 128) * HD; const bf16_t* Kc = (const bf16_t*)(ws + WS_RK) + ((size_t)bh * S + n * 128) * HD;
    const bf16_t* Vc = (const bf16_t*)(ws + WS_RV) + ((size_t)bh * S + n * 128) * HD; const bf16_t* Gc = (const bf16_t*)(ws + WS_RG) + ((size_t)bh * S + n * 128) * HD;
    const unsigned char* SF = ws + st_off(0, bh, n); const unsigned char* SB = ws + st_off(1, bh, n);
    const float lg0 = a.in[IN_DECAY][h] * LOG2E, lg1 = a.in[IN_DECAY][NH + h] * LOG2E;
    LAS unsigned char* slot = (LAS unsigned char*)lds + wave * MIX_WAVE_LDS; lds_cptr slot3 = (lds_cptr)slot; LAS unsigned char* kslot = slot + VSLOT;
    const int t = lane & 31, hi = lane >> 5, rr = lane >> 3, ch = lane & 7;
    bf16x8 qf[2][4];
    u32x2 rst[4][4]; u32x4 kvn[2][4];
    { u32x4 rq[2][4];
#pragma unroll
      for (int j = 0; j < 2; ++j) ld_rows32(Qc + (size_t)(64 * hq + 32 * j) * HD, rq[j], lane);
#pragma unroll
      for (int q = 0; q < 4; ++q) { const unsigned char* sb = ((q >> 1) == 0 ? SF : SB) + (32 * (q & 1)) * 64 + (lane >> 3) * 64 + (lane & 7) * 8;
#pragma unroll
        for (int i = 0; i < 4; ++i) rst[q][i] = *(const u32x2*)(sb + i * 512); }
#pragma unroll
      for (int j = 0; j < 2; ++j) { stage_rows_k(kslot, rq[j], lane); asm volatile("" ::: "memory"); read_row_frags(qf[j], kslot, lane); asm volatile("" ::: "memory"); } }
    f32x16 o[2][2] = {};
#pragma unroll
    for (int dir = 0; dir < 2; ++dir) {
#pragma unroll
        for (int eb = 0; eb < 2; ++eb) { bf16x8 sf[4]; u32x4 sraw[4];
#pragma unroll
            for (int i = 0; i < 4; ++i) { const u32x2 w8 = rst[2 * dir + eb][i];
                const auto a0 = __builtin_amdgcn_cvt_pk_f32_fp8((int)w8.x, false), a1 = __builtin_amdgcn_cvt_pk_f32_fp8((int)w8.x, true), a2 = __builtin_amdgcn_cvt_pk_f32_fp8((int)w8.y, false), a3 = __builtin_amdgcn_cvt_pk_f32_fp8((int)w8.y, true);
                sraw[i] = (u32x4){pg8::cvt_pk_bf16(a0[0], a0[1]), pg8::cvt_pk_bf16(a1[0], a1[1]), pg8::cvt_pk_bf16(a2[0], a2[1]), pg8::cvt_pk_bf16(a3[0], a3[1])}; }
            stage_rows_k(kslot, sraw, lane); asm volatile("" ::: "memory"); read_row_frags(sf, kslot, lane); asm volatile("" ::: "memory");
#pragma unroll
            for (int j = 0; j < 2; ++j)
#pragma unroll
                for (int st = 0; st < 4; ++st) o[j][eb] = MFMA32(sf[st], qf[j][st], o[j][eb]); }
#pragma unroll
        for (int j = 0; j < 2; ++j) { const int c = 64 * hq + 32 * j + t; const float f = dir == 0 ? ex2(lg0 * (float)(c + 1) - lg1 * (float)(128 - c)) : 0.25f * ex2(lg1 * (float)(128 - c));
#pragma unroll
            for (int rg = 0; rg < 16; ++rg) { o[j][0][rg] *= f; o[j][1][rg] *= f; } }
        if (dir == 0) { ld_rows32(Kc, kvn[0], lane); ld_rows32(Vc, kvn[1], lane); }
    }
    float f1[4], f2[4], b1[4], b2[4];
#pragma unroll
    for (int i = 0; i < 4; ++i) { f1[i] = __builtin_bit_cast(float, __builtin_amdgcn_readfirstlane(__builtin_bit_cast(int, ex2(-lg0 * (float)i)))); f2[i] = __builtin_bit_cast(float, __builtin_amdgcn_readfirstlane(__builtin_bit_cast(int, ex2(-lg0 * (float)(8 * i)))));
        b1[i] = __builtin_bit_cast(float, __builtin_amdgcn_readfirstlane(__builtin_bit_cast(int, ex2(lg1 * (float)i)))); b2[i] = __builtin_bit_cast(float, __builtin_amdgcn_readfirstlane(__builtin_bit_cast(int, ex2(lg1 * (float)(8 * i))))); }
#pragma nounroll
    for (int kb = 0; kb < 4; ++kb) {
      {
#pragma unroll
        for (int i = 0; i < 4; ++i) *(LAS u32x4*)(slot + (rr + 8 * i) * VROW + ch * 16) = kvn[1][i];
        stage_rows_k(kslot, kvn[0], lane);
        asm volatile("" ::: "memory");
          bf16x8 kf[4]; read_row_frags(kf, kslot, lane);
          const bf16x8 v00 = tr_frag(slot3, 0, 0, lane), v10 = tr_frag(slot3, 1, 0, lane), v01 = tr_frag(slot3, 0, 1, lane), v11 = tr_frag(slot3, 1, 1, lane);
          asm volatile("" ::: "memory");
          if (kb < 3) { ld_rows32(Kc + (size_t)(32 * (kb + 1)) * HD, kvn[0], lane); ld_rows32(Vc + (size_t)(32 * (kb + 1)) * HD, kvn[1], lane); }
          else { ld_rows32(Gc + (size_t)(64 * hq) * HD, kvn[0], lane); ld_rows32(Gc + (size_t)(64 * hq + 32) * HD, kvn[1], lane); }
  #pragma unroll
          for (int j = 0; j < 2; ++j) {
              const int qbi = 2 * hq + j;
              f32x16 sc = {};
  #pragma unroll
              for (int st = 0; st < 4; ++st) sc = MFMA32(kf[st], qf[j][st], sc);
              if (kb < qbi) { const float A = ex2(lg0 * (float)(32 * (qbi - kb) + t - 4 * hi)); float a2[4];
  #pragma unroll
                  for (int q = 0; q < 4; ++q) a2[q] = A * f2[q];
  #pragma unroll
                  for (int rg = 0; rg < 16; ++rg) sc[rg] *= a2[rg >> 2] * f1[rg & 3];
              } else if (kb > qbi) { const float A = ex2(lg1 * (float)(32 * (kb - qbi) - t + 4 * hi)); float a2[4];
  #pragma unroll
                  for (int q = 0; q < 4; ++q) a2[q] = A * b2[q];
  #pragma unroll
                  for (int rg = 0; rg < 16; ++rg) sc[rg] *= a2[rg >> 2] * b1[rg & 3];
              } else {
                  int tt = t - 4 * hi; asm volatile("" : "+v"(tt));
                  { const float A0 = ex2(lg0 * (float)tt), A1 = ex2(-lg1 * (float)tt); float a0q[4], a1q[4];
  #pragma unroll
                    for (int q = 0; q < 4; ++q) { a0q[q] = A0 * f2[q]; a1q[q] = A1 * b2[q]; }
  #pragma unroll
                    for (int rg = 0; rg < 16; ++rg) { const int df = tt - ((rg & 3) + 8 * (rg >> 2)); sc[rg] *= df >= 0 ? a0q[rg >> 2] * f1[rg & 3] : a1q[rg >> 2] * b1[rg & 3]; } }
              }
              const bf16x8 p0 = pack_p(sc, 0), p1 = pack_p(sc, 1);
              o[j][0] = MFMA32(v00, p0, o[j][0]); o[j][0] = MFMA32(v10, p1, o[j][0]);
              o[j][1] = MFMA32(v01, p0, o[j][1]); o[j][1] = MFMA32(v11, p1, o[j][1]);
          }
      }
    }
    const float* gn = a.in[IN_GN] + h * HD; const unsigned gnoff = (unsigned)(16 * hi); LAS unsigned char* kq = kslot + t * KROW + 8 * hi;
    float4 ggv[2][4];
#pragma unroll
    for (int db = 0; db < 2; ++db)
#pragma unroll
        for (int g4 = 0; g4 < 4; ++g4) ggv[db][g4] = *(const float4*)((const char*)gn + gnoff + (32 * db + 8 * g4) * 4);
#pragma unroll
    for (int j = 0; j < 2; ++j) {
        const int r0 = n * 128 + 64 * hq + 32 * j;
        stage_rows_k(kslot, kvn[j], lane); asm volatile("" ::: "memory");
        float sm = 0.f;
#pragma unroll
        for (int rg = 0; rg < 16; ++rg) sm += o[j][0][rg] + o[j][1][rg];
        sm = sum_halves(sm); const float mu = sm * (1.f / 64.f); float vq = 0.f;
#pragma unroll
        for (int rg = 0; rg < 16; ++rg) { const float d0 = o[j][0][rg] - mu, d1 = o[j][1][rg] - mu; vq += d0 * d0 + d1 * d1; }
        vq = sum_halves(vq); const float rstd = rsqrtf(vq * (1.f / 64.f) + EPS);
        u32x2 ow[2][4];
#pragma unroll
        for (int db = 0; db < 2; ++db)
#pragma unroll
            for (int g4 = 0; g4 < 4; ++g4) { const u32x2 gw = *(const LAS u32x2*)(kq + (32 * db + 8 * g4) * 2); const float4 gg = ggv[db][g4];
                const f32x4 gate = {bf2f(gw[0] & 0xffffu), bf2f(gw[0] >> 16), bf2f(gw[1] & 0xffffu), bf2f(gw[1] >> 16)}, gv = {gg.x, gg.y, gg.z, gg.w};
                const f32x4 ov4 = {o[j][db][4 * g4], o[j][db][4 * g4 + 1], o[j][db][4 * g4 + 2], o[j][db][4 * g4 + 3]};
                const f32x4 tq = gate * (-LOG2E); f32x4 eq, rq;
#pragma unroll
                for (int i = 0; i < 4; ++i) eq[i] = ex2(tq[i]);
                const f32x4 dq = eq + 1.f;
#pragma unroll
                for (int i = 0; i < 4; ++i) rq[i] = __builtin_amdgcn_rcpf(dq[i]);
                const f32x4 ov = ((ov4 - mu) * (gv * rstd)) * (gate * rq);
                ow[db][g4] = (u32x2){pg8::cvt_pk_bf16(ov[0], ov[1]), pg8::cvt_pk_bf16(ov[2], ov[3])}; }
        asm volatile("" ::: "memory");
#pragma unroll
        for (int db = 0; db < 2; ++db)
#pragma unroll
            for (int g4 = 0; g4 < 4; ++g4) *(LAS u32x2*)(kq + (32 * db + 8 * g4) * 2) = ow[db][g4];
        asm volatile("" ::: "memory");
        { bf16_t* ob = (bf16_t*)(ws + WS_AK + mix_rel(b * S + r0)) + h * HD;
#pragma unroll
          for (int i = 0; i < 4; ++i) { const u32x4 w = *(const LAS u32x4*)(kslot + (rr + 8 * i) * KROW + ch * 16); *(u32x4*)(ob + (size_t)(rr + 8 * i) * D + ch * 8) = w; } }
        asm volatile("" ::: "memory");
    }
}
DEV void phase_attn_merge(const Args& a, int xg, int gtid, int NT) {
    unsigned char* ws = a.ws; const unsigned char* O = ws + WS_ATTO; unsigned char* mixb = ws + WS_AK;
    for (int it0 = gtid; it0 < NH * S * 4; it0 += 4 * NT) {
        float l0[4], l1[4], l2[4]; uint4 a0[4], a1[4], a2[4];
#pragma unroll
        for (int k = 0; k < 4; ++k) { const int it = it0 + k * NT; const int ch = it & 3, row = xg * NH * S + (it >> 2);
            l0[k] = ((const float*)(ws + WS_ATTL0))[row]; l1[k] = ((const float*)(ws + WS_ATTL1))[row]; l2[k] = ((const float*)(ws + WS_ATTL2))[row];
            a0[k] = *(const uint4*)(O + (size_t)row * 64 + ch * 16); a1[k] = *(const uint4*)(O + ((size_t)NB * NH * S + row) * 64 + ch * 16); a2[k] = *(const uint4*)(O + ((size_t)2 * NB * NH * S + row) * 64 + ch * 16); }
#pragma unroll
        for (int k = 0; k < 4; ++k) { const int it = it0 + k * NT; const int ch = it & 3, row = xg * NH * S + (it >> 2);
            const int bh = row >> 12, pos = row & 4095, b = bh >> 3, h = bh & 7;
            const float mx = fmaxf(l0[k], fmaxf(l1[k], l2[k])); float w0 = ex2(l0[k] - mx), w1 = ex2(l1[k] - mx), w2 = ex2(l2[k] - mx); const float is = (1.f / 16.f) / (w0 + w1 + w2); w0 *= is; w1 *= is; w2 *= is;
            const unsigned x0[4] = {a0[k].x, a0[k].y, a0[k].z, a0[k].w}, x1[4] = {a1[k].x, a1[k].y, a1[k].z, a1[k].w}, x2[4] = {a2[k].x, a2[k].y, a2[k].z, a2[k].w}; unsigned o[8];
#pragma unroll
            for (int j = 0; j < 4; ++j) {
                const auto p0 = __builtin_amdgcn_cvt_pk_f32_fp8((int)x0[j], false), q0 = __builtin_amdgcn_cvt_pk_f32_fp8((int)x0[j], true);
                const auto p1 = __builtin_amdgcn_cvt_pk_f32_fp8((int)x1[j], false), q1 = __builtin_amdgcn_cvt_pk_f32_fp8((int)x1[j], true);
                const auto p2 = __builtin_amdgcn_cvt_pk_f32_fp8((int)x2[j], false), q2 = __builtin_amdgcn_cvt_pk_f32_fp8((int)x2[j], true);
                o[2 * j] = pg8::cvt_pk_bf16(w0 * p0[0] + w1 * p1[0] + w2 * p2[0], w0 * p0[1] + w1 * p1[1] + w2 * p2[1]);
                o[2 * j + 1] = pg8::cvt_pk_bf16(w0 * q0[0] + w1 * q1[0] + w2 * q2[0], w0 * q0[1] + w1 * q1[1] + w2 * q2[1]); }
            uint4* dst = (uint4*)(mixb + mix_rel(b * S + pos) + (512 + h * HD + ch * 16) * 2);
            dst[0] = make_uint4(o[0], o[1], o[2], o[3]); dst[1] = make_uint4(o[4], o[5], o[6], o[7]); }
    }
}
DEV void phase_mix_a(const Args& a, unsigned char* lds, int wg, int G, int lane, int wave, int tid) {
    LAS unsigned* ctr = (LAS unsigned*)((LAS unsigned char*)lds + LDS_BYTES - 64) + 4;
    { const float* bt = (const float*)(a.ws + WS_BIAS); LAS float* bl = (LAS float*)((LAS unsigned char*)lds + MIX_BIAS_OFF);
      float bv[9];
#pragma unroll
      for (int k = 0; k < 9; ++k) { const int i = tid + k * NTHR, ph = i / 192, bi = i % 192 - 32; bv[k] = bt[ph * 129 + (bi < 0 ? 0 : (bi > 128 ? 128 : bi))]; }
#pragma unroll
      for (int k = 0; k < 9; ++k) { const int i = tid + k * NTHR, bi = i % 192 - 32; bl[i] = (bi >= 0 && bi <= 128) ? bv[k] : -1e30f; }
      if (tid == 0) *ctr = 0u; }
    __syncthreads();
    if (wave < NWM) {
        const int x = wg & 7, wq = (wg >> 3) * NWM + wave, WPX = (G >> 3) * NWM;
        for (int rep = 0; rep < a.rep[0]; ++rep) { asm volatile("" : "+v"(lane)); for (int it = wq; it < 2 * 32 * NH; it += WPX) retstate_item(a, lds, it, x, lane, wave); }
        for (int rep = 0; rep < a.rep[1]; ++rep) { asm volatile("" : "+v"(lane)); attn_items(a, lds, wg, G, lane, wave); }
    }
    asm volatile("" : "+v"(lane));
    phase_latew(a, lds, wg, G, lane, wave, ctr, G == 256 ? CONV1_TILES : 0);
}
template <class WaitF> DEV void phase_mix_b(const Args& a, unsigned char* lds, int wg, int G, int lane, int wave, int tid, const WaitF& seam_wait) {
    const int x = wg & 7, wq = (wg >> 3) * NWAVES + wave, WPX = (G >> 3) * NWAVES;
    for (int rep = 0; rep < a.rep[3]; ++rep) { asm volatile("" : "+v"(tid)); phase_attn_merge(a, x, (wg >> 3) * NTHR + tid, (G >> 3) * NTHR); }
    seam_wait();
    for (int rep = 0; rep < a.rep[2]; ++rep) { asm volatile("" : "+v"(lane)); for (int it = wq; it < NH * 32 * 2; it += WPX) retout_item(a, lds, it, x, lane, wave); }
}
#define XB_TMO      128
#define XB_XCNT(j)  (256  + 64 * (j))
#define XB_XSUB(j)  (1280 + 64 * (j))
#define XB_XGEN(j)  (2304 + 64 * (j))
#define XB_TOP      3328
#define XB_TOPGEN   3392
#define XCD_BAR_WORDS 3456
#define XB_SPIN_CAP (1u << 18)

__device__ __forceinline__ unsigned xb_ld(unsigned* p)              { return __hip_atomic_load(p, __ATOMIC_RELAXED, __HIP_MEMORY_SCOPE_AGENT); }
__device__ __forceinline__ unsigned xb_add(unsigned* p, unsigned v) { return __hip_atomic_fetch_add(p, v, __ATOMIC_RELAXED, __HIP_MEMORY_SCOPE_AGENT); }
__device__ __forceinline__ unsigned xb_xcc_id() { return (unsigned)__builtin_amdgcn_s_getreg((3 << 11) | 20) & 0xFu; }
#define XB_SPIN(cond, bar) do { unsigned _sp = 0; while (cond) { __builtin_amdgcn_s_sleep(1); \
    if ((++_sp & 255u) == 0u) { if (xb_ld(&(bar)[XB_TMO])) break; if (_sp > XB_SPIN_CAP) { atomicAdd(&(bar)[XB_TMO], 1u); break; } } } } while (0)

struct XcdBarrier {
    unsigned* bar; unsigned x;
    volatile LAS unsigned* st;
};

__device__ __forceinline__ XcdBarrier xcd_barrier_post(unsigned* bar, volatile LAS unsigned* st) {
    XcdBarrier b; b.bar = bar; b.x = xb_xcc_id(); b.st = st;
    if (threadIdx.x == 0) (void)xb_add(&bar[XB_XCNT(b.x)], 1u);
    return b;
}
__device__ __forceinline__ void xcd_barrier_complete(unsigned* bar, unsigned x, unsigned& nloc, unsigned& nx) {
    const unsigned G = gridDim.x * gridDim.y * gridDim.z;
    unsigned sum, cnt, mine, sp = 0u;
    for (;;) {
        sum = 0u; cnt = 0u; mine = 0u;
#pragma unroll
        for (unsigned j = 0; j < 16; ++j) { const unsigned c = xb_ld(&bar[XB_XCNT(j)]); sum += c; cnt += (c > 0u) ? 1u : 0u; mine = (j == x) ? c : mine; }
        if (sum == G) break;
        __builtin_amdgcn_s_sleep(1);
        if ((++sp & 255u) == 0u) { if (xb_ld(&bar[XB_TMO])) break; if (sp > XB_SPIN_CAP) { atomicAdd(&bar[XB_TMO], 1u); break; } }
    }
    nloc = mine > 0u ? mine : 1u; nx = cnt > 0u ? cnt : 1u;
}

__device__ __forceinline__ void xcd_barrier(const XcdBarrier& b) {
    asm volatile("s_waitcnt vmcnt(0)" ::: "memory");
    __syncthreads();
    if (threadIdx.x == 0) {
        unsigned* bar = b.bar;
        __builtin_amdgcn_s_waitcnt(0);
        unsigned nloc = b.st[0], nx = b.st[1];
        if (nloc == 0u) { xcd_barrier_complete(bar, b.x, nloc, nx); b.st[0] = nloc; b.st[1] = nx; }
        const unsigned old = xb_add(&bar[XB_XSUB(b.x)], 1u);
        const unsigned gen = old / nloc;
        if (old + 1u == (gen + 1u) * nloc) {
            __builtin_amdgcn_fence(__ATOMIC_RELEASE, "agent");
            asm volatile("s_waitcnt vmcnt(0)" ::: "memory");
            const unsigned og = xb_add(&bar[XB_TOP], 1u);
            const unsigned tg = og / nx;
            if (og + 1u == (tg + 1u) * nx) xb_add(&bar[XB_TOPGEN], 1u);
            else XB_SPIN(xb_ld(&bar[XB_TOPGEN]) == tg, bar);
            __builtin_amdgcn_fence(__ATOMIC_ACQUIRE, "agent");
            xb_add(&bar[XB_XGEN(b.x)], 1u);
            asm volatile("s_waitcnt vmcnt(0)" ::: "memory");
        } else {
            XB_SPIN(xb_ld(&bar[XB_XGEN(b.x)]) == gen, bar);
            __builtin_amdgcn_fence(__ATOMIC_ACQUIRE, "agent");
            asm volatile("s_waitcnt vmcnt(0)" ::: "memory");
        }
    }
    __syncthreads();
}


#define GB_GC(g)     (8192 + 64 * (g))
#define GB_N(g, j)   (9216 + 16 * (16 * (g) + (j)))
#define GB_A(g, j)   (13312 + 16 * (16 * (g) + (j)))
struct GroupBarrier { unsigned* ctl; unsigned g, x, ng; volatile LAS unsigned* st; };
__device__ __forceinline__ GroupBarrier group_barrier_post(unsigned* ctl, unsigned g, unsigned ng, volatile LAS unsigned* st) {
    GroupBarrier b; b.ctl = ctl; b.g = g; b.x = xb_xcc_id(); b.ng = ng; b.st = st;
    if (threadIdx.x == 0) (void)xb_add(&ctl[GB_N(g, b.x)], 1u);
    return b;
}
__device__ __forceinline__ void group_barrier(const GroupBarrier& b, unsigned epoch) {
    asm volatile("s_waitcnt vmcnt(0)" ::: "memory");
    __syncthreads();
    if (threadIdx.x == 0) {
        unsigned* ctl = b.ctl; unsigned n = b.st[0];
        if (n == 0u) {
            unsigned sp = 0u;
            for (;;) { unsigned sum = 0u, mine = 0u;
#pragma unroll
                for (unsigned j = 0; j < 16; ++j) { const unsigned c = xb_ld(&ctl[GB_N(b.g, j)]); sum += c; mine = (j == b.x) ? c : mine; }
                n = mine; if (sum == b.ng) break;
                __builtin_amdgcn_s_sleep(1); if (++sp > (1u << 22)) break; }
            n = n ? n : 1u; b.st[0] = n;
        }
        const unsigned old = xb_add(&ctl[GB_A(b.g, b.x)], 1u);
        if (old + 1u == epoch * n) {
            __builtin_amdgcn_fence(__ATOMIC_RELEASE, "agent");
            asm volatile("s_waitcnt vmcnt(0)" ::: "memory");
            (void)xb_add(&ctl[GB_GC(b.g)], n);
        }
        unsigned sp = 0u; const unsigned target = epoch * b.ng;
        while (xb_ld(&ctl[GB_GC(b.g)]) < target) { __builtin_amdgcn_s_sleep(1); if (++sp > (1u << 22)) break; }
        __builtin_amdgcn_fence(__ATOMIC_ACQUIRE, "agent");
        asm volatile("s_waitcnt vmcnt(0)" ::: "memory");
    }
    __syncthreads();
}
__device__ __forceinline__ void group_barrier_arrive(const GroupBarrier& b, unsigned epoch) {
    asm volatile("s_waitcnt vmcnt(0)" ::: "memory");
    __syncthreads();
    if (threadIdx.x == 0) {
        unsigned* ctl = b.ctl; const unsigned n = b.st[0];
        const unsigned old = xb_add(&ctl[GB_A(b.g, b.x)], 1u);
        if (old + 1u == epoch * n) {
            __builtin_amdgcn_fence(__ATOMIC_RELEASE, "agent");
            asm volatile("s_waitcnt vmcnt(0)" ::: "memory");
            (void)xb_add(&ctl[GB_GC(b.g)], n);
        }
    }
}
__device__ __forceinline__ void group_barrier_wait(const GroupBarrier& b, unsigned epoch) {
    if (threadIdx.x == 0) {
        unsigned* ctl = b.ctl; unsigned sp = 0u; const unsigned target = epoch * b.ng;
        while (xb_ld(&ctl[GB_GC(b.g)]) < target) { __builtin_amdgcn_s_sleep(1); if (++sp > (1u << 22)) break; }
        __builtin_amdgcn_fence(__ATOMIC_ACQUIRE, "agent");
        asm volatile("s_waitcnt vmcnt(0)" ::: "memory");
    }
    __syncthreads();
}
#ifndef MK_LAUNCHES
#define MK_LAUNCHES 1
#endif
#ifndef WGM_MOE1
#define WGM_MOE1 8
#endif
#ifndef WGM_MOE2
#define WGM_MOE2 8
#endif
constexpr int NPH = 11;
typedef const __attribute__((address_space(4))) Args* kargs_t;
DEV Args load_args(kargs_t kp) { Args a;
#pragma unroll
    for (int i = 0; i < 13; ++i) a.in[i] = kp->in[i];
    a.out = kp->out; a.ws = kp->ws; a.ph_lo = kp->ph_lo; a.ph_hi = kp->ph_hi;
#pragma unroll
    for (int i = 0; i < 16; ++i) a.rep[i] = kp->rep[i];
    return a; }
__global__ void __launch_bounds__(NTHR, 2) mega(Args a_) {
    kargs_t kp = (kargs_t)__builtin_amdgcn_kernarg_segment_ptr();
    extern __shared__ __attribute__((aligned(16))) unsigned char lds[];
    int tid = threadIdx.x, lane = tid & 63, wave = __builtin_amdgcn_readfirstlane(tid >> 6);
    const int G = gridDim.x, wg = blockIdx.x, NGW = G * NWAVES; int gw = wg * NWAVES + wave;
#define FRESH_IDS() do { tid = threadIdx.x; asm volatile("" : "+v"(tid)); lane = tid & 63; wave = __builtin_amdgcn_readfirstlane(tid >> 6); gw = wg * NWAVES + wave; } while (0)
    const int lo = kp->ph_lo, hi = kp->ph_hi;
    unsigned char* ws = kp->ws;
    volatile LAS unsigned* bst = (volatile LAS unsigned*)((LAS unsigned char*)lds + LDS_BYTES - 64);
    if (tid < 4) bst[tid] = 0u;
    __syncthreads();
    XcdBarrier bar = xcd_barrier_post((unsigned*)(ws + WS_CTL) + 4096, bst);
    const GroupBarrier gbar = group_barrier_post((unsigned*)(ws + WS_CTL), (unsigned)(wg & 7), (unsigned)(G >> 3), bst + 2);
    const GroupBarrier gall = group_barrier_post((unsigned*)(ws + WS_CTL), 8u, (unsigned)G, bst + 3);
    unsigned gep = 0u;
#define IN(k) (lo <= (k) && (k) < hi)
#define SEAM(k) do { if (IN(k) && IN((k) + 1)) { if ((k) >= 1 && (k) <= 6) group_barrier(gbar, (unsigned)(k)); else group_barrier(gall, ++gep); } } while (0)
    if (IN(0)) { FRESH_IDS(); const Args a = load_args(kp); unsigned char* ws = a.ws; for (int r = 0; r < a.rep[6]; ++r) { FRESH_IDS(); phase_prep(a, lds, gw, NGW, lane, wave); } }
    SEAM(0);
    if (IN(1)) { FRESH_IDS(); const Args a = load_args(kp); unsigned char* ws = a.ws;
        if (G == 256 && (wg >> 3) >= P1_GW) { phase_conv1(a, lds, ((wg & 7) * (32 - P1_GW) + (wg >> 3) - P1_GW) * NWAVES + wave, 8 * (32 - P1_GW) * NWAVES, lane, wave, CONV1_TILES); __syncthreads(); }
        { const int gwn = G == 256 ? P1_GW : (G >> 3);
          pg8::Gemm g{(const bf16_t*)(ws + WS_XN), (const bf16_t*)(ws + WS_WIN), D}; SchedInProj Sc; Sc.init(M, PC, G, wg); Sc.upg = 128; Sc.ncol = 8; Sc.pn0 = 0; Sc.gw = gwn; Sc.rev = 0; Sc.f8 = 0;
          EpiInProj E{ws, (const float*)(ws + WS_ROPE), 1.f};
          for (int r = 0; r < a.rep[8]; ++r) { FRESH_IDS(); pg8::Gemm g2 = g; asm volatile("" : "+s"(g2.A), "+s"(g2.Bt)); pg8::gemm_phase<EpiInProj, SchedInProj, true>((LAS unsigned char*)lds, g2, Sc, E); }
          pg8::Gemm g8{(const bf16_t*)(ws + WS_ATTO), (const bf16_t*)(ws + WS_WIN8 - (size_t)8 * 256 * D), D}; SchedInProj Sc8; Sc8.init(M, PC, G, wg); Sc8.upg = 96; Sc8.ncol = 6; Sc8.pn0 = 8; Sc8.gw = gwn; Sc8.rev = 1; Sc8.f8 = 1;
          EpiInProj E8{ws, (const float*)(ws + WS_ROPE), 1.f / 32.f};
          for (int r = 0; r < a.rep[8]; ++r) { FRESH_IDS(); pg8::Gemm g2 = g8; asm volatile("" : "+s"(g2.A), "+s"(g2.Bt)); pg8::gemm_phase<EpiInProj, SchedInProj, true, true>((LAS unsigned char*)lds, g2, Sc8, E8); } } }
    SEAM(1);
    if (IN(2)) { FRESH_IDS(); const Args a = load_args(kp); unsigned char* ws = a.ws; phase_mix_a(a, lds, wg, G, lane, wave, tid); }
    SEAM(2);
    if (IN(3)) { FRESH_IDS(); const Args a = load_args(kp); unsigned char* ws = a.ws; for (int r = 0; r < a.rep[13]; ++r) { FRESH_IDS(); phase_scan(a, wg & 7, (wg >> 3) * NTHR + tid, (G >> 3) * NTHR); } }
    const bool s3 = IN(3) && IN(4);
    if (s3) group_barrier_arrive(gbar, 3u);
    if (IN(4)) { FRESH_IDS(); const Args a = load_args(kp); unsigned char* ws = a.ws; phase_mix_b(a, lds, wg, G, lane, wave, tid, [&]() { if (s3) group_barrier_wait(gbar, 3u); }); }
    const bool s4 = IN(4) && IN(5);
    if (s4) group_barrier_arrive(gbar, 4u);
    { const Args a = load_args(kp); for (int r = 0; r < a.rep[14]; ++r) xcd_barrier(bar); for (int r = 0; r < a.rep[15]; ++r) cg::this_grid().sync(); }
    if (IN(5)) { FRESH_IDS(); const Args a = load_args(kp); unsigned char* ws = a.ws; pg8::Gemm g{(const bf16_t*)(ws + WS_AK), (const bf16_t*)(ws + WS_WOUT), D}; SchedMix Sc; Sc.init(M, D, G, wg);
        EpiOutProj E{a.in[IN_G1], ws};
        for (int r = 0; r < a.rep[9]; ++r) { FRESH_IDS(); pg8::Gemm g2 = g; asm volatile("" : "+s"(g2.A), "+s"(g2.Bt)); pg8::gemm_phase<EpiOutProj, SchedMix, true>((LAS unsigned char*)lds, g2, Sc, E, [&]() { if (s4 && r == 0) group_barrier_wait(gbar, 4u); }); } }
    SEAM(5);
    if (IN(6)) { FRESH_IDS(); const Args a = load_args(kp); unsigned char* ws = a.ws; for (int r = 0; r < a.rep[4]; ++r) { FRESH_IDS(); phase_router(a, lds, wg & 7, (wg >> 3) * NWAVES + wave, (G >> 3) * NWAVES, lane, tid); } }
    SEAM(6);
    if (IN(7)) { FRESH_IDS(); const Args a = load_args(kp); unsigned char* ws = a.ws; for (int r = 0; r < a.rep[7]; ++r) { FRESH_IDS(); phase_topk(a, lds, wg, G, tid, lane, wave); } }
    const bool s7 = IN(7) && IN(8);
    if (s7) group_barrier_arrive(gall, ++gep);
    if (IN(8)) { FRESH_IDS(); const Args a = load_args(kp); unsigned char* ws = a.ws; pg8::Gemm g{(const bf16_t*)(ws + WS_XN), (const bf16_t*)(ws + WS_WGU), D}; SchedMoe1 Sc; Sc.init(MR, 4096, G, wg, WGM_MOE1); Sc.idxl = (const LAS int*)((LAS unsigned char*)lds + 131072);
        auto stage_idx = [&]() { const int* idxg = (const int*)(ws + WS_IDX); LAS int* il = (LAS int*)((LAS unsigned char*)lds + 131072); pg8::Unit uu;
          if (tid < 256) { int iv[16];
#pragma unroll
              for (int i = 0; i < 16; ++i) { const bool ok = Sc.next(i, uu); iv[i] = idxg[(ok ? uu.pm : 0) * 256 + tid]; }
#pragma unroll
              for (int i = 0; i < 16; ++i) il[i * 256 + tid] = iv[i]; }
          __syncthreads(); };
        EpiSwiGLU E{ws + WS_HID};
        for (int r = 0; r < a.rep[10]; ++r) { FRESH_IDS(); pg8::Gemm g2 = g; asm volatile("" : "+s"(g2.A), "+s"(g2.Bt)); pg8::gemm_phase<EpiSwiGLU, SchedMoe1, true, true>((LAS unsigned char*)lds, g2, Sc, E, [&]() { if (r == 0) { if (s7) group_barrier_wait(gall, gep); stage_idx(); } }); } }
    const bool s8 = IN(8) && IN(9);
    if (s8) group_barrier_arrive(gall, ++gep);
    if (IN(9)) { FRESH_IDS(); const Args a = load_args(kp); unsigned char* ws = a.ws; pg8::Gemm g{(const bf16_t*)(ws + WS_HID), (const bf16_t*)(ws + WS_WD), DFF}; SchedMoe2 Sc; Sc.init(MR, D, G, wg, WGM_MOE2);
        EpiDown E{ws + WS_Y};
        for (int r = 0; r < a.rep[11]; ++r) { FRESH_IDS(); pg8::Gemm g2 = g; asm volatile("" : "+s"(g2.A), "+s"(g2.Bt)); pg8::gemm_phase<EpiDown, SchedMoe2, true, true>((LAS unsigned char*)lds, g2, Sc, E, [&]() { if (s8 && r == 0) group_barrier_wait(gall, gep); }); } }
    const bool s9 = IN(9) && IN(10);
    if (s9) group_barrier_arrive(gall, ++gep);
    if (IN(10)) { FRESH_IDS(); const Args a = load_args(kp); unsigned char* ws = a.ws; for (int r = 0; r < a.rep[12]; ++r) { FRESH_IDS(); phase_final(a, gw, NGW, lane, [&]() { if (s9 && r == 0) group_barrier_wait(gall, gep); }); } }
#undef IN
#undef SEAM
}

extern "C" void kernel_launch(void* const* d_in, const int* in_sizes, int n_in, void* d_out, int out_size, void* d_ws, size_t ws_size, hipStream_t stream) {
    static int grid = 0;
    if (grid == 0) {
        if (n_in != 13 || in_sizes[0] != M * D || out_size != M * D || ws_size < WS_END) { fprintf(stderr, "kernel_launch: unexpected shapes n_in %d in0 %d out %d ws %zu (need %zu)\n", n_in, n_in > 0 ? in_sizes[0] : -1, out_size, ws_size, (size_t)WS_END); grid = -1; return; }
        int dev = 0, cus = 0, per_cu = 0;
        (void)hipGetDevice(&dev); (void)hipDeviceGetAttribute(&cus, hipDeviceAttributeMultiprocessorCount, dev);
        (void)hipFuncSetAttribute((const void*)mega, hipFuncAttributeMaxDynamicSharedMemorySize, LDS_BYTES);
        if (hipOccupancyMaxActiveBlocksPerMultiprocessor(&per_cu, (const void*)mega, NTHR, LDS_BYTES) != hipSuccess || per_cu < 1) { fprintf(stderr, "kernel_launch: occupancy query says %d blocks/CU\n", per_cu); per_cu = 1; }
        (void)hipGetLastError();
        grid = cus * 1;
        if (grid > cus * per_cu) grid = cus * per_cu;
    }
    if (grid < 0) return;
    (void)hipMemsetAsync((char*)d_ws + WS_CTL + 16384, 0, 49152, stream);
    Args a{};
    for (int i = 0; i < 13; ++i) a.in[i] = (const float*)d_in[i];
    a.out = (float*)d_out; a.ws = (unsigned char*)d_ws;
#ifndef PROBE_R
#define PROBE_R {1, 1, 1, 1, 1, 1, 1, 1, 1, 1, 1, 1, 1, 1, 0, 0}
#endif
    { const int rr[16] = PROBE_R; for (int i = 0; i < 16; ++i) a.rep[i] = rr[i]; }
#if MK_LAUNCHES == 1
    a.ph_lo = 0; a.ph_hi = NPH;
    void* args[] = {&a};
    hipError_t e = hipLaunchCooperativeKernel((const void*)mega, dim3(grid), dim3(NTHR), args, LDS_BYTES, stream);
    if (e != hipSuccess) fprintf(stderr, "cooperative launch failed: %s (grid %d)\n", hipGetErrorString(e), grid);
#else
    for (int p = 0; p < NPH; ++p) { a.ph_lo = p; a.ph_hi = p + 1; hipLaunchKernelGGL(mega, dim3(grid), dim3(NTHR), LDS_BYTES, stream, a); }
#endif
}
```
